# Optimizing an MI355X kernel written in HIP

```python
import math
import jax, jax.numpy as jnp
from jax import lax
import numpy as np

D_MODEL = 1024
BATCH = 1
SEQ = 16384
DEPTH = 1

MIX_WIDTH = D_MODEL
HG_HEADS = 4
HG_VAL_DIM = (MIX_WIDTH // 2) // HG_HEADS
HG_KEY_DIM = HG_VAL_DIM
HG_CHUNK = 64
DA_HEADS = 4
DA_V_DIM = (MIX_WIDTH // 2) // DA_HEADS
DA_QK_DIM = DA_V_DIM // 2
Q_BLOCK = 128
ROPE_THETA = 500000.0
ROT_DIM = DA_QK_DIM // 4
N_GROUPS = 4
EXPERTS_PER_GROUP = 8
N_EXPERTS = N_GROUPS * EXPERTS_PER_GROUP
TOP_K_IN_GROUP = 2
D_EXPERT = D_MODEL // 2
NORM_EPS = 1e-6
SUBLN_EPS = 1e-5

IN_SPLITS = (HG_HEADS * HG_KEY_DIM, HG_HEADS * HG_KEY_DIM, HG_HEADS * HG_KEY_DIM,
             HG_HEADS * HG_VAL_DIM, HG_HEADS * HG_VAL_DIM,
             DA_HEADS * 2 * DA_QK_DIM, DA_HEADS * 2 * DA_QK_DIM, DA_HEADS * DA_V_DIM)
IN_WIDTH = sum(IN_SPLITS)

kernel_name = 'hybrid_hgrn2_diffattn_hmoe_encoder'


def rms_norm(x, gain, eps=NORM_EPS):
    xf = x.astype(jnp.float32)
    y = xf * lax.rsqrt(jnp.mean(xf * xf, axis=-1, keepdims=True) + eps)
    return (y * gain.astype(jnp.float32)).astype(x.dtype)


def partial_rotary(t, positions):
    half = ROT_DIM // 2
    inv_freq = jnp.float32(ROPE_THETA) ** (-jnp.arange(0, ROT_DIM, 2, dtype=jnp.float32) / ROT_DIM)
    ang = positions.astype(jnp.float32)[:, :, None, None] * inv_freq
    cos = jnp.cos(ang).astype(t.dtype)
    sin = jnp.sin(ang).astype(t.dtype)
    t1 = t[..., :half]
    t2 = t[..., half:ROT_DIM]
    return jnp.concatenate([t1 * cos - t2 * sin, t2 * cos + t1 * sin, t[..., ROT_DIM:]], axis=-1)


def hgrn2_chunkwise(q, k, v, log_f):
    G, S, K = q.shape
    V = v.shape[-1]
    n_chunks = S // HG_CHUNK

    def split(a):
        return jnp.moveaxis(a.reshape(G, n_chunks, HG_CHUNK, a.shape[-1]), 1, 0)

    tri = jnp.tril(jnp.ones((HG_CHUNK, HG_CHUNK), dtype=bool))[None, :, :, None]

    def step(state, blk):
        qc, kc, vc, lfc = blk
        b = jnp.cumsum(lfc, axis=1)
        o_inter = jnp.einsum('gck,gkv->gcv', qc * jnp.exp(b), state)
        rel = jnp.where(tri, b[:, :, None, :] - b[:, None, :, :], -jnp.inf)
        scores = jnp.einsum('gtk,gsk,gtsk->gts', qc, kc, jnp.exp(rel))
        o_intra = jnp.einsum('gts,gsv->gtv', scores, vc)
        b_last = b[:, -1]
        new_state = jnp.exp(b_last)[:, :, None] * state + jnp.einsum(
            'gsk,gsv->gkv', kc * jnp.exp(b_last[:, None, :] - b), vc)
        return new_state, o_inter + o_intra

    init = jnp.zeros((G, K, V), jnp.float32)
    _, o = lax.scan(step, init, (split(q), split(k), split(v), split(log_f)))
    return jnp.moveaxis(o, 0, 1).reshape(G, S, V)


def hgrn2_bidirectional(q, i, f_fwd, f_bwd):
    B, S, H, _ = q.shape

    def flip(a):
        return a[:, ::-1]

    def to_groups(a):
        return jnp.transpose(a, (0, 1, 3, 2, 4)).reshape(2 * B * H, S, a.shape[-1])

    f2 = jnp.stack([f_fwd, flip(f_bwd)]).astype(jnp.float32)
    q2 = to_groups(jnp.stack([q, flip(q)]).astype(jnp.float32))
    v2 = to_groups(jnp.stack([i, flip(i)]).astype(jnp.float32))
    o = hgrn2_chunkwise(q2, to_groups(1.0 - f2), v2, to_groups(jnp.log(f2)))
    o = jnp.transpose(o.reshape(2, B, H, S, -1), (0, 1, 3, 2, 4))
    return o[0] + flip(o[1])


def diff_attention(q, k, v, lam):
    B, S, H, _, d = q.shape
    n_blocks = S // Q_BLOCK
    qb = jnp.moveaxis(q.reshape(B, n_blocks, Q_BLOCK, H, 2, d), 1, 0)
    kf = k.astype(jnp.float32)
    vf = v.astype(jnp.float32)
    scale = d ** -0.5

    def block(q_blk):
        s = jnp.einsum('bqhcd,bkhcd->bhcqk', q_blk.astype(jnp.float32), kf) * scale
        p = jax.nn.softmax(s, axis=-1)
        a = p[:, :, 0] - lam * p[:, :, 1]
        return jnp.einsum('bhqk,bkhv->bqhv', a, vf)

    o = lax.map(block, qb)
    return jnp.moveaxis(o, 0, 1).reshape(B, S, H, -1)


def hierarchical_moe(h, rg_w, rg_b, re_w, re_b, w_gate, w_up, w_down):
    B, S, D = h.shape
    hf = h.reshape(B * S, D)
    group_prob = jax.nn.softmax((hf @ rg_w + rg_b).astype(jnp.float32), axis=-1)
    g_idx = jnp.argmax(group_prob, axis=-1)
    g_p = jnp.take_along_axis(group_prob, g_idx[:, None], axis=-1)
    exp_logits = (hf @ re_w + re_b).astype(jnp.float32).reshape(-1, N_GROUPS, EXPERTS_PER_GROUP)
    in_group = jnp.take_along_axis(exp_logits, g_idx[:, None, None], axis=1)[:, 0]
    top_p, top_e = lax.top_k(jax.nn.softmax(in_group, axis=-1), TOP_K_IN_GROUP)
    weights = g_p * top_p / jnp.sum(top_p, axis=-1, keepdims=True)
    expert_id = g_idx[:, None] * EXPERTS_PER_GROUP + top_e
    gates = jnp.sum(jax.nn.one_hot(expert_id, N_EXPERTS, dtype=jnp.float32) * weights[..., None], axis=1)
    y = jnp.zeros(hf.shape, jnp.float32)
    for e in range(N_EXPERTS):
        a = jax.nn.silu(hf @ w_gate[e]) * (hf @ w_up[e])
        y = y + gates[:, e:e + 1] * (a @ w_down[e]).astype(jnp.float32)
    return y.reshape(B, S, D).astype(h.dtype)


def setup_inputs(seed: int = 0) -> dict:
    key = jax.random.key(seed)
    ks = jax.random.split(key, 20)

    def nrm(k, shape, scale):
        return jax.random.normal(k, shape, jnp.float32) * scale

    return {
        'x': nrm(ks[0], (BATCH, SEQ, D_MODEL), 1.0),
        'positions': jnp.broadcast_to(jnp.arange(SEQ, dtype=jnp.int32), (BATCH, SEQ)),
        'norm1_gain': 1.0 + nrm(ks[1], (DEPTH, D_MODEL), 0.02),
        'w_in': nrm(ks[2], (DEPTH, D_MODEL, IN_WIDTH), D_MODEL ** -0.5),
        'hg_lower_bounds': 1.0 + nrm(ks[3], (2, DEPTH + 1, HG_HEADS * HG_KEY_DIM), 0.1),
        'hg_norm_gain': 1.0 + nrm(ks[4], (DEPTH, HG_VAL_DIM), 0.02),
        'diff_lambda': nrm(ks[5], (DEPTH, 4, DA_QK_DIM), 0.1),
        'diff_subln_gain': 1.0 + nrm(ks[6], (DEPTH, DA_V_DIM), 0.02),
        'w_out': nrm(ks[7], (DEPTH, MIX_WIDTH, D_MODEL), MIX_WIDTH ** -0.5),
        'norm2_gain': 1.0 + nrm(ks[8], (DEPTH, D_MODEL), 0.02),
        'router_group_w': nrm(ks[9], (DEPTH, D_MODEL, N_GROUPS), D_MODEL ** -0.5),
        'router_group_b': nrm(ks[10], (DEPTH, N_GROUPS), 0.01),
        'router_expert_w': nrm(ks[11], (DEPTH, D_MODEL, N_EXPERTS), D_MODEL ** -0.5),
        'router_expert_b': nrm(ks[12], (DEPTH, N_EXPERTS), 0.01),
        'moe_w_gate': nrm(ks[13], (DEPTH, N_EXPERTS, D_MODEL, D_EXPERT), D_MODEL ** -0.5),
        'moe_w_up': nrm(ks[14], (DEPTH, N_EXPERTS, D_MODEL, D_EXPERT), D_MODEL ** -0.5),
        'moe_w_down': nrm(ks[15], (DEPTH, N_EXPERTS, D_EXPERT, D_MODEL), D_EXPERT ** -0.5),
        'final_norm_gain': 1.0 + nrm(ks[16], (D_MODEL,), 0.02),
    }


def reference(x, positions, norm1_gain, w_in, hg_lower_bounds, hg_norm_gain, diff_lambda,
              diff_subln_gain, w_out, norm2_gain, router_group_w, router_group_b,
              router_expert_w, router_expert_b, moe_w_gate, moe_w_up, moe_w_down,
              final_norm_gain):
    B, S, _ = x.shape
    split_at = np.cumsum(IN_SPLITS)[:-1].tolist()
    lb_cum = jnp.cumsum(jax.nn.softmax(hg_lower_bounds.astype(jnp.float32), axis=1), axis=1)

    def heads(a, n):
        return a.reshape(B, S, n, -1)

    for layer in range(DEPTH):
        h = rms_norm(x, norm1_gain[layer])
        proj = h @ w_in[layer]
        hq, hff, hfb, hi, hg, dq, dk, dv = jnp.split(proj, split_at, axis=-1)

        lb = lb_cum[:, layer + 1] - lb_cum[:, 0]
        f_fwd = lb[0] + (1.0 - lb[0]) * jax.nn.sigmoid(hff.astype(jnp.float32))
        f_bwd = lb[1] + (1.0 - lb[1]) * jax.nn.sigmoid(hfb.astype(jnp.float32))
        o_hg = hgrn2_bidirectional(heads(hq, HG_HEADS), heads(hi, HG_HEADS),
                                   heads(f_fwd, HG_HEADS), heads(f_bwd, HG_HEADS))
        o_hg = (rms_norm(o_hg, hg_norm_gain[layer])
                * jax.nn.silu(heads(hg, HG_HEADS).astype(jnp.float32))).reshape(B, S, -1)

        qd = partial_rotary(heads(dq, 2 * DA_HEADS), positions).reshape(B, S, DA_HEADS, 2, DA_QK_DIM)
        kd = partial_rotary(heads(dk, 2 * DA_HEADS), positions).reshape(B, S, DA_HEADS, 2, DA_QK_DIM)
        lam_p = diff_lambda[layer].astype(jnp.float32)
        lambda_init = 0.8 - 0.6 * math.exp(-0.3 * layer)
        lam = (jnp.exp(jnp.sum(lam_p[0] * lam_p[1])) - jnp.exp(jnp.sum(lam_p[2] * lam_p[3]))
               + lambda_init)
        o_da = diff_attention(qd, kd, heads(dv, DA_HEADS), lam)
        o_da = (rms_norm(o_da, diff_subln_gain[layer], SUBLN_EPS) * (1.0 - lambda_init)).reshape(B, S, -1)

        mixed = jnp.concatenate([o_hg, o_da], axis=-1).astype(x.dtype)
        x = x + mixed @ w_out[layer]

        h = rms_norm(x, norm2_gain[layer])
        x = x + hierarchical_moe(h, router_group_w[layer], router_group_b[layer],
                                 router_expert_w[layer], router_expert_b[layer],
                                 moe_w_gate[layer], moe_w_up[layer], moe_w_down[layer])

    return rms_norm(x, final_norm_gain)
```

```cpp
#include <hip/hip_runtime.h>
#include <cstdio>
#include <cstdint>
__device__ __forceinline__ int opaque_tid() { int t = threadIdx.x; asm volatile("" : "+v"(t)); return t; }
namespace pg8 {
#define PG8_LAS __attribute__((address_space(3)))
typedef unsigned short bf16_t;
typedef short bf16x8 __attribute__((ext_vector_type(8)));
typedef float f32x4 __attribute__((ext_vector_type(4)));
typedef unsigned u32x4 __attribute__((ext_vector_type(4)));
constexpr int BM = 256, BK = 64, HALF = 128, HTB = HALF * BK * 2  , STAGE_BYTES = 8 * HTB, NXCD = 8, WGM = 8;

__host__ __device__ __forceinline__ int lds_byte(int r, int c) { const int st = (r >> 4) * 2 + (c >> 5), rr = r & 15, cc = c & 31, ob = rr * 64 + cc * 2; return st * 1024 + (ob ^ (((ob >> 9) & 1) << 5)); }
__host__ __device__ __forceinline__ void stage_rc(int b, int& R, int& C) { const int st = b / 1024, sb = b % 1024, swz = sb ^ (((sb >> 9) & 1) << 5); R = (st >> 1) * 16 + swz / 64; C = (st & 1) * 32 + (swz % 64) / 2; }
__host__ __device__ __forceinline__ int perm32(int rho) { const int n = rho >> 4, i = rho & 15; return 8 * (i >> 2) + 4 * n + (i & 3); }

struct Unit { int pm, pn; };
struct Gemm { const bf16_t* A; const bf16_t* Bt; int M, N, K; };

struct StaticOrder {
    int nM, nN, nwg, G, c;
    __host__ __device__ void init(int M, int N, int G_, int c_) { nM = M / BM; nN = N / BM; nwg = nM * nN; G = G_; c = c_; }
    __host__ __device__ bool next(int i, Unit& u) const {
        const long L = (long)i * G + c; if (L >= nwg) return false;
        int wgid = (int)L; { const int q = nwg / NXCD, r = nwg % NXCD, xcd = wgid % NXCD, off = wgid / NXCD; wgid = (xcd < r ? xcd * (q + 1) : r * (q + 1) + (xcd - r) * q) + off; }
        const int nig = WGM * nN, gid = wgid / nig, fm = gid * WGM, gsz = (nM - fm) < WGM ? (nM - fm) : WGM;
        u.pm = fm + ((wgid % nig) % gsz); u.pn = (wgid % nig) / gsz; return true;
    }
    __device__ __forceinline__ void a_ready(const Unit&) const {}
    __device__ __forceinline__ void done(const Unit&) const {}
};

template <class Epi, class Sched, bool ALIGN_EPI = false, bool SP2 = false>
__device__ __forceinline__ void gemm_phase(PG8_LAS unsigned char* lds, const Gemm g, const Sched& S, const Epi& E) {
    const int tid = opaque_tid(), wid = __builtin_amdgcn_readfirstlane(tid >> 6), lane = tid & 63, wr = wid >> 2, wc = wid & 3, fr = lane & 15, fq = lane >> 4;
    const int K = g.K, nt = K / BK;
    unsigned voffA[2], voffB[2];
#pragma unroll
    for (int i = 0; i < 2; ++i) { int R, C; stage_rc(tid * 16 + i * 8192, R, C); const int Rb = Epi::PERM ? ((R & ~31) + perm32(R & 31)) : R;
        voffA[i] = (unsigned)(R * K + C) * 2u; voffB[i] = (unsigned)(Rb * K + C) * 2u; }
    const size_t kstep = (size_t)(BK * 2);
    const size_t hstep = (size_t)HALF * K * 2;
    const size_t tstep = 2 * hstep;
    const unsigned ldsw = (unsigned)wid * 1024u;
    const int aoff = lds_byte(wr * 64 + fr, fq * 8), boff = lds_byte(wc * 32 + fr, fq * 8);
#define PG8_SA(b, h) (((b) * 2 + (h)) * HTB)
#define PG8_SB(b, h) ((4 + (b) * 2 + (h)) * HTB)
#define PG8_STAGE(bufoff, gbase, voff) do { _Pragma("unroll") for (int _i = 0; _i < 2; ++_i) \
        __builtin_amdgcn_global_load_lds((const unsigned*)((const char*)(gbase) + (voff)[_i]), (PG8_LAS unsigned*)(lds + (bufoff) + ldsw + _i * 8192), 16, 0, 0); } while (0)
#define PG8_LDA(dst, b, h) do { _Pragma("unroll") for (int m = 0; m < 4; ++m) _Pragma("unroll") for (int k = 0; k < 2; ++k) dst[m][k] = *(const PG8_LAS bf16x8*)(lds + PG8_SA(b, h) + aoff + m * 2048 + k * 1024); } while (0)
#define PG8_LDB(dst, b, h) do { _Pragma("unroll") for (int n = 0; n < 2; ++n) _Pragma("unroll") for (int k = 0; k < 2; ++k) dst[n][k] = *(const PG8_LAS bf16x8*)(lds + PG8_SB(b, h) + boff + n * 2048 + k * 1024); } while (0)
#define PG8_MMA(ai, bj, At, Bt) do { __builtin_amdgcn_s_setprio(1); _Pragma("unroll") for (int m = 0; m < 4; ++m) _Pragma("unroll") for (int n = 0; n < 2; ++n) _Pragma("unroll") for (int k = 0; k < 2; ++k) \
        acc[ai][bj][m][n] = __builtin_amdgcn_mfma_f32_16x16x32_bf16(Bt[n][k], At[m][k], acc[ai][bj][m][n], 0, 0, 0); __builtin_amdgcn_s_setprio(0); } while (0)
#define PG8_WAIT_V(n) asm volatile("s_waitcnt vmcnt(" #n ")" ::: "memory")
#define PG8_WAIT_L(n) asm volatile("s_waitcnt lgkmcnt(" #n ")" ::: "memory")
#define PG8_BAR __builtin_amdgcn_s_barrier()
#define PG8_SCHED __builtin_amdgcn_sched_barrier(0)
    Unit cur, nxt; int ui = 0;
    if (!S.next(0, cur)) return;
    f32x4 acc[2][2][4][2];
#pragma unroll
    for (int a = 0; a < 2; ++a)
#pragma unroll
        for (int b = 0; b < 2; ++b)
#pragma unroll
            for (int m = 0; m < 4; ++m)
#pragma unroll
                for (int n = 0; n < 2; ++n) acc[a][b][m][n] = (f32x4){0.f, 0.f, 0.f, 0.f};
    bf16x8 At[4][2], B0[2][2], B1[2][2];
    const char* cA = (const char*)g.A + (size_t)cur.pm * tstep; const char* cB = (const char*)g.Bt + (size_t)cur.pn * tstep;
    S.a_ready(cur);
    if constexpr (SP2) {
        PG8_STAGE(PG8_SB(0, 0), cB, voffB); PG8_STAGE(PG8_SB(0, 1), cB + hstep, voffB); PG8_STAGE(PG8_SA(0, 0), cA, voffA); PG8_STAGE(PG8_SA(0, 1), cA + hstep, voffA);
        if (wr == 1) PG8_BAR;
        PG8_WAIT_V(2); PG8_BAR;
        PG8_STAGE(PG8_SB(1, 0), cB + kstep, voffB); PG8_STAGE(PG8_SA(1, 0), cA + kstep, voffA); PG8_STAGE(PG8_SB(1, 1), cB + hstep + kstep, voffB);
        PG8_WAIT_V(6); PG8_BAR;
    } else {
        PG8_STAGE(PG8_SB(0, 0), cB, voffB); PG8_STAGE(PG8_SA(0, 0), cA, voffA); PG8_STAGE(PG8_SB(0, 1), cB + hstep, voffB); PG8_STAGE(PG8_SA(0, 1), cA + hstep, voffA);
        if (wr == 1) PG8_BAR;
        PG8_WAIT_V(4); PG8_BAR;
        PG8_STAGE(PG8_SB(1, 0), cB + kstep, voffB); PG8_STAGE(PG8_SA(1, 0), cA + kstep, voffA); PG8_STAGE(PG8_SB(1, 1), cB + hstep + kstep, voffB);
        PG8_WAIT_V(6); PG8_BAR;
    }
    for (;;) {
        const bool has_next = S.next(ui + 1, nxt);
        const char* nA = has_next ? (const char*)g.A + (size_t)nxt.pm * tstep : cA; const char* nB = has_next ? (const char*)g.Bt + (size_t)nxt.pn * tstep : cB;
        for (int t = 0; t < nt; t += 2) {
            const bool last = (t == nt - 2);
            const char* a1 = cA + (size_t)(t + 1) * kstep;
            const char* a2 = last ? nA : cA + (size_t)(t + 2) * kstep; const char* b2 = last ? nB : cB + (size_t)(t + 2) * kstep;
            const char* a3 = a2 + kstep; const char* b3 = b2 + kstep;
            if (last && has_next) S.a_ready(nxt);
            if constexpr (SP2) {
            PG8_LDB(B0, 0, 0); PG8_LDB(B1, 0, 1); PG8_SCHED; PG8_LDA(At, 0, 0); PG8_STAGE(PG8_SA(1, 1), a1 + hstep, voffA);
            PG8_WAIT_V(8); PG8_WAIT_L(0); PG8_BAR; PG8_MMA(0, 0, At, B0); PG8_MMA(0, 1, At, B1); PG8_BAR; PG8_SCHED;
            PG8_LDA(At, 0, 1); PG8_STAGE(PG8_SB(0, 0), b2, voffB); PG8_STAGE(PG8_SB(0, 1), b2 + hstep, voffB); PG8_STAGE(PG8_SA(0, 0), a2, voffA);
            PG8_WAIT_V(8); PG8_WAIT_L(0); PG8_BAR; PG8_MMA(1, 0, At, B0); PG8_MMA(1, 1, At, B1); PG8_BAR; PG8_SCHED;
            PG8_LDB(B0, 1, 0); PG8_LDB(B1, 1, 1); PG8_SCHED; PG8_LDA(At, 1, 0); PG8_STAGE(PG8_SA(0, 1), a2 + hstep, voffA);
            PG8_WAIT_V(8); PG8_WAIT_L(0); PG8_BAR; PG8_MMA(0, 0, At, B0); PG8_MMA(0, 1, At, B1); PG8_BAR; PG8_SCHED;
            PG8_LDA(At, 1, 1); PG8_STAGE(PG8_SB(1, 0), b3, voffB); PG8_STAGE(PG8_SB(1, 1), b3 + hstep, voffB); PG8_STAGE(PG8_SA(1, 0), a3, voffA);
            PG8_WAIT_V(8); PG8_WAIT_L(0); PG8_BAR; PG8_MMA(1, 0, At, B0); PG8_MMA(1, 1, At, B1); PG8_BAR; PG8_SCHED;
            } else {
            PG8_LDB(B0, 0, 0); PG8_SCHED; PG8_LDA(At, 0, 0); PG8_STAGE(PG8_SA(1, 1), a1 + hstep, voffA);
            PG8_WAIT_L(8); PG8_BAR; PG8_WAIT_L(0); PG8_MMA(0, 0, At, B0); PG8_BAR; PG8_SCHED;
            PG8_LDB(B1, 0, 1); PG8_STAGE(PG8_SB(0, 0), b2, voffB);
            PG8_BAR; PG8_WAIT_L(0); PG8_MMA(0, 1, At, B1); PG8_BAR;
            PG8_LDA(At, 0, 1); PG8_STAGE(PG8_SA(0, 0), a2, voffA);
            PG8_BAR; PG8_WAIT_L(0); PG8_MMA(1, 0, At, B0); PG8_BAR; PG8_SCHED;
            PG8_STAGE(PG8_SB(0, 1), b2 + hstep, voffB);
            PG8_WAIT_V(6); PG8_BAR; PG8_MMA(1, 1, At, B1); PG8_BAR;
            PG8_LDB(B0, 1, 0); PG8_SCHED; PG8_LDA(At, 1, 0); PG8_STAGE(PG8_SA(0, 1), a2 + hstep, voffA);
            PG8_WAIT_L(8); PG8_BAR; PG8_WAIT_L(0); PG8_MMA(0, 0, At, B0); PG8_BAR; PG8_SCHED;
            PG8_LDB(B1, 1, 1); PG8_STAGE(PG8_SB(1, 0), b3, voffB);
            PG8_BAR; PG8_WAIT_L(0); PG8_MMA(0, 1, At, B1); PG8_BAR;
            PG8_LDA(At, 1, 1); PG8_STAGE(PG8_SA(1, 0), a3, voffA);
            PG8_BAR; PG8_WAIT_L(0); PG8_MMA(1, 0, At, B0); PG8_BAR; PG8_SCHED;
            PG8_STAGE(PG8_SB(1, 1), b3 + hstep, voffB);
            PG8_WAIT_V(6); PG8_BAR; PG8_MMA(1, 1, At, B1); PG8_BAR;
            }
        }
        if constexpr (ALIGN_EPI) { if (wr == 0) PG8_BAR; }
        if constexpr (!Epi::AFTER_DRAIN) { E(acc, cur, wr, wc, fr, fq); S.done(cur); }
        if (!has_next) break;
#pragma unroll
        for (int a = 0; a < 2; ++a)
#pragma unroll
            for (int b = 0; b < 2; ++b)
#pragma unroll
                for (int m = 0; m < 4; ++m)
#pragma unroll
                    for (int n = 0; n < 2; ++n) acc[a][b][m][n] = (f32x4){0.f, 0.f, 0.f, 0.f};
        cur = nxt; cA = nA; cB = nB; ++ui;
        if constexpr (ALIGN_EPI) { if (wr == 1) PG8_BAR; }
    }
    PG8_WAIT_V(0);
    if constexpr (!ALIGN_EPI) { if (wr == 0) PG8_BAR; }
    PG8_BAR;
    if constexpr (Epi::AFTER_DRAIN) { E.fused(acc, cur, wr, wc, fr, fq, lds, wid, lane); S.done(cur); }
#undef PG8_SA
#undef PG8_SB
#undef PG8_STAGE
#undef PG8_LDA
#undef PG8_LDB
#undef PG8_MMA
#undef PG8_WAIT_V
#undef PG8_WAIT_L
#undef PG8_BAR
#undef PG8_SCHED
}
}

constexpr int NWAVES = 8;
constexpr int M = 16384, D = 1024, NIN = 4096, HSEC = 512;
constexpr int NEXP = 32, DEXP = 512, MAXTILES = 160, MAXSLOTS = MAXTILES * 256;
constexpr float QSCALE = 0.18033688011112042f;

constexpr size_t MiB = 1u << 20;
constexpr size_t WS_CTL = 0, CTL_ZERO_BYTES = 1 * MiB;
constexpr size_t WS_WR = 1 * MiB;
constexpr size_t WS_ROPE = 2 * MiB;
constexpr size_t WS_HD = 3 * MiB;
constexpr size_t WS_TOKE = 3 * MiB + 256 * 1024, WS_TOKW = WS_TOKE + 128 * 1024, WS_TOKR = WS_TOKW + 128 * 1024, WS_TOKS = WS_TOKR + 128 * 1024, WS_LAM = WS_TOKS + 128 * 1024;
constexpr size_t WS_WOUT = 4 * MiB, WS_WIN = 6 * MiB;
constexpr size_t WS_XN = 16 * MiB;
constexpr size_t WS_OF = 16 * MiB;
constexpr size_t WS_H2 = 16 * MiB;
constexpr size_t WS_HM = 6 * MiB;
constexpr size_t WS_QH = 48 * MiB, WS_VH = 64 * MiB, WS_SG = 80 * MiB, WS_QD = 96 * MiB, WS_KD = 112 * MiB, WS_VD = 128 * MiB;
constexpr size_t WS_WGU = 48 * MiB, WS_WD = 112 * MiB;
constexpr size_t WS_GF = 144 * MiB, WS_GB = 176 * MiB;
constexpr size_t WS_MIX = 144 * MiB;
constexpr size_t WS_HS = 208 * MiB, WS_HL = 224 * MiB;
constexpr size_t WS_OB = 224 * MiB;
constexpr size_t WS_HG = 176 * MiB;
constexpr size_t WS_Y = 176 * MiB;
constexpr size_t WS_END = 256 * MiB;
static_assert(WS_HM + (size_t)MAXSLOTS * 512 * 2 <= WS_WGU && WS_HG + (size_t)MAXSLOTS * 1024 * 2 <= WS_END, "ws map");
constexpr int CW_BAR = 4096, CW_CNT = 16384;

constexpr int PHASE_LDS = 147456, MISC_OFF = PHASE_LDS, LDS_BYTES = PHASE_LDS + 1024;

#define GAS __attribute__((address_space(1)))
#define LAS __attribute__((address_space(3)))
typedef unsigned short bf16_t;
typedef float f32x4 __attribute__((ext_vector_type(4)));
typedef float f32x16 __attribute__((ext_vector_type(16)));
typedef short bf16x8 __attribute__((ext_vector_type(8)));
typedef short s16x4 __attribute__((ext_vector_type(4)));
typedef unsigned u32x4 __attribute__((ext_vector_type(4)));
typedef unsigned u32x2 __attribute__((ext_vector_type(2)));
#define LDS_WAIT() asm volatile("s_waitcnt lgkmcnt(0)" ::: "memory")
#define VM_WAIT() asm volatile("s_waitcnt vmcnt(0)" ::: "memory")
#define SBAR() __builtin_amdgcn_sched_barrier(0)
__device__ __forceinline__ unsigned f2bf(float f) { unsigned u = __builtin_bit_cast(unsigned, f); return (u + 0x7fffu + ((u >> 16) & 1u)) >> 16; }
__device__ __forceinline__ unsigned pk2(float lo, float hi) { return f2bf(lo) | (f2bf(hi) << 16); }
__device__ __forceinline__ float bf2f(unsigned b) { return __builtin_bit_cast(float, b << 16); }
__device__ __forceinline__ float bflo(unsigned w) { return __builtin_bit_cast(float, w << 16); }
__device__ __forceinline__ float bfhi(unsigned w) { return __builtin_bit_cast(float, w & 0xffff0000u); }
__device__ __forceinline__ unsigned cvtpk(float lo, float hi) { unsigned r; asm volatile("v_cvt_pk_bf16_f32 %0, %1, %2" : "=v"(r) : "v"(lo), "v"(hi)); return r; }
__device__ __forceinline__ float ex2(float x) { return __builtin_amdgcn_exp2f(x); }
__device__ __forceinline__ float lg2(float x) { return __builtin_amdgcn_logf(x); }
__device__ __forceinline__ float sigmoidf_(float v) { return __builtin_amdgcn_rcpf(1.f + ex2(-1.4426950408889634f * v)); }
__device__ __forceinline__ bool lane_is_hi() { return (opaque_tid() & 32) != 0; }
template <int X> __device__ __forceinline__ float lane_xor(float v) {
    if constexpr (X == 32) { auto rr = __builtin_amdgcn_permlane32_swap(__float_as_uint(v), __float_as_uint(v), false, false); return __uint_as_float(lane_is_hi() ? rr[0] : rr[1]); }
    else return __int_as_float(__builtin_amdgcn_ds_swizzle(__float_as_int(v), (X << 10) | 0x1F));
}
__device__ __forceinline__ float wave_sum(float v) {
    v += lane_xor<1>(v); v += lane_xor<2>(v); v += lane_xor<4>(v); v += lane_xor<8>(v); v += lane_xor<16>(v);
    auto rr = __builtin_amdgcn_permlane32_swap(__float_as_uint(v), __float_as_uint(v), false, false);
    return __uint_as_float(rr[0]) + __uint_as_float(rr[1]);
}
__device__ __forceinline__ int crow(int r, int hi) { return (r & 3) + 8 * (r >> 2) + 4 * hi; }
#define XB_TMO      128
#define XB_XCNT(j)  (256  + 64 * (j))
#define XB_XSUB(j)  (1280 + 64 * (j))
#define XB_XGEN(j)  (2304 + 64 * (j))
#define XB_TOP      3328
#define XB_TOPGEN   3392
#define XCD_BAR_WORDS 3456
#define XB_SPIN_CAP (1u << 18)

__device__ __forceinline__ unsigned xb_ld(unsigned* p)              { return __hip_atomic_load(p, __ATOMIC_RELAXED, __HIP_MEMORY_SCOPE_AGENT); }
__device__ __forceinline__ unsigned xb_add(unsigned* p, unsigned v) { return __hip_atomic_fetch_add(p, v, __ATOMIC_RELAXED, __HIP_MEMORY_SCOPE_AGENT); }
__device__ __forceinline__ unsigned xb_xcc_id() { return (unsigned)__builtin_amdgcn_s_getreg((3 << 11) | 20) & 0xFu; }
#define XB_SPIN(cond, bar) do { unsigned _sp = 0; while (cond) { __builtin_amdgcn_s_sleep(1); \
    if ((++_sp & 255u) == 0u) { if (xb_ld(&(bar)[XB_TMO])) break; if (_sp > XB_SPIN_CAP) { atomicAdd(&(bar)[XB_TMO], 1u); break; } } } } while (0)

struct XcdBarrier {
    unsigned* bar; unsigned x;
    volatile LAS unsigned* st;
};

__device__ __forceinline__ XcdBarrier xcd_barrier_post(unsigned* bar, volatile LAS unsigned* st) {
    XcdBarrier b; b.bar = bar; b.x = xb_xcc_id(); b.st = st;
    if (threadIdx.x == 0) (void)xb_add(&bar[XB_XCNT(b.x)], 1u);
    return b;
}
__device__ __forceinline__ void xcd_barrier_complete(unsigned* bar, unsigned x, unsigned& nloc, unsigned& nx) {
    const unsigned G = gridDim.x * gridDim.y * gridDim.z;
    unsigned sum, cnt, mine, sp = 0u;
    for (;;) {
        sum = 0u; cnt = 0u; mine = 0u;
#pragma unroll
        for (unsigned j = 0; j < 16; ++j) { const unsigned c = xb_ld(&bar[XB_XCNT(j)]); sum += c; cnt += (c > 0u) ? 1u : 0u; mine = (j == x) ? c : mine; }
        if (sum == G) break;
        __builtin_amdgcn_s_sleep(1);
        if ((++sp & 255u) == 0u) { if (xb_ld(&bar[XB_TMO])) break; if (sp > XB_SPIN_CAP) { atomicAdd(&bar[XB_TMO], 1u); break; } }
    }
    nloc = mine > 0u ? mine : 1u; nx = cnt > 0u ? cnt : 1u;
}

__device__ __forceinline__ void xcd_barrier(const XcdBarrier& b) {
    asm volatile("s_waitcnt vmcnt(0)" ::: "memory");
    __syncthreads();
    if (threadIdx.x == 0) {
        unsigned* bar = b.bar;
        __builtin_amdgcn_s_waitcnt(0);
        unsigned nloc = b.st[0], nx = b.st[1];
        if (nloc == 0u) { xcd_barrier_complete(bar, b.x, nloc, nx); b.st[0] = nloc; b.st[1] = nx; }
        const unsigned old = xb_add(&bar[XB_XSUB(b.x)], 1u);
        const unsigned gen = old / nloc;
        if (old + 1u == (gen + 1u) * nloc) {
            __builtin_amdgcn_fence(__ATOMIC_RELEASE, "agent");
            asm volatile("s_waitcnt vmcnt(0)" ::: "memory");
            const unsigned og = xb_add(&bar[XB_TOP], 1u);
            const unsigned tg = og / nx;
            if (og + 1u == (tg + 1u) * nx) xb_add(&bar[XB_TOPGEN], 1u);
            else XB_SPIN(xb_ld(&bar[XB_TOPGEN]) == tg, bar);
            __builtin_amdgcn_fence(__ATOMIC_ACQUIRE, "agent");
            xb_add(&bar[XB_XGEN(b.x)], 1u);
            asm volatile("s_waitcnt vmcnt(0)" ::: "memory");
        } else {
            XB_SPIN(xb_ld(&bar[XB_XGEN(b.x)]) == gen, bar);
            __builtin_amdgcn_fence(__ATOMIC_ACQUIRE, "agent");
            asm volatile("s_waitcnt vmcnt(0)" ::: "memory");
        }
    }
    __syncthreads();
}

__device__ __forceinline__ void transpose_item(const float* W, int K, int N, bf16_t* WT, int row_off, int row_mul, LAS float* scr, int item, int lane) {
    const int nblk = N / 32, kb = item / nblk, nb = item % nblk, k0 = 64 * kb, n0 = 32 * nb;
#pragma unroll 8
    for (int i = 0; i < 32; ++i) { const int kk = 2 * i + (lane >> 5); scr[kk * 33 + (lane & 31)] = W[(size_t)(k0 + kk) * N + n0 + (lane & 31)]; }
    LDS_WAIT(); asm volatile("" ::: "memory");
    const int c = lane & 7;
#pragma unroll
    for (int j = 0; j < 4; ++j) { const int n = (lane >> 3) + 8 * j; const LAS float* s = scr + (8 * c) * 33 + n;
        u32x4 o; o.x = pk2(s[0 * 33], s[1 * 33]); o.y = pk2(s[2 * 33], s[3 * 33]); o.z = pk2(s[4 * 33], s[5 * 33]); o.w = pk2(s[6 * 33], s[7 * 33]);
        *(GAS u32x4*)(WT + (size_t)(row_off + (n0 + n) * row_mul) * K + k0 + 8 * c) = o; }
    LDS_WAIT(); asm volatile("" ::: "memory");
}
__device__ __forceinline__ void rms_row_to_bf16(const float* xrow, const float* gain, bf16_t* orow, int lane, float eps) {
    const GAS f32x4* xr = (const GAS f32x4*)xrow + lane; const GAS f32x4* gr = (const GAS f32x4*)gain + lane;
    f32x4 v[4]; float s = 0.f;
#pragma unroll
    for (int j = 0; j < 4; ++j) { v[j] = xr[64 * j]; s += (v[j].x * v[j].x + v[j].y * v[j].y) + (v[j].z * v[j].z + v[j].w * v[j].w); }
    const float rstd = 1.f / sqrtf(wave_sum(s) * (1.f / 1024.f) + eps);
    GAS u32x2* o8 = (GAS u32x2*)orow + lane;
#pragma unroll
    for (int j = 0; j < 4; ++j) { const f32x4 g = gr[64 * j]; u32x2 w; w.x = pk2(v[j].x * rstd * g.x, v[j].y * rstd * g.y); w.y = pk2(v[j].z * rstd * g.z, v[j].w * rstd * g.w); o8[64 * j] = w; }
}

struct EpiInProj {
    static constexpr bool PERM = true, AFTER_DRAIN = false;
    bf16_t *QH, *VH, *SG, *QD, *KD, *VD; float *GF, *GB; const float* lbraw; const float *cosT, *sinT;
    __device__ __forceinline__ void operator()(const pg8::f32x4 (&acc)[2][2][4][2], const pg8::Unit& u, int wr, int wc, int fr, int fq) const {
        const int sec = u.pn >> 1;
        const int row0 = u.pm * 256 + wr * 64 + fr;
        const int cs0 = (u.pn & 1) * 256 + wc * 32 + 8 * fq;
        if (sec == 1 || sec == 2) {
            float* G = sec == 1 ? GF : GB; const float* lbp = lbraw + (sec - 1) * 1024;
#pragma unroll
            for (int bj = 0; bj < 2; ++bj) { const int c = cs0 + bj * 128; float lb[8];
#pragma unroll
                for (int j = 0; j < 8; ++j) { const float l0 = lbp[c + j], l1 = lbp[512 + c + j]; lb[j] = __builtin_amdgcn_rcpf(1.f + ex2(1.4426950408889634f * (l0 - l1))); }
#pragma unroll
                for (int ai = 0; ai < 2; ++ai)
#pragma unroll
                    for (int m = 0; m < 4; ++m) { const int row = row0 + ai * 128 + m * 16; f32x4 o0, o1;
#pragma unroll
                        for (int j = 0; j < 4; ++j) { o0[j] = lg2(lb[j] + (1.f - lb[j]) * sigmoidf_(acc[ai][bj][m][0][j])); o1[j] = lg2(lb[4 + j] + (1.f - lb[4 + j]) * sigmoidf_(acc[ai][bj][m][1][j])); }
                        *(f32x4*)(G + (size_t)row * HSEC + c) = o0; *(f32x4*)(G + (size_t)row * HSEC + c + 4) = o1; } }
            return;
        }
        bf16_t* O = sec == 0 ? QH : sec == 3 ? VH : sec == 4 ? SG : sec == 5 ? QD : sec == 6 ? KD : VD;
        const bool rot = (sec == 5 || sec == 6) && ((wc & 1) == 0);
        const float sc = sec == 5 ? QSCALE : 1.f;
#pragma unroll
        for (int ai = 0; ai < 2; ++ai)
#pragma unroll
            for (int m = 0; m < 4; ++m) { const int row = row0 + ai * 128 + m * 16;
#pragma unroll
                for (int bj = 0; bj < 2; ++bj) { const int c = cs0 + bj * 128; float v[8];
#pragma unroll
                    for (int j = 0; j < 4; ++j) { v[j] = acc[ai][bj][m][0][j]; v[4 + j] = acc[ai][bj][m][1][j]; }
                    if (sec == 4) {
#pragma unroll
                        for (int j = 0; j < 8; ++j) v[j] = v[j] * sigmoidf_(v[j]);
                    }
                    if (rot) {
                        const f32x4 c0 = *(const f32x4*)(cosT + (size_t)row * 8), c1 = *(const f32x4*)(cosT + (size_t)row * 8 + 4);
                        const f32x4 s0 = *(const f32x4*)(sinT + (size_t)row * 8), s1 = *(const f32x4*)(sinT + (size_t)row * 8 + 4);
#pragma unroll
                        for (int j = 0; j < 8; ++j) { const float p = lane_xor<16>(v[j]); const float cj = j < 4 ? c0[j & 3] : c1[j & 3], sj = j < 4 ? s0[j & 3] : s1[j & 3];
                            const float r = fq == 0 ? v[j] * cj - p * sj : v[j] * cj + p * sj; v[j] = fq < 2 ? r : v[j]; }
                    }
                    u32x4 w; w.x = cvtpk(v[0] * sc, v[1] * sc); w.y = cvtpk(v[2] * sc, v[3] * sc); w.z = cvtpk(v[4] * sc, v[5] * sc); w.w = cvtpk(v[6] * sc, v[7] * sc);
                    *(u32x4*)(O + (size_t)row * HSEC + c) = w; } }
    }
};
struct EpiResid {
    static constexpr bool PERM = true, AFTER_DRAIN = false;
    const float* X; float* O;
    __device__ __forceinline__ void operator()(const pg8::f32x4 (&acc)[2][2][4][2], const pg8::Unit& u, int wr, int wc, int fr, int fq) const {
        const int row0 = u.pm * 256 + wr * 64 + fr, col0 = u.pn * 256 + wc * 32 + 8 * fq;
#pragma unroll
        for (int ai = 0; ai < 2; ++ai)
#pragma unroll
            for (int m = 0; m < 4; ++m) { const size_t off = (size_t)(row0 + ai * 128 + m * 16) * D + col0;
#pragma unroll
                for (int bj = 0; bj < 2; ++bj) { const f32x4 a = *(const f32x4*)(X + off + bj * 128), b = *(const f32x4*)(X + off + bj * 128 + 4);
                    *(f32x4*)(O + off + bj * 128) = a + acc[ai][bj][m][0]; *(f32x4*)(O + off + bj * 128 + 4) = b + acc[ai][bj][m][1]; } }
    }
};
struct EpiSwiGlu {
    static constexpr bool PERM = true, AFTER_DRAIN = false;
    bf16_t* O;
    __device__ __forceinline__ void operator()(const pg8::f32x4 (&acc)[2][2][4][2], const pg8::Unit& u, int wr, int wc, int fr, int fq) const {
        const int row0 = u.pm * 256 + wr * 64 + fr, col0 = ((u.pn & 3) * 256 + wc * 32 + 8 * fq) >> 1;
#pragma unroll
        for (int ai = 0; ai < 2; ++ai)
#pragma unroll
            for (int m = 0; m < 4; ++m) { bf16_t* rowp = O + (size_t)(row0 + ai * 128 + m * 16) * DEXP + col0;
#pragma unroll
                for (int bj = 0; bj < 2; ++bj) { const f32x4 a = acc[ai][bj][m][0], b = acc[ai][bj][m][1];
                    const float h0 = a[0] * sigmoidf_(a[0]) * a[1], h1 = a[2] * sigmoidf_(a[2]) * a[3], h2 = b[0] * sigmoidf_(b[0]) * b[1], h3 = b[2] * sigmoidf_(b[2]) * b[3];
                    u32x2 w; w.x = cvtpk(h0, h1); w.y = cvtpk(h2, h3); *(u32x2*)(rowp + bj * 64) = w; } }
    }
};
struct EpiDown {
    static constexpr bool PERM = true, AFTER_DRAIN = false;
    bf16_t* O;
    __device__ __forceinline__ void operator()(const pg8::f32x4 (&acc)[2][2][4][2], const pg8::Unit& u, int wr, int wc, int fr, int fq) const {
        const int row0 = u.pm * 256 + wr * 64 + fr, col0 = (u.pn & 3) * 256 + wc * 32 + 8 * fq;
#pragma unroll
        for (int ai = 0; ai < 2; ++ai)
#pragma unroll
            for (int m = 0; m < 4; ++m) { bf16_t* rowp = O + (size_t)(row0 + ai * 128 + m * 16) * D + col0;
#pragma unroll
                for (int bj = 0; bj < 2; ++bj) { const f32x4 a = acc[ai][bj][m][0], b = acc[ai][bj][m][1];
                    u32x4 w; w.x = cvtpk(a[0], a[1]); w.y = cvtpk(a[2], a[3]); w.z = cvtpk(b[0], b[1]); w.w = cvtpk(b[2], b[3]); *(u32x4*)(rowp + bj * 128) = w; } }
    }
};
struct MoeOrder {
    const volatile LAS int* tb; int G, c;
    __device__ __forceinline__ bool next(int i, pg8::Unit& u) const {
        const int L = i * G + c, T = __builtin_amdgcn_readfirstlane(tb[32]); if (L >= 4 * T) return false;
        const int tile = L >> 2; int e = 0;
#pragma unroll 1
        for (int j = 1; j < 32; ++j) e += (__builtin_amdgcn_readfirstlane(tb[j]) <= tile) ? 1 : 0;
        u.pm = tile; u.pn = e * 4 + (L & 3); return true;
    }
    __device__ __forceinline__ void a_ready(const pg8::Unit&) const {}
    __device__ __forceinline__ void done(const pg8::Unit&) const {}
};

namespace hg {
constexpr int S128 = 272, S64 = 144;
constexpr int L_QD = 0, L_QE = L_QD + 64 * S128, L_KE = L_QE + 64 * S128, L_KET = L_KE + 64 * S128, L_VT = L_KET + 128 * S64, L_ST = L_VT + 128 * S64,
              L_P = L_ST + 128 * S128, L_QS = L_P + 64 * S64, L_DC = L_QS + 4 * 128 * 4, L_END = L_DC + 128 * 4;
static_assert(L_END <= PHASE_LDS, "hgrn LDS");
__device__ __forceinline__ bf16x8 frag(const LAS unsigned char* base, int row, int stride, int kb  ) { return *(const LAS bf16x8*)(base + row * stride + kb); }

template <bool PASS_C>
__device__ __forceinline__ void pass(LAS unsigned char* lds, int unit, const bf16_t* QH, const bf16_t* VH, const float* GF, const float* GB,
                                     float* HL, float* HD, const float* HS, float* OF, float* OB) {
    const int tid = opaque_tid(), lane = tid & 63, wid = __builtin_amdgcn_readfirstlane(tid >> 6), r32 = lane & 31, hi = lane >> 5;
    const int dir = unit >> 7, head = (unit >> 5) & 3, sc = unit & 31;
    const int k = tid & 127, qtr = tid >> 7;
    const float* G = dir ? GB : GF; float* O = dir ? OB : OF;
    const int vi = wid >> 1, ki0 = (wid & 1) * 2;
    f32x16 sacc[2];
    LAS float* QS = (LAS float*)(lds + L_QS); LAS float* DC = (LAS float*)(lds + L_DC);
    if (PASS_C) {
        const float* hs = HS + (size_t)unit * 16384;
#pragma unroll
        for (int tt = 0; tt < 2; ++tt)
#pragma unroll
            for (int r = 0; r < 16; ++r) { const int v = vi * 32 + crow(r, hi), kk = (ki0 + tt) * 32 + r32; const float s = hs[v * 128 + kk]; sacc[tt][r] = s;
                *(LAS bf16_t*)(lds + L_ST + v * S128 + kk * 2) = (bf16_t)f2bf(s); }
    } else { sacc[0] = f32x16{}; sacc[1] = f32x16{}; }
    float btot = 0.f;
#pragma unroll 1
    for (int c = 0; c < 8; ++c) {
        const int t0 = sc * 512 + c * 64;
        float g[16]; unsigned qv[16], vv[16];
#pragma unroll
        for (int i = 0; i < 16; ++i) { const int tl = t0 + 16 * qtr + i, tok = dir ? (M - 1 - tl) : tl; const size_t off = (size_t)tok * HSEC + head * 128 + k;
            g[i] = G[off]; vv[i] = VH[off]; if (PASS_C) qv[i] = QH[off]; }
        float b[16]; b[0] = g[0];
#pragma unroll
        for (int i = 1; i < 16; ++i) b[i] = b[i - 1] + g[i];
        QS[qtr * 128 + k] = b[15];
        LDS_WAIT(); __syncthreads();
        float pre = 0.f, tot = 0.f;
#pragma unroll
        for (int q = 0; q < 4; ++q) { const float s = QS[q * 128 + k]; tot += s; pre += (q < qtr) ? s : 0.f; }
        btot += tot;
        if (qtr == 0) DC[k] = ex2(tot);
        unsigned ket[8], vt[8];
#pragma unroll
        for (int i = 0; i < 16; i += 2) {
            const float b0 = b[i] + pre, b1 = b[i + 1] + pre;
            const float ke0 = (1.f - ex2(g[i])) * ex2(tot - b0), ke1 = (1.f - ex2(g[i + 1])) * ex2(tot - b1);
            ket[i >> 1] = cvtpk(ke0, ke1); vt[i >> 1] = vv[i] | (vv[i + 1] << 16);
            if (PASS_C) {
                const int tr0 = 16 * qtr + i;
                const float q0 = bf2f(qv[i]), q1 = bf2f(qv[i + 1]);
                *(LAS bf16_t*)(lds + L_KE + tr0 * S128 + k * 2) = (bf16_t)(ket[i >> 1] & 0xffffu); *(LAS bf16_t*)(lds + L_KE + (tr0 + 1) * S128 + k * 2) = (bf16_t)(ket[i >> 1] >> 16);
                *(LAS bf16_t*)(lds + L_QD + tr0 * S128 + k * 2) = (bf16_t)f2bf(q0 * ex2(b0)); *(LAS bf16_t*)(lds + L_QD + (tr0 + 1) * S128 + k * 2) = (bf16_t)f2bf(q1 * ex2(b1));
                *(LAS bf16_t*)(lds + L_QE + tr0 * S128 + k * 2) = (bf16_t)f2bf(q0 * ex2(b0 - tot)); *(LAS bf16_t*)(lds + L_QE + (tr0 + 1) * S128 + k * 2) = (bf16_t)f2bf(q1 * ex2(b1 - tot));
            }
        }
        *(LAS u32x4*)(lds + L_KET + k * S64 + qtr * 32) = (u32x4){ket[0], ket[1], ket[2], ket[3]}; *(LAS u32x4*)(lds + L_KET + k * S64 + qtr * 32 + 16) = (u32x4){ket[4], ket[5], ket[6], ket[7]};
        *(LAS u32x4*)(lds + L_VT + k * S64 + qtr * 32) = (u32x4){vt[0], vt[1], vt[2], vt[3]};     *(LAS u32x4*)(lds + L_VT + k * S64 + qtr * 32 + 16) = (u32x4){vt[4], vt[5], vt[6], vt[7]};
        LDS_WAIT(); __syncthreads();
        if (PASS_C) {
            if (wid < 4) {
                const int ti = wid >> 1, si = wid & 1; f32x16 p = f32x16{};
                if (!(ti == 0 && si == 1)) {
#pragma unroll
                    for (int ks = 0; ks < 8; ++ks) p = __builtin_amdgcn_mfma_f32_32x32x16_bf16(frag(lds + L_QE, ti * 32 + r32, S128, ks * 32 + hi * 16), frag(lds + L_KE, si * 32 + r32, S128, ks * 32 + hi * 16), p, 0, 0, 0);
                }
#pragma unroll
                for (int r = 0; r < 16; ++r) { const int t = ti * 32 + crow(r, hi), s = si * 32 + r32; *(LAS bf16_t*)(lds + L_P + t * S64 + s * 2) = (bf16_t)f2bf(s <= t ? p[r] : 0.f); }
            }
            LDS_WAIT(); __syncthreads();
            { const int ti = wid >> 2, vo = wid & 3; f32x16 o = f32x16{};
#pragma unroll
                for (int ks = 0; ks < 8; ++ks) o = __builtin_amdgcn_mfma_f32_32x32x16_bf16(frag(lds + L_QD, ti * 32 + r32, S128, ks * 32 + hi * 16), frag(lds + L_ST, vo * 32 + r32, S128, ks * 32 + hi * 16), o, 0, 0, 0);
#pragma unroll
                for (int ss = 0; ss < 4; ++ss) o = __builtin_amdgcn_mfma_f32_32x32x16_bf16(frag(lds + L_P, ti * 32 + r32, S64, ss * 32 + hi * 16), frag(lds + L_VT, vo * 32 + r32, S64, ss * 32 + hi * 16), o, 0, 0, 0);
#pragma unroll
                for (int r = 0; r < 16; ++r) { const int tl = t0 + ti * 32 + crow(r, hi), tok = dir ? (M - 1 - tl) : tl; O[(size_t)tok * HSEC + head * 128 + vo * 32 + r32] = o[r]; }
            }
        }
#pragma unroll
        for (int tt = 0; tt < 2; ++tt) { const int ki = ki0 + tt; const float d = DC[ki * 32 + r32];
#pragma unroll
            for (int r = 0; r < 16; ++r) sacc[tt][r] *= d;
#pragma unroll
            for (int ss = 0; ss < 4; ++ss) sacc[tt] = __builtin_amdgcn_mfma_f32_32x32x16_bf16(frag(lds + L_VT, vi * 32 + r32, S64, ss * 32 + hi * 16), frag(lds + L_KET, ki * 32 + r32, S64, ss * 32 + hi * 16), sacc[tt], 0, 0, 0);
        }
        LDS_WAIT(); __syncthreads();
        if (PASS_C) {
#pragma unroll
            for (int tt = 0; tt < 2; ++tt)
#pragma unroll
                for (int r = 0; r < 16; ++r) { const int v = vi * 32 + crow(r, hi), kk = (ki0 + tt) * 32 + r32; *(LAS bf16_t*)(lds + L_ST + v * S128 + kk * 2) = (bf16_t)f2bf(sacc[tt][r]); }
        }
    }
    if (!PASS_C) {
        float* hl = HL + (size_t)unit * 16384;
#pragma unroll
        for (int tt = 0; tt < 2; ++tt)
#pragma unroll
            for (int r = 0; r < 16; ++r) { const int v = vi * 32 + crow(r, hi), kk = (ki0 + tt) * 32 + r32; hl[v * 128 + kk] = sacc[tt][r]; }
        if (qtr == 0) HD[unit * 128 + k] = ex2(btot);
    }
    __syncthreads();
}
__device__ __forceinline__ void scan(const float* HL, const float* HD, float* HS, int gtid, int gthreads) {
    for (int id = gtid; id < 8 * 16384; id += gthreads) {
        const int dh = id >> 14, e = id & 16383, k = e & 127; float S = 0.f;
#pragma unroll 4
        for (int sc = 0; sc < 32; ++sc) { const int u = dh * 32 + sc; HS[(size_t)u * 16384 + e] = S; S = HD[u * 128 + k] * S + HL[(size_t)u * 16384 + e]; }
    }
}
}

namespace att {
constexpr int QBLK = 32, KVBLK = 64, LDR = HSEC;
constexpr int SHM_V = 16384, SHM_K = 8192;
constexpr int OFF_V = 0, OFF_K = 2 * SHM_V, OFF_WS = OFF_K + 2 * SHM_K, OFF_O0 = OFF_WS + NWAVES * 64 * 4, OFF_END = OFF_O0 + 32 * 512 * 4;
static_assert(OFF_END <= PHASE_LDS, "attention LDS");
constexpr float THRL = 11.5f;

__device__ __forceinline__ void partialSM(f32x16& p0, f32x16& p1, float& m_reg, float& mn, float& alpha) {
    float pmax = p0[0];
#pragma unroll
    for (int r = 1; r < 16; ++r) pmax = fmaxf(pmax, p0[r]);
#pragma unroll
    for (int r = 0; r < 16; ++r) pmax = fmaxf(pmax, p1[r]);
    { auto rr = __builtin_amdgcn_permlane32_swap(__float_as_uint(pmax), __float_as_uint(pmax), false, false); pmax = fmaxf(__uint_as_float(rr[0]), __uint_as_float(rr[1])); }
    if (__builtin_expect(__all(pmax - m_reg <= THRL), 1)) { mn = m_reg; alpha = 1.f; }
    else { mn = fmaxf(m_reg, pmax); alpha = ex2(m_reg - mn); m_reg = mn; }
#pragma unroll
    for (int r = 0; r < 16; ++r) { p0[r] -= mn; p1[r] -= mn; }
#pragma unroll
    for (int r = 0; r < 16; ++r) p0[r] = ex2(p0[r]);
}
__device__ __forceinline__ void finishSM(f32x16& p0, f32x16& p1, float alpha, float& l_reg, bf16x8& pa0, bf16x8& pa1, bf16x8& pa2, bf16x8& pa3) {
#pragma unroll
    for (int r = 0; r < 16; ++r) p1[r] = ex2(p1[r]);
    float ps = 0.f;
#pragma unroll
    for (int r = 0; r < 16; ++r) ps += p0[r];
#pragma unroll
    for (int r = 0; r < 16; ++r) ps += p1[r];
    { auto rr = __builtin_amdgcn_permlane32_swap(__float_as_uint(ps), __float_as_uint(ps), false, false); ps = __uint_as_float(rr[0]) + __uint_as_float(rr[1]); }
    l_reg = l_reg * alpha + ps;
#define PK4(P, BASE, OUT) do { unsigned a0 = cvtpk(P[BASE + 0], P[BASE + 1]), a1 = cvtpk(P[BASE + 2], P[BASE + 3]);   \
    unsigned b0 = cvtpk(P[BASE + 4], P[BASE + 5]), b1 = cvtpk(P[BASE + 6], P[BASE + 7]);                              \
    auto r0 = __builtin_amdgcn_permlane32_swap(a0, b0, false, false); auto r1 = __builtin_amdgcn_permlane32_swap(a1, b1, false, false); \
    u32x4 w = {r0[0], r1[0], r0[1], r1[1]}; OUT = *reinterpret_cast<bf16x8*>(&w); } while (0)
    PK4(p0, 0, pa0); PK4(p0, 8, pa1); PK4(p1, 0, pa2); PK4(p1, 8, pa3);
#undef PK4
}
__device__ __forceinline__ void qkt(f32x16& p0, f32x16& p1, const LAS unsigned char* Ks, const bf16x8* qr, int r32, int hi) {
    p0 = f32x16{}; p1 = f32x16{};
#pragma unroll
    for (int d0 = 0; d0 < 4; ++d0) {
        const bf16x8 b0 = *(const LAS bf16x8*)(Ks + (d0 * 2 + hi) * 1024 + r32 * 16);
        const bf16x8 b1 = *(const LAS bf16x8*)(Ks + (d0 * 2 + hi) * 1024 + (32 + r32) * 16);
        p0 = __builtin_amdgcn_mfma_f32_32x32x16_bf16(b0, qr[d0], p0, 0, 0, 0);
        p1 = __builtin_amdgcn_mfma_f32_32x32x16_bf16(b1, qr[d0], p1, 0, 0, 0); }
}
__device__ __forceinline__ int v_st(int k, int c) { const int kk = (k & ~0xC) | ((k & 4) << 1) | ((k & 8) >> 1); return ((kk >> 3) * 4 + (c >> 5)) * 512 + ((kk & 7) * 32 + (c & 31)) * 2; }
__device__ __forceinline__ int v_rd_base(int lane) { return ((lane & 3) << 3) | (((lane >> 2) & 3) << 6) | (((lane >> 4) & 1) << 5) | (((lane >> 5) & 1) << 8); }
constexpr int v_rd_off(int d0, int ks, int half) { return d0 * 512 + ks * 4096 + half * 2048; }
template <int OFF> __device__ __forceinline__ s16x4 tr_read(int vb) {
    s16x4 r; asm volatile("ds_read_b64_tr_b16 %0, %1 offset:%2" : "=&v"(r) : "v"(vb), "i"(OFF) : "memory"); return r;
}
template <int D0> __device__ __forceinline__ void pv_one(f32x16& od, int vb, bf16x8 pa0, bf16x8 pa1, bf16x8 pa2, bf16x8 pa3) {
    const s16x4 l0 = tr_read<v_rd_off(D0, 0, 0)>(vb), h0 = tr_read<v_rd_off(D0, 0, 1)>(vb), l1 = tr_read<v_rd_off(D0, 1, 0)>(vb), h1 = tr_read<v_rd_off(D0, 1, 1)>(vb);
    const s16x4 l2 = tr_read<v_rd_off(D0, 2, 0)>(vb), h2 = tr_read<v_rd_off(D0, 2, 1)>(vb), l3 = tr_read<v_rd_off(D0, 3, 0)>(vb), h3 = tr_read<v_rd_off(D0, 3, 1)>(vb);
    asm volatile("s_waitcnt lgkmcnt(0)" ::: "memory"); SBAR();
#define PK(L, H) (bf16x8){L[0], L[1], L[2], L[3], H[0], H[1], H[2], H[3]}
    od = __builtin_amdgcn_mfma_f32_32x32x16_bf16(pa0, PK(l0, h0), od, 0, 0, 0);
    od = __builtin_amdgcn_mfma_f32_32x32x16_bf16(pa1, PK(l1, h1), od, 0, 0, 0);
    od = __builtin_amdgcn_mfma_f32_32x32x16_bf16(pa2, PK(l2, h2), od, 0, 0, 0);
    od = __builtin_amdgcn_mfma_f32_32x32x16_bf16(pa3, PK(l3, h3), od, 0, 0, 0);
#undef PK
}
__device__ __forceinline__ void pv_d0(f32x16* o, int vb, bf16x8 pa0, bf16x8 pa1, bf16x8 pa2, bf16x8 pa3) {
    pv_one<0>(o[0], vb, pa0, pa1, pa2, pa3); pv_one<1>(o[1], vb, pa0, pa1, pa2, pa3); pv_one<2>(o[2], vb, pa0, pa1, pa2, pa3); pv_one<3>(o[3], vb, pa0, pa1, pa2, pa3);
}

__device__ __forceinline__ void unit(LAS unsigned char* lds, int h, int q0, const bf16_t* __restrict__ QD, const bf16_t* __restrict__ KD, const bf16_t* __restrict__ VD,
                                     float lam, const float* __restrict__ subg, bf16_t* MIX) {
    const int tid = opaque_tid(), wid = __builtin_amdgcn_readfirstlane(tid >> 6), lane = tid & 63, r32 = lane & 31, hi = lane >> 5;
    LAS unsigned char* V_lds = lds + OFF_V; LAS unsigned char* K_lds = lds + OFF_K;
    LAS float* ws = (LAS float*)(lds + OFF_WS) + wid * 64; LAS float* li_l = ws; LAS float* al_l = ws + 32;
    LAS unsigned* O0 = (LAS unsigned*)(lds + OFF_O0);
    const int sr = tid >> 4, sc = (tid & 15) * 8, vst0 = v_st(sr, sc), vst1 = v_st(32 + sr, sc), kst = wid * 1024 + lane * 16;
    const int vb0 = (int)(uintptr_t)V_lds + v_rd_base(lane);
    const unsigned voV0 = (unsigned)(sr * LDR + sc), voV1 = (unsigned)((32 + sr) * LDR + sc), voK = (unsigned)(lane * LDR + wid * 8);
    constexpr int NT = M / KVBLK;
#pragma unroll 1
    for (int mp = 0; mp < 2; ++mp) {
        const bf16_t* Kh = KD + h * 128 + mp * 64; const bf16_t* Vh = VD + h * 128;
        const bf16_t* Qw = QD + (size_t)(q0 + wid * QBLK + r32) * LDR + h * 128 + mp * 64 + hi * 8;
        float m_reg = -1e30f, l_reg = 0.f; f32x16 o[4] = {}; bf16x8 qr[4];
#pragma unroll
        for (int d0 = 0; d0 < 4; ++d0) qr[d0] = *reinterpret_cast<const bf16x8*>(Qw + d0 * 16);
        struct { bf16x8 vs0, vs1, ks0; } sr_[2];
#define SLOAD(i, k0) do { const bf16_t* vt_ = Vh + (size_t)(k0) * LDR; const bf16_t* kt_ = Kh + (size_t)(k0) * LDR; \
        sr_[i].vs0 = *reinterpret_cast<const bf16x8*>(vt_ + voV0); sr_[i].vs1 = *reinterpret_cast<const bf16x8*>(vt_ + voV1); sr_[i].ks0 = *reinterpret_cast<const bf16x8*>(kt_ + voK); } while (0)
#define SWRITE(b, i) do { *(LAS bf16x8*)(V_lds + (b) * SHM_V + vst0) = sr_[i].vs0; *(LAS bf16x8*)(V_lds + (b) * SHM_V + vst1) = sr_[i].vs1; \
        *(LAS bf16x8*)(K_lds + (b) * SHM_K + kst) = sr_[i].ks0; } while (0)
#define SWAIT() asm volatile("s_waitcnt vmcnt(3)" ::: "memory")
#define RESC(a) do { if (__any((a) < 1.f)) { if (hi == 0) al_l[r32] = (a); asm volatile("s_waitcnt lgkmcnt(0)" ::: "memory"); \
        _Pragma("unroll") for (int d = 0; d < 4; ++d) _Pragma("unroll") for (int r = 0; r < 16; ++r) o[d][r] *= al_l[crow(r, hi)]; } } while (0)
        f32x16 pA0, pA1, pB0, pB1; float mnA, mnB, alA, alB; bf16x8 pa0, pa1, pa2, pa3;
        constexpr int SE = 0, SO = 1;
        SLOAD(SE, 0); asm volatile("s_waitcnt vmcnt(0)" ::: "memory"); SWRITE(0, SE); __syncthreads();
        qkt(pA0, pA1, K_lds, qr, r32, hi); partialSM(pA0, pA1, m_reg, mnA, alA);
        SLOAD(SO, KVBLK); SLOAD(SE, 2 * KVBLK);
        SWAIT(); SWRITE(1, SO); __syncthreads();
#pragma unroll 1
        for (int j = 1; j + 1 < NT; j += 2) {
            SBAR(); qkt(pB0, pB1, K_lds + SHM_K, qr, r32, hi);
            finishSM(pA0, pA1, alA, l_reg, pa0, pa1, pa2, pa3); SBAR();
            SLOAD(SO, (j + 2) * KVBLK); SBAR();
            pv_d0(o, vb0, pa0, pa1, pa2, pa3); partialSM(pB0, pB1, m_reg, mnB, alB);
            __syncthreads(); SWAIT(); SWRITE(0, SE);
            RESC(alB); __syncthreads();
            SBAR(); qkt(pA0, pA1, K_lds, qr, r32, hi);
            finishSM(pB0, pB1, alB, l_reg, pa0, pa1, pa2, pa3); SBAR();
            if (j + 3 < NT) SLOAD(SE, (j + 3) * KVBLK); SBAR();
            pv_d0(o, vb0 + SHM_V, pa0, pa1, pa2, pa3); partialSM(pA0, pA1, m_reg, mnA, alA);
            __syncthreads(); SWAIT(); SWRITE(1, SO);
            RESC(alA); __syncthreads();
        }
        SBAR(); qkt(pB0, pB1, K_lds + SHM_K, qr, r32, hi);
        finishSM(pA0, pA1, alA, l_reg, pa0, pa1, pa2, pa3); SBAR();
        pv_d0(o, vb0, pa0, pa1, pa2, pa3); partialSM(pB0, pB1, m_reg, mnB, alB);
        __syncthreads(); RESC(alB);
        finishSM(pB0, pB1, alB, l_reg, pa0, pa1, pa2, pa3); SBAR();
        pv_d0(o, vb0 + SHM_V, pa0, pa1, pa2, pa3);
#undef SLOAD
#undef SWRITE
#undef SWAIT
#undef RESC
        if (hi == 0) li_l[r32] = l_reg; asm volatile("s_waitcnt lgkmcnt(0)" ::: "memory");
        int rowb = q0 + wid * QBLK; asm volatile("" : "+s"(rowb));
        float rli[16];
#pragma unroll
        for (int r = 0; r < 16; ++r) rli[r] = __builtin_amdgcn_rcpf(li_l[crow(r, hi)]);
        if (mp == 0) {
#pragma unroll
            for (int d0 = 0; d0 < 4; ++d0)
#pragma unroll
                for (int r = 0; r < 16; r += 2) O0[(d0 * 8 + (r >> 1)) * 512 + tid] = cvtpk(o[d0][r] * rli[r], o[d0][r + 1] * rli[r + 1]);
        } else {
            float ss[16];
#pragma unroll
            for (int r = 0; r < 16; ++r) ss[r] = 0.f;
#pragma unroll
            for (int d0 = 0; d0 < 4; ++d0)
#pragma unroll
                for (int r = 0; r < 16; r += 2) { const unsigned w = O0[(d0 * 8 + (r >> 1)) * 512 + tid];
                    const float c0 = bflo(w) - lam * o[d0][r] * rli[r], c1 = bfhi(w) - lam * o[d0][r + 1] * rli[r + 1];
                    o[d0][r] = c0; o[d0][r + 1] = c1; ss[r] += c0 * c0; ss[r + 1] += c1 * c1; }
#pragma unroll
            for (int r = 0; r < 16; ++r) {
                ss[r] += lane_xor<1>(ss[r]); ss[r] += lane_xor<2>(ss[r]); ss[r] += lane_xor<4>(ss[r]); ss[r] += lane_xor<8>(ss[r]); ss[r] += lane_xor<16>(ss[r]);
                ss[r] = 0.8f / sqrtf(ss[r] * (1.f / 128.f) + 1e-5f); }
#pragma unroll
            for (int d0 = 0; d0 < 4; ++d0) { const float g = subg[d0 * 32 + r32];
#pragma unroll
                for (int r = 0; r < 16; ++r) MIX[(size_t)(rowb + crow(r, hi)) * D + 512 + h * 128 + d0 * 32 + r32] = (bf16_t)f2bf(o[d0][r] * ss[r] * g); }
        }
        __syncthreads();
    }
}
__device__ __forceinline__ void hgrn_finalize(int h, int q0, const float* OF, const float* OB, const bf16_t* SG, const float* gain, bf16_t* MIX, int wid, int lane) {
    const float g0 = gain[2 * lane], g1 = gain[2 * lane + 1];
#pragma unroll 4
    for (int i = 0; i < 32; ++i) { const int row = q0 + wid * 32 + i; const size_t off = (size_t)row * HSEC + h * 128 + 2 * lane;
        const float2 a = *(const float2*)(OF + off), b = *(const float2*)(OB + off); const unsigned sg = *(const unsigned*)(SG + off);
        const float x0 = a.x + b.x, x1 = a.y + b.y; const float ssum = wave_sum(x0 * x0 + x1 * x1);
        const float rstd = 1.f / sqrtf(ssum * (1.f / 128.f) + 1e-6f);
        *(unsigned*)(MIX + (size_t)row * D + h * 128 + 2 * lane) = cvtpk(x0 * rstd * g0 * bflo(sg), x1 * rstd * g1 * bfhi(sg)); }
}
}

__device__ __forceinline__ void norm_route_rows(const float* X2, const float* gain, const float* WR  , const float* rgb, const float* reb,
                                                bf16_t* H2, int* TOKE, float* TOKW, int* TOKR, unsigned* CNT, int row0, int lane) {
    f32x4 v[4][4];
#pragma unroll
    for (int i = 0; i < 4; ++i) { const GAS f32x4* xr = (const GAS f32x4*)(X2 + (size_t)(row0 + i) * D) + lane; float s = 0.f;
#pragma unroll
        for (int j = 0; j < 4; ++j) { v[i][j] = xr[64 * j]; s += (v[i][j].x * v[i][j].x + v[i][j].y * v[i][j].y) + (v[i][j].z * v[i][j].z + v[i][j].w * v[i][j].w); }
        const float rstd = 1.f / sqrtf(wave_sum(s) * (1.f / 1024.f) + 1e-6f);
        GAS u32x2* o8 = (GAS u32x2*)(H2 + (size_t)(row0 + i) * D) + lane;
#pragma unroll
        for (int j = 0; j < 4; ++j) { const f32x4 g = ((const GAS f32x4*)gain)[64 * j + lane]; v[i][j] = v[i][j] * rstd * g;
            u32x2 w; w.x = pk2(v[i][j].x, v[i][j].y); w.y = pk2(v[i][j].z, v[i][j].w); o8[64 * j] = w; } }
    const bool b0 = lane & 1, b1 = lane & 2;
    auto logit = [&](int n) -> float {
        f32x4 w[4];
#pragma unroll
        for (int j = 0; j < 4; ++j) w[j] = ((const GAS f32x4*)(WR + n * 1024))[64 * j + lane];
        float x[4];
#pragma unroll
        for (int i = 0; i < 4; ++i) { float s = 0.f;
#pragma unroll
            for (int j = 0; j < 4; ++j) s += (v[i][j].x * w[j].x + v[i][j].y * w[j].y) + (v[i][j].z * w[j].z + v[i][j].w * w[j].w);
            x[i] = s; }
        float y[2], t;
#pragma unroll
        for (int i = 0; i < 2; ++i) { const float keep = b0 ? x[2 * i + 1] : x[2 * i], send = b0 ? x[2 * i] : x[2 * i + 1]; y[i] = keep + lane_xor<1>(send); }
        { const float keep = b1 ? y[1] : y[0], send = b1 ? y[0] : y[1]; t = keep + lane_xor<2>(send); }
        t += lane_xor<4>(t); t += lane_xor<8>(t); t += lane_xor<16>(t);
        { auto rr = __builtin_amdgcn_permlane32_swap(__float_as_uint(t), __float_as_uint(t), false, false); t = __uint_as_float(rr[0]) + __uint_as_float(rr[1]); }
        asm volatile("" ::: "memory"); SBAR();
        return t; };
    float gl[4];
#pragma unroll
    for (int g = 0; g < 4; ++g) gl[g] = logit(g) + rgb[g];
    int gi = 0; float gm = gl[0];
#pragma unroll
    for (int g = 1; g < 4; ++g) if (gl[g] > gm) { gm = gl[g]; gi = g; }
    float gs = 0.f;
#pragma unroll
    for (int g = 0; g < 4; ++g) gs += __expf(gl[g] - gm);
    const float gp = 1.f / gs;
    float t1[4], t2[4]; int j1[4], j2[4];
#pragma unroll
    for (int g = 0; g < 4; ++g) { t1[g] = -3.0e38f; t2[g] = -3.0e38f; j1[g] = 0; j2[g] = 0; }
#pragma unroll 1
    for (int j = 0; j < 8; ++j) {
#pragma unroll
        for (int g = 0; g < 4; ++g) { const float t = logit(4 + g * 8 + j) + reb[g * 8 + j];
            if (t > t1[g]) { t2[g] = t1[g]; j2[g] = j1[g]; t1[g] = t; j1[g] = j; } else if (t > t2[g]) { t2[g] = t; j2[g] = j; } }
    }
    const float m1 = gi == 0 ? t1[0] : gi == 1 ? t1[1] : gi == 2 ? t1[2] : t1[3], m2 = gi == 0 ? t2[0] : gi == 1 ? t2[1] : gi == 2 ? t2[2] : t2[3];
    const int i1 = gi == 0 ? j1[0] : gi == 1 ? j1[1] : gi == 2 ? j1[2] : j1[3], i2 = gi == 0 ? j2[0] : gi == 1 ? j2[1] : gi == 2 ? j2[2] : j2[3];
    const float p2 = __expf(m2 - m1);
    const float w1 = gp / (1.f + p2), w2 = gp * p2 / (1.f + p2);
    if (lane < 4) { const int row = row0 + lane; const int e1 = gi * 8 + i1, e2 = gi * 8 + i2;
        const int r1 = (int)atomicAdd(CNT + e1, 1u), r2 = (int)atomicAdd(CNT + e2, 1u);
        TOKE[row * 2] = e1; TOKE[row * 2 + 1] = e2; TOKW[row * 2] = w1; TOKW[row * 2 + 1] = w2; TOKR[row * 2] = r1; TOKR[row * 2 + 1] = r2; }
}
__device__ __forceinline__ void build_tile_prefix(volatile LAS int* tb, const unsigned* CNT) {
    if (threadIdx.x == 0) { int acc = 0;
        for (int e = 0; e < 32; ++e) { tb[e] = acc; const int c = (int)__hip_atomic_load(CNT + e, __ATOMIC_RELAXED, __HIP_MEMORY_SCOPE_AGENT); acc += (c + 255) >> 8; }
        tb[32] = acc; }
    LDS_WAIT(); __syncthreads();
}
__device__ __forceinline__ void final_row(float* XO, const bf16_t* Y, const int* TOKS, const float* TOKW, const float* gain, int row, int lane) {
    const int s0 = TOKS[row * 2], s1 = TOKS[row * 2 + 1]; const float w0 = TOKW[row * 2], w1 = TOKW[row * 2 + 1];
    GAS f32x4* xr = (GAS f32x4*)(XO + (size_t)row * D) + lane; const GAS u32x2* y0 = (const GAS u32x2*)(Y + (size_t)s0 * D) + lane; const GAS u32x2* y1 = (const GAS u32x2*)(Y + (size_t)s1 * D) + lane;
    f32x4 v[4]; float s = 0.f;
#pragma unroll
    for (int j = 0; j < 4; ++j) { v[j] = xr[64 * j]; const u32x2 a = y0[64 * j], b = y1[64 * j];
        v[j].x += w0 * bflo(a.x) + w1 * bflo(b.x); v[j].y += w0 * bfhi(a.x) + w1 * bfhi(b.x); v[j].z += w0 * bflo(a.y) + w1 * bflo(b.y); v[j].w += w0 * bfhi(a.y) + w1 * bfhi(b.y);
        s += (v[j].x * v[j].x + v[j].y * v[j].y) + (v[j].z * v[j].z + v[j].w * v[j].w); }
    const float rstd = 1.f / sqrtf(wave_sum(s) * (1.f / 1024.f) + 1e-6f);
#pragma unroll
    for (int j = 0; j < 4; ++j) { const f32x4 g = ((const GAS f32x4*)gain)[64 * j + lane]; xr[64 * j] = v[j] * rstd * g; }
}

#ifndef MK_N_LAUNCHES
#define MK_N_LAUNCHES 1
#endif
constexpr int N_PHASES = 12;
struct Args { const void* in[18]; float* out; unsigned char* ws; int ph_lo, ph_hi; };
static_assert(sizeof(Args) == 18 * 8 + 8 + 8 + 8, "Args has no padding");

__global__ void __launch_bounds__(NWAVES * 64, 2) mk_fwd(Args args) {
    extern __shared__ __attribute__((aligned(16))) unsigned char lds_raw[];
    LAS unsigned char* lds = (LAS unsigned char*)lds_raw;
    volatile LAS unsigned* MISC = (volatile LAS unsigned*)(lds + MISC_OFF);
    const int G = gridDim.x, bx = blockIdx.x, vcu = (G % 8 == 0) ? (bx % 8) * (G / 8) + bx / 8 : bx;
    const int NGW = G * NWAVES;
#define PHASE_IDS const int tid = opaque_tid(), lane = tid & 63, wave = __builtin_amdgcn_readfirstlane(tid >> 6), gw = vcu * NWAVES + wave; (void)lane; (void)gw
    const __attribute__((address_space(4))) Args* A = (const __attribute__((address_space(4))) Args*)__builtin_amdgcn_kernarg_segment_ptr();
    asm volatile("" : "+s"(A));
#define ARGF(i) ((const float*)A->in[i])
#define WSP(T, off) ((T*)(A->ws + (off)))
#define x_in ARGF(0)
#define positions ((const int*)A->in[1])
#define norm1_gain ARGF(2)
#define w_in ARGF(3)
#define hg_lb ARGF(4)
#define hg_norm_gain ARGF(5)
#define diff_lambda ARGF(6)
#define subln_gain ARGF(7)
#define w_out ARGF(8)
#define norm2_gain ARGF(9)
#define rg_w ARGF(10)
#define rg_b ARGF(11)
#define re_w ARGF(12)
#define re_b ARGF(13)
#define w_gate ARGF(14)
#define w_up ARGF(15)
#define w_down ARGF(16)
#define final_gain ARGF(17)
#define out (A->out)
#define WR WSP(float, WS_WR)
#define cosT WSP(float, WS_ROPE)
#define sinT (WSP(float, WS_ROPE) + M * 8)
#define HD WSP(float, WS_HD)
#define TOKE WSP(int, WS_TOKE)
#define TOKW WSP(float, WS_TOKW)
#define TOKR WSP(int, WS_TOKR)
#define TOKS WSP(int, WS_TOKS)
#define LAMP WSP(float, WS_LAM)
#define WOUT WSP(bf16_t, WS_WOUT)
#define WIN WSP(bf16_t, WS_WIN)
#define XN WSP(bf16_t, WS_XN)
#define QH WSP(bf16_t, WS_QH)
#define VH WSP(bf16_t, WS_VH)
#define SG WSP(bf16_t, WS_SG)
#define QD WSP(bf16_t, WS_QD)
#define KD WSP(bf16_t, WS_KD)
#define VD WSP(bf16_t, WS_VD)
#define GF WSP(float, WS_GF)
#define GB WSP(float, WS_GB)
#define HS WSP(float, WS_HS)
#define HL WSP(float, WS_HL)
#define OF WSP(float, WS_OF)
#define OB WSP(float, WS_OB)
#define MIX WSP(bf16_t, WS_MIX)
#define H2 WSP(bf16_t, WS_H2)
#define WGU WSP(bf16_t, WS_WGU)
#define WD WSP(bf16_t, WS_WD)
#define HGb WSP(bf16_t, WS_HG)
#define HM WSP(bf16_t, WS_HM)
#define Y WSP(bf16_t, WS_Y)
#define CNT (WSP(unsigned, WS_CTL) + CW_CNT)
    unsigned* ctl = WSP(unsigned, WS_CTL);
    volatile LAS int* tb = (volatile LAS int*)(MISC + 16);

    if (threadIdx.x < 64) MISC[threadIdx.x] = 0u;
    __syncthreads();
    XcdBarrier bar; bar.bar = ctl + CW_BAR; bar.x = 0; bar.st = nullptr;
    const int lo = A->ph_lo, hi = A->ph_hi;
    if (hi - lo > 1) bar = xcd_barrier_post(ctl + CW_BAR, MISC);
#ifndef PH_MASK
#define PH_MASK 0xFFF
#endif
#define IN(k) (((PH_MASK >> (k)) & 1) && lo <= (k) && (k) < hi)
#define SEAM(k) do { if (IN(k) && IN((k) + 1)) xcd_barrier(bar); } while (0)

    if (IN(0)) { PHASE_IDS;
        LAS float* scr = (LAS float*)(lds + wave * 16384);
        constexpr int I_IN = (D / 64) * (NIN / 32), I_OUT = (D / 64) * (D / 32);
        for (int it = gw; it < I_IN + I_OUT; it += NGW) {
            if (it < I_IN) transpose_item(w_in, D, NIN, WIN, 0, 1, scr, it, lane);
            else transpose_item(w_out, D, D, WOUT, 0, 1, scr, it - I_IN, lane);
        }
        for (int m = gw; m < M; m += NGW) rms_row_to_bf16(x_in + (size_t)m * D, norm1_gain, XN + (size_t)m * D, lane, 1e-6f);
        for (int id = bx * 512 + tid; id < M * 8; id += G * 512) {
            const int i = id & 7; const float invf[8] = {1.0f, 0.19392274474868576f, 0.03760603093086393f, 0.007292664737217109f, 0.001414213562373095f, 0.0002742481756762073f, 5.318295896944988e-05f, 1.031338537721246e-05f};
            float f = invf[0];
#pragma unroll
            for (int q = 1; q < 8; ++q) f = (i == q) ? invf[q] : f;
            const float ang = (float)positions[id >> 3] * f;
            const double rev = (double)ang * 0.15915494309189535; const float fr = (float)(rev - __builtin_rint(rev));
            cosT[id] = __builtin_amdgcn_cosf(fr); sinT[id] = __builtin_amdgcn_sinf(fr);
        }
        for (int id = bx * 512 + tid; id < 36 * 1024; id += G * 512) { const int n = id >> 10, c = id & 1023; WR[id] = n < 4 ? rg_w[c * 4 + n] : re_w[c * 32 + (n - 4)]; }
        if (bx == 0 && wave == 0) { const float a = wave_sum(diff_lambda[lane] * diff_lambda[64 + lane]), b = wave_sum(diff_lambda[128 + lane] * diff_lambda[192 + lane]);
            if (lane == 0) LAMP[0] = __expf(a) - __expf(b) + 0.2f; }
    }
    SEAM(0);
    if (IN(1)) {
        pg8::Gemm g{XN, WIN, M, NIN, D}; pg8::StaticOrder S; S.init(M, NIN, G, bx);
        EpiInProj E{QH, VH, SG, QD, KD, VD, GF, GB, hg_lb, cosT, sinT};
        pg8::gemm_phase<EpiInProj, pg8::StaticOrder, true, true>(lds, g, S, E);
    }
    SEAM(1);
    if (IN(2)) { for (int u = vcu; u < 256; u += G) hg::pass<false>(lds, u, QH, VH, GF, GB, HL, HD, HS, OF, OB); }
    SEAM(2);
    if (IN(3)) hg::scan(HL, HD, HS, bx * 512 + opaque_tid(), G * 512);
    SEAM(3);
    if (IN(4)) { for (int u = vcu; u < 256; u += G) hg::pass<true>(lds, u, QH, VH, GF, GB, HL, HD, HS, OF, OB); }
    SEAM(4);
    if (IN(5)) { PHASE_IDS;
        const float lam = LAMP[0];
        for (int u = vcu; u < 256; u += G) { const int h = u >> 6, q0 = (u & 63) * 256;
            int ln = lane; asm volatile("" : "+v"(ln));
            att::hgrn_finalize(h, q0, OF, OB, SG, hg_norm_gain, MIX, wave, ln);
            att::unit(lds, h, q0, QD, KD, VD, lam, subln_gain, MIX); }
    }
    SEAM(5);
    if (IN(6)) {
        pg8::Gemm g{MIX, WOUT, M, D, D}; pg8::StaticOrder S; S.init(M, D, G, bx);
        EpiResid E{x_in, out};
        pg8::gemm_phase<EpiResid, pg8::StaticOrder, true, true>(lds, g, S, E);
    }
    SEAM(6);
    if (IN(7)) { PHASE_IDS;
        for (int r0 = gw * 4; r0 < M; r0 += NGW * 4) norm_route_rows(out, norm2_gain, WR, rg_b, re_b, H2, TOKE, TOKW, TOKR, CNT, r0, lane);
        LAS float* scr = (LAS float*)(lds + wave * 16384);
        constexpr int I_GU = (D / 64) * (DEXP / 32), I_DN = (DEXP / 64) * (D / 32);
        for (int it = gw; it < NEXP * (2 * I_GU + I_DN); it += NGW) {
            const int e = it / (2 * I_GU + I_DN), r = it % (2 * I_GU + I_DN);
            if (r < I_GU) transpose_item(w_gate + (size_t)e * D * DEXP, D, DEXP, WGU + (size_t)e * 1024 * D, 0, 2, scr, r, lane);
            else if (r < 2 * I_GU) transpose_item(w_up + (size_t)e * D * DEXP, D, DEXP, WGU + (size_t)e * 1024 * D, 1, 2, scr, r - I_GU, lane);
            else transpose_item(w_down + (size_t)e * DEXP * D, DEXP, D, WD + (size_t)e * 1024 * DEXP, 0, 1, scr, r - 2 * I_GU, lane);
        }
    }
    SEAM(7);
    if (IN(8)) { PHASE_IDS;
        build_tile_prefix(tb, CNT);
        for (int p = gw; p < 2 * M; p += NGW) { const int e = TOKE[p], slot = tb[e] * 256 + TOKR[p];
            if (lane == 0) TOKS[p] = slot;
            const GAS u32x4* src = (const GAS u32x4*)(H2 + (size_t)(p >> 1) * D) + lane; GAS u32x4* dst = (GAS u32x4*)(HGb + (size_t)slot * D) + lane;
            const u32x4 a = src[0], b = src[64]; dst[0] = a; dst[64] = b; }
    }
    SEAM(8);
    if (IN(9)) {
        build_tile_prefix(tb, CNT);
        pg8::Gemm g{HGb, WGU, MAXSLOTS, NEXP * 1024, D}; MoeOrder S{tb, G, bx}; EpiSwiGlu E{HM};
        pg8::gemm_phase<EpiSwiGlu, MoeOrder, true, true>(lds, g, S, E);
    }
    SEAM(9);
    if (IN(10)) {
        build_tile_prefix(tb, CNT);
        pg8::Gemm g{HM, WD, MAXSLOTS, NEXP * 1024, DEXP}; MoeOrder S{tb, G, bx}; EpiDown E{Y};
        pg8::gemm_phase<EpiDown, MoeOrder, true, true>(lds, g, S, E);
    }
    SEAM(10);
    if (IN(11)) { PHASE_IDS; for (int m = gw; m < M; m += NGW) final_row(out, Y, TOKS, TOKW, final_gain, m, lane); }
#undef IN
#undef SEAM
#undef x_in
#undef positions
#undef out
#undef Y
#undef HM
#undef CNT
}

extern "C" void kernel_launch(void* const* d_in, const int* in_sizes, int n_in, void* d_out, int out_size, void* d_ws, size_t ws_size, hipStream_t stream) {
    static int grid = 0;
    if (grid == 0) {
        if (n_in != 18 || in_sizes[0] != M * D || out_size != M * D || ws_size < WS_END) { fprintf(stderr, "kernel_launch: unexpected shapes (n_in %d, in0 %d, out %d, ws %zu)\n", n_in, n_in > 0 ? in_sizes[0] : -1, out_size, ws_size); grid = -1; return; }
        int dev = 0, cus = 0, per_cu = 0;
        if (hipGetDevice(&dev) != hipSuccess || hipDeviceGetAttribute(&cus, hipDeviceAttributeMultiprocessorCount, dev) != hipSuccess) { grid = -1; return; }
        if (hipFuncSetAttribute((const void*)mk_fwd, hipFuncAttributeMaxDynamicSharedMemorySize, LDS_BYTES) != hipSuccess) { fprintf(stderr, "kernel_launch: hipFuncSetAttribute failed\n"); grid = -1; return; }
        if (hipOccupancyMaxActiveBlocksPerMultiprocessor(&per_cu, (const void*)mk_fwd, NWAVES * 64, LDS_BYTES) != hipSuccess || per_cu < 1) { fprintf(stderr, "kernel_launch: occupancy query says %d\n", per_cu); (void)hipGetLastError(); grid = -1; return; }
        grid = cus;
    }
    if (grid < 0) return;
    if (hipMemsetAsync((char*)d_ws + WS_CTL, 0, CTL_ZERO_BYTES, stream) != hipSuccess) return;
    Args a{};
    for (int i = 0; i < 18; ++i) a.in[i] = d_in[i];
    a.out = (float*)d_out; a.ws = (unsigned char*)d_ws;
#if MK_N_LAUNCHES == 1
    a.ph_lo = 0; a.ph_hi = N_PHASES;
    hipLaunchKernelGGL(mk_fwd, dim3(grid), dim3(NWAVES * 64), LDS_BYTES, stream, a);
#else
    for (int p = 0; p < N_PHASES; ++p) { a.ph_lo = p; a.ph_hi = p + 1; hipLaunchKernelGGL(mk_fwd, dim3(grid), dim3(NWAVES * 64), LDS_BYTES, stream, a); }
#endif
}
```

```cpp
#include <hip/hip_runtime.h>
#include <cstdio>
#include <cstdint>
__device__ __forceinline__ int opaque_tid() { int t = threadIdx.x; asm volatile("" : "+v"(t)); return t; }
namespace pg8 {
#define PG8_LAS __attribute__((address_space(3)))
typedef unsigned short bf16_t;
typedef short bf16x8 __attribute__((ext_vector_type(8)));
typedef float f32x4 __attribute__((ext_vector_type(4)));
typedef unsigned u32x4 __attribute__((ext_vector_type(4)));
constexpr int BM = 256, BK = 64, HALF = 128, HTB = HALF * BK * 2  , STAGE_BYTES = 8 * HTB, NXCD = 8, WGM = 8;

__host__ __device__ __forceinline__ int lds_byte(int r, int c) { const int st = (r >> 4) * 2 + (c >> 5), rr = r & 15, cc = c & 31, ob = rr * 64 + cc * 2; return st * 1024 + (ob ^ (((ob >> 9) & 1) << 5)); }
__host__ __device__ __forceinline__ void stage_rc(int b, int& R, int& C) { const int st = b / 1024, sb = b % 1024, swz = sb ^ (((sb >> 9) & 1) << 5); R = (st >> 1) * 16 + swz / 64; C = (st & 1) * 32 + (swz % 64) / 2; }
__host__ __device__ __forceinline__ int perm32(int rho) { const int n = rho >> 4, i = rho & 15; return 8 * (i >> 2) + 4 * n + (i & 3); }

struct Unit { int pm, pn; };
struct Gemm { const bf16_t* A; const bf16_t* Bt; int M, N, K; };

struct StaticOrder {
    int nM, nN, nwg, G, c;
    __host__ __device__ void init(int M, int N, int G_, int c_) { nM = M / BM; nN = N / BM; nwg = nM * nN; G = G_; c = c_; }
    __host__ __device__ bool next(int i, Unit& u) const {
        const long L = (long)i * G + c; if (L >= nwg) return false;
        int wgid = (int)L; { const int q = nwg / NXCD, r = nwg % NXCD, xcd = wgid % NXCD, off = wgid / NXCD; wgid = (xcd < r ? xcd * (q + 1) : r * (q + 1) + (xcd - r) * q) + off; }
        const int nig = WGM * nN, gid = wgid / nig, fm = gid * WGM, gsz = (nM - fm) < WGM ? (nM - fm) : WGM;
        u.pm = fm + ((wgid % nig) % gsz); u.pn = (wgid % nig) / gsz; return true;
    }
    __device__ __forceinline__ void a_ready(const Unit&) const {}
    __device__ __forceinline__ void done(const Unit&) const {}
};

template <class Epi, class Sched, bool ALIGN_EPI = false, bool SP2 = false>
__device__ __forceinline__ void gemm_phase(PG8_LAS unsigned char* lds, const Gemm g, const Sched& S, const Epi& E) {
    const int tid = opaque_tid(), wid = __builtin_amdgcn_readfirstlane(tid >> 6), lane = tid & 63, wr = wid >> 2, wc = wid & 3, fr = lane & 15, fq = lane >> 4;
    const int K = g.K, nt = K / BK;
    unsigned voffA[2], voffB[2];
#pragma unroll
    for (int i = 0; i < 2; ++i) { int R, C; stage_rc(tid * 16 + i * 8192, R, C); const int Rb = Epi::PERM ? ((R & ~31) + perm32(R & 31)) : R;
        voffA[i] = (unsigned)(R * K + C) * 2u; voffB[i] = (unsigned)(Rb * K + C) * 2u; }
    const size_t kstep = (size_t)(BK * 2);
    const size_t hstep = (size_t)HALF * K * 2;
    const size_t tstep = 2 * hstep;
    const unsigned ldsw = (unsigned)wid * 1024u;
    const int aoff = lds_byte(wr * 64 + fr, fq * 8), boff = lds_byte(wc * 32 + fr, fq * 8);
#define PG8_SA(b, h) (((b) * 2 + (h)) * HTB)
#define PG8_SB(b, h) ((4 + (b) * 2 + (h)) * HTB)
#define PG8_STAGE(bufoff, gbase, voff) do { _Pragma("unroll") for (int _i = 0; _i < 2; ++_i) \
        __builtin_amdgcn_global_load_lds((const unsigned*)((const char*)(gbase) + (voff)[_i]), (PG8_LAS unsigned*)(lds + (bufoff) + ldsw + _i * 8192), 16, 0, 0); } while (0)
#define PG8_LDA(dst, b, h) do { _Pragma("unroll") for (int m = 0; m < 4; ++m) _Pragma("unroll") for (int k = 0; k < 2; ++k) dst[m][k] = *(const PG8_LAS bf16x8*)(lds + PG8_SA(b, h) + aoff + m * 2048 + k * 1024); } while (0)
#define PG8_LDB(dst, b, h) do { _Pragma("unroll") for (int n = 0; n < 2; ++n) _Pragma("unroll") for (int k = 0; k < 2; ++k) dst[n][k] = *(const PG8_LAS bf16x8*)(lds + PG8_SB(b, h) + boff + n * 2048 + k * 1024); } while (0)
#define PG8_MMA(ai, bj, At, Bt) do { __builtin_amdgcn_s_setprio(1); _Pragma("unroll") for (int m = 0; m < 4; ++m) _Pragma("unroll") for (int n = 0; n < 2; ++n) _Pragma("unroll") for (int k = 0; k < 2; ++k) \
        acc[ai][bj][m][n] = __builtin_amdgcn_mfma_f32_16x16x32_bf16(Bt[n][k], At[m][k], acc[ai][bj][m][n], 0, 0, 0); __builtin_amdgcn_s_setprio(0); } while (0)
#define PG8_WAIT_V(n) asm volatile("s_waitcnt vmcnt(" #n ")" ::: "memory")
#define PG8_WAIT_L(n) asm volatile("s_waitcnt lgkmcnt(" #n ")" ::: "memory")
#define PG8_BAR __builtin_amdgcn_s_barrier()
#define PG8_SCHED __builtin_amdgcn_sched_barrier(0)
    Unit cur, nxt; int ui = 0;
    if (!S.next(0, cur)) return;
    f32x4 acc[2][2][4][2];
#pragma unroll
    for (int a = 0; a < 2; ++a)
#pragma unroll
        for (int b = 0; b < 2; ++b)
#pragma unroll
            for (int m = 0; m < 4; ++m)
#pragma unroll
                for (int n = 0; n < 2; ++n) acc[a][b][m][n] = (f32x4){0.f, 0.f, 0.f, 0.f};
    bf16x8 At[4][2], B0[2][2], B1[2][2];
    const char* cA = (const char*)g.A + (size_t)cur.pm * tstep; const char* cB = (const char*)g.Bt + (size_t)cur.pn * tstep;
    S.a_ready(cur);
    if constexpr (SP2) {
        PG8_STAGE(PG8_SB(0, 0), cB, voffB); PG8_STAGE(PG8_SB(0, 1), cB + hstep, voffB); PG8_STAGE(PG8_SA(0, 0), cA, voffA); PG8_STAGE(PG8_SA(0, 1), cA + hstep, voffA);
        if (wr == 1) PG8_BAR;
        PG8_WAIT_V(2); PG8_BAR;
        PG8_STAGE(PG8_SB(1, 0), cB + kstep, voffB); PG8_STAGE(PG8_SA(1, 0), cA + kstep, voffA); PG8_STAGE(PG8_SB(1, 1), cB + hstep + kstep, voffB);
        PG8_WAIT_V(6); PG8_BAR;
    } else {
        PG8_STAGE(PG8_SB(0, 0), cB, voffB); PG8_STAGE(PG8_SA(0, 0), cA, voffA); PG8_STAGE(PG8_SB(0, 1), cB + hstep, voffB); PG8_STAGE(PG8_SA(0, 1), cA + hstep, voffA);
        if (wr == 1) PG8_BAR;
        PG8_WAIT_V(4); PG8_BAR;
        PG8_STAGE(PG8_SB(1, 0), cB + kstep, voffB); PG8_STAGE(PG8_SA(1, 0), cA + kstep, voffA); PG8_STAGE(PG8_SB(1, 1), cB + hstep + kstep, voffB);
        PG8_WAIT_V(6); PG8_BAR;
    }
    for (;;) {
        const bool has_next = S.next(ui + 1, nxt);
        const char* nA = has_next ? (const char*)g.A + (size_t)nxt.pm * tstep : cA; const char* nB = has_next ? (const char*)g.Bt + (size_t)nxt.pn * tstep : cB;
        for (int t = 0; t < nt; t += 2) {
            const bool last = (t == nt - 2);
            const char* a1 = cA + (size_t)(t + 1) * kstep;
            const char* a2 = last ? nA : cA + (size_t)(t + 2) * kstep; const char* b2 = last ? nB : cB + (size_t)(t + 2) * kstep;
            const char* a3 = a2 + kstep; const char* b3 = b2 + kstep;
            if (last && has_next) S.a_ready(nxt);
            if constexpr (SP2) {
            PG8_LDB(B0, 0, 0); PG8_LDB(B1, 0, 1); PG8_SCHED; PG8_LDA(At, 0, 0); PG8_STAGE(PG8_SA(1, 1), a1 + hstep, voffA);
            PG8_WAIT_V(8); PG8_WAIT_L(0); PG8_BAR; PG8_MMA(0, 0, At, B0); PG8_MMA(0, 1, At, B1); PG8_BAR; PG8_SCHED;
            PG8_LDA(At, 0, 1); PG8_STAGE(PG8_SB(0, 0), b2, voffB); PG8_STAGE(PG8_SB(0, 1), b2 + hstep, voffB); PG8_STAGE(PG8_SA(0, 0), a2, voffA);
            PG8_WAIT_V(8); PG8_WAIT_L(0); PG8_BAR; PG8_MMA(1, 0, At, B0); PG8_MMA(1, 1, At, B1); PG8_BAR; PG8_SCHED;
            PG8_LDB(B0, 1, 0); PG8_LDB(B1, 1, 1); PG8_SCHED; PG8_LDA(At, 1, 0); PG8_STAGE(PG8_SA(0, 1), a2 + hstep, voffA);
            PG8_WAIT_V(8); PG8_WAIT_L(0); PG8_BAR; PG8_MMA(0, 0, At, B0); PG8_MMA(0, 1, At, B1); PG8_BAR; PG8_SCHED;
            PG8_LDA(At, 1, 1); PG8_STAGE(PG8_SB(1, 0), b3, voffB); PG8_STAGE(PG8_SB(1, 1), b3 + hstep, voffB); PG8_STAGE(PG8_SA(1, 0), a3, voffA);
            PG8_WAIT_V(8); PG8_WAIT_L(0); PG8_BAR; PG8_MMA(1, 0, At, B0); PG8_MMA(1, 1, At, B1); PG8_BAR; PG8_SCHED;
            } else {
            PG8_LDB(B0, 0, 0); PG8_SCHED; PG8_LDA(At, 0, 0); PG8_STAGE(PG8_SA(1, 1), a1 + hstep, voffA);
            PG8_WAIT_L(8); PG8_BAR; PG8_WAIT_L(0); PG8_MMA(0, 0, At, B0); PG8_BAR; PG8_SCHED;
            PG8_LDB(B1, 0, 1); PG8_STAGE(PG8_SB(0, 0), b2, voffB);
            PG8_BAR; PG8_WAIT_L(0); PG8_MMA(0, 1, At, B1); PG8_BAR;
            PG8_LDA(At, 0, 1); PG8_STAGE(PG8_SA(0, 0), a2, voffA);
            PG8_BAR; PG8_WAIT_L(0); PG8_MMA(1, 0, At, B0); PG8_BAR; PG8_SCHED;
            PG8_STAGE(PG8_SB(0, 1), b2 + hstep, voffB);
            PG8_WAIT_V(6); PG8_BAR; PG8_MMA(1, 1, At, B1); PG8_BAR;
            PG8_LDB(B0, 1, 0); PG8_SCHED; PG8_LDA(At, 1, 0); PG8_STAGE(PG8_SA(0, 1), a2 + hstep, voffA);
            PG8_WAIT_L(8); PG8_BAR; PG8_WAIT_L(0); PG8_MMA(0, 0, At, B0); PG8_BAR; PG8_SCHED;
            PG8_LDB(B1, 1, 1); PG8_STAGE(PG8_SB(1, 0), b3, voffB);
            PG8_BAR; PG8_WAIT_L(0); PG8_MMA(0, 1, At, B1); PG8_BAR;
            PG8_LDA(At, 1, 1); PG8_STAGE(PG8_SA(1, 0), a3, voffA);
            PG8_BAR; PG8_WAIT_L(0); PG8_MMA(1, 0, At, B0); PG8_BAR; PG8_SCHED;
            PG8_STAGE(PG8_SB(1, 1), b3 + hstep, voffB);
            PG8_WAIT_V(6); PG8_BAR; PG8_MMA(1, 1, At, B1); PG8_BAR;
            }
        }
        if constexpr (ALIGN_EPI) { if (wr == 0) PG8_BAR; }
        if constexpr (!Epi::AFTER_DRAIN) { E(acc, cur, wr, wc, fr, fq); S.done(cur); }
        if (!has_next) break;
#pragma unroll
        for (int a = 0; a < 2; ++a)
#pragma unroll
            for (int b = 0; b < 2; ++b)
#pragma unroll
                for (int m = 0; m < 4; ++m)
#pragma unroll
                    for (int n = 0; n < 2; ++n) acc[a][b][m][n] = (f32x4){0.f, 0.f, 0.f, 0.f};
        cur = nxt; cA = nA; cB = nB; ++ui;
        if constexpr (ALIGN_EPI) { if (wr == 1) PG8_BAR; }
    }
    PG8_WAIT_V(0);
    if constexpr (!ALIGN_EPI) { if (wr == 0) PG8_BAR; }
    PG8_BAR;
    if constexpr (Epi::AFTER_DRAIN) { E.fused(acc, cur, wr, wc, fr, fq, lds, wid, lane); S.done(cur); }
#undef PG8_SA
#undef PG8_SB
#undef PG8_STAGE
#undef PG8_LDA
#undef PG8_LDB
#undef PG8_MMA
#undef PG8_WAIT_V
#undef PG8_WAIT_L
#undef PG8_BAR
#undef PG8_SCHED
}
}

constexpr int NWAVES = 8;
constexpr int M = 16384, D = 1024, NIN = 4096, HSEC = 512;
constexpr int NEXP = 32, DEXP = 512, MAXTILES = 160, MAXSLOTS = MAXTILES * 256;
constexpr float QSCALE = 0.18033688011112042f;

constexpr size_t MiB = 1u << 20;
constexpr size_t WS_CTL = 0, CTL_ZERO_BYTES = 1 * MiB;
constexpr size_t WS_WR = 1 * MiB;
constexpr size_t WS_ROPE = 2 * MiB;
constexpr size_t WS_HD = 3 * MiB;
constexpr size_t WS_TOKE = 3 * MiB + 256 * 1024, WS_TOKW = WS_TOKE + 128 * 1024, WS_TOKR = WS_TOKW + 128 * 1024, WS_TOKS = WS_TOKR + 128 * 1024, WS_LAM = WS_TOKS + 128 * 1024;
constexpr size_t WS_WOUT = 4 * MiB, WS_WIN = 6 * MiB;
constexpr size_t WS_XN = 16 * MiB;
constexpr size_t WS_OF = 16 * MiB;
constexpr size_t WS_H2 = 16 * MiB;
constexpr size_t WS_HM = 6 * MiB;
constexpr size_t WS_QH = 48 * MiB, WS_VH = 64 * MiB, WS_SG = 80 * MiB, WS_QD = 96 * MiB, WS_KD = 112 * MiB, WS_VD = 128 * MiB;
constexpr size_t WS_WGU = 48 * MiB, WS_WD = 112 * MiB;
constexpr size_t WS_GF = 144 * MiB, WS_GB = 176 * MiB;
constexpr size_t WS_MIX = 144 * MiB;
constexpr size_t WS_HS = 208 * MiB, WS_HL = 224 * MiB;
constexpr size_t WS_OB = 224 * MiB;
constexpr size_t WS_HG = 176 * MiB;
constexpr size_t WS_O0S = 176 * MiB;
constexpr size_t WS_Y = 176 * MiB;
constexpr size_t WS_END = 256 * MiB;
static_assert(WS_HM + (size_t)MAXSLOTS * 512 * 2 <= WS_WGU && WS_HG + (size_t)MAXSLOTS * 1024 * 2 <= WS_END, "ws map");
constexpr int CW_BAR = 4096, CW_CNT = 16384, CW_KMAX = 16448;

constexpr int PHASE_LDS = 147456, MISC_OFF = PHASE_LDS, LDS_BYTES = PHASE_LDS + 1024;

#define GAS __attribute__((address_space(1)))
#define LAS __attribute__((address_space(3)))
typedef unsigned short bf16_t;
typedef float f32x4 __attribute__((ext_vector_type(4)));
typedef float f32x16 __attribute__((ext_vector_type(16)));
typedef short bf16x8 __attribute__((ext_vector_type(8)));
typedef short s16x4 __attribute__((ext_vector_type(4)));
typedef unsigned u32x4 __attribute__((ext_vector_type(4)));
typedef unsigned u32x2 __attribute__((ext_vector_type(2)));
#define LDS_WAIT() asm volatile("s_waitcnt lgkmcnt(0)" ::: "memory")
#define VM_WAIT() asm volatile("s_waitcnt vmcnt(0)" ::: "memory")
#define SBAR() __builtin_amdgcn_sched_barrier(0)
__device__ __forceinline__ unsigned f2bf(float f) { unsigned u = __builtin_bit_cast(unsigned, f); return (u + 0x7fffu + ((u >> 16) & 1u)) >> 16; }
__device__ __forceinline__ unsigned pk2(float lo, float hi) { return f2bf(lo) | (f2bf(hi) << 16); }
__device__ __forceinline__ float bf2f(unsigned b) { return __builtin_bit_cast(float, b << 16); }
__device__ __forceinline__ float bflo(unsigned w) { return __builtin_bit_cast(float, w << 16); }
__device__ __forceinline__ float bfhi(unsigned w) { return __builtin_bit_cast(float, w & 0xffff0000u); }
__device__ __forceinline__ unsigned cvtpk(float lo, float hi) { unsigned r; asm volatile("v_cvt_pk_bf16_f32 %0, %1, %2" : "=v"(r) : "v"(lo), "v"(hi)); return r; }
__device__ __forceinline__ float ex2(float x) { return __builtin_amdgcn_exp2f(x); }
__device__ __forceinline__ float lg2(float x) { return __builtin_amdgcn_logf(x); }
__device__ __forceinline__ float sigmoidf_(float v) { return __builtin_amdgcn_rcpf(1.f + ex2(-1.4426950408889634f * v)); }
__device__ __forceinline__ bool lane_is_hi() { return (opaque_tid() & 32) != 0; }
template <int X> __device__ __forceinline__ float lane_xor(float v) {
    if constexpr (X == 32) { auto rr = __builtin_amdgcn_permlane32_swap(__float_as_uint(v), __float_as_uint(v), false, false); return __uint_as_float(lane_is_hi() ? rr[0] : rr[1]); }
    else return __int_as_float(__builtin_amdgcn_ds_swizzle(__float_as_int(v), (X << 10) | 0x1F));
}
__device__ __forceinline__ float wave_sum(float v) {
    v += lane_xor<1>(v); v += lane_xor<2>(v); v += lane_xor<4>(v); v += lane_xor<8>(v); v += lane_xor<16>(v);
    auto rr = __builtin_amdgcn_permlane32_swap(__float_as_uint(v), __float_as_uint(v), false, false);
    return __uint_as_float(rr[0]) + __uint_as_float(rr[1]);
}
__device__ __forceinline__ int crow(int r, int hi) { return (r & 3) + 8 * (r >> 2) + 4 * hi; }
#define XB_TMO      128
#define XB_XCNT(j)  (256  + 64 * (j))
#define XB_XSUB(j)  (1280 + 64 * (j))
#define XB_XGEN(j)  (2304 + 64 * (j))
#define XB_TOP      3328
#define XB_TOPGEN   3392
#define XCD_BAR_WORDS 3456
#define XB_SPIN_CAP (1u << 18)

__device__ __forceinline__ unsigned xb_ld(unsigned* p)              { return __hip_atomic_load(p, __ATOMIC_RELAXED, __HIP_MEMORY_SCOPE_AGENT); }
__device__ __forceinline__ unsigned xb_add(unsigned* p, unsigned v) { return __hip_atomic_fetch_add(p, v, __ATOMIC_RELAXED, __HIP_MEMORY_SCOPE_AGENT); }
__device__ __forceinline__ unsigned xb_xcc_id() { return (unsigned)__builtin_amdgcn_s_getreg((3 << 11) | 20) & 0xFu; }
#define XB_SPIN(cond, bar) do { unsigned _sp = 0; while (cond) { __builtin_amdgcn_s_sleep(1); \
    if ((++_sp & 255u) == 0u) { if (xb_ld(&(bar)[XB_TMO])) break; if (_sp > XB_SPIN_CAP) { atomicAdd(&(bar)[XB_TMO], 1u); break; } } } } while (0)

struct XcdBarrier {
    unsigned* bar; unsigned x;
    volatile LAS unsigned* st;
};

__device__ __forceinline__ XcdBarrier xcd_barrier_post(unsigned* bar, volatile LAS unsigned* st) {
    XcdBarrier b; b.bar = bar; b.x = xb_xcc_id(); b.st = st;
    if (threadIdx.x == 0) (void)xb_add(&bar[XB_XCNT(b.x)], 1u);
    return b;
}
__device__ __forceinline__ void xcd_barrier_complete(unsigned* bar, unsigned x, unsigned& nloc, unsigned& nx) {
    const unsigned G = gridDim.x * gridDim.y * gridDim.z;
    unsigned sum, cnt, mine, sp = 0u;
    for (;;) {
        sum = 0u; cnt = 0u; mine = 0u;
#pragma unroll
        for (unsigned j = 0; j < 16; ++j) { const unsigned c = xb_ld(&bar[XB_XCNT(j)]); sum += c; cnt += (c > 0u) ? 1u : 0u; mine = (j == x) ? c : mine; }
        if (sum == G) break;
        __builtin_amdgcn_s_sleep(1);
        if ((++sp & 255u) == 0u) { if (xb_ld(&bar[XB_TMO])) break; if (sp > XB_SPIN_CAP) { atomicAdd(&bar[XB_TMO], 1u); break; } }
    }
    nloc = mine > 0u ? mine : 1u; nx = cnt > 0u ? cnt : 1u;
}

__device__ __forceinline__ void xcd_barrier(const XcdBarrier& b) {
    asm volatile("s_waitcnt vmcnt(0)" ::: "memory");
    __syncthreads();
    if (threadIdx.x == 0) {
        unsigned* bar = b.bar;
        __builtin_amdgcn_s_waitcnt(0);
        unsigned nloc = b.st[0], nx = b.st[1];
        if (nloc == 0u) { xcd_barrier_complete(bar, b.x, nloc, nx); b.st[0] = nloc; b.st[1] = nx; }
        const unsigned old = xb_add(&bar[XB_XSUB(b.x)], 1u);
        const unsigned gen = old / nloc;
        if (old + 1u == (gen + 1u) * nloc) {
            __builtin_amdgcn_fence(__ATOMIC_RELEASE, "agent");
            asm volatile("s_waitcnt vmcnt(0)" ::: "memory");
            const unsigned og = xb_add(&bar[XB_TOP], 1u);
            const unsigned tg = og / nx;
            if (og + 1u == (tg + 1u) * nx) xb_add(&bar[XB_TOPGEN], 1u);
            else XB_SPIN(xb_ld(&bar[XB_TOPGEN]) == tg, bar);
            __builtin_amdgcn_fence(__ATOMIC_ACQUIRE, "agent");
            xb_add(&bar[XB_XGEN(b.x)], 1u);
            asm volatile("s_waitcnt vmcnt(0)" ::: "memory");
        } else {
            XB_SPIN(xb_ld(&bar[XB_XGEN(b.x)]) == gen, bar);
            __builtin_amdgcn_fence(__ATOMIC_ACQUIRE, "agent");
            asm volatile("s_waitcnt vmcnt(0)" ::: "memory");
        }
    }
    __syncthreads();
}

__device__ __forceinline__ void transpose_item(const float* W, int K, int N, bf16_t* WT, int row_off, int row_mul, LAS float* scr, int item, int lane) {
    const int nblk = N / 32, kb = item / nblk, nb = item % nblk, k0 = 64 * kb, n0 = 32 * nb;
#pragma unroll 8
    for (int i = 0; i < 32; ++i) { const int kk = 2 * i + (lane >> 5); scr[kk * 33 + (lane & 31)] = W[(size_t)(k0 + kk) * N + n0 + (lane & 31)]; }
    LDS_WAIT(); asm volatile("" ::: "memory");
    const int c = lane & 7;
#pragma unroll
    for (int j = 0; j < 4; ++j) { const int n = (lane >> 3) + 8 * j; const LAS float* s = scr + (8 * c) * 33 + n;
        u32x4 o; o.x = pk2(s[0 * 33], s[1 * 33]); o.y = pk2(s[2 * 33], s[3 * 33]); o.z = pk2(s[4 * 33], s[5 * 33]); o.w = pk2(s[6 * 33], s[7 * 33]);
        *(GAS u32x4*)(WT + (size_t)(row_off + (n0 + n) * row_mul) * K + k0 + 8 * c) = o; }
    LDS_WAIT(); asm volatile("" ::: "memory");
}
__device__ __forceinline__ void rms_row_to_bf16(const float* xrow, const float* gain, bf16_t* orow, int lane, float eps) {
    const GAS f32x4* xr = (const GAS f32x4*)xrow + lane; const GAS f32x4* gr = (const GAS f32x4*)gain + lane;
    f32x4 v[4]; float s = 0.f;
#pragma unroll
    for (int j = 0; j < 4; ++j) { v[j] = xr[64 * j]; s += (v[j].x * v[j].x + v[j].y * v[j].y) + (v[j].z * v[j].z + v[j].w * v[j].w); }
    const float rstd = 1.f / sqrtf(wave_sum(s) * (1.f / 1024.f) + eps);
    GAS u32x2* o8 = (GAS u32x2*)orow + lane;
#pragma unroll
    for (int j = 0; j < 4; ++j) { const f32x4 g = gr[64 * j]; u32x2 w; w.x = pk2(v[j].x * rstd * g.x, v[j].y * rstd * g.y); w.y = pk2(v[j].z * rstd * g.z, v[j].w * rstd * g.w); o8[64 * j] = w; }
}

struct EpiInProj {
    static constexpr bool PERM = true, AFTER_DRAIN = false;
    bf16_t *QH, *VH, *SG, *QD, *KD, *VD; float *GF, *GB; const float* lbraw; const float *cosT, *sinT;
    __device__ __forceinline__ void operator()(const pg8::f32x4 (&acc)[2][2][4][2], const pg8::Unit& u, int wr, int wc, int fr, int fq) const {
        const int sec = u.pn >> 1;
        const int row0 = u.pm * 256 + wr * 64 + fr;
        const int cs0 = (u.pn & 1) * 256 + wc * 32 + 8 * fq;
        if (sec == 1 || sec == 2) {
            float* G = sec == 1 ? GF : GB; const float* lbp = lbraw + (sec - 1) * 1024;
#pragma unroll
            for (int bj = 0; bj < 2; ++bj) { const int c = cs0 + bj * 128; float lb[8];
#pragma unroll
                for (int j = 0; j < 8; ++j) { const float l0 = lbp[c + j], l1 = lbp[512 + c + j]; lb[j] = __builtin_amdgcn_rcpf(1.f + ex2(1.4426950408889634f * (l0 - l1))); }
#pragma unroll
                for (int ai = 0; ai < 2; ++ai)
#pragma unroll
                    for (int m = 0; m < 4; ++m) { const int row = row0 + ai * 128 + m * 16; f32x4 o0, o1;
#pragma unroll
                        for (int j = 0; j < 4; ++j) { o0[j] = lg2(lb[j] + (1.f - lb[j]) * sigmoidf_(acc[ai][bj][m][0][j])); o1[j] = lg2(lb[4 + j] + (1.f - lb[4 + j]) * sigmoidf_(acc[ai][bj][m][1][j])); }
                        *(f32x4*)(G + (size_t)row * HSEC + c) = o0; *(f32x4*)(G + (size_t)row * HSEC + c + 4) = o1; } }
            return;
        }
        bf16_t* O = sec == 0 ? QH : sec == 3 ? VH : sec == 4 ? SG : sec == 5 ? QD : sec == 6 ? KD : VD;
        const bool rot = (sec == 5 || sec == 6) && ((wc & 1) == 0);
        const float sc = sec == 5 ? QSCALE : 1.f;
#pragma unroll
        for (int ai = 0; ai < 2; ++ai)
#pragma unroll
            for (int m = 0; m < 4; ++m) { const int row = row0 + ai * 128 + m * 16;
#pragma unroll
                for (int bj = 0; bj < 2; ++bj) { const int c = cs0 + bj * 128; float v[8];
#pragma unroll
                    for (int j = 0; j < 4; ++j) { v[j] = acc[ai][bj][m][0][j]; v[4 + j] = acc[ai][bj][m][1][j]; }
                    if (sec == 4) {
#pragma unroll
                        for (int j = 0; j < 8; ++j) v[j] = v[j] * sigmoidf_(v[j]);
                    }
                    if (rot) {
                        const f32x4 c0 = *(const f32x4*)(cosT + (size_t)row * 8), c1 = *(const f32x4*)(cosT + (size_t)row * 8 + 4);
                        const f32x4 s0 = *(const f32x4*)(sinT + (size_t)row * 8), s1 = *(const f32x4*)(sinT + (size_t)row * 8 + 4);
#pragma unroll
                        for (int j = 0; j < 8; ++j) { const float p = lane_xor<16>(v[j]); const float cj = j < 4 ? c0[j & 3] : c1[j & 3], sj = j < 4 ? s0[j & 3] : s1[j & 3];
                            const float r = fq == 0 ? v[j] * cj - p * sj : v[j] * cj + p * sj; v[j] = fq < 2 ? r : v[j]; }
                    }
                    u32x4 w; w.x = cvtpk(v[0] * sc, v[1] * sc); w.y = cvtpk(v[2] * sc, v[3] * sc); w.z = cvtpk(v[4] * sc, v[5] * sc); w.w = cvtpk(v[6] * sc, v[7] * sc);
                    *(u32x4*)(O + (size_t)row * HSEC + c) = w; } }
    }
};
struct EpiResid {
    static constexpr bool PERM = true, AFTER_DRAIN = false;
    const float* X; float* O;
    __device__ __forceinline__ void operator()(const pg8::f32x4 (&acc)[2][2][4][2], const pg8::Unit& u, int wr, int wc, int fr, int fq) const {
        const int row0 = u.pm * 256 + wr * 64 + fr, col0 = u.pn * 256 + wc * 32 + 8 * fq;
#pragma unroll
        for (int ai = 0; ai < 2; ++ai)
#pragma unroll
            for (int m = 0; m < 4; ++m) { const size_t off = (size_t)(row0 + ai * 128 + m * 16) * D + col0;
#pragma unroll
                for (int bj = 0; bj < 2; ++bj) { const f32x4 a = *(const f32x4*)(X + off + bj * 128), b = *(const f32x4*)(X + off + bj * 128 + 4);
                    *(f32x4*)(O + off + bj * 128) = a + acc[ai][bj][m][0]; *(f32x4*)(O + off + bj * 128 + 4) = b + acc[ai][bj][m][1]; } }
    }
};
struct EpiSwiGlu {
    static constexpr bool PERM = true, AFTER_DRAIN = false;
    bf16_t* O;
    __device__ __forceinline__ void operator()(const pg8::f32x4 (&acc)[2][2][4][2], const pg8::Unit& u, int wr, int wc, int fr, int fq) const {
        const int row0 = u.pm * 256 + wr * 64 + fr, col0 = ((u.pn & 3) * 256 + wc * 32 + 8 * fq) >> 1;
#pragma unroll
        for (int ai = 0; ai < 2; ++ai)
#pragma unroll
            for (int m = 0; m < 4; ++m) { bf16_t* rowp = O + (size_t)(row0 + ai * 128 + m * 16) * DEXP + col0;
#pragma unroll
                for (int bj = 0; bj < 2; ++bj) { const f32x4 a = acc[ai][bj][m][0], b = acc[ai][bj][m][1];
                    const float h0 = a[0] * sigmoidf_(a[0]) * a[1], h1 = a[2] * sigmoidf_(a[2]) * a[3], h2 = b[0] * sigmoidf_(b[0]) * b[1], h3 = b[2] * sigmoidf_(b[2]) * b[3];
                    u32x2 w; w.x = cvtpk(h0, h1); w.y = cvtpk(h2, h3); *(u32x2*)(rowp + bj * 64) = w; } }
    }
};
struct EpiDown {
    static constexpr bool PERM = true, AFTER_DRAIN = false;
    bf16_t* O;
    __device__ __forceinline__ void operator()(const pg8::f32x4 (&acc)[2][2][4][2], const pg8::Unit& u, int wr, int wc, int fr, int fq) const {
        const int row0 = u.pm * 256 + wr * 64 + fr, col0 = (u.pn & 3) * 256 + wc * 32 + 8 * fq;
#pragma unroll
        for (int ai = 0; ai < 2; ++ai)
#pragma unroll
            for (int m = 0; m < 4; ++m) { bf16_t* rowp = O + (size_t)(row0 + ai * 128 + m * 16) * D + col0;
#pragma unroll
                for (int bj = 0; bj < 2; ++bj) { const f32x4 a = acc[ai][bj][m][0], b = acc[ai][bj][m][1];
                    u32x4 w; w.x = cvtpk(a[0], a[1]); w.y = cvtpk(a[2], a[3]); w.z = cvtpk(b[0], b[1]); w.w = cvtpk(b[2], b[3]); *(u32x4*)(rowp + bj * 128) = w; } }
    }
};
struct MoeOrder {
    const volatile LAS int* tb; int G, c;
    __device__ __forceinline__ bool next(int i, pg8::Unit& u) const {
        const int L = i * G + c, T = __builtin_amdgcn_readfirstlane(tb[32]); if (L >= 4 * T) return false;
        const int tile = L >> 2; int e = 0;
#pragma unroll 1
        for (int j = 1; j < 32; ++j) e += (__builtin_amdgcn_readfirstlane(tb[j]) <= tile) ? 1 : 0;
        u.pm = tile; u.pn = e * 4 + (L & 3); return true;
    }
    __device__ __forceinline__ void a_ready(const pg8::Unit&) const {}
    __device__ __forceinline__ void done(const pg8::Unit&) const {}
};

namespace hg {
constexpr int S128 = 272, S64 = 144;
constexpr int L_QD = 0, L_QE = L_QD + 64 * S128, L_KE = L_QE + 64 * S128, L_KET = L_KE + 64 * S128, L_VT = L_KET + 128 * S64, L_ST = L_VT + 128 * S64,
              L_P = L_ST + 128 * S128, L_QS = L_P + 64 * S64, L_DC = L_QS + 4 * 128 * 4, L_END = L_DC + 128 * 4;
static_assert(L_END <= PHASE_LDS, "hgrn LDS");
__device__ __forceinline__ bf16x8 frag(const LAS unsigned char* base, int row, int stride, int kb  ) { return *(const LAS bf16x8*)(base + row * stride + kb); }

template <bool PASS_C>
__device__ __forceinline__ void pass(LAS unsigned char* lds, int unit, const bf16_t* QH, const bf16_t* VH, const float* GF, const float* GB,
                                     float* HL, float* HD, const float* HS, float* OF, float* OB) {
    const int tid = opaque_tid(), lane = tid & 63, wid = __builtin_amdgcn_readfirstlane(tid >> 6), r32 = lane & 31, hi = lane >> 5;
    const int dir = unit >> 7, head = (unit >> 5) & 3, sc = unit & 31;
    const int k = tid & 127, qtr = tid >> 7;
    const float* G = dir ? GB : GF; float* O = dir ? OB : OF;
    const int vi = wid >> 1, ki0 = (wid & 1) * 2;
    f32x16 sacc[2];
    LAS float* QS = (LAS float*)(lds + L_QS); LAS float* DC = (LAS float*)(lds + L_DC);
    if (PASS_C) {
        const float* hs = HS + (size_t)unit * 16384;
#pragma unroll
        for (int tt = 0; tt < 2; ++tt)
#pragma unroll
            for (int r = 0; r < 16; ++r) { const int v = vi * 32 + crow(r, hi), kk = (ki0 + tt) * 32 + r32; const float s = hs[v * 128 + kk]; sacc[tt][r] = s;
                *(LAS bf16_t*)(lds + L_ST + v * S128 + kk * 2) = (bf16_t)f2bf(s); }
    } else { sacc[0] = f32x16{}; sacc[1] = f32x16{}; }
    float btot = 0.f;
#pragma unroll 1
    for (int c = 0; c < 8; ++c) {
        const int t0 = sc * 512 + c * 64;
        float g[16]; unsigned qv[16], vv[16];
#pragma unroll
        for (int i = 0; i < 16; ++i) { const int tl = t0 + 16 * qtr + i, tok = dir ? (M - 1 - tl) : tl; const size_t off = (size_t)tok * HSEC + head * 128 + k;
            g[i] = G[off]; vv[i] = VH[off]; if (PASS_C) qv[i] = QH[off]; }
        float b[16]; b[0] = g[0];
#pragma unroll
        for (int i = 1; i < 16; ++i) b[i] = b[i - 1] + g[i];
        QS[qtr * 128 + k] = b[15];
        LDS_WAIT(); __syncthreads();
        float pre = 0.f, tot = 0.f;
#pragma unroll
        for (int q = 0; q < 4; ++q) { const float s = QS[q * 128 + k]; tot += s; pre += (q < qtr) ? s : 0.f; }
        btot += tot;
        if (qtr == 0) DC[k] = ex2(tot);
        unsigned ket[8], vt[8];
#pragma unroll
        for (int i = 0; i < 16; i += 2) {
            const float b0 = b[i] + pre, b1 = b[i + 1] + pre;
            const float ke0 = (1.f - ex2(g[i])) * ex2(tot - b0), ke1 = (1.f - ex2(g[i + 1])) * ex2(tot - b1);
            ket[i >> 1] = cvtpk(ke0, ke1); vt[i >> 1] = vv[i] | (vv[i + 1] << 16);
            if (PASS_C) {
                const int tr0 = 16 * qtr + i;
                const float q0 = bf2f(qv[i]), q1 = bf2f(qv[i + 1]);
                *(LAS bf16_t*)(lds + L_KE + tr0 * S128 + k * 2) = (bf16_t)(ket[i >> 1] & 0xffffu); *(LAS bf16_t*)(lds + L_KE + (tr0 + 1) * S128 + k * 2) = (bf16_t)(ket[i >> 1] >> 16);
                *(LAS bf16_t*)(lds + L_QD + tr0 * S128 + k * 2) = (bf16_t)f2bf(q0 * ex2(b0)); *(LAS bf16_t*)(lds + L_QD + (tr0 + 1) * S128 + k * 2) = (bf16_t)f2bf(q1 * ex2(b1));
                *(LAS bf16_t*)(lds + L_QE + tr0 * S128 + k * 2) = (bf16_t)f2bf(q0 * ex2(b0 - tot)); *(LAS bf16_t*)(lds + L_QE + (tr0 + 1) * S128 + k * 2) = (bf16_t)f2bf(q1 * ex2(b1 - tot));
            }
        }
        *(LAS u32x4*)(lds + L_KET + k * S64 + qtr * 32) = (u32x4){ket[0], ket[1], ket[2], ket[3]}; *(LAS u32x4*)(lds + L_KET + k * S64 + qtr * 32 + 16) = (u32x4){ket[4], ket[5], ket[6], ket[7]};
        *(LAS u32x4*)(lds + L_VT + k * S64 + qtr * 32) = (u32x4){vt[0], vt[1], vt[2], vt[3]};     *(LAS u32x4*)(lds + L_VT + k * S64 + qtr * 32 + 16) = (u32x4){vt[4], vt[5], vt[6], vt[7]};
        LDS_WAIT(); __syncthreads();
        if (PASS_C) {
            if (wid < 4) {
                const int ti = wid >> 1, si = wid & 1; f32x16 p = f32x16{};
                if (!(ti == 0 && si == 1)) {
#pragma unroll
                    for (int ks = 0; ks < 8; ++ks) p = __builtin_amdgcn_mfma_f32_32x32x16_bf16(frag(lds + L_QE, ti * 32 + r32, S128, ks * 32 + hi * 16), frag(lds + L_KE, si * 32 + r32, S128, ks * 32 + hi * 16), p, 0, 0, 0);
                }
#pragma unroll
                for (int r = 0; r < 16; ++r) { const int t = ti * 32 + crow(r, hi), s = si * 32 + r32; *(LAS bf16_t*)(lds + L_P + t * S64 + s * 2) = (bf16_t)f2bf(s <= t ? p[r] : 0.f); }
            }
            LDS_WAIT(); __syncthreads();
            { const int ti = wid >> 2, vo = wid & 3; f32x16 o = f32x16{};
#pragma unroll
                for (int ks = 0; ks < 8; ++ks) o = __builtin_amdgcn_mfma_f32_32x32x16_bf16(frag(lds + L_QD, ti * 32 + r32, S128, ks * 32 + hi * 16), frag(lds + L_ST, vo * 32 + r32, S128, ks * 32 + hi * 16), o, 0, 0, 0);
#pragma unroll
                for (int ss = 0; ss < 4; ++ss) o = __builtin_amdgcn_mfma_f32_32x32x16_bf16(frag(lds + L_P, ti * 32 + r32, S64, ss * 32 + hi * 16), frag(lds + L_VT, vo * 32 + r32, S64, ss * 32 + hi * 16), o, 0, 0, 0);
#pragma unroll
                for (int r = 0; r < 16; ++r) { const int tl = t0 + ti * 32 + crow(r, hi), tok = dir ? (M - 1 - tl) : tl; O[(size_t)tok * HSEC + head * 128 + vo * 32 + r32] = o[r]; }
            }
        }
#pragma unroll
        for (int tt = 0; tt < 2; ++tt) { const int ki = ki0 + tt; const float d = DC[ki * 32 + r32];
#pragma unroll
            for (int r = 0; r < 16; ++r) sacc[tt][r] *= d;
#pragma unroll
            for (int ss = 0; ss < 4; ++ss) sacc[tt] = __builtin_amdgcn_mfma_f32_32x32x16_bf16(frag(lds + L_VT, vi * 32 + r32, S64, ss * 32 + hi * 16), frag(lds + L_KET, ki * 32 + r32, S64, ss * 32 + hi * 16), sacc[tt], 0, 0, 0);
        }
        LDS_WAIT(); __syncthreads();
        if (PASS_C) {
#pragma unroll
            for (int tt = 0; tt < 2; ++tt)
#pragma unroll
                for (int r = 0; r < 16; ++r) { const int v = vi * 32 + crow(r, hi), kk = (ki0 + tt) * 32 + r32; *(LAS bf16_t*)(lds + L_ST + v * S128 + kk * 2) = (bf16_t)f2bf(sacc[tt][r]); }
        }
    }
    if (!PASS_C) {
        float* hl = HL + (size_t)unit * 16384;
#pragma unroll
        for (int tt = 0; tt < 2; ++tt)
#pragma unroll
            for (int r = 0; r < 16; ++r) { const int v = vi * 32 + crow(r, hi), kk = (ki0 + tt) * 32 + r32; hl[v * 128 + kk] = sacc[tt][r]; }
        if (qtr == 0) HD[unit * 128 + k] = ex2(btot);
    }
    __syncthreads();
}
__device__ __forceinline__ void scan(const float* HL, const float* HD, float* HS, int gtid, int gthreads) {
    for (int id = gtid; id < 8 * 16384; id += gthreads) {
        const int dh = id >> 14, e = id & 16383, k = e & 127; float S = 0.f;
#pragma unroll 4
        for (int sc = 0; sc < 32; ++sc) { const int u = dh * 32 + sc; HS[(size_t)u * 16384 + e] = S; S = HD[u * 128 + k] * S + HL[(size_t)u * 16384 + e]; }
    }
}
}

namespace att {
constexpr int QBLK = 32, KVBLK = 64, LDR = HSEC;
constexpr int SHM_V = 16384, SHM_K = 8192;
constexpr int OFF_V = 0, OFF_K = 2 * SHM_V, OFF_WS = OFF_K + 2 * SHM_K, OFF_O0 = OFF_WS + NWAVES * 64 * 4, OFF_END = OFF_O0 + 32 * 512 * 4;
static_assert(OFF_END <= PHASE_LDS, "attention LDS");
constexpr float THRL = 11.5f;

__device__ __forceinline__ void partialSM(f32x16& p0, f32x16& p1, float& m_reg, float& mn, float& alpha) {
    float pmax = p0[0];
#pragma unroll
    for (int r = 1; r < 16; ++r) pmax = fmaxf(pmax, p0[r]);
#pragma unroll
    for (int r = 0; r < 16; ++r) pmax = fmaxf(pmax, p1[r]);
    { auto rr = __builtin_amdgcn_permlane32_swap(__float_as_uint(pmax), __float_as_uint(pmax), false, false); pmax = fmaxf(__uint_as_float(rr[0]), __uint_as_float(rr[1])); }
    if (__builtin_expect(__all(pmax - m_reg <= THRL), 1)) { mn = m_reg; alpha = 1.f; }
    else { mn = fmaxf(m_reg, pmax); alpha = ex2(m_reg - mn); m_reg = mn; }
#pragma unroll
    for (int r = 0; r < 16; ++r) { p0[r] -= mn; p1[r] -= mn; }
#pragma unroll
    for (int r = 0; r < 16; ++r) p0[r] = ex2(p0[r]);
}
__device__ __forceinline__ void finishSM(f32x16& p0, f32x16& p1, float alpha, float& l_reg, bf16x8& pa0, bf16x8& pa1, bf16x8& pa2, bf16x8& pa3) {
#pragma unroll
    for (int r = 0; r < 16; ++r) p1[r] = ex2(p1[r]);
    float ps = 0.f;
#pragma unroll
    for (int r = 0; r < 16; ++r) ps += p0[r];
#pragma unroll
    for (int r = 0; r < 16; ++r) ps += p1[r];
    { auto rr = __builtin_amdgcn_permlane32_swap(__float_as_uint(ps), __float_as_uint(ps), false, false); ps = __uint_as_float(rr[0]) + __uint_as_float(rr[1]); }
    l_reg = l_reg * alpha + ps;
#define PK4(P, BASE, OUT) do { unsigned a0 = cvtpk(P[BASE + 0], P[BASE + 1]), a1 = cvtpk(P[BASE + 2], P[BASE + 3]);   \
    unsigned b0 = cvtpk(P[BASE + 4], P[BASE + 5]), b1 = cvtpk(P[BASE + 6], P[BASE + 7]);                              \
    auto r0 = __builtin_amdgcn_permlane32_swap(a0, b0, false, false); auto r1 = __builtin_amdgcn_permlane32_swap(a1, b1, false, false); \
    u32x4 w = {r0[0], r1[0], r0[1], r1[1]}; OUT = *reinterpret_cast<bf16x8*>(&w); } while (0)
    PK4(p0, 0, pa0); PK4(p0, 8, pa1); PK4(p1, 0, pa2); PK4(p1, 8, pa3);
#undef PK4
}
__device__ __forceinline__ void qkt(f32x16& p0, f32x16& p1, const LAS unsigned char* Ks, const bf16x8* qr, int r32, int hi) {
    p0 = f32x16{}; p1 = f32x16{};
#pragma unroll
    for (int d0 = 0; d0 < 4; ++d0) {
        const bf16x8 b0 = *(const LAS bf16x8*)(Ks + (d0 * 2 + hi) * 1024 + r32 * 16);
        const bf16x8 b1 = *(const LAS bf16x8*)(Ks + (d0 * 2 + hi) * 1024 + (32 + r32) * 16);
        p0 = __builtin_amdgcn_mfma_f32_32x32x16_bf16(b0, qr[d0], p0, 0, 0, 0);
        p1 = __builtin_amdgcn_mfma_f32_32x32x16_bf16(b1, qr[d0], p1, 0, 0, 0); }
}
__device__ __forceinline__ int v_st(int k, int c) { const int kk = (k & ~0xC) | ((k & 4) << 1) | ((k & 8) >> 1); return ((kk >> 3) * 4 + (c >> 5)) * 512 + ((kk & 7) * 32 + (c & 31)) * 2; }
__device__ __forceinline__ int v_rd_base(int lane) { return ((lane & 3) << 3) | (((lane >> 2) & 3) << 6) | (((lane >> 4) & 1) << 5) | (((lane >> 5) & 1) << 8); }
constexpr int v_rd_off(int d0, int ks, int half) { return d0 * 512 + ks * 4096 + half * 2048; }
template <int OFF> __device__ __forceinline__ s16x4 tr_read(int vb) {
    s16x4 r; asm volatile("ds_read_b64_tr_b16 %0, %1 offset:%2" : "=&v"(r) : "v"(vb), "i"(OFF) : "memory"); return r;
}
template <int D0> __device__ __forceinline__ void pv_one(f32x16& od, int vb, bf16x8 pa0, bf16x8 pa1, bf16x8 pa2, bf16x8 pa3) {
    const s16x4 l0 = tr_read<v_rd_off(D0, 0, 0)>(vb), h0 = tr_read<v_rd_off(D0, 0, 1)>(vb), l1 = tr_read<v_rd_off(D0, 1, 0)>(vb), h1 = tr_read<v_rd_off(D0, 1, 1)>(vb);
    const s16x4 l2 = tr_read<v_rd_off(D0, 2, 0)>(vb), h2 = tr_read<v_rd_off(D0, 2, 1)>(vb), l3 = tr_read<v_rd_off(D0, 3, 0)>(vb), h3 = tr_read<v_rd_off(D0, 3, 1)>(vb);
    asm volatile("s_waitcnt lgkmcnt(0)" ::: "memory"); SBAR();
#define PK(L, H) (bf16x8){L[0], L[1], L[2], L[3], H[0], H[1], H[2], H[3]}
    od = __builtin_amdgcn_mfma_f32_32x32x16_bf16(pa0, PK(l0, h0), od, 0, 0, 0);
    od = __builtin_amdgcn_mfma_f32_32x32x16_bf16(pa1, PK(l1, h1), od, 0, 0, 0);
    od = __builtin_amdgcn_mfma_f32_32x32x16_bf16(pa2, PK(l2, h2), od, 0, 0, 0);
    od = __builtin_amdgcn_mfma_f32_32x32x16_bf16(pa3, PK(l3, h3), od, 0, 0, 0);
#undef PK
}
__device__ __forceinline__ void pv_d0(f32x16* o, int vb, bf16x8 pa0, bf16x8 pa1, bf16x8 pa2, bf16x8 pa3) {
    pv_one<0>(o[0], vb, pa0, pa1, pa2, pa3); pv_one<1>(o[1], vb, pa0, pa1, pa2, pa3); pv_one<2>(o[2], vb, pa0, pa1, pa2, pa3); pv_one<3>(o[3], vb, pa0, pa1, pa2, pa3);
}

__device__ __forceinline__ void unit(LAS unsigned char* lds, int h, int q0, const bf16_t* __restrict__ QD, const bf16_t* __restrict__ KD, const bf16_t* __restrict__ VD,
                                     float lam, const float* __restrict__ subg, bf16_t* MIX) {
    const int tid = opaque_tid(), wid = __builtin_amdgcn_readfirstlane(tid >> 6), lane = tid & 63, r32 = lane & 31, hi = lane >> 5;
    LAS unsigned char* V_lds = lds + OFF_V; LAS unsigned char* K_lds = lds + OFF_K;
    LAS float* ws = (LAS float*)(lds + OFF_WS) + wid * 64; LAS float* li_l = ws; LAS float* al_l = ws + 32;
    LAS unsigned* O0 = (LAS unsigned*)(lds + OFF_O0);
    const int sr = tid >> 4, sc = (tid & 15) * 8, vst0 = v_st(sr, sc), vst1 = v_st(32 + sr, sc), kst = wid * 1024 + lane * 16;
    const int vb0 = (int)(uintptr_t)V_lds + v_rd_base(lane);
    const unsigned voV0 = (unsigned)(sr * LDR + sc), voV1 = (unsigned)((32 + sr) * LDR + sc), voK = (unsigned)(lane * LDR + wid * 8);
    constexpr int NT = M / KVBLK;
#pragma unroll 1
    for (int mp = 0; mp < 2; ++mp) {
        const bf16_t* Kh = KD + h * 128 + mp * 64; const bf16_t* Vh = VD + h * 128;
        const bf16_t* Qw = QD + (size_t)(q0 + wid * QBLK + r32) * LDR + h * 128 + mp * 64 + hi * 8;
        float m_reg = -1e30f, l_reg = 0.f; f32x16 o[4] = {}; bf16x8 qr[4];
#pragma unroll
        for (int d0 = 0; d0 < 4; ++d0) qr[d0] = *reinterpret_cast<const bf16x8*>(Qw + d0 * 16);
        struct { bf16x8 vs0, vs1, ks0; } sr_[2];
#define SLOAD(i, k0) do { const bf16_t* vt_ = Vh + (size_t)(k0) * LDR; const bf16_t* kt_ = Kh + (size_t)(k0) * LDR; \
        sr_[i].vs0 = *reinterpret_cast<const bf16x8*>(vt_ + voV0); sr_[i].vs1 = *reinterpret_cast<const bf16x8*>(vt_ + voV1); sr_[i].ks0 = *reinterpret_cast<const bf16x8*>(kt_ + voK); } while (0)
#define SWRITE(b, i) do { *(LAS bf16x8*)(V_lds + (b) * SHM_V + vst0) = sr_[i].vs0; *(LAS bf16x8*)(V_lds + (b) * SHM_V + vst1) = sr_[i].vs1; \
        *(LAS bf16x8*)(K_lds + (b) * SHM_K + kst) = sr_[i].ks0; } while (0)
#define SWAIT() asm volatile("s_waitcnt vmcnt(3)" ::: "memory")
#define RESC(a) do { if (__any((a) < 1.f)) { if (hi == 0) al_l[r32] = (a); asm volatile("s_waitcnt lgkmcnt(0)" ::: "memory"); \
        _Pragma("unroll") for (int d = 0; d < 4; ++d) _Pragma("unroll") for (int r = 0; r < 16; ++r) o[d][r] *= al_l[crow(r, hi)]; } } while (0)
        f32x16 pA0, pA1, pB0, pB1; float mnA, mnB, alA, alB; bf16x8 pa0, pa1, pa2, pa3;
        constexpr int SE = 0, SO = 1;
        SLOAD(SE, 0); asm volatile("s_waitcnt vmcnt(0)" ::: "memory"); SWRITE(0, SE); __syncthreads();
        qkt(pA0, pA1, K_lds, qr, r32, hi); partialSM(pA0, pA1, m_reg, mnA, alA);
        SLOAD(SO, KVBLK); SLOAD(SE, 2 * KVBLK);
        SWAIT(); SWRITE(1, SO); __syncthreads();
#pragma unroll 1
        for (int j = 1; j + 1 < NT; j += 2) {
            SBAR(); qkt(pB0, pB1, K_lds + SHM_K, qr, r32, hi);
            finishSM(pA0, pA1, alA, l_reg, pa0, pa1, pa2, pa3); SBAR();
            SLOAD(SO, (j + 2) * KVBLK); SBAR();
            pv_d0(o, vb0, pa0, pa1, pa2, pa3); partialSM(pB0, pB1, m_reg, mnB, alB);
            __syncthreads(); SWAIT(); SWRITE(0, SE);
            RESC(alB); __syncthreads();
            SBAR(); qkt(pA0, pA1, K_lds, qr, r32, hi);
            finishSM(pB0, pB1, alB, l_reg, pa0, pa1, pa2, pa3); SBAR();
            if (j + 3 < NT) SLOAD(SE, (j + 3) * KVBLK); SBAR();
            pv_d0(o, vb0 + SHM_V, pa0, pa1, pa2, pa3); partialSM(pA0, pA1, m_reg, mnA, alA);
            __syncthreads(); SWAIT(); SWRITE(1, SO);
            RESC(alA); __syncthreads();
        }
        SBAR(); qkt(pB0, pB1, K_lds + SHM_K, qr, r32, hi);
        finishSM(pA0, pA1, alA, l_reg, pa0, pa1, pa2, pa3); SBAR();
        pv_d0(o, vb0, pa0, pa1, pa2, pa3); partialSM(pB0, pB1, m_reg, mnB, alB);
        __syncthreads(); RESC(alB);
        finishSM(pB0, pB1, alB, l_reg, pa0, pa1, pa2, pa3); SBAR();
        pv_d0(o, vb0 + SHM_V, pa0, pa1, pa2, pa3);
#undef SLOAD
#undef SWRITE
#undef SWAIT
#undef RESC
        if (hi == 0) li_l[r32] = l_reg; asm volatile("s_waitcnt lgkmcnt(0)" ::: "memory");
        int rowb = q0 + wid * QBLK; asm volatile("" : "+s"(rowb));
        float rli[16];
#pragma unroll
        for (int r = 0; r < 16; ++r) rli[r] = __builtin_amdgcn_rcpf(li_l[crow(r, hi)]);
        if (mp == 0) {
#pragma unroll
            for (int d0 = 0; d0 < 4; ++d0)
#pragma unroll
                for (int r = 0; r < 16; r += 2) O0[(d0 * 8 + (r >> 1)) * 512 + tid] = cvtpk(o[d0][r] * rli[r], o[d0][r + 1] * rli[r + 1]);
        } else {
            float ss[16];
#pragma unroll
            for (int r = 0; r < 16; ++r) ss[r] = 0.f;
#pragma unroll
            for (int d0 = 0; d0 < 4; ++d0)
#pragma unroll
                for (int r = 0; r < 16; r += 2) { const unsigned w = O0[(d0 * 8 + (r >> 1)) * 512 + tid];
                    const float c0 = bflo(w) - lam * o[d0][r] * rli[r], c1 = bfhi(w) - lam * o[d0][r + 1] * rli[r + 1];
                    o[d0][r] = c0; o[d0][r + 1] = c1; ss[r] += c0 * c0; ss[r + 1] += c1 * c1; }
#pragma unroll
            for (int r = 0; r < 16; ++r) {
                ss[r] += lane_xor<1>(ss[r]); ss[r] += lane_xor<2>(ss[r]); ss[r] += lane_xor<4>(ss[r]); ss[r] += lane_xor<8>(ss[r]); ss[r] += lane_xor<16>(ss[r]);
                ss[r] = 0.8f / sqrtf(ss[r] * (1.f / 128.f) + 1e-5f); }
#pragma unroll
            for (int d0 = 0; d0 < 4; ++d0) { const float g = subg[d0 * 32 + r32];
#pragma unroll
                for (int r = 0; r < 16; ++r) MIX[(size_t)(rowb + crow(r, hi)) * D + 512 + h * 128 + d0 * 32 + r32] = (bf16_t)f2bf(o[d0][r] * ss[r] * g); }
        }
        __syncthreads();
    }
}
__device__ __forceinline__ void hgrn_finalize(int h, int q0, const float* OF, const float* OB, const bf16_t* SG, const float* gain, bf16_t* MIX, int wid, int lane) {
    const float g0 = gain[2 * lane], g1 = gain[2 * lane + 1];
#pragma unroll 4
    for (int i = 0; i < 32; ++i) { const int row = q0 + wid * 32 + i; const size_t off = (size_t)row * HSEC + h * 128 + 2 * lane;
        const float2 a = *(const float2*)(OF + off), b = *(const float2*)(OB + off); const unsigned sg = *(const unsigned*)(SG + off);
        const float x0 = a.x + b.x, x1 = a.y + b.y; const float ssum = wave_sum(x0 * x0 + x1 * x1);
        const float rstd = 1.f / sqrtf(ssum * (1.f / 128.f) + 1e-6f);
        *(unsigned*)(MIX + (size_t)row * D + h * 128 + 2 * lane) = cvtpk(x0 * rstd * g0 * bflo(sg), x1 * rstd * g1 * bfhi(sg)); }
}
}

namespace att2 {
typedef short v4i16_t __attribute__((ext_vector_type(4)));
constexpr int KVBLK = 64, LDR = HSEC, NT = M / KVBLK;
constexpr int KSLOT = 8192, VSLOT = 16384, NSLOT = 4;
constexpr int OFF_K = 0, OFF_V = NSLOT * KSLOT, OFF_WS = OFF_V + NSLOT * VSLOT, OFF_END = OFF_WS + NWAVES * 64 * 4;
static_assert(OFF_END <= PHASE_LDS, "attention LDS");
__device__ __forceinline__ s16x4 vtr(const LAS unsigned char* p) { return __builtin_bit_cast(s16x4, __builtin_amdgcn_ds_read_tr16_b64_v4i16((LAS v4i16_t*)p)); }
__device__ __forceinline__ void glds16(const void* sbase, unsigned voff, unsigned lds_dst) { unsigned keep;
    asm volatile("s_mov_b32 %0, m0\n\ts_mov_b32 m0, %3\n\ts_nop 0\n\tglobal_load_lds_dwordx4 %1, %2\n\ts_mov_b32 m0, %0" : "=&s"(keep) : "v"(voff), "s"(sbase), "s"(lds_dst) : "memory"); }
#define ATT2_WAIT_BAR(N) asm volatile("s_waitcnt vmcnt(" #N ") lgkmcnt(0)\n\ts_barrier" ::: "memory")
template <bool DO_QK, bool DO_SM, bool DO_PV>
__device__ __forceinline__ void step(f32x16& sn0, f32x16& sn1, f32x16& sc0, f32x16& sc1, const u32x4& pap0, const u32x4& pap1, const u32x4& pap2, const u32x4& pap3,
                                     u32x4& pan0, u32x4& pan1, u32x4& pan2, u32x4& pan3, f32x16 (&o)[4], const bf16x8 (&qr)[4], const f32x16& negm, float& lsum,
                                     const LAS unsigned char* kc, const LAS unsigned char* knn, const LAS unsigned char* vb, bf16x8& kf0, bf16x8& kf1) {
    bf16x8 fr0 = kf0, fr1 = kf1, fr2 = kf0; unsigned ca0 = 0, ca1 = 0, cb0 = 0, cb1 = 0;
    (void)ca0; (void)ca1; (void)cb0; (void)cb1;
    if (DO_QK) { fr2 = *(const LAS bf16x8*)(kc + 2048); }
    if (DO_QK) sn0 = __builtin_amdgcn_mfma_f32_32x32x16_bf16(fr0, qr[0], negm, 0, 0, 0);
    if (DO_SM) { sc0[0] = ex2(sc0[0]); sc0[1] = ex2(sc0[1]); }
    SBAR();
    if (DO_QK) { fr0 = *(const LAS bf16x8*)(kc + 2560); }
    if (DO_QK) sn1 = __builtin_amdgcn_mfma_f32_32x32x16_bf16(fr1, qr[0], negm, 0, 0, 0);
    if (DO_SM) { sc0[2] = ex2(sc0[2]); sc0[3] = ex2(sc0[3]); lsum += sc0[0]; lsum += sc0[1]; }
    SBAR();
    if (DO_QK) { fr1 = *(const LAS bf16x8*)(kc + 4096); }
    if (DO_QK) sn0 = __builtin_amdgcn_mfma_f32_32x32x16_bf16(fr2, qr[1], sn0, 0, 0, 0);
    if (DO_SM) { sc0[4] = ex2(sc0[4]); sc0[5] = ex2(sc0[5]); lsum += sc0[2]; lsum += sc0[3]; }
    SBAR();
    if (DO_QK) { fr2 = *(const LAS bf16x8*)(kc + 4608); }
    if (DO_QK) sn1 = __builtin_amdgcn_mfma_f32_32x32x16_bf16(fr0, qr[1], sn1, 0, 0, 0);
    if (DO_SM) { sc0[6] = ex2(sc0[6]); sc0[7] = ex2(sc0[7]); lsum += sc0[4]; lsum += sc0[5]; }
    SBAR();
    if (DO_QK) { fr0 = *(const LAS bf16x8*)(kc + 6144); }
    if (DO_QK) sn0 = __builtin_amdgcn_mfma_f32_32x32x16_bf16(fr1, qr[2], sn0, 0, 0, 0);
    if (DO_SM) { sc0[8] = ex2(sc0[8]); sc0[9] = ex2(sc0[9]); lsum += sc0[6]; lsum += sc0[7]; }
    SBAR();
    if (DO_QK) { fr1 = *(const LAS bf16x8*)(kc + 6656); }
    if (DO_QK) sn1 = __builtin_amdgcn_mfma_f32_32x32x16_bf16(fr2, qr[2], sn1, 0, 0, 0);
    if (DO_SM) { sc0[10] = ex2(sc0[10]); sc0[11] = ex2(sc0[11]); lsum += sc0[8]; lsum += sc0[9]; }
    SBAR();
    if (DO_PV) { { const s16x4 l_ = vtr(vb + 0), h_ = vtr(vb + 2048); fr2 = (bf16x8){l_[0], l_[1], l_[2], l_[3], h_[0], h_[1], h_[2], h_[3]}; } }
    if (DO_QK) sn0 = __builtin_amdgcn_mfma_f32_32x32x16_bf16(fr0, qr[3], sn0, 0, 0, 0);
    if (DO_SM) { sc0[12] = ex2(sc0[12]); sc0[13] = ex2(sc0[13]); lsum += sc0[10]; lsum += sc0[11]; }
    SBAR();
    if (DO_PV) { { const s16x4 l_ = vtr(vb + 4096), h_ = vtr(vb + 6144); fr0 = (bf16x8){l_[0], l_[1], l_[2], l_[3], h_[0], h_[1], h_[2], h_[3]}; } }
    if (DO_QK) sn1 = __builtin_amdgcn_mfma_f32_32x32x16_bf16(fr1, qr[3], sn1, 0, 0, 0);
    if (DO_SM) { sc0[14] = ex2(sc0[14]); sc0[15] = ex2(sc0[15]); lsum += sc0[12]; lsum += sc0[13]; }
    SBAR();
    if (DO_PV) { { const s16x4 l_ = vtr(vb + 8192), h_ = vtr(vb + 10240); fr1 = (bf16x8){l_[0], l_[1], l_[2], l_[3], h_[0], h_[1], h_[2], h_[3]}; } }
    if (DO_PV) o[0] = __builtin_amdgcn_mfma_f32_32x32x16_bf16(__builtin_bit_cast(bf16x8, pap0), fr2, o[0], 0, 0, 0);
    if (DO_SM) { sc1[0] = ex2(sc1[0]); sc1[1] = ex2(sc1[1]); lsum += sc0[14]; lsum += sc0[15]; }
    SBAR();
    if (DO_PV) { { const s16x4 l_ = vtr(vb + 12288), h_ = vtr(vb + 14336); fr2 = (bf16x8){l_[0], l_[1], l_[2], l_[3], h_[0], h_[1], h_[2], h_[3]}; } }
    if (DO_PV) o[0] = __builtin_amdgcn_mfma_f32_32x32x16_bf16(__builtin_bit_cast(bf16x8, pap1), fr0, o[0], 0, 0, 0);
    if (DO_SM) { sc1[2] = ex2(sc1[2]); sc1[3] = ex2(sc1[3]); lsum += sc1[0]; lsum += sc1[1]; }
    SBAR();
    if (DO_PV) { { const s16x4 l_ = vtr(vb + 512), h_ = vtr(vb + 2560); fr0 = (bf16x8){l_[0], l_[1], l_[2], l_[3], h_[0], h_[1], h_[2], h_[3]}; } }
    if (DO_PV) o[0] = __builtin_amdgcn_mfma_f32_32x32x16_bf16(__builtin_bit_cast(bf16x8, pap2), fr1, o[0], 0, 0, 0);
    if (DO_SM) { sc1[4] = ex2(sc1[4]); sc1[5] = ex2(sc1[5]); lsum += sc1[2]; lsum += sc1[3]; }
    SBAR();
    if (DO_PV) { { const s16x4 l_ = vtr(vb + 4608), h_ = vtr(vb + 6656); fr1 = (bf16x8){l_[0], l_[1], l_[2], l_[3], h_[0], h_[1], h_[2], h_[3]}; } }
    if (DO_PV) o[0] = __builtin_amdgcn_mfma_f32_32x32x16_bf16(__builtin_bit_cast(bf16x8, pap3), fr2, o[0], 0, 0, 0);
    if (DO_SM) { sc1[6] = ex2(sc1[6]); sc1[7] = ex2(sc1[7]); lsum += sc1[4]; lsum += sc1[5]; }
    SBAR();
    if (DO_PV) { { const s16x4 l_ = vtr(vb + 8704), h_ = vtr(vb + 10752); fr2 = (bf16x8){l_[0], l_[1], l_[2], l_[3], h_[0], h_[1], h_[2], h_[3]}; } }
    if (DO_PV) o[1] = __builtin_amdgcn_mfma_f32_32x32x16_bf16(__builtin_bit_cast(bf16x8, pap0), fr0, o[1], 0, 0, 0);
    if (DO_SM) { sc1[8] = ex2(sc1[8]); sc1[9] = ex2(sc1[9]); lsum += sc1[6]; lsum += sc1[7]; }
    SBAR();
    if (DO_PV) { { const s16x4 l_ = vtr(vb + 12800), h_ = vtr(vb + 14848); fr0 = (bf16x8){l_[0], l_[1], l_[2], l_[3], h_[0], h_[1], h_[2], h_[3]}; } }
    if (DO_PV) o[1] = __builtin_amdgcn_mfma_f32_32x32x16_bf16(__builtin_bit_cast(bf16x8, pap1), fr1, o[1], 0, 0, 0);
    if (DO_SM) { sc1[10] = ex2(sc1[10]); sc1[11] = ex2(sc1[11]); lsum += sc1[8]; lsum += sc1[9]; }
    SBAR();
    if (DO_PV) { { const s16x4 l_ = vtr(vb + 1024), h_ = vtr(vb + 3072); fr1 = (bf16x8){l_[0], l_[1], l_[2], l_[3], h_[0], h_[1], h_[2], h_[3]}; } }
    if (DO_PV) o[1] = __builtin_amdgcn_mfma_f32_32x32x16_bf16(__builtin_bit_cast(bf16x8, pap2), fr2, o[1], 0, 0, 0);
    if (DO_SM) { sc1[12] = ex2(sc1[12]); sc1[13] = ex2(sc1[13]); lsum += sc1[10]; lsum += sc1[11]; }
    SBAR();
    if (DO_PV) { { const s16x4 l_ = vtr(vb + 5120), h_ = vtr(vb + 7168); fr2 = (bf16x8){l_[0], l_[1], l_[2], l_[3], h_[0], h_[1], h_[2], h_[3]}; } }
    if (DO_PV) o[1] = __builtin_amdgcn_mfma_f32_32x32x16_bf16(__builtin_bit_cast(bf16x8, pap3), fr0, o[1], 0, 0, 0);
    if (DO_SM) { sc1[14] = ex2(sc1[14]); sc1[15] = ex2(sc1[15]); lsum += sc1[12]; lsum += sc1[13]; }
    SBAR();
    if (DO_PV) { { const s16x4 l_ = vtr(vb + 9216), h_ = vtr(vb + 11264); fr0 = (bf16x8){l_[0], l_[1], l_[2], l_[3], h_[0], h_[1], h_[2], h_[3]}; } }
    if (DO_PV) o[2] = __builtin_amdgcn_mfma_f32_32x32x16_bf16(__builtin_bit_cast(bf16x8, pap0), fr1, o[2], 0, 0, 0);
    if (DO_SM) { lsum += sc1[14]; lsum += sc1[15]; ca0 = cvtpk(sc0[0], sc0[1]); ca1 = cvtpk(sc0[2], sc0[3]); }
    SBAR();
    if (DO_PV) { { const s16x4 l_ = vtr(vb + 13312), h_ = vtr(vb + 15360); fr1 = (bf16x8){l_[0], l_[1], l_[2], l_[3], h_[0], h_[1], h_[2], h_[3]}; } }
    if (DO_PV) o[2] = __builtin_amdgcn_mfma_f32_32x32x16_bf16(__builtin_bit_cast(bf16x8, pap1), fr2, o[2], 0, 0, 0);
    if (DO_SM) { cb0 = cvtpk(sc0[4], sc0[5]); cb1 = cvtpk(sc0[6], sc0[7]); { auto r0_ = __builtin_amdgcn_permlane32_swap(ca0, cb0, false, false); auto r1_ = __builtin_amdgcn_permlane32_swap(ca1, cb1, false, false); pan0 = (u32x4){r0_[0], r1_[0], r0_[1], r1_[1]}; } }
    SBAR();
    if (DO_PV) { { const s16x4 l_ = vtr(vb + 1536), h_ = vtr(vb + 3584); fr2 = (bf16x8){l_[0], l_[1], l_[2], l_[3], h_[0], h_[1], h_[2], h_[3]}; } }
    if (DO_PV) o[2] = __builtin_amdgcn_mfma_f32_32x32x16_bf16(__builtin_bit_cast(bf16x8, pap2), fr0, o[2], 0, 0, 0);
    if (DO_SM) { ca0 = cvtpk(sc0[8], sc0[9]); ca1 = cvtpk(sc0[10], sc0[11]); }
    SBAR();
    if (DO_PV) { { const s16x4 l_ = vtr(vb + 5632), h_ = vtr(vb + 7680); fr0 = (bf16x8){l_[0], l_[1], l_[2], l_[3], h_[0], h_[1], h_[2], h_[3]}; } }
    if (DO_PV) o[2] = __builtin_amdgcn_mfma_f32_32x32x16_bf16(__builtin_bit_cast(bf16x8, pap3), fr1, o[2], 0, 0, 0);
    if (DO_SM) { cb0 = cvtpk(sc0[12], sc0[13]); cb1 = cvtpk(sc0[14], sc0[15]); { auto r0_ = __builtin_amdgcn_permlane32_swap(ca0, cb0, false, false); auto r1_ = __builtin_amdgcn_permlane32_swap(ca1, cb1, false, false); pan1 = (u32x4){r0_[0], r1_[0], r0_[1], r1_[1]}; } }
    SBAR();
    if (DO_PV) { { const s16x4 l_ = vtr(vb + 9728), h_ = vtr(vb + 11776); fr1 = (bf16x8){l_[0], l_[1], l_[2], l_[3], h_[0], h_[1], h_[2], h_[3]}; } }
    if (DO_PV) o[3] = __builtin_amdgcn_mfma_f32_32x32x16_bf16(__builtin_bit_cast(bf16x8, pap0), fr2, o[3], 0, 0, 0);
    if (DO_SM) { ca0 = cvtpk(sc1[0], sc1[1]); ca1 = cvtpk(sc1[2], sc1[3]); }
    SBAR();
    if (DO_PV) { { const s16x4 l_ = vtr(vb + 13824), h_ = vtr(vb + 15872); fr2 = (bf16x8){l_[0], l_[1], l_[2], l_[3], h_[0], h_[1], h_[2], h_[3]}; } }
    if (DO_PV) o[3] = __builtin_amdgcn_mfma_f32_32x32x16_bf16(__builtin_bit_cast(bf16x8, pap1), fr0, o[3], 0, 0, 0);
    if (DO_SM) { cb0 = cvtpk(sc1[4], sc1[5]); cb1 = cvtpk(sc1[6], sc1[7]); { auto r0_ = __builtin_amdgcn_permlane32_swap(ca0, cb0, false, false); auto r1_ = __builtin_amdgcn_permlane32_swap(ca1, cb1, false, false); pan2 = (u32x4){r0_[0], r1_[0], r0_[1], r1_[1]}; } }
    SBAR();
    kf0 = *(const LAS bf16x8*)(knn + 0);
    if (DO_PV) o[3] = __builtin_amdgcn_mfma_f32_32x32x16_bf16(__builtin_bit_cast(bf16x8, pap2), fr1, o[3], 0, 0, 0);
    if (DO_SM) { ca0 = cvtpk(sc1[8], sc1[9]); ca1 = cvtpk(sc1[10], sc1[11]); }
    SBAR();
    kf1 = *(const LAS bf16x8*)(knn + 512);
    if (DO_PV) o[3] = __builtin_amdgcn_mfma_f32_32x32x16_bf16(__builtin_bit_cast(bf16x8, pap3), fr2, o[3], 0, 0, 0);
    if (DO_SM) { cb0 = cvtpk(sc1[12], sc1[13]); cb1 = cvtpk(sc1[14], sc1[15]); { auto r0_ = __builtin_amdgcn_permlane32_swap(ca0, cb0, false, false); auto r1_ = __builtin_amdgcn_permlane32_swap(ca1, cb1, false, false); pan3 = (u32x4){r0_[0], r1_[0], r0_[1], r1_[1]}; } }
    SBAR();
}

__device__ __forceinline__ void unit(LAS unsigned char* lds, int h, int q0, const bf16_t* __restrict__ QD, const bf16_t* __restrict__ KD, const bf16_t* __restrict__ VD,
                                     const unsigned* KMAX2, float* O0S, float lam, const float* __restrict__ subg, bf16_t* MIX) {
    const int tid = opaque_tid(), wid = __builtin_amdgcn_readfirstlane(tid >> 6), lane = tid & 63, r32 = lane & 31, hi = lane >> 5;
    const unsigned lds0 = (unsigned)(uintptr_t)lds;
    LAS float* ws = (LAS float*)(lds + OFF_WS) + wid * 64;
    const LAS unsigned char* kbase = lds + OFF_K + hi * 1024 + r32 * 16;
    const LAS unsigned char* vbase = lds + OFF_V + (((lane & 3) << 3) | (((lane >> 2) & 3) << 6) | (((lane >> 4) & 1) << 5) | (((lane >> 5) & 1) << 8));
    const unsigned voK = (unsigned)((lane * LDR + wid * 8) * 2);
    unsigned voV[2];
    { const int kk = 8 * wid + ((lane & 31) >> 2), key = (kk & ~0xC) | ((kk & 4) << 1) | ((kk & 8) >> 1);
#pragma unroll
      for (int j = 0; j < 2; ++j) voV[j] = (unsigned)((key * LDR + (2 * j + (lane >> 5)) * 32 + (lane & 3) * 8) * 2); }
    const unsigned kdst = lds0 + OFF_K + wid * 1024, vdst = lds0 + OFF_V + wid * 2048;
#pragma unroll 1
    for (int mp = 0; mp < 2; ++mp) {
        const bf16_t* Kh = KD + h * 128 + mp * 64; const bf16_t* Vh = VD + h * 128;
        const bf16_t* Qw = QD + (size_t)(q0 + wid * 32 + r32) * LDR + h * 128 + mp * 64 + hi * 8;
#define ATT2_DMA_K(t) do { const int t_ = (t) < NT ? (t) : NT - 1; glds16((const char*)Kh + (size_t)t_ * (KVBLK * LDR * 2), voK, (unsigned)__builtin_amdgcn_readfirstlane(kdst + ((t) & 3) * KSLOT)); } while (0)
#define ATT2_DMA_V(t) do { const int t_ = (t) < NT ? (t) : NT - 1; const char* vs_ = (const char*)Vh + (size_t)t_ * (KVBLK * LDR * 2); const unsigned vd_ = (unsigned)__builtin_amdgcn_readfirstlane(vdst + ((t) & 3) * VSLOT); \
        glds16(vs_, voV[0], vd_); glds16(vs_, voV[1], vd_ + 1024); } while (0)
        ATT2_DMA_K(0); ATT2_DMA_K(1); ATT2_DMA_K(2); ATT2_DMA_V(0);
        bf16x8 qr[4]; float qq = 0.f;
#pragma unroll
        for (int d0 = 0; d0 < 4; ++d0) { qr[d0] = *reinterpret_cast<const bf16x8*>(Qw + d0 * 16);
#pragma unroll
            for (int j = 0; j < 8; ++j) { const float q = bf2f((unsigned short)qr[d0][j]); qq += q * q; } }
        { auto rr = __builtin_amdgcn_permlane32_swap(__float_as_uint(qq), __float_as_uint(qq), false, false); qq = __uint_as_float(rr[0]) + __uint_as_float(rr[1]); }
        const float mref = sqrtf(qq * __uint_as_float(KMAX2[h * 2 + mp])) * 1.001f;
        f32x16 negm;
#pragma unroll
        for (int r = 0; r < 16; ++r) negm[r] = -mref;
        f32x16 o[4] = {}; float lsum = 0.f;
        f32x16 sA0, sA1, sB0, sB1; u32x4 pX0, pX1, pX2, pX3, pY0, pY1, pY2, pY3;
        sA0 = f32x16{}; sA1 = f32x16{}; sB0 = f32x16{}; sB1 = f32x16{}; pX0 = pX1 = pX2 = pX3 = pY0 = pY1 = pY2 = pY3 = (u32x4){0u, 0u, 0u, 0u};
        bf16x8 kf0, kf1;
        ATT2_WAIT_BAR(0);
        kf0 = *(const LAS bf16x8*)(kbase); kf1 = *(const LAS bf16x8*)(kbase + 512);
#define KS(t) (kbase + ((t) & 3) * KSLOT)
#define VS(t) (vbase + ((t) & 3) * VSLOT)
        ATT2_DMA_K(3); ATT2_DMA_V(1);
        step<true, false, false>(sA0, sA1, sB0, sB1, pX0, pX1, pX2, pX3, pY0, pY1, pY2, pY3, o, qr, negm, lsum, KS(0), KS(1), VS(0), kf0, kf1);
        ATT2_WAIT_BAR(3);
        ATT2_DMA_K(4); ATT2_DMA_V(2);
        step<true, true, false>(sB0, sB1, sA0, sA1, pY0, pY1, pY2, pY3, pX0, pX1, pX2, pX3, o, qr, negm, lsum, KS(1), KS(2), VS(0), kf0, kf1);
        ATT2_WAIT_BAR(3);
#pragma unroll 1
        for (int i = 1; i + 1 < NT - 1; i += 2) {
            ATT2_DMA_K(i + 4); ATT2_DMA_V(i + 2);
            step<true, true, true>(sA0, sA1, sB0, sB1, pX0, pX1, pX2, pX3, pY0, pY1, pY2, pY3, o, qr, negm, lsum, KS(i + 1), KS(i + 2), VS(i - 1), kf0, kf1);
            ATT2_WAIT_BAR(3);
            ATT2_DMA_K(i + 5); ATT2_DMA_V(i + 3);
            step<true, true, true>(sB0, sB1, sA0, sA1, pY0, pY1, pY2, pY3, pX0, pX1, pX2, pX3, o, qr, negm, lsum, KS(i + 2), KS(i + 3), VS(i), kf0, kf1);
            ATT2_WAIT_BAR(3);
        }
        step<false, true, true>(sA0, sA1, sB0, sB1, pX0, pX1, pX2, pX3, pY0, pY1, pY2, pY3, o, qr, negm, lsum, KS(0), KS(0), VS(NT - 2), kf0, kf1);
        ATT2_WAIT_BAR(0);
        step<false, false, true>(sB0, sB1, sA0, sA1, pY0, pY1, pY2, pY3, pX0, pX1, pX2, pX3, o, qr, negm, lsum, KS(0), KS(0), VS(NT - 1), kf0, kf1);
        ATT2_WAIT_BAR(0);
#undef KS
#undef VS
#undef ATT2_DMA_K
#undef ATT2_DMA_V
        { auto rr = __builtin_amdgcn_permlane32_swap(__float_as_uint(lsum), __float_as_uint(lsum), false, false); lsum = __uint_as_float(rr[0]) + __uint_as_float(rr[1]); }
        if (hi == 0) ws[r32] = lsum; asm volatile("s_waitcnt lgkmcnt(0)" ::: "memory");
        int rowb = q0 + wid * 32; asm volatile("" : "+s"(rowb));
        float rli[16];
#pragma unroll
        for (int r = 0; r < 16; ++r) rli[r] = __builtin_amdgcn_rcpf(ws[crow(r, hi)]);
        float* o0p = O0S + tid; asm volatile("" : "+v"(o0p));
        if (mp == 0) {
#pragma unroll
            for (int d0 = 0; d0 < 4; ++d0)
#pragma unroll
                for (int r = 0; r < 16; ++r) o0p[(d0 * 16 + r) * 512] = o[d0][r] * rli[r];
        } else {
            float ss[16];
#pragma unroll
            for (int r = 0; r < 16; ++r) ss[r] = 0.f;
#pragma unroll
            for (int d0 = 0; d0 < 4; ++d0)
#pragma unroll
                for (int r = 0; r < 16; ++r) { const float c = o0p[(d0 * 16 + r) * 512] - lam * o[d0][r] * rli[r]; o[d0][r] = c; ss[r] += c * c; }
#pragma unroll
            for (int r = 0; r < 16; ++r) {
                ss[r] += lane_xor<1>(ss[r]); ss[r] += lane_xor<2>(ss[r]); ss[r] += lane_xor<4>(ss[r]); ss[r] += lane_xor<8>(ss[r]); ss[r] += lane_xor<16>(ss[r]);
                ss[r] = 0.8f / sqrtf(ss[r] * (1.f / 128.f) + 1e-5f); }
#pragma unroll
            for (int d0 = 0; d0 < 4; ++d0) { const float g = subg[d0 * 32 + r32];
#pragma unroll
                for (int r = 0; r < 16; ++r) MIX[(size_t)(rowb + crow(r, hi)) * D + 512 + h * 128 + d0 * 32 + r32] = (bf16_t)f2bf(o[d0][r] * ss[r] * g); }
        }
        asm volatile("s_waitcnt vmcnt(0) lgkmcnt(0)\n\ts_barrier" ::: "memory");
    }
}
__device__ __forceinline__ void kmax_rows(const bf16_t* KD, unsigned* KMAX2, int gw, int ngw, int lane) {
    float mx = 0.f;
    for (int row = gw; row < M; row += ngw) { const u32x4 w = *(const GAS u32x4*)(KD + (size_t)row * HSEC + lane * 8);
        float s = bflo(w.x) * bflo(w.x) + bfhi(w.x) * bfhi(w.x) + bflo(w.y) * bflo(w.y) + bfhi(w.y) * bfhi(w.y) + bflo(w.z) * bflo(w.z) + bfhi(w.z) * bfhi(w.z) + bflo(w.w) * bflo(w.w) + bfhi(w.w) * bfhi(w.w);
        s += lane_xor<1>(s); s += lane_xor<2>(s); s += lane_xor<4>(s); mx = fmaxf(mx, s); }
    if ((lane & 7) == 0) atomicMax(KMAX2 + (lane >> 3), __float_as_uint(mx));
}
}

__device__ __forceinline__ void norm_route_rows(const float* X2, const float* gain, const float* WR  , const float* rgb, const float* reb,
                                                bf16_t* H2, int* TOKE, float* TOKW, int* TOKR, unsigned* CNT, int row0, int lane) {
    f32x4 v[4][4];
#pragma unroll
    for (int i = 0; i < 4; ++i) { const GAS f32x4* xr = (const GAS f32x4*)(X2 + (size_t)(row0 + i) * D) + lane; float s = 0.f;
#pragma unroll
        for (int j = 0; j < 4; ++j) { v[i][j] = xr[64 * j]; s += (v[i][j].x * v[i][j].x + v[i][j].y * v[i][j].y) + (v[i][j].z * v[i][j].z + v[i][j].w * v[i][j].w); }
        const float rstd = 1.f / sqrtf(wave_sum(s) * (1.f / 1024.f) + 1e-6f);
        GAS u32x2* o8 = (GAS u32x2*)(H2 + (size_t)(row0 + i) * D) + lane;
#pragma unroll
        for (int j = 0; j < 4; ++j) { const f32x4 g = ((const GAS f32x4*)gain)[64 * j + lane]; v[i][j] = v[i][j] * rstd * g;
            u32x2 w; w.x = pk2(v[i][j].x, v[i][j].y); w.y = pk2(v[i][j].z, v[i][j].w); o8[64 * j] = w; } }
    const bool b0 = lane & 1, b1 = lane & 2;
    auto logit = [&](int n) -> float {
        f32x4 w[4];
#pragma unroll
        for (int j = 0; j < 4; ++j) w[j] = ((const GAS f32x4*)(WR + n * 1024))[64 * j + lane];
        float x[4];
#pragma unroll
        for (int i = 0; i < 4; ++i) { float s = 0.f;
#pragma unroll
            for (int j = 0; j < 4; ++j) s += (v[i][j].x * w[j].x + v[i][j].y * w[j].y) + (v[i][j].z * w[j].z + v[i][j].w * w[j].w);
            x[i] = s; }
        float y[2], t;
#pragma unroll
        for (int i = 0; i < 2; ++i) { const float keep = b0 ? x[2 * i + 1] : x[2 * i], send = b0 ? x[2 * i] : x[2 * i + 1]; y[i] = keep + lane_xor<1>(send); }
        { const float keep = b1 ? y[1] : y[0], send = b1 ? y[0] : y[1]; t = keep + lane_xor<2>(send); }
        t += lane_xor<4>(t); t += lane_xor<8>(t); t += lane_xor<16>(t);
        { auto rr = __builtin_amdgcn_permlane32_swap(__float_as_uint(t), __float_as_uint(t), false, false); t = __uint_as_float(rr[0]) + __uint_as_float(rr[1]); }
        asm volatile("" ::: "memory"); SBAR();
        return t; };
    float gl[4];
#pragma unroll
    for (int g = 0; g < 4; ++g) gl[g] = logit(g) + rgb[g];
    int gi = 0; float gm = gl[0];
#pragma unroll
    for (int g = 1; g < 4; ++g) if (gl[g] > gm) { gm = gl[g]; gi = g; }
    float gs = 0.f;
#pragma unroll
    for (int g = 0; g < 4; ++g) gs += __expf(gl[g] - gm);
    const float gp = 1.f / gs;
    float t1[4], t2[4]; int j1[4], j2[4];
#pragma unroll
    for (int g = 0; g < 4; ++g) { t1[g] = -3.0e38f; t2[g] = -3.0e38f; j1[g] = 0; j2[g] = 0; }
#pragma unroll 1
    for (int j = 0; j < 8; ++j) {
#pragma unroll
        for (int g = 0; g < 4; ++g) { const float t = logit(4 + g * 8 + j) + reb[g * 8 + j];
            if (t > t1[g]) { t2[g] = t1[g]; j2[g] = j1[g]; t1[g] = t; j1[g] = j; } else if (t > t2[g]) { t2[g] = t; j2[g] = j; } }
    }
    const float m1 = gi == 0 ? t1[0] : gi == 1 ? t1[1] : gi == 2 ? t1[2] : t1[3], m2 = gi == 0 ? t2[0] : gi == 1 ? t2[1] : gi == 2 ? t2[2] : t2[3];
    const int i1 = gi == 0 ? j1[0] : gi == 1 ? j1[1] : gi == 2 ? j1[2] : j1[3], i2 = gi == 0 ? j2[0] : gi == 1 ? j2[1] : gi == 2 ? j2[2] : j2[3];
    const float p2 = __expf(m2 - m1);
    const float w1 = gp / (1.f + p2), w2 = gp * p2 / (1.f + p2);
    if (lane < 4) { const int row = row0 + lane; const int e1 = gi * 8 + i1, e2 = gi * 8 + i2;
        const int r1 = (int)atomicAdd(CNT + e1, 1u), r2 = (int)atomicAdd(CNT + e2, 1u);
        TOKE[row * 2] = e1; TOKE[row * 2 + 1] = e2; TOKW[row * 2] = w1; TOKW[row * 2 + 1] = w2; TOKR[row * 2] = r1; TOKR[row * 2 + 1] = r2; }
}
__device__ __forceinline__ void build_tile_prefix(volatile LAS int* tb, const unsigned* CNT) {
    if (threadIdx.x == 0) { int acc = 0;
        for (int e = 0; e < 32; ++e) { tb[e] = acc; const int c = (int)__hip_atomic_load(CNT + e, __ATOMIC_RELAXED, __HIP_MEMORY_SCOPE_AGENT); acc += (c + 255) >> 8; }
        tb[32] = acc; }
    LDS_WAIT(); __syncthreads();
}
__device__ __forceinline__ void final_row(float* XO, const bf16_t* Y, const int* TOKS, const float* TOKW, const float* gain, int row, int lane) {
    const int s0 = TOKS[row * 2], s1 = TOKS[row * 2 + 1]; const float w0 = TOKW[row * 2], w1 = TOKW[row * 2 + 1];
    GAS f32x4* xr = (GAS f32x4*)(XO + (size_t)row * D) + lane; const GAS u32x2* y0 = (const GAS u32x2*)(Y + (size_t)s0 * D) + lane; const GAS u32x2* y1 = (const GAS u32x2*)(Y + (size_t)s1 * D) + lane;
    f32x4 v[4]; float s = 0.f;
#pragma unroll
    for (int j = 0; j < 4; ++j) { v[j] = xr[64 * j]; const u32x2 a = y0[64 * j], b = y1[64 * j];
        v[j].x += w0 * bflo(a.x) + w1 * bflo(b.x); v[j].y += w0 * bfhi(a.x) + w1 * bfhi(b.x); v[j].z += w0 * bflo(a.y) + w1 * bflo(b.y); v[j].w += w0 * bfhi(a.y) + w1 * bfhi(b.y);
        s += (v[j].x * v[j].x + v[j].y * v[j].y) + (v[j].z * v[j].z + v[j].w * v[j].w); }
    const float rstd = 1.f / sqrtf(wave_sum(s) * (1.f / 1024.f) + 1e-6f);
#pragma unroll
    for (int j = 0; j < 4; ++j) { const f32x4 g = ((const GAS f32x4*)gain)[64 * j + lane]; xr[64 * j] = v[j] * rstd * g; }
}

#ifndef MK_N_LAUNCHES
#define MK_N_LAUNCHES 1
#endif
constexpr int N_PHASES = 12;
struct Args { const void* in[18]; float* out; unsigned char* ws; int ph_lo, ph_hi; };
static_assert(sizeof(Args) == 18 * 8 + 8 + 8 + 8, "Args has no padding");

__global__ void __launch_bounds__(NWAVES * 64, 2) mk_fwd(Args args) {
    extern __shared__ __attribute__((aligned(16))) unsigned char lds_raw[];
    LAS unsigned char* lds = (LAS unsigned char*)lds_raw;
    volatile LAS unsigned* MISC = (volatile LAS unsigned*)(lds + MISC_OFF);
    const int G = gridDim.x, bx = blockIdx.x, vcu = (G % 8 == 0) ? (bx % 8) * (G / 8) + bx / 8 : bx;
    const int NGW = G * NWAVES;
#define PHASE_IDS const int tid = opaque_tid(), lane = tid & 63, wave = __builtin_amdgcn_readfirstlane(tid >> 6), gw = vcu * NWAVES + wave; (void)lane; (void)gw
    const __attribute__((address_space(4))) Args* A = (const __attribute__((address_space(4))) Args*)__builtin_amdgcn_kernarg_segment_ptr();
    asm volatile("" : "+s"(A));
#define ARGF(i) ((const float*)A->in[i])
#define WSP(T, off) ((T*)(A->ws + (off)))
#define x_in ARGF(0)
#define positions ((const int*)A->in[1])
#define norm1_gain ARGF(2)
#define w_in ARGF(3)
#define hg_lb ARGF(4)
#define hg_norm_gain ARGF(5)
#define diff_lambda ARGF(6)
#define subln_gain ARGF(7)
#define w_out ARGF(8)
#define norm2_gain ARGF(9)
#define rg_w ARGF(10)
#define rg_b ARGF(11)
#define re_w ARGF(12)
#define re_b ARGF(13)
#define w_gate ARGF(14)
#define w_up ARGF(15)
#define w_down ARGF(16)
#define final_gain ARGF(17)
#define out (A->out)
#define WR WSP(float, WS_WR)
#define cosT WSP(float, WS_ROPE)
#define sinT (WSP(float, WS_ROPE) + M * 8)
#define HD WSP(float, WS_HD)
#define TOKE WSP(int, WS_TOKE)
#define TOKW WSP(float, WS_TOKW)
#define TOKR WSP(int, WS_TOKR)
#define TOKS WSP(int, WS_TOKS)
#define LAMP WSP(float, WS_LAM)
#define WOUT WSP(bf16_t, WS_WOUT)
#define WIN WSP(bf16_t, WS_WIN)
#define XN WSP(bf16_t, WS_XN)
#define QH WSP(bf16_t, WS_QH)
#define VH WSP(bf16_t, WS_VH)
#define SG WSP(bf16_t, WS_SG)
#define QD WSP(bf16_t, WS_QD)
#define KD WSP(bf16_t, WS_KD)
#define VD WSP(bf16_t, WS_VD)
#define GF WSP(float, WS_GF)
#define GB WSP(float, WS_GB)
#define HS WSP(float, WS_HS)
#define HL WSP(float, WS_HL)
#define OF WSP(float, WS_OF)
#define OB WSP(float, WS_OB)
#define MIX WSP(bf16_t, WS_MIX)
#define H2 WSP(bf16_t, WS_H2)
#define WGU WSP(bf16_t, WS_WGU)
#define WD WSP(bf16_t, WS_WD)
#define HGb WSP(bf16_t, WS_HG)
#define HM WSP(bf16_t, WS_HM)
#define Y WSP(bf16_t, WS_Y)
#define CNT (WSP(unsigned, WS_CTL) + CW_CNT)
    unsigned* ctl = WSP(unsigned, WS_CTL);
    volatile LAS int* tb = (volatile LAS int*)(MISC + 16);

    if (threadIdx.x < 64) MISC[threadIdx.x] = 0u;
    __syncthreads();
    XcdBarrier bar; bar.bar = ctl + CW_BAR; bar.x = 0; bar.st = nullptr;
    const int lo = A->ph_lo, hi = A->ph_hi;
    if (hi - lo > 1) bar = xcd_barrier_post(ctl + CW_BAR, MISC);
#ifndef PH_MASK
#define PH_MASK 0xFFF
#endif
#define IN(k) (((PH_MASK >> (k)) & 1) && lo <= (k) && (k) < hi)
#ifndef DOUBLE_PHASE
#define DOUBLE_PHASE -1
#endif
#define REP(k) for (int rep_ = 0; rep_ < ((DOUBLE_PHASE) == (k) ? 2 : 1); ++rep_)
#define SEAM(k) do { if (IN(k) && IN((k) + 1)) xcd_barrier(bar); } while (0)

    if (IN(0)) REP(0) { PHASE_IDS;
        LAS float* scr = (LAS float*)(lds + wave * 16384);
        constexpr int I_IN = (D / 64) * (NIN / 32), I_OUT = (D / 64) * (D / 32);
        for (int it = gw; it < I_IN + I_OUT; it += NGW) {
            if (it < I_IN) transpose_item(w_in, D, NIN, WIN, 0, 1, scr, it, lane);
            else transpose_item(w_out, D, D, WOUT, 0, 1, scr, it - I_IN, lane);
        }
        for (int m = gw; m < M; m += NGW) rms_row_to_bf16(x_in + (size_t)m * D, norm1_gain, XN + (size_t)m * D, lane, 1e-6f);
        for (int id = bx * 512 + tid; id < M * 8; id += G * 512) {
            const int i = id & 7; const float invf[8] = {1.0f, 0.19392274474868576f, 0.03760603093086393f, 0.007292664737217109f, 0.001414213562373095f, 0.0002742481756762073f, 5.318295896944988e-05f, 1.031338537721246e-05f};
            float f = invf[0];
#pragma unroll
            for (int q = 1; q < 8; ++q) f = (i == q) ? invf[q] : f;
            const float ang = (float)positions[id >> 3] * f;
            const double rev = (double)ang * 0.15915494309189535; const float fr = (float)(rev - __builtin_rint(rev));
            cosT[id] = __builtin_amdgcn_cosf(fr); sinT[id] = __builtin_amdgcn_sinf(fr);
        }
        for (int id = bx * 512 + tid; id < 36 * 1024; id += G * 512) { const int n = id >> 10, c = id & 1023; WR[id] = n < 4 ? rg_w[c * 4 + n] : re_w[c * 32 + (n - 4)]; }
        if (bx == 0 && wave == 0) { const float a = wave_sum(diff_lambda[lane] * diff_lambda[64 + lane]), b = wave_sum(diff_lambda[128 + lane] * diff_lambda[192 + lane]);
            if (lane == 0) LAMP[0] = __expf(a) - __expf(b) + 0.2f; }
    }
    SEAM(0);
    if (IN(1)) REP(1) {
        pg8::Gemm g{XN, WIN, M, NIN, D}; pg8::StaticOrder S; S.init(M, NIN, G, bx);
        EpiInProj E{QH, VH, SG, QD, KD, VD, GF, GB, hg_lb, cosT, sinT};
        pg8::gemm_phase<EpiInProj, pg8::StaticOrder, true, true>(lds, g, S, E);
    }
    SEAM(1);
    if (IN(2)) REP(2) { for (int u = vcu; u < 256; u += G) hg::pass<false>(lds, u, QH, VH, GF, GB, HL, HD, HS, OF, OB);
        { PHASE_IDS; att2::kmax_rows(KD, WSP(unsigned, WS_CTL) + CW_KMAX, gw, NGW, lane); } }
    SEAM(2);
    if (IN(3)) REP(3) hg::scan(HL, HD, HS, bx * 512 + opaque_tid(), G * 512);
    SEAM(3);
    if (IN(4)) REP(4) { for (int u = vcu; u < 256; u += G) hg::pass<true>(lds, u, QH, VH, GF, GB, HL, HD, HS, OF, OB); }
    SEAM(4);
    if (IN(5)) REP(5) { PHASE_IDS;
        const float lam = LAMP[0];
        for (int u = vcu; u < 256; u += G) { const int h = u >> 6, q0 = (u & 63) * 256;
            int ln = lane; asm volatile("" : "+v"(ln));
            att::hgrn_finalize(h, q0, OF, OB, SG, hg_norm_gain, MIX, wave, ln);
#ifdef ATT_OLD
            att::unit(lds, h, q0, QD, KD, VD, lam, subln_gain, MIX); }
#else
            att2::unit(lds, h, q0, QD, KD, VD, WSP(unsigned, WS_CTL) + CW_KMAX, WSP(float, WS_O0S) + (size_t)bx * 32768, lam, subln_gain, MIX); }
#endif
    }
    SEAM(5);
    if (IN(6)) REP(6) {
        pg8::Gemm g{MIX, WOUT, M, D, D}; pg8::StaticOrder S; S.init(M, D, G, bx);
        EpiResid E{x_in, out};
        pg8::gemm_phase<EpiResid, pg8::StaticOrder, true, true>(lds, g, S, E);
    }
    SEAM(6);
    if (IN(7)) { PHASE_IDS;
        for (int r0 = gw * 4; r0 < M; r0 += NGW * 4) norm_route_rows(out, norm2_gain, WR, rg_b, re_b, H2, TOKE, TOKW, TOKR, CNT, r0, lane);
        LAS float* scr = (LAS float*)(lds + wave * 16384);
        constexpr int I_GU = (D / 64) * (DEXP / 32), I_DN = (DEXP / 64) * (D / 32);
        REP(7) for (int it = gw; it < NEXP * (2 * I_GU + I_DN); it += NGW) {
            const int e = it / (2 * I_GU + I_DN), r = it % (2 * I_GU + I_DN);
            if (r < I_GU) transpose_item(w_gate + (size_t)e * D * DEXP, D, DEXP, WGU + (size_t)e * 1024 * D, 0, 2, scr, r, lane);
            else if (r < 2 * I_GU) transpose_item(w_up + (size_t)e * D * DEXP, D, DEXP, WGU + (size_t)e * 1024 * D, 1, 2, scr, r - I_GU, lane);
            else transpose_item(w_down + (size_t)e * DEXP * D, DEXP, D, WD + (size_t)e * 1024 * DEXP, 0, 1, scr, r - 2 * I_GU, lane);
        }
    }
    SEAM(7);
    if (IN(8)) REP(8) { PHASE_IDS;
        build_tile_prefix(tb, CNT);
        for (int p = gw; p < 2 * M; p += NGW) { const int e = TOKE[p], slot = tb[e] * 256 + TOKR[p];
            if (lane == 0) TOKS[p] = slot;
            const GAS u32x4* src = (const GAS u32x4*)(H2 + (size_t)(p >> 1) * D) + lane; GAS u32x4* dst = (GAS u32x4*)(HGb + (size_t)slot * D) + lane;
            const u32x4 a = src[0], b = src[64]; dst[0] = a; dst[64] = b; }
    }
    SEAM(8);
    if (IN(9)) REP(9) {
        build_tile_prefix(tb, CNT);
        pg8::Gemm g{HGb, WGU, MAXSLOTS, NEXP * 1024, D}; MoeOrder S{tb, G, bx}; EpiSwiGlu E{HM};
        pg8::gemm_phase<EpiSwiGlu, MoeOrder, true, true>(lds, g, S, E);
    }
    SEAM(9);
    if (IN(10)) REP(10) {
        build_tile_prefix(tb, CNT);
        pg8::Gemm g{HM, WD, MAXSLOTS, NEXP * 1024, DEXP}; MoeOrder S{tb, G, bx}; EpiDown E{Y};
        pg8::gemm_phase<EpiDown, MoeOrder, true, true>(lds, g, S, E);
    }
    SEAM(10);
    if (IN(11)) { PHASE_IDS; for (int m = gw; m < M; m += NGW) final_row(out, Y, TOKS, TOKW, final_gain, m, lane); }
#undef IN
#undef SEAM
#undef x_in
#undef positions
#undef out
#undef Y
#undef HM
#undef CNT
}

extern "C" void kernel_launch(void* const* d_in, const int* in_sizes, int n_in, void* d_out, int out_size, void* d_ws, size_t ws_size, hipStream_t stream) {
    static int grid = 0;
    if (grid == 0) {
        if (n_in != 18 || in_sizes[0] != M * D || out_size != M * D || ws_size < WS_END) { fprintf(stderr, "kernel_launch: unexpected shapes (n_in %d, in0 %d, out %d, ws %zu)\n", n_in, n_in > 0 ? in_sizes[0] : -1, out_size, ws_size); grid = -1; return; }
        int dev = 0, cus = 0, per_cu = 0;
        if (hipGetDevice(&dev) != hipSuccess || hipDeviceGetAttribute(&cus, hipDeviceAttributeMultiprocessorCount, dev) != hipSuccess) { grid = -1; return; }
        if (hipFuncSetAttribute((const void*)mk_fwd, hipFuncAttributeMaxDynamicSharedMemorySize, LDS_BYTES) != hipSuccess) { fprintf(stderr, "kernel_launch: hipFuncSetAttribute failed\n"); grid = -1; return; }
        if (hipOccupancyMaxActiveBlocksPerMultiprocessor(&per_cu, (const void*)mk_fwd, NWAVES * 64, LDS_BYTES) != hipSuccess || per_cu < 1) { fprintf(stderr, "kernel_launch: occupancy query says %d\n", per_cu); (void)hipGetLastError(); grid = -1; return; }
        grid = cus;
    }
    if (grid < 0) return;
    if (hipMemsetAsync((char*)d_ws + WS_CTL, 0, CTL_ZERO_BYTES, stream) != hipSuccess) return;
    Args a{};
    for (int i = 0; i < 18; ++i) a.in[i] = d_in[i];
    a.out = (float*)d_out; a.ws = (unsigned char*)d_ws;
#if MK_N_LAUNCHES == 1
    a.ph_lo = 0; a.ph_hi = N_PHASES;
    hipLaunchKernelGGL(mk_fwd, dim3(grid), dim3(NWAVES * 64), LDS_BYTES, stream, a);
#else
    for (int p = 0; p < N_PHASES; ++p) { a.ph_lo = p; a.ph_hi = p + 1; hipLaunchKernelGGL(mk_fwd, dim3(grid), dim3(NWAVES * 64), LDS_BYTES, stream, a); }
#endif
}
```

```cpp
#include <hip/hip_runtime.h>
#include <cstdio>
#include <cstdint>
__device__ __forceinline__ int opaque_tid() { int t = threadIdx.x; asm volatile("" : "+v"(t)); return t; }
namespace pg8 {
#define PG8_LAS __attribute__((address_space(3)))
typedef unsigned short bf16_t;
typedef short bf16x8 __attribute__((ext_vector_type(8)));
typedef float f32x4 __attribute__((ext_vector_type(4)));
typedef unsigned u32x4 __attribute__((ext_vector_type(4)));
constexpr int BM = 256, BK = 64, HALF = 128, HTB = HALF * BK * 2  , STAGE_BYTES = 8 * HTB, NXCD = 8, WGM = 8;

__host__ __device__ __forceinline__ int lds_byte(int r, int c) { const int st = (r >> 4) * 2 + (c >> 5), rr = r & 15, cc = c & 31, ob = rr * 64 + cc * 2; return st * 1024 + (ob ^ (((ob >> 9) & 1) << 5)); }
__host__ __device__ __forceinline__ void stage_rc(int b, int& R, int& C) { const int st = b / 1024, sb = b % 1024, swz = sb ^ (((sb >> 9) & 1) << 5); R = (st >> 1) * 16 + swz / 64; C = (st & 1) * 32 + (swz % 64) / 2; }
__host__ __device__ __forceinline__ int perm32(int rho) { const int n = rho >> 4, i = rho & 15; return 8 * (i >> 2) + 4 * n + (i & 3); }

struct Unit { int pm, pn; };
struct Gemm { const bf16_t* A; const bf16_t* Bt; int M, N, K; };

struct StaticOrder {
    int nM, nN, nwg, G, c;
    __host__ __device__ void init(int M, int N, int G_, int c_) { nM = M / BM; nN = N / BM; nwg = nM * nN; G = G_; c = c_; }
    __host__ __device__ bool next(int i, Unit& u) const {
        const long L = (long)i * G + c; if (L >= nwg) return false;
        int wgid = (int)L; { const int q = nwg / NXCD, r = nwg % NXCD, xcd = wgid % NXCD, off = wgid / NXCD; wgid = (xcd < r ? xcd * (q + 1) : r * (q + 1) + (xcd - r) * q) + off; }
        const int nig = WGM * nN, gid = wgid / nig, fm = gid * WGM, gsz = (nM - fm) < WGM ? (nM - fm) : WGM;
        u.pm = fm + ((wgid % nig) % gsz); u.pn = (wgid % nig) / gsz; return true;
    }
    __device__ __forceinline__ void a_ready(const Unit&) const {}
    __device__ __forceinline__ void done(const Unit&) const {}
};

template <class Epi, class Sched, bool ALIGN_EPI = false, bool SP2 = false>
__device__ __forceinline__ void gemm_phase(PG8_LAS unsigned char* lds, const Gemm g, const Sched& S, const Epi& E) {
    const int tid = opaque_tid(), wid = __builtin_amdgcn_readfirstlane(tid >> 6), lane = tid & 63, wr = wid >> 2, wc = wid & 3, fr = lane & 15, fq = lane >> 4;
    const int K = g.K, nt = K / BK;
    unsigned voffA[2], voffB[2];
#pragma unroll
    for (int i = 0; i < 2; ++i) { int R, C; stage_rc(tid * 16 + i * 8192, R, C); const int Rb = Epi::PERM ? ((R & ~31) + perm32(R & 31)) : R;
        voffA[i] = (unsigned)(R * K + C) * 2u; voffB[i] = (unsigned)(Rb * K + C) * 2u; }
    const size_t kstep = (size_t)(BK * 2);
    const size_t hstep = (size_t)HALF * K * 2;
    const size_t tstep = 2 * hstep;
    const unsigned ldsw = (unsigned)wid * 1024u;
    const int aoff = lds_byte(wr * 64 + fr, fq * 8), boff = lds_byte(wc * 32 + fr, fq * 8);
#define PG8_SA(b, h) (((b) * 2 + (h)) * HTB)
#define PG8_SB(b, h) ((4 + (b) * 2 + (h)) * HTB)
#define PG8_STAGE(bufoff, gbase, voff) do { _Pragma("unroll") for (int _i = 0; _i < 2; ++_i) \
        __builtin_amdgcn_global_load_lds((const unsigned*)((const char*)(gbase) + (voff)[_i]), (PG8_LAS unsigned*)(lds + (bufoff) + ldsw + _i * 8192), 16, 0, 0); } while (0)
#define PG8_LDA(dst, b, h) do { _Pragma("unroll") for (int m = 0; m < 4; ++m) _Pragma("unroll") for (int k = 0; k < 2; ++k) dst[m][k] = *(const PG8_LAS bf16x8*)(lds + PG8_SA(b, h) + aoff + m * 2048 + k * 1024); } while (0)
#define PG8_LDB(dst, b, h) do { _Pragma("unroll") for (int n = 0; n < 2; ++n) _Pragma("unroll") for (int k = 0; k < 2; ++k) dst[n][k] = *(const PG8_LAS bf16x8*)(lds + PG8_SB(b, h) + boff + n * 2048 + k * 1024); } while (0)
#define PG8_MMA(ai, bj, At, Bt) do { __builtin_amdgcn_s_setprio(1); _Pragma("unroll") for (int m = 0; m < 4; ++m) _Pragma("unroll") for (int n = 0; n < 2; ++n) _Pragma("unroll") for (int k = 0; k < 2; ++k) \
        acc[ai][bj][m][n] = __builtin_amdgcn_mfma_f32_16x16x32_bf16(Bt[n][k], At[m][k], acc[ai][bj][m][n], 0, 0, 0); __builtin_amdgcn_s_setprio(0); } while (0)
#define PG8_WAIT_V(n) asm volatile("s_waitcnt vmcnt(" #n ")" ::: "memory")
#define PG8_WAIT_L(n) asm volatile("s_waitcnt lgkmcnt(" #n ")" ::: "memory")
#define PG8_BAR __builtin_amdgcn_s_barrier()
#define PG8_SCHED __builtin_amdgcn_sched_barrier(0)
    Unit cur, nxt; int ui = 0;
    if (!S.next(0, cur)) return;
    f32x4 acc[2][2][4][2];
#pragma unroll
    for (int a = 0; a < 2; ++a)
#pragma unroll
        for (int b = 0; b < 2; ++b)
#pragma unroll
            for (int m = 0; m < 4; ++m)
#pragma unroll
                for (int n = 0; n < 2; ++n) acc[a][b][m][n] = (f32x4){0.f, 0.f, 0.f, 0.f};
    bf16x8 At[4][2], B0[2][2], B1[2][2];
    const char* cA = (const char*)g.A + (size_t)cur.pm * tstep; const char* cB = (const char*)g.Bt + (size_t)cur.pn * tstep;
    S.a_ready(cur);
    if constexpr (SP2) {
        PG8_STAGE(PG8_SB(0, 0), cB, voffB); PG8_STAGE(PG8_SB(0, 1), cB + hstep, voffB); PG8_STAGE(PG8_SA(0, 0), cA, voffA); PG8_STAGE(PG8_SA(0, 1), cA + hstep, voffA);
        if (wr == 1) PG8_BAR;
        PG8_WAIT_V(2); PG8_BAR;
        PG8_STAGE(PG8_SB(1, 0), cB + kstep, voffB); PG8_STAGE(PG8_SA(1, 0), cA + kstep, voffA); PG8_STAGE(PG8_SB(1, 1), cB + hstep + kstep, voffB);
        PG8_WAIT_V(6); PG8_BAR;
    } else {
        PG8_STAGE(PG8_SB(0, 0), cB, voffB); PG8_STAGE(PG8_SA(0, 0), cA, voffA); PG8_STAGE(PG8_SB(0, 1), cB + hstep, voffB); PG8_STAGE(PG8_SA(0, 1), cA + hstep, voffA);
        if (wr == 1) PG8_BAR;
        PG8_WAIT_V(4); PG8_BAR;
        PG8_STAGE(PG8_SB(1, 0), cB + kstep, voffB); PG8_STAGE(PG8_SA(1, 0), cA + kstep, voffA); PG8_STAGE(PG8_SB(1, 1), cB + hstep + kstep, voffB);
        PG8_WAIT_V(6); PG8_BAR;
    }
    for (;;) {
        const bool has_next = S.next(ui + 1, nxt);
        const char* nA = has_next ? (const char*)g.A + (size_t)nxt.pm * tstep : cA; const char* nB = has_next ? (const char*)g.Bt + (size_t)nxt.pn * tstep : cB;
        for (int t = 0; t < nt; t += 2) {
            const bool last = (t == nt - 2);
            const char* a1 = cA + (size_t)(t + 1) * kstep;
            const char* a2 = last ? nA : cA + (size_t)(t + 2) * kstep; const char* b2 = last ? nB : cB + (size_t)(t + 2) * kstep;
            const char* a3 = a2 + kstep; const char* b3 = b2 + kstep;
            if (last && has_next) S.a_ready(nxt);
            if constexpr (SP2) {
            PG8_LDB(B0, 0, 0); PG8_LDB(B1, 0, 1); PG8_SCHED; PG8_LDA(At, 0, 0); PG8_STAGE(PG8_SA(1, 1), a1 + hstep, voffA);
            PG8_WAIT_V(8); PG8_WAIT_L(0); PG8_BAR; PG8_MMA(0, 0, At, B0); PG8_MMA(0, 1, At, B1); PG8_BAR; PG8_SCHED;
            PG8_LDA(At, 0, 1); PG8_STAGE(PG8_SB(0, 0), b2, voffB); PG8_STAGE(PG8_SB(0, 1), b2 + hstep, voffB); PG8_STAGE(PG8_SA(0, 0), a2, voffA);
            PG8_WAIT_V(8); PG8_WAIT_L(0); PG8_BAR; PG8_MMA(1, 0, At, B0); PG8_MMA(1, 1, At, B1); PG8_BAR; PG8_SCHED;
            PG8_LDB(B0, 1, 0); PG8_LDB(B1, 1, 1); PG8_SCHED; PG8_LDA(At, 1, 0); PG8_STAGE(PG8_SA(0, 1), a2 + hstep, voffA);
            PG8_WAIT_V(8); PG8_WAIT_L(0); PG8_BAR; PG8_MMA(0, 0, At, B0); PG8_MMA(0, 1, At, B1); PG8_BAR; PG8_SCHED;
            PG8_LDA(At, 1, 1); PG8_STAGE(PG8_SB(1, 0), b3, voffB); PG8_STAGE(PG8_SB(1, 1), b3 + hstep, voffB); PG8_STAGE(PG8_SA(1, 0), a3, voffA);
            PG8_WAIT_V(8); PG8_WAIT_L(0); PG8_BAR; PG8_MMA(1, 0, At, B0); PG8_MMA(1, 1, At, B1); PG8_BAR; PG8_SCHED;
            } else {
            PG8_LDB(B0, 0, 0); PG8_SCHED; PG8_LDA(At, 0, 0); PG8_STAGE(PG8_SA(1, 1), a1 + hstep, voffA);
            PG8_WAIT_L(8); PG8_BAR; PG8_WAIT_L(0); PG8_MMA(0, 0, At, B0); PG8_BAR; PG8_SCHED;
            PG8_LDB(B1, 0, 1); PG8_STAGE(PG8_SB(0, 0), b2, voffB);
            PG8_BAR; PG8_WAIT_L(0); PG8_MMA(0, 1, At, B1); PG8_BAR;
            PG8_LDA(At, 0, 1); PG8_STAGE(PG8_SA(0, 0), a2, voffA);
            PG8_BAR; PG8_WAIT_L(0); PG8_MMA(1, 0, At, B0); PG8_BAR; PG8_SCHED;
            PG8_STAGE(PG8_SB(0, 1), b2 + hstep, voffB);
            PG8_WAIT_V(6); PG8_BAR; PG8_MMA(1, 1, At, B1); PG8_BAR;
            PG8_LDB(B0, 1, 0); PG8_SCHED; PG8_LDA(At, 1, 0); PG8_STAGE(PG8_SA(0, 1), a2 + hstep, voffA);
            PG8_WAIT_L(8); PG8_BAR; PG8_WAIT_L(0); PG8_MMA(0, 0, At, B0); PG8_BAR; PG8_SCHED;
            PG8_LDB(B1, 1, 1); PG8_STAGE(PG8_SB(1, 0), b3, voffB);
            PG8_BAR; PG8_WAIT_L(0); PG8_MMA(0, 1, At, B1); PG8_BAR;
            PG8_LDA(At, 1, 1); PG8_STAGE(PG8_SA(1, 0), a3, voffA);
            PG8_BAR; PG8_WAIT_L(0); PG8_MMA(1, 0, At, B0); PG8_BAR; PG8_SCHED;
            PG8_STAGE(PG8_SB(1, 1), b3 + hstep, voffB);
            PG8_WAIT_V(6); PG8_BAR; PG8_MMA(1, 1, At, B1); PG8_BAR;
            }
        }
        if constexpr (ALIGN_EPI) { if (wr == 0) PG8_BAR; }
        if constexpr (!Epi::AFTER_DRAIN) { E(acc, cur, wr, wc, fr, fq); S.done(cur); }
        if (!has_next) break;
#pragma unroll
        for (int a = 0; a < 2; ++a)
#pragma unroll
            for (int b = 0; b < 2; ++b)
#pragma unroll
                for (int m = 0; m < 4; ++m)
#pragma unroll
                    for (int n = 0; n < 2; ++n) acc[a][b][m][n] = (f32x4){0.f, 0.f, 0.f, 0.f};
        cur = nxt; cA = nA; cB = nB; ++ui;
        if constexpr (ALIGN_EPI) { if (wr == 1) PG8_BAR; }
    }
    PG8_WAIT_V(0);
    if constexpr (!ALIGN_EPI) { if (wr == 0) PG8_BAR; }
    PG8_BAR;
    if constexpr (Epi::AFTER_DRAIN) { E.fused(acc, cur, wr, wc, fr, fq, lds, wid, lane); S.done(cur); }
#undef PG8_SA
#undef PG8_SB
#undef PG8_STAGE
#undef PG8_LDA
#undef PG8_LDB
#undef PG8_MMA
#undef PG8_WAIT_V
#undef PG8_WAIT_L
#undef PG8_BAR
#undef PG8_SCHED
}
}

constexpr int NWAVES = 8;
constexpr int M = 16384, D = 1024, NIN = 4096, HSEC = 512;
constexpr int NEXP = 32, DEXP = 512, MAXTILES = 160, MAXSLOTS = MAXTILES * 256;
constexpr float QSCALE = 0.18033688011112042f;

constexpr size_t MiB = 1u << 20;
constexpr size_t WS_CTL = 0, CTL_ZERO_BYTES = 1 * MiB;
constexpr size_t WS_WR = 1 * MiB;
constexpr size_t WS_ROPE = 2 * MiB;
constexpr size_t WS_HD = 3 * MiB;
constexpr size_t WS_TOKE = 3 * MiB + 256 * 1024, WS_TOKW = WS_TOKE + 128 * 1024, WS_TOKR = WS_TOKW + 128 * 1024, WS_TOKS = WS_TOKR + 128 * 1024, WS_LAM = WS_TOKS + 128 * 1024;
constexpr size_t WS_WOUT = 4 * MiB, WS_WIN = 6 * MiB;
constexpr size_t WS_XN = 16 * MiB;
constexpr size_t WS_OF = 16 * MiB;
constexpr size_t WS_H2 = 16 * MiB;
constexpr size_t WS_HM = 6 * MiB;
constexpr size_t WS_QH = 48 * MiB, WS_VH = 64 * MiB, WS_SG = 80 * MiB, WS_QD = 96 * MiB, WS_KD = 112 * MiB, WS_VD = 128 * MiB;
constexpr size_t WS_WGU = 48 * MiB, WS_WD = 112 * MiB;
constexpr size_t WS_GF = 144 * MiB, WS_GB = 176 * MiB;
constexpr size_t WS_MIX = 144 * MiB;
constexpr size_t WS_HS = 208 * MiB, WS_HL = 224 * MiB;
constexpr size_t WS_OB = 224 * MiB;
constexpr size_t WS_HG = 176 * MiB;
constexpr size_t WS_O0S = 176 * MiB;
constexpr size_t WS_Y = 176 * MiB;
constexpr size_t WS_END = 256 * MiB;
static_assert(WS_HM + (size_t)MAXSLOTS * 512 * 2 <= WS_WGU && WS_HG + (size_t)MAXSLOTS * 1024 * 2 <= WS_END, "ws map");
constexpr int CW_BAR = 4096, CW_CNT = 16384, CW_KMAX = 16448;

constexpr int PHASE_LDS = 147456, MISC_OFF = PHASE_LDS, LDS_BYTES = PHASE_LDS + 1024;

#define GAS __attribute__((address_space(1)))
#define LAS __attribute__((address_space(3)))
typedef unsigned short bf16_t;
typedef float f32x4 __attribute__((ext_vector_type(4)));
typedef float f32x16 __attribute__((ext_vector_type(16)));
typedef short bf16x8 __attribute__((ext_vector_type(8)));
typedef short s16x4 __attribute__((ext_vector_type(4)));
typedef unsigned u32x4 __attribute__((ext_vector_type(4)));
typedef unsigned u32x2 __attribute__((ext_vector_type(2)));
#define LDS_WAIT() asm volatile("s_waitcnt lgkmcnt(0)" ::: "memory")
#define VM_WAIT() asm volatile("s_waitcnt vmcnt(0)" ::: "memory")
#define SBAR() __builtin_amdgcn_sched_barrier(0)
__device__ __forceinline__ unsigned f2bf(float f) { unsigned u = __builtin_bit_cast(unsigned, f); return (u + 0x7fffu + ((u >> 16) & 1u)) >> 16; }
__device__ __forceinline__ unsigned pk2(float lo, float hi) { return f2bf(lo) | (f2bf(hi) << 16); }
__device__ __forceinline__ float bf2f(unsigned b) { return __builtin_bit_cast(float, b << 16); }
__device__ __forceinline__ float bflo(unsigned w) { return __builtin_bit_cast(float, w << 16); }
__device__ __forceinline__ float bfhi(unsigned w) { return __builtin_bit_cast(float, w & 0xffff0000u); }
__device__ __forceinline__ unsigned cvtpk(float lo, float hi) { unsigned r; asm volatile("v_cvt_pk_bf16_f32 %0, %1, %2" : "=v"(r) : "v"(lo), "v"(hi)); return r; }
__device__ __forceinline__ float ex2(float x) { return __builtin_amdgcn_exp2f(x); }
__device__ __forceinline__ float lg2(float x) { return __builtin_amdgcn_logf(x); }
__device__ __forceinline__ float sigmoidf_(float v) { return __builtin_amdgcn_rcpf(1.f + ex2(-1.4426950408889634f * v)); }
__device__ __forceinline__ bool lane_is_hi() { return (opaque_tid() & 32) != 0; }
template <int X> __device__ __forceinline__ float lane_xor(float v) {
    if constexpr (X == 32) { auto rr = __builtin_amdgcn_permlane32_swap(__float_as_uint(v), __float_as_uint(v), false, false); return __uint_as_float(lane_is_hi() ? rr[0] : rr[1]); }
    else return __int_as_float(__builtin_amdgcn_ds_swizzle(__float_as_int(v), (X << 10) | 0x1F));
}
__device__ __forceinline__ float wave_sum(float v) {
    v += lane_xor<1>(v); v += lane_xor<2>(v); v += lane_xor<4>(v); v += lane_xor<8>(v); v += lane_xor<16>(v);
    auto rr = __builtin_amdgcn_permlane32_swap(__float_as_uint(v), __float_as_uint(v), false, false);
    return __uint_as_float(rr[0]) + __uint_as_float(rr[1]);
}
__device__ __forceinline__ int crow(int r, int hi) { return (r & 3) + 8 * (r >> 2) + 4 * hi; }
#define XB_TMO      128
#define XB_XCNT(j)  (256  + 64 * (j))
#define XB_XSUB(j)  (1280 + 64 * (j))
#define XB_XGEN(j)  (2304 + 64 * (j))
#define XB_TOP      3328
#define XB_TOPGEN   3392
#define XCD_BAR_WORDS 3456
#define XB_SPIN_CAP (1u << 18)

__device__ __forceinline__ unsigned xb_ld(unsigned* p)              { return __hip_atomic_load(p, __ATOMIC_RELAXED, __HIP_MEMORY_SCOPE_AGENT); }
__device__ __forceinline__ unsigned xb_add(unsigned* p, unsigned v) { return __hip_atomic_fetch_add(p, v, __ATOMIC_RELAXED, __HIP_MEMORY_SCOPE_AGENT); }
__device__ __forceinline__ unsigned xb_xcc_id() { return (unsigned)__builtin_amdgcn_s_getreg((3 << 11) | 20) & 0xFu; }
#define XB_SPIN(cond, bar) do { unsigned _sp = 0; while (cond) { __builtin_amdgcn_s_sleep(1); \
    if ((++_sp & 255u) == 0u) { if (xb_ld(&(bar)[XB_TMO])) break; if (_sp > XB_SPIN_CAP) { atomicAdd(&(bar)[XB_TMO], 1u); break; } } } } while (0)

struct XcdBarrier {
    unsigned* bar; unsigned x;
    volatile LAS unsigned* st;
};

__device__ __forceinline__ XcdBarrier xcd_barrier_post(unsigned* bar, volatile LAS unsigned* st) {
    XcdBarrier b; b.bar = bar; b.x = xb_xcc_id(); b.st = st;
    if (threadIdx.x == 0) (void)xb_add(&bar[XB_XCNT(b.x)], 1u);
    return b;
}
__device__ __forceinline__ void xcd_barrier_complete(unsigned* bar, unsigned x, unsigned& nloc, unsigned& nx) {
    const unsigned G = gridDim.x * gridDim.y * gridDim.z;
    unsigned sum, cnt, mine, sp = 0u;
    for (;;) {
        sum = 0u; cnt = 0u; mine = 0u;
#pragma unroll
        for (unsigned j = 0; j < 16; ++j) { const unsigned c = xb_ld(&bar[XB_XCNT(j)]); sum += c; cnt += (c > 0u) ? 1u : 0u; mine = (j == x) ? c : mine; }
        if (sum == G) break;
        __builtin_amdgcn_s_sleep(1);
        if ((++sp & 255u) == 0u) { if (xb_ld(&bar[XB_TMO])) break; if (sp > XB_SPIN_CAP) { atomicAdd(&bar[XB_TMO], 1u); break; } }
    }
    nloc = mine > 0u ? mine : 1u; nx = cnt > 0u ? cnt : 1u;
}

__device__ __forceinline__ void xcd_barrier(const XcdBarrier& b) {
    asm volatile("s_waitcnt vmcnt(0)" ::: "memory");
    __syncthreads();
    if (threadIdx.x == 0) {
        unsigned* bar = b.bar;
        __builtin_amdgcn_s_waitcnt(0);
        unsigned nloc = b.st[0], nx = b.st[1];
        if (nloc == 0u) { xcd_barrier_complete(bar, b.x, nloc, nx); b.st[0] = nloc; b.st[1] = nx; }
        const unsigned old = xb_add(&bar[XB_XSUB(b.x)], 1u);
        const unsigned gen = old / nloc;
        if (old + 1u == (gen + 1u) * nloc) {
            __builtin_amdgcn_fence(__ATOMIC_RELEASE, "agent");
            asm volatile("s_waitcnt vmcnt(0)" ::: "memory");
            const unsigned og = xb_add(&bar[XB_TOP], 1u);
            const unsigned tg = og / nx;
            if (og + 1u == (tg + 1u) * nx) xb_add(&bar[XB_TOPGEN], 1u);
            else XB_SPIN(xb_ld(&bar[XB_TOPGEN]) == tg, bar);
            __builtin_amdgcn_fence(__ATOMIC_ACQUIRE, "agent");
            xb_add(&bar[XB_XGEN(b.x)], 1u);
            asm volatile("s_waitcnt vmcnt(0)" ::: "memory");
        } else {
            XB_SPIN(xb_ld(&bar[XB_XGEN(b.x)]) == gen, bar);
            __builtin_amdgcn_fence(__ATOMIC_ACQUIRE, "agent");
            asm volatile("s_waitcnt vmcnt(0)" ::: "memory");
        }
    }
    __syncthreads();
}

__device__ __forceinline__ void transpose_item(const float* W, int K, int N, bf16_t* WT, int row_off, int row_mul, LAS float* scr, int item, int lane) {
    const int nblk = N / 32, kb = item / nblk, nb = item % nblk, k0 = 64 * kb, n0 = 32 * nb;
#pragma unroll 8
    for (int i = 0; i < 32; ++i) { const int kk = 2 * i + (lane >> 5); scr[kk * 33 + (lane & 31)] = W[(size_t)(k0 + kk) * N + n0 + (lane & 31)]; }
    LDS_WAIT(); asm volatile("" ::: "memory");
    const int c = lane & 7;
#pragma unroll
    for (int j = 0; j < 4; ++j) { const int n = (lane >> 3) + 8 * j; const LAS float* s = scr + (8 * c) * 33 + n;
        u32x4 o; o.x = pk2(s[0 * 33], s[1 * 33]); o.y = pk2(s[2 * 33], s[3 * 33]); o.z = pk2(s[4 * 33], s[5 * 33]); o.w = pk2(s[6 * 33], s[7 * 33]);
        *(GAS u32x4*)(WT + (size_t)(row_off + (n0 + n) * row_mul) * K + k0 + 8 * c) = o; }
    LDS_WAIT(); asm volatile("" ::: "memory");
}
__device__ __forceinline__ void rms_row_to_bf16(const float* xrow, const float* gain, bf16_t* orow, int lane, float eps) {
    const GAS f32x4* xr = (const GAS f32x4*)xrow + lane; const GAS f32x4* gr = (const GAS f32x4*)gain + lane;
    f32x4 v[4]; float s = 0.f;
#pragma unroll
    for (int j = 0; j < 4; ++j) { v[j] = xr[64 * j]; s += (v[j].x * v[j].x + v[j].y * v[j].y) + (v[j].z * v[j].z + v[j].w * v[j].w); }
    const float rstd = 1.f / sqrtf(wave_sum(s) * (1.f / 1024.f) + eps);
    GAS u32x2* o8 = (GAS u32x2*)orow + lane;
#pragma unroll
    for (int j = 0; j < 4; ++j) { const f32x4 g = gr[64 * j]; u32x2 w; w.x = pk2(v[j].x * rstd * g.x, v[j].y * rstd * g.y); w.y = pk2(v[j].z * rstd * g.z, v[j].w * rstd * g.w); o8[64 * j] = w; }
}

struct EpiInProj {
    static constexpr bool PERM = true, AFTER_DRAIN = false;
    bf16_t *QH, *VH, *SG, *QD, *KD, *VD; float *GF, *GB; const float* lbraw; const float *cosT, *sinT;
    __device__ __forceinline__ void operator()(const pg8::f32x4 (&acc)[2][2][4][2], const pg8::Unit& u, int wr, int wc, int fr, int fq) const {
        const int sec = u.pn >> 1;
        const int row0 = u.pm * 256 + wr * 64 + fr;
        const int cs0 = (u.pn & 1) * 256 + wc * 32 + 8 * fq;
        if (sec == 1 || sec == 2) {
            float* G = sec == 1 ? GF : GB; const float* lbp = lbraw + (sec - 1) * 1024;
#pragma unroll
            for (int bj = 0; bj < 2; ++bj) { const int c = cs0 + bj * 128; float lb[8];
#pragma unroll
                for (int j = 0; j < 8; ++j) { const float l0 = lbp[c + j], l1 = lbp[512 + c + j]; lb[j] = __builtin_amdgcn_rcpf(1.f + ex2(1.4426950408889634f * (l0 - l1))); }
#pragma unroll
                for (int ai = 0; ai < 2; ++ai)
#pragma unroll
                    for (int m = 0; m < 4; ++m) { const int row = row0 + ai * 128 + m * 16; f32x4 o0, o1;
#pragma unroll
                        for (int j = 0; j < 4; ++j) { o0[j] = lg2(lb[j] + (1.f - lb[j]) * sigmoidf_(acc[ai][bj][m][0][j])); o1[j] = lg2(lb[4 + j] + (1.f - lb[4 + j]) * sigmoidf_(acc[ai][bj][m][1][j])); }
                        *(f32x4*)(G + (size_t)row * HSEC + c) = o0; *(f32x4*)(G + (size_t)row * HSEC + c + 4) = o1; } }
            return;
        }
        bf16_t* O = sec == 0 ? QH : sec == 3 ? VH : sec == 4 ? SG : sec == 5 ? QD : sec == 6 ? KD : VD;
        const bool rot = (sec == 5 || sec == 6) && ((wc & 1) == 0);
        const float sc = sec == 5 ? QSCALE : 1.f;
#pragma unroll
        for (int ai = 0; ai < 2; ++ai)
#pragma unroll
            for (int m = 0; m < 4; ++m) { const int row = row0 + ai * 128 + m * 16;
#pragma unroll
                for (int bj = 0; bj < 2; ++bj) { const int c = cs0 + bj * 128; float v[8];
#pragma unroll
                    for (int j = 0; j < 4; ++j) { v[j] = acc[ai][bj][m][0][j]; v[4 + j] = acc[ai][bj][m][1][j]; }
                    if (sec == 4) {
#pragma unroll
                        for (int j = 0; j < 8; ++j) v[j] = v[j] * sigmoidf_(v[j]);
                    }
                    if (rot) {
                        const f32x4 c0 = *(const f32x4*)(cosT + (size_t)row * 8), c1 = *(const f32x4*)(cosT + (size_t)row * 8 + 4);
                        const f32x4 s0 = *(const f32x4*)(sinT + (size_t)row * 8), s1 = *(const f32x4*)(sinT + (size_t)row * 8 + 4);
#pragma unroll
                        for (int j = 0; j < 8; ++j) { const float p = lane_xor<16>(v[j]); const float cj = j < 4 ? c0[j & 3] : c1[j & 3], sj = j < 4 ? s0[j & 3] : s1[j & 3];
                            const float r = fq == 0 ? v[j] * cj - p * sj : v[j] * cj + p * sj; v[j] = fq < 2 ? r : v[j]; }
                    }
                    u32x4 w; w.x = cvtpk(v[0] * sc, v[1] * sc); w.y = cvtpk(v[2] * sc, v[3] * sc); w.z = cvtpk(v[4] * sc, v[5] * sc); w.w = cvtpk(v[6] * sc, v[7] * sc);
                    *(u32x4*)(O + (size_t)row * HSEC + c) = w; } }
    }
};
struct EpiResid {
    static constexpr bool PERM = true, AFTER_DRAIN = false;
    const float* X; float* O;
    __device__ __forceinline__ void operator()(const pg8::f32x4 (&acc)[2][2][4][2], const pg8::Unit& u, int wr, int wc, int fr, int fq) const {
        const int row0 = u.pm * 256 + wr * 64 + fr, col0 = u.pn * 256 + wc * 32 + 8 * fq;
#pragma unroll
        for (int ai = 0; ai < 2; ++ai)
#pragma unroll
            for (int m = 0; m < 4; ++m) { const size_t off = (size_t)(row0 + ai * 128 + m * 16) * D + col0;
#pragma unroll
                for (int bj = 0; bj < 2; ++bj) { const f32x4 a = *(const f32x4*)(X + off + bj * 128), b = *(const f32x4*)(X + off + bj * 128 + 4);
                    *(f32x4*)(O + off + bj * 128) = a + acc[ai][bj][m][0]; *(f32x4*)(O + off + bj * 128 + 4) = b + acc[ai][bj][m][1]; } }
    }
};
struct EpiSwiGlu {
    static constexpr bool PERM = true, AFTER_DRAIN = false;
    bf16_t* O;
    __device__ __forceinline__ void operator()(const pg8::f32x4 (&acc)[2][2][4][2], const pg8::Unit& u, int wr, int wc, int fr, int fq) const {
        const int row0 = u.pm * 256 + wr * 64 + fr, col0 = ((u.pn & 3) * 256 + wc * 32 + 8 * fq) >> 1;
#pragma unroll
        for (int ai = 0; ai < 2; ++ai)
#pragma unroll
            for (int m = 0; m < 4; ++m) { bf16_t* rowp = O + (size_t)(row0 + ai * 128 + m * 16) * DEXP + col0;
#pragma unroll
                for (int bj = 0; bj < 2; ++bj) { const f32x4 a = acc[ai][bj][m][0], b = acc[ai][bj][m][1];
                    const float h0 = a[0] * sigmoidf_(a[0]) * a[1], h1 = a[2] * sigmoidf_(a[2]) * a[3], h2 = b[0] * sigmoidf_(b[0]) * b[1], h3 = b[2] * sigmoidf_(b[2]) * b[3];
                    u32x2 w; w.x = cvtpk(h0, h1); w.y = cvtpk(h2, h3); *(u32x2*)(rowp + bj * 64) = w; } }
    }
};
struct EpiDown {
    static constexpr bool PERM = true, AFTER_DRAIN = false;
    bf16_t* O;
    __device__ __forceinline__ void operator()(const pg8::f32x4 (&acc)[2][2][4][2], const pg8::Unit& u, int wr, int wc, int fr, int fq) const {
        const int row0 = u.pm * 256 + wr * 64 + fr, col0 = (u.pn & 3) * 256 + wc * 32 + 8 * fq;
#pragma unroll
        for (int ai = 0; ai < 2; ++ai)
#pragma unroll
            for (int m = 0; m < 4; ++m) { bf16_t* rowp = O + (size_t)(row0 + ai * 128 + m * 16) * D + col0;
#pragma unroll
                for (int bj = 0; bj < 2; ++bj) { const f32x4 a = acc[ai][bj][m][0], b = acc[ai][bj][m][1];
                    u32x4 w; w.x = cvtpk(a[0], a[1]); w.y = cvtpk(a[2], a[3]); w.z = cvtpk(b[0], b[1]); w.w = cvtpk(b[2], b[3]); *(u32x4*)(rowp + bj * 128) = w; } }
    }
};
struct MoeOrder {
    const volatile LAS int* tb; int G, c;
    __device__ __forceinline__ bool next(int i, pg8::Unit& u) const {
        const int L = i * G + c, T = __builtin_amdgcn_readfirstlane(tb[32]); if (L >= 4 * T) return false;
        const int tile = L >> 2; int e = 0;
#pragma unroll 1
        for (int j = 1; j < 32; ++j) e += (__builtin_amdgcn_readfirstlane(tb[j]) <= tile) ? 1 : 0;
        u.pm = tile; u.pn = e * 4 + (L & 3); return true;
    }
    __device__ __forceinline__ void a_ready(const pg8::Unit&) const {}
    __device__ __forceinline__ void done(const pg8::Unit&) const {}
};

namespace hg {
constexpr int S128 = 272, S64 = 144;
constexpr int L_QD = 0, L_QE = L_QD + 64 * S128, L_KE = L_QE + 64 * S128, L_KET = L_KE + 64 * S128, L_VT = L_KET + 128 * S64, L_ST = L_VT + 128 * S64,
              L_P = L_ST + 128 * S128, L_QS = L_P + 64 * S64, L_DC = L_QS + 4 * 128 * 4, L_END = L_DC + 128 * 4;
static_assert(L_END <= PHASE_LDS, "hgrn LDS");
__device__ __forceinline__ bf16x8 frag(const LAS unsigned char* base, int row, int stride, int kb  ) { return *(const LAS bf16x8*)(base + row * stride + kb); }

template <bool PASS_C>
__device__ __forceinline__ void pass(LAS unsigned char* lds, int unit, const bf16_t* QH, const bf16_t* VH, const float* GF, const float* GB,
                                     float* HL, float* HD, const float* HS, float* OF, float* OB) {
    const int tid = opaque_tid(), lane = tid & 63, wid = __builtin_amdgcn_readfirstlane(tid >> 6), r32 = lane & 31, hi = lane >> 5;
    const int dir = unit >> 7, head = (unit >> 5) & 3, sc = unit & 31;
    const int k = tid & 127, qtr = tid >> 7;
    const float* G = dir ? GB : GF; float* O = dir ? OB : OF;
    const int vi = wid >> 1, ki0 = (wid & 1) * 2;
    f32x16 sacc[2];
    LAS float* QS = (LAS float*)(lds + L_QS); LAS float* DC = (LAS float*)(lds + L_DC);
    if (PASS_C) {
        const float* hs = HS + (size_t)unit * 16384;
#pragma unroll
        for (int tt = 0; tt < 2; ++tt)
#pragma unroll
            for (int r = 0; r < 16; ++r) { const int v = vi * 32 + crow(r, hi), kk = (ki0 + tt) * 32 + r32; const float s = hs[v * 128 + kk]; sacc[tt][r] = s;
                *(LAS bf16_t*)(lds + L_ST + v * S128 + kk * 2) = (bf16_t)f2bf(s); }
    } else { sacc[0] = f32x16{}; sacc[1] = f32x16{}; }
    float btot = 0.f;
#pragma unroll 1
    for (int c = 0; c < 8; ++c) {
        const int t0 = sc * 512 + c * 64;
        float g[16]; unsigned qv[16], vv[16];
#pragma unroll
        for (int i = 0; i < 16; ++i) { const int tl = t0 + 16 * qtr + i, tok = dir ? (M - 1 - tl) : tl; const size_t off = (size_t)tok * HSEC + head * 128 + k;
            g[i] = G[off]; vv[i] = VH[off]; if (PASS_C) qv[i] = QH[off]; }
        float b[16]; b[0] = g[0];
#pragma unroll
        for (int i = 1; i < 16; ++i) b[i] = b[i - 1] + g[i];
        QS[qtr * 128 + k] = b[15];
        LDS_WAIT(); __syncthreads();
        float pre = 0.f, tot = 0.f;
#pragma unroll
        for (int q = 0; q < 4; ++q) { const float s = QS[q * 128 + k]; tot += s; pre += (q < qtr) ? s : 0.f; }
        btot += tot;
        if (qtr == 0) DC[k] = ex2(tot);
        unsigned ket[8], vt[8];
#pragma unroll
        for (int i = 0; i < 16; i += 2) {
            const float b0 = b[i] + pre, b1 = b[i + 1] + pre;
            const float ke0 = (1.f - ex2(g[i])) * ex2(tot - b0), ke1 = (1.f - ex2(g[i + 1])) * ex2(tot - b1);
            ket[i >> 1] = cvtpk(ke0, ke1); vt[i >> 1] = vv[i] | (vv[i + 1] << 16);
            if (PASS_C) {
                const int tr0 = 16 * qtr + i;
                const float q0 = bf2f(qv[i]), q1 = bf2f(qv[i + 1]);
                *(LAS bf16_t*)(lds + L_KE + tr0 * S128 + k * 2) = (bf16_t)(ket[i >> 1] & 0xffffu); *(LAS bf16_t*)(lds + L_KE + (tr0 + 1) * S128 + k * 2) = (bf16_t)(ket[i >> 1] >> 16);
                *(LAS bf16_t*)(lds + L_QD + tr0 * S128 + k * 2) = (bf16_t)f2bf(q0 * ex2(b0)); *(LAS bf16_t*)(lds + L_QD + (tr0 + 1) * S128 + k * 2) = (bf16_t)f2bf(q1 * ex2(b1));
                *(LAS bf16_t*)(lds + L_QE + tr0 * S128 + k * 2) = (bf16_t)f2bf(q0 * ex2(b0 - tot)); *(LAS bf16_t*)(lds + L_QE + (tr0 + 1) * S128 + k * 2) = (bf16_t)f2bf(q1 * ex2(b1 - tot));
            }
        }
        *(LAS u32x4*)(lds + L_KET + k * S64 + qtr * 32) = (u32x4){ket[0], ket[1], ket[2], ket[3]}; *(LAS u32x4*)(lds + L_KET + k * S64 + qtr * 32 + 16) = (u32x4){ket[4], ket[5], ket[6], ket[7]};
        *(LAS u32x4*)(lds + L_VT + k * S64 + qtr * 32) = (u32x4){vt[0], vt[1], vt[2], vt[3]};     *(LAS u32x4*)(lds + L_VT + k * S64 + qtr * 32 + 16) = (u32x4){vt[4], vt[5], vt[6], vt[7]};
        LDS_WAIT(); __syncthreads();
        if (PASS_C) {
            if (wid < 4) {
                const int ti = wid >> 1, si = wid & 1; f32x16 p = f32x16{};
                if (!(ti == 0 && si == 1)) {
#pragma unroll
                    for (int ks = 0; ks < 8; ++ks) p = __builtin_amdgcn_mfma_f32_32x32x16_bf16(frag(lds + L_QE, ti * 32 + r32, S128, ks * 32 + hi * 16), frag(lds + L_KE, si * 32 + r32, S128, ks * 32 + hi * 16), p, 0, 0, 0);
                }
#pragma unroll
                for (int r = 0; r < 16; ++r) { const int t = ti * 32 + crow(r, hi), s = si * 32 + r32; *(LAS bf16_t*)(lds + L_P + t * S64 + s * 2) = (bf16_t)f2bf(s <= t ? p[r] : 0.f); }
            }
            LDS_WAIT(); __syncthreads();
            { const int ti = wid >> 2, vo = wid & 3; f32x16 o = f32x16{};
#pragma unroll
                for (int ks = 0; ks < 8; ++ks) o = __builtin_amdgcn_mfma_f32_32x32x16_bf16(frag(lds + L_QD, ti * 32 + r32, S128, ks * 32 + hi * 16), frag(lds + L_ST, vo * 32 + r32, S128, ks * 32 + hi * 16), o, 0, 0, 0);
#pragma unroll
                for (int ss = 0; ss < 4; ++ss) o = __builtin_amdgcn_mfma_f32_32x32x16_bf16(frag(lds + L_P, ti * 32 + r32, S64, ss * 32 + hi * 16), frag(lds + L_VT, vo * 32 + r32, S64, ss * 32 + hi * 16), o, 0, 0, 0);
#pragma unroll
                for (int r = 0; r < 16; ++r) { const int tl = t0 + ti * 32 + crow(r, hi), tok = dir ? (M - 1 - tl) : tl; O[(size_t)tok * HSEC + head * 128 + vo * 32 + r32] = o[r]; }
            }
        }
#pragma unroll
        for (int tt = 0; tt < 2; ++tt) { const int ki = ki0 + tt; const float d = DC[ki * 32 + r32];
#pragma unroll
            for (int r = 0; r < 16; ++r) sacc[tt][r] *= d;
#pragma unroll
            for (int ss = 0; ss < 4; ++ss) sacc[tt] = __builtin_amdgcn_mfma_f32_32x32x16_bf16(frag(lds + L_VT, vi * 32 + r32, S64, ss * 32 + hi * 16), frag(lds + L_KET, ki * 32 + r32, S64, ss * 32 + hi * 16), sacc[tt], 0, 0, 0);
        }
        LDS_WAIT(); __syncthreads();
        if (PASS_C) {
#pragma unroll
            for (int tt = 0; tt < 2; ++tt)
#pragma unroll
                for (int r = 0; r < 16; ++r) { const int v = vi * 32 + crow(r, hi), kk = (ki0 + tt) * 32 + r32; *(LAS bf16_t*)(lds + L_ST + v * S128 + kk * 2) = (bf16_t)f2bf(sacc[tt][r]); }
        }
    }
    if (!PASS_C) {
        float* hl = HL + (size_t)unit * 16384;
#pragma unroll
        for (int tt = 0; tt < 2; ++tt)
#pragma unroll
            for (int r = 0; r < 16; ++r) { const int v = vi * 32 + crow(r, hi), kk = (ki0 + tt) * 32 + r32; hl[v * 128 + kk] = sacc[tt][r]; }
        if (qtr == 0) HD[unit * 128 + k] = ex2(btot);
    }
    __syncthreads();
}
__device__ __forceinline__ void scan(const float* HL, const float* HD, float* HS, int gtid, int gthreads) {
    for (int id = gtid; id < 8 * 16384; id += gthreads) {
        const int dh = id >> 14, e = id & 16383, k = e & 127; float S = 0.f;
#pragma unroll 4
        for (int sc = 0; sc < 32; ++sc) { const int u = dh * 32 + sc; HS[(size_t)u * 16384 + e] = S; S = HD[u * 128 + k] * S + HL[(size_t)u * 16384 + e]; }
    }
}
}

namespace att {
constexpr int QBLK = 32, KVBLK = 64, LDR = HSEC;
constexpr int SHM_V = 16384, SHM_K = 8192;
constexpr int OFF_V = 0, OFF_K = 2 * SHM_V, OFF_WS = OFF_K + 2 * SHM_K, OFF_O0 = OFF_WS + NWAVES * 64 * 4, OFF_END = OFF_O0 + 32 * 512 * 4;
static_assert(OFF_END <= PHASE_LDS, "attention LDS");
constexpr float THRL = 11.5f;

__device__ __forceinline__ void partialSM(f32x16& p0, f32x16& p1, float& m_reg, float& mn, float& alpha) {
    float pmax = p0[0];
#pragma unroll
    for (int r = 1; r < 16; ++r) pmax = fmaxf(pmax, p0[r]);
#pragma unroll
    for (int r = 0; r < 16; ++r) pmax = fmaxf(pmax, p1[r]);
    { auto rr = __builtin_amdgcn_permlane32_swap(__float_as_uint(pmax), __float_as_uint(pmax), false, false); pmax = fmaxf(__uint_as_float(rr[0]), __uint_as_float(rr[1])); }
    if (__builtin_expect(__all(pmax - m_reg <= THRL), 1)) { mn = m_reg; alpha = 1.f; }
    else { mn = fmaxf(m_reg, pmax); alpha = ex2(m_reg - mn); m_reg = mn; }
#pragma unroll
    for (int r = 0; r < 16; ++r) { p0[r] -= mn; p1[r] -= mn; }
#pragma unroll
    for (int r = 0; r < 16; ++r) p0[r] = ex2(p0[r]);
}
__device__ __forceinline__ void finishSM(f32x16& p0, f32x16& p1, float alpha, float& l_reg, bf16x8& pa0, bf16x8& pa1, bf16x8& pa2, bf16x8& pa3) {
#pragma unroll
    for (int r = 0; r < 16; ++r) p1[r] = ex2(p1[r]);
    float ps = 0.f;
#pragma unroll
    for (int r = 0; r < 16; ++r) ps += p0[r];
#pragma unroll
    for (int r = 0; r < 16; ++r) ps += p1[r];
    { auto rr = __builtin_amdgcn_permlane32_swap(__float_as_uint(ps), __float_as_uint(ps), false, false); ps = __uint_as_float(rr[0]) + __uint_as_float(rr[1]); }
    l_reg = l_reg * alpha + ps;
#define PK4(P, BASE, OUT) do { unsigned a0 = cvtpk(P[BASE + 0], P[BASE + 1]), a1 = cvtpk(P[BASE + 2], P[BASE + 3]);   \
    unsigned b0 = cvtpk(P[BASE + 4], P[BASE + 5]), b1 = cvtpk(P[BASE + 6], P[BASE + 7]);                              \
    auto r0 = __builtin_amdgcn_permlane32_swap(a0, b0, false, false); auto r1 = __builtin_amdgcn_permlane32_swap(a1, b1, false, false); \
    u32x4 w = {r0[0], r1[0], r0[1], r1[1]}; OUT = *reinterpret_cast<bf16x8*>(&w); } while (0)
    PK4(p0, 0, pa0); PK4(p0, 8, pa1); PK4(p1, 0, pa2); PK4(p1, 8, pa3);
#undef PK4
}
__device__ __forceinline__ void qkt(f32x16& p0, f32x16& p1, const LAS unsigned char* Ks, const bf16x8* qr, int r32, int hi) {
    p0 = f32x16{}; p1 = f32x16{};
#pragma unroll
    for (int d0 = 0; d0 < 4; ++d0) {
        const bf16x8 b0 = *(const LAS bf16x8*)(Ks + (d0 * 2 + hi) * 1024 + r32 * 16);
        const bf16x8 b1 = *(const LAS bf16x8*)(Ks + (d0 * 2 + hi) * 1024 + (32 + r32) * 16);
        p0 = __builtin_amdgcn_mfma_f32_32x32x16_bf16(b0, qr[d0], p0, 0, 0, 0);
        p1 = __builtin_amdgcn_mfma_f32_32x32x16_bf16(b1, qr[d0], p1, 0, 0, 0); }
}
__device__ __forceinline__ int v_st(int k, int c) { const int kk = (k & ~0xC) | ((k & 4) << 1) | ((k & 8) >> 1); return ((kk >> 3) * 4 + (c >> 5)) * 512 + ((kk & 7) * 32 + (c & 31)) * 2; }
__device__ __forceinline__ int v_rd_base(int lane) { return ((lane & 3) << 3) | (((lane >> 2) & 3) << 6) | (((lane >> 4) & 1) << 5) | (((lane >> 5) & 1) << 8); }
constexpr int v_rd_off(int d0, int ks, int half) { return d0 * 512 + ks * 4096 + half * 2048; }
template <int OFF> __device__ __forceinline__ s16x4 tr_read(int vb) {
    s16x4 r; asm volatile("ds_read_b64_tr_b16 %0, %1 offset:%2" : "=&v"(r) : "v"(vb), "i"(OFF) : "memory"); return r;
}
template <int D0> __device__ __forceinline__ void pv_one(f32x16& od, int vb, bf16x8 pa0, bf16x8 pa1, bf16x8 pa2, bf16x8 pa3) {
    const s16x4 l0 = tr_read<v_rd_off(D0, 0, 0)>(vb), h0 = tr_read<v_rd_off(D0, 0, 1)>(vb), l1 = tr_read<v_rd_off(D0, 1, 0)>(vb), h1 = tr_read<v_rd_off(D0, 1, 1)>(vb);
    const s16x4 l2 = tr_read<v_rd_off(D0, 2, 0)>(vb), h2 = tr_read<v_rd_off(D0, 2, 1)>(vb), l3 = tr_read<v_rd_off(D0, 3, 0)>(vb), h3 = tr_read<v_rd_off(D0, 3, 1)>(vb);
    asm volatile("s_waitcnt lgkmcnt(0)" ::: "memory"); SBAR();
#define PK(L, H) (bf16x8){L[0], L[1], L[2], L[3], H[0], H[1], H[2], H[3]}
    od = __builtin_amdgcn_mfma_f32_32x32x16_bf16(pa0, PK(l0, h0), od, 0, 0, 0);
    od = __builtin_amdgcn_mfma_f32_32x32x16_bf16(pa1, PK(l1, h1), od, 0, 0, 0);
    od = __builtin_amdgcn_mfma_f32_32x32x16_bf16(pa2, PK(l2, h2), od, 0, 0, 0);
    od = __builtin_amdgcn_mfma_f32_32x32x16_bf16(pa3, PK(l3, h3), od, 0, 0, 0);
#undef PK
}
__device__ __forceinline__ void pv_d0(f32x16* o, int vb, bf16x8 pa0, bf16x8 pa1, bf16x8 pa2, bf16x8 pa3) {
    pv_one<0>(o[0], vb, pa0, pa1, pa2, pa3); pv_one<1>(o[1], vb, pa0, pa1, pa2, pa3); pv_one<2>(o[2], vb, pa0, pa1, pa2, pa3); pv_one<3>(o[3], vb, pa0, pa1, pa2, pa3);
}

__device__ __forceinline__ void unit(LAS unsigned char* lds, int h, int q0, const bf16_t* __restrict__ QD, const bf16_t* __restrict__ KD, const bf16_t* __restrict__ VD,
                                     float lam, const float* __restrict__ subg, bf16_t* MIX) {
    const int tid = opaque_tid(), wid = __builtin_amdgcn_readfirstlane(tid >> 6), lane = tid & 63, r32 = lane & 31, hi = lane >> 5;
    LAS unsigned char* V_lds = lds + OFF_V; LAS unsigned char* K_lds = lds + OFF_K;
    LAS float* ws = (LAS float*)(lds + OFF_WS) + wid * 64; LAS float* li_l = ws; LAS float* al_l = ws + 32;
    LAS unsigned* O0 = (LAS unsigned*)(lds + OFF_O0);
    const int sr = tid >> 4, sc = (tid & 15) * 8, vst0 = v_st(sr, sc), vst1 = v_st(32 + sr, sc), kst = wid * 1024 + lane * 16;
    const int vb0 = (int)(uintptr_t)V_lds + v_rd_base(lane);
    const unsigned voV0 = (unsigned)(sr * LDR + sc), voV1 = (unsigned)((32 + sr) * LDR + sc), voK = (unsigned)(lane * LDR + wid * 8);
    constexpr int NT = M / KVBLK;
#pragma unroll 1
    for (int mp = 0; mp < 2; ++mp) {
        const bf16_t* Kh = KD + h * 128 + mp * 64; const bf16_t* Vh = VD + h * 128;
        const bf16_t* Qw = QD + (size_t)(q0 + wid * QBLK + r32) * LDR + h * 128 + mp * 64 + hi * 8;
        float m_reg = -1e30f, l_reg = 0.f; f32x16 o[4] = {}; bf16x8 qr[4];
#pragma unroll
        for (int d0 = 0; d0 < 4; ++d0) qr[d0] = *reinterpret_cast<const bf16x8*>(Qw + d0 * 16);
        struct { bf16x8 vs0, vs1, ks0; } sr_[2];
#define SLOAD(i, k0) do { const bf16_t* vt_ = Vh + (size_t)(k0) * LDR; const bf16_t* kt_ = Kh + (size_t)(k0) * LDR; \
        sr_[i].vs0 = *reinterpret_cast<const bf16x8*>(vt_ + voV0); sr_[i].vs1 = *reinterpret_cast<const bf16x8*>(vt_ + voV1); sr_[i].ks0 = *reinterpret_cast<const bf16x8*>(kt_ + voK); } while (0)
#define SWRITE(b, i) do { *(LAS bf16x8*)(V_lds + (b) * SHM_V + vst0) = sr_[i].vs0; *(LAS bf16x8*)(V_lds + (b) * SHM_V + vst1) = sr_[i].vs1; \
        *(LAS bf16x8*)(K_lds + (b) * SHM_K + kst) = sr_[i].ks0; } while (0)
#define SWAIT() asm volatile("s_waitcnt vmcnt(3)" ::: "memory")
#define RESC(a) do { if (__any((a) < 1.f)) { if (hi == 0) al_l[r32] = (a); asm volatile("s_waitcnt lgkmcnt(0)" ::: "memory"); \
        _Pragma("unroll") for (int d = 0; d < 4; ++d) _Pragma("unroll") for (int r = 0; r < 16; ++r) o[d][r] *= al_l[crow(r, hi)]; } } while (0)
        f32x16 pA0, pA1, pB0, pB1; float mnA, mnB, alA, alB; bf16x8 pa0, pa1, pa2, pa3;
        constexpr int SE = 0, SO = 1;
        SLOAD(SE, 0); asm volatile("s_waitcnt vmcnt(0)" ::: "memory"); SWRITE(0, SE); __syncthreads();
        qkt(pA0, pA1, K_lds, qr, r32, hi); partialSM(pA0, pA1, m_reg, mnA, alA);
        SLOAD(SO, KVBLK); SLOAD(SE, 2 * KVBLK);
        SWAIT(); SWRITE(1, SO); __syncthreads();
#pragma unroll 1
        for (int j = 1; j + 1 < NT; j += 2) {
            SBAR(); qkt(pB0, pB1, K_lds + SHM_K, qr, r32, hi);
            finishSM(pA0, pA1, alA, l_reg, pa0, pa1, pa2, pa3); SBAR();
            SLOAD(SO, (j + 2) * KVBLK); SBAR();
            pv_d0(o, vb0, pa0, pa1, pa2, pa3); partialSM(pB0, pB1, m_reg, mnB, alB);
            __syncthreads(); SWAIT(); SWRITE(0, SE);
            RESC(alB); __syncthreads();
            SBAR(); qkt(pA0, pA1, K_lds, qr, r32, hi);
            finishSM(pB0, pB1, alB, l_reg, pa0, pa1, pa2, pa3); SBAR();
            if (j + 3 < NT) SLOAD(SE, (j + 3) * KVBLK); SBAR();
            pv_d0(o, vb0 + SHM_V, pa0, pa1, pa2, pa3); partialSM(pA0, pA1, m_reg, mnA, alA);
            __syncthreads(); SWAIT(); SWRITE(1, SO);
            RESC(alA); __syncthreads();
        }
        SBAR(); qkt(pB0, pB1, K_lds + SHM_K, qr, r32, hi);
        finishSM(pA0, pA1, alA, l_reg, pa0, pa1, pa2, pa3); SBAR();
        pv_d0(o, vb0, pa0, pa1, pa2, pa3); partialSM(pB0, pB1, m_reg, mnB, alB);
        __syncthreads(); RESC(alB);
        finishSM(pB0, pB1, alB, l_reg, pa0, pa1, pa2, pa3); SBAR();
        pv_d0(o, vb0 + SHM_V, pa0, pa1, pa2, pa3);
#undef SLOAD
#undef SWRITE
#undef SWAIT
#undef RESC
        if (hi == 0) li_l[r32] = l_reg; asm volatile("s_waitcnt lgkmcnt(0)" ::: "memory");
        int rowb = q0 + wid * QBLK; asm volatile("" : "+s"(rowb));
        float rli[16];
#pragma unroll
        for (int r = 0; r < 16; ++r) rli[r] = __builtin_amdgcn_rcpf(li_l[crow(r, hi)]);
        if (mp == 0) {
#pragma unroll
            for (int d0 = 0; d0 < 4; ++d0)
#pragma unroll
                for (int r = 0; r < 16; r += 2) O0[(d0 * 8 + (r >> 1)) * 512 + tid] = cvtpk(o[d0][r] * rli[r], o[d0][r + 1] * rli[r + 1]);
        } else {
            float ss[16];
#pragma unroll
            for (int r = 0; r < 16; ++r) ss[r] = 0.f;
#pragma unroll
            for (int d0 = 0; d0 < 4; ++d0)
#pragma unroll
                for (int r = 0; r < 16; r += 2) { const unsigned w = O0[(d0 * 8 + (r >> 1)) * 512 + tid];
                    const float c0 = bflo(w) - lam * o[d0][r] * rli[r], c1 = bfhi(w) - lam * o[d0][r + 1] * rli[r + 1];
                    o[d0][r] = c0; o[d0][r + 1] = c1; ss[r] += c0 * c0; ss[r + 1] += c1 * c1; }
#pragma unroll
            for (int r = 0; r < 16; ++r) {
                ss[r] += lane_xor<1>(ss[r]); ss[r] += lane_xor<2>(ss[r]); ss[r] += lane_xor<4>(ss[r]); ss[r] += lane_xor<8>(ss[r]); ss[r] += lane_xor<16>(ss[r]);
                ss[r] = 0.8f / sqrtf(ss[r] * (1.f / 128.f) + 1e-5f); }
#pragma unroll
            for (int d0 = 0; d0 < 4; ++d0) { const float g = subg[d0 * 32 + r32];
#pragma unroll
                for (int r = 0; r < 16; ++r) MIX[(size_t)(rowb + crow(r, hi)) * D + 512 + h * 128 + d0 * 32 + r32] = (bf16_t)f2bf(o[d0][r] * ss[r] * g); }
        }
        __syncthreads();
    }
}
__device__ __forceinline__ void hgrn_finalize(int h, int q0, const float* OF, const float* OB, const bf16_t* SG, const float* gain, bf16_t* MIX, int wid, int lane) {
    const float g0 = gain[2 * lane], g1 = gain[2 * lane + 1];
#pragma unroll 4
    for (int i = 0; i < 32; ++i) { const int row = q0 + wid * 32 + i; const size_t off = (size_t)row * HSEC + h * 128 + 2 * lane;
        const float2 a = *(const float2*)(OF + off), b = *(const float2*)(OB + off); const unsigned sg = *(const unsigned*)(SG + off);
        const float x0 = a.x + b.x, x1 = a.y + b.y; const float ssum = wave_sum(x0 * x0 + x1 * x1);
        const float rstd = 1.f / sqrtf(ssum * (1.f / 128.f) + 1e-6f);
        *(unsigned*)(MIX + (size_t)row * D + h * 128 + 2 * lane) = cvtpk(x0 * rstd * g0 * bflo(sg), x1 * rstd * g1 * bfhi(sg)); }
}
}

namespace att2 {
typedef short v4i16_t __attribute__((ext_vector_type(4)));
constexpr int KVBLK = 64, LDR = HSEC, NT = M / KVBLK;
constexpr int KSLOT = 8192, VSLOT = 16384, NSLOT = 4;
constexpr int OFF_K = 0, OFF_V = NSLOT * KSLOT, OFF_WS = OFF_V + NSLOT * VSLOT, OFF_END = OFF_WS + NWAVES * 64 * 4;
static_assert(OFF_END <= PHASE_LDS, "attention LDS");
__device__ __forceinline__ s16x4 vtr(const LAS unsigned char* p) { return __builtin_bit_cast(s16x4, __builtin_amdgcn_ds_read_tr16_b64_v4i16((LAS v4i16_t*)p)); }
__device__ __forceinline__ void glds16(const void* sbase, unsigned voff, unsigned lds_dst) { unsigned keep;
    asm volatile("s_mov_b32 %0, m0\n\ts_mov_b32 m0, %3\n\ts_nop 0\n\tglobal_load_lds_dwordx4 %1, %2\n\ts_mov_b32 m0, %0" : "=&s"(keep) : "v"(voff), "s"(sbase), "s"(lds_dst) : "memory"); }
#define ATT2_WAIT_BAR(N) asm volatile("s_waitcnt vmcnt(" #N ") lgkmcnt(0)\n\ts_barrier" ::: "memory")
template <bool DO_QK, bool DO_SM, bool DO_PV>
__device__ __forceinline__ void step(f32x16& sn0, f32x16& sn1, f32x16& sc0, f32x16& sc1, const u32x4& pap0, const u32x4& pap1, const u32x4& pap2, const u32x4& pap3,
                                     u32x4& pan0, u32x4& pan1, u32x4& pan2, u32x4& pan3, f32x16 (&o)[4], const bf16x8 (&qr)[4], const f32x16& negm, float& lsum,
                                     const LAS unsigned char* kc, const LAS unsigned char* knn, const LAS unsigned char* vb, bf16x8& kf0, bf16x8& kf1) {
    bf16x8 fr0 = kf0, fr1 = kf1, fr2 = kf0; unsigned ca0 = 0, ca1 = 0, cb0 = 0, cb1 = 0;
    (void)ca0; (void)ca1; (void)cb0; (void)cb1;
    if (DO_QK) { fr2 = *(const LAS bf16x8*)(kc + 2048); }
    if (DO_QK) sn0 = __builtin_amdgcn_mfma_f32_32x32x16_bf16(fr0, qr[0], negm, 0, 0, 0);
    if (DO_SM) { sc0[0] = ex2(sc0[0]); sc0[1] = ex2(sc0[1]); }
    SBAR();
    if (DO_QK) { fr0 = *(const LAS bf16x8*)(kc + 2560); }
    if (DO_QK) sn1 = __builtin_amdgcn_mfma_f32_32x32x16_bf16(fr1, qr[0], negm, 0, 0, 0);
    if (DO_SM) { sc0[2] = ex2(sc0[2]); sc0[3] = ex2(sc0[3]); lsum += sc0[0]; lsum += sc0[1]; }
    SBAR();
    if (DO_QK) { fr1 = *(const LAS bf16x8*)(kc + 4096); }
    if (DO_QK) sn0 = __builtin_amdgcn_mfma_f32_32x32x16_bf16(fr2, qr[1], sn0, 0, 0, 0);
    if (DO_SM) { sc0[4] = ex2(sc0[4]); sc0[5] = ex2(sc0[5]); lsum += sc0[2]; lsum += sc0[3]; }
    SBAR();
    if (DO_QK) { fr2 = *(const LAS bf16x8*)(kc + 4608); }
    if (DO_QK) sn1 = __builtin_amdgcn_mfma_f32_32x32x16_bf16(fr0, qr[1], sn1, 0, 0, 0);
    if (DO_SM) { sc0[6] = ex2(sc0[6]); sc0[7] = ex2(sc0[7]); lsum += sc0[4]; lsum += sc0[5]; }
    SBAR();
    if (DO_QK) { fr0 = *(const LAS bf16x8*)(kc + 6144); }
    if (DO_QK) sn0 = __builtin_amdgcn_mfma_f32_32x32x16_bf16(fr1, qr[2], sn0, 0, 0, 0);
    if (DO_SM) { sc0[8] = ex2(sc0[8]); sc0[9] = ex2(sc0[9]); lsum += sc0[6]; lsum += sc0[7]; }
    SBAR();
    if (DO_QK) { fr1 = *(const LAS bf16x8*)(kc + 6656); }
    if (DO_QK) sn1 = __builtin_amdgcn_mfma_f32_32x32x16_bf16(fr2, qr[2], sn1, 0, 0, 0);
    if (DO_SM) { sc0[10] = ex2(sc0[10]); sc0[11] = ex2(sc0[11]); lsum += sc0[8]; lsum += sc0[9]; }
    SBAR();
    if (DO_PV) { { const s16x4 l_ = vtr(vb + 0), h_ = vtr(vb + 2048); fr2 = (bf16x8){l_[0], l_[1], l_[2], l_[3], h_[0], h_[1], h_[2], h_[3]}; } }
    if (DO_QK) sn0 = __builtin_amdgcn_mfma_f32_32x32x16_bf16(fr0, qr[3], sn0, 0, 0, 0);
    if (DO_SM) { sc0[12] = ex2(sc0[12]); sc0[13] = ex2(sc0[13]); lsum += sc0[10]; lsum += sc0[11]; }
    SBAR();
    if (DO_PV) { { const s16x4 l_ = vtr(vb + 4096), h_ = vtr(vb + 6144); fr0 = (bf16x8){l_[0], l_[1], l_[2], l_[3], h_[0], h_[1], h_[2], h_[3]}; } }
    if (DO_QK) sn1 = __builtin_amdgcn_mfma_f32_32x32x16_bf16(fr1, qr[3], sn1, 0, 0, 0);
    if (DO_SM) { sc0[14] = ex2(sc0[14]); sc0[15] = ex2(sc0[15]); lsum += sc0[12]; lsum += sc0[13]; }
    SBAR();
    if (DO_PV) { { const s16x4 l_ = vtr(vb + 8192), h_ = vtr(vb + 10240); fr1 = (bf16x8){l_[0], l_[1], l_[2], l_[3], h_[0], h_[1], h_[2], h_[3]}; } }
    if (DO_PV) o[0] = __builtin_amdgcn_mfma_f32_32x32x16_bf16(__builtin_bit_cast(bf16x8, pap0), fr2, o[0], 0, 0, 0);
    if (DO_SM) { sc1[0] = ex2(sc1[0]); sc1[1] = ex2(sc1[1]); lsum += sc0[14]; lsum += sc0[15]; }
    SBAR();
    if (DO_PV) { { const s16x4 l_ = vtr(vb + 12288), h_ = vtr(vb + 14336); fr2 = (bf16x8){l_[0], l_[1], l_[2], l_[3], h_[0], h_[1], h_[2], h_[3]}; } }
    if (DO_PV) o[0] = __builtin_amdgcn_mfma_f32_32x32x16_bf16(__builtin_bit_cast(bf16x8, pap1), fr0, o[0], 0, 0, 0);
    if (DO_SM) { sc1[2] = ex2(sc1[2]); sc1[3] = ex2(sc1[3]); lsum += sc1[0]; lsum += sc1[1]; }
    SBAR();
    if (DO_PV) { { const s16x4 l_ = vtr(vb + 512), h_ = vtr(vb + 2560); fr0 = (bf16x8){l_[0], l_[1], l_[2], l_[3], h_[0], h_[1], h_[2], h_[3]}; } }
    if (DO_PV) o[0] = __builtin_amdgcn_mfma_f32_32x32x16_bf16(__builtin_bit_cast(bf16x8, pap2), fr1, o[0], 0, 0, 0);
    if (DO_SM) { sc1[4] = ex2(sc1[4]); sc1[5] = ex2(sc1[5]); lsum += sc1[2]; lsum += sc1[3]; }
    SBAR();
    if (DO_PV) { { const s16x4 l_ = vtr(vb + 4608), h_ = vtr(vb + 6656); fr1 = (bf16x8){l_[0], l_[1], l_[2], l_[3], h_[0], h_[1], h_[2], h_[3]}; } }
    if (DO_PV) o[0] = __builtin_amdgcn_mfma_f32_32x32x16_bf16(__builtin_bit_cast(bf16x8, pap3), fr2, o[0], 0, 0, 0);
    if (DO_SM) { sc1[6] = ex2(sc1[6]); sc1[7] = ex2(sc1[7]); lsum += sc1[4]; lsum += sc1[5]; }
    SBAR();
    if (DO_PV) { { const s16x4 l_ = vtr(vb + 8704), h_ = vtr(vb + 10752); fr2 = (bf16x8){l_[0], l_[1], l_[2], l_[3], h_[0], h_[1], h_[2], h_[3]}; } }
    if (DO_PV) o[1] = __builtin_amdgcn_mfma_f32_32x32x16_bf16(__builtin_bit_cast(bf16x8, pap0), fr0, o[1], 0, 0, 0);
    if (DO_SM) { sc1[8] = ex2(sc1[8]); sc1[9] = ex2(sc1[9]); lsum += sc1[6]; lsum += sc1[7]; }
    SBAR();
    if (DO_PV) { { const s16x4 l_ = vtr(vb + 12800), h_ = vtr(vb + 14848); fr0 = (bf16x8){l_[0], l_[1], l_[2], l_[3], h_[0], h_[1], h_[2], h_[3]}; } }
    if (DO_PV) o[1] = __builtin_amdgcn_mfma_f32_32x32x16_bf16(__builtin_bit_cast(bf16x8, pap1), fr1, o[1], 0, 0, 0);
    if (DO_SM) { sc1[10] = ex2(sc1[10]); sc1[11] = ex2(sc1[11]); lsum += sc1[8]; lsum += sc1[9]; }
    SBAR();
    if (DO_PV) { { const s16x4 l_ = vtr(vb + 1024), h_ = vtr(vb + 3072); fr1 = (bf16x8){l_[0], l_[1], l_[2], l_[3], h_[0], h_[1], h_[2], h_[3]}; } }
    if (DO_PV) o[1] = __builtin_amdgcn_mfma_f32_32x32x16_bf16(__builtin_bit_cast(bf16x8, pap2), fr2, o[1], 0, 0, 0);
    if (DO_SM) { sc1[12] = ex2(sc1[12]); sc1[13] = ex2(sc1[13]); lsum += sc1[10]; lsum += sc1[11]; }
    SBAR();
    if (DO_PV) { { const s16x4 l_ = vtr(vb + 5120), h_ = vtr(vb + 7168); fr2 = (bf16x8){l_[0], l_[1], l_[2], l_[3], h_[0], h_[1], h_[2], h_[3]}; } }
    if (DO_PV) o[1] = __builtin_amdgcn_mfma_f32_32x32x16_bf16(__builtin_bit_cast(bf16x8, pap3), fr0, o[1], 0, 0, 0);
    if (DO_SM) { sc1[14] = ex2(sc1[14]); sc1[15] = ex2(sc1[15]); lsum += sc1[12]; lsum += sc1[13]; }
    SBAR();
    if (DO_PV) { { const s16x4 l_ = vtr(vb + 9216), h_ = vtr(vb + 11264); fr0 = (bf16x8){l_[0], l_[1], l_[2], l_[3], h_[0], h_[1], h_[2], h_[3]}; } }
    if (DO_PV) o[2] = __builtin_amdgcn_mfma_f32_32x32x16_bf16(__builtin_bit_cast(bf16x8, pap0), fr1, o[2], 0, 0, 0);
    if (DO_SM) { lsum += sc1[14]; lsum += sc1[15]; ca0 = cvtpk(sc0[0], sc0[1]); ca1 = cvtpk(sc0[2], sc0[3]); }
    SBAR();
    if (DO_PV) { { const s16x4 l_ = vtr(vb + 13312), h_ = vtr(vb + 15360); fr1 = (bf16x8){l_[0], l_[1], l_[2], l_[3], h_[0], h_[1], h_[2], h_[3]}; } }
    if (DO_PV) o[2] = __builtin_amdgcn_mfma_f32_32x32x16_bf16(__builtin_bit_cast(bf16x8, pap1), fr2, o[2], 0, 0, 0);
    if (DO_SM) { cb0 = cvtpk(sc0[4], sc0[5]); cb1 = cvtpk(sc0[6], sc0[7]); { auto r0_ = __builtin_amdgcn_permlane32_swap(ca0, cb0, false, false); auto r1_ = __builtin_amdgcn_permlane32_swap(ca1, cb1, false, false); pan0 = (u32x4){r0_[0], r1_[0], r0_[1], r1_[1]}; } }
    SBAR();
    if (DO_PV) { { const s16x4 l_ = vtr(vb + 1536), h_ = vtr(vb + 3584); fr2 = (bf16x8){l_[0], l_[1], l_[2], l_[3], h_[0], h_[1], h_[2], h_[3]}; } }
    if (DO_PV) o[2] = __builtin_amdgcn_mfma_f32_32x32x16_bf16(__builtin_bit_cast(bf16x8, pap2), fr0, o[2], 0, 0, 0);
    if (DO_SM) { ca0 = cvtpk(sc0[8], sc0[9]); ca1 = cvtpk(sc0[10], sc0[11]); }
    SBAR();
    if (DO_PV) { { const s16x4 l_ = vtr(vb + 5632), h_ = vtr(vb + 7680); fr0 = (bf16x8){l_[0], l_[1], l_[2], l_[3], h_[0], h_[1], h_[2], h_[3]}; } }
    if (DO_PV) o[2] = __builtin_amdgcn_mfma_f32_32x32x16_bf16(__builtin_bit_cast(bf16x8, pap3), fr1, o[2], 0, 0, 0);
    if (DO_SM) { cb0 = cvtpk(sc0[12], sc0[13]); cb1 = cvtpk(sc0[14], sc0[15]); { auto r0_ = __builtin_amdgcn_permlane32_swap(ca0, cb0, false, false); auto r1_ = __builtin_amdgcn_permlane32_swap(ca1, cb1, false, false); pan1 = (u32x4){r0_[0], r1_[0], r0_[1], r1_[1]}; } }
    SBAR();
    if (DO_PV) { { const s16x4 l_ = vtr(vb + 9728), h_ = vtr(vb + 11776); fr1 = (bf16x8){l_[0], l_[1], l_[2], l_[3], h_[0], h_[1], h_[2], h_[3]}; } }
    if (DO_PV) o[3] = __builtin_amdgcn_mfma_f32_32x32x16_bf16(__builtin_bit_cast(bf16x8, pap0), fr2, o[3], 0, 0, 0);
    if (DO_SM) { ca0 = cvtpk(sc1[0], sc1[1]); ca1 = cvtpk(sc1[2], sc1[3]); }
    SBAR();
    if (DO_PV) { { const s16x4 l_ = vtr(vb + 13824), h_ = vtr(vb + 15872); fr2 = (bf16x8){l_[0], l_[1], l_[2], l_[3], h_[0], h_[1], h_[2], h_[3]}; } }
    if (DO_PV) o[3] = __builtin_amdgcn_mfma_f32_32x32x16_bf16(__builtin_bit_cast(bf16x8, pap1), fr0, o[3], 0, 0, 0);
    if (DO_SM) { cb0 = cvtpk(sc1[4], sc1[5]); cb1 = cvtpk(sc1[6], sc1[7]); { auto r0_ = __builtin_amdgcn_permlane32_swap(ca0, cb0, false, false); auto r1_ = __builtin_amdgcn_permlane32_swap(ca1, cb1, false, false); pan2 = (u32x4){r0_[0], r1_[0], r0_[1], r1_[1]}; } }
    SBAR();
    kf0 = *(const LAS bf16x8*)(knn + 0);
    if (DO_PV) o[3] = __builtin_amdgcn_mfma_f32_32x32x16_bf16(__builtin_bit_cast(bf16x8, pap2), fr1, o[3], 0, 0, 0);
    if (DO_SM) { ca0 = cvtpk(sc1[8], sc1[9]); ca1 = cvtpk(sc1[10], sc1[11]); }
    SBAR();
    kf1 = *(const LAS bf16x8*)(knn + 512);
    if (DO_PV) o[3] = __builtin_amdgcn_mfma_f32_32x32x16_bf16(__builtin_bit_cast(bf16x8, pap3), fr2, o[3], 0, 0, 0);
    if (DO_SM) { cb0 = cvtpk(sc1[12], sc1[13]); cb1 = cvtpk(sc1[14], sc1[15]); { auto r0_ = __builtin_amdgcn_permlane32_swap(ca0, cb0, false, false); auto r1_ = __builtin_amdgcn_permlane32_swap(ca1, cb1, false, false); pan3 = (u32x4){r0_[0], r1_[0], r0_[1], r1_[1]}; } }
    SBAR();
}

__device__ __forceinline__ void unit(LAS unsigned char* lds, int h, int q0, const bf16_t* __restrict__ QD, const bf16_t* __restrict__ KD, const bf16_t* __restrict__ VD,
                                     const unsigned* KMAX2, float* O0S, float lam, const float* __restrict__ subg, bf16_t* MIX) {
    const int tid = opaque_tid(), wid = __builtin_amdgcn_readfirstlane(tid >> 6), lane = tid & 63, r32 = lane & 31, hi = lane >> 5;
    const unsigned lds0 = (unsigned)(uintptr_t)lds;
    LAS float* ws = (LAS float*)(lds + OFF_WS) + wid * 64;
    const LAS unsigned char* kbase = lds + OFF_K + hi * 1024 + r32 * 16;
    const LAS unsigned char* vbase = lds + OFF_V + (((lane & 3) << 3) | (((lane >> 2) & 3) << 6) | (((lane >> 4) & 1) << 5) | (((lane >> 5) & 1) << 8));
    const unsigned voK = (unsigned)((lane * LDR + wid * 8) * 2);
    unsigned voV[2];
    { const int kk = 8 * wid + ((lane & 31) >> 2), key = (kk & ~0xC) | ((kk & 4) << 1) | ((kk & 8) >> 1);
#pragma unroll
      for (int j = 0; j < 2; ++j) voV[j] = (unsigned)((key * LDR + (2 * j + (lane >> 5)) * 32 + (lane & 3) * 8) * 2); }
    const unsigned kdst = lds0 + OFF_K + wid * 1024, vdst = lds0 + OFF_V + wid * 2048;
#pragma unroll 1
    for (int mp = 0; mp < 2; ++mp) {
        const bf16_t* Kh = KD + h * 128 + mp * 64; const bf16_t* Vh = VD + h * 128;
        const bf16_t* Qw = QD + (size_t)(q0 + wid * 32 + r32) * LDR + h * 128 + mp * 64 + hi * 8;
#define ATT2_DMA_K(t) do { const int t_ = (t) < NT ? (t) : NT - 1; glds16((const char*)Kh + (size_t)t_ * (KVBLK * LDR * 2), voK, (unsigned)__builtin_amdgcn_readfirstlane(kdst + ((t) & 3) * KSLOT)); } while (0)
#define ATT2_DMA_V(t) do { const int t_ = (t) < NT ? (t) : NT - 1; const char* vs_ = (const char*)Vh + (size_t)t_ * (KVBLK * LDR * 2); const unsigned vd_ = (unsigned)__builtin_amdgcn_readfirstlane(vdst + ((t) & 3) * VSLOT); \
        glds16(vs_, voV[0], vd_); glds16(vs_, voV[1], vd_ + 1024); } while (0)
        ATT2_DMA_K(0); ATT2_DMA_K(1); ATT2_DMA_K(2); ATT2_DMA_V(0);
        bf16x8 qr[4]; float qq = 0.f;
#pragma unroll
        for (int d0 = 0; d0 < 4; ++d0) { qr[d0] = *reinterpret_cast<const bf16x8*>(Qw + d0 * 16);
#pragma unroll
            for (int j = 0; j < 8; ++j) { const float q = bf2f((unsigned short)qr[d0][j]); qq += q * q; } }
        { auto rr = __builtin_amdgcn_permlane32_swap(__float_as_uint(qq), __float_as_uint(qq), false, false); qq = __uint_as_float(rr[0]) + __uint_as_float(rr[1]); }
        const float mref = sqrtf(qq * __uint_as_float(KMAX2[h * 2 + mp])) * 1.001f;
        f32x16 negm;
#pragma unroll
        for (int r = 0; r < 16; ++r) negm[r] = -mref;
        f32x16 o[4] = {}; float lsum = 0.f;
        f32x16 sA0, sA1, sB0, sB1; u32x4 pX0, pX1, pX2, pX3, pY0, pY1, pY2, pY3;
        sA0 = f32x16{}; sA1 = f32x16{}; sB0 = f32x16{}; sB1 = f32x16{}; pX0 = pX1 = pX2 = pX3 = pY0 = pY1 = pY2 = pY3 = (u32x4){0u, 0u, 0u, 0u};
        bf16x8 kf0, kf1;
        ATT2_WAIT_BAR(0);
        kf0 = *(const LAS bf16x8*)(kbase); kf1 = *(const LAS bf16x8*)(kbase + 512);
#define KS(t) (kbase + ((t) & 3) * KSLOT)
#define VS(t) (vbase + ((t) & 3) * VSLOT)
        ATT2_DMA_K(3); ATT2_DMA_V(1);
        step<true, false, false>(sA0, sA1, sB0, sB1, pX0, pX1, pX2, pX3, pY0, pY1, pY2, pY3, o, qr, negm, lsum, KS(0), KS(1), VS(0), kf0, kf1);
        ATT2_WAIT_BAR(3);
        ATT2_DMA_K(4); ATT2_DMA_V(2);
        step<true, true, false>(sB0, sB1, sA0, sA1, pY0, pY1, pY2, pY3, pX0, pX1, pX2, pX3, o, qr, negm, lsum, KS(1), KS(2), VS(0), kf0, kf1);
        ATT2_WAIT_BAR(3);
#pragma unroll 1
        for (int i = 1; i + 1 < NT - 1; i += 2) {
            ATT2_DMA_K(i + 4); ATT2_DMA_V(i + 2);
            step<true, true, true>(sA0, sA1, sB0, sB1, pX0, pX1, pX2, pX3, pY0, pY1, pY2, pY3, o, qr, negm, lsum, KS(i + 1), KS(i + 2), VS(i - 1), kf0, kf1);
            ATT2_WAIT_BAR(3);
            ATT2_DMA_K(i + 5); ATT2_DMA_V(i + 3);
            step<true, true, true>(sB0, sB1, sA0, sA1, pY0, pY1, pY2, pY3, pX0, pX1, pX2, pX3, o, qr, negm, lsum, KS(i + 2), KS(i + 3), VS(i), kf0, kf1);
            ATT2_WAIT_BAR(3);
        }
        step<false, true, true>(sA0, sA1, sB0, sB1, pX0, pX1, pX2, pX3, pY0, pY1, pY2, pY3, o, qr, negm, lsum, KS(0), KS(0), VS(NT - 2), kf0, kf1);
        ATT2_WAIT_BAR(0);
        step<false, false, true>(sB0, sB1, sA0, sA1, pY0, pY1, pY2, pY3, pX0, pX1, pX2, pX3, o, qr, negm, lsum, KS(0), KS(0), VS(NT - 1), kf0, kf1);
        ATT2_WAIT_BAR(0);
#undef KS
#undef VS
#undef ATT2_DMA_K
#undef ATT2_DMA_V
        { auto rr = __builtin_amdgcn_permlane32_swap(__float_as_uint(lsum), __float_as_uint(lsum), false, false); lsum = __uint_as_float(rr[0]) + __uint_as_float(rr[1]); }
        if (hi == 0) ws[r32] = lsum; asm volatile("s_waitcnt lgkmcnt(0)" ::: "memory");
        int rowb = q0 + wid * 32; asm volatile("" : "+s"(rowb));
        float rli[16];
#pragma unroll
        for (int r = 0; r < 16; ++r) rli[r] = __builtin_amdgcn_rcpf(ws[crow(r, hi)]);
        float* o0p = O0S + tid; asm volatile("" : "+v"(o0p));
        if (mp == 0) {
#pragma unroll
            for (int d0 = 0; d0 < 4; ++d0)
#pragma unroll
                for (int r = 0; r < 16; ++r) o0p[(d0 * 16 + r) * 512] = o[d0][r] * rli[r];
        } else {
            float ss[16];
#pragma unroll
            for (int r = 0; r < 16; ++r) ss[r] = 0.f;
#pragma unroll
            for (int d0 = 0; d0 < 4; ++d0)
#pragma unroll
                for (int r = 0; r < 16; ++r) { const float c = o0p[(d0 * 16 + r) * 512] - lam * o[d0][r] * rli[r]; o[d0][r] = c; ss[r] += c * c; }
#pragma unroll
            for (int r = 0; r < 16; ++r) {
                ss[r] += lane_xor<1>(ss[r]); ss[r] += lane_xor<2>(ss[r]); ss[r] += lane_xor<4>(ss[r]); ss[r] += lane_xor<8>(ss[r]); ss[r] += lane_xor<16>(ss[r]);
                ss[r] = 0.8f / sqrtf(ss[r] * (1.f / 128.f) + 1e-5f); }
#pragma unroll
            for (int d0 = 0; d0 < 4; ++d0) { const float g = subg[d0 * 32 + r32];
#pragma unroll
                for (int r = 0; r < 16; ++r) MIX[(size_t)(rowb + crow(r, hi)) * D + 512 + h * 128 + d0 * 32 + r32] = (bf16_t)f2bf(o[d0][r] * ss[r] * g); }
        }
        asm volatile("s_waitcnt vmcnt(0) lgkmcnt(0)\n\ts_barrier" ::: "memory");
    }
}
__device__ __forceinline__ void kmax_rows(const bf16_t* KD, unsigned* KMAX2, int gw, int ngw, int lane) {
    float mx = 0.f;
    for (int row = gw; row < M; row += ngw) { const u32x4 w = *(const GAS u32x4*)(KD + (size_t)row * HSEC + lane * 8);
        float s = bflo(w.x) * bflo(w.x) + bfhi(w.x) * bfhi(w.x) + bflo(w.y) * bflo(w.y) + bfhi(w.y) * bfhi(w.y) + bflo(w.z) * bflo(w.z) + bfhi(w.z) * bfhi(w.z) + bflo(w.w) * bflo(w.w) + bfhi(w.w) * bfhi(w.w);
        s += lane_xor<1>(s); s += lane_xor<2>(s); s += lane_xor<4>(s); mx = fmaxf(mx, s); }
    if ((lane & 7) == 0) atomicMax(KMAX2 + (lane >> 3), __float_as_uint(mx));
}
}

__device__ __forceinline__ void route16(const float* X2, const u32x4* WRB, const float* gain, const float* rgb, const float* reb,
                                        bf16_t* H2, int* TOKE, float* TOKW, int* TOKR, unsigned* CNT, int row0, int lane, LAS float* wl) {
    typedef float f32x4_ __attribute__((ext_vector_type(4)));
    const int r = lane & 15, q = lane >> 4;
    f32x4_ acc[3]; acc[0] = (f32x4_){0.f, 0.f, 0.f, 0.f}; acc[1] = acc[0]; acc[2] = acc[0];
    float ssq = 0.f;
    const float* xp = X2 + (size_t)(row0 + r) * D + 8 * q;
#pragma unroll 4
    for (int ks = 0; ks < 32; ++ks) {
        const f32x4 a0 = *(const GAS f32x4*)(xp + ks * 32), a1 = *(const GAS f32x4*)(xp + ks * 32 + 4);
        ssq += (a0.x * a0.x + a0.y * a0.y) + (a0.z * a0.z + a0.w * a0.w) + (a1.x * a1.x + a1.y * a1.y) + (a1.z * a1.z + a1.w * a1.w);
        const unsigned h0 = cvtpk(a0.x, a0.y), h1 = cvtpk(a0.z, a0.w), h2 = cvtpk(a1.x, a1.y), h3 = cvtpk(a1.z, a1.w);
        const unsigned l0 = cvtpk(a0.x - bflo(h0), a0.y - bfhi(h0)), l1 = cvtpk(a0.z - bflo(h1), a0.w - bfhi(h1)), l2 = cvtpk(a1.x - bflo(h2), a1.y - bfhi(h2)), l3 = cvtpk(a1.z - bflo(h3), a1.w - bfhi(h3));
        const bf16x8 xh = __builtin_bit_cast(bf16x8, (u32x4){h0, h1, h2, h3}), xl = __builtin_bit_cast(bf16x8, (u32x4){l0, l1, l2, l3});
#pragma unroll
        for (int nt = 0; nt < 3; ++nt) {
            const bf16x8 wh = __builtin_bit_cast(bf16x8, WRB[((ks * 3 + nt) * 2 + 0) * 64 + lane]), wlo = __builtin_bit_cast(bf16x8, WRB[((ks * 3 + nt) * 2 + 1) * 64 + lane]);
            acc[nt] = __builtin_amdgcn_mfma_f32_16x16x32_bf16(wh, xh, acc[nt], 0, 0, 0);
            acc[nt] = __builtin_amdgcn_mfma_f32_16x16x32_bf16(wh, xl, acc[nt], 0, 0, 0);
            acc[nt] = __builtin_amdgcn_mfma_f32_16x16x32_bf16(wlo, xh, acc[nt], 0, 0, 0);
        }
    }
    ssq += lane_xor<16>(ssq);
    { auto rr = __builtin_amdgcn_permlane32_swap(__float_as_uint(ssq), __float_as_uint(ssq), false, false); ssq = __uint_as_float(rr[0]) + __uint_as_float(rr[1]); }
    const float rstd = 1.f / sqrtf(ssq * (1.f / 1024.f) + 1e-6f);
#pragma unroll
    for (int nt = 0; nt < 3; ++nt) *(LAS f32x4_*)(wl + r * 48 + nt * 16 + 4 * q) = acc[nt] * rstd;
    if (q == 0) wl[768 + r] = rstd;
    LDS_WAIT();
    float lg[36];
#pragma unroll
    for (int n4 = 0; n4 < 9; ++n4) { const f32x4_ t = *(const LAS f32x4_*)(wl + r * 48 + 4 * n4); lg[4 * n4] = t[0]; lg[4 * n4 + 1] = t[1]; lg[4 * n4 + 2] = t[2]; lg[4 * n4 + 3] = t[3]; }
    float gl[4];
#pragma unroll
    for (int g = 0; g < 4; ++g) gl[g] = lg[g] + rgb[g];
    int gi = 0; float gm = gl[0];
#pragma unroll
    for (int g = 1; g < 4; ++g) if (gl[g] > gm) { gm = gl[g]; gi = g; }
    float gs = 0.f;
#pragma unroll
    for (int g = 0; g < 4; ++g) gs += __expf(gl[g] - gm);
    const float gp = 1.f / gs;
    float e[8];
#pragma unroll
    for (int j = 0; j < 8; ++j) { const float a0 = lg[4 + j] + reb[j], a1 = lg[12 + j] + reb[8 + j], a2 = lg[20 + j] + reb[16 + j], a3 = lg[28 + j] + reb[24 + j];
        e[j] = gi == 0 ? a0 : gi == 1 ? a1 : gi == 2 ? a2 : a3; }
    int i1 = 0; float m1 = e[0];
#pragma unroll
    for (int j = 1; j < 8; ++j) if (e[j] > m1) { m1 = e[j]; i1 = j; }
    int i2 = 0; float m2 = -3.0e38f;
#pragma unroll
    for (int j = 0; j < 8; ++j) if (j != i1 && e[j] > m2) { m2 = e[j]; i2 = j; }
    const float p2 = __expf(m2 - m1);
    const float w1 = gp / (1.f + p2), w2 = gp * p2 / (1.f + p2);
    if (q == 0) { const int row = row0 + r; const int e1 = gi * 8 + i1, e2 = gi * 8 + i2;
        const int r1 = (int)atomicAdd(CNT + e1, 1u), r2 = (int)atomicAdd(CNT + e2, 1u);
        TOKE[row * 2] = e1; TOKE[row * 2 + 1] = e2; TOKW[row * 2] = w1; TOKW[row * 2 + 1] = w2; TOKR[row * 2] = r1; TOKR[row * 2 + 1] = r2; }
    f32x4 g4[4];
#pragma unroll
    for (int j = 0; j < 4; ++j) g4[j] = *(const GAS f32x4*)(gain + lane * 16 + 4 * j);
#pragma unroll 2
    for (int i = 0; i < 16; ++i) { const float rs = wl[768 + i]; const float* xr = X2 + (size_t)(row0 + i) * D + lane * 16; unsigned w[8];
#pragma unroll
        for (int j = 0; j < 4; ++j) { const f32x4 v = *(const GAS f32x4*)(xr + 4 * j); w[2 * j] = cvtpk(v.x * rs * g4[j].x, v.y * rs * g4[j].y); w[2 * j + 1] = cvtpk(v.z * rs * g4[j].z, v.w * rs * g4[j].w); }
        GAS u32x4* o = (GAS u32x4*)(H2 + (size_t)(row0 + i) * D + lane * 16); o[0] = (u32x4){w[0], w[1], w[2], w[3]}; o[1] = (u32x4){w[4], w[5], w[6], w[7]}; }
}
__device__ __forceinline__ void build_tile_prefix(volatile LAS int* tb, const unsigned* CNT) {
    if (threadIdx.x == 0) { int acc = 0;
        for (int e = 0; e < 32; ++e) { tb[e] = acc; const int c = (int)__hip_atomic_load(CNT + e, __ATOMIC_RELAXED, __HIP_MEMORY_SCOPE_AGENT); acc += (c + 255) >> 8; }
        tb[32] = acc; }
    LDS_WAIT(); __syncthreads();
}
__device__ __forceinline__ void final_row(float* XO, const bf16_t* Y, const int* TOKS, const float* TOKW, const float* gain, int row, int lane) {
    const int s0 = TOKS[row * 2], s1 = TOKS[row * 2 + 1]; const float w0 = TOKW[row * 2], w1 = TOKW[row * 2 + 1];
    GAS f32x4* xr = (GAS f32x4*)(XO + (size_t)row * D) + lane; const GAS u32x2* y0 = (const GAS u32x2*)(Y + (size_t)s0 * D) + lane; const GAS u32x2* y1 = (const GAS u32x2*)(Y + (size_t)s1 * D) + lane;
    f32x4 v[4]; float s = 0.f;
#pragma unroll
    for (int j = 0; j < 4; ++j) { v[j] = xr[64 * j]; const u32x2 a = y0[64 * j], b = y1[64 * j];
        v[j].x += w0 * bflo(a.x) + w1 * bflo(b.x); v[j].y += w0 * bfhi(a.x) + w1 * bfhi(b.x); v[j].z += w0 * bflo(a.y) + w1 * bflo(b.y); v[j].w += w0 * bfhi(a.y) + w1 * bfhi(b.y);
        s += (v[j].x * v[j].x + v[j].y * v[j].y) + (v[j].z * v[j].z + v[j].w * v[j].w); }
    const float rstd = 1.f / sqrtf(wave_sum(s) * (1.f / 1024.f) + 1e-6f);
#pragma unroll
    for (int j = 0; j < 4; ++j) { const f32x4 g = ((const GAS f32x4*)gain)[64 * j + lane]; xr[64 * j] = v[j] * rstd * g; }
}

#ifndef MK_N_LAUNCHES
#define MK_N_LAUNCHES 1
#endif
constexpr int N_PHASES = 12;
struct Args { const void* in[18]; float* out; unsigned char* ws; int ph_lo, ph_hi; };
static_assert(sizeof(Args) == 18 * 8 + 8 + 8 + 8, "Args has no padding");

__global__ void __launch_bounds__(NWAVES * 64, 2) mk_fwd(Args args) {
    extern __shared__ __attribute__((aligned(16))) unsigned char lds_raw[];
    LAS unsigned char* lds = (LAS unsigned char*)lds_raw;
    volatile LAS unsigned* MISC = (volatile LAS unsigned*)(lds + MISC_OFF);
    const int G = gridDim.x, bx = blockIdx.x, vcu = (G % 8 == 0) ? (bx % 8) * (G / 8) + bx / 8 : bx;
    const int NGW = G * NWAVES;
#define PHASE_IDS const int tid = opaque_tid(), lane = tid & 63, wave = __builtin_amdgcn_readfirstlane(tid >> 6), gw = vcu * NWAVES + wave; (void)lane; (void)gw
    const __attribute__((address_space(4))) Args* A = (const __attribute__((address_space(4))) Args*)__builtin_amdgcn_kernarg_segment_ptr();
    asm volatile("" : "+s"(A));
#define ARGF(i) ((const float*)A->in[i])
#define WSP(T, off) ((T*)(A->ws + (off)))
#define x_in ARGF(0)
#define positions ((const int*)A->in[1])
#define norm1_gain ARGF(2)
#define w_in ARGF(3)
#define hg_lb ARGF(4)
#define hg_norm_gain ARGF(5)
#define diff_lambda ARGF(6)
#define subln_gain ARGF(7)
#define w_out ARGF(8)
#define norm2_gain ARGF(9)
#define rg_w ARGF(10)
#define rg_b ARGF(11)
#define re_w ARGF(12)
#define re_b ARGF(13)
#define w_gate ARGF(14)
#define w_up ARGF(15)
#define w_down ARGF(16)
#define final_gain ARGF(17)
#define out (A->out)
#define cosT WSP(float, WS_ROPE)
#define sinT (WSP(float, WS_ROPE) + M * 8)
#define HD WSP(float, WS_HD)
#define TOKE WSP(int, WS_TOKE)
#define TOKW WSP(float, WS_TOKW)
#define TOKR WSP(int, WS_TOKR)
#define TOKS WSP(int, WS_TOKS)
#define LAMP WSP(float, WS_LAM)
#define WOUT WSP(bf16_t, WS_WOUT)
#define WIN WSP(bf16_t, WS_WIN)
#define XN WSP(bf16_t, WS_XN)
#define QH WSP(bf16_t, WS_QH)
#define VH WSP(bf16_t, WS_VH)
#define SG WSP(bf16_t, WS_SG)
#define QD WSP(bf16_t, WS_QD)
#define KD WSP(bf16_t, WS_KD)
#define VD WSP(bf16_t, WS_VD)
#define GF WSP(float, WS_GF)
#define GB WSP(float, WS_GB)
#define HS WSP(float, WS_HS)
#define HL WSP(float, WS_HL)
#define OF WSP(float, WS_OF)
#define OB WSP(float, WS_OB)
#define MIX WSP(bf16_t, WS_MIX)
#define H2 WSP(bf16_t, WS_H2)
#define WGU WSP(bf16_t, WS_WGU)
#define WD WSP(bf16_t, WS_WD)
#define HGb WSP(bf16_t, WS_HG)
#define HM WSP(bf16_t, WS_HM)
#define Y WSP(bf16_t, WS_Y)
#define CNT (WSP(unsigned, WS_CTL) + CW_CNT)
    unsigned* ctl = WSP(unsigned, WS_CTL);
    volatile LAS int* tb = (volatile LAS int*)(MISC + 16);

    if (threadIdx.x < 64) MISC[threadIdx.x] = 0u;
    __syncthreads();
    XcdBarrier bar; bar.bar = ctl + CW_BAR; bar.x = 0; bar.st = nullptr;
    const int lo = A->ph_lo, hi = A->ph_hi;
    if (hi - lo > 1) bar = xcd_barrier_post(ctl + CW_BAR, MISC);
#ifndef PH_MASK
#define PH_MASK 0xFFF
#endif
#define IN(k) (((PH_MASK >> (k)) & 1) && lo <= (k) && (k) < hi)
#ifndef DOUBLE_PHASE
#define DOUBLE_PHASE -1
#endif
#define REP(k) for (int rep_ = 0; rep_ < ((DOUBLE_PHASE) == (k) ? 2 : 1); ++rep_)
#define SEAM(k) do { if (IN(k) && IN((k) + 1)) xcd_barrier(bar); } while (0)

    if (IN(0)) REP(0) { PHASE_IDS;
        LAS float* scr = (LAS float*)(lds + wave * 16384);
        constexpr int I_IN = (D / 64) * (NIN / 32), I_OUT = (D / 64) * (D / 32);
        for (int it = gw; it < I_IN + I_OUT; it += NGW) {
            if (it < I_IN) transpose_item(w_in, D, NIN, WIN, 0, 1, scr, it, lane);
            else transpose_item(w_out, D, D, WOUT, 0, 1, scr, it - I_IN, lane);
        }
        for (int m = gw; m < M; m += NGW) rms_row_to_bf16(x_in + (size_t)m * D, norm1_gain, XN + (size_t)m * D, lane, 1e-6f);
        for (int id = bx * 512 + tid; id < M * 8; id += G * 512) {
            const int i = id & 7; const float invf[8] = {1.0f, 0.19392274474868576f, 0.03760603093086393f, 0.007292664737217109f, 0.001414213562373095f, 0.0002742481756762073f, 5.318295896944988e-05f, 1.031338537721246e-05f};
            float f = invf[0];
#pragma unroll
            for (int q = 1; q < 8; ++q) f = (i == q) ? invf[q] : f;
            const float ang = (float)positions[id >> 3] * f;
            const double rev = (double)ang * 0.15915494309189535; const float fr = (float)(rev - __builtin_rint(rev));
            cosT[id] = __builtin_amdgcn_cosf(fr); sinT[id] = __builtin_amdgcn_sinf(fr);
        }
        for (int id = bx * 512 + tid; id < 32 * 3 * 2 * 64; id += G * 512) {
            const int ln = id & 63, part = (id >> 6) & 1, nt = (id >> 7) % 3, ks = (id >> 7) / 3, n = nt * 16 + (ln & 15), k0 = ks * 32 + 8 * (ln >> 4); unsigned w[4];
#pragma unroll
            for (int jj = 0; jj < 4; ++jj) { float v[2];
#pragma unroll
                for (int u = 0; u < 2; ++u) { const int k = k0 + 2 * jj + u; const float wv = (n < 4 ? rg_w[k * 4 + n] : n < 36 ? re_w[k * 32 + (n - 4)] : 0.f) * norm2_gain[k];
                    const float hv = bf2f(f2bf(wv)); v[u] = part ? wv - hv : hv; }
                w[jj] = pk2(v[0], v[1]); }
            WSP(u32x4, WS_WR)[id] = (u32x4){w[0], w[1], w[2], w[3]}; }
        if (bx == 0 && wave == 0) { const float a = wave_sum(diff_lambda[lane] * diff_lambda[64 + lane]), b = wave_sum(diff_lambda[128 + lane] * diff_lambda[192 + lane]);
            if (lane == 0) LAMP[0] = __expf(a) - __expf(b) + 0.2f; }
    }
    SEAM(0);
    if (IN(1)) REP(1) {
        pg8::Gemm g{XN, WIN, M, NIN, D}; pg8::StaticOrder S; S.init(M, NIN, G, bx);
        EpiInProj E{QH, VH, SG, QD, KD, VD, GF, GB, hg_lb, cosT, sinT};
        pg8::gemm_phase<EpiInProj, pg8::StaticOrder, true, true>(lds, g, S, E);
    }
    SEAM(1);
    if (IN(2)) REP(2) { for (int u = vcu; u < 256; u += G) hg::pass<false>(lds, u, QH, VH, GF, GB, HL, HD, HS, OF, OB);
        { PHASE_IDS; att2::kmax_rows(KD, WSP(unsigned, WS_CTL) + CW_KMAX, gw, NGW, lane); } }
    SEAM(2);
    if (IN(3)) REP(3) hg::scan(HL, HD, HS, bx * 512 + opaque_tid(), G * 512);
    SEAM(3);
    if (IN(4)) REP(4) { for (int u = vcu; u < 256; u += G) hg::pass<true>(lds, u, QH, VH, GF, GB, HL, HD, HS, OF, OB); }
    SEAM(4);
    if (IN(5)) REP(5) { PHASE_IDS;
        const float lam = LAMP[0];
        for (int u = vcu; u < 256; u += G) { const int h = u >> 6, q0 = (u & 63) * 256;
            int ln = lane; asm volatile("" : "+v"(ln));
            att::hgrn_finalize(h, q0, OF, OB, SG, hg_norm_gain, MIX, wave, ln);
#ifdef ATT_OLD
            att::unit(lds, h, q0, QD, KD, VD, lam, subln_gain, MIX); }
#else
            att2::unit(lds, h, q0, QD, KD, VD, WSP(unsigned, WS_CTL) + CW_KMAX, WSP(float, WS_O0S) + (size_t)bx * 32768, lam, subln_gain, MIX); }
#endif
    }
    SEAM(5);
    if (IN(6)) REP(6) {
        pg8::Gemm g{MIX, WOUT, M, D, D}; pg8::StaticOrder S; S.init(M, D, G, bx);
        EpiResid E{x_in, out};
        pg8::gemm_phase<EpiResid, pg8::StaticOrder, true, true>(lds, g, S, E);
    }
    SEAM(6);
    if (IN(7)) { PHASE_IDS;
        const int grp = wave * G + vcu; const bool router = grp * 16 < M;
        LAS float* scr = (LAS float*)(lds + wave * 16384);
        if (router) route16(out, WSP(const u32x4, WS_WR), norm2_gain, rg_b, re_b, H2, TOKE, TOKW, TOKR, CNT, grp * 16, lane, scr + 3072);
        constexpr int I_GU = (D / 64) * (DEXP / 32), I_DN = (DEXP / 64) * (D / 32), I_ALL = NEXP * (2 * I_GU + I_DN);
        const int nrt = M / 16, nA = nrt < NGW ? nrt : NGW, nB = NGW - nA;
        const int perA = nB ? (I_ALL * 5 / 12 + nA - 1) / nA : (I_ALL + nA - 1) / nA, totA = perA * nA < I_ALL ? perA * nA : I_ALL;
        int it0, it1, stp;
        if (router) { it0 = grp; it1 = totA; stp = nA; } else { it0 = totA + (grp - nA); it1 = I_ALL; stp = nB; }
        REP(7) for (int it = it0; it < it1; it += stp) {
            const int e = it / (2 * I_GU + I_DN), r = it % (2 * I_GU + I_DN);
            if (r < I_GU) transpose_item(w_gate + (size_t)e * D * DEXP, D, DEXP, WGU + (size_t)e * 1024 * D, 0, 2, scr, r, lane);
            else if (r < 2 * I_GU) transpose_item(w_up + (size_t)e * D * DEXP, D, DEXP, WGU + (size_t)e * 1024 * D, 1, 2, scr, r - I_GU, lane);
            else transpose_item(w_down + (size_t)e * DEXP * D, DEXP, D, WD + (size_t)e * 1024 * DEXP, 0, 1, scr, r - 2 * I_GU, lane);
        }
    }
    SEAM(7);
    if (IN(8)) REP(8) { PHASE_IDS;
        build_tile_prefix(tb, CNT);
        for (int p = gw; p < 2 * M; p += NGW) { const int e = TOKE[p], slot = tb[e] * 256 + TOKR[p];
            if (lane == 0) TOKS[p] = slot;
            const GAS u32x4* src = (const GAS u32x4*)(H2 + (size_t)(p >> 1) * D) + lane; GAS u32x4* dst = (GAS u32x4*)(HGb + (size_t)slot * D) + lane;
            const u32x4 a = src[0], b = src[64]; dst[0] = a; dst[64] = b; }
    }
    SEAM(8);
    if (IN(9)) REP(9) {
        build_tile_prefix(tb, CNT);
        pg8::Gemm g{HGb, WGU, MAXSLOTS, NEXP * 1024, D}; MoeOrder S{tb, G, bx}; EpiSwiGlu E{HM};
        pg8::gemm_phase<EpiSwiGlu, MoeOrder, true, true>(lds, g, S, E);
    }
    SEAM(9);
    if (IN(10)) REP(10) {
        build_tile_prefix(tb, CNT);
        pg8::Gemm g{HM, WD, MAXSLOTS, NEXP * 1024, DEXP}; MoeOrder S{tb, G, bx}; EpiDown E{Y};
        pg8::gemm_phase<EpiDown, MoeOrder, true, true>(lds, g, S, E);
    }
    SEAM(10);
    if (IN(11)) { PHASE_IDS; for (int m = gw; m < M; m += NGW) final_row(out, Y, TOKS, TOKW, final_gain, m, lane); }
#undef IN
#undef SEAM
#undef x_in
#undef positions
#undef out
#undef Y
#undef HM
#undef CNT
}

extern "C" void kernel_launch(void* const* d_in, const int* in_sizes, int n_in, void* d_out, int out_size, void* d_ws, size_t ws_size, hipStream_t stream) {
    static int grid = 0;
    if (grid == 0) {
        if (n_in != 18 || in_sizes[0] != M * D || out_size != M * D || ws_size < WS_END) { fprintf(stderr, "kernel_launch: unexpected shapes (n_in %d, in0 %d, out %d, ws %zu)\n", n_in, n_in > 0 ? in_sizes[0] : -1, out_size, ws_size); grid = -1; return; }
        int dev = 0, cus = 0, per_cu = 0;
        if (hipGetDevice(&dev) != hipSuccess || hipDeviceGetAttribute(&cus, hipDeviceAttributeMultiprocessorCount, dev) != hipSuccess) { grid = -1; return; }
        if (hipFuncSetAttribute((const void*)mk_fwd, hipFuncAttributeMaxDynamicSharedMemorySize, LDS_BYTES) != hipSuccess) { fprintf(stderr, "kernel_launch: hipFuncSetAttribute failed\n"); grid = -1; return; }
        if (hipOccupancyMaxActiveBlocksPerMultiprocessor(&per_cu, (const void*)mk_fwd, NWAVES * 64, LDS_BYTES) != hipSuccess || per_cu < 1) { fprintf(stderr, "kernel_launch: occupancy query says %d\n", per_cu); (void)hipGetLastError(); grid = -1; return; }
        grid = cus;
    }
    if (grid < 0) return;
    if (hipMemsetAsync((char*)d_ws + WS_CTL, 0, CTL_ZERO_BYTES, stream) != hipSuccess) return;
    Args a{};
    for (int i = 0; i < 18; ++i) a.in[i] = d_in[i];
    a.out = (float*)d_out; a.ws = (unsigned char*)d_ws;
#if MK_N_LAUNCHES == 1
    a.ph_lo = 0; a.ph_hi = N_PHASES;
    hipLaunchKernelGGL(mk_fwd, dim3(grid), dim3(NWAVES * 64), LDS_BYTES, stream, a);
#else
    for (int p = 0; p < N_PHASES; ++p) { a.ph_lo = p; a.ph_hi = p + 1; hipLaunchKernelGGL(mk_fwd, dim3(grid), dim3(NWAVES * 64), LDS_BYTES, stream, a); }
#endif
}
```

```cpp
#include <hip/hip_runtime.h>
#include <cstdio>
#include <cstdint>
__device__ __forceinline__ int opaque_tid() { int t = threadIdx.x; asm volatile("" : "+v"(t)); return t; }
namespace pg8 {
#define PG8_LAS __attribute__((address_space(3)))
typedef unsigned short bf16_t;
typedef short bf16x8 __attribute__((ext_vector_type(8)));
typedef float f32x4 __attribute__((ext_vector_type(4)));
typedef unsigned u32x4 __attribute__((ext_vector_type(4)));
constexpr int BM = 256, BK = 64, HALF = 128, HTB = HALF * BK * 2  , STAGE_BYTES = 8 * HTB, NXCD = 8, WGM = 8;

__host__ __device__ __forceinline__ int lds_byte(int r, int c) { const int st = (r >> 4) * 2 + (c >> 5), rr = r & 15, cc = c & 31, ob = rr * 64 + cc * 2; return st * 1024 + (ob ^ (((ob >> 9) & 1) << 5)); }
__host__ __device__ __forceinline__ void stage_rc(int b, int& R, int& C) { const int st = b / 1024, sb = b % 1024, swz = sb ^ (((sb >> 9) & 1) << 5); R = (st >> 1) * 16 + swz / 64; C = (st & 1) * 32 + (swz % 64) / 2; }
__host__ __device__ __forceinline__ int perm32(int rho) { const int n = rho >> 4, i = rho & 15; return 8 * (i >> 2) + 4 * n + (i & 3); }

struct Unit { int pm, pn; };
struct Gemm { const bf16_t* A; const bf16_t* Bt; int M, N, K; };

struct StaticOrder {
    int nM, nN, nwg, G, c;
    __host__ __device__ void init(int M, int N, int G_, int c_) { nM = M / BM; nN = N / BM; nwg = nM * nN; G = G_; c = c_; }
    __host__ __device__ bool next(int i, Unit& u) const {
        const long L = (long)i * G + c; if (L >= nwg) return false;
        int wgid = (int)L; { const int q = nwg / NXCD, r = nwg % NXCD, xcd = wgid % NXCD, off = wgid / NXCD; wgid = (xcd < r ? xcd * (q + 1) : r * (q + 1) + (xcd - r) * q) + off; }
        const int nig = WGM * nN, gid = wgid / nig, fm = gid * WGM, gsz = (nM - fm) < WGM ? (nM - fm) : WGM;
        u.pm = fm + ((wgid % nig) % gsz); u.pn = (wgid % nig) / gsz; return true;
    }
    __device__ __forceinline__ bool half_only(const Unit&) const { return false; }
    __device__ __forceinline__ void a_ready(const Unit&) const {}
    __device__ __forceinline__ void done(const Unit&) const {}
};

template <class Epi, class Sched, bool ALIGN_EPI = false, bool SP2 = false>
__device__ __forceinline__ void gemm_phase(PG8_LAS unsigned char* lds, const Gemm g, const Sched& S, const Epi& E) {
    const int tid = opaque_tid(), wid = __builtin_amdgcn_readfirstlane(tid >> 6), lane = tid & 63, wr = wid >> 2, wc = wid & 3, fr = lane & 15, fq = lane >> 4;
    const int K = g.K, nt = K / BK;
    unsigned voffA[2], voffB[2];
#pragma unroll
    for (int i = 0; i < 2; ++i) { int R, C; stage_rc(tid * 16 + i * 8192, R, C); const int Rb = Epi::PERM ? ((R & ~31) + perm32(R & 31)) : R;
        voffA[i] = (unsigned)(R * K + C) * 2u; voffB[i] = (unsigned)(Rb * K + C) * 2u; }
    const size_t kstep = (size_t)(BK * 2);
    const size_t hstep = (size_t)HALF * K * 2;
    const size_t tstep = 2 * hstep;
    const unsigned ldsw = (unsigned)wid * 1024u;
    const int aoff = lds_byte(wr * 64 + fr, fq * 8), boff = lds_byte(wc * 32 + fr, fq * 8);
#define PG8_SA(b, h) (((b) * 2 + (h)) * HTB)
#define PG8_SB(b, h) ((4 + (b) * 2 + (h)) * HTB)
#define PG8_STAGE(bufoff, gbase, voff) do { _Pragma("unroll") for (int _i = 0; _i < 2; ++_i) \
        __builtin_amdgcn_global_load_lds((const unsigned*)((const char*)(gbase) + (voff)[_i]), (PG8_LAS unsigned*)(lds + (bufoff) + ldsw + _i * 8192), 16, 0, 0); } while (0)
#define PG8_LDA(dst, b, h) do { _Pragma("unroll") for (int m = 0; m < 4; ++m) _Pragma("unroll") for (int k = 0; k < 2; ++k) dst[m][k] = *(const PG8_LAS bf16x8*)(lds + PG8_SA(b, h) + aoff + m * 2048 + k * 1024); } while (0)
#define PG8_LDB(dst, b, h) do { _Pragma("unroll") for (int n = 0; n < 2; ++n) _Pragma("unroll") for (int k = 0; k < 2; ++k) dst[n][k] = *(const PG8_LAS bf16x8*)(lds + PG8_SB(b, h) + boff + n * 2048 + k * 1024); } while (0)
#define PG8_MMA(ai, bj, At, Bt) do { __builtin_amdgcn_s_setprio(1); _Pragma("unroll") for (int m = 0; m < 4; ++m) _Pragma("unroll") for (int n = 0; n < 2; ++n) _Pragma("unroll") for (int k = 0; k < 2; ++k) \
        acc[ai][bj][m][n] = __builtin_amdgcn_mfma_f32_16x16x32_bf16(Bt[n][k], At[m][k], acc[ai][bj][m][n], 0, 0, 0); __builtin_amdgcn_s_setprio(0); } while (0)
#define PG8_WAIT_V(n) asm volatile("s_waitcnt vmcnt(" #n ")" ::: "memory")
#define PG8_WAIT_L(n) asm volatile("s_waitcnt lgkmcnt(" #n ")" ::: "memory")
#define PG8_BAR __builtin_amdgcn_s_barrier()
#define PG8_SCHED __builtin_amdgcn_sched_barrier(0)
    Unit cur, nxt; int ui = 0;
    if (!S.next(0, cur)) return;
    f32x4 acc[2][2][4][2];
#pragma unroll
    for (int a = 0; a < 2; ++a)
#pragma unroll
        for (int b = 0; b < 2; ++b)
#pragma unroll
            for (int m = 0; m < 4; ++m)
#pragma unroll
                for (int n = 0; n < 2; ++n) acc[a][b][m][n] = (f32x4){0.f, 0.f, 0.f, 0.f};
    bf16x8 At[4][2], B0[2][2], B1[2][2];
    const char* cA = (const char*)g.A + (size_t)cur.pm * tstep; const char* cB = (const char*)g.Bt + (size_t)cur.pn * tstep;
    S.a_ready(cur);
    if constexpr (SP2) {
        PG8_STAGE(PG8_SB(0, 0), cB, voffB); PG8_STAGE(PG8_SB(0, 1), cB + hstep, voffB); PG8_STAGE(PG8_SA(0, 0), cA, voffA); PG8_STAGE(PG8_SA(0, 1), cA + hstep, voffA);
        if (wr == 1) PG8_BAR;
        PG8_WAIT_V(2); PG8_BAR;
        PG8_STAGE(PG8_SB(1, 0), cB + kstep, voffB); PG8_STAGE(PG8_SA(1, 0), cA + kstep, voffA); PG8_STAGE(PG8_SB(1, 1), cB + hstep + kstep, voffB);
        PG8_WAIT_V(6); PG8_BAR;
    } else {
        PG8_STAGE(PG8_SB(0, 0), cB, voffB); PG8_STAGE(PG8_SA(0, 0), cA, voffA); PG8_STAGE(PG8_SB(0, 1), cB + hstep, voffB); PG8_STAGE(PG8_SA(0, 1), cA + hstep, voffA);
        if (wr == 1) PG8_BAR;
        PG8_WAIT_V(4); PG8_BAR;
        PG8_STAGE(PG8_SB(1, 0), cB + kstep, voffB); PG8_STAGE(PG8_SA(1, 0), cA + kstep, voffA); PG8_STAGE(PG8_SB(1, 1), cB + hstep + kstep, voffB);
        PG8_WAIT_V(6); PG8_BAR;
    }
    for (;;) {
        const bool has_next = S.next(ui + 1, nxt);
        const char* nA = has_next ? (const char*)g.A + (size_t)nxt.pm * tstep : cA; const char* nB = has_next ? (const char*)g.Bt + (size_t)nxt.pn * tstep : cB;
        for (int t = 0; t < nt; t += 2) {
            const bool last = (t == nt - 2);
            const char* a1 = cA + (size_t)(t + 1) * kstep;
            const char* a2 = last ? nA : cA + (size_t)(t + 2) * kstep; const char* b2 = last ? nB : cB + (size_t)(t + 2) * kstep;
            const char* a3 = a2 + kstep; const char* b3 = b2 + kstep;
            if (last && has_next) S.a_ready(nxt);
            if constexpr (SP2) {
            PG8_LDB(B0, 0, 0); PG8_LDB(B1, 0, 1); PG8_SCHED; PG8_LDA(At, 0, 0); PG8_STAGE(PG8_SA(1, 1), a1 + hstep, voffA);
            PG8_WAIT_V(8); PG8_WAIT_L(0); PG8_BAR; PG8_MMA(0, 0, At, B0); PG8_MMA(0, 1, At, B1); PG8_BAR; PG8_SCHED;
            PG8_LDA(At, 0, 1); PG8_STAGE(PG8_SB(0, 0), b2, voffB); PG8_STAGE(PG8_SB(0, 1), b2 + hstep, voffB); PG8_STAGE(PG8_SA(0, 0), a2, voffA);
            PG8_WAIT_V(8); PG8_WAIT_L(0); PG8_BAR; PG8_MMA(1, 0, At, B0); PG8_MMA(1, 1, At, B1); PG8_BAR; PG8_SCHED;
            PG8_LDB(B0, 1, 0); PG8_LDB(B1, 1, 1); PG8_SCHED; PG8_LDA(At, 1, 0); PG8_STAGE(PG8_SA(0, 1), a2 + hstep, voffA);
            PG8_WAIT_V(8); PG8_WAIT_L(0); PG8_BAR; PG8_MMA(0, 0, At, B0); PG8_MMA(0, 1, At, B1); PG8_BAR; PG8_SCHED;
            PG8_LDA(At, 1, 1); PG8_STAGE(PG8_SB(1, 0), b3, voffB); PG8_STAGE(PG8_SB(1, 1), b3 + hstep, voffB); PG8_STAGE(PG8_SA(1, 0), a3, voffA);
            PG8_WAIT_V(8); PG8_WAIT_L(0); PG8_BAR; PG8_MMA(1, 0, At, B0); PG8_MMA(1, 1, At, B1); PG8_BAR; PG8_SCHED;
            } else {
            PG8_LDB(B0, 0, 0); PG8_SCHED; PG8_LDA(At, 0, 0); PG8_STAGE(PG8_SA(1, 1), a1 + hstep, voffA);
            PG8_WAIT_L(8); PG8_BAR; PG8_WAIT_L(0); PG8_MMA(0, 0, At, B0); PG8_BAR; PG8_SCHED;
            PG8_LDB(B1, 0, 1); PG8_STAGE(PG8_SB(0, 0), b2, voffB);
            PG8_BAR; PG8_WAIT_L(0); PG8_MMA(0, 1, At, B1); PG8_BAR;
            PG8_LDA(At, 0, 1); PG8_STAGE(PG8_SA(0, 0), a2, voffA);
            PG8_BAR; PG8_WAIT_L(0); PG8_MMA(1, 0, At, B0); PG8_BAR; PG8_SCHED;
            PG8_STAGE(PG8_SB(0, 1), b2 + hstep, voffB);
            PG8_WAIT_V(6); PG8_BAR; PG8_MMA(1, 1, At, B1); PG8_BAR;
            PG8_LDB(B0, 1, 0); PG8_SCHED; PG8_LDA(At, 1, 0); PG8_STAGE(PG8_SA(0, 1), a2 + hstep, voffA);
            PG8_WAIT_L(8); PG8_BAR; PG8_WAIT_L(0); PG8_MMA(0, 0, At, B0); PG8_BAR; PG8_SCHED;
            PG8_LDB(B1, 1, 1); PG8_STAGE(PG8_SB(1, 0), b3, voffB);
            PG8_BAR; PG8_WAIT_L(0); PG8_MMA(0, 1, At, B1); PG8_BAR;
            PG8_LDA(At, 1, 1); PG8_STAGE(PG8_SA(1, 0), a3, voffA);
            PG8_BAR; PG8_WAIT_L(0); PG8_MMA(1, 0, At, B0); PG8_BAR; PG8_SCHED;
            PG8_STAGE(PG8_SB(1, 1), b3 + hstep, voffB);
            PG8_WAIT_V(6); PG8_BAR; PG8_MMA(1, 1, At, B1); PG8_BAR;
            }
        }
        if constexpr (ALIGN_EPI) { if (wr == 0) PG8_BAR; }
        if constexpr (!Epi::AFTER_DRAIN) { E(acc, cur, wr, wc, fr, fq); S.done(cur); }
        if (!has_next) break;
#pragma unroll
        for (int a = 0; a < 2; ++a)
#pragma unroll
            for (int b = 0; b < 2; ++b)
#pragma unroll
                for (int m = 0; m < 4; ++m)
#pragma unroll
                    for (int n = 0; n < 2; ++n) acc[a][b][m][n] = (f32x4){0.f, 0.f, 0.f, 0.f};
        cur = nxt; cA = nA; cB = nB; ++ui;
        if constexpr (ALIGN_EPI) { if (wr == 1) PG8_BAR; }
    }
    PG8_WAIT_V(0);
    if constexpr (!ALIGN_EPI) { if (wr == 0) PG8_BAR; }
    PG8_BAR;
    if constexpr (Epi::AFTER_DRAIN) { E.fused(acc, cur, wr, wc, fr, fq, lds, wid, lane); S.done(cur); }
#undef PG8_SA
#undef PG8_SB
#undef PG8_STAGE
#undef PG8_LDA
#undef PG8_LDB
#undef PG8_MMA
#undef PG8_WAIT_V
#undef PG8_WAIT_L
#undef PG8_BAR
#undef PG8_SCHED
}
}

constexpr int NWAVES = 8;
constexpr int M = 16384, D = 1024, NIN = 4096, HSEC = 512;
constexpr int NEXP = 32, DEXP = 512, MAXTILES = 160, MAXSLOTS = MAXTILES * 256;
constexpr float QSCALE = 0.18033688011112042f;

constexpr size_t MiB = 1u << 20;
constexpr size_t WS_CTL = 0, CTL_ZERO_BYTES = 1 * MiB;
constexpr size_t WS_WR = 1 * MiB;
constexpr size_t WS_ROPE = 2 * MiB;
constexpr size_t WS_HD = 3 * MiB;
constexpr size_t WS_TOKE = 3 * MiB + 256 * 1024, WS_TOKW = WS_TOKE + 128 * 1024, WS_TOKR = WS_TOKW + 128 * 1024, WS_TOKS = WS_TOKR + 128 * 1024, WS_LAM = WS_TOKS + 128 * 1024, WS_GCNT = WS_LAM + 128 * 1024, WS_RSTD = 1 * MiB + 256 * 1024, WS_RSLOT = 1 * MiB + 768 * 1024, WS_PERM = 1 * MiB + 512 * 1024;
constexpr size_t WS_WOUT = 4 * MiB, WS_WIN = 6 * MiB;
constexpr size_t WS_XN = 16 * MiB;
constexpr size_t WS_OF = 16 * MiB;
constexpr size_t WS_X2B = 16 * MiB;
constexpr size_t WS_HM = 144 * MiB;
constexpr size_t WS_QH = 48 * MiB, WS_VH = 64 * MiB, WS_SG = 80 * MiB, WS_QD = 96 * MiB, WS_KD = 112 * MiB, WS_VD = 128 * MiB;
constexpr size_t WS_WGU = 48 * MiB, WS_WD = 216 * MiB;
constexpr size_t WS_GF = 144 * MiB, WS_GB = 176 * MiB;
constexpr size_t WS_MIX = 144 * MiB;
constexpr size_t WS_HS = 208 * MiB, WS_HL = 224 * MiB;
constexpr size_t WS_OB = 224 * MiB;
constexpr size_t WS_HG = 176 * MiB;
constexpr size_t WS_O0S = 176 * MiB;
constexpr size_t WS_Y = 48 * MiB;
constexpr size_t WS_END = 256 * MiB;
static_assert(WS_Y + (size_t)MAXSLOTS * 1024 * 2 <= WS_HM && WS_HM + (size_t)MAXSLOTS * 512 * 2 <= WS_WD && WS_WD + 32 * MiB <= WS_END, "ws map");
constexpr int CW_BAR = 4096, CW_CNT = 16384, CW_KMAX = 20480, CW_QWD = 21504, CW_READY = 32768, CNT_STRIDE = 64;

constexpr int PHASE_LDS = 147456, MISC_OFF = PHASE_LDS, LDS_BYTES = PHASE_LDS + 1024;

#define GAS __attribute__((address_space(1)))
#define LAS __attribute__((address_space(3)))
typedef unsigned short bf16_t;
typedef _Float16 half_t;
typedef float f32x4 __attribute__((ext_vector_type(4)));
typedef float f32x16 __attribute__((ext_vector_type(16)));
typedef short bf16x8 __attribute__((ext_vector_type(8)));
typedef short s16x4 __attribute__((ext_vector_type(4)));
typedef unsigned u32x4 __attribute__((ext_vector_type(4)));
typedef unsigned u32x2 __attribute__((ext_vector_type(2)));
#define LDS_WAIT() asm volatile("s_waitcnt lgkmcnt(0)" ::: "memory")
#define VM_WAIT() asm volatile("s_waitcnt vmcnt(0)" ::: "memory")
#define SBAR() __builtin_amdgcn_sched_barrier(0)
__device__ __forceinline__ unsigned f2bf(float f) { unsigned u = __builtin_bit_cast(unsigned, f); return (u + 0x7fffu + ((u >> 16) & 1u)) >> 16; }
__device__ __forceinline__ unsigned pk2(float lo, float hi) { return f2bf(lo) | (f2bf(hi) << 16); }
__device__ __forceinline__ float bf2f(unsigned b) { return __builtin_bit_cast(float, b << 16); }
__device__ __forceinline__ float bflo(unsigned w) { return __builtin_bit_cast(float, w << 16); }
__device__ __forceinline__ float bfhi(unsigned w) { return __builtin_bit_cast(float, w & 0xffff0000u); }
__device__ __forceinline__ unsigned cvtpk(float lo, float hi) { unsigned r; asm volatile("v_cvt_pk_bf16_f32 %0, %1, %2" : "=v"(r) : "v"(lo), "v"(hi)); return r; }
__device__ __forceinline__ float ex2(float x) { return __builtin_amdgcn_exp2f(x); }
__device__ __forceinline__ float lg2(float x) { return __builtin_amdgcn_logf(x); }
__device__ __forceinline__ float sigmoidf_(float v) { return __builtin_amdgcn_rcpf(1.f + ex2(-1.4426950408889634f * v)); }
__device__ __forceinline__ bool lane_is_hi() { return (opaque_tid() & 32) != 0; }
template <int X> __device__ __forceinline__ float lane_xor(float v) {
    if constexpr (X == 32) { auto rr = __builtin_amdgcn_permlane32_swap(__float_as_uint(v), __float_as_uint(v), false, false); return __uint_as_float(lane_is_hi() ? rr[0] : rr[1]); }
    else return __int_as_float(__builtin_amdgcn_ds_swizzle(__float_as_int(v), (X << 10) | 0x1F));
}
__device__ __forceinline__ float wave_sum(float v) {
    v += lane_xor<1>(v); v += lane_xor<2>(v); v += lane_xor<4>(v); v += lane_xor<8>(v); v += lane_xor<16>(v);
    auto rr = __builtin_amdgcn_permlane32_swap(__float_as_uint(v), __float_as_uint(v), false, false);
    return __uint_as_float(rr[0]) + __uint_as_float(rr[1]);
}
__device__ __forceinline__ int crow(int r, int hi) { return (r & 3) + 8 * (r >> 2) + 4 * hi; }
#define XB_TMO      128
#define XB_XCNT(j)  (256  + 64 * (j))
#define XB_XSUB(j)  (1280 + 64 * (j))
#define XB_XGEN(j)  (2304 + 64 * (j))
#define XB_TOP      3328
#define XB_TOPGEN   3392
#define XCD_BAR_WORDS 3456
#define XB_SPIN_CAP (1u << 18)

__device__ __forceinline__ unsigned xb_ld(unsigned* p)              { return __hip_atomic_load(p, __ATOMIC_RELAXED, __HIP_MEMORY_SCOPE_AGENT); }
__device__ __forceinline__ unsigned xb_add(unsigned* p, unsigned v) { return __hip_atomic_fetch_add(p, v, __ATOMIC_RELAXED, __HIP_MEMORY_SCOPE_AGENT); }
__device__ __forceinline__ unsigned xb_xcc_id() { return (unsigned)__builtin_amdgcn_s_getreg((3 << 11) | 20) & 0xFu; }
#define XB_SPIN(cond, bar) do { unsigned _sp = 0; while (cond) { __builtin_amdgcn_s_sleep(1); \
    if ((++_sp & 255u) == 0u) { if (xb_ld(&(bar)[XB_TMO])) break; if (_sp > XB_SPIN_CAP) { atomicAdd(&(bar)[XB_TMO], 1u); break; } } } } while (0)

struct XcdBarrier {
    unsigned* bar; unsigned x;
    volatile LAS unsigned* st;
};

__device__ __forceinline__ XcdBarrier xcd_barrier_post(unsigned* bar, volatile LAS unsigned* st) {
    XcdBarrier b; b.bar = bar; b.x = xb_xcc_id(); b.st = st;
    if (threadIdx.x == 0) (void)xb_add(&bar[XB_XCNT(b.x)], 1u);
    return b;
}
__device__ __forceinline__ void xcd_barrier_complete(unsigned* bar, unsigned x, unsigned& nloc, unsigned& nx) {
    const unsigned G = gridDim.x * gridDim.y * gridDim.z;
    unsigned sum, cnt, mine, sp = 0u;
    for (;;) {
        sum = 0u; cnt = 0u; mine = 0u;
#pragma unroll
        for (unsigned j = 0; j < 16; ++j) { const unsigned c = xb_ld(&bar[XB_XCNT(j)]); sum += c; cnt += (c > 0u) ? 1u : 0u; mine = (j == x) ? c : mine; }
        if (sum == G) break;
        __builtin_amdgcn_s_sleep(1);
        if ((++sp & 255u) == 0u) { if (xb_ld(&bar[XB_TMO])) break; if (sp > XB_SPIN_CAP) { atomicAdd(&bar[XB_TMO], 1u); break; } }
    }
    nloc = mine > 0u ? mine : 1u; nx = cnt > 0u ? cnt : 1u;
}

__device__ __forceinline__ void xcd_barrier(const XcdBarrier& b) {
    asm volatile("s_waitcnt vmcnt(0)" ::: "memory");
    __syncthreads();
    if (threadIdx.x == 0) {
        unsigned* bar = b.bar;
        __builtin_amdgcn_s_waitcnt(0);
        unsigned nloc = b.st[0], nx = b.st[1];
        if (nloc == 0u) { xcd_barrier_complete(bar, b.x, nloc, nx); b.st[0] = nloc; b.st[1] = nx; }
        const unsigned old = xb_add(&bar[XB_XSUB(b.x)], 1u);
        const unsigned gen = old / nloc;
        if (old + 1u == (gen + 1u) * nloc) {
            __builtin_amdgcn_fence(__ATOMIC_RELEASE, "agent");
            asm volatile("s_waitcnt vmcnt(0)" ::: "memory");
            const unsigned og = xb_add(&bar[XB_TOP], 1u);
            const unsigned tg = og / nx;
            if (og + 1u == (tg + 1u) * nx) xb_add(&bar[XB_TOPGEN], 1u);
            else XB_SPIN(xb_ld(&bar[XB_TOPGEN]) == tg, bar);
            __builtin_amdgcn_fence(__ATOMIC_ACQUIRE, "agent");
            xb_add(&bar[XB_XGEN(b.x)], 1u);
            asm volatile("s_waitcnt vmcnt(0)" ::: "memory");
        } else {
            XB_SPIN(xb_ld(&bar[XB_XGEN(b.x)]) == gen, bar);
            __builtin_amdgcn_fence(__ATOMIC_ACQUIRE, "agent");
            asm volatile("s_waitcnt vmcnt(0)" ::: "memory");
        }
    }
    __syncthreads();
}

struct XposeRegs { f32x4 v[8]; };
__device__ __forceinline__ void xpose_load(XposeRegs& R, const float* W, int K, int N, int item, int lane) {
    const int nblk = N / 32, kb = item / nblk, nb = item % nblk, k0 = 64 * kb, n0 = 32 * nb; (void)K;
    const float* p = W + (size_t)(k0 + (lane >> 3)) * N + n0 + (lane & 7) * 4;
#pragma unroll
    for (int i = 0; i < 8; ++i) R.v[i] = __builtin_nontemporal_load((const GAS f32x4*)(p + (size_t)(8 * i) * N));
}
__device__ __forceinline__ void xpose_store(const XposeRegs& R, int K, int N, bf16_t* WT, int row_off, int row_mul, LAS float* scr, int item, int lane, const float* kgain = nullptr) {
    const int nblk = N / 32, kb = item / nblk, nb = item % nblk, k0 = 64 * kb, n0 = 32 * nb;
#pragma unroll
    for (int i = 0; i < 8; ++i) { LAS float* d = scr + (8 * i + (lane >> 3)) * 33 + (lane & 7) * 4; d[0] = R.v[i].x; d[1] = R.v[i].y; d[2] = R.v[i].z; d[3] = R.v[i].w; }
    LDS_WAIT(); asm volatile("" ::: "memory");
    const int c = lane & 7;
    f32x4 g0 = {1.f, 1.f, 1.f, 1.f}, g1 = g0;
    if (kgain) { g0 = *(const GAS f32x4*)(kgain + k0 + 8 * c); g1 = *(const GAS f32x4*)(kgain + k0 + 8 * c + 4); }
#pragma unroll
    for (int j = 0; j < 4; ++j) { const int n = (lane >> 3) + 8 * j; const LAS float* s = scr + (8 * c) * 33 + n;
        u32x4 o; o.x = cvtpk(s[0 * 33] * g0.x, s[1 * 33] * g0.y); o.y = cvtpk(s[2 * 33] * g0.z, s[3 * 33] * g0.w); o.z = cvtpk(s[4 * 33] * g1.x, s[5 * 33] * g1.y); o.w = cvtpk(s[6 * 33] * g1.z, s[7 * 33] * g1.w);
        *(GAS u32x4*)(WT + (size_t)(row_off + (n0 + n) * row_mul) * K + k0 + 8 * c) = o; }
    LDS_WAIT(); asm volatile("" ::: "memory");
}
template <int NR>
__device__ __forceinline__ void rms_rows_to_bf16(const float* X, const float* gain, bf16_t* O, int m0, int stride, int lane, float eps) {
    f32x4 v[NR][4]; float s[NR];
#pragma unroll
    for (int i = 0; i < NR; ++i) { const GAS f32x4* xr = (const GAS f32x4*)(X + (size_t)(m0 + i * stride) * D) + lane;
#pragma unroll
        for (int j = 0; j < 4; ++j) v[i][j] = xr[64 * j]; }
#pragma unroll
    for (int i = 0; i < NR; ++i) { float t = 0.f;
#pragma unroll
        for (int j = 0; j < 4; ++j) t += (v[i][j].x * v[i][j].x + v[i][j].y * v[i][j].y) + (v[i][j].z * v[i][j].z + v[i][j].w * v[i][j].w);
        s[i] = t; }
#pragma unroll
    for (int i = 0; i < NR; ++i) s[i] = 1.f / sqrtf(wave_sum(s[i]) * (1.f / 1024.f) + eps);
#pragma unroll
    for (int j = 0; j < 4; ++j) { const f32x4 g = ((const GAS f32x4*)gain)[64 * j + lane];
#pragma unroll
        for (int i = 0; i < NR; ++i) { u32x2 w; w.x = cvtpk(v[i][j].x * s[i] * g.x, v[i][j].y * s[i] * g.y); w.y = cvtpk(v[i][j].z * s[i] * g.z, v[i][j].w * s[i] * g.w);
            ((GAS u32x2*)(O + (size_t)(m0 + i * stride) * D) + lane)[64 * j] = w; } }
}

struct EpiInProj {
    static constexpr bool PERM = true, AFTER_DRAIN = false;
    bf16_t *QH, *VH, *SG, *QD, *KD, *VD; half_t *GF, *GB; const float* lbraw; const float *cosT, *sinT;
    __device__ __forceinline__ void operator()(const pg8::f32x4 (&acc)[2][2][4][2], const pg8::Unit& u, int wr, int wc, int fr, int fq) const {
        const int sec = u.pn >> 1;
        const int row0 = u.pm * 256 + wr * 64 + fr;
        const int cs0 = (u.pn & 1) * 256 + wc * 32 + 8 * fq;
        if (sec == 1 || sec == 2) {
            half_t* G = sec == 1 ? GF : GB; const float* lbp = lbraw + (sec - 1) * 1024;
#pragma unroll
            for (int bj = 0; bj < 2; ++bj) { const int c = cs0 + bj * 128; float lb[8];
#pragma unroll
                for (int j = 0; j < 8; ++j) { const float l0 = lbp[c + j], l1 = lbp[512 + c + j]; lb[j] = __builtin_amdgcn_rcpf(1.f + ex2(1.4426950408889634f * (l0 - l1))); }
#pragma unroll
                for (int ai = 0; ai < 2; ++ai)
#pragma unroll
                    for (int m = 0; m < 4; ++m) { const int row = row0 + ai * 128 + m * 16; f32x4 o0, o1;
#pragma unroll
                        for (int j = 0; j < 4; ++j) { o0[j] = lb[j] + (1.f - lb[j]) * sigmoidf_(acc[ai][bj][m][0][j]); o1[j] = lb[4 + j] + (1.f - lb[4 + j]) * sigmoidf_(acc[ai][bj][m][1][j]); }
                        typedef _Float16 h8 __attribute__((ext_vector_type(8)));
                        const h8 hv = {(_Float16)o0[0], (_Float16)o0[1], (_Float16)o0[2], (_Float16)o0[3], (_Float16)o1[0], (_Float16)o1[1], (_Float16)o1[2], (_Float16)o1[3]};
                        *(h8*)(G + (size_t)row * HSEC + c) = hv; } }
            return;
        }
        bf16_t* O = sec == 0 ? QH : sec == 3 ? VH : sec == 4 ? SG : sec == 5 ? QD : sec == 6 ? KD : VD;
        const bool rot = (sec == 5 || sec == 6) && ((wc & 1) == 0);
        const float sc = sec == 5 ? QSCALE : 1.f;
#pragma unroll
        for (int ai = 0; ai < 2; ++ai)
#pragma unroll
            for (int m = 0; m < 4; ++m) { const int row = row0 + ai * 128 + m * 16;
#pragma unroll
                for (int bj = 0; bj < 2; ++bj) { const int c = cs0 + bj * 128; float v[8];
#pragma unroll
                    for (int j = 0; j < 4; ++j) { v[j] = acc[ai][bj][m][0][j]; v[4 + j] = acc[ai][bj][m][1][j]; }
                    if (sec == 4) {
#pragma unroll
                        for (int j = 0; j < 8; ++j) v[j] = v[j] * sigmoidf_(v[j]);
                    }
                    if (rot) {
                        const f32x4 c0 = *(const f32x4*)(cosT + (size_t)row * 8), c1 = *(const f32x4*)(cosT + (size_t)row * 8 + 4);
                        const f32x4 s0 = *(const f32x4*)(sinT + (size_t)row * 8), s1 = *(const f32x4*)(sinT + (size_t)row * 8 + 4);
#pragma unroll
                        for (int j = 0; j < 8; ++j) { const float p = lane_xor<16>(v[j]); const float cj = j < 4 ? c0[j & 3] : c1[j & 3], sj = j < 4 ? s0[j & 3] : s1[j & 3];
                            const float r = fq == 0 ? v[j] * cj - p * sj : v[j] * cj + p * sj; v[j] = fq < 2 ? r : v[j]; }
                    }
                    u32x4 w; w.x = cvtpk(v[0] * sc, v[1] * sc); w.y = cvtpk(v[2] * sc, v[3] * sc); w.z = cvtpk(v[4] * sc, v[5] * sc); w.w = cvtpk(v[6] * sc, v[7] * sc);
                    *(u32x4*)(O + (size_t)row * HSEC + c) = w; } }
    }
};
struct EpiResid {
    static constexpr bool PERM = true, AFTER_DRAIN = false;
    const float* X; bf16_t* O;
    __device__ __forceinline__ void operator()(const pg8::f32x4 (&acc)[2][2][4][2], const pg8::Unit& u, int wr, int wc, int fr, int fq) const {
        const int row0 = u.pm * 256 + wr * 64 + fr, col0 = u.pn * 256 + wc * 32 + 8 * fq;
#pragma unroll
        for (int ai = 0; ai < 2; ++ai)
#pragma unroll
            for (int m = 0; m < 4; ++m) { const size_t off = (size_t)(row0 + ai * 128 + m * 16) * D + col0;
#pragma unroll
                for (int bj = 0; bj < 2; ++bj) { const f32x4 a = *(const f32x4*)(X + off + bj * 128) + acc[ai][bj][m][0], b = *(const f32x4*)(X + off + bj * 128 + 4) + acc[ai][bj][m][1];
                    u32x4 w; w.x = cvtpk(a[0], a[1]); w.y = cvtpk(a[2], a[3]); w.z = cvtpk(b[0], b[1]); w.w = cvtpk(b[2], b[3]); *(u32x4*)(O + off + bj * 128) = w; } }
    }
};
struct EpiSwiGlu {
    static constexpr bool PERM = true, AFTER_DRAIN = false;
    bf16_t* O; const float* RS;
    __device__ __forceinline__ void operator()(const pg8::f32x4 (&acc)[2][2][4][2], const pg8::Unit& u, int wr, int wc, int fr, int fq) const {
        const int row0 = u.pm * 256 + wr * 64 + fr, col0 = ((u.pn & 3) * 256 + wc * 32 + 8 * fq) >> 1;
#pragma unroll
        for (int ai = 0; ai < 2; ++ai)
#pragma unroll
            for (int m = 0; m < 4; ++m) { const int row = row0 + ai * 128 + m * 16; const float rs = RS[row]; bf16_t* rowp = O + (size_t)row * DEXP + col0;
#pragma unroll
                for (int bj = 0; bj < 2; ++bj) { const f32x4 a = acc[ai][bj][m][0] * rs, b = acc[ai][bj][m][1] * rs;
                    const float h0 = a[0] * sigmoidf_(a[0]) * a[1], h1 = a[2] * sigmoidf_(a[2]) * a[3], h2 = b[0] * sigmoidf_(b[0]) * b[1], h3 = b[2] * sigmoidf_(b[2]) * b[3];
                    u32x2 w; w.x = cvtpk(h0, h1); w.y = cvtpk(h2, h3); *(u32x2*)(rowp + bj * 64) = w; } }
    }
};
struct EpiDown {
    static constexpr bool PERM = true, AFTER_DRAIN = false;
    bf16_t* O;
    __device__ __forceinline__ void operator()(const pg8::f32x4 (&acc)[2][2][4][2], const pg8::Unit& u, int wr, int wc, int fr, int fq) const {
        const int row0 = u.pm * 256 + wr * 64 + fr, col0 = (u.pn & 3) * 256 + wc * 32 + 8 * fq;
#pragma unroll
        for (int ai = 0; ai < 2; ++ai)
#pragma unroll
            for (int m = 0; m < 4; ++m) { bf16_t* rowp = O + (size_t)(row0 + ai * 128 + m * 16) * D + col0;
#pragma unroll
                for (int bj = 0; bj < 2; ++bj) { const f32x4 a = acc[ai][bj][m][0], b = acc[ai][bj][m][1];
                    u32x4 w; w.x = cvtpk(a[0], a[1]); w.y = cvtpk(a[2], a[3]); w.z = cvtpk(b[0], b[1]); w.w = cvtpk(b[2], b[3]); *(u32x4*)(rowp + bj * 128) = w; } }
    }
};
struct MoeOrder {
    const volatile LAS int* tb; int G, c; const int* PERM; unsigned* ready; int mode;
    __device__ __forceinline__ bool decode(int L, pg8::Unit& u) const {
        const int x = c & 7; int base = 0;
#pragma unroll 1
        for (int k = 0; k < 4; ++k) { const int e = 4 * x + k, t0 = __builtin_amdgcn_readfirstlane(tb[e]), nt = __builtin_amdgcn_readfirstlane(tb[e + 1]) - t0;
            if (L < base + 4 * nt) { const int idx = L - base; u.pm = t0 + idx % nt; u.pn = e * 4 + idx / nt; return true; }
            base += 4 * nt; }
        return false;
    }
    __device__ __forceinline__ bool next(int i, pg8::Unit& u) const {
        if ((G & 7) == 0) {
            const int x = c & 7, s = c >> 3, nb = G >> 3;
            const int U = 4 * (__builtin_amdgcn_readfirstlane(tb[4 * x + 4]) - __builtin_amdgcn_readfirstlane(tb[4 * x]));
            if (mode == 0) return decode(i * nb + s, u);
            const int i0 = s < U ? (U - s + nb - 1) / nb : 0;
            return decode((i0 + i) * nb + s - U, u);
        }
        const int L = i * G + c, T = __builtin_amdgcn_readfirstlane(tb[32]); if (L >= 4 * T) return false;
        const int tile = L >> 2; int e = 0;
#pragma unroll 1
        for (int j = 1; j < 32; ++j) e += (__builtin_amdgcn_readfirstlane(tb[j]) <= tile) ? 1 : 0;
        u.pm = tile; u.pn = e * 4 + (L & 3); return true;
    }
    __device__ __forceinline__ int row_tok(const pg8::Unit& u, int r) const {
        const int e = u.pn >> 2, rem = __builtin_amdgcn_readfirstlane(tb[64 + e]) - (u.pm - __builtin_amdgcn_readfirstlane(tb[e])) * 256;
        return r < rem ? PERM[u.pm * 256 + r] : 0;
    }
    __device__ __forceinline__ bool half_only(const pg8::Unit&) const { return false; }
    __device__ __forceinline__ void done(const pg8::Unit& u) const {
        if (mode == 2) { asm volatile("s_waitcnt vmcnt(0)" ::: "memory");
            if ((threadIdx.x & 63) == 0) __hip_atomic_fetch_add(ready + 64 * u.pm, 1u, __ATOMIC_RELAXED, __HIP_MEMORY_SCOPE_AGENT); }
    }
    __device__ __forceinline__ void a_ready(const pg8::Unit& u) const {
        if (mode == 1) {
            if (threadIdx.x < 64) { const unsigned long long t0 = __builtin_amdgcn_s_memrealtime();
                while ((unsigned)__builtin_amdgcn_readfirstlane(__hip_atomic_load(ready + 64 * u.pm, __ATOMIC_RELAXED, __HIP_MEMORY_SCOPE_AGENT)) < 32u) {
                    if (__builtin_amdgcn_s_memrealtime() - t0 > 2000000ull) break;
                    __builtin_amdgcn_s_sleep(2); }
                __builtin_amdgcn_fence(__ATOMIC_ACQUIRE, "agent");
                asm volatile("s_waitcnt vmcnt(0)" ::: "memory"); }
            asm volatile("" ::: "memory"); __builtin_amdgcn_s_barrier(); asm volatile("" ::: "memory");
        }
    }
};
namespace pg8 {
template <class Epi, class Sched, bool ALIGN_EPI = false, bool SP2 = false>
__device__ __forceinline__ void gemm_phase_g(PG8_LAS unsigned char* lds, const Gemm g, const Sched& S, const Epi& E) {
    const int tid = opaque_tid(), wid = __builtin_amdgcn_readfirstlane(tid >> 6), lane = tid & 63, wr = wid >> 2, wc = wid & 3, fr = lane & 15, fq = lane >> 4;
    const int K = g.K, nt = K / BK;
    unsigned voffB[2]; int rowA[2]; unsigned colA[2];
#pragma unroll
    for (int i = 0; i < 2; ++i) { int R, C; stage_rc(tid * 16 + i * 8192, R, C); const int Rb = Epi::PERM ? ((R & ~31) + perm32(R & 31)) : R;
        rowA[i] = R; colA[i] = (unsigned)C * 2u; voffB[i] = (unsigned)(Rb * K + C) * 2u; }
    unsigned vAc[2][2], vAn[2][2];
#define PG8_GATHER(dst, u) do { _Pragma("unroll") for (int h_ = 0; h_ < 2; ++h_) _Pragma("unroll") for (int i_ = 0; i_ < 2; ++i_) dst[h_][i_] = (unsigned)S.row_tok(u, h_ * HALF + rowA[i_]) * (unsigned)(K * 2) + colA[i_]; } while (0)
    const size_t kstep = (size_t)(BK * 2);
    const size_t hstep = (size_t)HALF * K * 2;
    const size_t tstep = 2 * hstep;
    const unsigned ldsw = (unsigned)wid * 1024u;
    const int aoff = lds_byte(wr * 64 + fr, fq * 8), boff = lds_byte(wc * 32 + fr, fq * 8);
#define PG8_SA(b, h) (((b) * 2 + (h)) * HTB)
#define PG8_SB(b, h) ((4 + (b) * 2 + (h)) * HTB)
#define PG8_STAGE(bufoff, gbase, voff) do { _Pragma("unroll") for (int _i = 0; _i < 2; ++_i) \
        __builtin_amdgcn_global_load_lds((const unsigned*)((const char*)(gbase) + (voff)[_i]), (PG8_LAS unsigned*)(lds + (bufoff) + ldsw + _i * 8192), 16, 0, 0); } while (0)
#define PG8_LDA(dst, b, h) do { _Pragma("unroll") for (int m = 0; m < 4; ++m) _Pragma("unroll") for (int k = 0; k < 2; ++k) dst[m][k] = *(const PG8_LAS bf16x8*)(lds + PG8_SA(b, h) + aoff + m * 2048 + k * 1024); } while (0)
#define PG8_LDB(dst, b, h) do { _Pragma("unroll") for (int n = 0; n < 2; ++n) _Pragma("unroll") for (int k = 0; k < 2; ++k) dst[n][k] = *(const PG8_LAS bf16x8*)(lds + PG8_SB(b, h) + boff + n * 2048 + k * 1024); } while (0)
#define PG8_MMA(ai, bj, At, Bt) do { __builtin_amdgcn_s_setprio(1); _Pragma("unroll") for (int m = 0; m < 4; ++m) _Pragma("unroll") for (int n = 0; n < 2; ++n) _Pragma("unroll") for (int k = 0; k < 2; ++k) \
        acc[ai][bj][m][n] = __builtin_amdgcn_mfma_f32_16x16x32_bf16(Bt[n][k], At[m][k], acc[ai][bj][m][n], 0, 0, 0); __builtin_amdgcn_s_setprio(0); } while (0)
#define PG8_WAIT_V(n) asm volatile("s_waitcnt vmcnt(" #n ")" ::: "memory")
#define PG8_WAIT_L(n) asm volatile("s_waitcnt lgkmcnt(" #n ")" ::: "memory")
#define PG8_BAR __builtin_amdgcn_s_barrier()
#define PG8_SCHED __builtin_amdgcn_sched_barrier(0)
    Unit cur, nxt; int ui = 0;
    if (!S.next(0, cur)) return;
    f32x4 acc[2][2][4][2];
#pragma unroll
    for (int a = 0; a < 2; ++a)
#pragma unroll
        for (int b = 0; b < 2; ++b)
#pragma unroll
            for (int m = 0; m < 4; ++m)
#pragma unroll
                for (int n = 0; n < 2; ++n) acc[a][b][m][n] = (f32x4){0.f, 0.f, 0.f, 0.f};
    bf16x8 At[4][2], B0[2][2], B1[2][2];
    const char* cA = (const char*)g.A; PG8_GATHER(vAc, cur); const char* cB = (const char*)g.Bt + (size_t)cur.pn * tstep;
    S.a_ready(cur);
    if constexpr (SP2) {
        PG8_STAGE(PG8_SB(0, 0), cB, voffB); PG8_STAGE(PG8_SB(0, 1), cB + hstep, voffB); PG8_STAGE(PG8_SA(0, 0), cA, vAc[0]); PG8_STAGE(PG8_SA(0, 1), cA, vAc[1]);
        if (wr == 1) PG8_BAR;
        PG8_WAIT_V(2); PG8_BAR;
        PG8_STAGE(PG8_SB(1, 0), cB + kstep, voffB); PG8_STAGE(PG8_SA(1, 0), cA + kstep, vAc[0]); PG8_STAGE(PG8_SB(1, 1), cB + hstep + kstep, voffB);
        PG8_WAIT_V(6); PG8_BAR;
    } else {
        PG8_STAGE(PG8_SB(0, 0), cB, voffB); PG8_STAGE(PG8_SA(0, 0), cA, vAc[0]); PG8_STAGE(PG8_SB(0, 1), cB + hstep, voffB); PG8_STAGE(PG8_SA(0, 1), cA, vAc[1]);
        if (wr == 1) PG8_BAR;
        PG8_WAIT_V(4); PG8_BAR;
        PG8_STAGE(PG8_SB(1, 0), cB + kstep, voffB); PG8_STAGE(PG8_SA(1, 0), cA + kstep, vAc[0]); PG8_STAGE(PG8_SB(1, 1), cB + hstep + kstep, voffB);
        PG8_WAIT_V(6); PG8_BAR;
    }
    for (;;) {
        const bool has_next = S.next(ui + 1, nxt);
        const char* nA = cA; if (has_next) PG8_GATHER(vAn, nxt); else { _Pragma("unroll") for (int h_ = 0; h_ < 2; ++h_) _Pragma("unroll") for (int i_ = 0; i_ < 2; ++i_) vAn[h_][i_] = vAc[h_][i_]; } const char* nB = has_next ? (const char*)g.Bt + (size_t)nxt.pn * tstep : cB;
        for (int t = 0; t < nt; t += 2) {
            const bool last = (t == nt - 2);
            const char* a1 = cA + (size_t)(t + 1) * kstep;
            const char* a2 = last ? nA : cA + (size_t)(t + 2) * kstep; const char* b2 = last ? nB : cB + (size_t)(t + 2) * kstep;
            const char* a3 = a2 + kstep; const char* b3 = b2 + kstep;
            unsigned vA2[2][2]; _Pragma("unroll") for (int h_ = 0; h_ < 2; ++h_) _Pragma("unroll") for (int i_ = 0; i_ < 2; ++i_) vA2[h_][i_] = last ? vAn[h_][i_] : vAc[h_][i_];
            if (last && has_next) S.a_ready(nxt);
            if constexpr (SP2) {
            PG8_LDB(B0, 0, 0); PG8_LDB(B1, 0, 1); PG8_SCHED; PG8_LDA(At, 0, 0); PG8_STAGE(PG8_SA(1, 1), a1, vAc[1]);
            PG8_WAIT_V(8); PG8_WAIT_L(0); PG8_BAR; PG8_MMA(0, 0, At, B0); PG8_MMA(0, 1, At, B1); PG8_BAR; PG8_SCHED;
            PG8_LDA(At, 0, 1); PG8_STAGE(PG8_SB(0, 0), b2, voffB); PG8_STAGE(PG8_SB(0, 1), b2 + hstep, voffB); PG8_STAGE(PG8_SA(0, 0), a2, vA2[0]);
            PG8_WAIT_V(8); PG8_WAIT_L(0); PG8_BAR; PG8_MMA(1, 0, At, B0); PG8_MMA(1, 1, At, B1); PG8_BAR; PG8_SCHED;
            PG8_LDB(B0, 1, 0); PG8_LDB(B1, 1, 1); PG8_SCHED; PG8_LDA(At, 1, 0); PG8_STAGE(PG8_SA(0, 1), a2, vA2[1]);
            PG8_WAIT_V(8); PG8_WAIT_L(0); PG8_BAR; PG8_MMA(0, 0, At, B0); PG8_MMA(0, 1, At, B1); PG8_BAR; PG8_SCHED;
            PG8_LDA(At, 1, 1); PG8_STAGE(PG8_SB(1, 0), b3, voffB); PG8_STAGE(PG8_SB(1, 1), b3 + hstep, voffB); PG8_STAGE(PG8_SA(1, 0), a3, vA2[0]);
            PG8_WAIT_V(8); PG8_WAIT_L(0); PG8_BAR; PG8_MMA(1, 0, At, B0); PG8_MMA(1, 1, At, B1); PG8_BAR; PG8_SCHED;
            } else {
            PG8_LDB(B0, 0, 0); PG8_SCHED; PG8_LDA(At, 0, 0); PG8_STAGE(PG8_SA(1, 1), a1, vAc[1]);
            PG8_WAIT_L(8); PG8_BAR; PG8_WAIT_L(0); PG8_MMA(0, 0, At, B0); PG8_BAR; PG8_SCHED;
            PG8_LDB(B1, 0, 1); PG8_STAGE(PG8_SB(0, 0), b2, voffB);
            PG8_BAR; PG8_WAIT_L(0); PG8_MMA(0, 1, At, B1); PG8_BAR;
            PG8_LDA(At, 0, 1); PG8_STAGE(PG8_SA(0, 0), a2, vA2[0]);
            PG8_BAR; PG8_WAIT_L(0); PG8_MMA(1, 0, At, B0); PG8_BAR; PG8_SCHED;
            PG8_STAGE(PG8_SB(0, 1), b2 + hstep, voffB);
            PG8_WAIT_V(6); PG8_BAR; PG8_MMA(1, 1, At, B1); PG8_BAR;
            PG8_LDB(B0, 1, 0); PG8_SCHED; PG8_LDA(At, 1, 0); PG8_STAGE(PG8_SA(0, 1), a2, vA2[1]);
            PG8_WAIT_L(8); PG8_BAR; PG8_WAIT_L(0); PG8_MMA(0, 0, At, B0); PG8_BAR; PG8_SCHED;
            PG8_LDB(B1, 1, 1); PG8_STAGE(PG8_SB(1, 0), b3, voffB);
            PG8_BAR; PG8_WAIT_L(0); PG8_MMA(0, 1, At, B1); PG8_BAR;
            PG8_LDA(At, 1, 1); PG8_STAGE(PG8_SA(1, 0), a3, vA2[0]);
            PG8_BAR; PG8_WAIT_L(0); PG8_MMA(1, 0, At, B0); PG8_BAR; PG8_SCHED;
            PG8_STAGE(PG8_SB(1, 1), b3 + hstep, voffB);
            PG8_WAIT_V(6); PG8_BAR; PG8_MMA(1, 1, At, B1); PG8_BAR;
            }
        }
        if constexpr (ALIGN_EPI) { if (wr == 0) PG8_BAR; }
        if constexpr (!Epi::AFTER_DRAIN) { E(acc, cur, wr, wc, fr, fq); S.done(cur); }
        if (!has_next) break;
#pragma unroll
        for (int a = 0; a < 2; ++a)
#pragma unroll
            for (int b = 0; b < 2; ++b)
#pragma unroll
                for (int m = 0; m < 4; ++m)
#pragma unroll
                    for (int n = 0; n < 2; ++n) acc[a][b][m][n] = (f32x4){0.f, 0.f, 0.f, 0.f};
        cur = nxt; cA = nA; cB = nB; ++ui; _Pragma("unroll") for (int h_ = 0; h_ < 2; ++h_) _Pragma("unroll") for (int i_ = 0; i_ < 2; ++i_) vAc[h_][i_] = vAn[h_][i_];
        if constexpr (ALIGN_EPI) { if (wr == 1) PG8_BAR; }
    }
    PG8_WAIT_V(0);
    if constexpr (!ALIGN_EPI) { if (wr == 0) PG8_BAR; }
    PG8_BAR;
    if constexpr (Epi::AFTER_DRAIN) { E.fused(acc, cur, wr, wc, fr, fq, lds, wid, lane); S.done(cur); }
#undef PG8_GATHER
#undef PG8_SA
#undef PG8_SB
#undef PG8_STAGE
#undef PG8_LDA
#undef PG8_LDB
#undef PG8_MMA
#undef PG8_WAIT_V
#undef PG8_WAIT_L
#undef PG8_BAR
#undef PG8_SCHED
}
}

namespace hg {
typedef short v4i16_t __attribute__((ext_vector_type(4)));
constexpr int S128 = 272, S64 = 144;
constexpr int L_QD = 0, L_QE = L_QD + 64 * S128, L_KE = L_QE + 64 * S128, L_VR = L_KE + 64 * S128, L_ST = L_VR + 64 * S128,
              L_P = L_ST + 128 * S128, L_QS = L_P + 64 * S64, L_DC = L_QS + 16 * 128 * 4, L_END = L_DC + 128 * 4;
static_assert(L_END <= PHASE_LDS, "hgrn LDS");
__device__ __forceinline__ bf16x8 frag(const LAS unsigned char* base, int row, int stride, int kb  ) { return *(const LAS bf16x8*)(base + row * stride + kb); }
__device__ __forceinline__ bf16x8 trfrag(const LAS unsigned char* tile, int tok0, int chan0, int lane) {
    const LAS unsigned char* p = tile + (tok0 + 8 * (lane >> 5) + ((lane & 15) >> 2)) * S128 + (chan0 + 16 * ((lane >> 4) & 1) + 4 * (lane & 3)) * 2;
    const s16x4 lo = __builtin_bit_cast(s16x4, __builtin_amdgcn_ds_read_tr16_b64_v4i16((LAS v4i16_t*)p)), hi = __builtin_bit_cast(s16x4, __builtin_amdgcn_ds_read_tr16_b64_v4i16((LAS v4i16_t*)(p + 4 * S128)));
    return (bf16x8){lo[0], lo[1], lo[2], lo[3], hi[0], hi[1], hi[2], hi[3]};
}

template <bool PASS_C, int ABL = 0>
__device__ __forceinline__ void pass(LAS unsigned char* lds, int unit, const bf16_t* QH, const bf16_t* VH, const half_t* GF, const half_t* GB,
                                     float* HL, float* HD, const float* HS, float* OF, float* OB) {
    typedef _Float16 h4 __attribute__((ext_vector_type(4)));
    const int tid = opaque_tid(), lane = tid & 63, wid = __builtin_amdgcn_readfirstlane(tid >> 6), r32 = lane & 31, hi = lane >> 5;
    const int dir = unit >> 7, head = (unit >> 5) & 3, sc = unit & 31;
    const int kq = tid & 31, tq = tid >> 5;
    const half_t* G = dir ? GB : GF; float* O = dir ? OB : OF;
    const int vi = wid >> 1, ki0 = (wid & 1) * 2;
    f32x16 sacc[2];
    LAS f32x4* QS = (LAS f32x4*)(lds + L_QS); LAS float* DC = (LAS float*)(lds + L_DC);
    if (PASS_C) {
        const float* hs = HS + (size_t)unit * 16384;
#pragma unroll
        for (int tt = 0; tt < 2; ++tt)
#pragma unroll
            for (int r = 0; r < 16; r += 2) { const int v = vi * 32 + crow(r, hi), kk = (ki0 + tt) * 32 + r32; const float s0 = hs[v * 128 + kk], s1 = hs[(v + 1) * 128 + kk]; sacc[tt][r] = s0; sacc[tt][r + 1] = s1;
                const unsigned w = cvtpk(s0, s1); *(LAS bf16_t*)(lds + L_ST + v * S128 + kk * 2) = (bf16_t)(w & 0xffffu); *(LAS bf16_t*)(lds + L_ST + (v + 1) * S128 + kk * 2) = (bf16_t)(w >> 16); }
    } else { sacc[0] = f32x16{}; sacc[1] = f32x16{}; }
    f32x4 btot = {1.f, 1.f, 1.f, 1.f};
    h4 gh[4]; u32x2 qv[4], vv[4];
#define HG_LOAD(c_) do { const int tb_ = sc * 512 + (c_) * 64 + 4 * tq; _Pragma("unroll") for (int i = 0; i < 4; ++i) { const int tl = tb_ + i, tok = dir ? (M - 1 - tl) : tl; \
        const size_t off = (size_t)tok * HSEC + head * 128 + 4 * kq; gh[i] = *(const h4*)(G + off); vv[i] = *(const u32x2*)(VH + off); if (PASS_C) qv[i] = *(const u32x2*)(QH + off); } } while (0)
    HG_LOAD(0);
#pragma unroll 1
    for (int c = 0; c < 8; ++c) {
        const int t0 = sc * 512 + c * 64;
        f32x4 g[4], b[4];
#pragma unroll
        for (int i = 0; i < 4; ++i) { g[i] = (f32x4){(float)gh[i][0], (float)gh[i][1], (float)gh[i][2], (float)gh[i][3]}; b[i] = i ? b[i - 1] * g[i] : g[i]; }
        QS[tq * 32 + kq] = b[3];
        LDS_WAIT(); __syncthreads();
        if (tid < 128) { LAS float* qs = (LAS float*)QS; float run = 1.f;
#pragma unroll
            for (int q = 0; q < 16; ++q) { const float t = qs[q * 128 + tid]; qs[q * 128 + tid] = run; run *= t; }
            DC[tid] = run; }
        LDS_WAIT(); __syncthreads();
        const f32x4 pre = QS[tq * 32 + kq], etot = *(const LAS f32x4*)(DC + 4 * kq);
        btot *= etot;
        f32x4 itot; itot[0] = __builtin_amdgcn_rcpf(etot[0]); itot[1] = __builtin_amdgcn_rcpf(etot[1]); itot[2] = __builtin_amdgcn_rcpf(etot[2]); itot[3] = __builtin_amdgcn_rcpf(etot[3]);
#pragma unroll
        for (int i = 0; i < 4; ++i) { const int tr = 4 * tq + i; float ke[4], qd[4], qe[4];
            const float q4[4] = {bflo(qv[i].x), bfhi(qv[i].x), bflo(qv[i].y), bfhi(qv[i].y)};
#pragma unroll
            for (int cc = 0; cc < 4; ++cc) { const float pb = b[i][cc] * pre[cc];
                ke[cc] = (1.f - g[i][cc]) * etot[cc] * __builtin_amdgcn_rcpf(pb);
                if (PASS_C) { qd[cc] = q4[cc] * pb; qe[cc] = qd[cc] * itot[cc]; } }
            *(LAS u32x2*)(lds + L_KE + tr * S128 + kq * 8) = (u32x2){cvtpk(ke[0], ke[1]), cvtpk(ke[2], ke[3])};
            *(LAS u32x2*)(lds + L_VR + tr * S128 + kq * 8) = vv[i];
            if (PASS_C) { *(LAS u32x2*)(lds + L_QD + tr * S128 + kq * 8) = (u32x2){cvtpk(qd[0], qd[1]), cvtpk(qd[2], qd[3])};
                *(LAS u32x2*)(lds + L_QE + tr * S128 + kq * 8) = (u32x2){cvtpk(qe[0], qe[1]), cvtpk(qe[2], qe[3])}; } }
        LDS_WAIT(); __syncthreads();
        if (c < 7 && !(ABL & 2)) HG_LOAD(c + 1);
        if (PASS_C && !(ABL & 4)) {
            if (wid < 4) {
                const int ti = wid >> 1, si = wid & 1; f32x16 p = f32x16{};
                if (!(ti == 0 && si == 1)) {
#pragma unroll
                    for (int ks = 0; ks < 8; ++ks) p = __builtin_amdgcn_mfma_f32_32x32x16_bf16(frag(lds + L_QE, ti * 32 + r32, S128, ks * 32 + hi * 16), frag(lds + L_KE, si * 32 + r32, S128, ks * 32 + hi * 16), p, 0, 0, 0);
                }
#pragma unroll
                for (int r = 0; r < 16; r += 2) { const int t = ti * 32 + crow(r, hi), s = si * 32 + r32; const unsigned w = cvtpk(s <= t ? p[r] : 0.f, s <= t + 1 ? p[r + 1] : 0.f);
                    *(LAS bf16_t*)(lds + L_P + t * S64 + s * 2) = (bf16_t)(w & 0xffffu); *(LAS bf16_t*)(lds + L_P + (t + 1) * S64 + s * 2) = (bf16_t)(w >> 16); }
            }
            LDS_WAIT(); __syncthreads();
            { const int ti = wid >> 2, vo = wid & 3; f32x16 o = f32x16{};
#pragma unroll
                for (int ks = 0; ks < 8; ++ks) o = __builtin_amdgcn_mfma_f32_32x32x16_bf16(frag(lds + L_QD, ti * 32 + r32, S128, ks * 32 + hi * 16), frag(lds + L_ST, vo * 32 + r32, S128, ks * 32 + hi * 16), o, 0, 0, 0);
#pragma unroll
                for (int ss = 0; ss < 4; ++ss) o = __builtin_amdgcn_mfma_f32_32x32x16_bf16(frag(lds + L_P, ti * 32 + r32, S64, ss * 32 + hi * 16), trfrag(lds + L_VR, ss * 16, vo * 32, lane), o, 0, 0, 0);
#pragma unroll
                for (int r = 0; r < 16; ++r) { const int tl = t0 + ti * 32 + crow(r, hi), tok = dir ? (M - 1 - tl) : tl; if (!(ABL & 1)) O[(size_t)tok * HSEC + head * 128 + vo * 32 + r32] = o[r]; else asm volatile("" :: "v"(o[r])); }
            }
        }
#pragma unroll
        for (int tt = 0; tt < ((ABL & 4) ? 0 : 2); ++tt) { const int ki = ki0 + tt; const float d = DC[ki * 32 + r32];
#pragma unroll
            for (int r = 0; r < 16; ++r) sacc[tt][r] *= d;
#pragma unroll
            for (int ss = 0; ss < 4; ++ss) sacc[tt] = __builtin_amdgcn_mfma_f32_32x32x16_bf16(trfrag(lds + L_VR, ss * 16, vi * 32, lane), trfrag(lds + L_KE, ss * 16, ki * 32, lane), sacc[tt], 0, 0, 0);
        }
        LDS_WAIT(); __syncthreads();
        if (PASS_C) {
#pragma unroll
            for (int tt = 0; tt < 2; ++tt)
#pragma unroll
                for (int r = 0; r < 16; r += 2) { const int v = vi * 32 + crow(r, hi), kk = (ki0 + tt) * 32 + r32; const unsigned w = cvtpk(sacc[tt][r], sacc[tt][r + 1]);
                    *(LAS bf16_t*)(lds + L_ST + v * S128 + kk * 2) = (bf16_t)(w & 0xffffu); *(LAS bf16_t*)(lds + L_ST + (v + 1) * S128 + kk * 2) = (bf16_t)(w >> 16); }
        }
    }
#undef HG_LOAD
    if (!PASS_C) {
        float* hl = HL + (size_t)unit * 16384;
#pragma unroll
        for (int tt = 0; tt < 2; ++tt)
#pragma unroll
            for (int r = 0; r < 16; ++r) { const int v = vi * 32 + crow(r, hi), kk = (ki0 + tt) * 32 + r32; hl[v * 128 + kk] = sacc[tt][r]; }
        if (tq == 0) *(f32x4*)(HD + unit * 128 + 4 * kq) = btot;
    }
    __syncthreads();
}
__device__ __forceinline__ void scan(const float* HL, const float* HD, float* HS, int gtid, int gthreads) {
    for (int id = gtid; id < 8 * 16384; id += gthreads) {
        const int dh = id >> 14, e = id & 16383, k = e & 127; float S = 0.f;
        float hl[32], hd[32];
#pragma unroll
        for (int sc = 0; sc < 32; ++sc) { const int u = dh * 32 + sc; hl[sc] = HL[(size_t)u * 16384 + e]; hd[sc] = HD[u * 128 + k]; }
#pragma unroll
        for (int sc = 0; sc < 32; ++sc) { const int u = dh * 32 + sc; HS[(size_t)u * 16384 + e] = S; S = hd[sc] * S + hl[sc]; }
    }
}
}

namespace att {
constexpr int QBLK = 32, KVBLK = 64, LDR = HSEC;
constexpr int SHM_V = 16384, SHM_K = 8192;
constexpr int OFF_V = 0, OFF_K = 2 * SHM_V, OFF_WS = OFF_K + 2 * SHM_K, OFF_O0 = OFF_WS + NWAVES * 64 * 4, OFF_END = OFF_O0 + 32 * 512 * 4;
static_assert(OFF_END <= PHASE_LDS, "attention LDS");
constexpr float THRL = 11.5f;

__device__ __forceinline__ void partialSM(f32x16& p0, f32x16& p1, float& m_reg, float& mn, float& alpha) {
    float pmax = p0[0];
#pragma unroll
    for (int r = 1; r < 16; ++r) pmax = fmaxf(pmax, p0[r]);
#pragma unroll
    for (int r = 0; r < 16; ++r) pmax = fmaxf(pmax, p1[r]);
    { auto rr = __builtin_amdgcn_permlane32_swap(__float_as_uint(pmax), __float_as_uint(pmax), false, false); pmax = fmaxf(__uint_as_float(rr[0]), __uint_as_float(rr[1])); }
    if (__builtin_expect(__all(pmax - m_reg <= THRL), 1)) { mn = m_reg; alpha = 1.f; }
    else { mn = fmaxf(m_reg, pmax); alpha = ex2(m_reg - mn); m_reg = mn; }
#pragma unroll
    for (int r = 0; r < 16; ++r) { p0[r] -= mn; p1[r] -= mn; }
#pragma unroll
    for (int r = 0; r < 16; ++r) p0[r] = ex2(p0[r]);
}
__device__ __forceinline__ void finishSM(f32x16& p0, f32x16& p1, float alpha, float& l_reg, bf16x8& pa0, bf16x8& pa1, bf16x8& pa2, bf16x8& pa3) {
#pragma unroll
    for (int r = 0; r < 16; ++r) p1[r] = ex2(p1[r]);
    float ps = 0.f;
#pragma unroll
    for (int r = 0; r < 16; ++r) ps += p0[r];
#pragma unroll
    for (int r = 0; r < 16; ++r) ps += p1[r];
    { auto rr = __builtin_amdgcn_permlane32_swap(__float_as_uint(ps), __float_as_uint(ps), false, false); ps = __uint_as_float(rr[0]) + __uint_as_float(rr[1]); }
    l_reg = l_reg * alpha + ps;
#define PK4(P, BASE, OUT) do { unsigned a0 = cvtpk(P[BASE + 0], P[BASE + 1]), a1 = cvtpk(P[BASE + 2], P[BASE + 3]);   \
    unsigned b0 = cvtpk(P[BASE + 4], P[BASE + 5]), b1 = cvtpk(P[BASE + 6], P[BASE + 7]);                              \
    auto r0 = __builtin_amdgcn_permlane32_swap(a0, b0, false, false); auto r1 = __builtin_amdgcn_permlane32_swap(a1, b1, false, false); \
    u32x4 w = {r0[0], r1[0], r0[1], r1[1]}; OUT = *reinterpret_cast<bf16x8*>(&w); } while (0)
    PK4(p0, 0, pa0); PK4(p0, 8, pa1); PK4(p1, 0, pa2); PK4(p1, 8, pa3);
#undef PK4
}
__device__ __forceinline__ void qkt(f32x16& p0, f32x16& p1, const LAS unsigned char* Ks, const bf16x8* qr, int r32, int hi) {
    p0 = f32x16{}; p1 = f32x16{};
#pragma unroll
    for (int d0 = 0; d0 < 4; ++d0) {
        const bf16x8 b0 = *(const LAS bf16x8*)(Ks + (d0 * 2 + hi) * 1024 + r32 * 16);
        const bf16x8 b1 = *(const LAS bf16x8*)(Ks + (d0 * 2 + hi) * 1024 + (32 + r32) * 16);
        p0 = __builtin_amdgcn_mfma_f32_32x32x16_bf16(b0, qr[d0], p0, 0, 0, 0);
        p1 = __builtin_amdgcn_mfma_f32_32x32x16_bf16(b1, qr[d0], p1, 0, 0, 0); }
}
__device__ __forceinline__ int v_st(int k, int c) { const int kk = (k & ~0xC) | ((k & 4) << 1) | ((k & 8) >> 1); return ((kk >> 3) * 4 + (c >> 5)) * 512 + ((kk & 7) * 32 + (c & 31)) * 2; }
__device__ __forceinline__ int v_rd_base(int lane) { return ((lane & 3) << 3) | (((lane >> 2) & 3) << 6) | (((lane >> 4) & 1) << 5) | (((lane >> 5) & 1) << 8); }
constexpr int v_rd_off(int d0, int ks, int half) { return d0 * 512 + ks * 4096 + half * 2048; }
template <int OFF> __device__ __forceinline__ s16x4 tr_read(int vb) {
    s16x4 r; asm volatile("ds_read_b64_tr_b16 %0, %1 offset:%2" : "=&v"(r) : "v"(vb), "i"(OFF) : "memory"); return r;
}
template <int D0> __device__ __forceinline__ void pv_one(f32x16& od, int vb, bf16x8 pa0, bf16x8 pa1, bf16x8 pa2, bf16x8 pa3) {
    const s16x4 l0 = tr_read<v_rd_off(D0, 0, 0)>(vb), h0 = tr_read<v_rd_off(D0, 0, 1)>(vb), l1 = tr_read<v_rd_off(D0, 1, 0)>(vb), h1 = tr_read<v_rd_off(D0, 1, 1)>(vb);
    const s16x4 l2 = tr_read<v_rd_off(D0, 2, 0)>(vb), h2 = tr_read<v_rd_off(D0, 2, 1)>(vb), l3 = tr_read<v_rd_off(D0, 3, 0)>(vb), h3 = tr_read<v_rd_off(D0, 3, 1)>(vb);
    asm volatile("s_waitcnt lgkmcnt(0)" ::: "memory"); SBAR();
#define PK(L, H) (bf16x8){L[0], L[1], L[2], L[3], H[0], H[1], H[2], H[3]}
    od = __builtin_amdgcn_mfma_f32_32x32x16_bf16(pa0, PK(l0, h0), od, 0, 0, 0);
    od = __builtin_amdgcn_mfma_f32_32x32x16_bf16(pa1, PK(l1, h1), od, 0, 0, 0);
    od = __builtin_amdgcn_mfma_f32_32x32x16_bf16(pa2, PK(l2, h2), od, 0, 0, 0);
    od = __builtin_amdgcn_mfma_f32_32x32x16_bf16(pa3, PK(l3, h3), od, 0, 0, 0);
#undef PK
}
__device__ __forceinline__ void pv_d0(f32x16* o, int vb, bf16x8 pa0, bf16x8 pa1, bf16x8 pa2, bf16x8 pa3) {
    pv_one<0>(o[0], vb, pa0, pa1, pa2, pa3); pv_one<1>(o[1], vb, pa0, pa1, pa2, pa3); pv_one<2>(o[2], vb, pa0, pa1, pa2, pa3); pv_one<3>(o[3], vb, pa0, pa1, pa2, pa3);
}

__device__ __forceinline__ void unit(LAS unsigned char* lds, int h, int q0, const bf16_t* __restrict__ QD, const bf16_t* __restrict__ KD, const bf16_t* __restrict__ VD,
                                     float lam, const float* __restrict__ subg, bf16_t* MIX) {
    const int tid = opaque_tid(), wid = __builtin_amdgcn_readfirstlane(tid >> 6), lane = tid & 63, r32 = lane & 31, hi = lane >> 5;
    LAS unsigned char* V_lds = lds + OFF_V; LAS unsigned char* K_lds = lds + OFF_K;
    LAS float* ws = (LAS float*)(lds + OFF_WS) + wid * 64; LAS float* li_l = ws; LAS float* al_l = ws + 32;
    LAS unsigned* O0 = (LAS unsigned*)(lds + OFF_O0);
    const int sr = tid >> 4, sc = (tid & 15) * 8, vst0 = v_st(sr, sc), vst1 = v_st(32 + sr, sc), kst = wid * 1024 + lane * 16;
    const int vb0 = (int)(uintptr_t)V_lds + v_rd_base(lane);
    const unsigned voV0 = (unsigned)(sr * LDR + sc), voV1 = (unsigned)((32 + sr) * LDR + sc), voK = (unsigned)(lane * LDR + wid * 8);
    constexpr int NT = M / KVBLK;
#pragma unroll 1
    for (int mp = 0; mp < 2; ++mp) {
        const bf16_t* Kh = KD + h * 128 + mp * 64; const bf16_t* Vh = VD + h * 128;
        const bf16_t* Qw = QD + (size_t)(q0 + wid * QBLK + r32) * LDR + h * 128 + mp * 64 + hi * 8;
        float m_reg = -1e30f, l_reg = 0.f; f32x16 o[4] = {}; bf16x8 qr[4];
#pragma unroll
        for (int d0 = 0; d0 < 4; ++d0) qr[d0] = *reinterpret_cast<const bf16x8*>(Qw + d0 * 16);
        struct { bf16x8 vs0, vs1, ks0; } sr_[2];
#define SLOAD(i, k0) do { const bf16_t* vt_ = Vh + (size_t)(k0) * LDR; const bf16_t* kt_ = Kh + (size_t)(k0) * LDR; \
        sr_[i].vs0 = *reinterpret_cast<const bf16x8*>(vt_ + voV0); sr_[i].vs1 = *reinterpret_cast<const bf16x8*>(vt_ + voV1); sr_[i].ks0 = *reinterpret_cast<const bf16x8*>(kt_ + voK); } while (0)
#define SWRITE(b, i) do { *(LAS bf16x8*)(V_lds + (b) * SHM_V + vst0) = sr_[i].vs0; *(LAS bf16x8*)(V_lds + (b) * SHM_V + vst1) = sr_[i].vs1; \
        *(LAS bf16x8*)(K_lds + (b) * SHM_K + kst) = sr_[i].ks0; } while (0)
#define SWAIT() asm volatile("s_waitcnt vmcnt(3)" ::: "memory")
#define RESC(a) do { if (__any((a) < 1.f)) { if (hi == 0) al_l[r32] = (a); asm volatile("s_waitcnt lgkmcnt(0)" ::: "memory"); \
        _Pragma("unroll") for (int d = 0; d < 4; ++d) _Pragma("unroll") for (int r = 0; r < 16; ++r) o[d][r] *= al_l[crow(r, hi)]; } } while (0)
        f32x16 pA0, pA1, pB0, pB1; float mnA, mnB, alA, alB; bf16x8 pa0, pa1, pa2, pa3;
        constexpr int SE = 0, SO = 1;
        SLOAD(SE, 0); asm volatile("s_waitcnt vmcnt(0)" ::: "memory"); SWRITE(0, SE); __syncthreads();
        qkt(pA0, pA1, K_lds, qr, r32, hi); partialSM(pA0, pA1, m_reg, mnA, alA);
        SLOAD(SO, KVBLK); SLOAD(SE, 2 * KVBLK);
        SWAIT(); SWRITE(1, SO); __syncthreads();
#pragma unroll 1
        for (int j = 1; j + 1 < NT; j += 2) {
            SBAR(); qkt(pB0, pB1, K_lds + SHM_K, qr, r32, hi);
            finishSM(pA0, pA1, alA, l_reg, pa0, pa1, pa2, pa3); SBAR();
            SLOAD(SO, (j + 2) * KVBLK); SBAR();
            pv_d0(o, vb0, pa0, pa1, pa2, pa3); partialSM(pB0, pB1, m_reg, mnB, alB);
            __syncthreads(); SWAIT(); SWRITE(0, SE);
            RESC(alB); __syncthreads();
            SBAR(); qkt(pA0, pA1, K_lds, qr, r32, hi);
            finishSM(pB0, pB1, alB, l_reg, pa0, pa1, pa2, pa3); SBAR();
            if (j + 3 < NT) SLOAD(SE, (j + 3) * KVBLK); SBAR();
            pv_d0(o, vb0 + SHM_V, pa0, pa1, pa2, pa3); partialSM(pA0, pA1, m_reg, mnA, alA);
            __syncthreads(); SWAIT(); SWRITE(1, SO);
            RESC(alA); __syncthreads();
        }
        SBAR(); qkt(pB0, pB1, K_lds + SHM_K, qr, r32, hi);
        finishSM(pA0, pA1, alA, l_reg, pa0, pa1, pa2, pa3); SBAR();
        pv_d0(o, vb0, pa0, pa1, pa2, pa3); partialSM(pB0, pB1, m_reg, mnB, alB);
        __syncthreads(); RESC(alB);
        finishSM(pB0, pB1, alB, l_reg, pa0, pa1, pa2, pa3); SBAR();
        pv_d0(o, vb0 + SHM_V, pa0, pa1, pa2, pa3);
#undef SLOAD
#undef SWRITE
#undef SWAIT
#undef RESC
        if (hi == 0) li_l[r32] = l_reg; asm volatile("s_waitcnt lgkmcnt(0)" ::: "memory");
        int rowb = q0 + wid * QBLK; asm volatile("" : "+s"(rowb));
        float rli[16];
#pragma unroll
        for (int r = 0; r < 16; ++r) rli[r] = __builtin_amdgcn_rcpf(li_l[crow(r, hi)]);
        if (mp == 0) {
#pragma unroll
            for (int d0 = 0; d0 < 4; ++d0)
#pragma unroll
                for (int r = 0; r < 16; r += 2) O0[(d0 * 8 + (r >> 1)) * 512 + tid] = cvtpk(o[d0][r] * rli[r], o[d0][r + 1] * rli[r + 1]);
        } else {
            float ss[16];
#pragma unroll
            for (int r = 0; r < 16; ++r) ss[r] = 0.f;
#pragma unroll
            for (int d0 = 0; d0 < 4; ++d0)
#pragma unroll
                for (int r = 0; r < 16; r += 2) { const unsigned w = O0[(d0 * 8 + (r >> 1)) * 512 + tid];
                    const float c0 = bflo(w) - lam * o[d0][r] * rli[r], c1 = bfhi(w) - lam * o[d0][r + 1] * rli[r + 1];
                    o[d0][r] = c0; o[d0][r + 1] = c1; ss[r] += c0 * c0; ss[r + 1] += c1 * c1; }
#pragma unroll
            for (int r = 0; r < 16; ++r) {
                ss[r] += lane_xor<1>(ss[r]); ss[r] += lane_xor<2>(ss[r]); ss[r] += lane_xor<4>(ss[r]); ss[r] += lane_xor<8>(ss[r]); ss[r] += lane_xor<16>(ss[r]);
                ss[r] = 0.8f / sqrtf(ss[r] * (1.f / 128.f) + 1e-5f); }
#pragma unroll
            for (int d0 = 0; d0 < 4; ++d0) { const float g = subg[d0 * 32 + r32];
#pragma unroll
                for (int r = 0; r < 16; ++r) MIX[(size_t)(rowb + crow(r, hi)) * D + 512 + h * 128 + d0 * 32 + r32] = (bf16_t)f2bf(o[d0][r] * ss[r] * g); }
        }
        __syncthreads();
    }
}
__device__ __forceinline__ void hgrn_finalize(int h, int q0, const float* OF, const float* OB, const bf16_t* SG, const float* gain, bf16_t* MIX, int wid, int lane) {
    const float g0 = gain[2 * lane], g1 = gain[2 * lane + 1];
#pragma unroll 4
    for (int i = 0; i < 32; ++i) { const int row = q0 + wid * 32 + i; const size_t off = (size_t)row * HSEC + h * 128 + 2 * lane;
        const float2 a = *(const float2*)(OF + off), b = *(const float2*)(OB + off); const unsigned sg = *(const unsigned*)(SG + off);
        const float x0 = a.x + b.x, x1 = a.y + b.y; const float ssum = wave_sum(x0 * x0 + x1 * x1);
        const float rstd = 1.f / sqrtf(ssum * (1.f / 128.f) + 1e-6f);
        *(unsigned*)(MIX + (size_t)row * D + h * 128 + 2 * lane) = cvtpk(x0 * rstd * g0 * bflo(sg), x1 * rstd * g1 * bfhi(sg)); }
}
}

namespace att2 {
typedef short v4i16_t __attribute__((ext_vector_type(4)));
constexpr int KVBLK = 64, LDR = HSEC, NT = M / KVBLK;
constexpr int KSLOT = 8192, VSLOT = 16384, NSLOT = 4;
constexpr int OFF_K = 0, OFF_V = NSLOT * KSLOT, OFF_WS = OFF_V + NSLOT * VSLOT, OFF_END = OFF_WS + NWAVES * 64 * 4;
static_assert(OFF_END <= PHASE_LDS, "attention LDS");
__device__ __forceinline__ s16x4 vtr(const LAS unsigned char* p) { return __builtin_bit_cast(s16x4, __builtin_amdgcn_ds_read_tr16_b64_v4i16((LAS v4i16_t*)p)); }
__device__ __forceinline__ void glds16(const void* sbase, unsigned voff, unsigned lds_dst) { unsigned keep;
    asm volatile("s_mov_b32 %0, m0\n\ts_mov_b32 m0, %3\n\ts_nop 0\n\tglobal_load_lds_dwordx4 %1, %2\n\ts_mov_b32 m0, %0" : "=&s"(keep) : "v"(voff), "s"(sbase), "s"(lds_dst) : "memory"); }
#define ATT2_WAIT_BAR(N) asm volatile("s_waitcnt vmcnt(" #N ") lgkmcnt(0)\n\ts_barrier" ::: "memory")
template <bool DO_QK, bool DO_SM, bool DO_PV>
__device__ __forceinline__ void step(f32x16& sn0, f32x16& sn1, f32x16& sc0, f32x16& sc1, const u32x4& pap0, const u32x4& pap1, const u32x4& pap2, const u32x4& pap3,
                                     u32x4& pan0, u32x4& pan1, u32x4& pan2, u32x4& pan3, f32x16 (&o)[4], const bf16x8 (&qr)[4], const f32x16& negm, float& lsum,
                                     const LAS unsigned char* kc, const LAS unsigned char* knn, const LAS unsigned char* vb, bf16x8& kf0, bf16x8& kf1, bf16x8& kf2) {
    bf16x8 fr0 = kf0, fr1 = kf1, fr2 = kf2, fr3 = kf0; unsigned ca0 = 0, ca1 = 0, cb0 = 0, cb1 = 0;
    (void)ca0; (void)ca1; (void)cb0; (void)cb1;
    if (DO_QK) sn0 = __builtin_amdgcn_mfma_f32_32x32x16_bf16(fr0, qr[0], negm, 0, 0, 0);
    SBAR();
    if (DO_QK) { fr3 = *(const LAS bf16x8*)(kc + 2560); }
    if (DO_SM) { sc0[0] = ex2(sc0[0]); sc0[1] = ex2(sc0[1]); }
    SBAR();
    if (DO_QK) sn1 = __builtin_amdgcn_mfma_f32_32x32x16_bf16(fr1, qr[0], negm, 0, 0, 0);
    SBAR();
    if (DO_QK) { fr0 = *(const LAS bf16x8*)(kc + 4096); }
    if (DO_SM) { sc0[2] = ex2(sc0[2]); sc0[3] = ex2(sc0[3]); lsum += sc0[0]; lsum += sc0[1]; }
    SBAR();
    if (DO_QK) sn0 = __builtin_amdgcn_mfma_f32_32x32x16_bf16(fr2, qr[1], sn0, 0, 0, 0);
    SBAR();
    if (DO_QK) { fr1 = *(const LAS bf16x8*)(kc + 4608); }
    if (DO_SM) { sc0[4] = ex2(sc0[4]); sc0[5] = ex2(sc0[5]); lsum += sc0[2]; lsum += sc0[3]; }
    SBAR();
    if (DO_QK) sn1 = __builtin_amdgcn_mfma_f32_32x32x16_bf16(fr3, qr[1], sn1, 0, 0, 0);
    SBAR();
    if (DO_QK) { fr2 = *(const LAS bf16x8*)(kc + 6144); }
    if (DO_SM) { sc0[6] = ex2(sc0[6]); sc0[7] = ex2(sc0[7]); lsum += sc0[4]; lsum += sc0[5]; }
    SBAR();
    if (DO_QK) sn0 = __builtin_amdgcn_mfma_f32_32x32x16_bf16(fr0, qr[2], sn0, 0, 0, 0);
    SBAR();
    if (DO_QK) { fr3 = *(const LAS bf16x8*)(kc + 6656); }
    if (DO_SM) { sc0[8] = ex2(sc0[8]); sc0[9] = ex2(sc0[9]); lsum += sc0[6]; lsum += sc0[7]; }
    SBAR();
    if (DO_QK) sn1 = __builtin_amdgcn_mfma_f32_32x32x16_bf16(fr1, qr[2], sn1, 0, 0, 0);
    SBAR();
    if (DO_PV) { { const s16x4 l_ = vtr(vb + 0), h_ = vtr(vb + 256); fr0 = (bf16x8){l_[0], l_[1], l_[2], l_[3], h_[0], h_[1], h_[2], h_[3]}; } }
    if (DO_SM) { sc0[10] = ex2(sc0[10]); sc0[11] = ex2(sc0[11]); lsum += sc0[8]; lsum += sc0[9]; }
    SBAR();
    if (DO_QK) sn0 = __builtin_amdgcn_mfma_f32_32x32x16_bf16(fr2, qr[3], sn0, 0, 0, 0);
    SBAR();
    if (DO_PV) { { const s16x4 l_ = vtr(vb + 4096), h_ = vtr(vb + 4352); fr1 = (bf16x8){l_[0], l_[1], l_[2], l_[3], h_[0], h_[1], h_[2], h_[3]}; } }
    if (DO_SM) { sc0[12] = ex2(sc0[12]); sc0[13] = ex2(sc0[13]); lsum += sc0[10]; lsum += sc0[11]; }
    SBAR();
    if (DO_QK) sn1 = __builtin_amdgcn_mfma_f32_32x32x16_bf16(fr3, qr[3], sn1, 0, 0, 0);
    SBAR();
    if (DO_PV) { { const s16x4 l_ = vtr(vb + 8192), h_ = vtr(vb + 8448); fr2 = (bf16x8){l_[0], l_[1], l_[2], l_[3], h_[0], h_[1], h_[2], h_[3]}; } }
    if (DO_SM) { sc0[14] = ex2(sc0[14]); sc0[15] = ex2(sc0[15]); lsum += sc0[12]; lsum += sc0[13]; }
    SBAR();
    if (DO_PV) o[0] = __builtin_amdgcn_mfma_f32_32x32x16_bf16(__builtin_bit_cast(bf16x8, pap0), fr0, o[0], 0, 0, 0);
    SBAR();
    if (DO_PV) { { const s16x4 l_ = vtr(vb + 12288), h_ = vtr(vb + 12544); fr3 = (bf16x8){l_[0], l_[1], l_[2], l_[3], h_[0], h_[1], h_[2], h_[3]}; } }
    if (DO_SM) { sc1[0] = ex2(sc1[0]); sc1[1] = ex2(sc1[1]); lsum += sc0[14]; lsum += sc0[15]; }
    SBAR();
    if (DO_PV) o[0] = __builtin_amdgcn_mfma_f32_32x32x16_bf16(__builtin_bit_cast(bf16x8, pap1), fr1, o[0], 0, 0, 0);
    SBAR();
    if (DO_PV) { { const s16x4 l_ = vtr(vb + 512), h_ = vtr(vb + 768); fr0 = (bf16x8){l_[0], l_[1], l_[2], l_[3], h_[0], h_[1], h_[2], h_[3]}; } }
    if (DO_SM) { sc1[2] = ex2(sc1[2]); sc1[3] = ex2(sc1[3]); lsum += sc1[0]; lsum += sc1[1]; }
    SBAR();
    if (DO_PV) o[0] = __builtin_amdgcn_mfma_f32_32x32x16_bf16(__builtin_bit_cast(bf16x8, pap2), fr2, o[0], 0, 0, 0);
    SBAR();
    if (DO_PV) { { const s16x4 l_ = vtr(vb + 4608), h_ = vtr(vb + 4864); fr1 = (bf16x8){l_[0], l_[1], l_[2], l_[3], h_[0], h_[1], h_[2], h_[3]}; } }
    if (DO_SM) { sc1[4] = ex2(sc1[4]); sc1[5] = ex2(sc1[5]); lsum += sc1[2]; lsum += sc1[3]; }
    SBAR();
    if (DO_PV) o[0] = __builtin_amdgcn_mfma_f32_32x32x16_bf16(__builtin_bit_cast(bf16x8, pap3), fr3, o[0], 0, 0, 0);
    SBAR();
    if (DO_PV) { { const s16x4 l_ = vtr(vb + 8704), h_ = vtr(vb + 8960); fr2 = (bf16x8){l_[0], l_[1], l_[2], l_[3], h_[0], h_[1], h_[2], h_[3]}; } }
    if (DO_SM) { sc1[6] = ex2(sc1[6]); sc1[7] = ex2(sc1[7]); lsum += sc1[4]; lsum += sc1[5]; }
    SBAR();
    if (DO_PV) o[1] = __builtin_amdgcn_mfma_f32_32x32x16_bf16(__builtin_bit_cast(bf16x8, pap0), fr0, o[1], 0, 0, 0);
    SBAR();
    if (DO_PV) { { const s16x4 l_ = vtr(vb + 12800), h_ = vtr(vb + 13056); fr3 = (bf16x8){l_[0], l_[1], l_[2], l_[3], h_[0], h_[1], h_[2], h_[3]}; } }
    if (DO_SM) { sc1[8] = ex2(sc1[8]); sc1[9] = ex2(sc1[9]); lsum += sc1[6]; lsum += sc1[7]; }
    SBAR();
    if (DO_PV) o[1] = __builtin_amdgcn_mfma_f32_32x32x16_bf16(__builtin_bit_cast(bf16x8, pap1), fr1, o[1], 0, 0, 0);
    SBAR();
    if (DO_PV) { { const s16x4 l_ = vtr(vb + 1024), h_ = vtr(vb + 1280); fr0 = (bf16x8){l_[0], l_[1], l_[2], l_[3], h_[0], h_[1], h_[2], h_[3]}; } }
    if (DO_SM) { sc1[10] = ex2(sc1[10]); sc1[11] = ex2(sc1[11]); lsum += sc1[8]; lsum += sc1[9]; }
    SBAR();
    if (DO_PV) o[1] = __builtin_amdgcn_mfma_f32_32x32x16_bf16(__builtin_bit_cast(bf16x8, pap2), fr2, o[1], 0, 0, 0);
    SBAR();
    if (DO_PV) { { const s16x4 l_ = vtr(vb + 5120), h_ = vtr(vb + 5376); fr1 = (bf16x8){l_[0], l_[1], l_[2], l_[3], h_[0], h_[1], h_[2], h_[3]}; } }
    if (DO_SM) { sc1[12] = ex2(sc1[12]); sc1[13] = ex2(sc1[13]); lsum += sc1[10]; lsum += sc1[11]; }
    SBAR();
    if (DO_PV) o[1] = __builtin_amdgcn_mfma_f32_32x32x16_bf16(__builtin_bit_cast(bf16x8, pap3), fr3, o[1], 0, 0, 0);
    SBAR();
    if (DO_PV) { { const s16x4 l_ = vtr(vb + 9216), h_ = vtr(vb + 9472); fr2 = (bf16x8){l_[0], l_[1], l_[2], l_[3], h_[0], h_[1], h_[2], h_[3]}; } }
    if (DO_SM) { sc1[14] = ex2(sc1[14]); sc1[15] = ex2(sc1[15]); lsum += sc1[12]; lsum += sc1[13]; }
    SBAR();
    if (DO_PV) o[2] = __builtin_amdgcn_mfma_f32_32x32x16_bf16(__builtin_bit_cast(bf16x8, pap0), fr0, o[2], 0, 0, 0);
    SBAR();
    if (DO_PV) { { const s16x4 l_ = vtr(vb + 13312), h_ = vtr(vb + 13568); fr3 = (bf16x8){l_[0], l_[1], l_[2], l_[3], h_[0], h_[1], h_[2], h_[3]}; } }
    if (DO_SM) { lsum += sc1[14]; lsum += sc1[15]; ca0 = cvtpk(sc0[0], sc0[1]); ca1 = cvtpk(sc0[2], sc0[3]); }
    SBAR();
    if (DO_PV) o[2] = __builtin_amdgcn_mfma_f32_32x32x16_bf16(__builtin_bit_cast(bf16x8, pap1), fr1, o[2], 0, 0, 0);
    SBAR();
    if (DO_PV) { { const s16x4 l_ = vtr(vb + 1536), h_ = vtr(vb + 1792); fr0 = (bf16x8){l_[0], l_[1], l_[2], l_[3], h_[0], h_[1], h_[2], h_[3]}; } }
    if (DO_SM) { cb0 = cvtpk(sc0[4], sc0[5]); cb1 = cvtpk(sc0[6], sc0[7]); pan0 = (u32x4){ca0, ca1, cb0, cb1}; }
    SBAR();
    if (DO_PV) o[2] = __builtin_amdgcn_mfma_f32_32x32x16_bf16(__builtin_bit_cast(bf16x8, pap2), fr2, o[2], 0, 0, 0);
    SBAR();
    if (DO_PV) { { const s16x4 l_ = vtr(vb + 5632), h_ = vtr(vb + 5888); fr1 = (bf16x8){l_[0], l_[1], l_[2], l_[3], h_[0], h_[1], h_[2], h_[3]}; } }
    if (DO_SM) { ca0 = cvtpk(sc0[8], sc0[9]); ca1 = cvtpk(sc0[10], sc0[11]); }
    SBAR();
    if (DO_PV) o[2] = __builtin_amdgcn_mfma_f32_32x32x16_bf16(__builtin_bit_cast(bf16x8, pap3), fr3, o[2], 0, 0, 0);
    SBAR();
    if (DO_PV) { { const s16x4 l_ = vtr(vb + 9728), h_ = vtr(vb + 9984); fr2 = (bf16x8){l_[0], l_[1], l_[2], l_[3], h_[0], h_[1], h_[2], h_[3]}; } }
    if (DO_SM) { cb0 = cvtpk(sc0[12], sc0[13]); cb1 = cvtpk(sc0[14], sc0[15]); pan1 = (u32x4){ca0, ca1, cb0, cb1}; }
    SBAR();
    if (DO_PV) o[3] = __builtin_amdgcn_mfma_f32_32x32x16_bf16(__builtin_bit_cast(bf16x8, pap0), fr0, o[3], 0, 0, 0);
    SBAR();
    if (DO_PV) { { const s16x4 l_ = vtr(vb + 13824), h_ = vtr(vb + 14080); fr3 = (bf16x8){l_[0], l_[1], l_[2], l_[3], h_[0], h_[1], h_[2], h_[3]}; } }
    if (DO_SM) { ca0 = cvtpk(sc1[0], sc1[1]); ca1 = cvtpk(sc1[2], sc1[3]); }
    SBAR();
    if (DO_PV) o[3] = __builtin_amdgcn_mfma_f32_32x32x16_bf16(__builtin_bit_cast(bf16x8, pap1), fr1, o[3], 0, 0, 0);
    SBAR();
    kf0 = *(const LAS bf16x8*)(knn + 0);
    if (DO_SM) { cb0 = cvtpk(sc1[4], sc1[5]); cb1 = cvtpk(sc1[6], sc1[7]); pan2 = (u32x4){ca0, ca1, cb0, cb1}; }
    SBAR();
    if (DO_PV) o[3] = __builtin_amdgcn_mfma_f32_32x32x16_bf16(__builtin_bit_cast(bf16x8, pap2), fr2, o[3], 0, 0, 0);
    SBAR();
    kf1 = *(const LAS bf16x8*)(knn + 512);
    if (DO_SM) { ca0 = cvtpk(sc1[8], sc1[9]); ca1 = cvtpk(sc1[10], sc1[11]); }
    SBAR();
    if (DO_PV) o[3] = __builtin_amdgcn_mfma_f32_32x32x16_bf16(__builtin_bit_cast(bf16x8, pap3), fr3, o[3], 0, 0, 0);
    SBAR();
    kf2 = *(const LAS bf16x8*)(knn + 2048);
    if (DO_SM) { cb0 = cvtpk(sc1[12], sc1[13]); cb1 = cvtpk(sc1[14], sc1[15]); pan3 = (u32x4){ca0, ca1, cb0, cb1}; }
    SBAR();
}

template <bool AB_SM = true, bool AB_PV = true, bool AB_QK = true, bool AB_DMA = true>
__device__ __forceinline__ void unit(LAS unsigned char* lds, int h, int q0, const bf16_t* __restrict__ QD, const bf16_t* __restrict__ KD, const bf16_t* __restrict__ VD,
                                     const unsigned* KMAX2, float* O0S, float lam, const float* __restrict__ subg, bf16_t* MIX) {
    const int tid = opaque_tid(), wid = __builtin_amdgcn_readfirstlane(tid >> 6), lane = tid & 63, r32 = lane & 31, hi = lane >> 5;
    const unsigned lds0 = (unsigned)(uintptr_t)lds;
    LAS float* ws = (LAS float*)(lds + OFF_WS) + wid * 64;
    const LAS unsigned char* kbase = lds + OFF_K + hi * 1024 + r32 * 16;
    const LAS unsigned char* vbase = lds + OFF_V + (((lane & 3) << 3) | (((lane >> 2) & 3) << 6) | (((lane >> 4) & 1) << 5) | (((lane >> 5) & 1) << 11));
    const unsigned voK = (unsigned)((lane * LDR + wid * 8) * 2);
    unsigned voV[2];
    { const int kk = 8 * wid + ((lane & 31) >> 2), key = (kk & ~0xC) | ((kk & 4) << 1) | ((kk & 8) >> 1);
#pragma unroll
      for (int j = 0; j < 2; ++j) voV[j] = (unsigned)((key * LDR + (2 * j + (lane >> 5)) * 32 + (lane & 3) * 8) * 2); }
    const unsigned kdst = lds0 + OFF_K + wid * 1024, vdst = lds0 + OFF_V + wid * 2048;
#pragma unroll 1
    for (int mp = 0; mp < 2; ++mp) {
        const bf16_t* Kh = KD + h * 128 + mp * 64; const bf16_t* Vh = VD + h * 128;
        const bf16_t* Qw = QD + (size_t)(q0 + wid * 32 + r32) * LDR + h * 128 + mp * 64 + hi * 8;
#define ATT2_DMA_K(t) do { const int t_ = (t) < NT ? (t) : NT - 1; glds16((const char*)Kh + (size_t)t_ * (KVBLK * LDR * 2), voK, (unsigned)__builtin_amdgcn_readfirstlane(kdst + ((t) & 3) * KSLOT)); } while (0)
#define ATT2_DMA_V(t) do { const int t_ = (t) < NT ? (t) : NT - 1; const char* vs_ = (const char*)Vh + (size_t)t_ * (KVBLK * LDR * 2); const unsigned vd_ = (unsigned)__builtin_amdgcn_readfirstlane(vdst + ((t) & 3) * VSLOT); \
        glds16(vs_, voV[0], vd_); glds16(vs_, voV[1], vd_ + 1024); } while (0)
        ATT2_DMA_K(0); ATT2_DMA_K(1); ATT2_DMA_K(2); ATT2_DMA_V(0);
        bf16x8 qr[4]; float qq = 0.f;
#pragma unroll
        for (int d0 = 0; d0 < 4; ++d0) { qr[d0] = *reinterpret_cast<const bf16x8*>(Qw + d0 * 16);
#pragma unroll
            for (int j = 0; j < 8; ++j) { const float q = bf2f((unsigned short)qr[d0][j]); qq += q * q; } }
        { auto rr = __builtin_amdgcn_permlane32_swap(__float_as_uint(qq), __float_as_uint(qq), false, false); qq = __uint_as_float(rr[0]) + __uint_as_float(rr[1]); }
        const float mref = sqrtf(qq * __uint_as_float(KMAX2[(h * 2 + mp) * 64])) * 1.001f;
        f32x16 negm;
#pragma unroll
        for (int r = 0; r < 16; ++r) negm[r] = -mref;
        f32x16 o[4] = {}; float lsum = 0.f;
        f32x16 sA0, sA1, sB0, sB1; u32x4 pX0, pX1, pX2, pX3, pY0, pY1, pY2, pY3;
        sA0 = f32x16{}; sA1 = f32x16{}; sB0 = f32x16{}; sB1 = f32x16{}; pX0 = pX1 = pX2 = pX3 = pY0 = pY1 = pY2 = pY3 = (u32x4){0u, 0u, 0u, 0u};
        bf16x8 kf0, kf1, kf2;
        ATT2_WAIT_BAR(0);
        kf0 = *(const LAS bf16x8*)(kbase); kf1 = *(const LAS bf16x8*)(kbase + 512); kf2 = *(const LAS bf16x8*)(kbase + 2048);
#define KS(t) (kbase + ((t) & 3) * KSLOT)
#define VS(t) (vbase + ((t) & 3) * VSLOT)
        ATT2_DMA_K(3); ATT2_DMA_V(1);
        step<true, false, false>(sA0, sA1, sB0, sB1, pX0, pX1, pX2, pX3, pY0, pY1, pY2, pY3, o, qr, negm, lsum, KS(0), KS(1), VS(0), kf0, kf1, kf2);
        ATT2_WAIT_BAR(3);
        ATT2_DMA_K(4); ATT2_DMA_V(2);
        step<true, true, false>(sB0, sB1, sA0, sA1, pY0, pY1, pY2, pY3, pX0, pX1, pX2, pX3, o, qr, negm, lsum, KS(1), KS(2), VS(0), kf0, kf1, kf2);
        ATT2_WAIT_BAR(3);
#pragma unroll 1
        for (int i = 1; i + 1 < NT - 1; i += 2) {
            if (AB_DMA) { ATT2_DMA_K(i + 4); ATT2_DMA_V(i + 2); }
            step<AB_QK, AB_SM, AB_PV>(sA0, sA1, sB0, sB1, pX0, pX1, pX2, pX3, pY0, pY1, pY2, pY3, o, qr, negm, lsum, KS(i + 1), KS(i + 2), VS(i - 1), kf0, kf1, kf2);
            if (AB_DMA) ATT2_WAIT_BAR(3); else ATT2_WAIT_BAR(0);
            if (AB_DMA) { ATT2_DMA_K(i + 5); ATT2_DMA_V(i + 3); }
            step<AB_QK, AB_SM, AB_PV>(sB0, sB1, sA0, sA1, pY0, pY1, pY2, pY3, pX0, pX1, pX2, pX3, o, qr, negm, lsum, KS(i + 2), KS(i + 3), VS(i), kf0, kf1, kf2);
            ATT2_WAIT_BAR(3);
        }
        step<false, true, true>(sA0, sA1, sB0, sB1, pX0, pX1, pX2, pX3, pY0, pY1, pY2, pY3, o, qr, negm, lsum, KS(0), KS(0), VS(NT - 2), kf0, kf1, kf2);
        ATT2_WAIT_BAR(0);
        step<false, false, true>(sB0, sB1, sA0, sA1, pY0, pY1, pY2, pY3, pX0, pX1, pX2, pX3, o, qr, negm, lsum, KS(0), KS(0), VS(NT - 1), kf0, kf1, kf2);
        ATT2_WAIT_BAR(0);
#undef KS
#undef VS
#undef ATT2_DMA_K
#undef ATT2_DMA_V
        { auto rr = __builtin_amdgcn_permlane32_swap(__float_as_uint(lsum), __float_as_uint(lsum), false, false); lsum = __uint_as_float(rr[0]) + __uint_as_float(rr[1]); }
        if (hi == 0) ws[r32] = lsum; asm volatile("s_waitcnt lgkmcnt(0)" ::: "memory");
        int rowb = q0 + wid * 32; asm volatile("" : "+s"(rowb));
        float rli[16];
#pragma unroll
        for (int r = 0; r < 16; ++r) rli[r] = __builtin_amdgcn_rcpf(ws[crow(r, hi)]);
        float* o0p = O0S + tid; asm volatile("" : "+v"(o0p));
        if (mp == 0) {
#pragma unroll
            for (int d0 = 0; d0 < 4; ++d0)
#pragma unroll
                for (int r = 0; r < 16; ++r) o0p[(d0 * 16 + r) * 512] = o[d0][r] * rli[r];
        } else {
            float ss[16];
#pragma unroll
            for (int r = 0; r < 16; ++r) ss[r] = 0.f;
#pragma unroll
            for (int d0 = 0; d0 < 4; ++d0)
#pragma unroll
                for (int r = 0; r < 16; ++r) { const float c = o0p[(d0 * 16 + r) * 512] - lam * o[d0][r] * rli[r]; o[d0][r] = c; ss[r] += c * c; }
#pragma unroll
            for (int r = 0; r < 16; ++r) {
                ss[r] += lane_xor<1>(ss[r]); ss[r] += lane_xor<2>(ss[r]); ss[r] += lane_xor<4>(ss[r]); ss[r] += lane_xor<8>(ss[r]); ss[r] += lane_xor<16>(ss[r]);
                ss[r] = 0.8f / sqrtf(ss[r] * (1.f / 128.f) + 1e-5f); }
#pragma unroll
            for (int d0 = 0; d0 < 4; ++d0) { const float g = subg[d0 * 32 + r32];
#pragma unroll
                for (int r = 0; r < 16; ++r) MIX[(size_t)(rowb + crow(r, hi)) * D + 512 + h * 128 + d0 * 32 + r32] = (bf16_t)f2bf(o[d0][r] * ss[r] * g); }
        }
        asm volatile("s_waitcnt vmcnt(0) lgkmcnt(0)\n\ts_barrier" ::: "memory");
    }
}
__device__ __forceinline__ void kmax_rows(LAS unsigned char* lds, const bf16_t* KD, unsigned* KMAX2, int gw, int ngw, int lane, int wave) {
    float mx = 0.f;
    for (int row0 = gw; row0 < M; row0 += 8 * ngw) { u32x4 w[8];
#pragma unroll
        for (int i = 0; i < 8; ++i) { const int row = row0 + i * ngw; w[i] = row < M ? *(const GAS u32x4*)(KD + (size_t)row * HSEC + lane * 8) : (u32x4){0u, 0u, 0u, 0u}; }
#pragma unroll
        for (int i = 0; i < 8; ++i) { const u32x4 v = w[i];
            float s = bflo(v.x) * bflo(v.x) + bfhi(v.x) * bfhi(v.x) + bflo(v.y) * bflo(v.y) + bfhi(v.y) * bfhi(v.y) + bflo(v.z) * bflo(v.z) + bfhi(v.z) * bfhi(v.z) + bflo(v.w) * bflo(v.w) + bfhi(v.w) * bfhi(v.w);
            s += lane_xor<1>(s); s += lane_xor<2>(s); s += lane_xor<4>(s); mx = fmaxf(mx, s); } }
    LAS float* red = (LAS float*)lds; if ((lane & 7) == 0) red[wave * 8 + (lane >> 3)] = mx;
    LDS_WAIT(); __syncthreads();
    if (wave == 0 && lane < 8) { float m = red[lane];
#pragma unroll
        for (int w = 1; w < NWAVES; ++w) m = fmaxf(m, red[w * 8 + lane]);
        atomicMax(KMAX2 + lane * 64, __float_as_uint(m)); }
    __syncthreads();
}
}

__device__ __forceinline__ void route16(const bf16_t* X2B, const u32x4* WRB, const float* rgb, const float* reb,
                                        float* RSTD, int* TOKE, float* TOKW, int* TOKR, unsigned* GCNT, int row0, int lane, LAS float* wl, bool dry = false) {
    typedef float f32x4_ __attribute__((ext_vector_type(4)));
    const int r = lane & 15, q = lane >> 4;
    LAS unsigned* lc = (LAS unsigned*)(wl + 800);
    if (lane < 32) lc[lane] = 0u;
    f32x4_ acc[3]; acc[0] = (f32x4_){0.f, 0.f, 0.f, 0.f}; acc[1] = acc[0]; acc[2] = acc[0];
    float ssq = 0.f;
    const bf16_t* xp = X2B + (size_t)(row0 + r) * D + 8 * q;
#pragma unroll 8
    for (int ks = 0; ks < 32; ++ks) {
        const u32x4 xw = *(const GAS u32x4*)(xp + ks * 32);
        ssq += (bflo(xw.x) * bflo(xw.x) + bfhi(xw.x) * bfhi(xw.x)) + (bflo(xw.y) * bflo(xw.y) + bfhi(xw.y) * bfhi(xw.y)) + (bflo(xw.z) * bflo(xw.z) + bfhi(xw.z) * bfhi(xw.z)) + (bflo(xw.w) * bflo(xw.w) + bfhi(xw.w) * bfhi(xw.w));
        const bf16x8 xh = __builtin_bit_cast(bf16x8, xw);
#pragma unroll
        for (int nt = 0; nt < 3; ++nt) {
            const bf16x8 wh = __builtin_bit_cast(bf16x8, WRB[((ks * 3 + nt) * 2 + 0) * 64 + lane]), wlo = __builtin_bit_cast(bf16x8, WRB[((ks * 3 + nt) * 2 + 1) * 64 + lane]);
            acc[nt] = __builtin_amdgcn_mfma_f32_16x16x32_bf16(wh, xh, acc[nt], 0, 0, 0);
            acc[nt] = __builtin_amdgcn_mfma_f32_16x16x32_bf16(wlo, xh, acc[nt], 0, 0, 0);
        }
    }
    ssq += lane_xor<16>(ssq);
    { auto rr = __builtin_amdgcn_permlane32_swap(__float_as_uint(ssq), __float_as_uint(ssq), false, false); ssq = __uint_as_float(rr[0]) + __uint_as_float(rr[1]); }
    const float rstd = 1.f / sqrtf(ssq * (1.f / 1024.f) + 1e-6f);
#pragma unroll
    for (int nt = 0; nt < 3; ++nt) *(LAS f32x4_*)(wl + r * 48 + nt * 16 + 4 * q) = acc[nt] * rstd;
    LDS_WAIT();
    float lg[36];
#pragma unroll
    for (int n4 = 0; n4 < 9; ++n4) { const f32x4_ t = *(const LAS f32x4_*)(wl + r * 48 + 4 * n4); lg[4 * n4] = t[0]; lg[4 * n4 + 1] = t[1]; lg[4 * n4 + 2] = t[2]; lg[4 * n4 + 3] = t[3]; }
    float gl[4];
#pragma unroll
    for (int g = 0; g < 4; ++g) gl[g] = lg[g] + rgb[g];
    int gi = 0; float gm = gl[0];
#pragma unroll
    for (int g = 1; g < 4; ++g) if (gl[g] > gm) { gm = gl[g]; gi = g; }
    float gs = 0.f;
#pragma unroll
    for (int g = 0; g < 4; ++g) gs += __expf(gl[g] - gm);
    const float gp = 1.f / gs;
    float e[8];
#pragma unroll
    for (int j = 0; j < 8; ++j) { const float a0 = lg[4 + j] + reb[j], a1 = lg[12 + j] + reb[8 + j], a2 = lg[20 + j] + reb[16 + j], a3 = lg[28 + j] + reb[24 + j];
        e[j] = gi == 0 ? a0 : gi == 1 ? a1 : gi == 2 ? a2 : a3; }
    int i1 = 0; float m1 = e[0];
#pragma unroll
    for (int j = 1; j < 8; ++j) if (e[j] > m1) { m1 = e[j]; i1 = j; }
    int i2 = 0; float m2 = -3.0e38f;
#pragma unroll
    for (int j = 0; j < 8; ++j) if (j != i1 && e[j] > m2) { m2 = e[j]; i2 = j; }
    const float p2 = __expf(m2 - m1);
    const float w1 = gp / (1.f + p2), w2 = gp * p2 / (1.f + p2);
    if (q == 0 && !dry) { const int row = row0 + r; const int e1 = gi * 8 + i1, e2 = gi * 8 + i2;
        const int r1 = (int)__hip_atomic_fetch_add(lc + e1, 1u, __ATOMIC_RELAXED, __HIP_MEMORY_SCOPE_WORKGROUP), r2 = (int)__hip_atomic_fetch_add(lc + e2, 1u, __ATOMIC_RELAXED, __HIP_MEMORY_SCOPE_WORKGROUP);
        RSTD[row] = rstd; TOKE[row * 2] = e1; TOKE[row * 2 + 1] = e2; TOKW[row * 2] = w1; TOKW[row * 2 + 1] = w2; TOKR[row * 2] = r1; TOKR[row * 2 + 1] = r2; }
    LDS_WAIT();
    if (lane < 32 && !dry) GCNT[(row0 >> 4) * 32 + lane] = lc[lane];
}
__device__ __forceinline__ void build_tile_prefix(volatile LAS int* tb, const unsigned* CNT) {
    if (threadIdx.x == 0) { int acc = 0;
        for (int e = 0; e < 32; ++e) { tb[e] = acc; const int c = (int)__hip_atomic_load(CNT + e * CNT_STRIDE, __ATOMIC_RELAXED, __HIP_MEMORY_SCOPE_AGENT); tb[64 + e] = c; acc += (c + 255) >> 8; }
        tb[32] = acc; }
    LDS_WAIT(); __syncthreads();
}
__device__ __forceinline__ void sort_slots(LAS unsigned char* lds, volatile LAS int* tb, const unsigned* GCNT, const int* TOKE, const int* TOKR, int* TOKS, int* PERM, const float* RSTD, float* RSLOT, unsigned* CNT, int blk, int nblk) {
    const int t = opaque_tid(), e = t & 31, j = t >> 5; constexpr int NG = M / 16;
    const int gpb = (NG + nblk - 1) / nblk, g0 = blk * gpb, g1 = g0 + gpb < NG ? g0 + gpb : NG;
    LAS int* part = (LAS int*)lds; LAS int* part2 = part + 512; LAS int* tot = part2 + 512; LAS int* base0 = tot + 32;
    int s = 0, s2 = 0;
    for (int g = j; g < NG; g += 16) { const int c = (int)GCNT[g * 32 + e]; s += c; s2 += g < g0 ? c : 0; }
    part[j * 32 + e] = s; part2[j * 32 + e] = s2;
    LDS_WAIT(); __syncthreads();
    if (t < 32) { int a = 0, b = 0;
#pragma unroll
        for (int jj = 0; jj < 16; ++jj) { a += part[jj * 32 + t]; b += part2[jj * 32 + t]; }
        tot[t] = a; base0[t] = b; if (blk == 0) __hip_atomic_store(CNT + t * CNT_STRIDE, (unsigned)a, __ATOMIC_RELAXED, __HIP_MEMORY_SCOPE_AGENT); }
    LDS_WAIT(); __syncthreads();
    if (t == 0) { int acc = 0; for (int ee = 0; ee < 32; ++ee) { tb[ee] = acc; tb[64 + ee] = tot[ee]; acc += (tot[ee] + 255) >> 8; } tb[32] = acc; }
    LDS_WAIT(); __syncthreads();
    for (int idx = t; idx < (g1 - g0) * 32; idx += 512) { const int gi = idx >> 5, p = (g0 + gi) * 32 + (idx & 31), ex = TOKE[p]; int base = base0[ex];
        for (int g = g0; g < g0 + gi; ++g) base += (int)GCNT[g * 32 + ex];
        const int slot = tb[ex] * 256 + base + TOKR[p]; TOKS[p] = slot; PERM[slot] = p >> 1; RSLOT[slot] = RSTD[p >> 1]; }
}
template <int NR>
__device__ __forceinline__ void final_rows(const bf16_t* X2B, float* OUT, const bf16_t* Y, const int* TOKS, const float* TOKW, const float* gain, int m0, int stride, int lane) {
    int s0[NR], s1[NR]; float w0[NR], w1[NR];
#pragma unroll
    for (int i = 0; i < NR; ++i) { const int row = m0 + i * stride; s0[i] = TOKS[row * 2]; s1[i] = TOKS[row * 2 + 1]; w0[i] = TOKW[row * 2]; w1[i] = TOKW[row * 2 + 1]; }
    u32x2 xx[NR][4], ya[NR][4], yb[NR][4];
#pragma unroll
    for (int i = 0; i < NR; ++i) { const int row = m0 + i * stride;
        const GAS u32x2* xr = (const GAS u32x2*)(X2B + (size_t)row * D) + lane; const GAS u32x2* y0 = (const GAS u32x2*)(Y + (size_t)s0[i] * D) + lane; const GAS u32x2* y1 = (const GAS u32x2*)(Y + (size_t)s1[i] * D) + lane;
#pragma unroll
        for (int j = 0; j < 4; ++j) { xx[i][j] = xr[64 * j]; ya[i][j] = y0[64 * j]; yb[i][j] = y1[64 * j]; } }
#pragma unroll
    for (int i = 0; i < NR; ++i) { const int row = m0 + i * stride; f32x4 v[4]; float s = 0.f;
#pragma unroll
        for (int j = 0; j < 4; ++j) { const u32x2 x_ = xx[i][j], a = ya[i][j], b = yb[i][j];
            v[j].x = bflo(x_.x) + w0[i] * bflo(a.x) + w1[i] * bflo(b.x); v[j].y = bfhi(x_.x) + w0[i] * bfhi(a.x) + w1[i] * bfhi(b.x); v[j].z = bflo(x_.y) + w0[i] * bflo(a.y) + w1[i] * bflo(b.y); v[j].w = bfhi(x_.y) + w0[i] * bfhi(a.y) + w1[i] * bfhi(b.y);
            s += (v[j].x * v[j].x + v[j].y * v[j].y) + (v[j].z * v[j].z + v[j].w * v[j].w); }
        const float rstd = 1.f / sqrtf(wave_sum(s) * (1.f / 1024.f) + 1e-6f);
        GAS f32x4* orow = (GAS f32x4*)(OUT + (size_t)row * D) + lane;
#pragma unroll
        for (int j = 0; j < 4; ++j) { const f32x4 g = ((const GAS f32x4*)gain)[64 * j + lane]; orow[64 * j] = v[j] * rstd * g; } }
}

#ifndef MK_N_LAUNCHES
#define MK_N_LAUNCHES 1
#endif
constexpr int N_PHASES = 12;
struct Args { const void* in[18]; float* out; unsigned char* ws; int ph_lo, ph_hi; };
static_assert(sizeof(Args) == 18 * 8 + 8 + 8 + 8, "Args has no padding");

__global__ void __launch_bounds__(NWAVES * 64, 2) mk_fwd(Args args) {
    extern __shared__ __attribute__((aligned(16))) unsigned char lds_raw[];
    LAS unsigned char* lds = (LAS unsigned char*)lds_raw;
    volatile LAS unsigned* MISC = (volatile LAS unsigned*)(lds + MISC_OFF);
    const int G = gridDim.x, bx = blockIdx.x, vcu = (G % 8 == 0) ? (bx % 8) * (G / 8) + bx / 8 : bx;
    const int NGW = G * NWAVES;
#define PHASE_IDS const int tid = opaque_tid(), lane = tid & 63, wave = __builtin_amdgcn_readfirstlane(tid >> 6), gw = vcu * NWAVES + wave; (void)lane; (void)gw
    const __attribute__((address_space(4))) Args* A = (const __attribute__((address_space(4))) Args*)__builtin_amdgcn_kernarg_segment_ptr();
    asm volatile("" : "+s"(A));
#define ARGF(i) ((const float*)A->in[i])
#define WSP(T, off) ((T*)(A->ws + (off)))
#define x_in ARGF(0)
#define positions ((const int*)A->in[1])
#define norm1_gain ARGF(2)
#define w_in ARGF(3)
#define hg_lb ARGF(4)
#define hg_norm_gain ARGF(5)
#define diff_lambda ARGF(6)
#define subln_gain ARGF(7)
#define w_out ARGF(8)
#define norm2_gain ARGF(9)
#define rg_w ARGF(10)
#define rg_b ARGF(11)
#define re_w ARGF(12)
#define re_b ARGF(13)
#define w_gate ARGF(14)
#define w_up ARGF(15)
#define w_down ARGF(16)
#define final_gain ARGF(17)
#define out (A->out)
#define cosT WSP(float, WS_ROPE)
#define sinT (WSP(float, WS_ROPE) + M * 8)
#define HD WSP(float, WS_HD)
#define TOKE WSP(int, WS_TOKE)
#define TOKW WSP(float, WS_TOKW)
#define TOKR WSP(int, WS_TOKR)
#define TOKS WSP(int, WS_TOKS)
#define LAMP WSP(float, WS_LAM)
#define WOUT WSP(bf16_t, WS_WOUT)
#define WIN WSP(bf16_t, WS_WIN)
#define XN WSP(bf16_t, WS_XN)
#define QH WSP(bf16_t, WS_QH)
#define VH WSP(bf16_t, WS_VH)
#define SG WSP(bf16_t, WS_SG)
#define QD WSP(bf16_t, WS_QD)
#define KD WSP(bf16_t, WS_KD)
#define VD WSP(bf16_t, WS_VD)
#define GF WSP(half_t, WS_GF)
#define GB WSP(half_t, WS_GB)
#define HS WSP(float, WS_HS)
#define HL WSP(float, WS_HL)
#define OF WSP(float, WS_OF)
#define OB WSP(float, WS_OB)
#define MIX WSP(bf16_t, WS_MIX)
#define X2B WSP(bf16_t, WS_X2B)
#define WGU WSP(bf16_t, WS_WGU)
#define WD WSP(bf16_t, WS_WD)
#define HGb WSP(bf16_t, WS_HG)
#define HM WSP(bf16_t, WS_HM)
#define Y WSP(bf16_t, WS_Y)
#define CNT (WSP(unsigned, WS_CTL) + CW_CNT)
    unsigned* ctl = WSP(unsigned, WS_CTL);
    volatile LAS int* tb = (volatile LAS int*)(MISC + 16);

    if (threadIdx.x < 64) MISC[threadIdx.x] = 0u;
    __syncthreads();
    XcdBarrier bar; bar.bar = ctl + CW_BAR; bar.x = 0; bar.st = nullptr;
    const int lo = A->ph_lo, hi = A->ph_hi;
    if (hi - lo > 1) bar = xcd_barrier_post(ctl + CW_BAR, MISC);
#ifndef PH_MASK
#define PH_MASK 0xFFF
#endif
#define IN(k) (((PH_MASK >> (k)) & 1) && lo <= (k) && (k) < hi)
#ifndef DOUBLE_PHASE
#define DOUBLE_PHASE -1
#endif
#define REP(k) for (int rep_ = 0; rep_ < ((DOUBLE_PHASE) == (k) ? 2 : 1); ++rep_)
#ifndef BAR_REPS
#define BAR_REPS 1
#endif
#ifdef DIAG_SPAN_A
#define STAMP(k) do { if (blockIdx.x == 0 && threadIdx.x == 0) WSP(unsigned long long, WS_LAM + 64)[k] = __builtin_amdgcn_s_memrealtime(); } while (0)
#else
#define STAMP(k) do { } while (0)
#endif
#define SEAM(k) do { if (IN(k) && IN((k) + 1)) for (int b_ = 0; b_ < BAR_REPS; ++b_) xcd_barrier(bar); STAMP((k) + 1); } while (0)

    STAMP(0);
    if (IN(0)) REP(0) { PHASE_IDS;
        LAS float* scr = (LAS float*)(lds + wave * 16384);
        constexpr int I_IN = (D / 64) * (NIN / 32), I_OUT = (D / 64) * (D / 32);
        { XposeRegs R;
#define P0_LOAD(it_) do { if ((it_) < I_IN) xpose_load(R, w_in, D, NIN, (it_), lane); else xpose_load(R, w_out, D, D, (it_) - I_IN, lane); } while (0)
            if (gw < I_IN + I_OUT) P0_LOAD(gw);
            for (int it = gw; it < I_IN + I_OUT; it += NGW) { const XposeRegs C = R; const int nx = it + NGW;
                if (nx < I_IN + I_OUT) P0_LOAD(nx);
                if (it < I_IN) xpose_store(C, D, NIN, WIN, 0, 1, scr, it, lane); else xpose_store(C, D, D, WOUT, 0, 1, scr, it - I_IN, lane); }
#undef P0_LOAD
        }
        for (int m = gw; m < M; m += NGW) rms_rows_to_bf16<1>(x_in, norm1_gain, XN, m, NGW, lane, 1e-6f);
        for (int id = bx * 512 + tid; id < M * 8; id += G * 512) {
            const int i = id & 7; const float invf[8] = {1.0f, 0.19392274474868576f, 0.03760603093086393f, 0.007292664737217109f, 0.001414213562373095f, 0.0002742481756762073f, 5.318295896944988e-05f, 1.031338537721246e-05f};
            float f = invf[0];
#pragma unroll
            for (int q = 1; q < 8; ++q) f = (i == q) ? invf[q] : f;
            const float ang = (float)positions[id >> 3] * f;
            const double rev = (double)ang * 0.15915494309189535; const float fr = (float)(rev - __builtin_rint(rev));
            cosT[id] = __builtin_amdgcn_cosf(fr); sinT[id] = __builtin_amdgcn_sinf(fr);
        }
        for (int id = bx * 512 + tid; id < 32 * 3 * 2 * 64; id += G * 512) {
            const int ln = id & 63, part = (id >> 6) & 1, nt = (id >> 7) % 3, ks = (id >> 7) / 3, n = nt * 16 + (ln & 15), k0 = ks * 32 + 8 * (ln >> 4); unsigned w[4];
#pragma unroll
            for (int jj = 0; jj < 4; ++jj) { float v[2];
#pragma unroll
                for (int u = 0; u < 2; ++u) { const int k = k0 + 2 * jj + u; const float wv = (n < 4 ? rg_w[k * 4 + n] : n < 36 ? re_w[k * 32 + (n - 4)] : 0.f) * norm2_gain[k];
                    const float hv = bf2f(f2bf(wv)); v[u] = part ? wv - hv : hv; }
                w[jj] = pk2(v[0], v[1]); }
            WSP(u32x4, WS_WR)[id] = (u32x4){w[0], w[1], w[2], w[3]}; }
        if (bx == 0 && wave == 0) { const float a = wave_sum(diff_lambda[lane] * diff_lambda[64 + lane]), b = wave_sum(diff_lambda[128 + lane] * diff_lambda[192 + lane]);
            if (lane == 0) LAMP[0] = __expf(a) - __expf(b) + 0.2f; }
    }
    SEAM(0);
    if (IN(1)) REP(1) {
        pg8::Gemm g{XN, WIN, M, NIN, D}; pg8::StaticOrder S; S.init(M, NIN, G, bx);
        EpiInProj E{QH, VH, SG, QD, KD, VD, GF, GB, hg_lb, cosT, sinT};
        pg8::gemm_phase<EpiInProj, pg8::StaticOrder, true, true>(lds, g, S, E);
    }
    SEAM(1);
    if (IN(2)) REP(2) { for (int u = vcu; u < 256; u += G) hg::pass<false>(lds, u, QH, VH, GF, GB, HL, HD, HS, OF, OB);
        { PHASE_IDS; att2::kmax_rows(lds, KD, WSP(unsigned, WS_CTL) + CW_KMAX, gw, NGW, lane, wave); } }
    SEAM(2);
    if (IN(3)) REP(3) hg::scan(HL, HD, HS, bx * 512 + opaque_tid(), G * 512);
    SEAM(3);
    if (IN(4)) REP(4) { for (int u = vcu; u < 256; u += G) hg::pass<true>(lds, u, QH, VH, GF, GB, HL, HD, HS, OF, OB); }
#ifdef HG_ABL
    if (IN(4)) { for (int u = vcu; u < 256; u += G) hg::pass<true, HG_ABL>(lds, u, QH, VH, GF, GB, HL, HD, HS, OF, OB); }
#endif
    SEAM(4);
    if (IN(5)) REP(5) { PHASE_IDS;
#ifdef DIAG_CLOCK
        if (blockIdx.x == 0 && threadIdx.x == 0) { WSP(unsigned long long, WS_LAM + 64)[20] = __builtin_amdgcn_s_memtime(); WSP(unsigned long long, WS_LAM + 64)[21] = __builtin_amdgcn_s_memrealtime(); }
#endif
        const float lam = LAMP[0];
        for (int u = vcu; u < 256; u += G) { const int h = u >> 6, q0 = (u & 63) * 256;
            int ln = lane; asm volatile("" : "+v"(ln));
            att::hgrn_finalize(h, q0, OF, OB, SG, hg_norm_gain, MIX, wave, ln);
#ifdef ATT_OLD
            att::unit(lds, h, q0, QD, KD, VD, lam, subln_gain, MIX); }
#else
            att2::unit(lds, h, q0, QD, KD, VD, WSP(unsigned, WS_CTL) + CW_KMAX, WSP(float, WS_O0S) + (size_t)bx * 32768, lam, subln_gain, MIX);
#ifdef SHADOW_ATT
            att2::unit<SHADOW_ATT>(lds, h, q0, QD, KD, VD, WSP(unsigned, WS_CTL) + CW_KMAX, WSP(float, WS_O0S) + (size_t)bx * 32768, lam, subln_gain, WSP(bf16_t, WS_HS));
#endif
            }
#endif
    }
#ifdef DIAG_CLOCK
    if (blockIdx.x == 0 && threadIdx.x == 0) { WSP(unsigned long long, WS_LAM + 64)[22] = __builtin_amdgcn_s_memtime(); WSP(unsigned long long, WS_LAM + 64)[23] = __builtin_amdgcn_s_memrealtime(); }
#endif
    SEAM(5);
    if (IN(6)) REP(6) {
        pg8::Gemm g{MIX, WOUT, M, D, D}; pg8::StaticOrder S; S.init(M, D, G, bx);
        EpiResid E{x_in, X2B};
        pg8::gemm_phase<EpiResid, pg8::StaticOrder, true, true>(lds, g, S, E);
    }
    SEAM(6);
    if (IN(7)) { PHASE_IDS;
        const int grp = wave * G + vcu; const bool router = grp * 16 < M;
        LAS float* scr = (LAS float*)(lds + wave * 16384);
        if (router) route16(X2B, WSP(const u32x4, WS_WR), rg_b, re_b, WSP(float, WS_RSTD), TOKE, TOKW, TOKR, WSP(unsigned, WS_GCNT), grp * 16, lane, scr + 3072);
        if (router && (DOUBLE_PHASE) == 77) route16(X2B, WSP(const u32x4, WS_WR), rg_b, re_b, WSP(float, WS_RSTD), TOKE, TOKW, TOKR, WSP(unsigned, WS_GCNT), grp * 16, lane, scr + 3072, true);
        constexpr int I_GU = (D / 64) * (DEXP / 32), I_DN = (DEXP / 64) * (D / 32), I_ALL = NEXP * (2 * I_GU + I_DN);
#ifndef P7_SHARE
#define P7_SHARE 10
#endif
        const int nrt = M / 16, nA = nrt < NGW ? nrt : NGW, nB = NGW - nA;
        const int perA = nB ? (I_ALL * P7_SHARE / 24 + nA - 1) / nA : (I_ALL + nA - 1) / nA, totA = perA * nA < I_ALL ? perA * nA : I_ALL;
        int it0, it1, stp;
        if (router) { it0 = grp; it1 = totA; stp = nA; } else { it0 = totA + (grp - nA); it1 = I_ALL; stp = nB; }
        REP(7) { XposeRegs R0, R1;
#define P7_LOAD(R, it_) do { const int e_ = (it_) / (2 * I_GU + I_DN), r_ = (it_) % (2 * I_GU + I_DN); \
            if (r_ < I_GU) xpose_load(R, w_gate + (size_t)e_ * D * DEXP, D, DEXP, r_, lane); else if (r_ < 2 * I_GU) xpose_load(R, w_up + (size_t)e_ * D * DEXP, D, DEXP, r_ - I_GU, lane); \
            else xpose_load(R, w_down + (size_t)e_ * DEXP * D, DEXP, D, r_ - 2 * I_GU, lane); } while (0)
#define P7_STORE(C, it_) do { const int e = (it_) / (2 * I_GU + I_DN), r = (it_) % (2 * I_GU + I_DN); \
            if (r < I_GU) xpose_store(C, D, DEXP, WGU + (size_t)e * 1024 * D, 0, 2, scr, r, lane, norm2_gain); \
            else if (r < 2 * I_GU) xpose_store(C, D, DEXP, WGU + (size_t)e * 1024 * D, 1, 2, scr, r - I_GU, lane, norm2_gain); \
            else xpose_store(C, DEXP, D, WD + (size_t)e * 1024 * DEXP, 0, 1, scr, r - 2 * I_GU, lane); } while (0)
            if (it0 < it1) P7_LOAD(R0, it0);
            if (it0 + stp < it1) P7_LOAD(R1, it0 + stp);
            for (int it = it0; it < it1; it += 2 * stp) {
                { const XposeRegs C = R0; if (it + 2 * stp < it1) P7_LOAD(R0, it + 2 * stp); P7_STORE(C, it); }
                if (it + stp < it1) { const XposeRegs C = R1; if (it + 3 * stp < it1) P7_LOAD(R1, it + 3 * stp); P7_STORE(C, it + stp); }
            }
#undef P7_STORE
#undef P7_LOAD
        }
    }
    SEAM(7);
    if (IN(8)) REP(8) { sort_slots(lds, tb, WSP(unsigned, WS_GCNT), TOKE, TOKR, TOKS, WSP(int, WS_PERM), WSP(const float, WS_RSTD), WSP(float, WS_RSLOT), CNT, bx, G); }
    SEAM(8);
    if (IN(9)) REP(9) {
        build_tile_prefix(tb, CNT);
        pg8::Gemm g{X2B, WGU, MAXSLOTS, NEXP * 1024, D}; MoeOrder S{tb, G, bx, WSP(const int, WS_PERM), WSP(unsigned, WS_CTL) + CW_READY, 0}; EpiSwiGlu E{HM, WSP(const float, WS_RSLOT)};
        pg8::gemm_phase_g<EpiSwiGlu, MoeOrder, true, true>(lds, g, S, E);
    }
    SEAM(9);
    if (IN(10)) REP(10) {
        build_tile_prefix(tb, CNT);
        pg8::Gemm g{HM, WD, MAXSLOTS, NEXP * 1024, DEXP}; MoeOrder S{tb, G, bx, WSP(const int, WS_PERM), WSP(unsigned, WS_CTL) + CW_READY, 0}; EpiDown E{Y};
        pg8::gemm_phase<EpiDown, MoeOrder, true, true>(lds, g, S, E);
    }
    SEAM(10);
    if (IN(11)) { PHASE_IDS; for (int m = gw; m < M; m += NGW) final_rows<1>(X2B, out, Y, TOKS, TOKW, final_gain, m, NGW, lane); }
#ifdef DIAG_SPAN_A
    xcd_barrier(bar); STAMP(12); xcd_barrier(bar);
    { const unsigned long long* st_ = WSP(unsigned long long, WS_LAM + 64);
#ifdef DIAG_CLOCK
      const float d_ = (float)(long long)(st_[22] - st_[20]) / (float)(long long)(st_[23] - st_[21]) * 10.f * DIAG_C;
#else
      const float d_ = (float)(long long)(st_[DIAG_SPAN_B] - st_[DIAG_SPAN_A]) * 0.01f * DIAG_C;
#endif
      for (int m = blockIdx.x * 512 + threadIdx.x; m < M; m += gridDim.x * 512) out[(size_t)m * D] += d_; }
#endif
#undef IN
#undef SEAM
#undef x_in
#undef positions
#undef out
#undef Y
#undef HM
#undef CNT
}

extern "C" void kernel_launch(void* const* d_in, const int* in_sizes, int n_in, void* d_out, int out_size, void* d_ws, size_t ws_size, hipStream_t stream) {
    static int grid = 0;
    if (grid == 0) {
        if (n_in != 18 || in_sizes[0] != M * D || out_size != M * D || ws_size < WS_END) { fprintf(stderr, "kernel_launch: unexpected shapes (n_in %d, in0 %d, out %d, ws %zu)\n", n_in, n_in > 0 ? in_sizes[0] : -1, out_size, ws_size); grid = -1; return; }
        int dev = 0, cus = 0, per_cu = 0;
        if (hipGetDevice(&dev) != hipSuccess || hipDeviceGetAttribute(&cus, hipDeviceAttributeMultiprocessorCount, dev) != hipSuccess) { grid = -1; return; }
        if (hipFuncSetAttribute((const void*)mk_fwd, hipFuncAttributeMaxDynamicSharedMemorySize, LDS_BYTES) != hipSuccess) { fprintf(stderr, "kernel_launch: hipFuncSetAttribute failed\n"); grid = -1; return; }
        if (hipOccupancyMaxActiveBlocksPerMultiprocessor(&per_cu, (const void*)mk_fwd, NWAVES * 64, LDS_BYTES) != hipSuccess || per_cu < 1) { fprintf(stderr, "kernel_launch: occupancy query says %d\n", per_cu); (void)hipGetLastError(); grid = -1; return; }
        grid = cus;
    }
    if (grid < 0) return;
    if (hipMemsetAsync((char*)d_ws + WS_CTL, 0, CTL_ZERO_BYTES, stream) != hipSuccess) return;
    Args a{};
    for (int i = 0; i < 18; ++i) a.in[i] = d_in[i];
    a.out = (float*)d_out; a.ws = (unsigned char*)d_ws;
#if MK_N_LAUNCHES == 1
    a.ph_lo = 0; a.ph_hi = N_PHASES;
    hipLaunchKernelGGL(mk_fwd, dim3(grid), dim3(NWAVES * 64), LDS_BYTES, stream, a);
#else
    for (int p = 0; p < N_PHASES; ++p) { a.ph_lo = p; a.ph_hi = p + 1; hipLaunchKernelGGL(mk_fwd, dim3(grid), dim3(NWAVES * 64), LDS_BYTES, stream, a); }
#endif
}
```

```cpp
#include <hip/hip_runtime.h>
#include <cstdio>
#include <cstdint>
__device__ __forceinline__ int opaque_tid() { int t = threadIdx.x; asm volatile("" : "+v"(t)); return t; }
namespace pg8 {
#define PG8_LAS __attribute__((address_space(3)))
typedef unsigned short bf16_t;
typedef short bf16x8 __attribute__((ext_vector_type(8)));
typedef float f32x4 __attribute__((ext_vector_type(4)));
typedef unsigned u32x4 __attribute__((ext_vector_type(4)));
constexpr int BM = 256, BK = 64, HALF = 128, HTB = HALF * BK * 2  , STAGE_BYTES = 8 * HTB, NXCD = 8, WGM = 8;

__host__ __device__ __forceinline__ int lds_byte(int r, int c) { const int st = (r >> 4) * 2 + (c >> 5), rr = r & 15, cc = c & 31, ob = rr * 64 + cc * 2; return st * 1024 + (ob ^ (((ob >> 9) & 1) << 5)); }
__host__ __device__ __forceinline__ void stage_rc(int b, int& R, int& C) { const int st = b / 1024, sb = b % 1024, swz = sb ^ (((sb >> 9) & 1) << 5); R = (st >> 1) * 16 + swz / 64; C = (st & 1) * 32 + (swz % 64) / 2; }
__host__ __device__ __forceinline__ int perm32(int rho) { const int n = rho >> 4, i = rho & 15; return 8 * (i >> 2) + 4 * n + (i & 3); }

struct Unit { int pm, pn; };
struct Gemm { const bf16_t* A; const bf16_t* Bt; int M, N, K; };

struct StaticOrder {
    int nM, nN, nwg, G, c;
    __host__ __device__ void init(int M, int N, int G_, int c_) { nM = M / BM; nN = N / BM; nwg = nM * nN; G = G_; c = c_; }
    __host__ __device__ bool next(int i, Unit& u) const {
        const long L = (long)i * G + c; if (L >= nwg) return false;
        int wgid = (int)L; { const int q = nwg / NXCD, r = nwg % NXCD, xcd = wgid % NXCD, off = wgid / NXCD; wgid = (xcd < r ? xcd * (q + 1) : r * (q + 1) + (xcd - r) * q) + off; }
        const int nig = WGM * nN, gid = wgid / nig, fm = gid * WGM, gsz = (nM - fm) < WGM ? (nM - fm) : WGM;
        u.pm = fm + ((wgid % nig) % gsz); u.pn = (wgid % nig) / gsz; return true;
    }
    __device__ __forceinline__ bool half_only(const Unit&) const { return false; }
    __device__ __forceinline__ void a_ready(const Unit&) const {}
    __device__ __forceinline__ void done(const Unit&) const {}
};

template <class Epi, class Sched, bool ALIGN_EPI = false, bool SP2 = false>
__device__ __forceinline__ void gemm_phase(PG8_LAS unsigned char* lds, const Gemm g, const Sched& S, const Epi& E) {
    const int tid = opaque_tid(), wid = __builtin_amdgcn_readfirstlane(tid >> 6), lane = tid & 63, wr = wid >> 2, wc = wid & 3, fr = lane & 15, fq = lane >> 4;
    const int K = g.K, nt = K / BK;
    unsigned voffA[2], voffB[2];
#pragma unroll
    for (int i = 0; i < 2; ++i) { int R, C; stage_rc(tid * 16 + i * 8192, R, C); const int Rb = Epi::PERM ? ((R & ~31) + perm32(R & 31)) : R;
        voffA[i] = (unsigned)(R * K + C) * 2u; voffB[i] = (unsigned)(Rb * K + C) * 2u; }
    const size_t kstep = (size_t)(BK * 2);
    const size_t hstep = (size_t)HALF * K * 2;
    const size_t tstep = 2 * hstep;
    const unsigned ldsw = (unsigned)wid * 1024u;
    const int aoff = lds_byte(wr * 64 + fr, fq * 8), boff = lds_byte(wc * 32 + fr, fq * 8);
#define PG8_SA(b, h) (((b) * 2 + (h)) * HTB)
#define PG8_SB(b, h) ((4 + (b) * 2 + (h)) * HTB)
#define PG8_STAGE(bufoff, gbase, voff) do { _Pragma("unroll") for (int _i = 0; _i < 2; ++_i) \
        __builtin_amdgcn_global_load_lds((const unsigned*)((const char*)(gbase) + (voff)[_i]), (PG8_LAS unsigned*)(lds + (bufoff) + ldsw + _i * 8192), 16, 0, 0); } while (0)
#define PG8_LDA(dst, b, h) do { _Pragma("unroll") for (int m = 0; m < 4; ++m) _Pragma("unroll") for (int k = 0; k < 2; ++k) dst[m][k] = *(const PG8_LAS bf16x8*)(lds + PG8_SA(b, h) + aoff + m * 2048 + k * 1024); } while (0)
#define PG8_LDB(dst, b, h) do { _Pragma("unroll") for (int n = 0; n < 2; ++n) _Pragma("unroll") for (int k = 0; k < 2; ++k) dst[n][k] = *(const PG8_LAS bf16x8*)(lds + PG8_SB(b, h) + boff + n * 2048 + k * 1024); } while (0)
#define PG8_MMA(ai, bj, At, Bt) do { __builtin_amdgcn_s_setprio(1); _Pragma("unroll") for (int m = 0; m < 4; ++m) _Pragma("unroll") for (int n = 0; n < 2; ++n) _Pragma("unroll") for (int k = 0; k < 2; ++k) \
        acc[ai][bj][m][n] = __builtin_amdgcn_mfma_f32_16x16x32_bf16(Bt[n][k], At[m][k], acc[ai][bj][m][n], 0, 0, 0); __builtin_amdgcn_s_setprio(0); } while (0)
#define PG8_WAIT_V(n) asm volatile("s_waitcnt vmcnt(" #n ")" ::: "memory")
#define PG8_WAIT_L(n) asm volatile("s_waitcnt lgkmcnt(" #n ")" ::: "memory")
#define PG8_BAR __builtin_amdgcn_s_barrier()
#define PG8_SCHED __builtin_amdgcn_sched_barrier(0)
    Unit cur, nxt; int ui = 0;
    if (!S.next(0, cur)) return;
    f32x4 acc[2][2][4][2];
#pragma unroll
    for (int a = 0; a < 2; ++a)
#pragma unroll
        for (int b = 0; b < 2; ++b)
#pragma unroll
            for (int m = 0; m < 4; ++m)
#pragma unroll
                for (int n = 0; n < 2; ++n) acc[a][b][m][n] = (f32x4){0.f, 0.f, 0.f, 0.f};
    bf16x8 At[4][2], B0[2][2], B1[2][2];
    const char* cA = (const char*)g.A + (size_t)cur.pm * tstep; const char* cB = (const char*)g.Bt + (size_t)cur.pn * tstep;
    S.a_ready(cur);
    if constexpr (SP2) {
        PG8_STAGE(PG8_SB(0, 0), cB, voffB); PG8_STAGE(PG8_SB(0, 1), cB + hstep, voffB); PG8_STAGE(PG8_SA(0, 0), cA, voffA); PG8_STAGE(PG8_SA(0, 1), cA + hstep, voffA);
        if (wr == 1) PG8_BAR;
        PG8_WAIT_V(2); PG8_BAR;
        PG8_STAGE(PG8_SB(1, 0), cB + kstep, voffB); PG8_STAGE(PG8_SA(1, 0), cA + kstep, voffA); PG8_STAGE(PG8_SB(1, 1), cB + hstep + kstep, voffB);
        PG8_WAIT_V(6); PG8_BAR;
    } else {
        PG8_STAGE(PG8_SB(0, 0), cB, voffB); PG8_STAGE(PG8_SA(0, 0), cA, voffA); PG8_STAGE(PG8_SB(0, 1), cB + hstep, voffB); PG8_STAGE(PG8_SA(0, 1), cA + hstep, voffA);
        if (wr == 1) PG8_BAR;
        PG8_WAIT_V(4); PG8_BAR;
        PG8_STAGE(PG8_SB(1, 0), cB + kstep, voffB); PG8_STAGE(PG8_SA(1, 0), cA + kstep, voffA); PG8_STAGE(PG8_SB(1, 1), cB + hstep + kstep, voffB);
        PG8_WAIT_V(6); PG8_BAR;
    }
    for (;;) {
        const bool has_next = S.next(ui + 1, nxt);
        const char* nA = has_next ? (const char*)g.A + (size_t)nxt.pm * tstep : cA; const char* nB = has_next ? (const char*)g.Bt + (size_t)nxt.pn * tstep : cB;
        for (int t = 0; t < nt; t += 2) {
            const bool last = (t == nt - 2);
            const char* a1 = cA + (size_t)(t + 1) * kstep;
            const char* a2 = last ? nA : cA + (size_t)(t + 2) * kstep; const char* b2 = last ? nB : cB + (size_t)(t + 2) * kstep;
            const char* a3 = a2 + kstep; const char* b3 = b2 + kstep;
            if (last && has_next) S.a_ready(nxt);
            if constexpr (SP2) {
            PG8_LDB(B0, 0, 0); PG8_LDB(B1, 0, 1); PG8_SCHED; PG8_LDA(At, 0, 0); PG8_STAGE(PG8_SA(1, 1), a1 + hstep, voffA);
            PG8_WAIT_V(8); PG8_WAIT_L(0); PG8_BAR; PG8_MMA(0, 0, At, B0); PG8_MMA(0, 1, At, B1); PG8_BAR; PG8_SCHED;
            PG8_LDA(At, 0, 1); PG8_STAGE(PG8_SB(0, 0), b2, voffB); PG8_STAGE(PG8_SB(0, 1), b2 + hstep, voffB); PG8_STAGE(PG8_SA(0, 0), a2, voffA);
            PG8_WAIT_V(8); PG8_WAIT_L(0); PG8_BAR; PG8_MMA(1, 0, At, B0); PG8_MMA(1, 1, At, B1); PG8_BAR; PG8_SCHED;
            PG8_LDB(B0, 1, 0); PG8_LDB(B1, 1, 1); PG8_SCHED; PG8_LDA(At, 1, 0); PG8_STAGE(PG8_SA(0, 1), a2 + hstep, voffA);
            PG8_WAIT_V(8); PG8_WAIT_L(0); PG8_BAR; PG8_MMA(0, 0, At, B0); PG8_MMA(0, 1, At, B1); PG8_BAR; PG8_SCHED;
            PG8_LDA(At, 1, 1); PG8_STAGE(PG8_SB(1, 0), b3, voffB); PG8_STAGE(PG8_SB(1, 1), b3 + hstep, voffB); PG8_STAGE(PG8_SA(1, 0), a3, voffA);
            PG8_WAIT_V(8); PG8_WAIT_L(0); PG8_BAR; PG8_MMA(1, 0, At, B0); PG8_MMA(1, 1, At, B1); PG8_BAR; PG8_SCHED;
            } else {
            PG8_LDB(B0, 0, 0); PG8_SCHED; PG8_LDA(At, 0, 0); PG8_STAGE(PG8_SA(1, 1), a1 + hstep, voffA);
            PG8_WAIT_L(8); PG8_BAR; PG8_WAIT_L(0); PG8_MMA(0, 0, At, B0); PG8_BAR; PG8_SCHED;
            PG8_LDB(B1, 0, 1); PG8_STAGE(PG8_SB(0, 0), b2, voffB);
            PG8_BAR; PG8_WAIT_L(0); PG8_MMA(0, 1, At, B1); PG8_BAR;
            PG8_LDA(At, 0, 1); PG8_STAGE(PG8_SA(0, 0), a2, voffA);
            PG8_BAR; PG8_WAIT_L(0); PG8_MMA(1, 0, At, B0); PG8_BAR; PG8_SCHED;
            PG8_STAGE(PG8_SB(0, 1), b2 + hstep, voffB);
            PG8_WAIT_V(6); PG8_BAR; PG8_MMA(1, 1, At, B1); PG8_BAR;
            PG8_LDB(B0, 1, 0); PG8_SCHED; PG8_LDA(At, 1, 0); PG8_STAGE(PG8_SA(0, 1), a2 + hstep, voffA);
            PG8_WAIT_L(8); PG8_BAR; PG8_WAIT_L(0); PG8_MMA(0, 0, At, B0); PG8_BAR; PG8_SCHED;
            PG8_LDB(B1, 1, 1); PG8_STAGE(PG8_SB(1, 0), b3, voffB);
            PG8_BAR; PG8_WAIT_L(0); PG8_MMA(0, 1, At, B1); PG8_BAR;
            PG8_LDA(At, 1, 1); PG8_STAGE(PG8_SA(1, 0), a3, voffA);
            PG8_BAR; PG8_WAIT_L(0); PG8_MMA(1, 0, At, B0); PG8_BAR; PG8_SCHED;
            PG8_STAGE(PG8_SB(1, 1), b3 + hstep, voffB);
            PG8_WAIT_V(6); PG8_BAR; PG8_MMA(1, 1, At, B1); PG8_BAR;
            }
        }
        if constexpr (ALIGN_EPI) { if (wr == 0) PG8_BAR; }
        if constexpr (!Epi::AFTER_DRAIN) { E(acc, cur, wr, wc, fr, fq); S.done(cur); }
        if (!has_next) break;
#pragma unroll
        for (int a = 0; a < 2; ++a)
#pragma unroll
            for (int b = 0; b < 2; ++b)
#pragma unroll
                for (int m = 0; m < 4; ++m)
#pragma unroll
                    for (int n = 0; n < 2; ++n) acc[a][b][m][n] = (f32x4){0.f, 0.f, 0.f, 0.f};
        cur = nxt; cA = nA; cB = nB; ++ui;
        if constexpr (ALIGN_EPI) { if (wr == 1) PG8_BAR; }
    }
    PG8_WAIT_V(0);
    if constexpr (!ALIGN_EPI) { if (wr == 0) PG8_BAR; }
    PG8_BAR;
    if constexpr (Epi::AFTER_DRAIN) { E.fused(acc, cur, wr, wc, fr, fq, lds, wid, lane); S.done(cur); }
#undef PG8_SA
#undef PG8_SB
#undef PG8_STAGE
#undef PG8_LDA
#undef PG8_LDB
#undef PG8_MMA
#undef PG8_WAIT_V
#undef PG8_WAIT_L
#undef PG8_BAR
#undef PG8_SCHED
}
}

constexpr int NWAVES = 8;
constexpr int M = 16384, D = 1024, NIN = 4096, HSEC = 512;
constexpr int NEXP = 32, DEXP = 512, MAXTILES = 160, MAXSLOTS = MAXTILES * 256;
constexpr float QSCALE = 0.18033688011112042f;

constexpr size_t MiB = 1u << 20;
constexpr size_t WS_CTL = 0, CTL_ZERO_BYTES = 1 * MiB;
constexpr size_t WS_WR = 1 * MiB;
constexpr size_t WS_ROPE = 2 * MiB;
constexpr size_t WS_HD = 3 * MiB;
constexpr size_t WS_TOKE = 3 * MiB + 256 * 1024, WS_TOKW = WS_TOKE + 128 * 1024, WS_TOKR = WS_TOKW + 128 * 1024, WS_TOKS = WS_TOKR + 128 * 1024, WS_LAM = WS_TOKS + 128 * 1024, WS_GCNT = WS_LAM + 128 * 1024, WS_RSTD = 1 * MiB + 256 * 1024, WS_RSLOT = 1 * MiB + 768 * 1024, WS_PERM = 1 * MiB + 512 * 1024;
constexpr size_t WS_WOUT = 4 * MiB, WS_WIN = 6 * MiB;
constexpr size_t WS_XN = 16 * MiB;
constexpr size_t WS_OF = 16 * MiB;
constexpr size_t WS_X2B = 16 * MiB;
constexpr size_t WS_HM = 144 * MiB;
constexpr size_t WS_QH = 48 * MiB, WS_VH = 64 * MiB, WS_SG = 80 * MiB, WS_QD = 96 * MiB, WS_KD = 112 * MiB, WS_VD = 128 * MiB;
constexpr size_t WS_WGU = 48 * MiB, WS_WD = 216 * MiB;
constexpr size_t WS_GF = 144 * MiB, WS_GB = 176 * MiB;
constexpr size_t WS_MIX = 144 * MiB;
constexpr size_t WS_HS = 208 * MiB, WS_HL = 224 * MiB;
constexpr size_t WS_OB = 224 * MiB;
constexpr size_t WS_HG = 176 * MiB;
constexpr size_t WS_O0S = 176 * MiB;
constexpr size_t WS_Y = 48 * MiB;
constexpr size_t WS_END = 256 * MiB;
static_assert(WS_Y + (size_t)MAXSLOTS * 1024 * 2 <= WS_HM && WS_HM + (size_t)MAXSLOTS * 512 * 2 <= WS_WD && WS_WD + 32 * MiB <= WS_END, "ws map");
constexpr int CW_BAR = 4096, CW_CNT = 16384, CW_KMAX = 20480, CW_QWD = 21504, CW_READY = 32768, CNT_STRIDE = 64;

constexpr int PHASE_LDS = 147456, MISC_OFF = PHASE_LDS, LDS_BYTES = PHASE_LDS + 1024;

#define GAS __attribute__((address_space(1)))
#define LAS __attribute__((address_space(3)))
typedef unsigned short bf16_t;
typedef _Float16 half_t;
typedef float f32x4 __attribute__((ext_vector_type(4)));
typedef float f32x16 __attribute__((ext_vector_type(16)));
typedef short bf16x8 __attribute__((ext_vector_type(8)));
typedef short s16x4 __attribute__((ext_vector_type(4)));
typedef unsigned u32x4 __attribute__((ext_vector_type(4)));
typedef unsigned u32x2 __attribute__((ext_vector_type(2)));
#define LDS_WAIT() asm volatile("s_waitcnt lgkmcnt(0)" ::: "memory")
#define VM_WAIT() asm volatile("s_waitcnt vmcnt(0)" ::: "memory")
#define SBAR() __builtin_amdgcn_sched_barrier(0)
__device__ __forceinline__ unsigned f2bf(float f) { unsigned u = __builtin_bit_cast(unsigned, f); return (u + 0x7fffu + ((u >> 16) & 1u)) >> 16; }
__device__ __forceinline__ unsigned pk2(float lo, float hi) { return f2bf(lo) | (f2bf(hi) << 16); }
__device__ __forceinline__ float bf2f(unsigned b) { return __builtin_bit_cast(float, b << 16); }
__device__ __forceinline__ float bflo(unsigned w) { return __builtin_bit_cast(float, w << 16); }
__device__ __forceinline__ float bfhi(unsigned w) { return __builtin_bit_cast(float, w & 0xffff0000u); }
__device__ __forceinline__ unsigned cvtpk(float lo, float hi) { unsigned r; asm volatile("v_cvt_pk_bf16_f32 %0, %1, %2" : "=v"(r) : "v"(lo), "v"(hi)); return r; }
__device__ __forceinline__ float ex2(float x) { return __builtin_amdgcn_exp2f(x); }
__device__ __forceinline__ float lg2(float x) { return __builtin_amdgcn_logf(x); }
__device__ __forceinline__ float sigmoidf_(float v) { return __builtin_amdgcn_rcpf(1.f + ex2(-1.4426950408889634f * v)); }
__device__ __forceinline__ bool lane_is_hi() { return (opaque_tid() & 32) != 0; }
template <int X> __device__ __forceinline__ float lane_xor(float v) {
    if constexpr (X == 32) { auto rr = __builtin_amdgcn_permlane32_swap(__float_as_uint(v), __float_as_uint(v), false, false); return __uint_as_float(lane_is_hi() ? rr[0] : rr[1]); }
    else return __int_as_float(__builtin_amdgcn_ds_swizzle(__float_as_int(v), (X << 10) | 0x1F));
}
__device__ __forceinline__ float wave_sum(float v) {
    v += lane_xor<1>(v); v += lane_xor<2>(v); v += lane_xor<4>(v); v += lane_xor<8>(v); v += lane_xor<16>(v);
    auto rr = __builtin_amdgcn_permlane32_swap(__float_as_uint(v), __float_as_uint(v), false, false);
    return __uint_as_float(rr[0]) + __uint_as_float(rr[1]);
}
__device__ __forceinline__ int crow(int r, int hi) { return (r & 3) + 8 * (r >> 2) + 4 * hi; }
#define XB_TMO      128
#define XB_XCNT(j)  (256  + 64 * (j))
#define XB_XSUB(j)  (1280 + 64 * (j))
#define XB_XGEN(j)  (2304 + 64 * (j))
#define XB_TOP      3328
#define XB_TOPGEN   3392
#define XCD_BAR_WORDS 3456
#define XB_SPIN_CAP (1u << 18)

__device__ __forceinline__ unsigned xb_ld(unsigned* p)              { return __hip_atomic_load(p, __ATOMIC_RELAXED, __HIP_MEMORY_SCOPE_AGENT); }
__device__ __forceinline__ unsigned xb_add(unsigned* p, unsigned v) { return __hip_atomic_fetch_add(p, v, __ATOMIC_RELAXED, __HIP_MEMORY_SCOPE_AGENT); }
__device__ __forceinline__ unsigned xb_xcc_id() { return (unsigned)__builtin_amdgcn_s_getreg((3 << 11) | 20) & 0xFu; }
#define XB_SPIN(cond, bar) do { unsigned _sp = 0; while (cond) { __builtin_amdgcn_s_sleep(1); \
    if ((++_sp & 255u) == 0u) { if (xb_ld(&(bar)[XB_TMO])) break; if (_sp > XB_SPIN_CAP) { atomicAdd(&(bar)[XB_TMO], 1u); break; } } } } while (0)

struct XcdBarrier {
    unsigned* bar; unsigned x;
    volatile LAS unsigned* st;
};

__device__ __forceinline__ XcdBarrier xcd_barrier_post(unsigned* bar, volatile LAS unsigned* st) {
    XcdBarrier b; b.bar = bar; b.x = xb_xcc_id(); b.st = st;
    if (threadIdx.x == 0) (void)xb_add(&bar[XB_XCNT(b.x)], 1u);
    return b;
}
__device__ __forceinline__ void xcd_barrier_complete(unsigned* bar, unsigned x, unsigned& nloc, unsigned& nx) {
    const unsigned G = gridDim.x * gridDim.y * gridDim.z;
    unsigned sum, cnt, mine, sp = 0u;
    for (;;) {
        sum = 0u; cnt = 0u; mine = 0u;
#pragma unroll
        for (unsigned j = 0; j < 16; ++j) { const unsigned c = xb_ld(&bar[XB_XCNT(j)]); sum += c; cnt += (c > 0u) ? 1u : 0u; mine = (j == x) ? c : mine; }
        if (sum == G) break;
        __builtin_amdgcn_s_sleep(1);
        if ((++sp & 255u) == 0u) { if (xb_ld(&bar[XB_TMO])) break; if (sp > XB_SPIN_CAP) { atomicAdd(&bar[XB_TMO], 1u); break; } }
    }
    nloc = mine > 0u ? mine : 1u; nx = cnt > 0u ? cnt : 1u;
}

__device__ __forceinline__ void xcd_barrier(const XcdBarrier& b) {
    asm volatile("s_waitcnt vmcnt(0)" ::: "memory");
    __syncthreads();
    if (threadIdx.x == 0) {
        unsigned* bar = b.bar;
        __builtin_amdgcn_s_waitcnt(0);
        unsigned nloc = b.st[0], nx = b.st[1];
        if (nloc == 0u) { xcd_barrier_complete(bar, b.x, nloc, nx); b.st[0] = nloc; b.st[1] = nx; }
        const unsigned old = xb_add(&bar[XB_XSUB(b.x)], 1u);
        const unsigned gen = old / nloc;
        if (old + 1u == (gen + 1u) * nloc) {
            __builtin_amdgcn_fence(__ATOMIC_RELEASE, "agent");
            asm volatile("s_waitcnt vmcnt(0)" ::: "memory");
            const unsigned og = xb_add(&bar[XB_TOP], 1u);
            const unsigned tg = og / nx;
            if (og + 1u == (tg + 1u) * nx) xb_add(&bar[XB_TOPGEN], 1u);
            else XB_SPIN(xb_ld(&bar[XB_TOPGEN]) == tg, bar);
            __builtin_amdgcn_fence(__ATOMIC_ACQUIRE, "agent");
            xb_add(&bar[XB_XGEN(b.x)], 1u);
            asm volatile("s_waitcnt vmcnt(0)" ::: "memory");
        } else {
            XB_SPIN(xb_ld(&bar[XB_XGEN(b.x)]) == gen, bar);
            __builtin_amdgcn_fence(__ATOMIC_ACQUIRE, "agent");
            asm volatile("s_waitcnt vmcnt(0)" ::: "memory");
        }
    }
    __syncthreads();
}

struct XposeRegs { f32x4 v[8]; };
__device__ __forceinline__ void xpose_load(XposeRegs& R, const float* W, int K, int N, int item, int lane) {
    const int nblk = N / 32, kb = item / nblk, nb = item % nblk, k0 = 64 * kb, n0 = 32 * nb; (void)K;
    const float* p = W + (size_t)(k0 + (lane >> 3)) * N + n0 + (lane & 7) * 4;
#pragma unroll
    for (int i = 0; i < 8; ++i) R.v[i] = __builtin_nontemporal_load((const GAS f32x4*)(p + (size_t)(8 * i) * N));
}
__device__ __forceinline__ void xpose_store(const XposeRegs& R, int K, int N, bf16_t* WT, int row_off, int row_mul, LAS float* scr, int item, int lane, const float* kgain = nullptr) {
    const int nblk = N / 32, kb = item / nblk, nb = item % nblk, k0 = 64 * kb, n0 = 32 * nb;
#pragma unroll
    for (int i = 0; i < 8; ++i) { LAS float* d = scr + (8 * i + (lane >> 3)) * 33 + (lane & 7) * 4; d[0] = R.v[i].x; d[1] = R.v[i].y; d[2] = R.v[i].z; d[3] = R.v[i].w; }
    LDS_WAIT(); asm volatile("" ::: "memory");
    const int c = lane & 7;
    f32x4 g0 = {1.f, 1.f, 1.f, 1.f}, g1 = g0;
    if (kgain) { g0 = *(const GAS f32x4*)(kgain + k0 + 8 * c); g1 = *(const GAS f32x4*)(kgain + k0 + 8 * c + 4); }
#pragma unroll
    for (int j = 0; j < 4; ++j) { const int n = (lane >> 3) + 8 * j; const LAS float* s = scr + (8 * c) * 33 + n;
        u32x4 o; o.x = cvtpk(s[0 * 33] * g0.x, s[1 * 33] * g0.y); o.y = cvtpk(s[2 * 33] * g0.z, s[3 * 33] * g0.w); o.z = cvtpk(s[4 * 33] * g1.x, s[5 * 33] * g1.y); o.w = cvtpk(s[6 * 33] * g1.z, s[7 * 33] * g1.w);
        *(GAS u32x4*)(WT + (size_t)(row_off + (n0 + n) * row_mul) * K + k0 + 8 * c) = o; }
    LDS_WAIT(); asm volatile("" ::: "memory");
}
template <int NR>
__device__ __forceinline__ void rms_rows_to_bf16(const float* X, const float* gain, bf16_t* O, int m0, int stride, int lane, float eps) {
    f32x4 v[NR][4]; float s[NR];
#pragma unroll
    for (int i = 0; i < NR; ++i) { const GAS f32x4* xr = (const GAS f32x4*)(X + (size_t)(m0 + i * stride) * D) + lane;
#pragma unroll
        for (int j = 0; j < 4; ++j) v[i][j] = xr[64 * j]; }
#pragma unroll
    for (int i = 0; i < NR; ++i) { float t = 0.f;
#pragma unroll
        for (int j = 0; j < 4; ++j) t += (v[i][j].x * v[i][j].x + v[i][j].y * v[i][j].y) + (v[i][j].z * v[i][j].z + v[i][j].w * v[i][j].w);
        s[i] = t; }
#pragma unroll
    for (int i = 0; i < NR; ++i) s[i] = 1.f / sqrtf(wave_sum(s[i]) * (1.f / 1024.f) + eps);
#pragma unroll
    for (int j = 0; j < 4; ++j) { const f32x4 g = ((const GAS f32x4*)gain)[64 * j + lane];
#pragma unroll
        for (int i = 0; i < NR; ++i) { u32x2 w; w.x = cvtpk(v[i][j].x * s[i] * g.x, v[i][j].y * s[i] * g.y); w.y = cvtpk(v[i][j].z * s[i] * g.z, v[i][j].w * s[i] * g.w);
            ((GAS u32x2*)(O + (size_t)(m0 + i * stride) * D) + lane)[64 * j] = w; } }
}

struct EpiInProj {
    static constexpr bool PERM = true, AFTER_DRAIN = false;
    bf16_t *QH, *VH, *SG, *QD, *KD, *VD; half_t *GF, *GB; const float* lbraw; const float *cosT, *sinT;
    __device__ __forceinline__ void operator()(const pg8::f32x4 (&acc)[2][2][4][2], const pg8::Unit& u, int wr, int wc, int fr, int fq) const {
        const int sec = u.pn >> 1;
        const int row0 = u.pm * 256 + wr * 64 + fr;
        const int cs0 = (u.pn & 1) * 256 + wc * 32 + 8 * fq;
        if (sec == 1 || sec == 2) {
            half_t* G = sec == 1 ? GF : GB; const float* lbp = lbraw + (sec - 1) * 1024;
#pragma unroll
            for (int bj = 0; bj < 2; ++bj) { const int c = cs0 + bj * 128; float lb[8];
#pragma unroll
                for (int j = 0; j < 8; ++j) { const float l0 = lbp[c + j], l1 = lbp[512 + c + j]; lb[j] = __builtin_amdgcn_rcpf(1.f + ex2(1.4426950408889634f * (l0 - l1))); }
#pragma unroll
                for (int ai = 0; ai < 2; ++ai)
#pragma unroll
                    for (int m = 0; m < 4; ++m) { const int row = row0 + ai * 128 + m * 16; f32x4 o0, o1;
#pragma unroll
                        for (int j = 0; j < 4; ++j) { o0[j] = lb[j] + (1.f - lb[j]) * sigmoidf_(acc[ai][bj][m][0][j]); o1[j] = lb[4 + j] + (1.f - lb[4 + j]) * sigmoidf_(acc[ai][bj][m][1][j]); }
                        typedef _Float16 h8 __attribute__((ext_vector_type(8)));
                        const h8 hv = {(_Float16)o0[0], (_Float16)o0[1], (_Float16)o0[2], (_Float16)o0[3], (_Float16)o1[0], (_Float16)o1[1], (_Float16)o1[2], (_Float16)o1[3]};
                        *(h8*)(G + (size_t)row * HSEC + c) = hv; } }
            return;
        }
        bf16_t* O = sec == 0 ? QH : sec == 3 ? VH : sec == 4 ? SG : sec == 5 ? QD : sec == 6 ? KD : VD;
        const bool rot = (sec == 5 || sec == 6) && ((wc & 1) == 0);
        const float sc = sec == 5 ? QSCALE : 1.f;
#pragma unroll
        for (int ai = 0; ai < 2; ++ai)
#pragma unroll
            for (int m = 0; m < 4; ++m) { const int row = row0 + ai * 128 + m * 16;
#pragma unroll
                for (int bj = 0; bj < 2; ++bj) { const int c = cs0 + bj * 128; float v[8];
#pragma unroll
                    for (int j = 0; j < 4; ++j) { v[j] = acc[ai][bj][m][0][j]; v[4 + j] = acc[ai][bj][m][1][j]; }
                    if (sec == 4) {
#pragma unroll
                        for (int j = 0; j < 8; ++j) v[j] = v[j] * sigmoidf_(v[j]);
                    }
                    if (rot) {
                        const f32x4 c0 = *(const f32x4*)(cosT + (size_t)row * 8), c1 = *(const f32x4*)(cosT + (size_t)row * 8 + 4);
                        const f32x4 s0 = *(const f32x4*)(sinT + (size_t)row * 8), s1 = *(const f32x4*)(sinT + (size_t)row * 8 + 4);
#pragma unroll
                        for (int j = 0; j < 8; ++j) { const float p = lane_xor<16>(v[j]); const float cj = j < 4 ? c0[j & 3] : c1[j & 3], sj = j < 4 ? s0[j & 3] : s1[j & 3];
                            const float r = fq == 0 ? v[j] * cj - p * sj : v[j] * cj + p * sj; v[j] = fq < 2 ? r : v[j]; }
                    }
                    u32x4 w; w.x = cvtpk(v[0] * sc, v[1] * sc); w.y = cvtpk(v[2] * sc, v[3] * sc); w.z = cvtpk(v[4] * sc, v[5] * sc); w.w = cvtpk(v[6] * sc, v[7] * sc);
                    *(u32x4*)(O + (size_t)row * HSEC + c) = w; } }
    }
};
struct EpiResid {
    static constexpr bool PERM = true, AFTER_DRAIN = false;
    const float* X; bf16_t* O;
    __device__ __forceinline__ void operator()(const pg8::f32x4 (&acc)[2][2][4][2], const pg8::Unit& u, int wr, int wc, int fr, int fq) const {
        const int row0 = u.pm * 256 + wr * 64 + fr, col0 = u.pn * 256 + wc * 32 + 8 * fq;
#pragma unroll
        for (int ai = 0; ai < 2; ++ai)
#pragma unroll
            for (int m = 0; m < 4; ++m) { const size_t off = (size_t)(row0 + ai * 128 + m * 16) * D + col0;
#pragma unroll
                for (int bj = 0; bj < 2; ++bj) { const f32x4 a = *(const f32x4*)(X + off + bj * 128) + acc[ai][bj][m][0], b = *(const f32x4*)(X + off + bj * 128 + 4) + acc[ai][bj][m][1];
                    u32x4 w; w.x = cvtpk(a[0], a[1]); w.y = cvtpk(a[2], a[3]); w.z = cvtpk(b[0], b[1]); w.w = cvtpk(b[2], b[3]); *(u32x4*)(O + off + bj * 128) = w; } }
    }
};
struct EpiSwiGlu {
    static constexpr bool PERM = true, AFTER_DRAIN = false;
    bf16_t* O; const float* RS;
    __device__ __forceinline__ void operator()(const pg8::f32x4 (&acc)[2][2][4][2], const pg8::Unit& u, int wr, int wc, int fr, int fq) const {
        const int row0 = u.pm * 256 + wr * 64 + fr, col0 = ((u.pn & 3) * 256 + wc * 32 + 8 * fq) >> 1;
#pragma unroll
        for (int ai = 0; ai < 2; ++ai)
#pragma unroll
            for (int m = 0; m < 4; ++m) { const int row = row0 + ai * 128 + m * 16; const float rs = RS[row]; bf16_t* rowp = O + (size_t)row * DEXP + col0;
#pragma unroll
                for (int bj = 0; bj < 2; ++bj) { const f32x4 a = acc[ai][bj][m][0] * rs, b = acc[ai][bj][m][1] * rs;
                    const float h0 = a[0] * sigmoidf_(a[0]) * a[1], h1 = a[2] * sigmoidf_(a[2]) * a[3], h2 = b[0] * sigmoidf_(b[0]) * b[1], h3 = b[2] * sigmoidf_(b[2]) * b[3];
                    u32x2 w; w.x = cvtpk(h0, h1); w.y = cvtpk(h2, h3); *(u32x2*)(rowp + bj * 64) = w; } }
    }
};
struct EpiDown {
    static constexpr bool PERM = true, AFTER_DRAIN = false;
    bf16_t* O;
    __device__ __forceinline__ void operator()(const pg8::f32x4 (&acc)[2][2][4][2], const pg8::Unit& u, int wr, int wc, int fr, int fq) const {
        const int row0 = u.pm * 256 + wr * 64 + fr, col0 = (u.pn & 3) * 256 + wc * 32 + 8 * fq;
#pragma unroll
        for (int ai = 0; ai < 2; ++ai)
#pragma unroll
            for (int m = 0; m < 4; ++m) { bf16_t* rowp = O + (size_t)(row0 + ai * 128 + m * 16) * D + col0;
#pragma unroll
                for (int bj = 0; bj < 2; ++bj) { const f32x4 a = acc[ai][bj][m][0], b = acc[ai][bj][m][1];
                    u32x4 w; w.x = cvtpk(a[0], a[1]); w.y = cvtpk(a[2], a[3]); w.z = cvtpk(b[0], b[1]); w.w = cvtpk(b[2], b[3]); *(u32x4*)(rowp + bj * 128) = w; } }
    }
};
struct MoeOrder {
    const volatile LAS int* tb; int G, c; const int* PERM; unsigned* ready; int mode;
    __device__ __forceinline__ bool decode(int L, pg8::Unit& u) const {
        const int x = c & 7; int base = 0;
#pragma unroll 1
        for (int k = 0; k < 4; ++k) { const int e = 4 * x + k, t0 = __builtin_amdgcn_readfirstlane(tb[e]), nt = __builtin_amdgcn_readfirstlane(tb[e + 1]) - t0;
            if (L < base + 4 * nt) { const int idx = L - base; u.pm = t0 + idx % nt; u.pn = e * 4 + idx / nt; return true; }
            base += 4 * nt; }
        return false;
    }
    __device__ __forceinline__ bool next(int i, pg8::Unit& u) const {
        if ((G & 7) == 0) {
            const int x = c & 7, s = c >> 3, nb = G >> 3;
            const int U = 4 * (__builtin_amdgcn_readfirstlane(tb[4 * x + 4]) - __builtin_amdgcn_readfirstlane(tb[4 * x]));
            if (mode == 0) return decode(i * nb + s, u);
            const int i0 = s < U ? (U - s + nb - 1) / nb : 0;
            return decode((i0 + i) * nb + s - U, u);
        }
        const int L = i * G + c, T = __builtin_amdgcn_readfirstlane(tb[32]); if (L >= 4 * T) return false;
        const int tile = L >> 2; int e = 0;
#pragma unroll 1
        for (int j = 1; j < 32; ++j) e += (__builtin_amdgcn_readfirstlane(tb[j]) <= tile) ? 1 : 0;
        u.pm = tile; u.pn = e * 4 + (L & 3); return true;
    }
    __device__ __forceinline__ int row_tok(const pg8::Unit& u, int r) const {
        const int e = u.pn >> 2, rem = __builtin_amdgcn_readfirstlane(tb[64 + e]) - (u.pm - __builtin_amdgcn_readfirstlane(tb[e])) * 256;
        return r < rem ? PERM[u.pm * 256 + r] : 0;
    }
    __device__ __forceinline__ bool half_only(const pg8::Unit&) const { return false; }
    __device__ __forceinline__ void done(const pg8::Unit& u) const {
        if (mode == 2) { asm volatile("s_waitcnt vmcnt(0)" ::: "memory");
            if ((threadIdx.x & 63) == 0) __hip_atomic_fetch_add(ready + 64 * u.pm, 1u, __ATOMIC_RELAXED, __HIP_MEMORY_SCOPE_AGENT); }
    }
    __device__ __forceinline__ void a_ready(const pg8::Unit& u) const {
        if (mode == 1) {
            if (threadIdx.x < 64) { const unsigned long long t0 = __builtin_amdgcn_s_memrealtime();
                while ((unsigned)__builtin_amdgcn_readfirstlane(__hip_atomic_load(ready + 64 * u.pm, __ATOMIC_RELAXED, __HIP_MEMORY_SCOPE_AGENT)) < 32u) {
                    if (__builtin_amdgcn_s_memrealtime() - t0 > 2000000ull) break;
                    __builtin_amdgcn_s_sleep(2); }
                __builtin_amdgcn_fence(__ATOMIC_ACQUIRE, "agent");
                asm volatile("s_waitcnt vmcnt(0)" ::: "memory"); }
            asm volatile("" ::: "memory"); __builtin_amdgcn_s_barrier(); asm volatile("" ::: "memory");
        }
    }
};
namespace pg8 {
template <class Epi, class Sched, bool ALIGN_EPI = false, bool SP2 = false>
__device__ __forceinline__ void gemm_phase_g(PG8_LAS unsigned char* lds, const Gemm g, const Sched& S, const Epi& E) {
    const int tid = opaque_tid(), wid = __builtin_amdgcn_readfirstlane(tid >> 6), lane = tid & 63, wr = wid >> 2, wc = wid & 3, fr = lane & 15, fq = lane >> 4;
    const int K = g.K, nt = K / BK;
    unsigned voffB[2]; int rowA[2]; unsigned colA[2];
#pragma unroll
    for (int i = 0; i < 2; ++i) { int R, C; stage_rc(tid * 16 + i * 8192, R, C); const int Rb = Epi::PERM ? ((R & ~31) + perm32(R & 31)) : R;
        rowA[i] = R; colA[i] = (unsigned)C * 2u; voffB[i] = (unsigned)(Rb * K + C) * 2u; }
    unsigned vAc[2][2], vAn[2][2];
#define PG8_GATHER(dst, u) do { _Pragma("unroll") for (int h_ = 0; h_ < 2; ++h_) _Pragma("unroll") for (int i_ = 0; i_ < 2; ++i_) dst[h_][i_] = (unsigned)S.row_tok(u, h_ * HALF + rowA[i_]) * (unsigned)(K * 2) + colA[i_]; } while (0)
    const size_t kstep = (size_t)(BK * 2);
    const size_t hstep = (size_t)HALF * K * 2;
    const size_t tstep = 2 * hstep;
    const unsigned ldsw = (unsigned)wid * 1024u;
    const int aoff = lds_byte(wr * 64 + fr, fq * 8), boff = lds_byte(wc * 32 + fr, fq * 8);
#define PG8_SA(b, h) (((b) * 2 + (h)) * HTB)
#define PG8_SB(b, h) ((4 + (b) * 2 + (h)) * HTB)
#define PG8_STAGE(bufoff, gbase, voff) do { _Pragma("unroll") for (int _i = 0; _i < 2; ++_i) \
        __builtin_amdgcn_global_load_lds((const unsigned*)((const char*)(gbase) + (voff)[_i]), (PG8_LAS unsigned*)(lds + (bufoff) + ldsw + _i * 8192), 16, 0, 0); } while (0)
#define PG8_LDA(dst, b, h) do { _Pragma("unroll") for (int m = 0; m < 4; ++m) _Pragma("unroll") for (int k = 0; k < 2; ++k) dst[m][k] = *(const PG8_LAS bf16x8*)(lds + PG8_SA(b, h) + aoff + m * 2048 + k * 1024); } while (0)
#define PG8_LDB(dst, b, h) do { _Pragma("unroll") for (int n = 0; n < 2; ++n) _Pragma("unroll") for (int k = 0; k < 2; ++k) dst[n][k] = *(const PG8_LAS bf16x8*)(lds + PG8_SB(b, h) + boff + n * 2048 + k * 1024); } while (0)
#define PG8_MMA(ai, bj, At, Bt) do { __builtin_amdgcn_s_setprio(1); _Pragma("unroll") for (int m = 0; m < 4; ++m) _Pragma("unroll") for (int n = 0; n < 2; ++n) _Pragma("unroll") for (int k = 0; k < 2; ++k) \
        acc[ai][bj][m][n] = __builtin_amdgcn_mfma_f32_16x16x32_bf16(Bt[n][k], At[m][k], acc[ai][bj][m][n], 0, 0, 0); __builtin_amdgcn_s_setprio(0); } while (0)
#define PG8_WAIT_V(n) asm volatile("s_waitcnt vmcnt(" #n ")" ::: "memory")
#define PG8_WAIT_L(n) asm volatile("s_waitcnt lgkmcnt(" #n ")" ::: "memory")
#define PG8_BAR __builtin_amdgcn_s_barrier()
#define PG8_SCHED __builtin_amdgcn_sched_barrier(0)
    Unit cur, nxt; int ui = 0;
    if (!S.next(0, cur)) return;
    f32x4 acc[2][2][4][2];
#pragma unroll
    for (int a = 0; a < 2; ++a)
#pragma unroll
        for (int b = 0; b < 2; ++b)
#pragma unroll
            for (int m = 0; m < 4; ++m)
#pragma unroll
                for (int n = 0; n < 2; ++n) acc[a][b][m][n] = (f32x4){0.f, 0.f, 0.f, 0.f};
    bf16x8 At[4][2], B0[2][2], B1[2][2];
    const char* cA = (const char*)g.A; PG8_GATHER(vAc, cur); const char* cB = (const char*)g.Bt + (size_t)cur.pn * tstep;
    S.a_ready(cur);
    if constexpr (SP2) {
        PG8_STAGE(PG8_SB(0, 0), cB, voffB); PG8_STAGE(PG8_SB(0, 1), cB + hstep, voffB); PG8_STAGE(PG8_SA(0, 0), cA, vAc[0]); PG8_STAGE(PG8_SA(0, 1), cA, vAc[1]);
        if (wr == 1) PG8_BAR;
        PG8_WAIT_V(2); PG8_BAR;
        PG8_STAGE(PG8_SB(1, 0), cB + kstep, voffB); PG8_STAGE(PG8_SA(1, 0), cA + kstep, vAc[0]); PG8_STAGE(PG8_SB(1, 1), cB + hstep + kstep, voffB);
        PG8_WAIT_V(6); PG8_BAR;
    } else {
        PG8_STAGE(PG8_SB(0, 0), cB, voffB); PG8_STAGE(PG8_SA(0, 0), cA, vAc[0]); PG8_STAGE(PG8_SB(0, 1), cB + hstep, voffB); PG8_STAGE(PG8_SA(0, 1), cA, vAc[1]);
        if (wr == 1) PG8_BAR;
        PG8_WAIT_V(4); PG8_BAR;
        PG8_STAGE(PG8_SB(1, 0), cB + kstep, voffB); PG8_STAGE(PG8_SA(1, 0), cA + kstep, vAc[0]); PG8_STAGE(PG8_SB(1, 1), cB + hstep + kstep, voffB);
        PG8_WAIT_V(6); PG8_BAR;
    }
    for (;;) {
        const bool has_next = S.next(ui + 1, nxt);
        const char* nA = cA; if (has_next) PG8_GATHER(vAn, nxt); else { _Pragma("unroll") for (int h_ = 0; h_ < 2; ++h_) _Pragma("unroll") for (int i_ = 0; i_ < 2; ++i_) vAn[h_][i_] = vAc[h_][i_]; } const char* nB = has_next ? (const char*)g.Bt + (size_t)nxt.pn * tstep : cB;
        for (int t = 0; t < nt; t += 2) {
            const bool last = (t == nt - 2);
            const char* a1 = cA + (size_t)(t + 1) * kstep;
            const char* a2 = last ? nA : cA + (size_t)(t + 2) * kstep; const char* b2 = last ? nB : cB + (size_t)(t + 2) * kstep;
            const char* a3 = a2 + kstep; const char* b3 = b2 + kstep;
            unsigned vA2[2][2]; _Pragma("unroll") for (int h_ = 0; h_ < 2; ++h_) _Pragma("unroll") for (int i_ = 0; i_ < 2; ++i_) vA2[h_][i_] = last ? vAn[h_][i_] : vAc[h_][i_];
            if (last && has_next) S.a_ready(nxt);
            if constexpr (SP2) {
            PG8_LDB(B0, 0, 0); PG8_LDB(B1, 0, 1); PG8_SCHED; PG8_LDA(At, 0, 0); PG8_STAGE(PG8_SA(1, 1), a1, vAc[1]);
            PG8_WAIT_V(8); PG8_WAIT_L(0); PG8_BAR; PG8_MMA(0, 0, At, B0); PG8_MMA(0, 1, At, B1); PG8_BAR; PG8_SCHED;
            PG8_LDA(At, 0, 1); PG8_STAGE(PG8_SB(0, 0), b2, voffB); PG8_STAGE(PG8_SB(0, 1), b2 + hstep, voffB); PG8_STAGE(PG8_SA(0, 0), a2, vA2[0]);
            PG8_WAIT_V(8); PG8_WAIT_L(0); PG8_BAR; PG8_MMA(1, 0, At, B0); PG8_MMA(1, 1, At, B1); PG8_BAR; PG8_SCHED;
            PG8_LDB(B0, 1, 0); PG8_LDB(B1, 1, 1); PG8_SCHED; PG8_LDA(At, 1, 0); PG8_STAGE(PG8_SA(0, 1), a2, vA2[1]);
            PG8_WAIT_V(8); PG8_WAIT_L(0); PG8_BAR; PG8_MMA(0, 0, At, B0); PG8_MMA(0, 1, At, B1); PG8_BAR; PG8_SCHED;
            PG8_LDA(At, 1, 1); PG8_STAGE(PG8_SB(1, 0), b3, voffB); PG8_STAGE(PG8_SB(1, 1), b3 + hstep, voffB); PG8_STAGE(PG8_SA(1, 0), a3, vA2[0]);
            PG8_WAIT_V(8); PG8_WAIT_L(0); PG8_BAR; PG8_MMA(1, 0, At, B0); PG8_MMA(1, 1, At, B1); PG8_BAR; PG8_SCHED;
            } else {
            PG8_LDB(B0, 0, 0); PG8_SCHED; PG8_LDA(At, 0, 0); PG8_STAGE(PG8_SA(1, 1), a1, vAc[1]);
            PG8_WAIT_L(8); PG8_BAR; PG8_WAIT_L(0); PG8_MMA(0, 0, At, B0); PG8_BAR; PG8_SCHED;
            PG8_LDB(B1, 0, 1); PG8_STAGE(PG8_SB(0, 0), b2, voffB);
            PG8_BAR; PG8_WAIT_L(0); PG8_MMA(0, 1, At, B1); PG8_BAR;
            PG8_LDA(At, 0, 1); PG8_STAGE(PG8_SA(0, 0), a2, vA2[0]);
            PG8_BAR; PG8_WAIT_L(0); PG8_MMA(1, 0, At, B0); PG8_BAR; PG8_SCHED;
            PG8_STAGE(PG8_SB(0, 1), b2 + hstep, voffB);
            PG8_WAIT_V(6); PG8_BAR; PG8_MMA(1, 1, At, B1); PG8_BAR;
            PG8_LDB(B0, 1, 0); PG8_SCHED; PG8_LDA(At, 1, 0); PG8_STAGE(PG8_SA(0, 1), a2, vA2[1]);
            PG8_WAIT_L(8); PG8_BAR; PG8_WAIT_L(0); PG8_MMA(0, 0, At, B0); PG8_BAR; PG8_SCHED;
            PG8_LDB(B1, 1, 1); PG8_STAGE(PG8_SB(1, 0), b3, voffB);
            PG8_BAR; PG8_WAIT_L(0); PG8_MMA(0, 1, At, B1); PG8_BAR;
            PG8_LDA(At, 1, 1); PG8_STAGE(PG8_SA(1, 0), a3, vA2[0]);
            PG8_BAR; PG8_WAIT_L(0); PG8_MMA(1, 0, At, B0); PG8_BAR; PG8_SCHED;
            PG8_STAGE(PG8_SB(1, 1), b3 + hstep, voffB);
            PG8_WAIT_V(6); PG8_BAR; PG8_MMA(1, 1, At, B1); PG8_BAR;
            }
        }
        if constexpr (ALIGN_EPI) { if (wr == 0) PG8_BAR; }
        if constexpr (!Epi::AFTER_DRAIN) { E(acc, cur, wr, wc, fr, fq); S.done(cur); }
        if (!has_next) break;
#pragma unroll
        for (int a = 0; a < 2; ++a)
#pragma unroll
            for (int b = 0; b < 2; ++b)
#pragma unroll
                for (int m = 0; m < 4; ++m)
#pragma unroll
                    for (int n = 0; n < 2; ++n) acc[a][b][m][n] = (f32x4){0.f, 0.f, 0.f, 0.f};
        cur = nxt; cA = nA; cB = nB; ++ui; _Pragma("unroll") for (int h_ = 0; h_ < 2; ++h_) _Pragma("unroll") for (int i_ = 0; i_ < 2; ++i_) vAc[h_][i_] = vAn[h_][i_];
        if constexpr (ALIGN_EPI) { if (wr == 1) PG8_BAR; }
    }
    PG8_WAIT_V(0);
    if constexpr (!ALIGN_EPI) { if (wr == 0) PG8_BAR; }
    PG8_BAR;
    if constexpr (Epi::AFTER_DRAIN) { E.fused(acc, cur, wr, wc, fr, fq, lds, wid, lane); S.done(cur); }
#undef PG8_GATHER
#undef PG8_SA
#undef PG8_SB
#undef PG8_STAGE
#undef PG8_LDA
#undef PG8_LDB
#undef PG8_MMA
#undef PG8_WAIT_V
#undef PG8_WAIT_L
#undef PG8_BAR
#undef PG8_SCHED
}
}

namespace hg {
typedef short v4i16_t __attribute__((ext_vector_type(4)));
constexpr int S128 = 272, S64 = 144;
constexpr int L_QD = 0, L_QE = L_QD + 64 * S128, L_KE = L_QE + 64 * S128, L_VR = L_KE + 64 * S128, L_ST = L_VR + 64 * S128,
              L_P = L_ST + 128 * S128, L_QS = L_P + 64 * S64, L_DC = L_QS + 16 * 128 * 4, L_END = L_DC + 128 * 4;
static_assert(L_END <= PHASE_LDS, "hgrn LDS");
__device__ __forceinline__ bf16x8 frag(const LAS unsigned char* base, int row, int stride, int kb  ) { return *(const LAS bf16x8*)(base + row * stride + kb); }
__device__ __forceinline__ bf16x8 trfrag(const LAS unsigned char* tile, int tok0, int chan0, int lane) {
    const LAS unsigned char* p = tile + (tok0 + 8 * (lane >> 5) + ((lane & 15) >> 2)) * S128 + (chan0 + 16 * ((lane >> 4) & 1) + 4 * (lane & 3)) * 2;
    const s16x4 lo = __builtin_bit_cast(s16x4, __builtin_amdgcn_ds_read_tr16_b64_v4i16((LAS v4i16_t*)p)), hi = __builtin_bit_cast(s16x4, __builtin_amdgcn_ds_read_tr16_b64_v4i16((LAS v4i16_t*)(p + 4 * S128)));
    return (bf16x8){lo[0], lo[1], lo[2], lo[3], hi[0], hi[1], hi[2], hi[3]};
}

template <bool PASS_C, int ABL = 0>
__device__ __forceinline__ void pass(LAS unsigned char* lds, int unit, const bf16_t* QH, const bf16_t* VH, const half_t* GF, const half_t* GB,
                                     float* HL, float* HD, const float* HS, float* OF, float* OB) {
    typedef _Float16 h4 __attribute__((ext_vector_type(4)));
    const int tid = opaque_tid(), lane = tid & 63, wid = __builtin_amdgcn_readfirstlane(tid >> 6), r32 = lane & 31, hi = lane >> 5;
    const int dir = unit >> 7, head = (unit >> 5) & 3, sc = unit & 31;
    const int kq = tid & 31, tq = tid >> 5;
    const half_t* G = dir ? GB : GF; float* O = dir ? OB : OF;
    const int vi = wid >> 1, ki0 = (wid & 1) * 2;
    f32x16 sacc[2];
    LAS f32x4* QS = (LAS f32x4*)(lds + L_QS); LAS float* DC = (LAS float*)(lds + L_DC);
    if (PASS_C) {
        const float* hs = HS + (size_t)unit * 16384;
#pragma unroll
        for (int tt = 0; tt < 2; ++tt)
#pragma unroll
            for (int r = 0; r < 16; r += 2) { const int v = vi * 32 + crow(r, hi), kk = (ki0 + tt) * 32 + r32; const float s0 = hs[v * 128 + kk], s1 = hs[(v + 1) * 128 + kk]; sacc[tt][r] = s0; sacc[tt][r + 1] = s1;
                const unsigned w = cvtpk(s0, s1); *(LAS bf16_t*)(lds + L_ST + v * S128 + kk * 2) = (bf16_t)(w & 0xffffu); *(LAS bf16_t*)(lds + L_ST + (v + 1) * S128 + kk * 2) = (bf16_t)(w >> 16); }
    } else { sacc[0] = f32x16{}; sacc[1] = f32x16{}; }
    f32x4 btot = {1.f, 1.f, 1.f, 1.f};
    h4 gh[4]; u32x2 qv[4], vv[4];
#define HG_LOAD(c_) do { const int tb_ = sc * 512 + (c_) * 64 + 4 * tq; _Pragma("unroll") for (int i = 0; i < 4; ++i) { const int tl = tb_ + i, tok = dir ? (M - 1 - tl) : tl; \
        const size_t off = (size_t)tok * HSEC + head * 128 + 4 * kq; gh[i] = *(const h4*)(G + off); vv[i] = *(const u32x2*)(VH + off); if (PASS_C) qv[i] = *(const u32x2*)(QH + off); } } while (0)
    HG_LOAD(0);
#pragma unroll 1
    for (int c = 0; c < 8; ++c) {
        const int t0 = sc * 512 + c * 64;
        f32x4 g[4], b[4];
#pragma unroll
        for (int i = 0; i < 4; ++i) { g[i] = (f32x4){(float)gh[i][0], (float)gh[i][1], (float)gh[i][2], (float)gh[i][3]}; b[i] = i ? b[i - 1] * g[i] : g[i]; }
        QS[tq * 32 + kq] = b[3];
        LDS_WAIT(); __syncthreads();
        if (tid < 128) { LAS float* qs = (LAS float*)QS; float run = 1.f;
#pragma unroll
            for (int q = 0; q < 16; ++q) { const float t = qs[q * 128 + tid]; qs[q * 128 + tid] = run; run *= t; }
            DC[tid] = run; }
        LDS_WAIT(); __syncthreads();
        const f32x4 pre = QS[tq * 32 + kq], etot = *(const LAS f32x4*)(DC + 4 * kq);
        btot *= etot;
        f32x4 itot; itot[0] = __builtin_amdgcn_rcpf(etot[0]); itot[1] = __builtin_amdgcn_rcpf(etot[1]); itot[2] = __builtin_amdgcn_rcpf(etot[2]); itot[3] = __builtin_amdgcn_rcpf(etot[3]);
#pragma unroll
        for (int i = 0; i < 4; ++i) { const int tr = 4 * tq + i; float ke[4], qd[4], qe[4];
            const float q4[4] = {bflo(qv[i].x), bfhi(qv[i].x), bflo(qv[i].y), bfhi(qv[i].y)};
#pragma unroll
            for (int cc = 0; cc < 4; ++cc) { const float pb = b[i][cc] * pre[cc];
                ke[cc] = (1.f - g[i][cc]) * etot[cc] * __builtin_amdgcn_rcpf(pb);
                if (PASS_C) { qd[cc] = q4[cc] * pb; qe[cc] = qd[cc] * itot[cc]; } }
            *(LAS u32x2*)(lds + L_KE + tr * S128 + kq * 8) = (u32x2){cvtpk(ke[0], ke[1]), cvtpk(ke[2], ke[3])};
            *(LAS u32x2*)(lds + L_VR + tr * S128 + kq * 8) = vv[i];
            if (PASS_C) { *(LAS u32x2*)(lds + L_QD + tr * S128 + kq * 8) = (u32x2){cvtpk(qd[0], qd[1]), cvtpk(qd[2], qd[3])};
                *(LAS u32x2*)(lds + L_QE + tr * S128 + kq * 8) = (u32x2){cvtpk(qe[0], qe[1]), cvtpk(qe[2], qe[3])}; } }
        LDS_WAIT(); __syncthreads();
        if (c < 7 && !(ABL & 2)) HG_LOAD(c + 1);
        if (PASS_C && !(ABL & 4)) {
            if (wid < 4) {
                const int ti = wid >> 1, si = wid & 1; f32x16 p = f32x16{};
                if (!(ti == 0 && si == 1)) {
#pragma unroll
                    for (int ks = 0; ks < 8; ++ks) p = __builtin_amdgcn_mfma_f32_32x32x16_bf16(frag(lds + L_QE, ti * 32 + r32, S128, ks * 32 + hi * 16), frag(lds + L_KE, si * 32 + r32, S128, ks * 32 + hi * 16), p, 0, 0, 0);
                }
#pragma unroll
                for (int r = 0; r < 16; r += 2) { const int t = ti * 32 + crow(r, hi), s = si * 32 + r32; const unsigned w = cvtpk(s <= t ? p[r] : 0.f, s <= t + 1 ? p[r + 1] : 0.f);
                    *(LAS bf16_t*)(lds + L_P + t * S64 + s * 2) = (bf16_t)(w & 0xffffu); *(LAS bf16_t*)(lds + L_P + (t + 1) * S64 + s * 2) = (bf16_t)(w >> 16); }
            }
            LDS_WAIT(); __syncthreads();
            { const int ti = wid >> 2, vo = wid & 3; f32x16 o = f32x16{};
#pragma unroll
                for (int ks = 0; ks < 8; ++ks) o = __builtin_amdgcn_mfma_f32_32x32x16_bf16(frag(lds + L_QD, ti * 32 + r32, S128, ks * 32 + hi * 16), frag(lds + L_ST, vo * 32 + r32, S128, ks * 32 + hi * 16), o, 0, 0, 0);
#pragma unroll
                for (int ss = 0; ss < 4; ++ss) o = __builtin_amdgcn_mfma_f32_32x32x16_bf16(frag(lds + L_P, ti * 32 + r32, S64, ss * 32 + hi * 16), trfrag(lds + L_VR, ss * 16, vo * 32, lane), o, 0, 0, 0);
#pragma unroll
                for (int r = 0; r < 16; ++r) { const int tl = t0 + ti * 32 + crow(r, hi), tok = dir ? (M - 1 - tl) : tl; if (!(ABL & 1)) O[(size_t)tok * HSEC + head * 128 + vo * 32 + r32] = o[r]; else asm volatile("" :: "v"(o[r])); }
            }
        }
#pragma unroll
        for (int tt = 0; tt < ((ABL & 4) ? 0 : 2); ++tt) { const int ki = ki0 + tt; const float d = DC[ki * 32 + r32];
#pragma unroll
            for (int r = 0; r < 16; ++r) sacc[tt][r] *= d;
#pragma unroll
            for (int ss = 0; ss < 4; ++ss) sacc[tt] = __builtin_amdgcn_mfma_f32_32x32x16_bf16(trfrag(lds + L_VR, ss * 16, vi * 32, lane), trfrag(lds + L_KE, ss * 16, ki * 32, lane), sacc[tt], 0, 0, 0);
        }
        LDS_WAIT(); __syncthreads();
        if (PASS_C) {
#pragma unroll
            for (int tt = 0; tt < 2; ++tt)
#pragma unroll
                for (int r = 0; r < 16; r += 2) { const int v = vi * 32 + crow(r, hi), kk = (ki0 + tt) * 32 + r32; const unsigned w = cvtpk(sacc[tt][r], sacc[tt][r + 1]);
                    *(LAS bf16_t*)(lds + L_ST + v * S128 + kk * 2) = (bf16_t)(w & 0xffffu); *(LAS bf16_t*)(lds + L_ST + (v + 1) * S128 + kk * 2) = (bf16_t)(w >> 16); }
        }
    }
#undef HG_LOAD
    if (!PASS_C) {
        float* hl = HL + (size_t)unit * 16384;
#pragma unroll
        for (int tt = 0; tt < 2; ++tt)
#pragma unroll
            for (int r = 0; r < 16; ++r) { const int v = vi * 32 + crow(r, hi), kk = (ki0 + tt) * 32 + r32; hl[v * 128 + kk] = sacc[tt][r]; }
        if (tq == 0) *(f32x4*)(HD + unit * 128 + 4 * kq) = btot;
    }
    __syncthreads();
}
__device__ __forceinline__ void scan(const float* HL, const float* HD, float* HS, int gtid, int gthreads) {
    for (int id = gtid; id < 8 * 16384; id += gthreads) {
        const int dh = id >> 14, e = id & 16383, k = e & 127; float S = 0.f;
        float hl[32], hd[32];
#pragma unroll
        for (int sc = 0; sc < 32; ++sc) { const int u = dh * 32 + sc; hl[sc] = HL[(size_t)u * 16384 + e]; hd[sc] = HD[u * 128 + k]; }
#pragma unroll
        for (int sc = 0; sc < 32; ++sc) { const int u = dh * 32 + sc; HS[(size_t)u * 16384 + e] = S; S = hd[sc] * S + hl[sc]; }
    }
}
}

namespace att {
__device__ __forceinline__ void hgrn_finalize(int h, int q0, const float* OF, const float* OB, const bf16_t* SG, const float* gain, bf16_t* MIX, int wid, int lane) {
    const float g0 = gain[2 * lane], g1 = gain[2 * lane + 1];
#pragma unroll 1
    for (int i0 = 0; i0 < 32; i0 += 4) { float2 a[4], b[4]; unsigned sg[4]; float x0[4], x1[4], ss[4];
#pragma unroll
        for (int i = 0; i < 4; ++i) { const size_t off = (size_t)(q0 + wid * 32 + i0 + i) * HSEC + h * 128 + 2 * lane; a[i] = *(const float2*)(OF + off); b[i] = *(const float2*)(OB + off); sg[i] = *(const unsigned*)(SG + off); }
#pragma unroll
        for (int i = 0; i < 4; ++i) { x0[i] = a[i].x + b[i].x; x1[i] = a[i].y + b[i].y; ss[i] = x0[i] * x0[i] + x1[i] * x1[i]; }
#pragma unroll
        for (int i = 0; i < 4; ++i) ss[i] = wave_sum(ss[i]);
#pragma unroll
        for (int i = 0; i < 4; ++i) { const float rstd = 1.f / sqrtf(ss[i] * (1.f / 128.f) + 1e-6f);
            *(unsigned*)(MIX + (size_t)(q0 + wid * 32 + i0 + i) * D + h * 128 + 2 * lane) = cvtpk(x0[i] * rstd * g0 * bflo(sg[i]), x1[i] * rstd * g1 * bfhi(sg[i])); } }
}
}

namespace att2 {
typedef short v4i16_t __attribute__((ext_vector_type(4)));
constexpr int KVBLK = 64, LDR = HSEC, NT = M / KVBLK;
constexpr int KSLOT = 8192, VSLOT = 16384, NSLOT = 4;
constexpr int OFF_K = 0, OFF_V = NSLOT * KSLOT, OFF_WS = OFF_V + NSLOT * VSLOT, OFF_END = OFF_WS + NWAVES * 64 * 4;
static_assert(OFF_END <= PHASE_LDS, "attention LDS");
__device__ __forceinline__ s16x4 vtr(const LAS unsigned char* p) { return __builtin_bit_cast(s16x4, __builtin_amdgcn_ds_read_tr16_b64_v4i16((LAS v4i16_t*)p)); }
__device__ __forceinline__ void glds16(const void* sbase, unsigned voff, unsigned lds_dst) { unsigned keep;
    asm volatile("s_mov_b32 %0, m0\n\ts_mov_b32 m0, %3\n\ts_nop 0\n\tglobal_load_lds_dwordx4 %1, %2\n\ts_mov_b32 m0, %0" : "=&s"(keep) : "v"(voff), "s"(sbase), "s"(lds_dst) : "memory"); }
#define ATT2_WAIT_BAR(N) asm volatile("s_waitcnt vmcnt(" #N ") lgkmcnt(0)\n\ts_barrier" ::: "memory")
template <bool DO_QK, bool DO_SM, bool DO_PV>
__device__ __forceinline__ void step(f32x16& sn0, f32x16& sn1, f32x16& sc0, f32x16& sc1, const u32x4& pap0, const u32x4& pap1, const u32x4& pap2, const u32x4& pap3,
                                     u32x4& pan0, u32x4& pan1, u32x4& pan2, u32x4& pan3, f32x16 (&o)[4], const bf16x8 (&qr)[4], const f32x16& negm, float& lsum,
                                     const LAS unsigned char* kc, const LAS unsigned char* knn, const LAS unsigned char* vb, bf16x8& kf0, bf16x8& kf1, bf16x8& kf2) {
    bf16x8 fr0 = kf0, fr1 = kf1, fr2 = kf2, fr3 = kf0; unsigned ca0 = 0, ca1 = 0, cb0 = 0, cb1 = 0;
    (void)ca0; (void)ca1; (void)cb0; (void)cb1;
    if (DO_QK) sn0 = __builtin_amdgcn_mfma_f32_32x32x16_bf16(fr0, qr[0], negm, 0, 0, 0);
    SBAR();
    if (DO_QK) { fr3 = *(const LAS bf16x8*)(kc + 2560); }
    if (DO_SM) { sc0[0] = ex2(sc0[0]); sc0[1] = ex2(sc0[1]); }
    SBAR();
    if (DO_QK) sn1 = __builtin_amdgcn_mfma_f32_32x32x16_bf16(fr1, qr[0], negm, 0, 0, 0);
    SBAR();
    if (DO_QK) { fr0 = *(const LAS bf16x8*)(kc + 4096); }
    if (DO_SM) { sc0[2] = ex2(sc0[2]); sc0[3] = ex2(sc0[3]); lsum += sc0[0]; lsum += sc0[1]; }
    SBAR();
    if (DO_QK) sn0 = __builtin_amdgcn_mfma_f32_32x32x16_bf16(fr2, qr[1], sn0, 0, 0, 0);
    SBAR();
    if (DO_QK) { fr1 = *(const LAS bf16x8*)(kc + 4608); }
    if (DO_SM) { sc0[4] = ex2(sc0[4]); sc0[5] = ex2(sc0[5]); lsum += sc0[2]; lsum += sc0[3]; }
    SBAR();
    if (DO_QK) sn1 = __builtin_amdgcn_mfma_f32_32x32x16_bf16(fr3, qr[1], sn1, 0, 0, 0);
    SBAR();
    if (DO_QK) { fr2 = *(const LAS bf16x8*)(kc + 6144); }
    if (DO_SM) { sc0[6] = ex2(sc0[6]); sc0[7] = ex2(sc0[7]); lsum += sc0[4]; lsum += sc0[5]; }
    SBAR();
    if (DO_QK) sn0 = __builtin_amdgcn_mfma_f32_32x32x16_bf16(fr0, qr[2], sn0, 0, 0, 0);
    SBAR();
    if (DO_QK) { fr3 = *(const LAS bf16x8*)(kc + 6656); }
    if (DO_SM) { sc0[8] = ex2(sc0[8]); sc0[9] = ex2(sc0[9]); lsum += sc0[6]; lsum += sc0[7]; }
    SBAR();
    if (DO_QK) sn1 = __builtin_amdgcn_mfma_f32_32x32x16_bf16(fr1, qr[2], sn1, 0, 0, 0);
    SBAR();
    if (DO_PV) { { const s16x4 l_ = vtr(vb + 0), h_ = vtr(vb + 256); fr0 = (bf16x8){l_[0], l_[1], l_[2], l_[3], h_[0], h_[1], h_[2], h_[3]}; } }
    if (DO_SM) { sc0[10] = ex2(sc0[10]); sc0[11] = ex2(sc0[11]); lsum += sc0[8]; lsum += sc0[9]; }
    SBAR();
    if (DO_QK) sn0 = __builtin_amdgcn_mfma_f32_32x32x16_bf16(fr2, qr[3], sn0, 0, 0, 0);
    SBAR();
    if (DO_PV) { { const s16x4 l_ = vtr(vb + 4096), h_ = vtr(vb + 4352); fr1 = (bf16x8){l_[0], l_[1], l_[2], l_[3], h_[0], h_[1], h_[2], h_[3]}; } }
    if (DO_SM) { sc0[12] = ex2(sc0[12]); sc0[13] = ex2(sc0[13]); lsum += sc0[10]; lsum += sc0[11]; }
    SBAR();
    if (DO_QK) sn1 = __builtin_amdgcn_mfma_f32_32x32x16_bf16(fr3, qr[3], sn1, 0, 0, 0);
    SBAR();
    if (DO_PV) { { const s16x4 l_ = vtr(vb + 8192), h_ = vtr(vb + 8448); fr2 = (bf16x8){l_[0], l_[1], l_[2], l_[3], h_[0], h_[1], h_[2], h_[3]}; } }
    if (DO_SM) { sc0[14] = ex2(sc0[14]); sc0[15] = ex2(sc0[15]); lsum += sc0[12]; lsum += sc0[13]; }
    SBAR();
    if (DO_PV) o[0] = __builtin_amdgcn_mfma_f32_32x32x16_bf16(__builtin_bit_cast(bf16x8, pap0), fr0, o[0], 0, 0, 0);
    SBAR();
    if (DO_PV) { { const s16x4 l_ = vtr(vb + 12288), h_ = vtr(vb + 12544); fr3 = (bf16x8){l_[0], l_[1], l_[2], l_[3], h_[0], h_[1], h_[2], h_[3]}; } }
    if (DO_SM) { sc1[0] = ex2(sc1[0]); sc1[1] = ex2(sc1[1]); lsum += sc0[14]; lsum += sc0[15]; }
    SBAR();
    if (DO_PV) o[0] = __builtin_amdgcn_mfma_f32_32x32x16_bf16(__builtin_bit_cast(bf16x8, pap1), fr1, o[0], 0, 0, 0);
    SBAR();
    if (DO_PV) { { const s16x4 l_ = vtr(vb + 512), h_ = vtr(vb + 768); fr0 = (bf16x8){l_[0], l_[1], l_[2], l_[3], h_[0], h_[1], h_[2], h_[3]}; } }
    if (DO_SM) { sc1[2] = ex2(sc1[2]); sc1[3] = ex2(sc1[3]); lsum += sc1[0]; lsum += sc1[1]; }
    SBAR();
    if (DO_PV) o[0] = __builtin_amdgcn_mfma_f32_32x32x16_bf16(__builtin_bit_cast(bf16x8, pap2), fr2, o[0], 0, 0, 0);
    SBAR();
    if (DO_PV) { { const s16x4 l_ = vtr(vb + 4608), h_ = vtr(vb + 4864); fr1 = (bf16x8){l_[0], l_[1], l_[2], l_[3], h_[0], h_[1], h_[2], h_[3]}; } }
    if (DO_SM) { sc1[4] = ex2(sc1[4]); sc1[5] = ex2(sc1[5]); lsum += sc1[2]; lsum += sc1[3]; }
    SBAR();
    if (DO_PV) o[0] = __builtin_amdgcn_mfma_f32_32x32x16_bf16(__builtin_bit_cast(bf16x8, pap3), fr3, o[0], 0, 0, 0);
    SBAR();
    if (DO_PV) { { const s16x4 l_ = vtr(vb + 8704), h_ = vtr(vb + 8960); fr2 = (bf16x8){l_[0], l_[1], l_[2], l_[3], h_[0], h_[1], h_[2], h_[3]}; } }
    if (DO_SM) { sc1[6] = ex2(sc1[6]); sc1[7] = ex2(sc1[7]); lsum += sc1[4]; lsum += sc1[5]; }
    SBAR();
    if (DO_PV) o[1] = __builtin_amdgcn_mfma_f32_32x32x16_bf16(__builtin_bit_cast(bf16x8, pap0), fr0, o[1], 0, 0, 0);
    SBAR();
    if (DO_PV) { { const s16x4 l_ = vtr(vb + 12800), h_ = vtr(vb + 13056); fr3 = (bf16x8){l_[0], l_[1], l_[2], l_[3], h_[0], h_[1], h_[2], h_[3]}; } }
    if (DO_SM) { sc1[8] = ex2(sc1[8]); sc1[9] = ex2(sc1[9]); lsum += sc1[6]; lsum += sc1[7]; }
    SBAR();
    if (DO_PV) o[1] = __builtin_amdgcn_mfma_f32_32x32x16_bf16(__builtin_bit_cast(bf16x8, pap1), fr1, o[1], 0, 0, 0);
    SBAR();
    if (DO_PV) { { const s16x4 l_ = vtr(vb + 1024), h_ = vtr(vb + 1280); fr0 = (bf16x8){l_[0], l_[1], l_[2], l_[3], h_[0], h_[1], h_[2], h_[3]}; } }
    if (DO_SM) { sc1[10] = ex2(sc1[10]); sc1[11] = ex2(sc1[11]); lsum += sc1[8]; lsum += sc1[9]; }
    SBAR();
    if (DO_PV) o[1] = __builtin_amdgcn_mfma_f32_32x32x16_bf16(__builtin_bit_cast(bf16x8, pap2), fr2, o[1], 0, 0, 0);
    SBAR();
    if (DO_PV) { { const s16x4 l_ = vtr(vb + 5120), h_ = vtr(vb + 5376); fr1 = (bf16x8){l_[0], l_[1], l_[2], l_[3], h_[0], h_[1], h_[2], h_[3]}; } }
    if (DO_SM) { sc1[12] = ex2(sc1[12]); sc1[13] = ex2(sc1[13]); lsum += sc1[10]; lsum += sc1[11]; }
    SBAR();
    if (DO_PV) o[1] = __builtin_amdgcn_mfma_f32_32x32x16_bf16(__builtin_bit_cast(bf16x8, pap3), fr3, o[1], 0, 0, 0);
    SBAR();
    if (DO_PV) { { const s16x4 l_ = vtr(vb + 9216), h_ = vtr(vb + 9472); fr2 = (bf16x8){l_[0], l_[1], l_[2], l_[3], h_[0], h_[1], h_[2], h_[3]}; } }
    if (DO_SM) { sc1[14] = ex2(sc1[14]); sc1[15] = ex2(sc1[15]); lsum += sc1[12]; lsum += sc1[13]; }
    SBAR();
    if (DO_PV) o[2] = __builtin_amdgcn_mfma_f32_32x32x16_bf16(__builtin_bit_cast(bf16x8, pap0), fr0, o[2], 0, 0, 0);
    SBAR();
    if (DO_PV) { { const s16x4 l_ = vtr(vb + 13312), h_ = vtr(vb + 13568); fr3 = (bf16x8){l_[0], l_[1], l_[2], l_[3], h_[0], h_[1], h_[2], h_[3]}; } }
    if (DO_SM) { lsum += sc1[14]; lsum += sc1[15]; ca0 = cvtpk(sc0[0], sc0[1]); ca1 = cvtpk(sc0[2], sc0[3]); }
    SBAR();
    if (DO_PV) o[2] = __builtin_amdgcn_mfma_f32_32x32x16_bf16(__builtin_bit_cast(bf16x8, pap1), fr1, o[2], 0, 0, 0);
    SBAR();
    if (DO_PV) { { const s16x4 l_ = vtr(vb + 1536), h_ = vtr(vb + 1792); fr0 = (bf16x8){l_[0], l_[1], l_[2], l_[3], h_[0], h_[1], h_[2], h_[3]}; } }
    if (DO_SM) { cb0 = cvtpk(sc0[4], sc0[5]); cb1 = cvtpk(sc0[6], sc0[7]); pan0 = (u32x4){ca0, ca1, cb0, cb1}; }
    SBAR();
    if (DO_PV) o[2] = __builtin_amdgcn_mfma_f32_32x32x16_bf16(__builtin_bit_cast(bf16x8, pap2), fr2, o[2], 0, 0, 0);
    SBAR();
    if (DO_PV) { { const s16x4 l_ = vtr(vb + 5632), h_ = vtr(vb + 5888); fr1 = (bf16x8){l_[0], l_[1], l_[2], l_[3], h_[0], h_[1], h_[2], h_[3]}; } }
    if (DO_SM) { ca0 = cvtpk(sc0[8], sc0[9]); ca1 = cvtpk(sc0[10], sc0[11]); }
    SBAR();
    if (DO_PV) o[2] = __builtin_amdgcn_mfma_f32_32x32x16_bf16(__builtin_bit_cast(bf16x8, pap3), fr3, o[2], 0, 0, 0);
    SBAR();
    if (DO_PV) { { const s16x4 l_ = vtr(vb + 9728), h_ = vtr(vb + 9984); fr2 = (bf16x8){l_[0], l_[1], l_[2], l_[3], h_[0], h_[1], h_[2], h_[3]}; } }
    if (DO_SM) { cb0 = cvtpk(sc0[12], sc0[13]); cb1 = cvtpk(sc0[14], sc0[15]); pan1 = (u32x4){ca0, ca1, cb0, cb1}; }
    SBAR();
    if (DO_PV) o[3] = __builtin_amdgcn_mfma_f32_32x32x16_bf16(__builtin_bit_cast(bf16x8, pap0), fr0, o[3], 0, 0, 0);
    SBAR();
    if (DO_PV) { { const s16x4 l_ = vtr(vb + 13824), h_ = vtr(vb + 14080); fr3 = (bf16x8){l_[0], l_[1], l_[2], l_[3], h_[0], h_[1], h_[2], h_[3]}; } }
    if (DO_SM) { ca0 = cvtpk(sc1[0], sc1[1]); ca1 = cvtpk(sc1[2], sc1[3]); }
    SBAR();
    if (DO_PV) o[3] = __builtin_amdgcn_mfma_f32_32x32x16_bf16(__builtin_bit_cast(bf16x8, pap1), fr1, o[3], 0, 0, 0);
    SBAR();
    kf0 = *(const LAS bf16x8*)(knn + 0);
    if (DO_SM) { cb0 = cvtpk(sc1[4], sc1[5]); cb1 = cvtpk(sc1[6], sc1[7]); pan2 = (u32x4){ca0, ca1, cb0, cb1}; }
    SBAR();
    if (DO_PV) o[3] = __builtin_amdgcn_mfma_f32_32x32x16_bf16(__builtin_bit_cast(bf16x8, pap2), fr2, o[3], 0, 0, 0);
    SBAR();
    kf1 = *(const LAS bf16x8*)(knn + 512);
    if (DO_SM) { ca0 = cvtpk(sc1[8], sc1[9]); ca1 = cvtpk(sc1[10], sc1[11]); }
    SBAR();
    if (DO_PV) o[3] = __builtin_amdgcn_mfma_f32_32x32x16_bf16(__builtin_bit_cast(bf16x8, pap3), fr3, o[3], 0, 0, 0);
    SBAR();
    kf2 = *(const LAS bf16x8*)(knn + 2048);
    if (DO_SM) { cb0 = cvtpk(sc1[12], sc1[13]); cb1 = cvtpk(sc1[14], sc1[15]); pan3 = (u32x4){ca0, ca1, cb0, cb1}; }
    SBAR();
}

__device__ __forceinline__ void unit(LAS unsigned char* lds, int h, int q0, const bf16_t* __restrict__ QD, const bf16_t* __restrict__ KD, const bf16_t* __restrict__ VD,
                                     const unsigned* KMAX2, float* O0S, float lam, const float* __restrict__ subg, bf16_t* MIX) {
    const int tid = opaque_tid(), wid = __builtin_amdgcn_readfirstlane(tid >> 6), lane = tid & 63, r32 = lane & 31, hi = lane >> 5;
    const unsigned lds0 = (unsigned)(uintptr_t)lds;
    LAS float* ws = (LAS float*)(lds + OFF_WS) + wid * 64;
    const LAS unsigned char* kbase = lds + OFF_K + hi * 1024 + r32 * 16;
    const LAS unsigned char* vbase = lds + OFF_V + (((lane & 3) << 3) | (((lane >> 2) & 3) << 6) | (((lane >> 4) & 1) << 5) | (((lane >> 5) & 1) << 11));
    const unsigned voK = (unsigned)((lane * LDR + wid * 8) * 2);
    unsigned voV[2];
    { const int kk = 8 * wid + ((lane & 31) >> 2), key = (kk & ~0xC) | ((kk & 4) << 1) | ((kk & 8) >> 1);
#pragma unroll
      for (int j = 0; j < 2; ++j) voV[j] = (unsigned)((key * LDR + (2 * j + (lane >> 5)) * 32 + (lane & 3) * 8) * 2); }
    const unsigned kdst = lds0 + OFF_K + wid * 1024, vdst = lds0 + OFF_V + wid * 2048;
#pragma unroll 1
    for (int mp = 0; mp < 2; ++mp) {
        const bf16_t* Kh = KD + h * 128 + mp * 64; const bf16_t* Vh = VD + h * 128;
        const bf16_t* Qw = QD + (size_t)(q0 + wid * 32 + r32) * LDR + h * 128 + mp * 64 + hi * 8;
#define ATT2_DMA_K(t) do { const int t_ = (t) < NT ? (t) : NT - 1; glds16((const char*)Kh + (size_t)t_ * (KVBLK * LDR * 2), voK, (unsigned)__builtin_amdgcn_readfirstlane(kdst + ((t) & 3) * KSLOT)); } while (0)
#define ATT2_DMA_V(t) do { const int t_ = (t) < NT ? (t) : NT - 1; const char* vs_ = (const char*)Vh + (size_t)t_ * (KVBLK * LDR * 2); const unsigned vd_ = (unsigned)__builtin_amdgcn_readfirstlane(vdst + ((t) & 3) * VSLOT); \
        glds16(vs_, voV[0], vd_); glds16(vs_, voV[1], vd_ + 1024); } while (0)
        ATT2_DMA_K(0); ATT2_DMA_K(1); ATT2_DMA_K(2); ATT2_DMA_V(0);
        bf16x8 qr[4]; float qq = 0.f;
#pragma unroll
        for (int d0 = 0; d0 < 4; ++d0) { qr[d0] = *reinterpret_cast<const bf16x8*>(Qw + d0 * 16);
#pragma unroll
            for (int j = 0; j < 8; ++j) { const float q = bf2f((unsigned short)qr[d0][j]); qq += q * q; } }
        { auto rr = __builtin_amdgcn_permlane32_swap(__float_as_uint(qq), __float_as_uint(qq), false, false); qq = __uint_as_float(rr[0]) + __uint_as_float(rr[1]); }
        const float mref = sqrtf(qq * __uint_as_float(KMAX2[(h * 2 + mp) * 64])) * 1.001f;
        f32x16 negm;
#pragma unroll
        for (int r = 0; r < 16; ++r) negm[r] = -mref;
        f32x16 o[4] = {}; float lsum = 0.f;
        f32x16 sA0, sA1, sB0, sB1; u32x4 pX0, pX1, pX2, pX3, pY0, pY1, pY2, pY3;
        sA0 = f32x16{}; sA1 = f32x16{}; sB0 = f32x16{}; sB1 = f32x16{}; pX0 = pX1 = pX2 = pX3 = pY0 = pY1 = pY2 = pY3 = (u32x4){0u, 0u, 0u, 0u};
        bf16x8 kf0, kf1, kf2;
        ATT2_WAIT_BAR(0);
        kf0 = *(const LAS bf16x8*)(kbase); kf1 = *(const LAS bf16x8*)(kbase + 512); kf2 = *(const LAS bf16x8*)(kbase + 2048);
#define KS(t) (kbase + ((t) & 3) * KSLOT)
#define VS(t) (vbase + ((t) & 3) * VSLOT)
        ATT2_DMA_K(3); ATT2_DMA_V(1);
        step<true, false, false>(sA0, sA1, sB0, sB1, pX0, pX1, pX2, pX3, pY0, pY1, pY2, pY3, o, qr, negm, lsum, KS(0), KS(1), VS(0), kf0, kf1, kf2);
        ATT2_WAIT_BAR(3);
        ATT2_DMA_K(4); ATT2_DMA_V(2);
        step<true, true, false>(sB0, sB1, sA0, sA1, pY0, pY1, pY2, pY3, pX0, pX1, pX2, pX3, o, qr, negm, lsum, KS(1), KS(2), VS(0), kf0, kf1, kf2);
        ATT2_WAIT_BAR(3);
#pragma unroll 1
        for (int i = 1; i + 1 < NT - 1; i += 2) {
            ATT2_DMA_K(i + 4); ATT2_DMA_V(i + 2);
            step<true, true, true>(sA0, sA1, sB0, sB1, pX0, pX1, pX2, pX3, pY0, pY1, pY2, pY3, o, qr, negm, lsum, KS(i + 1), KS(i + 2), VS(i - 1), kf0, kf1, kf2);
            ATT2_WAIT_BAR(3);
            ATT2_DMA_K(i + 5); ATT2_DMA_V(i + 3);
            step<true, true, true>(sB0, sB1, sA0, sA1, pY0, pY1, pY2, pY3, pX0, pX1, pX2, pX3, o, qr, negm, lsum, KS(i + 2), KS(i + 3), VS(i), kf0, kf1, kf2);
            ATT2_WAIT_BAR(3);
        }
        step<false, true, true>(sA0, sA1, sB0, sB1, pX0, pX1, pX2, pX3, pY0, pY1, pY2, pY3, o, qr, negm, lsum, KS(0), KS(0), VS(NT - 2), kf0, kf1, kf2);
        ATT2_WAIT_BAR(0);
        step<false, false, true>(sB0, sB1, sA0, sA1, pY0, pY1, pY2, pY3, pX0, pX1, pX2, pX3, o, qr, negm, lsum, KS(0), KS(0), VS(NT - 1), kf0, kf1, kf2);
        ATT2_WAIT_BAR(0);
#undef KS
#undef VS
#undef ATT2_DMA_K
#undef ATT2_DMA_V
        { auto rr = __builtin_amdgcn_permlane32_swap(__float_as_uint(lsum), __float_as_uint(lsum), false, false); lsum = __uint_as_float(rr[0]) + __uint_as_float(rr[1]); }
        if (hi == 0) ws[r32] = lsum; asm volatile("s_waitcnt lgkmcnt(0)" ::: "memory");
        int rowb = q0 + wid * 32; asm volatile("" : "+s"(rowb));
        float rli[16];
#pragma unroll
        for (int r = 0; r < 16; ++r) rli[r] = __builtin_amdgcn_rcpf(ws[crow(r, hi)]);
        float* o0p = O0S + tid; asm volatile("" : "+v"(o0p));
        if (mp == 0) {
#pragma unroll
            for (int d0 = 0; d0 < 4; ++d0)
#pragma unroll
                for (int r = 0; r < 16; ++r) o0p[(d0 * 16 + r) * 512] = o[d0][r] * rli[r];
        } else {
            float ss[16];
#pragma unroll
            for (int r = 0; r < 16; ++r) ss[r] = 0.f;
#pragma unroll
            for (int d0 = 0; d0 < 4; ++d0)
#pragma unroll
                for (int r = 0; r < 16; ++r) { const float c = o0p[(d0 * 16 + r) * 512] - lam * o[d0][r] * rli[r]; o[d0][r] = c; ss[r] += c * c; }
#pragma unroll
            for (int r = 0; r < 16; ++r) {
                ss[r] += lane_xor<1>(ss[r]); ss[r] += lane_xor<2>(ss[r]); ss[r] += lane_xor<4>(ss[r]); ss[r] += lane_xor<8>(ss[r]); ss[r] += lane_xor<16>(ss[r]);
                ss[r] = 0.8f / sqrtf(ss[r] * (1.f / 128.f) + 1e-5f); }
#pragma unroll
            for (int d0 = 0; d0 < 4; ++d0) { const float g = subg[d0 * 32 + r32];
#pragma unroll
                for (int r = 0; r < 16; ++r) MIX[(size_t)(rowb + crow(r, hi)) * D + 512 + h * 128 + d0 * 32 + r32] = (bf16_t)f2bf(o[d0][r] * ss[r] * g); }
        }
        asm volatile("s_waitcnt vmcnt(0) lgkmcnt(0)\n\ts_barrier" ::: "memory");
    }
}
__device__ __forceinline__ void kmax_rows(LAS unsigned char* lds, const bf16_t* KD, unsigned* KMAX2, int gw, int ngw, int lane, int wave) {
    float mx = 0.f;
    for (int row0 = gw; row0 < M; row0 += 8 * ngw) { u32x4 w[8];
#pragma unroll
        for (int i = 0; i < 8; ++i) { const int row = row0 + i * ngw; w[i] = row < M ? *(const GAS u32x4*)(KD + (size_t)row * HSEC + lane * 8) : (u32x4){0u, 0u, 0u, 0u}; }
#pragma unroll
        for (int i = 0; i < 8; ++i) { const u32x4 v = w[i];
            float s = bflo(v.x) * bflo(v.x) + bfhi(v.x) * bfhi(v.x) + bflo(v.y) * bflo(v.y) + bfhi(v.y) * bfhi(v.y) + bflo(v.z) * bflo(v.z) + bfhi(v.z) * bfhi(v.z) + bflo(v.w) * bflo(v.w) + bfhi(v.w) * bfhi(v.w);
            s += lane_xor<1>(s); s += lane_xor<2>(s); s += lane_xor<4>(s); mx = fmaxf(mx, s); } }
    LAS float* red = (LAS float*)lds; if ((lane & 7) == 0) red[wave * 8 + (lane >> 3)] = mx;
    LDS_WAIT(); __syncthreads();
    if (wave == 0 && lane < 8) { float m = red[lane];
#pragma unroll
        for (int w = 1; w < NWAVES; ++w) m = fmaxf(m, red[w * 8 + lane]);
        atomicMax(KMAX2 + lane * 64, __float_as_uint(m)); }
    __syncthreads();
}
}

__device__ __forceinline__ void route16(const bf16_t* X2B, const u32x4* WRB, const float* rgb, const float* reb,
                                        float* RSTD, int* TOKE, float* TOKW, int* TOKR, unsigned* GCNT, int row0, int lane, LAS float* wl, bool dry = false) {
    typedef float f32x4_ __attribute__((ext_vector_type(4)));
    const int r = lane & 15, q = lane >> 4;
    LAS unsigned* lc = (LAS unsigned*)(wl + 800);
    if (lane < 32) lc[lane] = 0u;
    f32x4_ acc[3]; acc[0] = (f32x4_){0.f, 0.f, 0.f, 0.f}; acc[1] = acc[0]; acc[2] = acc[0];
    float ssq = 0.f;
    const bf16_t* xp = X2B + (size_t)(row0 + r) * D + 8 * q;
#pragma unroll 8
    for (int ks = 0; ks < 32; ++ks) {
        const u32x4 xw = *(const GAS u32x4*)(xp + ks * 32);
        ssq += (bflo(xw.x) * bflo(xw.x) + bfhi(xw.x) * bfhi(xw.x)) + (bflo(xw.y) * bflo(xw.y) + bfhi(xw.y) * bfhi(xw.y)) + (bflo(xw.z) * bflo(xw.z) + bfhi(xw.z) * bfhi(xw.z)) + (bflo(xw.w) * bflo(xw.w) + bfhi(xw.w) * bfhi(xw.w));
        const bf16x8 xh = __builtin_bit_cast(bf16x8, xw);
#pragma unroll
        for (int nt = 0; nt < 3; ++nt) {
            const bf16x8 wh = __builtin_bit_cast(bf16x8, WRB[((ks * 3 + nt) * 2 + 0) * 64 + lane]), wlo = __builtin_bit_cast(bf16x8, WRB[((ks * 3 + nt) * 2 + 1) * 64 + lane]);
            acc[nt] = __builtin_amdgcn_mfma_f32_16x16x32_bf16(wh, xh, acc[nt], 0, 0, 0);
            acc[nt] = __builtin_amdgcn_mfma_f32_16x16x32_bf16(wlo, xh, acc[nt], 0, 0, 0);
        }
    }
    ssq += lane_xor<16>(ssq);
    { auto rr = __builtin_amdgcn_permlane32_swap(__float_as_uint(ssq), __float_as_uint(ssq), false, false); ssq = __uint_as_float(rr[0]) + __uint_as_float(rr[1]); }
    const float rstd = 1.f / sqrtf(ssq * (1.f / 1024.f) + 1e-6f);
#pragma unroll
    for (int nt = 0; nt < 3; ++nt) *(LAS f32x4_*)(wl + r * 48 + nt * 16 + 4 * q) = acc[nt] * rstd;
    LDS_WAIT();
    float lg[36];
#pragma unroll
    for (int n4 = 0; n4 < 9; ++n4) { const f32x4_ t = *(const LAS f32x4_*)(wl + r * 48 + 4 * n4); lg[4 * n4] = t[0]; lg[4 * n4 + 1] = t[1]; lg[4 * n4 + 2] = t[2]; lg[4 * n4 + 3] = t[3]; }
    float gl[4];
#pragma unroll
    for (int g = 0; g < 4; ++g) gl[g] = lg[g] + rgb[g];
    int gi = 0; float gm = gl[0];
#pragma unroll
    for (int g = 1; g < 4; ++g) if (gl[g] > gm) { gm = gl[g]; gi = g; }
    float gs = 0.f;
#pragma unroll
    for (int g = 0; g < 4; ++g) gs += __expf(gl[g] - gm);
    const float gp = 1.f / gs;
    float e[8];
#pragma unroll
    for (int j = 0; j < 8; ++j) { const float a0 = lg[4 + j] + reb[j], a1 = lg[12 + j] + reb[8 + j], a2 = lg[20 + j] + reb[16 + j], a3 = lg[28 + j] + reb[24 + j];
        e[j] = gi == 0 ? a0 : gi == 1 ? a1 : gi == 2 ? a2 : a3; }
    int i1 = 0; float m1 = e[0];
#pragma unroll
    for (int j = 1; j < 8; ++j) if (e[j] > m1) { m1 = e[j]; i1 = j; }
    int i2 = 0; float m2 = -3.0e38f;
#pragma unroll
    for (int j = 0; j < 8; ++j) if (j != i1 && e[j] > m2) { m2 = e[j]; i2 = j; }
    const float p2 = __expf(m2 - m1);
    const float w1 = gp / (1.f + p2), w2 = gp * p2 / (1.f + p2);
    if (q == 0 && !dry) { const int row = row0 + r; const int e1 = gi * 8 + i1, e2 = gi * 8 + i2;
        const int r1 = (int)__hip_atomic_fetch_add(lc + e1, 1u, __ATOMIC_RELAXED, __HIP_MEMORY_SCOPE_WORKGROUP), r2 = (int)__hip_atomic_fetch_add(lc + e2, 1u, __ATOMIC_RELAXED, __HIP_MEMORY_SCOPE_WORKGROUP);
        RSTD[row] = rstd; TOKE[row * 2] = e1; TOKE[row * 2 + 1] = e2; TOKW[row * 2] = w1; TOKW[row * 2 + 1] = w2; TOKR[row * 2] = r1; TOKR[row * 2 + 1] = r2; }
    LDS_WAIT();
    if (lane < 32 && !dry) GCNT[(row0 >> 4) * 32 + lane] = lc[lane];
}
__device__ __forceinline__ void build_tile_prefix(volatile LAS int* tb, const unsigned* CNT) {
    if (threadIdx.x == 0) { int acc = 0;
        for (int e = 0; e < 32; ++e) { tb[e] = acc; const int c = (int)__hip_atomic_load(CNT + e * CNT_STRIDE, __ATOMIC_RELAXED, __HIP_MEMORY_SCOPE_AGENT); tb[64 + e] = c; acc += (c + 255) >> 8; }
        tb[32] = acc; }
    LDS_WAIT(); __syncthreads();
}
__device__ __forceinline__ void sort_slots(LAS unsigned char* lds, volatile LAS int* tb, const unsigned* GCNT, const int* TOKE, const int* TOKR, int* TOKS, int* PERM, const float* RSTD, float* RSLOT, unsigned* CNT, int blk, int nblk) {
    const int t = opaque_tid(), e = t & 31, j = t >> 5; constexpr int NG = M / 16;
    const int gpb = (NG + nblk - 1) / nblk, g0 = blk * gpb, g1 = g0 + gpb < NG ? g0 + gpb : NG;
    LAS int* part = (LAS int*)lds; LAS int* part2 = part + 512; LAS int* tot = part2 + 512; LAS int* base0 = tot + 32;
    int s = 0, s2 = 0;
    for (int g = j; g < NG; g += 16) { const int c = (int)GCNT[g * 32 + e]; s += c; s2 += g < g0 ? c : 0; }
    part[j * 32 + e] = s; part2[j * 32 + e] = s2;
    LDS_WAIT(); __syncthreads();
    if (t < 32) { int a = 0, b = 0;
#pragma unroll
        for (int jj = 0; jj < 16; ++jj) { a += part[jj * 32 + t]; b += part2[jj * 32 + t]; }
        tot[t] = a; base0[t] = b; if (blk == 0) __hip_atomic_store(CNT + t * CNT_STRIDE, (unsigned)a, __ATOMIC_RELAXED, __HIP_MEMORY_SCOPE_AGENT); }
    LDS_WAIT(); __syncthreads();
    if (t == 0) { int acc = 0; for (int ee = 0; ee < 32; ++ee) { tb[ee] = acc; tb[64 + ee] = tot[ee]; acc += (tot[ee] + 255) >> 8; } tb[32] = acc; }
    LDS_WAIT(); __syncthreads();
    for (int idx = t; idx < (g1 - g0) * 32; idx += 512) { const int gi = idx >> 5, p = (g0 + gi) * 32 + (idx & 31), ex = TOKE[p]; int base = base0[ex];
        for (int g = g0; g < g0 + gi; ++g) base += (int)GCNT[g * 32 + ex];
        const int slot = tb[ex] * 256 + base + TOKR[p]; TOKS[p] = slot; PERM[slot] = p >> 1; RSLOT[slot] = RSTD[p >> 1]; }
}
template <int NR>
__device__ __forceinline__ void final_rows(const bf16_t* X2B, float* OUT, const bf16_t* Y, const int* TOKS, const float* TOKW, const float* gain, int m0, int stride, int lane) {
    int s0[NR], s1[NR]; float w0[NR], w1[NR];
#pragma unroll
    for (int i = 0; i < NR; ++i) { const int row = m0 + i * stride; s0[i] = TOKS[row * 2]; s1[i] = TOKS[row * 2 + 1]; w0[i] = TOKW[row * 2]; w1[i] = TOKW[row * 2 + 1]; }
    u32x2 xx[NR][4], ya[NR][4], yb[NR][4];
#pragma unroll
    for (int i = 0; i < NR; ++i) { const int row = m0 + i * stride;
        const GAS u32x2* xr = (const GAS u32x2*)(X2B + (size_t)row * D) + lane; const GAS u32x2* y0 = (const GAS u32x2*)(Y + (size_t)s0[i] * D) + lane; const GAS u32x2* y1 = (const GAS u32x2*)(Y + (size_t)s1[i] * D) + lane;
#pragma unroll
        for (int j = 0; j < 4; ++j) { xx[i][j] = xr[64 * j]; ya[i][j] = y0[64 * j]; yb[i][j] = y1[64 * j]; } }
#pragma unroll
    for (int i = 0; i < NR; ++i) { const int row = m0 + i * stride; f32x4 v[4]; float s = 0.f;
#pragma unroll
        for (int j = 0; j < 4; ++j) { const u32x2 x_ = xx[i][j], a = ya[i][j], b = yb[i][j];
            v[j].x = bflo(x_.x) + w0[i] * bflo(a.x) + w1[i] * bflo(b.x); v[j].y = bfhi(x_.x) + w0[i] * bfhi(a.x) + w1[i] * bfhi(b.x); v[j].z = bflo(x_.y) + w0[i] * bflo(a.y) + w1[i] * bflo(b.y); v[j].w = bfhi(x_.y) + w0[i] * bfhi(a.y) + w1[i] * bfhi(b.y);
            s += (v[j].x * v[j].x + v[j].y * v[j].y) + (v[j].z * v[j].z + v[j].w * v[j].w); }
        const float rstd = 1.f / sqrtf(wave_sum(s) * (1.f / 1024.f) + 1e-6f);
        GAS f32x4* orow = (GAS f32x4*)(OUT + (size_t)row * D) + lane;
#pragma unroll
        for (int j = 0; j < 4; ++j) { const f32x4 g = ((const GAS f32x4*)gain)[64 * j + lane]; orow[64 * j] = v[j] * rstd * g; } }
}

#ifndef MK_N_LAUNCHES
#define MK_N_LAUNCHES 1
#endif
constexpr int N_PHASES = 12;
struct Args { const void* in[18]; float* out; unsigned char* ws; int ph_lo, ph_hi; };
static_assert(sizeof(Args) == 18 * 8 + 8 + 8 + 8, "Args has no padding");

__global__ void __launch_bounds__(NWAVES * 64, 2) mk_fwd(Args args) {
    extern __shared__ __attribute__((aligned(16))) unsigned char lds_raw[];
    LAS unsigned char* lds = (LAS unsigned char*)lds_raw;
    volatile LAS unsigned* MISC = (volatile LAS unsigned*)(lds + MISC_OFF);
    const int G = gridDim.x, bx = blockIdx.x, vcu = (G % 8 == 0) ? (bx % 8) * (G / 8) + bx / 8 : bx;
    const int NGW = G * NWAVES;
#define PHASE_IDS const int tid = opaque_tid(), lane = tid & 63, wave = __builtin_amdgcn_readfirstlane(tid >> 6), gw = vcu * NWAVES + wave; (void)lane; (void)gw
    const __attribute__((address_space(4))) Args* A = (const __attribute__((address_space(4))) Args*)__builtin_amdgcn_kernarg_segment_ptr();
    asm volatile("" : "+s"(A));
#define ARGF(i) ((const float*)A->in[i])
#define WSP(T, off) ((T*)(A->ws + (off)))
#define x_in ARGF(0)
#define positions ((const int*)A->in[1])
#define norm1_gain ARGF(2)
#define w_in ARGF(3)
#define hg_lb ARGF(4)
#define hg_norm_gain ARGF(5)
#define diff_lambda ARGF(6)
#define subln_gain ARGF(7)
#define w_out ARGF(8)
#define norm2_gain ARGF(9)
#define rg_w ARGF(10)
#define rg_b ARGF(11)
#define re_w ARGF(12)
#define re_b ARGF(13)
#define w_gate ARGF(14)
#define w_up ARGF(15)
#define w_down ARGF(16)
#define final_gain ARGF(17)
#define out (A->out)
#define cosT WSP(float, WS_ROPE)
#define sinT (WSP(float, WS_ROPE) + M * 8)
#define HD WSP(float, WS_HD)
#define TOKE WSP(int, WS_TOKE)
#define TOKW WSP(float, WS_TOKW)
#define TOKR WSP(int, WS_TOKR)
#define TOKS WSP(int, WS_TOKS)
#define LAMP WSP(float, WS_LAM)
#define WOUT WSP(bf16_t, WS_WOUT)
#define WIN WSP(bf16_t, WS_WIN)
#define XN WSP(bf16_t, WS_XN)
#define QH WSP(bf16_t, WS_QH)
#define VH WSP(bf16_t, WS_VH)
#define SG WSP(bf16_t, WS_SG)
#define QD WSP(bf16_t, WS_QD)
#define KD WSP(bf16_t, WS_KD)
#define VD WSP(bf16_t, WS_VD)
#define GF WSP(half_t, WS_GF)
#define GB WSP(half_t, WS_GB)
#define HS WSP(float, WS_HS)
#define HL WSP(float, WS_HL)
#define OF WSP(float, WS_OF)
#define OB WSP(float, WS_OB)
#define MIX WSP(bf16_t, WS_MIX)
#define X2B WSP(bf16_t, WS_X2B)
#define WGU WSP(bf16_t, WS_WGU)
#define WD WSP(bf16_t, WS_WD)
#define HGb WSP(bf16_t, WS_HG)
#define HM WSP(bf16_t, WS_HM)
#define Y WSP(bf16_t, WS_Y)
#define CNT (WSP(unsigned, WS_CTL) + CW_CNT)
    unsigned* ctl = WSP(unsigned, WS_CTL);
    volatile LAS int* tb = (volatile LAS int*)(MISC + 16);

    if (threadIdx.x < 64) MISC[threadIdx.x] = 0u;
    __syncthreads();
    XcdBarrier bar; bar.bar = ctl + CW_BAR; bar.x = 0; bar.st = nullptr;
    const int lo = A->ph_lo, hi = A->ph_hi;
    if (hi - lo > 1) bar = xcd_barrier_post(ctl + CW_BAR, MISC);
#ifndef PH_MASK
#define PH_MASK 0xFFF
#endif
#define IN(k) (((PH_MASK >> (k)) & 1) && lo <= (k) && (k) < hi)
#ifndef DOUBLE_PHASE
#define DOUBLE_PHASE -1
#endif
#define REP(k) for (int rep_ = 0; rep_ < ((DOUBLE_PHASE) == (k) ? 2 : 1); ++rep_)
#ifndef BAR_REPS
#define BAR_REPS 1
#endif
#ifdef DIAG_SPAN_A
#define STAMP(k) do { if (blockIdx.x == 0 && threadIdx.x == 0) WSP(unsigned long long, WS_LAM + 64)[k] = __builtin_amdgcn_s_memrealtime(); } while (0)
#else
#define STAMP(k) do { } while (0)
#endif
#define SEAM(k) do { if (IN(k) && IN((k) + 1)) for (int b_ = 0; b_ < BAR_REPS; ++b_) xcd_barrier(bar); STAMP((k) + 1); } while (0)

    STAMP(0);
    if (IN(0)) REP(0) { PHASE_IDS;
        LAS float* scr = (LAS float*)(lds + wave * 16384);
        constexpr int I_IN = (D / 64) * (NIN / 32), I_OUT = (D / 64) * (D / 32);
        { XposeRegs R;
#define P0_LOAD(it_) do { if ((it_) < I_IN) xpose_load(R, w_in, D, NIN, (it_), lane); else xpose_load(R, w_out, D, D, (it_) - I_IN, lane); } while (0)
            if (gw < I_IN + I_OUT) P0_LOAD(gw);
            for (int it = gw; it < I_IN + I_OUT; it += NGW) { const XposeRegs C = R; const int nx = it + NGW;
                if (nx < I_IN + I_OUT) P0_LOAD(nx);
                if (it < I_IN) xpose_store(C, D, NIN, WIN, 0, 1, scr, it, lane); else xpose_store(C, D, D, WOUT, 0, 1, scr, it - I_IN, lane); }
#undef P0_LOAD
        }
        for (int m = gw; m < M; m += NGW) rms_rows_to_bf16<1>(x_in, norm1_gain, XN, m, NGW, lane, 1e-6f);
        for (int id = bx * 512 + tid; id < M * 8; id += G * 512) {
            const int i = id & 7; const float invf[8] = {1.0f, 0.19392274474868576f, 0.03760603093086393f, 0.007292664737217109f, 0.001414213562373095f, 0.0002742481756762073f, 5.318295896944988e-05f, 1.031338537721246e-05f};
            float f = invf[0];
#pragma unroll
            for (int q = 1; q < 8; ++q) f = (i == q) ? invf[q] : f;
            const float ang = (float)positions[id >> 3] * f;
            const double rev = (double)ang * 0.15915494309189535; const float fr = (float)(rev - __builtin_rint(rev));
            cosT[id] = __builtin_amdgcn_cosf(fr); sinT[id] = __builtin_amdgcn_sinf(fr);
        }
        for (int id = bx * 512 + tid; id < 32 * 3 * 2 * 64; id += G * 512) {
            const int ln = id & 63, part = (id >> 6) & 1, nt = (id >> 7) % 3, ks = (id >> 7) / 3, n = nt * 16 + (ln & 15), k0 = ks * 32 + 8 * (ln >> 4); unsigned w[4];
#pragma unroll
            for (int jj = 0; jj < 4; ++jj) { float v[2];
#pragma unroll
                for (int u = 0; u < 2; ++u) { const int k = k0 + 2 * jj + u; const float wv = (n < 4 ? rg_w[k * 4 + n] : n < 36 ? re_w[k * 32 + (n - 4)] : 0.f) * norm2_gain[k];
                    const float hv = bf2f(f2bf(wv)); v[u] = part ? wv - hv : hv; }
                w[jj] = pk2(v[0], v[1]); }
            WSP(u32x4, WS_WR)[id] = (u32x4){w[0], w[1], w[2], w[3]}; }
        if (bx == 0 && wave == 0) { const float a = wave_sum(diff_lambda[lane] * diff_lambda[64 + lane]), b = wave_sum(diff_lambda[128 + lane] * diff_lambda[192 + lane]);
            if (lane == 0) LAMP[0] = __expf(a) - __expf(b) + 0.2f; }
    }
    SEAM(0);
    if (IN(1)) REP(1) {
        pg8::Gemm g{XN, WIN, M, NIN, D}; pg8::StaticOrder S; S.init(M, NIN, G, bx);
        EpiInProj E{QH, VH, SG, QD, KD, VD, GF, GB, hg_lb, cosT, sinT};
        pg8::gemm_phase<EpiInProj, pg8::StaticOrder, true, true>(lds, g, S, E);
    }
    SEAM(1);
    if (IN(2)) REP(2) { for (int u = vcu; u < 256; u += G) hg::pass<false>(lds, u, QH, VH, GF, GB, HL, HD, HS, OF, OB);
        { PHASE_IDS; att2::kmax_rows(lds, KD, WSP(unsigned, WS_CTL) + CW_KMAX, gw, NGW, lane, wave); } }
    SEAM(2);
    if (IN(3)) REP(3) hg::scan(HL, HD, HS, bx * 512 + opaque_tid(), G * 512);
    SEAM(3);
    if (IN(4)) REP(4) { for (int u = vcu; u < 256; u += G) hg::pass<true>(lds, u, QH, VH, GF, GB, HL, HD, HS, OF, OB); }
    SEAM(4);
    if (IN(5)) REP(5) { PHASE_IDS;
#ifdef DIAG_CLOCK
        if (blockIdx.x == 0 && threadIdx.x == 0) { WSP(unsigned long long, WS_LAM + 64)[20] = __builtin_amdgcn_s_memtime(); WSP(unsigned long long, WS_LAM + 64)[21] = __builtin_amdgcn_s_memrealtime(); }
#endif
        const float lam = LAMP[0];
        for (int u = vcu; u < 256; u += G) { const int h = u >> 6, q0 = (u & 63) * 256;
            int ln = lane; asm volatile("" : "+v"(ln));
            att::hgrn_finalize(h, q0, OF, OB, SG, hg_norm_gain, MIX, wave, ln);
            att2::unit(lds, h, q0, QD, KD, VD, WSP(unsigned, WS_CTL) + CW_KMAX, WSP(float, WS_O0S) + (size_t)bx * 32768, lam, subln_gain, MIX); }
    }
#ifdef DIAG_CLOCK
    if (blockIdx.x == 0 && threadIdx.x == 0) { WSP(unsigned long long, WS_LAM + 64)[22] = __builtin_amdgcn_s_memtime(); WSP(unsigned long long, WS_LAM + 64)[23] = __builtin_amdgcn_s_memrealtime(); }
#endif
    SEAM(5);
    if (IN(6)) REP(6) {
        pg8::Gemm g{MIX, WOUT, M, D, D}; pg8::StaticOrder S; S.init(M, D, G, bx);
        EpiResid E{x_in, X2B};
        pg8::gemm_phase<EpiResid, pg8::StaticOrder, true, true>(lds, g, S, E);
    }
    SEAM(6);
    if (IN(7)) { PHASE_IDS;
        const int grp = wave * G + vcu; const bool router = grp * 16 < M;
        LAS float* scr = (LAS float*)(lds + wave * 16384);
        if (router) route16(X2B, WSP(const u32x4, WS_WR), rg_b, re_b, WSP(float, WS_RSTD), TOKE, TOKW, TOKR, WSP(unsigned, WS_GCNT), grp * 16, lane, scr + 3072);
        if (router && (DOUBLE_PHASE) == 77) route16(X2B, WSP(const u32x4, WS_WR), rg_b, re_b, WSP(float, WS_RSTD), TOKE, TOKW, TOKR, WSP(unsigned, WS_GCNT), grp * 16, lane, scr + 3072, true);
        constexpr int I_GU = (D / 64) * (DEXP / 32), I_DN = (DEXP / 64) * (D / 32), I_ALL = NEXP * (2 * I_GU + I_DN);
#ifndef P7_SHARE
#define P7_SHARE 10
#endif
        const int nrt = M / 16, nA = nrt < NGW ? nrt : NGW, nB = NGW - nA;
        const int perA = nB ? (I_ALL * P7_SHARE / 24 + nA - 1) / nA : (I_ALL + nA - 1) / nA, totA = perA * nA < I_ALL ? perA * nA : I_ALL;
        int it0, it1, stp;
        if (router) { it0 = grp; it1 = totA; stp = nA; } else { it0 = totA + (grp - nA); it1 = I_ALL; stp = nB; }
        REP(7) { XposeRegs R0, R1;
#define P7_LOAD(R, it_) do { const int e_ = (it_) / (2 * I_GU + I_DN), r_ = (it_) % (2 * I_GU + I_DN); \
            if (r_ < I_GU) xpose_load(R, w_gate + (size_t)e_ * D * DEXP, D, DEXP, r_, lane); else if (r_ < 2 * I_GU) xpose_load(R, w_up + (size_t)e_ * D * DEXP, D, DEXP, r_ - I_GU, lane); \
            else xpose_load(R, w_down + (size_t)e_ * DEXP * D, DEXP, D, r_ - 2 * I_GU, lane); } while (0)
#define P7_STORE(C, it_) do { const int e = (it_) / (2 * I_GU + I_DN), r = (it_) % (2 * I_GU + I_DN); \
            if (r < I_GU) xpose_store(C, D, DEXP, WGU + (size_t)e * 1024 * D, 0, 2, scr, r, lane, norm2_gain); \
            else if (r < 2 * I_GU) xpose_store(C, D, DEXP, WGU + (size_t)e * 1024 * D, 1, 2, scr, r - I_GU, lane, norm2_gain); \
            else xpose_store(C, DEXP, D, WD + (size_t)e * 1024 * DEXP, 0, 1, scr, r - 2 * I_GU, lane); } while (0)
            if (it0 < it1) P7_LOAD(R0, it0);
            if (it0 + stp < it1) P7_LOAD(R1, it0 + stp);
            for (int it = it0; it < it1; it += 2 * stp) {
                { const XposeRegs C = R0; if (it + 2 * stp < it1) P7_LOAD(R0, it + 2 * stp); P7_STORE(C, it); }
                if (it + stp < it1) { const XposeRegs C = R1; if (it + 3 * stp < it1) P7_LOAD(R1, it + 3 * stp); P7_STORE(C, it + stp); }
            }
#undef P7_STORE
#undef P7_LOAD
        }
    }
    SEAM(7);
    if (IN(8)) REP(8) { sort_slots(lds, tb, WSP(unsigned, WS_GCNT), TOKE, TOKR, TOKS, WSP(int, WS_PERM), WSP(const float, WS_RSTD), WSP(float, WS_RSLOT), CNT, bx, G); }
    SEAM(8);
    if (IN(9)) REP(9) {
        build_tile_prefix(tb, CNT);
        pg8::Gemm g{X2B, WGU, MAXSLOTS, NEXP * 1024, D}; MoeOrder S{tb, G, bx, WSP(const int, WS_PERM), WSP(unsigned, WS_CTL) + CW_READY, 0}; EpiSwiGlu E{HM, WSP(const float, WS_RSLOT)};
        pg8::gemm_phase_g<EpiSwiGlu, MoeOrder, true, true>(lds, g, S, E);
    }
    SEAM(9);
    if (IN(10)) REP(10) {
        build_tile_prefix(tb, CNT);
        pg8::Gemm g{HM, WD, MAXSLOTS, NEXP * 1024, DEXP}; MoeOrder S{tb, G, bx, WSP(const int, WS_PERM), WSP(unsigned, WS_CTL) + CW_READY, 0}; EpiDown E{Y};
        pg8::gemm_phase<EpiDown, MoeOrder, true, true>(lds, g, S, E);
    }
    SEAM(10);
    if (IN(11)) { PHASE_IDS; for (int m = gw; m < M; m += NGW) final_rows<1>(X2B, out, Y, TOKS, TOKW, final_gain, m, NGW, lane); }
#ifdef DIAG_SPAN_A
    xcd_barrier(bar); STAMP(12); xcd_barrier(bar);
    { const unsigned long long* st_ = WSP(unsigned long long, WS_LAM + 64);
#ifdef DIAG_CLOCK
      const float d_ = (float)(long long)(st_[22] - st_[20]) / (float)(long long)(st_[23] - st_[21]) * 10.f * DIAG_C;
#else
      const float d_ = (float)(long long)(st_[DIAG_SPAN_B] - st_[DIAG_SPAN_A]) * 0.01f * DIAG_C;
#endif
      for (int m = blockIdx.x * 512 + threadIdx.x; m < M; m += gridDim.x * 512) out[(size_t)m * D] += d_; }
#endif
#undef IN
#undef SEAM
#undef x_in
#undef positions
#undef out
#undef Y
#undef HM
#undef CNT
}

extern "C" void kernel_launch(void* const* d_in, const int* in_sizes, int n_in, void* d_out, int out_size, void* d_ws, size_t ws_size, hipStream_t stream) {
    static int grid = 0;
    if (grid == 0) {
        if (n_in != 18 || in_sizes[0] != M * D || out_size != M * D || ws_size < WS_END) { fprintf(stderr, "kernel_launch: unexpected shapes (n_in %d, in0 %d, out %d, ws %zu)\n", n_in, n_in > 0 ? in_sizes[0] : -1, out_size, ws_size); grid = -1; return; }
        int dev = 0, cus = 0, per_cu = 0;
        if (hipGetDevice(&dev) != hipSuccess || hipDeviceGetAttribute(&cus, hipDeviceAttributeMultiprocessorCount, dev) != hipSuccess) { grid = -1; return; }
        if (hipFuncSetAttribute((const void*)mk_fwd, hipFuncAttributeMaxDynamicSharedMemorySize, LDS_BYTES) != hipSuccess) { fprintf(stderr, "kernel_launch: hipFuncSetAttribute failed\n"); grid = -1; return; }
        if (hipOccupancyMaxActiveBlocksPerMultiprocessor(&per_cu, (const void*)mk_fwd, NWAVES * 64, LDS_BYTES) != hipSuccess || per_cu < 1) { fprintf(stderr, "kernel_launch: occupancy query says %d\n", per_cu); (void)hipGetLastError(); grid = -1; return; }
        grid = cus;
    }
    if (grid < 0) return;
    if (hipMemsetAsync((char*)d_ws + WS_CTL, 0, CTL_ZERO_BYTES, stream) != hipSuccess) return;
    Args a{};
    for (int i = 0; i < 18; ++i) a.in[i] = d_in[i];
    a.out = (float*)d_out; a.ws = (unsigned char*)d_ws;
#if MK_N_LAUNCHES == 1
    a.ph_lo = 0; a.ph_hi = N_PHASES;
    hipLaunchKernelGGL(mk_fwd, dim3(grid), dim3(NWAVES * 64), LDS_BYTES, stream, a);
#else
    for (int p = 0; p < N_PHASES; ++p) { a.ph_lo = p; a.ph_hi = p + 1; hipLaunchKernelGGL(mk_fwd, dim3(grid), dim3(NWAVES * 64), LDS_BYTES, stream, a); }
#endif
}
```

```cpp
#include <hip/hip_runtime.h>
#include <cstdio>
#include <cstdint>
__device__ __forceinline__ int opaque_tid() { int t = threadIdx.x; asm volatile("" : "+v"(t)); return t; }
namespace pg8 {
#define PG8_LAS __attribute__((address_space(3)))
typedef unsigned short bf16_t;
typedef short bf16x8 __attribute__((ext_vector_type(8)));
typedef float f32x4 __attribute__((ext_vector_type(4)));
typedef unsigned u32x4 __attribute__((ext_vector_type(4)));
constexpr int BM = 256, BK = 64, HALF = 128, HTB = HALF * BK * 2  , STAGE_BYTES = 8 * HTB, NXCD = 8, WGM = 8;

__host__ __device__ __forceinline__ int lds_byte(int r, int c) { const int st = (r >> 4) * 2 + (c >> 5), rr = r & 15, cc = c & 31, ob = rr * 64 + cc * 2; return st * 1024 + (ob ^ (((ob >> 9) & 1) << 5)); }
__host__ __device__ __forceinline__ void stage_rc(int b, int& R, int& C) { const int st = b / 1024, sb = b % 1024, swz = sb ^ (((sb >> 9) & 1) << 5); R = (st >> 1) * 16 + swz / 64; C = (st & 1) * 32 + (swz % 64) / 2; }
__host__ __device__ __forceinline__ int perm32(int rho) { const int n = rho >> 4, i = rho & 15; return 8 * (i >> 2) + 4 * n + (i & 3); }

struct Unit { int pm, pn; };
struct Gemm { const bf16_t* A; const bf16_t* Bt; int M, N, K; };

struct StaticOrder {
    int nM, nN, nwg, G, c;
    __host__ __device__ void init(int M, int N, int G_, int c_) { nM = M / BM; nN = N / BM; nwg = nM * nN; G = G_; c = c_; }
    __host__ __device__ bool next(int i, Unit& u) const {
        const long L = (long)i * G + c; if (L >= nwg) return false;
        int wgid = (int)L; { const int q = nwg / NXCD, r = nwg % NXCD, xcd = wgid % NXCD, off = wgid / NXCD; wgid = (xcd < r ? xcd * (q + 1) : r * (q + 1) + (xcd - r) * q) + off; }
        const int nig = WGM * nN, gid = wgid / nig, fm = gid * WGM, gsz = (nM - fm) < WGM ? (nM - fm) : WGM;
        u.pm = fm + ((wgid % nig) % gsz); u.pn = (wgid % nig) / gsz; return true;
    }
    __device__ __forceinline__ bool half_only(const Unit&) const { return false; }
    __device__ __forceinline__ void a_ready(const Unit&) const {}
    __device__ __forceinline__ void done(const Unit&) const {}
};

template <class Epi, class Sched, bool ALIGN_EPI = false, bool SP2 = false, bool F8 = false>
__device__ __forceinline__ void gemm_phase(PG8_LAS unsigned char* lds, const Gemm g, const Sched& S, const Epi& E) {
    const int tid = opaque_tid(), wid = __builtin_amdgcn_readfirstlane(tid >> 6), lane = tid & 63, wr = wid >> 2, wc = wid & 3, fr = lane & 15, fq = lane >> 4;
    const int K = g.K, nt = K / BK;
    unsigned voffA[2], voffB[2];
#pragma unroll
    for (int i = 0; i < 2; ++i) { int R, C; stage_rc(tid * 16 + i * 8192, R, C); const int Rb = Epi::PERM ? ((R & ~31) + perm32(R & 31)) : R;
        voffA[i] = (unsigned)(R * K + C) * 2u; voffB[i] = (unsigned)(Rb * K + C) * 2u; }
    const size_t kstep = (size_t)(BK * 2);
    const size_t hstep = (size_t)HALF * K * 2;
    const size_t tstep = 2 * hstep;
    const unsigned ldsw = (unsigned)wid * 1024u;
    const int aoff = lds_byte(wr * 64 + fr, fq * 8), boff = lds_byte(wc * 32 + fr, fq * 8);
#define PG8_SA(b, h) (((b) * 2 + (h)) * HTB)
#define PG8_SB(b, h) ((4 + (b) * 2 + (h)) * HTB)
#define PG8_STAGE(bufoff, gbase, voff) do { _Pragma("unroll") for (int _i = 0; _i < 2; ++_i) \
        __builtin_amdgcn_global_load_lds((const unsigned*)((const char*)(gbase) + (voff)[_i]), (PG8_LAS unsigned*)(lds + (bufoff) + ldsw + _i * 8192), 16, 0, 0); } while (0)
#define PG8_LDA(dst, b, h) do { _Pragma("unroll") for (int m = 0; m < 4; ++m) _Pragma("unroll") for (int k = 0; k < 2; ++k) dst[m][k] = *(const PG8_LAS bf16x8*)(lds + PG8_SA(b, h) + aoff + m * 2048 + k * 1024); } while (0)
#define PG8_LDB(dst, b, h) do { _Pragma("unroll") for (int n = 0; n < 2; ++n) _Pragma("unroll") for (int k = 0; k < 2; ++k) dst[n][k] = *(const PG8_LAS bf16x8*)(lds + PG8_SB(b, h) + boff + n * 2048 + k * 1024); } while (0)
#define PG8_MMA(ai, bj, At, Bt) do { __builtin_amdgcn_s_setprio(1); _Pragma("unroll") for (int m = 0; m < 4; ++m) _Pragma("unroll") for (int n = 0; n < 2; ++n) _Pragma("unroll") for (int k = 0; k < 2; ++k) { \
        if constexpr (F8) { typedef long v2l_ __attribute__((ext_vector_type(2))); const v2l_ b_ = __builtin_bit_cast(v2l_, Bt[n][k]), a_ = __builtin_bit_cast(v2l_, At[m][k]); \
            acc[ai][bj][m][n] = __builtin_amdgcn_mfma_f32_16x16x32_fp8_fp8(b_[0], a_[0], acc[ai][bj][m][n], 0, 0, 0); acc[ai][bj][m][n] = __builtin_amdgcn_mfma_f32_16x16x32_fp8_fp8(b_[1], a_[1], acc[ai][bj][m][n], 0, 0, 0); } \
        else acc[ai][bj][m][n] = __builtin_amdgcn_mfma_f32_16x16x32_bf16(Bt[n][k], At[m][k], acc[ai][bj][m][n], 0, 0, 0); } \
        __builtin_amdgcn_s_setprio(0); } while (0)
#define PG8_WAIT_V(n) asm volatile("s_waitcnt vmcnt(" #n ")" ::: "memory")
#define PG8_WAIT_L(n) asm volatile("s_waitcnt lgkmcnt(" #n ")" ::: "memory")
#define PG8_BAR __builtin_amdgcn_s_barrier()
#define PG8_SCHED __builtin_amdgcn_sched_barrier(0)
    Unit cur, nxt; int ui = 0;
    if (!S.next(0, cur)) return;
    f32x4 acc[2][2][4][2];
#pragma unroll
    for (int a = 0; a < 2; ++a)
#pragma unroll
        for (int b = 0; b < 2; ++b)
#pragma unroll
            for (int m = 0; m < 4; ++m)
#pragma unroll
                for (int n = 0; n < 2; ++n) acc[a][b][m][n] = (f32x4){0.f, 0.f, 0.f, 0.f};
    bf16x8 At[4][2], B0[2][2], B1[2][2];
    const char* cA = (const char*)g.A + (size_t)cur.pm * tstep; const char* cB = (const char*)g.Bt + (size_t)cur.pn * tstep;
    S.a_ready(cur);
    if constexpr (SP2) {
        PG8_STAGE(PG8_SB(0, 0), cB, voffB); PG8_STAGE(PG8_SB(0, 1), cB + hstep, voffB); PG8_STAGE(PG8_SA(0, 0), cA, voffA); PG8_STAGE(PG8_SA(0, 1), cA + hstep, voffA);
        if (wr == 1) PG8_BAR;
        PG8_WAIT_V(2); PG8_BAR;
        PG8_STAGE(PG8_SB(1, 0), cB + kstep, voffB); PG8_STAGE(PG8_SA(1, 0), cA + kstep, voffA); PG8_STAGE(PG8_SB(1, 1), cB + hstep + kstep, voffB);
        PG8_WAIT_V(6); PG8_BAR;
    } else {
        PG8_STAGE(PG8_SB(0, 0), cB, voffB); PG8_STAGE(PG8_SA(0, 0), cA, voffA); PG8_STAGE(PG8_SB(0, 1), cB + hstep, voffB); PG8_STAGE(PG8_SA(0, 1), cA + hstep, voffA);
        if (wr == 1) PG8_BAR;
        PG8_WAIT_V(4); PG8_BAR;
        PG8_STAGE(PG8_SB(1, 0), cB + kstep, voffB); PG8_STAGE(PG8_SA(1, 0), cA + kstep, voffA); PG8_STAGE(PG8_SB(1, 1), cB + hstep + kstep, voffB);
        PG8_WAIT_V(6); PG8_BAR;
    }
    for (;;) {
        const bool has_next = S.next(ui + 1, nxt);
        const char* nA = has_next ? (const char*)g.A + (size_t)nxt.pm * tstep : cA; const char* nB = has_next ? (const char*)g.Bt + (size_t)nxt.pn * tstep : cB;
        for (int t = 0; t < nt; t += 2) {
            const bool last = (t == nt - 2);
            const char* a1 = cA + (size_t)(t + 1) * kstep;
            const char* a2 = last ? nA : cA + (size_t)(t + 2) * kstep; const char* b2 = last ? nB : cB + (size_t)(t + 2) * kstep;
            const char* a3 = a2 + kstep; const char* b3 = b2 + kstep;
            if (last && has_next) S.a_ready(nxt);
            if constexpr (SP2) {
            PG8_LDB(B0, 0, 0); PG8_LDB(B1, 0, 1); PG8_SCHED; PG8_LDA(At, 0, 0); PG8_STAGE(PG8_SA(1, 1), a1 + hstep, voffA);
            PG8_WAIT_V(8); PG8_WAIT_L(0); PG8_BAR; PG8_MMA(0, 0, At, B0); PG8_MMA(0, 1, At, B1); PG8_BAR; PG8_SCHED;
            PG8_LDA(At, 0, 1); PG8_STAGE(PG8_SB(0, 0), b2, voffB); PG8_STAGE(PG8_SB(0, 1), b2 + hstep, voffB); PG8_STAGE(PG8_SA(0, 0), a2, voffA);
            PG8_WAIT_V(8); PG8_WAIT_L(0); PG8_BAR; PG8_MMA(1, 0, At, B0); PG8_MMA(1, 1, At, B1); PG8_BAR; PG8_SCHED;
            PG8_LDB(B0, 1, 0); PG8_LDB(B1, 1, 1); PG8_SCHED; PG8_LDA(At, 1, 0); PG8_STAGE(PG8_SA(0, 1), a2 + hstep, voffA);
            PG8_WAIT_V(8); PG8_WAIT_L(0); PG8_BAR; PG8_MMA(0, 0, At, B0); PG8_MMA(0, 1, At, B1); PG8_BAR; PG8_SCHED;
            PG8_LDA(At, 1, 1); PG8_STAGE(PG8_SB(1, 0), b3, voffB); PG8_STAGE(PG8_SB(1, 1), b3 + hstep, voffB); PG8_STAGE(PG8_SA(1, 0), a3, voffA);
            PG8_WAIT_V(8); PG8_WAIT_L(0); PG8_BAR; PG8_MMA(1, 0, At, B0); PG8_MMA(1, 1, At, B1); PG8_BAR; PG8_SCHED;
            } else {
            PG8_LDB(B0, 0, 0); PG8_SCHED; PG8_LDA(At, 0, 0); PG8_STAGE(PG8_SA(1, 1), a1 + hstep, voffA);
            PG8_WAIT_L(8); PG8_BAR; PG8_WAIT_L(0); PG8_MMA(0, 0, At, B0); PG8_BAR; PG8_SCHED;
            PG8_LDB(B1, 0, 1); PG8_STAGE(PG8_SB(0, 0), b2, voffB);
            PG8_BAR; PG8_WAIT_L(0); PG8_MMA(0, 1, At, B1); PG8_BAR;
            PG8_LDA(At, 0, 1); PG8_STAGE(PG8_SA(0, 0), a2, voffA);
            PG8_BAR; PG8_WAIT_L(0); PG8_MMA(1, 0, At, B0); PG8_BAR; PG8_SCHED;
            PG8_STAGE(PG8_SB(0, 1), b2 + hstep, voffB);
            PG8_WAIT_V(6); PG8_BAR; PG8_MMA(1, 1, At, B1); PG8_BAR;
            PG8_LDB(B0, 1, 0); PG8_SCHED; PG8_LDA(At, 1, 0); PG8_STAGE(PG8_SA(0, 1), a2 + hstep, voffA);
            PG8_WAIT_L(8); PG8_BAR; PG8_WAIT_L(0); PG8_MMA(0, 0, At, B0); PG8_BAR; PG8_SCHED;
            PG8_LDB(B1, 1, 1); PG8_STAGE(PG8_SB(1, 0), b3, voffB);
            PG8_BAR; PG8_WAIT_L(0); PG8_MMA(0, 1, At, B1); PG8_BAR;
            PG8_LDA(At, 1, 1); PG8_STAGE(PG8_SA(1, 0), a3, voffA);
            PG8_BAR; PG8_WAIT_L(0); PG8_MMA(1, 0, At, B0); PG8_BAR; PG8_SCHED;
            PG8_STAGE(PG8_SB(1, 1), b3 + hstep, voffB);
            PG8_WAIT_V(6); PG8_BAR; PG8_MMA(1, 1, At, B1); PG8_BAR;
            }
        }
        if constexpr (ALIGN_EPI) { if (wr == 0) PG8_BAR; }
        if constexpr (!Epi::AFTER_DRAIN) { E(acc, cur, wr, wc, fr, fq); S.done(cur); }
        if (!has_next) break;
#pragma unroll
        for (int a = 0; a < 2; ++a)
#pragma unroll
            for (int b = 0; b < 2; ++b)
#pragma unroll
                for (int m = 0; m < 4; ++m)
#pragma unroll
                    for (int n = 0; n < 2; ++n) acc[a][b][m][n] = (f32x4){0.f, 0.f, 0.f, 0.f};
        cur = nxt; cA = nA; cB = nB; ++ui;
        if constexpr (ALIGN_EPI) { if (wr == 1) PG8_BAR; }
    }
    PG8_WAIT_V(0);
    if constexpr (!ALIGN_EPI) { if (wr == 0) PG8_BAR; }
    PG8_BAR;
    if constexpr (Epi::AFTER_DRAIN) { E.fused(acc, cur, wr, wc, fr, fq, lds, wid, lane); S.done(cur); }
#undef PG8_SA
#undef PG8_SB
#undef PG8_STAGE
#undef PG8_LDA
#undef PG8_LDB
#undef PG8_MMA
#undef PG8_WAIT_V
#undef PG8_WAIT_L
#undef PG8_BAR
#undef PG8_SCHED
}
}

constexpr int NWAVES = 8;
constexpr int M = 16384, D = 1024, NIN = 4096, HSEC = 512;
constexpr int NEXP = 32, DEXP = 512, MAXTILES = 160, MAXSLOTS = MAXTILES * 256;
constexpr float QSCALE = 0.18033688011112042f;

constexpr size_t MiB = 1u << 20;
constexpr size_t WS_CTL = 0, CTL_ZERO_BYTES = 1 * MiB;
constexpr size_t WS_WR = 1 * MiB;
constexpr size_t WS_ROPE = 2 * MiB;
constexpr size_t WS_HD = 3 * MiB;
constexpr size_t WS_TOKE = 3 * MiB + 256 * 1024, WS_TOKW = WS_TOKE + 128 * 1024, WS_TOKR = WS_TOKW + 128 * 1024, WS_TOKS = WS_TOKR + 128 * 1024, WS_LAM = WS_TOKS + 128 * 1024, WS_GCNT = WS_LAM + 128 * 1024, WS_RSTD = 1 * MiB + 256 * 1024, WS_RSLOT = 1 * MiB + 768 * 1024, WS_PERM = 1 * MiB + 512 * 1024;
constexpr size_t WS_WOUT = 4 * MiB, WS_WIN = 6 * MiB;
constexpr size_t WS_XN = 16 * MiB;
constexpr size_t WS_OF = 16 * MiB;
constexpr size_t WS_X2B = 16 * MiB;
constexpr size_t WS_HM = 144 * MiB;
constexpr size_t WS_X2F8 = 112 * MiB;
constexpr size_t WS_QH = 48 * MiB, WS_VH = 64 * MiB, WS_SG = 80 * MiB, WS_QD = 96 * MiB, WS_KD = 112 * MiB, WS_VD = 128 * MiB;
constexpr size_t WS_WGU = 48 * MiB, WS_WD = 216 * MiB;
constexpr size_t WS_GF = 144 * MiB, WS_GB = 176 * MiB;
constexpr size_t WS_MIX = 144 * MiB;
constexpr size_t WS_HS = 208 * MiB, WS_HL = 224 * MiB;
constexpr size_t WS_OB = 224 * MiB;
constexpr size_t WS_HG = 176 * MiB;
constexpr size_t WS_O0S = 176 * MiB;
constexpr size_t WS_Y = 48 * MiB;
constexpr size_t WS_END = 256 * MiB;
static_assert(WS_Y + (size_t)MAXSLOTS * 1024 * 2 <= WS_HM && WS_HM + (size_t)MAXSLOTS * 512 * 2 <= WS_WD && WS_WD + 32 * MiB <= WS_END, "ws map");
constexpr int CW_BAR = 4096, CW_CNT = 16384, CW_KMAX = 20480, CW_QWD = 21504, CW_READY = 32768, CNT_STRIDE = 64;

constexpr int PHASE_LDS = 147456, MISC_OFF = PHASE_LDS, LDS_BYTES = PHASE_LDS + 1024;

#define GAS __attribute__((address_space(1)))
#define LAS __attribute__((address_space(3)))
typedef unsigned short bf16_t;
typedef _Float16 half_t;
typedef float f32x4 __attribute__((ext_vector_type(4)));
typedef float f32x16 __attribute__((ext_vector_type(16)));
typedef short bf16x8 __attribute__((ext_vector_type(8)));
typedef short s16x4 __attribute__((ext_vector_type(4)));
typedef unsigned u32x4 __attribute__((ext_vector_type(4)));
typedef unsigned u32x2 __attribute__((ext_vector_type(2)));
#define LDS_WAIT() asm volatile("s_waitcnt lgkmcnt(0)" ::: "memory")
#define VM_WAIT() asm volatile("s_waitcnt vmcnt(0)" ::: "memory")
#define SBAR() __builtin_amdgcn_sched_barrier(0)
__device__ __forceinline__ unsigned f2bf(float f) { unsigned u = __builtin_bit_cast(unsigned, f); return (u + 0x7fffu + ((u >> 16) & 1u)) >> 16; }
__device__ __forceinline__ unsigned pk2(float lo, float hi) { return f2bf(lo) | (f2bf(hi) << 16); }
__device__ __forceinline__ float bf2f(unsigned b) { return __builtin_bit_cast(float, b << 16); }
__device__ __forceinline__ float bflo(unsigned w) { return __builtin_bit_cast(float, w << 16); }
__device__ __forceinline__ float bfhi(unsigned w) { return __builtin_bit_cast(float, w & 0xffff0000u); }
__device__ __forceinline__ unsigned cvtpk(float lo, float hi) { unsigned r; asm volatile("v_cvt_pk_bf16_f32 %0, %1, %2" : "=v"(r) : "v"(lo), "v"(hi)); return r; }
__device__ __forceinline__ unsigned pk4_fp8(float a, float b, float c, float d) { int w = 0; w = __builtin_amdgcn_cvt_pk_fp8_f32(a, b, w, false); w = __builtin_amdgcn_cvt_pk_fp8_f32(c, d, w, true); return (unsigned)w; }
constexpr float F8_WSCALE = 256.f, F8_HSCALE = 16.f;
__device__ __forceinline__ float ex2(float x) { return __builtin_amdgcn_exp2f(x); }
__device__ __forceinline__ float lg2(float x) { return __builtin_amdgcn_logf(x); }
__device__ __forceinline__ float sigmoidf_(float v) { return __builtin_amdgcn_rcpf(1.f + ex2(-1.4426950408889634f * v)); }
__device__ __forceinline__ bool lane_is_hi() { return (opaque_tid() & 32) != 0; }
template <int X> __device__ __forceinline__ float lane_xor(float v) {
    if constexpr (X == 32) { auto rr = __builtin_amdgcn_permlane32_swap(__float_as_uint(v), __float_as_uint(v), false, false); return __uint_as_float(lane_is_hi() ? rr[0] : rr[1]); }
    else return __int_as_float(__builtin_amdgcn_ds_swizzle(__float_as_int(v), (X << 10) | 0x1F));
}
__device__ __forceinline__ float wave_sum(float v) {
    v += lane_xor<1>(v); v += lane_xor<2>(v); v += lane_xor<4>(v); v += lane_xor<8>(v); v += lane_xor<16>(v);
    auto rr = __builtin_amdgcn_permlane32_swap(__float_as_uint(v), __float_as_uint(v), false, false);
    return __uint_as_float(rr[0]) + __uint_as_float(rr[1]);
}
__device__ __forceinline__ int crow(int r, int hi) { return (r & 3) + 8 * (r >> 2) + 4 * hi; }
#define XB_TMO      128
#define XB_XCNT(j)  (256  + 64 * (j))
#define XB_XSUB(j)  (1280 + 64 * (j))
#define XB_XGEN(j)  (2304 + 64 * (j))
#define XB_TOP      3328
#define XB_TOPGEN   3392
#define XCD_BAR_WORDS 3456
#define XB_SPIN_CAP (1u << 18)

__device__ __forceinline__ unsigned xb_ld(unsigned* p)              { return __hip_atomic_load(p, __ATOMIC_RELAXED, __HIP_MEMORY_SCOPE_AGENT); }
__device__ __forceinline__ unsigned xb_add(unsigned* p, unsigned v) { return __hip_atomic_fetch_add(p, v, __ATOMIC_RELAXED, __HIP_MEMORY_SCOPE_AGENT); }
__device__ __forceinline__ unsigned xb_xcc_id() { return (unsigned)__builtin_amdgcn_s_getreg((3 << 11) | 20) & 0xFu; }
#define XB_SPIN(cond, bar) do { unsigned _sp = 0; while (cond) { __builtin_amdgcn_s_sleep(1); \
    if ((++_sp & 255u) == 0u) { if (xb_ld(&(bar)[XB_TMO])) break; if (_sp > XB_SPIN_CAP) { atomicAdd(&(bar)[XB_TMO], 1u); break; } } } } while (0)

struct XcdBarrier {
    unsigned* bar; unsigned x;
    volatile LAS unsigned* st;
};

__device__ __forceinline__ XcdBarrier xcd_barrier_post(unsigned* bar, volatile LAS unsigned* st) {
    XcdBarrier b; b.bar = bar; b.x = xb_xcc_id(); b.st = st;
    if (threadIdx.x == 0) (void)xb_add(&bar[XB_XCNT(b.x)], 1u);
    return b;
}
__device__ __forceinline__ void xcd_barrier_complete(unsigned* bar, unsigned x, unsigned& nloc, unsigned& nx) {
    const unsigned G = gridDim.x * gridDim.y * gridDim.z;
    unsigned sum, cnt, mine, sp = 0u;
    for (;;) {
        sum = 0u; cnt = 0u; mine = 0u;
#pragma unroll
        for (unsigned j = 0; j < 16; ++j) { const unsigned c = xb_ld(&bar[XB_XCNT(j)]); sum += c; cnt += (c > 0u) ? 1u : 0u; mine = (j == x) ? c : mine; }
        if (sum == G) break;
        __builtin_amdgcn_s_sleep(1);
        if ((++sp & 255u) == 0u) { if (xb_ld(&bar[XB_TMO])) break; if (sp > XB_SPIN_CAP) { atomicAdd(&bar[XB_TMO], 1u); break; } }
    }
    nloc = mine > 0u ? mine : 1u; nx = cnt > 0u ? cnt : 1u;
}

__device__ __forceinline__ void xcd_barrier(const XcdBarrier& b) {
    asm volatile("s_waitcnt vmcnt(0)" ::: "memory");
    __syncthreads();
    if (threadIdx.x == 0) {
        unsigned* bar = b.bar;
        __builtin_amdgcn_s_waitcnt(0);
        unsigned nloc = b.st[0], nx = b.st[1];
        if (nloc == 0u) { xcd_barrier_complete(bar, b.x, nloc, nx); b.st[0] = nloc; b.st[1] = nx; }
        const unsigned old = xb_add(&bar[XB_XSUB(b.x)], 1u);
        const unsigned gen = old / nloc;
        if (old + 1u == (gen + 1u) * nloc) {
            __builtin_amdgcn_fence(__ATOMIC_RELEASE, "agent");
            asm volatile("s_waitcnt vmcnt(0)" ::: "memory");
            const unsigned og = xb_add(&bar[XB_TOP], 1u);
            const unsigned tg = og / nx;
            if (og + 1u == (tg + 1u) * nx) xb_add(&bar[XB_TOPGEN], 1u);
            else XB_SPIN(xb_ld(&bar[XB_TOPGEN]) == tg, bar);
            __builtin_amdgcn_fence(__ATOMIC_ACQUIRE, "agent");
            xb_add(&bar[XB_XGEN(b.x)], 1u);
            asm volatile("s_waitcnt vmcnt(0)" ::: "memory");
        } else {
            XB_SPIN(xb_ld(&bar[XB_XGEN(b.x)]) == gen, bar);
            __builtin_amdgcn_fence(__ATOMIC_ACQUIRE, "agent");
            asm volatile("s_waitcnt vmcnt(0)" ::: "memory");
        }
    }
    __syncthreads();
}

struct XposeRegs { f32x4 v[8]; };
__device__ __forceinline__ void xpose_load(XposeRegs& R, const float* W, int K, int N, int item, int lane) {
    const int nblk = N / 32, kb = item / nblk, nb = item % nblk, k0 = 64 * kb, n0 = 32 * nb; (void)K;
    const float* p = W + (size_t)(k0 + (lane >> 3)) * N + n0 + (lane & 7) * 4;
#pragma unroll
    for (int i = 0; i < 8; ++i) R.v[i] = __builtin_nontemporal_load((const GAS f32x4*)(p + (size_t)(8 * i) * N));
}
__device__ __forceinline__ void xpose_store(const XposeRegs& R, int K, int N, bf16_t* WT, int row_off, int row_mul, LAS float* scr, int item, int lane, const float* kgain = nullptr) {
    const int nblk = N / 32, kb = item / nblk, nb = item % nblk, k0 = 64 * kb, n0 = 32 * nb;
#pragma unroll
    for (int i = 0; i < 8; ++i) { LAS float* d = scr + (8 * i + (lane >> 3)) * 33 + (lane & 7) * 4; d[0] = R.v[i].x; d[1] = R.v[i].y; d[2] = R.v[i].z; d[3] = R.v[i].w; }
    LDS_WAIT(); asm volatile("" ::: "memory");
    const int c = lane & 7;
    f32x4 g0 = {1.f, 1.f, 1.f, 1.f}, g1 = g0;
    if (kgain) { g0 = *(const GAS f32x4*)(kgain + k0 + 8 * c); g1 = *(const GAS f32x4*)(kgain + k0 + 8 * c + 4); }
#pragma unroll
    for (int j = 0; j < 4; ++j) { const int n = (lane >> 3) + 8 * j; const LAS float* s = scr + (8 * c) * 33 + n;
        u32x4 o; o.x = cvtpk(s[0 * 33] * g0.x, s[1 * 33] * g0.y); o.y = cvtpk(s[2 * 33] * g0.z, s[3 * 33] * g0.w); o.z = cvtpk(s[4 * 33] * g1.x, s[5 * 33] * g1.y); o.w = cvtpk(s[6 * 33] * g1.z, s[7 * 33] * g1.w);
        *(GAS u32x4*)(WT + (size_t)(row_off + (n0 + n) * row_mul) * K + k0 + 8 * c) = o; }
    LDS_WAIT(); asm volatile("" ::: "memory");
}
__device__ __forceinline__ void xpose_store_f8(const XposeRegs& R, int K, int N, unsigned char* WT, int row_off, int row_mul, LAS float* scr, int item, int lane, float scale, const float* kgain = nullptr) {
    const int nblk = N / 32, kb = item / nblk, nb = item % nblk, k0 = 64 * kb, n0 = 32 * nb;
#pragma unroll
    for (int i = 0; i < 8; ++i) { LAS float* d = scr + (8 * i + (lane >> 3)) * 33 + (lane & 7) * 4; d[0] = R.v[i].x; d[1] = R.v[i].y; d[2] = R.v[i].z; d[3] = R.v[i].w; }
    LDS_WAIT(); asm volatile("" ::: "memory");
    const int c = lane & 7;
    f32x4 g0 = {scale, scale, scale, scale}, g1 = g0;
    if (kgain) { g0 = *(const GAS f32x4*)(kgain + k0 + 8 * c) * scale; g1 = *(const GAS f32x4*)(kgain + k0 + 8 * c + 4) * scale; }
#pragma unroll
    for (int j = 0; j < 4; ++j) { const int n = (lane >> 3) + 8 * j; const LAS float* s = scr + (8 * c) * 33 + n;
        u32x2 o; o.x = pk4_fp8(s[0 * 33] * g0.x, s[1 * 33] * g0.y, s[2 * 33] * g0.z, s[3 * 33] * g0.w); o.y = pk4_fp8(s[4 * 33] * g1.x, s[5 * 33] * g1.y, s[6 * 33] * g1.z, s[7 * 33] * g1.w);
        *(GAS u32x2*)(WT + (size_t)(row_off + (n0 + n) * row_mul) * K + k0 + 8 * c) = o; }
    LDS_WAIT(); asm volatile("" ::: "memory");
}
template <int NR>
__device__ __forceinline__ void rms_rows_to_bf16(const float* X, const float* gain, bf16_t* O, int m0, int stride, int lane, float eps) {
    f32x4 v[NR][4]; float s[NR];
#pragma unroll
    for (int i = 0; i < NR; ++i) { const GAS f32x4* xr = (const GAS f32x4*)(X + (size_t)(m0 + i * stride) * D) + lane;
#pragma unroll
        for (int j = 0; j < 4; ++j) v[i][j] = xr[64 * j]; }
#pragma unroll
    for (int i = 0; i < NR; ++i) { float t = 0.f;
#pragma unroll
        for (int j = 0; j < 4; ++j) t += (v[i][j].x * v[i][j].x + v[i][j].y * v[i][j].y) + (v[i][j].z * v[i][j].z + v[i][j].w * v[i][j].w);
        s[i] = t; }
#pragma unroll
    for (int i = 0; i < NR; ++i) s[i] = 1.f / sqrtf(wave_sum(s[i]) * (1.f / 1024.f) + eps);
#pragma unroll
    for (int j = 0; j < 4; ++j) { const f32x4 g = ((const GAS f32x4*)gain)[64 * j + lane];
#pragma unroll
        for (int i = 0; i < NR; ++i) { u32x2 w; w.x = cvtpk(v[i][j].x * s[i] * g.x, v[i][j].y * s[i] * g.y); w.y = cvtpk(v[i][j].z * s[i] * g.z, v[i][j].w * s[i] * g.w);
            ((GAS u32x2*)(O + (size_t)(m0 + i * stride) * D) + lane)[64 * j] = w; } }
}

struct EpiInProj {
    static constexpr bool PERM = true, AFTER_DRAIN = false;
    bf16_t *QH, *VH, *SG, *QD, *KD, *VD; half_t *GF, *GB; const float* lbraw; const float *cosT, *sinT;
    __device__ __forceinline__ void operator()(const pg8::f32x4 (&acc)[2][2][4][2], const pg8::Unit& u, int wr, int wc, int fr, int fq) const {
        const int sec = u.pn >> 1;
        const int row0 = u.pm * 256 + wr * 64 + fr;
        const int cs0 = (u.pn & 1) * 256 + wc * 32 + 8 * fq;
        if (sec == 1 || sec == 2) {
            half_t* G = sec == 1 ? GF : GB; const float* lbp = lbraw + (sec - 1) * 1024;
#pragma unroll
            for (int bj = 0; bj < 2; ++bj) { const int c = cs0 + bj * 128; float lb[8];
#pragma unroll
                for (int j = 0; j < 8; ++j) { const float l0 = lbp[c + j], l1 = lbp[512 + c + j]; lb[j] = __builtin_amdgcn_rcpf(1.f + ex2(1.4426950408889634f * (l0 - l1))); }
#pragma unroll
                for (int ai = 0; ai < 2; ++ai)
#pragma unroll
                    for (int m = 0; m < 4; ++m) { const int row = row0 + ai * 128 + m * 16; f32x4 o0, o1;
#pragma unroll
                        for (int j = 0; j < 4; ++j) { o0[j] = lb[j] + (1.f - lb[j]) * sigmoidf_(acc[ai][bj][m][0][j]); o1[j] = lb[4 + j] + (1.f - lb[4 + j]) * sigmoidf_(acc[ai][bj][m][1][j]); }
                        typedef _Float16 h8 __attribute__((ext_vector_type(8)));
                        const h8 hv = {(_Float16)o0[0], (_Float16)o0[1], (_Float16)o0[2], (_Float16)o0[3], (_Float16)o1[0], (_Float16)o1[1], (_Float16)o1[2], (_Float16)o1[3]};
                        *(h8*)(G + (size_t)row * HSEC + c) = hv; } }
            return;
        }
        bf16_t* O = sec == 0 ? QH : sec == 3 ? VH : sec == 4 ? SG : sec == 5 ? QD : sec == 6 ? KD : VD;
        const bool rot = (sec == 5 || sec == 6) && ((wc & 1) == 0);
        const float sc = sec == 5 ? QSCALE : 1.f;
#pragma unroll
        for (int ai = 0; ai < 2; ++ai)
#pragma unroll
            for (int m = 0; m < 4; ++m) { const int row = row0 + ai * 128 + m * 16;
#pragma unroll
                for (int bj = 0; bj < 2; ++bj) { const int c = cs0 + bj * 128; float v[8];
#pragma unroll
                    for (int j = 0; j < 4; ++j) { v[j] = acc[ai][bj][m][0][j]; v[4 + j] = acc[ai][bj][m][1][j]; }
                    if (sec == 4) {
#pragma unroll
                        for (int j = 0; j < 8; ++j) v[j] = v[j] * sigmoidf_(v[j]);
                    }
                    if (rot) {
                        const f32x4 c0 = *(const f32x4*)(cosT + (size_t)row * 8), c1 = *(const f32x4*)(cosT + (size_t)row * 8 + 4);
                        const f32x4 s0 = *(const f32x4*)(sinT + (size_t)row * 8), s1 = *(const f32x4*)(sinT + (size_t)row * 8 + 4);
#pragma unroll
                        for (int j = 0; j < 8; ++j) { const float p = lane_xor<16>(v[j]); const float cj = j < 4 ? c0[j & 3] : c1[j & 3], sj = j < 4 ? s0[j & 3] : s1[j & 3];
                            const float r = fq == 0 ? v[j] * cj - p * sj : v[j] * cj + p * sj; v[j] = fq < 2 ? r : v[j]; }
                    }
                    u32x4 w; w.x = cvtpk(v[0] * sc, v[1] * sc); w.y = cvtpk(v[2] * sc, v[3] * sc); w.z = cvtpk(v[4] * sc, v[5] * sc); w.w = cvtpk(v[6] * sc, v[7] * sc);
                    *(u32x4*)(O + (size_t)row * HSEC + c) = w; } }
    }
};
struct EpiResid {
    static constexpr bool PERM = true, AFTER_DRAIN = false;
    const float* X; bf16_t* O; unsigned char* O8;
    __device__ __forceinline__ void operator()(const pg8::f32x4 (&acc)[2][2][4][2], const pg8::Unit& u, int wr, int wc, int fr, int fq) const {
        const int row0 = u.pm * 256 + wr * 64 + fr, col0 = u.pn * 256 + wc * 32 + 8 * fq;
#pragma unroll
        for (int ai = 0; ai < 2; ++ai)
#pragma unroll
            for (int m = 0; m < 4; ++m) { const size_t off = (size_t)(row0 + ai * 128 + m * 16) * D + col0;
#pragma unroll
                for (int bj = 0; bj < 2; ++bj) { const f32x4 a = *(const f32x4*)(X + off + bj * 128) + acc[ai][bj][m][0], b = *(const f32x4*)(X + off + bj * 128 + 4) + acc[ai][bj][m][1];
                    u32x4 w; w.x = cvtpk(a[0], a[1]); w.y = cvtpk(a[2], a[3]); w.z = cvtpk(b[0], b[1]); w.w = cvtpk(b[2], b[3]); *(u32x4*)(O + off + bj * 128) = w;
                    u32x2 f; f.x = pk4_fp8(a[0], a[1], a[2], a[3]); f.y = pk4_fp8(b[0], b[1], b[2], b[3]); *(u32x2*)(O8 + off + bj * 128) = f; } }
    }
};
struct EpiSwiGlu {
    static constexpr bool PERM = true, AFTER_DRAIN = false;
    unsigned char* O; const float* RS;
    __device__ __forceinline__ void operator()(const pg8::f32x4 (&acc)[2][2][4][2], const pg8::Unit& u, int wr, int wc, int fr, int fq) const {
        const int row0 = u.pm * 256 + wr * 64 + fr, col0 = ((u.pn & 3) * 256 + wc * 32 + 8 * fq) >> 1;
#pragma unroll
        for (int ai = 0; ai < 2; ++ai)
#pragma unroll
            for (int m = 0; m < 4; ++m) { const int row = row0 + ai * 128 + m * 16; const float rs = RS[row] * (1.f / F8_WSCALE); unsigned char* rowp = O + (size_t)row * DEXP + col0;
#pragma unroll
                for (int bj = 0; bj < 2; ++bj) { const f32x4 a = acc[ai][bj][m][0] * rs, b = acc[ai][bj][m][1] * rs;
                    const float h0 = a[0] * sigmoidf_(a[0]) * a[1], h1 = a[2] * sigmoidf_(a[2]) * a[3], h2 = b[0] * sigmoidf_(b[0]) * b[1], h3 = b[2] * sigmoidf_(b[2]) * b[3];
                    *(unsigned*)(rowp + bj * 64) = pk4_fp8(__builtin_amdgcn_fmed3f(h0 * F8_HSCALE, -448.f, 448.f), __builtin_amdgcn_fmed3f(h1 * F8_HSCALE, -448.f, 448.f), __builtin_amdgcn_fmed3f(h2 * F8_HSCALE, -448.f, 448.f), __builtin_amdgcn_fmed3f(h3 * F8_HSCALE, -448.f, 448.f)); } }
    }
};
struct EpiDown {
    static constexpr bool PERM = true, AFTER_DRAIN = false;
    bf16_t* O;
    __device__ __forceinline__ void operator()(const pg8::f32x4 (&acc)[2][2][4][2], const pg8::Unit& u, int wr, int wc, int fr, int fq) const {
        const int row0 = u.pm * 256 + wr * 64 + fr, col0 = (u.pn & 3) * 256 + wc * 32 + 8 * fq; constexpr float us = 1.f / (F8_WSCALE * F8_HSCALE);
#pragma unroll
        for (int ai = 0; ai < 2; ++ai)
#pragma unroll
            for (int m = 0; m < 4; ++m) { bf16_t* rowp = O + (size_t)(row0 + ai * 128 + m * 16) * D + col0;
#pragma unroll
                for (int bj = 0; bj < 2; ++bj) { const f32x4 a = acc[ai][bj][m][0] * us, b = acc[ai][bj][m][1] * us;
                    u32x4 w; w.x = cvtpk(a[0], a[1]); w.y = cvtpk(a[2], a[3]); w.z = cvtpk(b[0], b[1]); w.w = cvtpk(b[2], b[3]); *(u32x4*)(rowp + bj * 128) = w; } }
    }
};
struct MoeOrder {
    const volatile LAS int* tb; int G, c; const int* PERM; unsigned* ready; int mode;
    __device__ __forceinline__ bool decode(int L, pg8::Unit& u) const {
        const int x = c & 7; int base = 0;
#pragma unroll 1
        for (int k = 0; k < 4; ++k) { const int e = 4 * x + k, t0 = __builtin_amdgcn_readfirstlane(tb[e]), nt = __builtin_amdgcn_readfirstlane(tb[e + 1]) - t0;
            if (L < base + 4 * nt) { const int idx = L - base; u.pm = t0 + idx % nt; u.pn = e * 4 + idx / nt; return true; }
            base += 4 * nt; }
        return false;
    }
    __device__ __forceinline__ bool next(int i, pg8::Unit& u) const {
        if ((G & 7) == 0) {
            const int x = c & 7, s = c >> 3, nb = G >> 3;
            const int U = 4 * (__builtin_amdgcn_readfirstlane(tb[4 * x + 4]) - __builtin_amdgcn_readfirstlane(tb[4 * x]));
            if (mode == 0) return decode(i * nb + s, u);
            const int i0 = s < U ? (U - s + nb - 1) / nb : 0;
            return decode((i0 + i) * nb + s - U, u);
        }
        const int L = i * G + c, T = __builtin_amdgcn_readfirstlane(tb[32]); if (L >= 4 * T) return false;
        const int tile = L >> 2; int e = 0;
#pragma unroll 1
        for (int j = 1; j < 32; ++j) e += (__builtin_amdgcn_readfirstlane(tb[j]) <= tile) ? 1 : 0;
        u.pm = tile; u.pn = e * 4 + (L & 3); return true;
    }
    __device__ __forceinline__ int row_tok(const pg8::Unit& u, int r) const {
        const int e = u.pn >> 2, rem = __builtin_amdgcn_readfirstlane(tb[64 + e]) - (u.pm - __builtin_amdgcn_readfirstlane(tb[e])) * 256;
        return r < rem ? PERM[u.pm * 256 + r] : 0;
    }
    __device__ __forceinline__ bool half_only(const pg8::Unit&) const { return false; }
    __device__ __forceinline__ void done(const pg8::Unit& u) const {
        if (mode == 2) { asm volatile("s_waitcnt vmcnt(0)" ::: "memory");
            if ((threadIdx.x & 63) == 0) __hip_atomic_fetch_add(ready + 64 * u.pm, 1u, __ATOMIC_RELAXED, __HIP_MEMORY_SCOPE_AGENT); }
    }
    __device__ __forceinline__ void a_ready(const pg8::Unit& u) const {
        if (mode == 1) {
            if (threadIdx.x < 64) { const unsigned long long t0 = __builtin_amdgcn_s_memrealtime();
                while ((unsigned)__builtin_amdgcn_readfirstlane(__hip_atomic_load(ready + 64 * u.pm, __ATOMIC_RELAXED, __HIP_MEMORY_SCOPE_AGENT)) < 32u) {
                    if (__builtin_amdgcn_s_memrealtime() - t0 > 2000000ull) break;
                    __builtin_amdgcn_s_sleep(2); }
                __builtin_amdgcn_fence(__ATOMIC_ACQUIRE, "agent");
                asm volatile("s_waitcnt vmcnt(0)" ::: "memory"); }
            asm volatile("" ::: "memory"); __builtin_amdgcn_s_barrier(); asm volatile("" ::: "memory");
        }
    }
};
namespace pg8 {
template <class Epi, class Sched, bool ALIGN_EPI = false, bool SP2 = false, bool F8 = false>
__device__ __forceinline__ void gemm_phase_g(PG8_LAS unsigned char* lds, const Gemm g, const Sched& S, const Epi& E) {
    const int tid = opaque_tid(), wid = __builtin_amdgcn_readfirstlane(tid >> 6), lane = tid & 63, wr = wid >> 2, wc = wid & 3, fr = lane & 15, fq = lane >> 4;
    const int K = g.K, nt = K / BK;
    unsigned voffB[2]; int rowA[2]; unsigned colA[2];
#pragma unroll
    for (int i = 0; i < 2; ++i) { int R, C; stage_rc(tid * 16 + i * 8192, R, C); const int Rb = Epi::PERM ? ((R & ~31) + perm32(R & 31)) : R;
        rowA[i] = R; colA[i] = (unsigned)C * 2u; voffB[i] = (unsigned)(Rb * K + C) * 2u; }
    unsigned vAc[2][2], vAn[2][2];
#define PG8_GATHER(dst, u) do { _Pragma("unroll") for (int h_ = 0; h_ < 2; ++h_) _Pragma("unroll") for (int i_ = 0; i_ < 2; ++i_) dst[h_][i_] = (unsigned)S.row_tok(u, h_ * HALF + rowA[i_]) * (unsigned)(K * 2) + colA[i_]; } while (0)
    const size_t kstep = (size_t)(BK * 2);
    const size_t hstep = (size_t)HALF * K * 2;
    const size_t tstep = 2 * hstep;
    const unsigned ldsw = (unsigned)wid * 1024u;
    const int aoff = lds_byte(wr * 64 + fr, fq * 8), boff = lds_byte(wc * 32 + fr, fq * 8);
#define PG8_SA(b, h) (((b) * 2 + (h)) * HTB)
#define PG8_SB(b, h) ((4 + (b) * 2 + (h)) * HTB)
#define PG8_STAGE(bufoff, gbase, voff) do { _Pragma("unroll") for (int _i = 0; _i < 2; ++_i) \
        __builtin_amdgcn_global_load_lds((const unsigned*)((const char*)(gbase) + (voff)[_i]), (PG8_LAS unsigned*)(lds + (bufoff) + ldsw + _i * 8192), 16, 0, 0); } while (0)
#define PG8_LDA(dst, b, h) do { _Pragma("unroll") for (int m = 0; m < 4; ++m) _Pragma("unroll") for (int k = 0; k < 2; ++k) dst[m][k] = *(const PG8_LAS bf16x8*)(lds + PG8_SA(b, h) + aoff + m * 2048 + k * 1024); } while (0)
#define PG8_LDB(dst, b, h) do { _Pragma("unroll") for (int n = 0; n < 2; ++n) _Pragma("unroll") for (int k = 0; k < 2; ++k) dst[n][k] = *(const PG8_LAS bf16x8*)(lds + PG8_SB(b, h) + boff + n * 2048 + k * 1024); } while (0)
#define PG8_MMA(ai, bj, At, Bt) do { __builtin_amdgcn_s_setprio(1); _Pragma("unroll") for (int m = 0; m < 4; ++m) _Pragma("unroll") for (int n = 0; n < 2; ++n) _Pragma("unroll") for (int k = 0; k < 2; ++k) { \
        if constexpr (F8) { typedef long v2l_ __attribute__((ext_vector_type(2))); const v2l_ b_ = __builtin_bit_cast(v2l_, Bt[n][k]), a_ = __builtin_bit_cast(v2l_, At[m][k]); \
            acc[ai][bj][m][n] = __builtin_amdgcn_mfma_f32_16x16x32_fp8_fp8(b_[0], a_[0], acc[ai][bj][m][n], 0, 0, 0); acc[ai][bj][m][n] = __builtin_amdgcn_mfma_f32_16x16x32_fp8_fp8(b_[1], a_[1], acc[ai][bj][m][n], 0, 0, 0); } \
        else acc[ai][bj][m][n] = __builtin_amdgcn_mfma_f32_16x16x32_bf16(Bt[n][k], At[m][k], acc[ai][bj][m][n], 0, 0, 0); } \
        __builtin_amdgcn_s_setprio(0); } while (0)
#define PG8_WAIT_V(n) asm volatile("s_waitcnt vmcnt(" #n ")" ::: "memory")
#define PG8_WAIT_L(n) asm volatile("s_waitcnt lgkmcnt(" #n ")" ::: "memory")
#define PG8_BAR __builtin_amdgcn_s_barrier()
#define PG8_SCHED __builtin_amdgcn_sched_barrier(0)
    Unit cur, nxt; int ui = 0;
    if (!S.next(0, cur)) return;
    f32x4 acc[2][2][4][2];
#pragma unroll
    for (int a = 0; a < 2; ++a)
#pragma unroll
        for (int b = 0; b < 2; ++b)
#pragma unroll
            for (int m = 0; m < 4; ++m)
#pragma unroll
                for (int n = 0; n < 2; ++n) acc[a][b][m][n] = (f32x4){0.f, 0.f, 0.f, 0.f};
    bf16x8 At[4][2], B0[2][2], B1[2][2];
    const char* cA = (const char*)g.A; PG8_GATHER(vAc, cur); const char* cB = (const char*)g.Bt + (size_t)cur.pn * tstep;
    S.a_ready(cur);
    if constexpr (SP2) {
        PG8_STAGE(PG8_SB(0, 0), cB, voffB); PG8_STAGE(PG8_SB(0, 1), cB + hstep, voffB); PG8_STAGE(PG8_SA(0, 0), cA, vAc[0]); PG8_STAGE(PG8_SA(0, 1), cA, vAc[1]);
        if (wr == 1) PG8_BAR;
        PG8_WAIT_V(2); PG8_BAR;
        PG8_STAGE(PG8_SB(1, 0), cB + kstep, voffB); PG8_STAGE(PG8_SA(1, 0), cA + kstep, vAc[0]); PG8_STAGE(PG8_SB(1, 1), cB + hstep + kstep, voffB);
        PG8_WAIT_V(6); PG8_BAR;
    } else {
        PG8_STAGE(PG8_SB(0, 0), cB, voffB); PG8_STAGE(PG8_SA(0, 0), cA, vAc[0]); PG8_STAGE(PG8_SB(0, 1), cB + hstep, voffB); PG8_STAGE(PG8_SA(0, 1), cA, vAc[1]);
        if (wr == 1) PG8_BAR;
        PG8_WAIT_V(4); PG8_BAR;
        PG8_STAGE(PG8_SB(1, 0), cB + kstep, voffB); PG8_STAGE(PG8_SA(1, 0), cA + kstep, vAc[0]); PG8_STAGE(PG8_SB(1, 1), cB + hstep + kstep, voffB);
        PG8_WAIT_V(6); PG8_BAR;
    }
    for (;;) {
        const bool has_next = S.next(ui + 1, nxt);
        const char* nA = cA; if (has_next) PG8_GATHER(vAn, nxt); else { _Pragma("unroll") for (int h_ = 0; h_ < 2; ++h_) _Pragma("unroll") for (int i_ = 0; i_ < 2; ++i_) vAn[h_][i_] = vAc[h_][i_]; } const char* nB = has_next ? (const char*)g.Bt + (size_t)nxt.pn * tstep : cB;
        for (int t = 0; t < nt; t += 2) {
            const bool last = (t == nt - 2);
            const char* a1 = cA + (size_t)(t + 1) * kstep;
            const char* a2 = last ? nA : cA + (size_t)(t + 2) * kstep; const char* b2 = last ? nB : cB + (size_t)(t + 2) * kstep;
            const char* a3 = a2 + kstep; const char* b3 = b2 + kstep;
            unsigned vA2[2][2]; _Pragma("unroll") for (int h_ = 0; h_ < 2; ++h_) _Pragma("unroll") for (int i_ = 0; i_ < 2; ++i_) vA2[h_][i_] = last ? vAn[h_][i_] : vAc[h_][i_];
            if (last && has_next) S.a_ready(nxt);
            if constexpr (SP2) {
            PG8_LDB(B0, 0, 0); PG8_LDB(B1, 0, 1); PG8_SCHED; PG8_LDA(At, 0, 0); PG8_STAGE(PG8_SA(1, 1), a1, vAc[1]);
            PG8_WAIT_V(8); PG8_WAIT_L(0); PG8_BAR; PG8_MMA(0, 0, At, B0); PG8_MMA(0, 1, At, B1); PG8_BAR; PG8_SCHED;
            PG8_LDA(At, 0, 1); PG8_STAGE(PG8_SB(0, 0), b2, voffB); PG8_STAGE(PG8_SB(0, 1), b2 + hstep, voffB); PG8_STAGE(PG8_SA(0, 0), a2, vA2[0]);
            PG8_WAIT_V(8); PG8_WAIT_L(0); PG8_BAR; PG8_MMA(1, 0, At, B0); PG8_MMA(1, 1, At, B1); PG8_BAR; PG8_SCHED;
            PG8_LDB(B0, 1, 0); PG8_LDB(B1, 1, 1); PG8_SCHED; PG8_LDA(At, 1, 0); PG8_STAGE(PG8_SA(0, 1), a2, vA2[1]);
            PG8_WAIT_V(8); PG8_WAIT_L(0); PG8_BAR; PG8_MMA(0, 0, At, B0); PG8_MMA(0, 1, At, B1); PG8_BAR; PG8_SCHED;
            PG8_LDA(At, 1, 1); PG8_STAGE(PG8_SB(1, 0), b3, voffB); PG8_STAGE(PG8_SB(1, 1), b3 + hstep, voffB); PG8_STAGE(PG8_SA(1, 0), a3, vA2[0]);
            PG8_WAIT_V(8); PG8_WAIT_L(0); PG8_BAR; PG8_MMA(1, 0, At, B0); PG8_MMA(1, 1, At, B1); PG8_BAR; PG8_SCHED;
            } else {
            PG8_LDB(B0, 0, 0); PG8_SCHED; PG8_LDA(At, 0, 0); PG8_STAGE(PG8_SA(1, 1), a1, vAc[1]);
            PG8_WAIT_L(8); PG8_BAR; PG8_WAIT_L(0); PG8_MMA(0, 0, At, B0); PG8_BAR; PG8_SCHED;
            PG8_LDB(B1, 0, 1); PG8_STAGE(PG8_SB(0, 0), b2, voffB);
            PG8_BAR; PG8_WAIT_L(0); PG8_MMA(0, 1, At, B1); PG8_BAR;
            PG8_LDA(At, 0, 1); PG8_STAGE(PG8_SA(0, 0), a2, vA2[0]);
            PG8_BAR; PG8_WAIT_L(0); PG8_MMA(1, 0, At, B0); PG8_BAR; PG8_SCHED;
            PG8_STAGE(PG8_SB(0, 1), b2 + hstep, voffB);
            PG8_WAIT_V(6); PG8_BAR; PG8_MMA(1, 1, At, B1); PG8_BAR;
            PG8_LDB(B0, 1, 0); PG8_SCHED; PG8_LDA(At, 1, 0); PG8_STAGE(PG8_SA(0, 1), a2, vA2[1]);
            PG8_WAIT_L(8); PG8_BAR; PG8_WAIT_L(0); PG8_MMA(0, 0, At, B0); PG8_BAR; PG8_SCHED;
            PG8_LDB(B1, 1, 1); PG8_STAGE(PG8_SB(1, 0), b3, voffB);
            PG8_BAR; PG8_WAIT_L(0); PG8_MMA(0, 1, At, B1); PG8_BAR;
            PG8_LDA(At, 1, 1); PG8_STAGE(PG8_SA(1, 0), a3, vA2[0]);
            PG8_BAR; PG8_WAIT_L(0); PG8_MMA(1, 0, At, B0); PG8_BAR; PG8_SCHED;
            PG8_STAGE(PG8_SB(1, 1), b3 + hstep, voffB);
            PG8_WAIT_V(6); PG8_BAR; PG8_MMA(1, 1, At, B1); PG8_BAR;
            }
        }
        if constexpr (ALIGN_EPI) { if (wr == 0) PG8_BAR; }
        if constexpr (!Epi::AFTER_DRAIN) { E(acc, cur, wr, wc, fr, fq); S.done(cur); }
        if (!has_next) break;
#pragma unroll
        for (int a = 0; a < 2; ++a)
#pragma unroll
            for (int b = 0; b < 2; ++b)
#pragma unroll
                for (int m = 0; m < 4; ++m)
#pragma unroll
                    for (int n = 0; n < 2; ++n) acc[a][b][m][n] = (f32x4){0.f, 0.f, 0.f, 0.f};
        cur = nxt; cA = nA; cB = nB; ++ui; _Pragma("unroll") for (int h_ = 0; h_ < 2; ++h_) _Pragma("unroll") for (int i_ = 0; i_ < 2; ++i_) vAc[h_][i_] = vAn[h_][i_];
        if constexpr (ALIGN_EPI) { if (wr == 1) PG8_BAR; }
    }
    PG8_WAIT_V(0);
    if constexpr (!ALIGN_EPI) { if (wr == 0) PG8_BAR; }
    PG8_BAR;
    if constexpr (Epi::AFTER_DRAIN) { E.fused(acc, cur, wr, wc, fr, fq, lds, wid, lane); S.done(cur); }
#undef PG8_GATHER
#undef PG8_SA
#undef PG8_SB
#undef PG8_STAGE
#undef PG8_LDA
#undef PG8_LDB
#undef PG8_MMA
#undef PG8_WAIT_V
#undef PG8_WAIT_L
#undef PG8_BAR
#undef PG8_SCHED
}
}

namespace hg {
typedef short v4i16_t __attribute__((ext_vector_type(4)));
constexpr int S128 = 272, S64 = 144;
constexpr int L_QD = 0, L_QE = L_QD + 64 * S128, L_KE = L_QE + 64 * S128, L_VR = L_KE + 64 * S128, L_ST = L_VR + 64 * S128,
              L_P = L_ST + 128 * S128, L_QS = L_P + 64 * S64, L_DC = L_QS + 16 * 128 * 4, L_END = L_DC + 128 * 4;
static_assert(L_END <= PHASE_LDS, "hgrn LDS");
__device__ __forceinline__ bf16x8 frag(const LAS unsigned char* base, int row, int stride, int kb  ) { return *(const LAS bf16x8*)(base + row * stride + kb); }
__device__ __forceinline__ bf16x8 trfrag(const LAS unsigned char* tile, int tok0, int chan0, int lane) {
    const LAS unsigned char* p = tile + (tok0 + 8 * (lane >> 5) + ((lane & 15) >> 2)) * S128 + (chan0 + 16 * ((lane >> 4) & 1) + 4 * (lane & 3)) * 2;
    const s16x4 lo = __builtin_bit_cast(s16x4, __builtin_amdgcn_ds_read_tr16_b64_v4i16((LAS v4i16_t*)p)), hi = __builtin_bit_cast(s16x4, __builtin_amdgcn_ds_read_tr16_b64_v4i16((LAS v4i16_t*)(p + 4 * S128)));
    return (bf16x8){lo[0], lo[1], lo[2], lo[3], hi[0], hi[1], hi[2], hi[3]};
}

template <bool PASS_C, int ABL = 0>
__device__ __forceinline__ void pass(LAS unsigned char* lds, int unit, const bf16_t* QH, const bf16_t* VH, const half_t* GF, const half_t* GB,
                                     float* HL, float* HD, const float* HS, float* OF, float* OB) {
    typedef _Float16 h4 __attribute__((ext_vector_type(4)));
    const int tid = opaque_tid(), lane = tid & 63, wid = __builtin_amdgcn_readfirstlane(tid >> 6), r32 = lane & 31, hi = lane >> 5;
    const int dir = unit >> 7, head = (unit >> 5) & 3, sc = unit & 31;
    const int kq = tid & 31, tq = tid >> 5;
    const half_t* G = dir ? GB : GF; float* O = dir ? OB : OF;
    const int vi = wid >> 1, ki0 = (wid & 1) * 2;
    f32x16 sacc[2];
    LAS f32x4* QS = (LAS f32x4*)(lds + L_QS); LAS float* DC = (LAS float*)(lds + L_DC);
    if (PASS_C) {
        const float* hs = HS + (size_t)unit * 16384;
#pragma unroll
        for (int tt = 0; tt < 2; ++tt)
#pragma unroll
            for (int r = 0; r < 16; r += 2) { const int v = vi * 32 + crow(r, hi), kk = (ki0 + tt) * 32 + r32; const float s0 = hs[v * 128 + kk], s1 = hs[(v + 1) * 128 + kk]; sacc[tt][r] = s0; sacc[tt][r + 1] = s1;
                const unsigned w = cvtpk(s0, s1); *(LAS bf16_t*)(lds + L_ST + v * S128 + kk * 2) = (bf16_t)(w & 0xffffu); *(LAS bf16_t*)(lds + L_ST + (v + 1) * S128 + kk * 2) = (bf16_t)(w >> 16); }
    } else { sacc[0] = f32x16{}; sacc[1] = f32x16{}; }
    f32x4 btot = {1.f, 1.f, 1.f, 1.f};
    h4 gh[4]; u32x2 qv[4], vv[4];
#define HG_LOAD(c_) do { const int tb_ = sc * 512 + (c_) * 64 + 4 * tq; _Pragma("unroll") for (int i = 0; i < 4; ++i) { const int tl = tb_ + i, tok = dir ? (M - 1 - tl) : tl; \
        const size_t off = (size_t)tok * HSEC + head * 128 + 4 * kq; gh[i] = *(const h4*)(G + off); vv[i] = *(const u32x2*)(VH + off); if (PASS_C) qv[i] = *(const u32x2*)(QH + off); } } while (0)
    HG_LOAD(0);
#pragma unroll 1
    for (int c = 0; c < 8; ++c) {
        const int t0 = sc * 512 + c * 64;
        f32x4 g[4], b[4];
#pragma unroll
        for (int i = 0; i < 4; ++i) { g[i] = (f32x4){(float)gh[i][0], (float)gh[i][1], (float)gh[i][2], (float)gh[i][3]}; b[i] = i ? b[i - 1] * g[i] : g[i]; }
        QS[tq * 32 + kq] = b[3];
        LDS_WAIT(); __syncthreads();
        if (tid < 128) { LAS float* qs = (LAS float*)QS; float run = 1.f;
#pragma unroll
            for (int q = 0; q < 16; ++q) { const float t = qs[q * 128 + tid]; qs[q * 128 + tid] = run; run *= t; }
            DC[tid] = run; }
        LDS_WAIT(); __syncthreads();
        const f32x4 pre = QS[tq * 32 + kq], etot = *(const LAS f32x4*)(DC + 4 * kq);
        btot *= etot;
        f32x4 itot; itot[0] = __builtin_amdgcn_rcpf(etot[0]); itot[1] = __builtin_amdgcn_rcpf(etot[1]); itot[2] = __builtin_amdgcn_rcpf(etot[2]); itot[3] = __builtin_amdgcn_rcpf(etot[3]);
#pragma unroll
        for (int i = 0; i < 4; ++i) { const int tr = 4 * tq + i; float ke[4], qd[4], qe[4];
            const float q4[4] = {bflo(qv[i].x), bfhi(qv[i].x), bflo(qv[i].y), bfhi(qv[i].y)};
#pragma unroll
            for (int cc = 0; cc < 4; ++cc) { const float pb = b[i][cc] * pre[cc];
                ke[cc] = (1.f - g[i][cc]) * etot[cc] * __builtin_amdgcn_rcpf(pb);
                if (PASS_C) { qd[cc] = q4[cc] * pb; qe[cc] = qd[cc] * itot[cc]; } }
            *(LAS u32x2*)(lds + L_KE + tr * S128 + kq * 8) = (u32x2){cvtpk(ke[0], ke[1]), cvtpk(ke[2], ke[3])};
            *(LAS u32x2*)(lds + L_VR + tr * S128 + kq * 8) = vv[i];
            if (PASS_C) { *(LAS u32x2*)(lds + L_QD + tr * S128 + kq * 8) = (u32x2){cvtpk(qd[0], qd[1]), cvtpk(qd[2], qd[3])};
                *(LAS u32x2*)(lds + L_QE + tr * S128 + kq * 8) = (u32x2){cvtpk(qe[0], qe[1]), cvtpk(qe[2], qe[3])}; } }
        LDS_WAIT(); __syncthreads();
        if (c < 7 && !(ABL & 2)) HG_LOAD(c + 1);
        if (PASS_C && !(ABL & 4)) {
            if (wid < 4) {
                const int ti = wid >> 1, si = wid & 1; f32x16 p = f32x16{};
                if (!(ti == 0 && si == 1)) {
#pragma unroll
                    for (int ks = 0; ks < 8; ++ks) p = __builtin_amdgcn_mfma_f32_32x32x16_bf16(frag(lds + L_QE, ti * 32 + r32, S128, ks * 32 + hi * 16), frag(lds + L_KE, si * 32 + r32, S128, ks * 32 + hi * 16), p, 0, 0, 0);
                }
#pragma unroll
                for (int r = 0; r < 16; r += 2) { const int t = ti * 32 + crow(r, hi), s = si * 32 + r32; const unsigned w = cvtpk(s <= t ? p[r] : 0.f, s <= t + 1 ? p[r + 1] : 0.f);
                    *(LAS bf16_t*)(lds + L_P + t * S64 + s * 2) = (bf16_t)(w & 0xffffu); *(LAS bf16_t*)(lds + L_P + (t + 1) * S64 + s * 2) = (bf16_t)(w >> 16); }
            }
            LDS_WAIT(); __syncthreads();
            { const int ti = wid >> 2, vo = wid & 3; f32x16 o = f32x16{};
#pragma unroll
                for (int ks = 0; ks < 8; ++ks) o = __builtin_amdgcn_mfma_f32_32x32x16_bf16(frag(lds + L_QD, ti * 32 + r32, S128, ks * 32 + hi * 16), frag(lds + L_ST, vo * 32 + r32, S128, ks * 32 + hi * 16), o, 0, 0, 0);
#pragma unroll
                for (int ss = 0; ss < 4; ++ss) o = __builtin_amdgcn_mfma_f32_32x32x16_bf16(frag(lds + L_P, ti * 32 + r32, S64, ss * 32 + hi * 16), trfrag(lds + L_VR, ss * 16, vo * 32, lane), o, 0, 0, 0);
#pragma unroll
                for (int r = 0; r < 16; ++r) { const int tl = t0 + ti * 32 + crow(r, hi), tok = dir ? (M - 1 - tl) : tl; if (!(ABL & 1)) O[(size_t)tok * HSEC + head * 128 + vo * 32 + r32] = o[r]; else asm volatile("" :: "v"(o[r])); }
            }
        }
#pragma unroll
        for (int tt = 0; tt < ((ABL & 4) ? 0 : 2); ++tt) { const int ki = ki0 + tt; const float d = DC[ki * 32 + r32];
#pragma unroll
            for (int r = 0; r < 16; ++r) sacc[tt][r] *= d;
#pragma unroll
            for (int ss = 0; ss < 4; ++ss) sacc[tt] = __builtin_amdgcn_mfma_f32_32x32x16_bf16(trfrag(lds + L_VR, ss * 16, vi * 32, lane), trfrag(lds + L_KE, ss * 16, ki * 32, lane), sacc[tt], 0, 0, 0);
        }
        LDS_WAIT(); __syncthreads();
        if (PASS_C) {
#pragma unroll
            for (int tt = 0; tt < 2; ++tt)
#pragma unroll
                for (int r = 0; r < 16; r += 2) { const int v = vi * 32 + crow(r, hi), kk = (ki0 + tt) * 32 + r32; const unsigned w = cvtpk(sacc[tt][r], sacc[tt][r + 1]);
                    *(LAS bf16_t*)(lds + L_ST + v * S128 + kk * 2) = (bf16_t)(w & 0xffffu); *(LAS bf16_t*)(lds + L_ST + (v + 1) * S128 + kk * 2) = (bf16_t)(w >> 16); }
        }
    }
#undef HG_LOAD
    if (!PASS_C) {
        float* hl = HL + (size_t)unit * 16384;
#pragma unroll
        for (int tt = 0; tt < 2; ++tt)
#pragma unroll
            for (int r = 0; r < 16; ++r) { const int v = vi * 32 + crow(r, hi), kk = (ki0 + tt) * 32 + r32; hl[v * 128 + kk] = sacc[tt][r]; }
        if (tq == 0) *(f32x4*)(HD + unit * 128 + 4 * kq) = btot;
    }
    __syncthreads();
}
__device__ __forceinline__ void scan(const float* HL, const float* HD, float* HS, int gtid, int gthreads) {
    for (int id = gtid; id < 8 * 16384; id += gthreads) {
        const int dh = id >> 14, e = id & 16383, k = e & 127; float S = 0.f;
        float hl[32], hd[32];
#pragma unroll
        for (int sc = 0; sc < 32; ++sc) { const int u = dh * 32 + sc; hl[sc] = HL[(size_t)u * 16384 + e]; hd[sc] = HD[u * 128 + k]; }
#pragma unroll
        for (int sc = 0; sc < 32; ++sc) { const int u = dh * 32 + sc; HS[(size_t)u * 16384 + e] = S; S = hd[sc] * S + hl[sc]; }
    }
}
}

namespace att {
__device__ __forceinline__ void hgrn_finalize(int h, int q0, const float* OF, const float* OB, const bf16_t* SG, const float* gain, bf16_t* MIX, int wid, int lane) {
    const float g0 = gain[2 * lane], g1 = gain[2 * lane + 1];
#pragma unroll 1
    for (int i0 = 0; i0 < 32; i0 += 4) { float2 a[4], b[4]; unsigned sg[4]; float x0[4], x1[4], ss[4];
#pragma unroll
        for (int i = 0; i < 4; ++i) { const size_t off = (size_t)(q0 + wid * 32 + i0 + i) * HSEC + h * 128 + 2 * lane; a[i] = *(const float2*)(OF + off); b[i] = *(const float2*)(OB + off); sg[i] = *(const unsigned*)(SG + off); }
#pragma unroll
        for (int i = 0; i < 4; ++i) { x0[i] = a[i].x + b[i].x; x1[i] = a[i].y + b[i].y; ss[i] = x0[i] * x0[i] + x1[i] * x1[i]; }
#pragma unroll
        for (int i = 0; i < 4; ++i) ss[i] = wave_sum(ss[i]);
#pragma unroll
        for (int i = 0; i < 4; ++i) { const float rstd = 1.f / sqrtf(ss[i] * (1.f / 128.f) + 1e-6f);
            *(unsigned*)(MIX + (size_t)(q0 + wid * 32 + i0 + i) * D + h * 128 + 2 * lane) = cvtpk(x0[i] * rstd * g0 * bflo(sg[i]), x1[i] * rstd * g1 * bfhi(sg[i])); } }
}
}

namespace att2 {
typedef short v4i16_t __attribute__((ext_vector_type(4)));
constexpr int KVBLK = 64, LDR = HSEC, NT = M / KVBLK;
constexpr int KSLOT = 8192, VSLOT = 16384, NSLOT = 4;
constexpr int OFF_K = 0, OFF_V = NSLOT * KSLOT, OFF_WS = OFF_V + NSLOT * VSLOT, OFF_END = OFF_WS + NWAVES * 64 * 4;
static_assert(OFF_END <= PHASE_LDS, "attention LDS");
__device__ __forceinline__ s16x4 vtr(const LAS unsigned char* p) { return __builtin_bit_cast(s16x4, __builtin_amdgcn_ds_read_tr16_b64_v4i16((LAS v4i16_t*)p)); }
__device__ __forceinline__ void glds16(const void* sbase, unsigned voff, unsigned lds_dst) { unsigned keep;
    asm volatile("s_mov_b32 %0, m0\n\ts_mov_b32 m0, %3\n\ts_nop 0\n\tglobal_load_lds_dwordx4 %1, %2\n\ts_mov_b32 m0, %0" : "=&s"(keep) : "v"(voff), "s"(sbase), "s"(lds_dst) : "memory"); }
#define ATT2_WAIT_BAR(N) asm volatile("s_waitcnt vmcnt(" #N ") lgkmcnt(0)\n\ts_barrier" ::: "memory")
template <bool DO_QK, bool DO_SM, bool DO_PV>
__device__ __forceinline__ void step(f32x16& sn0, f32x16& sn1, f32x16& sc0, f32x16& sc1, const u32x4& pap0, const u32x4& pap1, const u32x4& pap2, const u32x4& pap3,
                                     u32x4& pan0, u32x4& pan1, u32x4& pan2, u32x4& pan3, f32x16 (&o)[4], const bf16x8 (&qr)[4], const f32x16& negm, float& lsum,
                                     const LAS unsigned char* kc, const LAS unsigned char* knn, const LAS unsigned char* vb, bf16x8& kf0, bf16x8& kf1, bf16x8& kf2) {
    bf16x8 fr0 = kf0, fr1 = kf1, fr2 = kf2, fr3 = kf0; unsigned ca0 = 0, ca1 = 0, cb0 = 0, cb1 = 0;
    (void)ca0; (void)ca1; (void)cb0; (void)cb1;
    if (DO_QK) sn0 = __builtin_amdgcn_mfma_f32_32x32x16_bf16(fr0, qr[0], negm, 0, 0, 0);
    SBAR();
    if (DO_QK) { fr3 = *(const LAS bf16x8*)(kc + 2560); }
    if (DO_SM) { sc0[0] = ex2(sc0[0]); sc0[1] = ex2(sc0[1]); }
    SBAR();
    if (DO_QK) sn1 = __builtin_amdgcn_mfma_f32_32x32x16_bf16(fr1, qr[0], negm, 0, 0, 0);
    SBAR();
    if (DO_QK) { fr0 = *(const LAS bf16x8*)(kc + 4096); }
    if (DO_SM) { sc0[2] = ex2(sc0[2]); sc0[3] = ex2(sc0[3]); lsum += sc0[0]; lsum += sc0[1]; }
    SBAR();
    if (DO_QK) sn0 = __builtin_amdgcn_mfma_f32_32x32x16_bf16(fr2, qr[1], sn0, 0, 0, 0);
    SBAR();
    if (DO_QK) { fr1 = *(const LAS bf16x8*)(kc + 4608); }
    if (DO_SM) { sc0[4] = ex2(sc0[4]); sc0[5] = ex2(sc0[5]); lsum += sc0[2]; lsum += sc0[3]; }
    SBAR();
    if (DO_QK) sn1 = __builtin_amdgcn_mfma_f32_32x32x16_bf16(fr3, qr[1], sn1, 0, 0, 0);
    SBAR();
    if (DO_QK) { fr2 = *(const LAS bf16x8*)(kc + 6144); }
    if (DO_SM) { sc0[6] = ex2(sc0[6]); sc0[7] = ex2(sc0[7]); lsum += sc0[4]; lsum += sc0[5]; }
    SBAR();
    if (DO_QK) sn0 = __builtin_amdgcn_mfma_f32_32x32x16_bf16(fr0, qr[2], sn0, 0, 0, 0);
    SBAR();
    if (DO_QK) { fr3 = *(const LAS bf16x8*)(kc + 6656); }
    if (DO_SM) { sc0[8] = ex2(sc0[8]); sc0[9] = ex2(sc0[9]); lsum += sc0[6]; lsum += sc0[7]; }
    SBAR();
    if (DO_QK) sn1 = __builtin_amdgcn_mfma_f32_32x32x16_bf16(fr1, qr[2], sn1, 0, 0, 0);
    SBAR();
    if (DO_PV) { { const s16x4 l_ = vtr(vb + 0), h_ = vtr(vb + 256); fr0 = (bf16x8){l_[0], l_[1], l_[2], l_[3], h_[0], h_[1], h_[2], h_[3]}; } }
    if (DO_SM) { sc0[10] = ex2(sc0[10]); sc0[11] = ex2(sc0[11]); lsum += sc0[8]; lsum += sc0[9]; }
    SBAR();
    if (DO_QK) sn0 = __builtin_amdgcn_mfma_f32_32x32x16_bf16(fr2, qr[3], sn0, 0, 0, 0);
    SBAR();
    if (DO_PV) { { const s16x4 l_ = vtr(vb + 4096), h_ = vtr(vb + 4352); fr1 = (bf16x8){l_[0], l_[1], l_[2], l_[3], h_[0], h_[1], h_[2], h_[3]}; } }
    if (DO_SM) { sc0[12] = ex2(sc0[12]); sc0[13] = ex2(sc0[13]); lsum += sc0[10]; lsum += sc0[11]; }
    SBAR();
    if (DO_QK) sn1 = __builtin_amdgcn_mfma_f32_32x32x16_bf16(fr3, qr[3], sn1, 0, 0, 0);
    SBAR();
    if (DO_PV) { { const s16x4 l_ = vtr(vb + 8192), h_ = vtr(vb + 8448); fr2 = (bf16x8){l_[0], l_[1], l_[2], l_[3], h_[0], h_[1], h_[2], h_[3]}; } }
    if (DO_SM) { sc0[14] = ex2(sc0[14]); sc0[15] = ex2(sc0[15]); lsum += sc0[12]; lsum += sc0[13]; }
    SBAR();
    if (DO_PV) o[0] = __builtin_amdgcn_mfma_f32_32x32x16_bf16(__builtin_bit_cast(bf16x8, pap0), fr0, o[0], 0, 0, 0);
    SBAR();
    if (DO_PV) { { const s16x4 l_ = vtr(vb + 12288), h_ = vtr(vb + 12544); fr3 = (bf16x8){l_[0], l_[1], l_[2], l_[3], h_[0], h_[1], h_[2], h_[3]}; } }
    if (DO_SM) { sc1[0] = ex2(sc1[0]); sc1[1] = ex2(sc1[1]); lsum += sc0[14]; lsum += sc0[15]; }
    SBAR();
    if (DO_PV) o[0] = __builtin_amdgcn_mfma_f32_32x32x16_bf16(__builtin_bit_cast(bf16x8, pap1), fr1, o[0], 0, 0, 0);
    SBAR();
    if (DO_PV) { { const s16x4 l_ = vtr(vb + 512), h_ = vtr(vb + 768); fr0 = (bf16x8){l_[0], l_[1], l_[2], l_[3], h_[0], h_[1], h_[2], h_[3]}; } }
    if (DO_SM) { sc1[2] = ex2(sc1[2]); sc1[3] = ex2(sc1[3]); lsum += sc1[0]; lsum += sc1[1]; }
    SBAR();
    if (DO_PV) o[0] = __builtin_amdgcn_mfma_f32_32x32x16_bf16(__builtin_bit_cast(bf16x8, pap2), fr2, o[0], 0, 0, 0);
    SBAR();
    if (DO_PV) { { const s16x4 l_ = vtr(vb + 4608), h_ = vtr(vb + 4864); fr1 = (bf16x8){l_[0], l_[1], l_[2], l_[3], h_[0], h_[1], h_[2], h_[3]}; } }
    if (DO_SM) { sc1[4] = ex2(sc1[4]); sc1[5] = ex2(sc1[5]); lsum += sc1[2]; lsum += sc1[3]; }
    SBAR();
    if (DO_PV) o[0] = __builtin_amdgcn_mfma_f32_32x32x16_bf16(__builtin_bit_cast(bf16x8, pap3), fr3, o[0], 0, 0, 0);
    SBAR();
    if (DO_PV) { { const s16x4 l_ = vtr(vb + 8704), h_ = vtr(vb + 8960); fr2 = (bf16x8){l_[0], l_[1], l_[2], l_[3], h_[0], h_[1], h_[2], h_[3]}; } }
    if (DO_SM) { sc1[6] = ex2(sc1[6]); sc1[7] = ex2(sc1[7]); lsum += sc1[4]; lsum += sc1[5]; }
    SBAR();
    if (DO_PV) o[1] = __builtin_amdgcn_mfma_f32_32x32x16_bf16(__builtin_bit_cast(bf16x8, pap0), fr0, o[1], 0, 0, 0);
    SBAR();
    if (DO_PV) { { const s16x4 l_ = vtr(vb + 12800), h_ = vtr(vb + 13056); fr3 = (bf16x8){l_[0], l_[1], l_[2], l_[3], h_[0], h_[1], h_[2], h_[3]}; } }
    if (DO_SM) { sc1[8] = ex2(sc1[8]); sc1[9] = ex2(sc1[9]); lsum += sc1[6]; lsum += sc1[7]; }
    SBAR();
    if (DO_PV) o[1] = __builtin_amdgcn_mfma_f32_32x32x16_bf16(__builtin_bit_cast(bf16x8, pap1), fr1, o[1], 0, 0, 0);
    SBAR();
    if (DO_PV) { { const s16x4 l_ = vtr(vb + 1024), h_ = vtr(vb + 1280); fr0 = (bf16x8){l_[0], l_[1], l_[2], l_[3], h_[0], h_[1], h_[2], h_[3]}; } }
    if (DO_SM) { sc1[10] = ex2(sc1[10]); sc1[11] = ex2(sc1[11]); lsum += sc1[8]; lsum += sc1[9]; }
    SBAR();
    if (DO_PV) o[1] = __builtin_amdgcn_mfma_f32_32x32x16_bf16(__builtin_bit_cast(bf16x8, pap2), fr2, o[1], 0, 0, 0);
    SBAR();
    if (DO_PV) { { const s16x4 l_ = vtr(vb + 5120), h_ = vtr(vb + 5376); fr1 = (bf16x8){l_[0], l_[1], l_[2], l_[3], h_[0], h_[1], h_[2], h_[3]}; } }
    if (DO_SM) { sc1[12] = ex2(sc1[12]); sc1[13] = ex2(sc1[13]); lsum += sc1[10]; lsum += sc1[11]; }
    SBAR();
    if (DO_PV) o[1] = __builtin_amdgcn_mfma_f32_32x32x16_bf16(__builtin_bit_cast(bf16x8, pap3), fr3, o[1], 0, 0, 0);
    SBAR();
    if (DO_PV) { { const s16x4 l_ = vtr(vb + 9216), h_ = vtr(vb + 9472); fr2 = (bf16x8){l_[0], l_[1], l_[2], l_[3], h_[0], h_[1], h_[2], h_[3]}; } }
    if (DO_SM) { sc1[14] = ex2(sc1[14]); sc1[15] = ex2(sc1[15]); lsum += sc1[12]; lsum += sc1[13]; }
    SBAR();
    if (DO_PV) o[2] = __builtin_amdgcn_mfma_f32_32x32x16_bf16(__builtin_bit_cast(bf16x8, pap0), fr0, o[2], 0, 0, 0);
    SBAR();
    if (DO_PV) { { const s16x4 l_ = vtr(vb + 13312), h_ = vtr(vb + 13568); fr3 = (bf16x8){l_[0], l_[1], l_[2], l_[3], h_[0], h_[1], h_[2], h_[3]}; } }
    if (DO_SM) { lsum += sc1[14]; lsum += sc1[15]; ca0 = cvtpk(sc0[0], sc0[1]); ca1 = cvtpk(sc0[2], sc0[3]); }
    SBAR();
    if (DO_PV) o[2] = __builtin_amdgcn_mfma_f32_32x32x16_bf16(__builtin_bit_cast(bf16x8, pap1), fr1, o[2], 0, 0, 0);
    SBAR();
    if (DO_PV) { { const s16x4 l_ = vtr(vb + 1536), h_ = vtr(vb + 1792); fr0 = (bf16x8){l_[0], l_[1], l_[2], l_[3], h_[0], h_[1], h_[2], h_[3]}; } }
    if (DO_SM) { cb0 = cvtpk(sc0[4], sc0[5]); cb1 = cvtpk(sc0[6], sc0[7]); pan0 = (u32x4){ca0, ca1, cb0, cb1}; }
    SBAR();
    if (DO_PV) o[2] = __builtin_amdgcn_mfma_f32_32x32x16_bf16(__builtin_bit_cast(bf16x8, pap2), fr2, o[2], 0, 0, 0);
    SBAR();
    if (DO_PV) { { const s16x4 l_ = vtr(vb + 5632), h_ = vtr(vb + 5888); fr1 = (bf16x8){l_[0], l_[1], l_[2], l_[3], h_[0], h_[1], h_[2], h_[3]}; } }
    if (DO_SM) { ca0 = cvtpk(sc0[8], sc0[9]); ca1 = cvtpk(sc0[10], sc0[11]); }
    SBAR();
    if (DO_PV) o[2] = __builtin_amdgcn_mfma_f32_32x32x16_bf16(__builtin_bit_cast(bf16x8, pap3), fr3, o[2], 0, 0, 0);
    SBAR();
    if (DO_PV) { { const s16x4 l_ = vtr(vb + 9728), h_ = vtr(vb + 9984); fr2 = (bf16x8){l_[0], l_[1], l_[2], l_[3], h_[0], h_[1], h_[2], h_[3]}; } }
    if (DO_SM) { cb0 = cvtpk(sc0[12], sc0[13]); cb1 = cvtpk(sc0[14], sc0[15]); pan1 = (u32x4){ca0, ca1, cb0, cb1}; }
    SBAR();
    if (DO_PV) o[3] = __builtin_amdgcn_mfma_f32_32x32x16_bf16(__builtin_bit_cast(bf16x8, pap0), fr0, o[3], 0, 0, 0);
    SBAR();
    if (DO_PV) { { const s16x4 l_ = vtr(vb + 13824), h_ = vtr(vb + 14080); fr3 = (bf16x8){l_[0], l_[1], l_[2], l_[3], h_[0], h_[1], h_[2], h_[3]}; } }
    if (DO_SM) { ca0 = cvtpk(sc1[0], sc1[1]); ca1 = cvtpk(sc1[2], sc1[3]); }
    SBAR();
    if (DO_PV) o[3] = __builtin_amdgcn_mfma_f32_32x32x16_bf16(__builtin_bit_cast(bf16x8, pap1), fr1, o[3], 0, 0, 0);
    SBAR();
    kf0 = *(const LAS bf16x8*)(knn + 0);
    if (DO_SM) { cb0 = cvtpk(sc1[4], sc1[5]); cb1 = cvtpk(sc1[6], sc1[7]); pan2 = (u32x4){ca0, ca1, cb0, cb1}; }
    SBAR();
    if (DO_PV) o[3] = __builtin_amdgcn_mfma_f32_32x32x16_bf16(__builtin_bit_cast(bf16x8, pap2), fr2, o[3], 0, 0, 0);
    SBAR();
    kf1 = *(const LAS bf16x8*)(knn + 512);
    if (DO_SM) { ca0 = cvtpk(sc1[8], sc1[9]); ca1 = cvtpk(sc1[10], sc1[11]); }
    SBAR();
    if (DO_PV) o[3] = __builtin_amdgcn_mfma_f32_32x32x16_bf16(__builtin_bit_cast(bf16x8, pap3), fr3, o[3], 0, 0, 0);
    SBAR();
    kf2 = *(const LAS bf16x8*)(knn + 2048);
    if (DO_SM) { cb0 = cvtpk(sc1[12], sc1[13]); cb1 = cvtpk(sc1[14], sc1[15]); pan3 = (u32x4){ca0, ca1, cb0, cb1}; }
    SBAR();
}

__device__ __forceinline__ void unit(LAS unsigned char* lds, int h, int q0, const bf16_t* __restrict__ QD, const bf16_t* __restrict__ KD, const bf16_t* __restrict__ VD,
                                     const unsigned* KMAX2, float* O0S, float lam, const float* __restrict__ subg, bf16_t* MIX) {
    const int tid = opaque_tid(), wid = __builtin_amdgcn_readfirstlane(tid >> 6), lane = tid & 63, r32 = lane & 31, hi = lane >> 5;
    const unsigned lds0 = (unsigned)(uintptr_t)lds;
    LAS float* ws = (LAS float*)(lds + OFF_WS) + wid * 64;
    const LAS unsigned char* kbase = lds + OFF_K + hi * 1024 + r32 * 16;
    const LAS unsigned char* vbase = lds + OFF_V + (((lane & 3) << 3) | (((lane >> 2) & 3) << 6) | (((lane >> 4) & 1) << 5) | (((lane >> 5) & 1) << 11));
    const unsigned voK = (unsigned)((lane * LDR + wid * 8) * 2);
    unsigned voV[2];
    { const int kk = 8 * wid + ((lane & 31) >> 2), key = (kk & ~0xC) | ((kk & 4) << 1) | ((kk & 8) >> 1);
#pragma unroll
      for (int j = 0; j < 2; ++j) voV[j] = (unsigned)((key * LDR + (2 * j + (lane >> 5)) * 32 + (lane & 3) * 8) * 2); }
    const unsigned kdst = lds0 + OFF_K + wid * 1024, vdst = lds0 + OFF_V + wid * 2048;
#pragma unroll 1
    for (int mp = 0; mp < 2; ++mp) {
        const bf16_t* Kh = KD + h * 128 + mp * 64; const bf16_t* Vh = VD + h * 128;
        const bf16_t* Qw = QD + (size_t)(q0 + wid * 32 + r32) * LDR + h * 128 + mp * 64 + hi * 8;
#define ATT2_DMA_K(t) do { const int t_ = (t) < NT ? (t) : NT - 1; glds16((const char*)Kh + (size_t)t_ * (KVBLK * LDR * 2), voK, (unsigned)__builtin_amdgcn_readfirstlane(kdst + ((t) & 3) * KSLOT)); } while (0)
#define ATT2_DMA_V(t) do { const int t_ = (t) < NT ? (t) : NT - 1; const char* vs_ = (const char*)Vh + (size_t)t_ * (KVBLK * LDR * 2); const unsigned vd_ = (unsigned)__builtin_amdgcn_readfirstlane(vdst + ((t) & 3) * VSLOT); \
        glds16(vs_, voV[0], vd_); glds16(vs_, voV[1], vd_ + 1024); } while (0)
        ATT2_DMA_K(0); ATT2_DMA_K(1); ATT2_DMA_K(2); ATT2_DMA_V(0);
        bf16x8 qr[4]; float qq = 0.f;
#pragma unroll
        for (int d0 = 0; d0 < 4; ++d0) { qr[d0] = *reinterpret_cast<const bf16x8*>(Qw + d0 * 16);
#pragma unroll
            for (int j = 0; j < 8; ++j) { const float q = bf2f((unsigned short)qr[d0][j]); qq += q * q; } }
        { auto rr = __builtin_amdgcn_permlane32_swap(__float_as_uint(qq), __float_as_uint(qq), false, false); qq = __uint_as_float(rr[0]) + __uint_as_float(rr[1]); }
        const float mref = sqrtf(qq * __uint_as_float(KMAX2[(h * 2 + mp) * 64])) * 1.001f;
        f32x16 negm;
#pragma unroll
        for (int r = 0; r < 16; ++r) negm[r] = -mref;
        f32x16 o[4] = {}; float lsum = 0.f;
        f32x16 sA0, sA1, sB0, sB1; u32x4 pX0, pX1, pX2, pX3, pY0, pY1, pY2, pY3;
        sA0 = f32x16{}; sA1 = f32x16{}; sB0 = f32x16{}; sB1 = f32x16{}; pX0 = pX1 = pX2 = pX3 = pY0 = pY1 = pY2 = pY3 = (u32x4){0u, 0u, 0u, 0u};
        bf16x8 kf0, kf1, kf2;
        ATT2_WAIT_BAR(0);
        kf0 = *(const LAS bf16x8*)(kbase); kf1 = *(const LAS bf16x8*)(kbase + 512); kf2 = *(const LAS bf16x8*)(kbase + 2048);
#define KS(t) (kbase + ((t) & 3) * KSLOT)
#define VS(t) (vbase + ((t) & 3) * VSLOT)
        ATT2_DMA_K(3); ATT2_DMA_V(1);
        step<true, false, false>(sA0, sA1, sB0, sB1, pX0, pX1, pX2, pX3, pY0, pY1, pY2, pY3, o, qr, negm, lsum, KS(0), KS(1), VS(0), kf0, kf1, kf2);
        ATT2_WAIT_BAR(3);
        ATT2_DMA_K(4); ATT2_DMA_V(2);
        step<true, true, false>(sB0, sB1, sA0, sA1, pY0, pY1, pY2, pY3, pX0, pX1, pX2, pX3, o, qr, negm, lsum, KS(1), KS(2), VS(0), kf0, kf1, kf2);
        ATT2_WAIT_BAR(3);
#pragma unroll 1
        for (int i = 1; i + 1 < NT - 1; i += 2) {
            ATT2_DMA_K(i + 4); ATT2_DMA_V(i + 2);
            step<true, true, true>(sA0, sA1, sB0, sB1, pX0, pX1, pX2, pX3, pY0, pY1, pY2, pY3, o, qr, negm, lsum, KS(i + 1), KS(i + 2), VS(i - 1), kf0, kf1, kf2);
            ATT2_WAIT_BAR(3);
            ATT2_DMA_K(i + 5); ATT2_DMA_V(i + 3);
            step<true, true, true>(sB0, sB1, sA0, sA1, pY0, pY1, pY2, pY3, pX0, pX1, pX2, pX3, o, qr, negm, lsum, KS(i + 2), KS(i + 3), VS(i), kf0, kf1, kf2);
            ATT2_WAIT_BAR(3);
        }
        step<false, true, true>(sA0, sA1, sB0, sB1, pX0, pX1, pX2, pX3, pY0, pY1, pY2, pY3, o, qr, negm, lsum, KS(0), KS(0), VS(NT - 2), kf0, kf1, kf2);
        ATT2_WAIT_BAR(0);
        step<false, false, true>(sB0, sB1, sA0, sA1, pY0, pY1, pY2, pY3, pX0, pX1, pX2, pX3, o, qr, negm, lsum, KS(0), KS(0), VS(NT - 1), kf0, kf1, kf2);
        ATT2_WAIT_BAR(0);
#undef KS
#undef VS
#undef ATT2_DMA_K
#undef ATT2_DMA_V
        { auto rr = __builtin_amdgcn_permlane32_swap(__float_as_uint(lsum), __float_as_uint(lsum), false, false); lsum = __uint_as_float(rr[0]) + __uint_as_float(rr[1]); }
        if (hi == 0) ws[r32] = lsum; asm volatile("s_waitcnt lgkmcnt(0)" ::: "memory");
        int rowb = q0 + wid * 32; asm volatile("" : "+s"(rowb));
        float rli[16];
#pragma unroll
        for (int r = 0; r < 16; ++r) rli[r] = __builtin_amdgcn_rcpf(ws[crow(r, hi)]);
        float* o0p = O0S + tid; asm volatile("" : "+v"(o0p));
        if (mp == 0) {
#pragma unroll
            for (int d0 = 0; d0 < 4; ++d0)
#pragma unroll
                for (int r = 0; r < 16; ++r) o0p[(d0 * 16 + r) * 512] = o[d0][r] * rli[r];
        } else {
            float ss[16];
#pragma unroll
            for (int r = 0; r < 16; ++r) ss[r] = 0.f;
#pragma unroll
            for (int d0 = 0; d0 < 4; ++d0)
#pragma unroll
                for (int r = 0; r < 16; ++r) { const float c = o0p[(d0 * 16 + r) * 512] - lam * o[d0][r] * rli[r]; o[d0][r] = c; ss[r] += c * c; }
#pragma unroll
            for (int r = 0; r < 16; ++r) {
                ss[r] += lane_xor<1>(ss[r]); ss[r] += lane_xor<2>(ss[r]); ss[r] += lane_xor<4>(ss[r]); ss[r] += lane_xor<8>(ss[r]); ss[r] += lane_xor<16>(ss[r]);
                ss[r] = 0.8f / sqrtf(ss[r] * (1.f / 128.f) + 1e-5f); }
#pragma unroll
            for (int d0 = 0; d0 < 4; ++d0) { const float g = subg[d0 * 32 + r32];
#pragma unroll
                for (int r = 0; r < 16; ++r) MIX[(size_t)(rowb + crow(r, hi)) * D + 512 + h * 128 + d0 * 32 + r32] = (bf16_t)f2bf(o[d0][r] * ss[r] * g); }
        }
        asm volatile("s_waitcnt vmcnt(0) lgkmcnt(0)\n\ts_barrier" ::: "memory");
    }
}
__device__ __forceinline__ void kmax_rows(LAS unsigned char* lds, const bf16_t* KD, unsigned* KMAX2, int gw, int ngw, int lane, int wave) {
    float mx = 0.f;
    for (int row0 = gw; row0 < M; row0 += 8 * ngw) { u32x4 w[8];
#pragma unroll
        for (int i = 0; i < 8; ++i) { const int row = row0 + i * ngw; w[i] = row < M ? *(const GAS u32x4*)(KD + (size_t)row * HSEC + lane * 8) : (u32x4){0u, 0u, 0u, 0u}; }
#pragma unroll
        for (int i = 0; i < 8; ++i) { const u32x4 v = w[i];
            float s = bflo(v.x) * bflo(v.x) + bfhi(v.x) * bfhi(v.x) + bflo(v.y) * bflo(v.y) + bfhi(v.y) * bfhi(v.y) + bflo(v.z) * bflo(v.z) + bfhi(v.z) * bfhi(v.z) + bflo(v.w) * bflo(v.w) + bfhi(v.w) * bfhi(v.w);
            s += lane_xor<1>(s); s += lane_xor<2>(s); s += lane_xor<4>(s); mx = fmaxf(mx, s); } }
    LAS float* red = (LAS float*)lds; if ((lane & 7) == 0) red[wave * 8 + (lane >> 3)] = mx;
    LDS_WAIT(); __syncthreads();
    if (wave == 0 && lane < 8) { float m = red[lane];
#pragma unroll
        for (int w = 1; w < NWAVES; ++w) m = fmaxf(m, red[w * 8 + lane]);
        atomicMax(KMAX2 + lane * 64, __float_as_uint(m)); }
    __syncthreads();
}
}

__device__ __forceinline__ void route16(const bf16_t* X2B, const u32x4* WRB, const float* rgb, const float* reb,
                                        float* RSTD, int* TOKE, float* TOKW, int* TOKR, unsigned* GCNT, int row0, int lane, LAS float* wl, bool dry = false) {
    typedef float f32x4_ __attribute__((ext_vector_type(4)));
    const int r = lane & 15, q = lane >> 4;
    LAS unsigned* lc = (LAS unsigned*)(wl + 800);
    if (lane < 32) lc[lane] = 0u;
    f32x4_ acc[3]; acc[0] = (f32x4_){0.f, 0.f, 0.f, 0.f}; acc[1] = acc[0]; acc[2] = acc[0];
    float ssq = 0.f;
    const bf16_t* xp = X2B + (size_t)(row0 + r) * D + 8 * q;
#pragma unroll 8
    for (int ks = 0; ks < 32; ++ks) {
        const u32x4 xw = *(const GAS u32x4*)(xp + ks * 32);
        ssq += (bflo(xw.x) * bflo(xw.x) + bfhi(xw.x) * bfhi(xw.x)) + (bflo(xw.y) * bflo(xw.y) + bfhi(xw.y) * bfhi(xw.y)) + (bflo(xw.z) * bflo(xw.z) + bfhi(xw.z) * bfhi(xw.z)) + (bflo(xw.w) * bflo(xw.w) + bfhi(xw.w) * bfhi(xw.w));
        const bf16x8 xh = __builtin_bit_cast(bf16x8, xw);
#pragma unroll
        for (int nt = 0; nt < 3; ++nt) {
            const bf16x8 wh = __builtin_bit_cast(bf16x8, WRB[((ks * 3 + nt) * 2 + 0) * 64 + lane]), wlo = __builtin_bit_cast(bf16x8, WRB[((ks * 3 + nt) * 2 + 1) * 64 + lane]);
            acc[nt] = __builtin_amdgcn_mfma_f32_16x16x32_bf16(wh, xh, acc[nt], 0, 0, 0);
            acc[nt] = __builtin_amdgcn_mfma_f32_16x16x32_bf16(wlo, xh, acc[nt], 0, 0, 0);
        }
    }
    ssq += lane_xor<16>(ssq);
    { auto rr = __builtin_amdgcn_permlane32_swap(__float_as_uint(ssq), __float_as_uint(ssq), false, false); ssq = __uint_as_float(rr[0]) + __uint_as_float(rr[1]); }
    const float rstd = 1.f / sqrtf(ssq * (1.f / 1024.f) + 1e-6f);
#pragma unroll
    for (int nt = 0; nt < 3; ++nt) *(LAS f32x4_*)(wl + r * 48 + nt * 16 + 4 * q) = acc[nt] * rstd;
    LDS_WAIT();
    float lg[36];
#pragma unroll
    for (int n4 = 0; n4 < 9; ++n4) { const f32x4_ t = *(const LAS f32x4_*)(wl + r * 48 + 4 * n4); lg[4 * n4] = t[0]; lg[4 * n4 + 1] = t[1]; lg[4 * n4 + 2] = t[2]; lg[4 * n4 + 3] = t[3]; }
    float gl[4];
#pragma unroll
    for (int g = 0; g < 4; ++g) gl[g] = lg[g] + rgb[g];
    int gi = 0; float gm = gl[0];
#pragma unroll
    for (int g = 1; g < 4; ++g) if (gl[g] > gm) { gm = gl[g]; gi = g; }
    float gs = 0.f;
#pragma unroll
    for (int g = 0; g < 4; ++g) gs += __expf(gl[g] - gm);
    const float gp = 1.f / gs;
    float e[8];
#pragma unroll
    for (int j = 0; j < 8; ++j) { const float a0 = lg[4 + j] + reb[j], a1 = lg[12 + j] + reb[8 + j], a2 = lg[20 + j] + reb[16 + j], a3 = lg[28 + j] + reb[24 + j];
        e[j] = gi == 0 ? a0 : gi == 1 ? a1 : gi == 2 ? a2 : a3; }
    int i1 = 0; float m1 = e[0];
#pragma unroll
    for (int j = 1; j < 8; ++j) if (e[j] > m1) { m1 = e[j]; i1 = j; }
    int i2 = 0; float m2 = -3.0e38f;
#pragma unroll
    for (int j = 0; j < 8; ++j) if (j != i1 && e[j] > m2) { m2 = e[j]; i2 = j; }
    const float p2 = __expf(m2 - m1);
    const float w1 = gp / (1.f + p2), w2 = gp * p2 / (1.f + p2);
    if (q == 0 && !dry) { const int row = row0 + r; const int e1 = gi * 8 + i1, e2 = gi * 8 + i2;
        const int r1 = (int)__hip_atomic_fetch_add(lc + e1, 1u, __ATOMIC_RELAXED, __HIP_MEMORY_SCOPE_WORKGROUP), r2 = (int)__hip_atomic_fetch_add(lc + e2, 1u, __ATOMIC_RELAXED, __HIP_MEMORY_SCOPE_WORKGROUP);
        RSTD[row] = rstd; TOKE[row * 2] = e1; TOKE[row * 2 + 1] = e2; TOKW[row * 2] = w1; TOKW[row * 2 + 1] = w2; TOKR[row * 2] = r1; TOKR[row * 2 + 1] = r2; }
    LDS_WAIT();
    if (lane < 32 && !dry) GCNT[(row0 >> 4) * 32 + lane] = lc[lane];
}
__device__ __forceinline__ void build_tile_prefix(volatile LAS int* tb, const unsigned* CNT) {
    if (threadIdx.x == 0) { int acc = 0;
        for (int e = 0; e < 32; ++e) { tb[e] = acc; const int c = (int)__hip_atomic_load(CNT + e * CNT_STRIDE, __ATOMIC_RELAXED, __HIP_MEMORY_SCOPE_AGENT); tb[64 + e] = c; acc += (c + 255) >> 8; }
        tb[32] = acc; }
    LDS_WAIT(); __syncthreads();
}
__device__ __forceinline__ void sort_slots(LAS unsigned char* lds, volatile LAS int* tb, const unsigned* GCNT, const int* TOKE, const int* TOKR, int* TOKS, int* PERM, const float* RSTD, float* RSLOT, unsigned* CNT, int blk, int nblk) {
    const int t = opaque_tid(), e = t & 31, j = t >> 5; constexpr int NG = M / 16;
    const int gpb = (NG + nblk - 1) / nblk, g0 = blk * gpb, g1 = g0 + gpb < NG ? g0 + gpb : NG;
    LAS int* part = (LAS int*)lds; LAS int* part2 = part + 512; LAS int* tot = part2 + 512; LAS int* base0 = tot + 32;
    int s = 0, s2 = 0;
    for (int g = j; g < NG; g += 16) { const int c = (int)GCNT[g * 32 + e]; s += c; s2 += g < g0 ? c : 0; }
    part[j * 32 + e] = s; part2[j * 32 + e] = s2;
    LDS_WAIT(); __syncthreads();
    if (t < 32) { int a = 0, b = 0;
#pragma unroll
        for (int jj = 0; jj < 16; ++jj) { a += part[jj * 32 + t]; b += part2[jj * 32 + t]; }
        tot[t] = a; base0[t] = b; if (blk == 0) __hip_atomic_store(CNT + t * CNT_STRIDE, (unsigned)a, __ATOMIC_RELAXED, __HIP_MEMORY_SCOPE_AGENT); }
    LDS_WAIT(); __syncthreads();
    if (t == 0) { int acc = 0; for (int ee = 0; ee < 32; ++ee) { tb[ee] = acc; tb[64 + ee] = tot[ee]; acc += (tot[ee] + 255) >> 8; } tb[32] = acc; }
    LDS_WAIT(); __syncthreads();
    for (int idx = t; idx < (g1 - g0) * 32; idx += 512) { const int gi = idx >> 5, p = (g0 + gi) * 32 + (idx & 31), ex = TOKE[p]; int base = base0[ex];
        for (int g = g0; g < g0 + gi; ++g) base += (int)GCNT[g * 32 + ex];
        const int slot = tb[ex] * 256 + base + TOKR[p]; TOKS[p] = slot; PERM[slot] = p >> 1; RSLOT[slot] = RSTD[p >> 1]; }
}
template <int NR>
__device__ __forceinline__ void final_rows(const bf16_t* X2B, float* OUT, const bf16_t* Y, const int* TOKS, const float* TOKW, const float* gain, int m0, int stride, int lane) {
    int s0[NR], s1[NR]; float w0[NR], w1[NR];
#pragma unroll
    for (int i = 0; i < NR; ++i) { const int row = m0 + i * stride; s0[i] = TOKS[row * 2]; s1[i] = TOKS[row * 2 + 1]; w0[i] = TOKW[row * 2]; w1[i] = TOKW[row * 2 + 1]; }
    u32x2 xx[NR][4], ya[NR][4], yb[NR][4];
#pragma unroll
    for (int i = 0; i < NR; ++i) { const int row = m0 + i * stride;
        const GAS u32x2* xr = (const GAS u32x2*)(X2B + (size_t)row * D) + lane; const GAS u32x2* y0 = (const GAS u32x2*)(Y + (size_t)s0[i] * D) + lane; const GAS u32x2* y1 = (const GAS u32x2*)(Y + (size_t)s1[i] * D) + lane;
#pragma unroll
        for (int j = 0; j < 4; ++j) { xx[i][j] = xr[64 * j]; ya[i][j] = y0[64 * j]; yb[i][j] = y1[64 * j]; } }
#pragma unroll
    for (int i = 0; i < NR; ++i) { const int row = m0 + i * stride; f32x4 v[4]; float s = 0.f;
#pragma unroll
        for (int j = 0; j < 4; ++j) { const u32x2 x_ = xx[i][j], a = ya[i][j], b = yb[i][j];
            v[j].x = bflo(x_.x) + w0[i] * bflo(a.x) + w1[i] * bflo(b.x); v[j].y = bfhi(x_.x) + w0[i] * bfhi(a.x) + w1[i] * bfhi(b.x); v[j].z = bflo(x_.y) + w0[i] * bflo(a.y) + w1[i] * bflo(b.y); v[j].w = bfhi(x_.y) + w0[i] * bfhi(a.y) + w1[i] * bfhi(b.y);
            s += (v[j].x * v[j].x + v[j].y * v[j].y) + (v[j].z * v[j].z + v[j].w * v[j].w); }
        const float rstd = 1.f / sqrtf(wave_sum(s) * (1.f / 1024.f) + 1e-6f);
        GAS f32x4* orow = (GAS f32x4*)(OUT + (size_t)row * D) + lane;
#pragma unroll
        for (int j = 0; j < 4; ++j) { const f32x4 g = ((const GAS f32x4*)gain)[64 * j + lane]; orow[64 * j] = v[j] * rstd * g; } }
}

#ifndef MK_N_LAUNCHES
#define MK_N_LAUNCHES 1
#endif
constexpr int N_PHASES = 12;
struct Args { const void* in[18]; float* out; unsigned char* ws; int ph_lo, ph_hi; };
static_assert(sizeof(Args) == 18 * 8 + 8 + 8 + 8, "Args has no padding");

__global__ void __launch_bounds__(NWAVES * 64, 2) mk_fwd(Args args) {
    extern __shared__ __attribute__((aligned(16))) unsigned char lds_raw[];
    LAS unsigned char* lds = (LAS unsigned char*)lds_raw;
    volatile LAS unsigned* MISC = (volatile LAS unsigned*)(lds + MISC_OFF);
    const int G = gridDim.x, bx = blockIdx.x, vcu = (G % 8 == 0) ? (bx % 8) * (G / 8) + bx / 8 : bx;
    const int NGW = G * NWAVES;
#define PHASE_IDS const int tid = opaque_tid(), lane = tid & 63, wave = __builtin_amdgcn_readfirstlane(tid >> 6), gw = vcu * NWAVES + wave; (void)lane; (void)gw
    const __attribute__((address_space(4))) Args* A = (const __attribute__((address_space(4))) Args*)__builtin_amdgcn_kernarg_segment_ptr();
    asm volatile("" : "+s"(A));
#define ARGF(i) ((const float*)A->in[i])
#define WSP(T, off) ((T*)(A->ws + (off)))
#define x_in ARGF(0)
#define positions ((const int*)A->in[1])
#define norm1_gain ARGF(2)
#define w_in ARGF(3)
#define hg_lb ARGF(4)
#define hg_norm_gain ARGF(5)
#define diff_lambda ARGF(6)
#define subln_gain ARGF(7)
#define w_out ARGF(8)
#define norm2_gain ARGF(9)
#define rg_w ARGF(10)
#define rg_b ARGF(11)
#define re_w ARGF(12)
#define re_b ARGF(13)
#define w_gate ARGF(14)
#define w_up ARGF(15)
#define w_down ARGF(16)
#define final_gain ARGF(17)
#define out (A->out)
#define cosT WSP(float, WS_ROPE)
#define sinT (WSP(float, WS_ROPE) + M * 8)
#define HD WSP(float, WS_HD)
#define TOKE WSP(int, WS_TOKE)
#define TOKW WSP(float, WS_TOKW)
#define TOKR WSP(int, WS_TOKR)
#define TOKS WSP(int, WS_TOKS)
#define LAMP WSP(float, WS_LAM)
#define WOUT WSP(bf16_t, WS_WOUT)
#define WIN WSP(bf16_t, WS_WIN)
#define XN WSP(bf16_t, WS_XN)
#define QH WSP(bf16_t, WS_QH)
#define VH WSP(bf16_t, WS_VH)
#define SG WSP(bf16_t, WS_SG)
#define QD WSP(bf16_t, WS_QD)
#define KD WSP(bf16_t, WS_KD)
#define VD WSP(bf16_t, WS_VD)
#define GF WSP(half_t, WS_GF)
#define GB WSP(half_t, WS_GB)
#define HS WSP(float, WS_HS)
#define HL WSP(float, WS_HL)
#define OF WSP(float, WS_OF)
#define OB WSP(float, WS_OB)
#define MIX WSP(bf16_t, WS_MIX)
#define X2B WSP(bf16_t, WS_X2B)
#define X2F8 WSP(unsigned char, WS_X2F8)
#define WGU WSP(unsigned char, WS_WGU)
#define WD WSP(unsigned char, WS_WD)
#define HGb WSP(bf16_t, WS_HG)
#define HM WSP(unsigned char, WS_HM)
#define Y WSP(bf16_t, WS_Y)
#define CNT (WSP(unsigned, WS_CTL) + CW_CNT)
    unsigned* ctl = WSP(unsigned, WS_CTL);
    volatile LAS int* tb = (volatile LAS int*)(MISC + 16);

    if (threadIdx.x < 64) MISC[threadIdx.x] = 0u;
    __syncthreads();
    XcdBarrier bar; bar.bar = ctl + CW_BAR; bar.x = 0; bar.st = nullptr;
    const int lo = A->ph_lo, hi = A->ph_hi;
    if (hi - lo > 1) bar = xcd_barrier_post(ctl + CW_BAR, MISC);
#ifndef PH_MASK
#define PH_MASK 0xFFF
#endif
#define IN(k) (((PH_MASK >> (k)) & 1) && lo <= (k) && (k) < hi)
#ifndef DOUBLE_PHASE
#define DOUBLE_PHASE -1
#endif
#define REP(k) for (int rep_ = 0; rep_ < ((DOUBLE_PHASE) == (k) ? 2 : 1); ++rep_)
#ifndef BAR_REPS
#define BAR_REPS 1
#endif
#ifdef DIAG_SPAN_A
#define STAMP(k) do { if (blockIdx.x == 0 && threadIdx.x == 0) WSP(unsigned long long, WS_LAM + 64)[k] = __builtin_amdgcn_s_memrealtime(); } while (0)
#else
#define STAMP(k) do { } while (0)
#endif
#define SEAM(k) do { if (IN(k) && IN((k) + 1)) for (int b_ = 0; b_ < BAR_REPS; ++b_) xcd_barrier(bar); STAMP((k) + 1); } while (0)

    STAMP(0);
    if (IN(0)) REP(0) { PHASE_IDS;
        LAS float* scr = (LAS float*)(lds + wave * 16384);
        constexpr int I_IN = (D / 64) * (NIN / 32), I_OUT = (D / 64) * (D / 32);
        { XposeRegs R;
#define P0_LOAD(it_) do { if ((it_) < I_IN) xpose_load(R, w_in, D, NIN, (it_), lane); else xpose_load(R, w_out, D, D, (it_) - I_IN, lane); } while (0)
            if (gw < I_IN + I_OUT) P0_LOAD(gw);
            for (int it = gw; it < I_IN + I_OUT; it += NGW) { const XposeRegs C = R; const int nx = it + NGW;
                if (nx < I_IN + I_OUT) P0_LOAD(nx);
                if (it < I_IN) xpose_store(C, D, NIN, WIN, 0, 1, scr, it, lane); else xpose_store(C, D, D, WOUT, 0, 1, scr, it - I_IN, lane); }
#undef P0_LOAD
        }
        for (int m = gw; m < M; m += NGW) rms_rows_to_bf16<1>(x_in, norm1_gain, XN, m, NGW, lane, 1e-6f);
        for (int id = bx * 512 + tid; id < M * 8; id += G * 512) {
            const int i = id & 7; const float invf[8] = {1.0f, 0.19392274474868576f, 0.03760603093086393f, 0.007292664737217109f, 0.001414213562373095f, 0.0002742481756762073f, 5.318295896944988e-05f, 1.031338537721246e-05f};
            float f = invf[0];
#pragma unroll
            for (int q = 1; q < 8; ++q) f = (i == q) ? invf[q] : f;
            const float ang = (float)positions[id >> 3] * f;
            const double rev = (double)ang * 0.15915494309189535; const float fr = (float)(rev - __builtin_rint(rev));
            cosT[id] = __builtin_amdgcn_cosf(fr); sinT[id] = __builtin_amdgcn_sinf(fr);
        }
        for (int id = bx * 512 + tid; id < 32 * 3 * 2 * 64; id += G * 512) {
            const int ln = id & 63, part = (id >> 6) & 1, nt = (id >> 7) % 3, ks = (id >> 7) / 3, n = nt * 16 + (ln & 15), k0 = ks * 32 + 8 * (ln >> 4); unsigned w[4];
#pragma unroll
            for (int jj = 0; jj < 4; ++jj) { float v[2];
#pragma unroll
                for (int u = 0; u < 2; ++u) { const int k = k0 + 2 * jj + u; const float wv = (n < 4 ? rg_w[k * 4 + n] : n < 36 ? re_w[k * 32 + (n - 4)] : 0.f) * norm2_gain[k];
                    const float hv = bf2f(f2bf(wv)); v[u] = part ? wv - hv : hv; }
                w[jj] = pk2(v[0], v[1]); }
            WSP(u32x4, WS_WR)[id] = (u32x4){w[0], w[1], w[2], w[3]}; }
        if (bx == 0 && wave == 0) { const float a = wave_sum(diff_lambda[lane] * diff_lambda[64 + lane]), b = wave_sum(diff_lambda[128 + lane] * diff_lambda[192 + lane]);
            if (lane == 0) LAMP[0] = __expf(a) - __expf(b) + 0.2f; }
    }
    SEAM(0);
    if (IN(1)) REP(1) {
        pg8::Gemm g{XN, WIN, M, NIN, D}; pg8::StaticOrder S; S.init(M, NIN, G, bx);
        EpiInProj E{QH, VH, SG, QD, KD, VD, GF, GB, hg_lb, cosT, sinT};
        pg8::gemm_phase<EpiInProj, pg8::StaticOrder, true, true>(lds, g, S, E);
    }
    SEAM(1);
    if (IN(2)) REP(2) { for (int u = vcu; u < 256; u += G) hg::pass<false>(lds, u, QH, VH, GF, GB, HL, HD, HS, OF, OB);
        { PHASE_IDS; att2::kmax_rows(lds, KD, WSP(unsigned, WS_CTL) + CW_KMAX, gw, NGW, lane, wave); } }
    SEAM(2);
    if (IN(3)) REP(3) hg::scan(HL, HD, HS, bx * 512 + opaque_tid(), G * 512);
    SEAM(3);
    if (IN(4)) REP(4) { for (int u = vcu; u < 256; u += G) hg::pass<true>(lds, u, QH, VH, GF, GB, HL, HD, HS, OF, OB); }
    SEAM(4);
    if (IN(5)) REP(5) { PHASE_IDS;
#ifdef DIAG_CLOCK
        if (blockIdx.x == 0 && threadIdx.x == 0) { WSP(unsigned long long, WS_LAM + 64)[20] = __builtin_amdgcn_s_memtime(); WSP(unsigned long long, WS_LAM + 64)[21] = __builtin_amdgcn_s_memrealtime(); }
#endif
        const float lam = LAMP[0];
        for (int u = vcu; u < 256; u += G) { const int h = u >> 6, q0 = (u & 63) * 256;
            int ln = lane; asm volatile("" : "+v"(ln));
            att::hgrn_finalize(h, q0, OF, OB, SG, hg_norm_gain, MIX, wave, ln);
            att2::unit(lds, h, q0, QD, KD, VD, WSP(unsigned, WS_CTL) + CW_KMAX, WSP(float, WS_O0S) + (size_t)bx * 32768, lam, subln_gain, MIX); }
    }
#ifdef DIAG_CLOCK
    if (blockIdx.x == 0 && threadIdx.x == 0) { WSP(unsigned long long, WS_LAM + 64)[22] = __builtin_amdgcn_s_memtime(); WSP(unsigned long long, WS_LAM + 64)[23] = __builtin_amdgcn_s_memrealtime(); }
#endif
    SEAM(5);
    if (IN(6)) REP(6) {
        pg8::Gemm g{MIX, WOUT, M, D, D}; pg8::StaticOrder S; S.init(M, D, G, bx);
        EpiResid E{x_in, X2B, X2F8};
        pg8::gemm_phase<EpiResid, pg8::StaticOrder, true, true>(lds, g, S, E);
    }
    SEAM(6);
    if (IN(7)) { PHASE_IDS;
        const int grp = wave * G + vcu; const bool router = grp * 16 < M;
        LAS float* scr = (LAS float*)(lds + wave * 16384);
        if (router) route16(X2B, WSP(const u32x4, WS_WR), rg_b, re_b, WSP(float, WS_RSTD), TOKE, TOKW, TOKR, WSP(unsigned, WS_GCNT), grp * 16, lane, scr + 3072);
        if (router && (DOUBLE_PHASE) == 77) route16(X2B, WSP(const u32x4, WS_WR), rg_b, re_b, WSP(float, WS_RSTD), TOKE, TOKW, TOKR, WSP(unsigned, WS_GCNT), grp * 16, lane, scr + 3072, true);
        constexpr int I_GU = (D / 64) * (DEXP / 32), I_DN = (DEXP / 64) * (D / 32), I_ALL = NEXP * (2 * I_GU + I_DN);
#ifndef P7_SHARE
#define P7_SHARE 10
#endif
        const int nrt = M / 16, nA = nrt < NGW ? nrt : NGW, nB = NGW - nA;
        const int perA = nB ? (I_ALL * P7_SHARE / 24 + nA - 1) / nA : (I_ALL + nA - 1) / nA, totA = perA * nA < I_ALL ? perA * nA : I_ALL;
        int it0, it1, stp;
        if (router) { it0 = grp; it1 = totA; stp = nA; } else { it0 = totA + (grp - nA); it1 = I_ALL; stp = nB; }
        REP(7) { XposeRegs R0, R1;
#define P7_LOAD(R, it_) do { const int e_ = (it_) / (2 * I_GU + I_DN), r_ = (it_) % (2 * I_GU + I_DN); \
            if (r_ < I_GU) xpose_load(R, w_gate + (size_t)e_ * D * DEXP, D, DEXP, r_, lane); else if (r_ < 2 * I_GU) xpose_load(R, w_up + (size_t)e_ * D * DEXP, D, DEXP, r_ - I_GU, lane); \
            else xpose_load(R, w_down + (size_t)e_ * DEXP * D, DEXP, D, r_ - 2 * I_GU, lane); } while (0)
#define P7_STORE(C, it_) do { const int e = (it_) / (2 * I_GU + I_DN), r = (it_) % (2 * I_GU + I_DN); \
            if (r < I_GU) xpose_store_f8(C, D, DEXP, WGU + (size_t)e * 1024 * D, 0, 2, scr, r, lane, F8_WSCALE, norm2_gain); \
            else if (r < 2 * I_GU) xpose_store_f8(C, D, DEXP, WGU + (size_t)e * 1024 * D, 1, 2, scr, r - I_GU, lane, F8_WSCALE, norm2_gain); \
            else xpose_store_f8(C, DEXP, D, WD + (size_t)e * 1024 * DEXP, 0, 1, scr, r - 2 * I_GU, lane, F8_WSCALE); } while (0)
            if (it0 < it1) P7_LOAD(R0, it0);
            if (it0 + stp < it1) P7_LOAD(R1, it0 + stp);
            for (int it = it0; it < it1; it += 2 * stp) {
                { const XposeRegs C = R0; if (it + 2 * stp < it1) P7_LOAD(R0, it + 2 * stp); P7_STORE(C, it); }
                if (it + stp < it1) { const XposeRegs C = R1; if (it + 3 * stp < it1) P7_LOAD(R1, it + 3 * stp); P7_STORE(C, it + stp); }
            }
#undef P7_STORE
#undef P7_LOAD
        }
    }
    SEAM(7);
    if (IN(8)) REP(8) { sort_slots(lds, tb, WSP(unsigned, WS_GCNT), TOKE, TOKR, TOKS, WSP(int, WS_PERM), WSP(const float, WS_RSTD), WSP(float, WS_RSLOT), CNT, bx, G); }
    SEAM(8);
    if (IN(9)) REP(9) {
        build_tile_prefix(tb, CNT);
        pg8::Gemm g{(const bf16_t*)X2F8, (const bf16_t*)WGU, MAXSLOTS, NEXP * 1024, D / 2}; MoeOrder S{tb, G, bx, WSP(const int, WS_PERM), WSP(unsigned, WS_CTL) + CW_READY, 0}; EpiSwiGlu E{HM, WSP(const float, WS_RSLOT)};
        pg8::gemm_phase_g<EpiSwiGlu, MoeOrder, true, true, true>(lds, g, S, E);
    }
    SEAM(9);
    if (IN(10)) REP(10) {
        build_tile_prefix(tb, CNT);
        pg8::Gemm g{(const bf16_t*)HM, (const bf16_t*)WD, MAXSLOTS, NEXP * 1024, DEXP / 2}; MoeOrder S{tb, G, bx, WSP(const int, WS_PERM), WSP(unsigned, WS_CTL) + CW_READY, 0}; EpiDown E{Y};
        pg8::gemm_phase<EpiDown, MoeOrder, true, true, true>(lds, g, S, E);
    }
    SEAM(10);
    if (IN(11)) { PHASE_IDS; for (int m = gw; m < M; m += NGW) final_rows<1>(X2B, out, Y, TOKS, TOKW, final_gain, m, NGW, lane); }
#ifdef DIAG_SPAN_A
    xcd_barrier(bar); STAMP(12); xcd_barrier(bar);
    { const unsigned long long* st_ = WSP(unsigned long long, WS_LAM + 64);
#ifdef DIAG_CLOCK
      const float d_ = (float)(long long)(st_[22] - st_[20]) / (float)(long long)(st_[23] - st_[21]) * 10.f * DIAG_C;
#else
      const float d_ = (float)(long long)(st_[DIAG_SPAN_B] - st_[DIAG_SPAN_A]) * 0.01f * DIAG_C;
#endif
      for (int m = blockIdx.x * 512 + threadIdx.x; m < M; m += gridDim.x * 512) out[(size_t)m * D] += d_; }
#endif
#undef IN
#undef SEAM
#undef x_in
#undef positions
#undef out
#undef Y
#undef HM
#undef CNT
}

extern "C" void kernel_launch(void* const* d_in, const int* in_sizes, int n_in, void* d_out, int out_size, void* d_ws, size_t ws_size, hipStream_t stream) {
    static int grid = 0;
    if (grid == 0) {
        if (n_in != 18 || in_sizes[0] != M * D || out_size != M * D || ws_size < WS_END) { fprintf(stderr, "kernel_launch: unexpected shapes (n_in %d, in0 %d, out %d, ws %zu)\n", n_in, n_in > 0 ? in_sizes[0] : -1, out_size, ws_size); grid = -1; return; }
        int dev = 0, cus = 0, per_cu = 0;
        if (hipGetDevice(&dev) != hipSuccess || hipDeviceGetAttribute(&cus, hipDeviceAttributeMultiprocessorCount, dev) != hipSuccess) { grid = -1; return; }
        if (hipFuncSetAttribute((const void*)mk_fwd, hipFuncAttributeMaxDynamicSharedMemorySize, LDS_BYTES) != hipSuccess) { fprintf(stderr, "kernel_launch: hipFuncSetAttribute failed\n"); grid = -1; return; }
        if (hipOccupancyMaxActiveBlocksPerMultiprocessor(&per_cu, (const void*)mk_fwd, NWAVES * 64, LDS_BYTES) != hipSuccess || per_cu < 1) { fprintf(stderr, "kernel_launch: occupancy query says %d\n", per_cu); (void)hipGetLastError(); grid = -1; return; }
        grid = cus;
    }
    if (grid < 0) return;
    if (hipMemsetAsync((char*)d_ws + WS_CTL, 0, CTL_ZERO_BYTES, stream) != hipSuccess) return;
    Args a{};
    for (int i = 0; i < 18; ++i) a.in[i] = d_in[i];
    a.out = (float*)d_out; a.ws = (unsigned char*)d_ws;
#if MK_N_LAUNCHES == 1
    a.ph_lo = 0; a.ph_hi = N_PHASES;
    hipLaunchKernelGGL(mk_fwd, dim3(grid), dim3(NWAVES * 64), LDS_BYTES, stream, a);
#else
    for (int p = 0; p < N_PHASES; ++p) { a.ph_lo = p; a.ph_hi = p + 1; hipLaunchKernelGGL(mk_fwd, dim3(grid), dim3(NWAVES * 64), LDS_BYTES, stream, a); }
#endif
}
```

```cpp
#include <hip/hip_runtime.h>
#include <cstdio>
#include <cstdint>
__device__ __forceinline__ int opaque_tid() { int t = threadIdx.x; asm volatile("" : "+v"(t)); return t; }
namespace pg8 {
#define PG8_LAS __attribute__((address_space(3)))
typedef unsigned short bf16_t;
typedef short bf16x8 __attribute__((ext_vector_type(8)));
typedef float f32x4 __attribute__((ext_vector_type(4)));
typedef unsigned u32x4 __attribute__((ext_vector_type(4)));
constexpr int BM = 256, BK = 64, HALF = 128, HTB = HALF * BK * 2  , STAGE_BYTES = 8 * HTB, NXCD = 8, WGM = 8;

__host__ __device__ __forceinline__ int lds_byte(int r, int c) { const int st = (r >> 4) * 2 + (c >> 5), rr = r & 15, cc = c & 31, ob = rr * 64 + cc * 2; return st * 1024 + (ob ^ (((ob >> 9) & 1) << 5)); }
__host__ __device__ __forceinline__ void stage_rc(int b, int& R, int& C) { const int st = b / 1024, sb = b % 1024, swz = sb ^ (((sb >> 9) & 1) << 5); R = (st >> 1) * 16 + swz / 64; C = (st & 1) * 32 + (swz % 64) / 2; }
__host__ __device__ __forceinline__ int perm32(int rho) { const int n = rho >> 4, i = rho & 15; return 8 * (i >> 2) + 4 * n + (i & 3); }

struct Unit { int pm, pn; };
struct Gemm { const bf16_t* A; const bf16_t* Bt; int M, N, K; };

struct StaticOrder {
    int nM, nN, nwg, G, c;
    __host__ __device__ void init(int M, int N, int G_, int c_) { nM = M / BM; nN = N / BM; nwg = nM * nN; G = G_; c = c_; }
    __host__ __device__ bool next(int i, Unit& u) const {
        const long L = (long)i * G + c; if (L >= nwg) return false;
        int wgid = (int)L; { const int q = nwg / NXCD, r = nwg % NXCD, xcd = wgid % NXCD, off = wgid / NXCD; wgid = (xcd < r ? xcd * (q + 1) : r * (q + 1) + (xcd - r) * q) + off; }
        const int nig = WGM * nN, gid = wgid / nig, fm = gid * WGM, gsz = (nM - fm) < WGM ? (nM - fm) : WGM;
        u.pm = fm + ((wgid % nig) % gsz); u.pn = (wgid % nig) / gsz; return true;
    }
    __device__ __forceinline__ bool half_only(const Unit&) const { return false; }
    __device__ __forceinline__ void a_ready(const Unit&) const {}
    __device__ __forceinline__ void done(const Unit&) const {}
};

template <class Epi, class Sched, bool ALIGN_EPI = false, bool SP2 = false, bool F8 = false>
__device__ __forceinline__ void gemm_phase(PG8_LAS unsigned char* lds, const Gemm g, const Sched& S, const Epi& E) {
    const int tid = opaque_tid(), wid = __builtin_amdgcn_readfirstlane(tid >> 6), lane = tid & 63, wr = wid >> 2, wc = wid & 3, fr = lane & 15, fq = lane >> 4;
    const int K = g.K, nt = K / BK;
    unsigned voffA[2], voffB[2];
#pragma unroll
    for (int i = 0; i < 2; ++i) { int R, C; stage_rc(tid * 16 + i * 8192, R, C); const int Rb = Epi::PERM ? ((R & ~31) + perm32(R & 31)) : R;
        voffA[i] = (unsigned)(R * K + C) * 2u; voffB[i] = (unsigned)(Rb * K + C) * 2u; }
    const size_t kstep = (size_t)(BK * 2);
    const size_t hstep = (size_t)HALF * K * 2;
    const size_t tstep = 2 * hstep;
    const unsigned ldsw = (unsigned)wid * 1024u;
    const int aoff = lds_byte(wr * 64 + fr, fq * 8), boff = lds_byte(wc * 32 + fr, fq * 8);
#define PG8_SA(b, h) (((b) * 2 + (h)) * HTB)
#define PG8_SB(b, h) ((4 + (b) * 2 + (h)) * HTB)
#define PG8_STAGE(bufoff, gbase, voff) do { _Pragma("unroll") for (int _i = 0; _i < 2; ++_i) \
        __builtin_amdgcn_global_load_lds((const unsigned*)((const char*)(gbase) + (voff)[_i]), (PG8_LAS unsigned*)(lds + (bufoff) + ldsw + _i * 8192), 16, 0, 0); } while (0)
#define PG8_LDA(dst, b, h) do { _Pragma("unroll") for (int m = 0; m < 4; ++m) _Pragma("unroll") for (int k = 0; k < 2; ++k) dst[m][k] = *(const PG8_LAS bf16x8*)(lds + PG8_SA(b, h) + aoff + m * 2048 + k * 1024); } while (0)
#define PG8_LDB(dst, b, h) do { _Pragma("unroll") for (int n = 0; n < 2; ++n) _Pragma("unroll") for (int k = 0; k < 2; ++k) dst[n][k] = *(const PG8_LAS bf16x8*)(lds + PG8_SB(b, h) + boff + n * 2048 + k * 1024); } while (0)
#define PG8_MMA(ai, bj, At, Bt) do { __builtin_amdgcn_s_setprio(1); _Pragma("unroll") for (int m = 0; m < 4; ++m) _Pragma("unroll") for (int n = 0; n < 2; ++n) _Pragma("unroll") for (int k = 0; k < 2; ++k) { \
        if constexpr (F8) { typedef long v2l_ __attribute__((ext_vector_type(2))); const v2l_ b_ = __builtin_bit_cast(v2l_, Bt[n][k]), a_ = __builtin_bit_cast(v2l_, At[m][k]); \
            acc[ai][bj][m][n] = __builtin_amdgcn_mfma_f32_16x16x32_fp8_fp8(b_[0], a_[0], acc[ai][bj][m][n], 0, 0, 0); acc[ai][bj][m][n] = __builtin_amdgcn_mfma_f32_16x16x32_fp8_fp8(b_[1], a_[1], acc[ai][bj][m][n], 0, 0, 0); } \
        else acc[ai][bj][m][n] = __builtin_amdgcn_mfma_f32_16x16x32_bf16(Bt[n][k], At[m][k], acc[ai][bj][m][n], 0, 0, 0); } \
        __builtin_amdgcn_s_setprio(0); } while (0)
#define PG8_WAIT_V(n) asm volatile("s_waitcnt vmcnt(" #n ")" ::: "memory")
#define PG8_WAIT_L(n) asm volatile("s_waitcnt lgkmcnt(" #n ")" ::: "memory")
#define PG8_BAR __builtin_amdgcn_s_barrier()
#define PG8_SCHED __builtin_amdgcn_sched_barrier(0)
    Unit cur, nxt; int ui = 0;
    if (!S.next(0, cur)) return;
    f32x4 acc[2][2][4][2];
#pragma unroll
    for (int a = 0; a < 2; ++a)
#pragma unroll
        for (int b = 0; b < 2; ++b)
#pragma unroll
            for (int m = 0; m < 4; ++m)
#pragma unroll
                for (int n = 0; n < 2; ++n) acc[a][b][m][n] = (f32x4){0.f, 0.f, 0.f, 0.f};
    bf16x8 At[4][2], B0[2][2], B1[2][2];
    const char* cA = (const char*)g.A + (size_t)cur.pm * tstep; const char* cB = (const char*)g.Bt + (size_t)cur.pn * tstep;
    S.a_ready(cur);
    if constexpr (SP2) {
        PG8_STAGE(PG8_SB(0, 0), cB, voffB); PG8_STAGE(PG8_SB(0, 1), cB + hstep, voffB); PG8_STAGE(PG8_SA(0, 0), cA, voffA); PG8_STAGE(PG8_SA(0, 1), cA + hstep, voffA);
        if (wr == 1) PG8_BAR;
        PG8_WAIT_V(2); PG8_BAR;
        PG8_STAGE(PG8_SB(1, 0), cB + kstep, voffB); PG8_STAGE(PG8_SA(1, 0), cA + kstep, voffA); PG8_STAGE(PG8_SB(1, 1), cB + hstep + kstep, voffB);
        PG8_WAIT_V(6); PG8_BAR;
    } else {
        PG8_STAGE(PG8_SB(0, 0), cB, voffB); PG8_STAGE(PG8_SA(0, 0), cA, voffA); PG8_STAGE(PG8_SB(0, 1), cB + hstep, voffB); PG8_STAGE(PG8_SA(0, 1), cA + hstep, voffA);
        if (wr == 1) PG8_BAR;
        PG8_WAIT_V(4); PG8_BAR;
        PG8_STAGE(PG8_SB(1, 0), cB + kstep, voffB); PG8_STAGE(PG8_SA(1, 0), cA + kstep, voffA); PG8_STAGE(PG8_SB(1, 1), cB + hstep + kstep, voffB);
        PG8_WAIT_V(6); PG8_BAR;
    }
    for (;;) {
        const bool has_next = S.next(ui + 1, nxt);
        const char* nA = has_next ? (const char*)g.A + (size_t)nxt.pm * tstep : cA; const char* nB = has_next ? (const char*)g.Bt + (size_t)nxt.pn * tstep : cB;
        for (int t = 0; t < nt; t += 2) {
            const bool last = (t == nt - 2);
            const char* a1 = cA + (size_t)(t + 1) * kstep;
            const char* a2 = last ? nA : cA + (size_t)(t + 2) * kstep; const char* b2 = last ? nB : cB + (size_t)(t + 2) * kstep;
            const char* a3 = a2 + kstep; const char* b3 = b2 + kstep;
            if (last && has_next) S.a_ready(nxt);
            if constexpr (SP2) {
            PG8_LDB(B0, 0, 0); PG8_LDB(B1, 0, 1); PG8_SCHED; PG8_LDA(At, 0, 0); PG8_STAGE(PG8_SA(1, 1), a1 + hstep, voffA);
            PG8_WAIT_V(8); PG8_WAIT_L(0); PG8_BAR; PG8_MMA(0, 0, At, B0); PG8_MMA(0, 1, At, B1); PG8_BAR; PG8_SCHED;
            PG8_LDA(At, 0, 1); PG8_STAGE(PG8_SB(0, 0), b2, voffB); PG8_STAGE(PG8_SB(0, 1), b2 + hstep, voffB); PG8_STAGE(PG8_SA(0, 0), a2, voffA);
            PG8_WAIT_V(8); PG8_WAIT_L(0); PG8_BAR; PG8_MMA(1, 0, At, B0); PG8_MMA(1, 1, At, B1); PG8_BAR; PG8_SCHED;
            PG8_LDB(B0, 1, 0); PG8_LDB(B1, 1, 1); PG8_SCHED; PG8_LDA(At, 1, 0); PG8_STAGE(PG8_SA(0, 1), a2 + hstep, voffA);
            PG8_WAIT_V(8); PG8_WAIT_L(0); PG8_BAR; PG8_MMA(0, 0, At, B0); PG8_MMA(0, 1, At, B1); PG8_BAR; PG8_SCHED;
            PG8_LDA(At, 1, 1); PG8_STAGE(PG8_SB(1, 0), b3, voffB); PG8_STAGE(PG8_SB(1, 1), b3 + hstep, voffB); PG8_STAGE(PG8_SA(1, 0), a3, voffA);
            PG8_WAIT_V(8); PG8_WAIT_L(0); PG8_BAR; PG8_MMA(1, 0, At, B0); PG8_MMA(1, 1, At, B1); PG8_BAR; PG8_SCHED;
            } else {
            PG8_LDB(B0, 0, 0); PG8_SCHED; PG8_LDA(At, 0, 0); PG8_STAGE(PG8_SA(1, 1), a1 + hstep, voffA);
            PG8_WAIT_L(8); PG8_BAR; PG8_WAIT_L(0); PG8_MMA(0, 0, At, B0); PG8_BAR; PG8_SCHED;
            PG8_LDB(B1, 0, 1); PG8_STAGE(PG8_SB(0, 0), b2, voffB);
            PG8_BAR; PG8_WAIT_L(0); PG8_MMA(0, 1, At, B1); PG8_BAR;
            PG8_LDA(At, 0, 1); PG8_STAGE(PG8_SA(0, 0), a2, voffA);
            PG8_BAR; PG8_WAIT_L(0); PG8_MMA(1, 0, At, B0); PG8_BAR; PG8_SCHED;
            PG8_STAGE(PG8_SB(0, 1), b2 + hstep, voffB);
            PG8_WAIT_V(6); PG8_BAR; PG8_MMA(1, 1, At, B1); PG8_BAR;
            PG8_LDB(B0, 1, 0); PG8_SCHED; PG8_LDA(At, 1, 0); PG8_STAGE(PG8_SA(0, 1), a2 + hstep, voffA);
            PG8_WAIT_L(8); PG8_BAR; PG8_WAIT_L(0); PG8_MMA(0, 0, At, B0); PG8_BAR; PG8_SCHED;
            PG8_LDB(B1, 1, 1); PG8_STAGE(PG8_SB(1, 0), b3, voffB);
            PG8_BAR; PG8_WAIT_L(0); PG8_MMA(0, 1, At, B1); PG8_BAR;
            PG8_LDA(At, 1, 1); PG8_STAGE(PG8_SA(1, 0), a3, voffA);
            PG8_BAR; PG8_WAIT_L(0); PG8_MMA(1, 0, At, B0); PG8_BAR; PG8_SCHED;
            PG8_STAGE(PG8_SB(1, 1), b3 + hstep, voffB);
            PG8_WAIT_V(6); PG8_BAR; PG8_MMA(1, 1, At, B1); PG8_BAR;
            }
        }
        if constexpr (ALIGN_EPI) { if (wr == 0) PG8_BAR; }
        if constexpr (!Epi::AFTER_DRAIN) { E(acc, cur, wr, wc, fr, fq); S.done(cur); }
        if (!has_next) break;
#pragma unroll
        for (int a = 0; a < 2; ++a)
#pragma unroll
            for (int b = 0; b < 2; ++b)
#pragma unroll
                for (int m = 0; m < 4; ++m)
#pragma unroll
                    for (int n = 0; n < 2; ++n) acc[a][b][m][n] = (f32x4){0.f, 0.f, 0.f, 0.f};
        cur = nxt; cA = nA; cB = nB; ++ui;
        if constexpr (ALIGN_EPI) { if (wr == 1) PG8_BAR; }
    }
    PG8_WAIT_V(0);
    if constexpr (!ALIGN_EPI) { if (wr == 0) PG8_BAR; }
    PG8_BAR;
    if constexpr (Epi::AFTER_DRAIN) { E.fused(acc, cur, wr, wc, fr, fq, lds, wid, lane); S.done(cur); }
#undef PG8_SA
#undef PG8_SB
#undef PG8_STAGE
#undef PG8_LDA
#undef PG8_LDB
#undef PG8_MMA
#undef PG8_WAIT_V
#undef PG8_WAIT_L
#undef PG8_BAR
#undef PG8_SCHED
}
}

constexpr int NWAVES = 8;
constexpr int M = 16384, D = 1024, NIN = 4096, HSEC = 512;
constexpr int NEXP = 32, DEXP = 512, MAXTILES = 160, MAXSLOTS = MAXTILES * 256;
constexpr float QSCALE = 0.18033688011112042f;

constexpr size_t MiB = 1u << 20;
constexpr size_t WS_CTL = 0, CTL_ZERO_BYTES = 1 * MiB;
constexpr size_t WS_WR = 1 * MiB;
constexpr size_t WS_ROPE = 2 * MiB;
constexpr size_t WS_HD = 3 * MiB;
constexpr size_t WS_TOKE = 3 * MiB + 256 * 1024, WS_TOKW = WS_TOKE + 128 * 1024, WS_TOKR = WS_TOKW + 128 * 1024, WS_TOKS = WS_TOKR + 128 * 1024, WS_LAM = WS_TOKS + 128 * 1024, WS_GCNT = WS_LAM + 128 * 1024, WS_RSTD = 1 * MiB + 256 * 1024, WS_RSLOT = 1 * MiB + 768 * 1024, WS_PERM = 1 * MiB + 512 * 1024;
constexpr size_t WS_WOUT = 4 * MiB, WS_WIN = 6 * MiB;
constexpr size_t WS_XN = 16 * MiB;
constexpr size_t WS_OF = 16 * MiB;
constexpr size_t WS_X2B = 16 * MiB;
constexpr size_t WS_HM = 144 * MiB;
constexpr size_t WS_X2F8 = 112 * MiB;
constexpr size_t WS_QH = 48 * MiB, WS_VH = 64 * MiB, WS_SG = 80 * MiB, WS_QD = 96 * MiB, WS_KD = 112 * MiB, WS_VD = 128 * MiB;
constexpr size_t WS_WGU = 48 * MiB, WS_WD = 216 * MiB;
constexpr size_t WS_GF = 144 * MiB, WS_GB = 176 * MiB;
constexpr size_t WS_MIX = 144 * MiB;
constexpr size_t WS_HS = 208 * MiB, WS_HL = 224 * MiB;
constexpr size_t WS_OB = 224 * MiB;
constexpr size_t WS_HG = 176 * MiB;
constexpr size_t WS_O0S = 176 * MiB;
constexpr size_t WS_Y = 48 * MiB;
constexpr size_t WS_END = 256 * MiB;
static_assert(WS_Y + (size_t)MAXSLOTS * 1024 * 2 <= WS_HM && WS_HM + (size_t)MAXSLOTS * 512 * 2 <= WS_WD && WS_WD + 32 * MiB <= WS_END, "ws map");
constexpr int CW_BAR = 4096, CW_CNT = 16384, CW_KMAX = 20480, CW_QWD = 21504, CW_READY = 32768, CNT_STRIDE = 64;

constexpr int PHASE_LDS = 147456, MISC_OFF = PHASE_LDS, LDS_BYTES = PHASE_LDS + 1024;

#define GAS __attribute__((address_space(1)))
#define LAS __attribute__((address_space(3)))
typedef unsigned short bf16_t;
typedef _Float16 half_t;
typedef float f32x4 __attribute__((ext_vector_type(4)));
typedef float f32x16 __attribute__((ext_vector_type(16)));
typedef short bf16x8 __attribute__((ext_vector_type(8)));
typedef short s16x4 __attribute__((ext_vector_type(4)));
typedef unsigned u32x4 __attribute__((ext_vector_type(4)));
typedef unsigned u32x2 __attribute__((ext_vector_type(2)));
#define LDS_WAIT() asm volatile("s_waitcnt lgkmcnt(0)" ::: "memory")
#define VM_WAIT() asm volatile("s_waitcnt vmcnt(0)" ::: "memory")
#define SBAR() __builtin_amdgcn_sched_barrier(0)
__device__ __forceinline__ unsigned f2bf(float f) { unsigned u = __builtin_bit_cast(unsigned, f); return (u + 0x7fffu + ((u >> 16) & 1u)) >> 16; }
__device__ __forceinline__ unsigned pk2(float lo, float hi) { return f2bf(lo) | (f2bf(hi) << 16); }
__device__ __forceinline__ float bf2f(unsigned b) { return __builtin_bit_cast(float, b << 16); }
__device__ __forceinline__ float bflo(unsigned w) { return __builtin_bit_cast(float, w << 16); }
__device__ __forceinline__ float bfhi(unsigned w) { return __builtin_bit_cast(float, w & 0xffff0000u); }
__device__ __forceinline__ unsigned cvtpk(float lo, float hi) { unsigned r; asm volatile("v_cvt_pk_bf16_f32 %0, %1, %2" : "=v"(r) : "v"(lo), "v"(hi)); return r; }
__device__ __forceinline__ unsigned pk4_fp8(float a, float b, float c, float d) { int w = 0; w = __builtin_amdgcn_cvt_pk_fp8_f32(a, b, w, false); w = __builtin_amdgcn_cvt_pk_fp8_f32(c, d, w, true); return (unsigned)w; }
constexpr float F8_WSCALE = 256.f, F8_HSCALE = 16.f, F8_YSCALE = 32.f;
__device__ __forceinline__ float ex2(float x) { return __builtin_amdgcn_exp2f(x); }
__device__ __forceinline__ float lg2(float x) { return __builtin_amdgcn_logf(x); }
__device__ __forceinline__ float sigmoidf_(float v) { return __builtin_amdgcn_rcpf(1.f + ex2(-1.4426950408889634f * v)); }
__device__ __forceinline__ bool lane_is_hi() { return (opaque_tid() & 32) != 0; }
template <int X> __device__ __forceinline__ float lane_xor(float v) {
    if constexpr (X == 32) { auto rr = __builtin_amdgcn_permlane32_swap(__float_as_uint(v), __float_as_uint(v), false, false); return __uint_as_float(lane_is_hi() ? rr[0] : rr[1]); }
    else return __int_as_float(__builtin_amdgcn_ds_swizzle(__float_as_int(v), (X << 10) | 0x1F));
}
__device__ __forceinline__ float wave_sum(float v) {
    v += lane_xor<1>(v); v += lane_xor<2>(v); v += lane_xor<4>(v); v += lane_xor<8>(v); v += lane_xor<16>(v);
    auto rr = __builtin_amdgcn_permlane32_swap(__float_as_uint(v), __float_as_uint(v), false, false);
    return __uint_as_float(rr[0]) + __uint_as_float(rr[1]);
}
__device__ __forceinline__ int crow(int r, int hi) { return (r & 3) + 8 * (r >> 2) + 4 * hi; }
#define XB_TMO      128
#define XB_XCNT(j)  (256  + 64 * (j))
#define XB_XSUB(j)  (1280 + 64 * (j))
#define XB_XGEN(j)  (2304 + 64 * (j))
#define XB_TOP      3328
#define XB_TOPGEN   3392
#define XCD_BAR_WORDS 3456
#define XB_SPIN_CAP (1u << 18)

__device__ __forceinline__ unsigned xb_ld(unsigned* p)              { return __hip_atomic_load(p, __ATOMIC_RELAXED, __HIP_MEMORY_SCOPE_AGENT); }
__device__ __forceinline__ unsigned xb_add(unsigned* p, unsigned v) { return __hip_atomic_fetch_add(p, v, __ATOMIC_RELAXED, __HIP_MEMORY_SCOPE_AGENT); }
__device__ __forceinline__ unsigned xb_xcc_id() { return (unsigned)__builtin_amdgcn_s_getreg((3 << 11) | 20) & 0xFu; }
#define XB_SPIN(cond, bar) do { unsigned _sp = 0; while (cond) { __builtin_amdgcn_s_sleep(1); \
    if ((++_sp & 255u) == 0u) { if (xb_ld(&(bar)[XB_TMO])) break; if (_sp > XB_SPIN_CAP) { atomicAdd(&(bar)[XB_TMO], 1u); break; } } } } while (0)

struct XcdBarrier {
    unsigned* bar; unsigned x;
    volatile LAS unsigned* st;
};

__device__ __forceinline__ XcdBarrier xcd_barrier_post(unsigned* bar, volatile LAS unsigned* st) {
    XcdBarrier b; b.bar = bar; b.x = xb_xcc_id(); b.st = st;
    if (threadIdx.x == 0) (void)xb_add(&bar[XB_XCNT(b.x)], 1u);
    return b;
}
__device__ __forceinline__ void xcd_barrier_complete(unsigned* bar, unsigned x, unsigned& nloc, unsigned& nx) {
    const unsigned G = gridDim.x * gridDim.y * gridDim.z;
    unsigned sum, cnt, mine, sp = 0u;
    for (;;) {
        sum = 0u; cnt = 0u; mine = 0u;
#pragma unroll
        for (unsigned j = 0; j < 16; ++j) { const unsigned c = xb_ld(&bar[XB_XCNT(j)]); sum += c; cnt += (c > 0u) ? 1u : 0u; mine = (j == x) ? c : mine; }
        if (sum == G) break;
        __builtin_amdgcn_s_sleep(1);
        if ((++sp & 255u) == 0u) { if (xb_ld(&bar[XB_TMO])) break; if (sp > XB_SPIN_CAP) { atomicAdd(&bar[XB_TMO], 1u); break; } }
    }
    nloc = mine > 0u ? mine : 1u; nx = cnt > 0u ? cnt : 1u;
}

__device__ __forceinline__ void xcd_barrier(const XcdBarrier& b) {
    asm volatile("s_waitcnt vmcnt(0)" ::: "memory");
    __syncthreads();
    if (threadIdx.x == 0) {
        unsigned* bar = b.bar;
        __builtin_amdgcn_s_waitcnt(0);
        unsigned nloc = b.st[0], nx = b.st[1];
        if (nloc == 0u) { xcd_barrier_complete(bar, b.x, nloc, nx); b.st[0] = nloc; b.st[1] = nx; }
        const unsigned old = xb_add(&bar[XB_XSUB(b.x)], 1u);
        const unsigned gen = old / nloc;
        if (old + 1u == (gen + 1u) * nloc) {
            __builtin_amdgcn_fence(__ATOMIC_RELEASE, "agent");
            asm volatile("s_waitcnt vmcnt(0)" ::: "memory");
            const unsigned og = xb_add(&bar[XB_TOP], 1u);
            const unsigned tg = og / nx;
            if (og + 1u == (tg + 1u) * nx) xb_add(&bar[XB_TOPGEN], 1u);
            else XB_SPIN(xb_ld(&bar[XB_TOPGEN]) == tg, bar);
            __builtin_amdgcn_fence(__ATOMIC_ACQUIRE, "agent");
            xb_add(&bar[XB_XGEN(b.x)], 1u);
            asm volatile("s_waitcnt vmcnt(0)" ::: "memory");
        } else {
            XB_SPIN(xb_ld(&bar[XB_XGEN(b.x)]) == gen, bar);
            __builtin_amdgcn_fence(__ATOMIC_ACQUIRE, "agent");
            asm volatile("s_waitcnt vmcnt(0)" ::: "memory");
        }
    }
    __syncthreads();
}

struct XposeRegs { f32x4 v[8]; };
__device__ __forceinline__ void xpose_load(XposeRegs& R, const float* W, int K, int N, int item, int lane) {
    const int nblk = N / 32, kb = item / nblk, nb = item % nblk, k0 = 64 * kb, n0 = 32 * nb; (void)K;
    const float* p = W + (size_t)(k0 + (lane >> 3)) * N + n0 + (lane & 7) * 4;
#pragma unroll
    for (int i = 0; i < 8; ++i) R.v[i] = __builtin_nontemporal_load((const GAS f32x4*)(p + (size_t)(8 * i) * N));
}
__device__ __forceinline__ void xpose_store(const XposeRegs& R, int K, int N, bf16_t* WT, int row_off, int row_mul, LAS float* scr, int item, int lane, const float* kgain = nullptr) {
    const int nblk = N / 32, kb = item / nblk, nb = item % nblk, k0 = 64 * kb, n0 = 32 * nb;
#pragma unroll
    for (int i = 0; i < 8; ++i) { LAS float* d = scr + (8 * i + (lane >> 3)) * 33 + (lane & 7) * 4; d[0] = R.v[i].x; d[1] = R.v[i].y; d[2] = R.v[i].z; d[3] = R.v[i].w; }
    LDS_WAIT(); asm volatile("" ::: "memory");
    const int c = lane & 7;
    f32x4 g0 = {1.f, 1.f, 1.f, 1.f}, g1 = g0;
    if (kgain) { g0 = *(const GAS f32x4*)(kgain + k0 + 8 * c); g1 = *(const GAS f32x4*)(kgain + k0 + 8 * c + 4); }
#pragma unroll
    for (int j = 0; j < 4; ++j) { const int n = (lane >> 3) + 8 * j; const LAS float* s = scr + (8 * c) * 33 + n;
        u32x4 o; o.x = cvtpk(s[0 * 33] * g0.x, s[1 * 33] * g0.y); o.y = cvtpk(s[2 * 33] * g0.z, s[3 * 33] * g0.w); o.z = cvtpk(s[4 * 33] * g1.x, s[5 * 33] * g1.y); o.w = cvtpk(s[6 * 33] * g1.z, s[7 * 33] * g1.w);
        *(GAS u32x4*)(WT + (size_t)(row_off + (n0 + n) * row_mul) * K + k0 + 8 * c) = o; }
    LDS_WAIT(); asm volatile("" ::: "memory");
}
__device__ __forceinline__ void xpose_store_f8(const XposeRegs& R, int K, int N, unsigned char* WT, int row_off, int row_mul, LAS float* scr, int item, int lane, float scale, const float* kgain = nullptr) {
    const int nblk = N / 32, kb = item / nblk, nb = item % nblk, k0 = 64 * kb, n0 = 32 * nb;
#pragma unroll
    for (int i = 0; i < 8; ++i) { LAS float* d = scr + (8 * i + (lane >> 3)) * 33 + (lane & 7) * 4; d[0] = R.v[i].x; d[1] = R.v[i].y; d[2] = R.v[i].z; d[3] = R.v[i].w; }
    LDS_WAIT(); asm volatile("" ::: "memory");
    const int c = lane & 7;
    f32x4 g0 = {scale, scale, scale, scale}, g1 = g0;
    if (kgain) { g0 = *(const GAS f32x4*)(kgain + k0 + 8 * c) * scale; g1 = *(const GAS f32x4*)(kgain + k0 + 8 * c + 4) * scale; }
#pragma unroll
    for (int j = 0; j < 4; ++j) { const int n = (lane >> 3) + 8 * j; const LAS float* s = scr + (8 * c) * 33 + n;
        u32x2 o; o.x = pk4_fp8(s[0 * 33] * g0.x, s[1 * 33] * g0.y, s[2 * 33] * g0.z, s[3 * 33] * g0.w); o.y = pk4_fp8(s[4 * 33] * g1.x, s[5 * 33] * g1.y, s[6 * 33] * g1.z, s[7 * 33] * g1.w);
        *(GAS u32x2*)(WT + (size_t)(row_off + (n0 + n) * row_mul) * K + k0 + 8 * c) = o; }
    LDS_WAIT(); asm volatile("" ::: "memory");
}
template <int NR>
__device__ __forceinline__ void rms_rows_to_bf16(const float* X, const float* gain, bf16_t* O, int m0, int stride, int lane, float eps) {
    f32x4 v[NR][4]; float s[NR];
#pragma unroll
    for (int i = 0; i < NR; ++i) { const GAS f32x4* xr = (const GAS f32x4*)(X + (size_t)(m0 + i * stride) * D) + lane;
#pragma unroll
        for (int j = 0; j < 4; ++j) v[i][j] = xr[64 * j]; }
#pragma unroll
    for (int i = 0; i < NR; ++i) { float t = 0.f;
#pragma unroll
        for (int j = 0; j < 4; ++j) t += (v[i][j].x * v[i][j].x + v[i][j].y * v[i][j].y) + (v[i][j].z * v[i][j].z + v[i][j].w * v[i][j].w);
        s[i] = t; }
#pragma unroll
    for (int i = 0; i < NR; ++i) s[i] = 1.f / sqrtf(wave_sum(s[i]) * (1.f / 1024.f) + eps);
#pragma unroll
    for (int j = 0; j < 4; ++j) { const f32x4 g = ((const GAS f32x4*)gain)[64 * j + lane];
#pragma unroll
        for (int i = 0; i < NR; ++i) { u32x2 w; w.x = cvtpk(v[i][j].x * s[i] * g.x, v[i][j].y * s[i] * g.y); w.y = cvtpk(v[i][j].z * s[i] * g.z, v[i][j].w * s[i] * g.w);
            ((GAS u32x2*)(O + (size_t)(m0 + i * stride) * D) + lane)[64 * j] = w; } }
}

struct EpiInProj {
    static constexpr bool PERM = true, AFTER_DRAIN = false;
    bf16_t *QH, *VH, *SG, *QD, *KD, *VD; half_t *GF, *GB; const float* lbraw; const float *cosT, *sinT;
    __device__ __forceinline__ void operator()(const pg8::f32x4 (&acc)[2][2][4][2], const pg8::Unit& u, int wr, int wc, int fr, int fq) const {
        const int sec = u.pn >> 1;
        const int row0 = u.pm * 256 + wr * 64 + fr;
        const int cs0 = (u.pn & 1) * 256 + wc * 32 + 8 * fq;
        if (sec == 1 || sec == 2) {
            half_t* G = sec == 1 ? GF : GB; const float* lbp = lbraw + (sec - 1) * 1024;
#pragma unroll
            for (int bj = 0; bj < 2; ++bj) { const int c = cs0 + bj * 128; float lb[8];
#pragma unroll
                for (int j = 0; j < 8; ++j) { const float l0 = lbp[c + j], l1 = lbp[512 + c + j]; lb[j] = __builtin_amdgcn_rcpf(1.f + ex2(1.4426950408889634f * (l0 - l1))); }
#pragma unroll
                for (int ai = 0; ai < 2; ++ai)
#pragma unroll
                    for (int m = 0; m < 4; ++m) { const int row = row0 + ai * 128 + m * 16; f32x4 o0, o1;
#pragma unroll
                        for (int j = 0; j < 4; ++j) { o0[j] = lb[j] + (1.f - lb[j]) * sigmoidf_(acc[ai][bj][m][0][j]); o1[j] = lb[4 + j] + (1.f - lb[4 + j]) * sigmoidf_(acc[ai][bj][m][1][j]); }
                        typedef _Float16 h8 __attribute__((ext_vector_type(8)));
                        const h8 hv = {(_Float16)o0[0], (_Float16)o0[1], (_Float16)o0[2], (_Float16)o0[3], (_Float16)o1[0], (_Float16)o1[1], (_Float16)o1[2], (_Float16)o1[3]};
                        *(h8*)(G + (size_t)row * HSEC + c) = hv; } }
            return;
        }
        bf16_t* O = sec == 0 ? QH : sec == 3 ? VH : sec == 4 ? SG : sec == 5 ? QD : sec == 6 ? KD : VD;
        const bool rot = (sec == 5 || sec == 6) && ((wc & 1) == 0);
        const float sc = sec == 5 ? QSCALE : 1.f;
#pragma unroll
        for (int ai = 0; ai < 2; ++ai)
#pragma unroll
            for (int m = 0; m < 4; ++m) { const int row = row0 + ai * 128 + m * 16;
#pragma unroll
                for (int bj = 0; bj < 2; ++bj) { const int c = cs0 + bj * 128; float v[8];
#pragma unroll
                    for (int j = 0; j < 4; ++j) { v[j] = acc[ai][bj][m][0][j]; v[4 + j] = acc[ai][bj][m][1][j]; }
                    if (sec == 4) {
#pragma unroll
                        for (int j = 0; j < 8; ++j) v[j] = v[j] * sigmoidf_(v[j]);
                    }
                    if (rot) {
                        const f32x4 c0 = *(const f32x4*)(cosT + (size_t)row * 8), c1 = *(const f32x4*)(cosT + (size_t)row * 8 + 4);
                        const f32x4 s0 = *(const f32x4*)(sinT + (size_t)row * 8), s1 = *(const f32x4*)(sinT + (size_t)row * 8 + 4);
#pragma unroll
                        for (int j = 0; j < 8; ++j) { const float p = lane_xor<16>(v[j]); const float cj = j < 4 ? c0[j & 3] : c1[j & 3], sj = j < 4 ? s0[j & 3] : s1[j & 3];
                            const float r = fq == 0 ? v[j] * cj - p * sj : v[j] * cj + p * sj; v[j] = fq < 2 ? r : v[j]; }
                    }
                    u32x4 w; w.x = cvtpk(v[0] * sc, v[1] * sc); w.y = cvtpk(v[2] * sc, v[3] * sc); w.z = cvtpk(v[4] * sc, v[5] * sc); w.w = cvtpk(v[6] * sc, v[7] * sc);
                    *(u32x4*)(O + (size_t)row * HSEC + c) = w; } }
    }
};
struct EpiResid {
    static constexpr bool PERM = true, AFTER_DRAIN = false;
    const float* X; bf16_t* O; unsigned char* O8;
    __device__ __forceinline__ void operator()(const pg8::f32x4 (&acc)[2][2][4][2], const pg8::Unit& u, int wr, int wc, int fr, int fq) const {
        const int row0 = u.pm * 256 + wr * 64 + fr, col0 = u.pn * 256 + wc * 32 + 8 * fq;
#pragma unroll
        for (int ai = 0; ai < 2; ++ai)
#pragma unroll
            for (int m = 0; m < 4; ++m) { const size_t off = (size_t)(row0 + ai * 128 + m * 16) * D + col0;
#pragma unroll
                for (int bj = 0; bj < 2; ++bj) { const f32x4 a = *(const f32x4*)(X + off + bj * 128) + acc[ai][bj][m][0], b = *(const f32x4*)(X + off + bj * 128 + 4) + acc[ai][bj][m][1];
                    u32x4 w; w.x = cvtpk(a[0], a[1]); w.y = cvtpk(a[2], a[3]); w.z = cvtpk(b[0], b[1]); w.w = cvtpk(b[2], b[3]); *(u32x4*)(O + off + bj * 128) = w;
                    u32x2 f; f.x = pk4_fp8(a[0], a[1], a[2], a[3]); f.y = pk4_fp8(b[0], b[1], b[2], b[3]); *(u32x2*)(O8 + off + bj * 128) = f; } }
    }
};
struct EpiSwiGlu {
    static constexpr bool PERM = true, AFTER_DRAIN = false;
    unsigned char* O; const float* RS;
    __device__ __forceinline__ void operator()(const pg8::f32x4 (&acc)[2][2][4][2], const pg8::Unit& u, int wr, int wc, int fr, int fq) const {
        const int row0 = u.pm * 256 + wr * 64 + fr, col0 = ((u.pn & 3) * 256 + wc * 32 + 8 * fq) >> 1;
#pragma unroll
        for (int ai = 0; ai < 2; ++ai)
#pragma unroll
            for (int m = 0; m < 4; ++m) { const int row = row0 + ai * 128 + m * 16; const float rs = RS[row] * (1.f / F8_WSCALE); unsigned char* rowp = O + (size_t)row * DEXP + col0;
#pragma unroll
                for (int bj = 0; bj < 2; ++bj) { const f32x4 a = acc[ai][bj][m][0] * rs, b = acc[ai][bj][m][1] * rs;
                    const float h0 = a[0] * sigmoidf_(a[0]) * a[1], h1 = a[2] * sigmoidf_(a[2]) * a[3], h2 = b[0] * sigmoidf_(b[0]) * b[1], h3 = b[2] * sigmoidf_(b[2]) * b[3];
                    *(unsigned*)(rowp + bj * 64) = pk4_fp8(__builtin_amdgcn_fmed3f(h0 * F8_HSCALE, -448.f, 448.f), __builtin_amdgcn_fmed3f(h1 * F8_HSCALE, -448.f, 448.f), __builtin_amdgcn_fmed3f(h2 * F8_HSCALE, -448.f, 448.f), __builtin_amdgcn_fmed3f(h3 * F8_HSCALE, -448.f, 448.f)); } }
    }
};
struct EpiDown {
    static constexpr bool PERM = true, AFTER_DRAIN = false;
    unsigned char* O;
    __device__ __forceinline__ void operator()(const pg8::f32x4 (&acc)[2][2][4][2], const pg8::Unit& u, int wr, int wc, int fr, int fq) const {
        const int row0 = u.pm * 256 + wr * 64 + fr, col0 = (u.pn & 3) * 256 + wc * 32 + 8 * fq; constexpr float us = F8_YSCALE / (F8_WSCALE * F8_HSCALE);
#pragma unroll
        for (int ai = 0; ai < 2; ++ai)
#pragma unroll
            for (int m = 0; m < 4; ++m) { unsigned char* rowp = O + (size_t)(row0 + ai * 128 + m * 16) * D + col0;
#pragma unroll
                for (int bj = 0; bj < 2; ++bj) { const f32x4 a = acc[ai][bj][m][0] * us, b = acc[ai][bj][m][1] * us;
                    u32x2 w; w.x = pk4_fp8(__builtin_amdgcn_fmed3f(a[0], -448.f, 448.f), __builtin_amdgcn_fmed3f(a[1], -448.f, 448.f), __builtin_amdgcn_fmed3f(a[2], -448.f, 448.f), __builtin_amdgcn_fmed3f(a[3], -448.f, 448.f));
                    w.y = pk4_fp8(__builtin_amdgcn_fmed3f(b[0], -448.f, 448.f), __builtin_amdgcn_fmed3f(b[1], -448.f, 448.f), __builtin_amdgcn_fmed3f(b[2], -448.f, 448.f), __builtin_amdgcn_fmed3f(b[3], -448.f, 448.f));
                    *(u32x2*)(rowp + bj * 128) = w; } }
    }
};
struct MoeOrder {
    const volatile LAS int* tb; int G, c; const int* PERM; unsigned* ready; int mode;
    __device__ __forceinline__ bool decode(int L, pg8::Unit& u) const {
        const int x = c & 7; int base = 0;
#pragma unroll 1
        for (int k = 0; k < 4; ++k) { const int e = 4 * x + k, t0 = __builtin_amdgcn_readfirstlane(tb[e]), nt = __builtin_amdgcn_readfirstlane(tb[e + 1]) - t0;
            if (L < base + 4 * nt) { const int idx = L - base; u.pm = t0 + idx % nt; u.pn = e * 4 + idx / nt; return true; }
            base += 4 * nt; }
        return false;
    }
    __device__ __forceinline__ bool next(int i, pg8::Unit& u) const {
        if ((G & 7) == 0) {
            const int x = c & 7, s = c >> 3, nb = G >> 3;
            const int U = 4 * (__builtin_amdgcn_readfirstlane(tb[4 * x + 4]) - __builtin_amdgcn_readfirstlane(tb[4 * x]));
            if (mode == 0) return decode(i * nb + s, u);
            const int i0 = s < U ? (U - s + nb - 1) / nb : 0;
            return decode((i0 + i) * nb + s - U, u);
        }
        const int L = i * G + c, T = __builtin_amdgcn_readfirstlane(tb[32]); if (L >= 4 * T) return false;
        const int tile = L >> 2; int e = 0;
#pragma unroll 1
        for (int j = 1; j < 32; ++j) e += (__builtin_amdgcn_readfirstlane(tb[j]) <= tile) ? 1 : 0;
        u.pm = tile; u.pn = e * 4 + (L & 3); return true;
    }
    __device__ __forceinline__ int row_tok(const pg8::Unit& u, int r) const {
        const int e = u.pn >> 2, rem = __builtin_amdgcn_readfirstlane(tb[64 + e]) - (u.pm - __builtin_amdgcn_readfirstlane(tb[e])) * 256;
        return r < rem ? PERM[u.pm * 256 + r] : 0;
    }
    __device__ __forceinline__ bool half_only(const pg8::Unit&) const { return false; }
    __device__ __forceinline__ void done(const pg8::Unit& u) const {
        if (mode == 2) { asm volatile("s_waitcnt vmcnt(0)" ::: "memory");
            if ((threadIdx.x & 63) == 0) __hip_atomic_fetch_add(ready + 64 * u.pm, 1u, __ATOMIC_RELAXED, __HIP_MEMORY_SCOPE_AGENT); }
    }
    __device__ __forceinline__ void a_ready(const pg8::Unit& u) const {
        if (mode == 1) {
            if (threadIdx.x < 64) { const unsigned long long t0 = __builtin_amdgcn_s_memrealtime();
                while ((unsigned)__builtin_amdgcn_readfirstlane(__hip_atomic_load(ready + 64 * u.pm, __ATOMIC_RELAXED, __HIP_MEMORY_SCOPE_AGENT)) < 32u) {
                    if (__builtin_amdgcn_s_memrealtime() - t0 > 2000000ull) break;
                    __builtin_amdgcn_s_sleep(2); }
                __builtin_amdgcn_fence(__ATOMIC_ACQUIRE, "agent");
                asm volatile("s_waitcnt vmcnt(0)" ::: "memory"); }
            asm volatile("" ::: "memory"); __builtin_amdgcn_s_barrier(); asm volatile("" ::: "memory");
        }
    }
};
namespace pg8 {
template <class Epi, class Sched, bool ALIGN_EPI = false, bool SP2 = false, bool F8 = false>
__device__ __forceinline__ void gemm_phase_g(PG8_LAS unsigned char* lds, const Gemm g, const Sched& S, const Epi& E) {
    const int tid = opaque_tid(), wid = __builtin_amdgcn_readfirstlane(tid >> 6), lane = tid & 63, wr = wid >> 2, wc = wid & 3, fr = lane & 15, fq = lane >> 4;
    const int K = g.K, nt = K / BK;
    unsigned voffB[2]; int rowA[2]; unsigned colA[2];
#pragma unroll
    for (int i = 0; i < 2; ++i) { int R, C; stage_rc(tid * 16 + i * 8192, R, C); const int Rb = Epi::PERM ? ((R & ~31) + perm32(R & 31)) : R;
        rowA[i] = R; colA[i] = (unsigned)C * 2u; voffB[i] = (unsigned)(Rb * K + C) * 2u; }
    unsigned vAc[2][2], vAn[2][2];
#define PG8_GATHER(dst, u) do { _Pragma("unroll") for (int h_ = 0; h_ < 2; ++h_) _Pragma("unroll") for (int i_ = 0; i_ < 2; ++i_) dst[h_][i_] = (unsigned)S.row_tok(u, h_ * HALF + rowA[i_]) * (unsigned)(K * 2) + colA[i_]; } while (0)
    const size_t kstep = (size_t)(BK * 2);
    const size_t hstep = (size_t)HALF * K * 2;
    const size_t tstep = 2 * hstep;
    const unsigned ldsw = (unsigned)wid * 1024u;
    const int aoff = lds_byte(wr * 64 + fr, fq * 8), boff = lds_byte(wc * 32 + fr, fq * 8);
#define PG8_SA(b, h) (((b) * 2 + (h)) * HTB)
#define PG8_SB(b, h) ((4 + (b) * 2 + (h)) * HTB)
#define PG8_STAGE(bufoff, gbase, voff) do { _Pragma("unroll") for (int _i = 0; _i < 2; ++_i) \
        __builtin_amdgcn_global_load_lds((const unsigned*)((const char*)(gbase) + (voff)[_i]), (PG8_LAS unsigned*)(lds + (bufoff) + ldsw + _i * 8192), 16, 0, 0); } while (0)
#define PG8_LDA(dst, b, h) do { _Pragma("unroll") for (int m = 0; m < 4; ++m) _Pragma("unroll") for (int k = 0; k < 2; ++k) dst[m][k] = *(const PG8_LAS bf16x8*)(lds + PG8_SA(b, h) + aoff + m * 2048 + k * 1024); } while (0)
#define PG8_LDB(dst, b, h) do { _Pragma("unroll") for (int n = 0; n < 2; ++n) _Pragma("unroll") for (int k = 0; k < 2; ++k) dst[n][k] = *(const PG8_LAS bf16x8*)(lds + PG8_SB(b, h) + boff + n * 2048 + k * 1024); } while (0)
#define PG8_MMA(ai, bj, At, Bt) do { __builtin_amdgcn_s_setprio(1); _Pragma("unroll") for (int m = 0; m < 4; ++m) _Pragma("unroll") for (int n = 0; n < 2; ++n) _Pragma("unroll") for (int k = 0; k < 2; ++k) { \
        if constexpr (F8) { typedef long v2l_ __attribute__((ext_vector_type(2))); const v2l_ b_ = __builtin_bit_cast(v2l_, Bt[n][k]), a_ = __builtin_bit_cast(v2l_, At[m][k]); \
            acc[ai][bj][m][n] = __builtin_amdgcn_mfma_f32_16x16x32_fp8_fp8(b_[0], a_[0], acc[ai][bj][m][n], 0, 0, 0); acc[ai][bj][m][n] = __builtin_amdgcn_mfma_f32_16x16x32_fp8_fp8(b_[1], a_[1], acc[ai][bj][m][n], 0, 0, 0); } \
        else acc[ai][bj][m][n] = __builtin_amdgcn_mfma_f32_16x16x32_bf16(Bt[n][k], At[m][k], acc[ai][bj][m][n], 0, 0, 0); } \
        __builtin_amdgcn_s_setprio(0); } while (0)
#define PG8_WAIT_V(n) asm volatile("s_waitcnt vmcnt(" #n ")" ::: "memory")
#define PG8_WAIT_L(n) asm volatile("s_waitcnt lgkmcnt(" #n ")" ::: "memory")
#define PG8_BAR __builtin_amdgcn_s_barrier()
#define PG8_SCHED __builtin_amdgcn_sched_barrier(0)
    Unit cur, nxt; int ui = 0;
    if (!S.next(0, cur)) return;
    f32x4 acc[2][2][4][2];
#pragma unroll
    for (int a = 0; a < 2; ++a)
#pragma unroll
        for (int b = 0; b < 2; ++b)
#pragma unroll
            for (int m = 0; m < 4; ++m)
#pragma unroll
                for (int n = 0; n < 2; ++n) acc[a][b][m][n] = (f32x4){0.f, 0.f, 0.f, 0.f};
    bf16x8 At[4][2], B0[2][2], B1[2][2];
    const char* cA = (const char*)g.A; PG8_GATHER(vAc, cur); const char* cB = (const char*)g.Bt + (size_t)cur.pn * tstep;
    S.a_ready(cur);
    if constexpr (SP2) {
        PG8_STAGE(PG8_SB(0, 0), cB, voffB); PG8_STAGE(PG8_SB(0, 1), cB + hstep, voffB); PG8_STAGE(PG8_SA(0, 0), cA, vAc[0]); PG8_STAGE(PG8_SA(0, 1), cA, vAc[1]);
        if (wr == 1) PG8_BAR;
        PG8_WAIT_V(2); PG8_BAR;
        PG8_STAGE(PG8_SB(1, 0), cB + kstep, voffB); PG8_STAGE(PG8_SA(1, 0), cA + kstep, vAc[0]); PG8_STAGE(PG8_SB(1, 1), cB + hstep + kstep, voffB);
        PG8_WAIT_V(6); PG8_BAR;
    } else {
        PG8_STAGE(PG8_SB(0, 0), cB, voffB); PG8_STAGE(PG8_SA(0, 0), cA, vAc[0]); PG8_STAGE(PG8_SB(0, 1), cB + hstep, voffB); PG8_STAGE(PG8_SA(0, 1), cA, vAc[1]);
        if (wr == 1) PG8_BAR;
        PG8_WAIT_V(4); PG8_BAR;
        PG8_STAGE(PG8_SB(1, 0), cB + kstep, voffB); PG8_STAGE(PG8_SA(1, 0), cA + kstep, vAc[0]); PG8_STAGE(PG8_SB(1, 1), cB + hstep + kstep, voffB);
        PG8_WAIT_V(6); PG8_BAR;
    }
    for (;;) {
        const bool has_next = S.next(ui + 1, nxt);
        const char* nA = cA; if (has_next) PG8_GATHER(vAn, nxt); else { _Pragma("unroll") for (int h_ = 0; h_ < 2; ++h_) _Pragma("unroll") for (int i_ = 0; i_ < 2; ++i_) vAn[h_][i_] = vAc[h_][i_]; } const char* nB = has_next ? (const char*)g.Bt + (size_t)nxt.pn * tstep : cB;
        for (int t = 0; t < nt; t += 2) {
            const bool last = (t == nt - 2);
            const char* a1 = cA + (size_t)(t + 1) * kstep;
            const char* a2 = last ? nA : cA + (size_t)(t + 2) * kstep; const char* b2 = last ? nB : cB + (size_t)(t + 2) * kstep;
            const char* a3 = a2 + kstep; const char* b3 = b2 + kstep;
            unsigned vA2[2][2]; _Pragma("unroll") for (int h_ = 0; h_ < 2; ++h_) _Pragma("unroll") for (int i_ = 0; i_ < 2; ++i_) vA2[h_][i_] = last ? vAn[h_][i_] : vAc[h_][i_];
            if (last && has_next) S.a_ready(nxt);
            if constexpr (SP2) {
            PG8_LDB(B0, 0, 0); PG8_LDB(B1, 0, 1); PG8_SCHED; PG8_LDA(At, 0, 0); PG8_STAGE(PG8_SA(1, 1), a1, vAc[1]);
            PG8_WAIT_V(8); PG8_WAIT_L(0); PG8_BAR; PG8_MMA(0, 0, At, B0); PG8_MMA(0, 1, At, B1); PG8_BAR; PG8_SCHED;
            PG8_LDA(At, 0, 1); PG8_STAGE(PG8_SB(0, 0), b2, voffB); PG8_STAGE(PG8_SB(0, 1), b2 + hstep, voffB); PG8_STAGE(PG8_SA(0, 0), a2, vA2[0]);
            PG8_WAIT_V(8); PG8_WAIT_L(0); PG8_BAR; PG8_MMA(1, 0, At, B0); PG8_MMA(1, 1, At, B1); PG8_BAR; PG8_SCHED;
            PG8_LDB(B0, 1, 0); PG8_LDB(B1, 1, 1); PG8_SCHED; PG8_LDA(At, 1, 0); PG8_STAGE(PG8_SA(0, 1), a2, vA2[1]);
            PG8_WAIT_V(8); PG8_WAIT_L(0); PG8_BAR; PG8_MMA(0, 0, At, B0); PG8_MMA(0, 1, At, B1); PG8_BAR; PG8_SCHED;
            PG8_LDA(At, 1, 1); PG8_STAGE(PG8_SB(1, 0), b3, voffB); PG8_STAGE(PG8_SB(1, 1), b3 + hstep, voffB); PG8_STAGE(PG8_SA(1, 0), a3, vA2[0]);
            PG8_WAIT_V(8); PG8_WAIT_L(0); PG8_BAR; PG8_MMA(1, 0, At, B0); PG8_MMA(1, 1, At, B1); PG8_BAR; PG8_SCHED;
            } else {
            PG8_LDB(B0, 0, 0); PG8_SCHED; PG8_LDA(At, 0, 0); PG8_STAGE(PG8_SA(1, 1), a1, vAc[1]);
            PG8_WAIT_L(8); PG8_BAR; PG8_WAIT_L(0); PG8_MMA(0, 0, At, B0); PG8_BAR; PG8_SCHED;
            PG8_LDB(B1, 0, 1); PG8_STAGE(PG8_SB(0, 0), b2, voffB);
            PG8_BAR; PG8_WAIT_L(0); PG8_MMA(0, 1, At, B1); PG8_BAR;
            PG8_LDA(At, 0, 1); PG8_STAGE(PG8_SA(0, 0), a2, vA2[0]);
            PG8_BAR; PG8_WAIT_L(0); PG8_MMA(1, 0, At, B0); PG8_BAR; PG8_SCHED;
            PG8_STAGE(PG8_SB(0, 1), b2 + hstep, voffB);
            PG8_WAIT_V(6); PG8_BAR; PG8_MMA(1, 1, At, B1); PG8_BAR;
            PG8_LDB(B0, 1, 0); PG8_SCHED; PG8_LDA(At, 1, 0); PG8_STAGE(PG8_SA(0, 1), a2, vA2[1]);
            PG8_WAIT_L(8); PG8_BAR; PG8_WAIT_L(0); PG8_MMA(0, 0, At, B0); PG8_BAR; PG8_SCHED;
            PG8_LDB(B1, 1, 1); PG8_STAGE(PG8_SB(1, 0), b3, voffB);
            PG8_BAR; PG8_WAIT_L(0); PG8_MMA(0, 1, At, B1); PG8_BAR;
            PG8_LDA(At, 1, 1); PG8_STAGE(PG8_SA(1, 0), a3, vA2[0]);
            PG8_BAR; PG8_WAIT_L(0); PG8_MMA(1, 0, At, B0); PG8_BAR; PG8_SCHED;
            PG8_STAGE(PG8_SB(1, 1), b3 + hstep, voffB);
            PG8_WAIT_V(6); PG8_BAR; PG8_MMA(1, 1, At, B1); PG8_BAR;
            }
        }
        if constexpr (ALIGN_EPI) { if (wr == 0) PG8_BAR; }
        if constexpr (!Epi::AFTER_DRAIN) { E(acc, cur, wr, wc, fr, fq); S.done(cur); }
        if (!has_next) break;
#pragma unroll
        for (int a = 0; a < 2; ++a)
#pragma unroll
            for (int b = 0; b < 2; ++b)
#pragma unroll
                for (int m = 0; m < 4; ++m)
#pragma unroll
                    for (int n = 0; n < 2; ++n) acc[a][b][m][n] = (f32x4){0.f, 0.f, 0.f, 0.f};
        cur = nxt; cA = nA; cB = nB; ++ui; _Pragma("unroll") for (int h_ = 0; h_ < 2; ++h_) _Pragma("unroll") for (int i_ = 0; i_ < 2; ++i_) vAc[h_][i_] = vAn[h_][i_];
        if constexpr (ALIGN_EPI) { if (wr == 1) PG8_BAR; }
    }
    PG8_WAIT_V(0);
    if constexpr (!ALIGN_EPI) { if (wr == 0) PG8_BAR; }
    PG8_BAR;
    if constexpr (Epi::AFTER_DRAIN) { E.fused(acc, cur, wr, wc, fr, fq, lds, wid, lane); S.done(cur); }
#undef PG8_GATHER
#undef PG8_SA
#undef PG8_SB
#undef PG8_STAGE
#undef PG8_LDA
#undef PG8_LDB
#undef PG8_MMA
#undef PG8_WAIT_V
#undef PG8_WAIT_L
#undef PG8_BAR
#undef PG8_SCHED
}
}

namespace hg {
typedef short v4i16_t __attribute__((ext_vector_type(4)));
constexpr int S128 = 272, S64 = 144;
constexpr int L_QD = 0, L_QE = L_QD + 64 * S128, L_KE = L_QE + 64 * S128, L_VR = L_KE + 64 * S128, L_ST = L_VR + 64 * S128,
              L_P = L_ST + 128 * S128, L_QS = L_P + 64 * S64, L_DC = L_QS + 16 * 128 * 4, L_END = L_DC + 128 * 4;
static_assert(L_END <= PHASE_LDS, "hgrn LDS");
__device__ __forceinline__ bf16x8 frag(const LAS unsigned char* base, int row, int stride, int kb  ) { return *(const LAS bf16x8*)(base + row * stride + kb); }
__device__ __forceinline__ bf16x8 trfrag(const LAS unsigned char* tile, int tok0, int chan0, int lane) {
    const LAS unsigned char* p = tile + (tok0 + 8 * (lane >> 5) + ((lane & 15) >> 2)) * S128 + (chan0 + 16 * ((lane >> 4) & 1) + 4 * (lane & 3)) * 2;
    const s16x4 lo = __builtin_bit_cast(s16x4, __builtin_amdgcn_ds_read_tr16_b64_v4i16((LAS v4i16_t*)p)), hi = __builtin_bit_cast(s16x4, __builtin_amdgcn_ds_read_tr16_b64_v4i16((LAS v4i16_t*)(p + 4 * S128)));
    return (bf16x8){lo[0], lo[1], lo[2], lo[3], hi[0], hi[1], hi[2], hi[3]};
}

template <bool PASS_C, int ABL = 0>
__device__ __forceinline__ void pass(LAS unsigned char* lds, int unit, const bf16_t* QH, const bf16_t* VH, const half_t* GF, const half_t* GB,
                                     float* HL, float* HD, const float* HS, float* OF, float* OB) {
    typedef _Float16 h4 __attribute__((ext_vector_type(4)));
    const int tid = opaque_tid(), lane = tid & 63, wid = __builtin_amdgcn_readfirstlane(tid >> 6), r32 = lane & 31, hi = lane >> 5;
    const int dir = unit >> 7, head = (unit >> 5) & 3, sc = unit & 31;
    const int kq = tid & 31, tq = tid >> 5;
    const half_t* G = dir ? GB : GF; float* O = dir ? OB : OF;
    const int vi = wid >> 1, ki0 = (wid & 1) * 2;
    f32x16 sacc[2];
    LAS f32x4* QS = (LAS f32x4*)(lds + L_QS); LAS float* DC = (LAS float*)(lds + L_DC);
    if (PASS_C) {
        const float* hs = HS + (size_t)unit * 16384;
#pragma unroll
        for (int tt = 0; tt < 2; ++tt)
#pragma unroll
            for (int r = 0; r < 16; r += 2) { const int v = vi * 32 + crow(r, hi), kk = (ki0 + tt) * 32 + r32; const float s0 = hs[v * 128 + kk], s1 = hs[(v + 1) * 128 + kk]; sacc[tt][r] = s0; sacc[tt][r + 1] = s1;
                const unsigned w = cvtpk(s0, s1); *(LAS bf16_t*)(lds + L_ST + v * S128 + kk * 2) = (bf16_t)(w & 0xffffu); *(LAS bf16_t*)(lds + L_ST + (v + 1) * S128 + kk * 2) = (bf16_t)(w >> 16); }
    } else { sacc[0] = f32x16{}; sacc[1] = f32x16{}; }
    f32x4 btot = {1.f, 1.f, 1.f, 1.f};
    h4 gh[4]; u32x2 qv[4], vv[4];
#define HG_LOAD(c_) do { const int tb_ = sc * 512 + (c_) * 64 + 4 * tq; _Pragma("unroll") for (int i = 0; i < 4; ++i) { const int tl = tb_ + i, tok = dir ? (M - 1 - tl) : tl; \
        const size_t off = (size_t)tok * HSEC + head * 128 + 4 * kq; gh[i] = *(const h4*)(G + off); vv[i] = *(const u32x2*)(VH + off); if (PASS_C) qv[i] = *(const u32x2*)(QH + off); } } while (0)
    HG_LOAD(0);
#pragma unroll 1
    for (int c = 0; c < 8; ++c) {
        const int t0 = sc * 512 + c * 64;
        f32x4 g[4], b[4];
#pragma unroll
        for (int i = 0; i < 4; ++i) { g[i] = (f32x4){(float)gh[i][0], (float)gh[i][1], (float)gh[i][2], (float)gh[i][3]}; b[i] = i ? b[i - 1] * g[i] : g[i]; }
        QS[tq * 32 + kq] = b[3];
        LDS_WAIT(); __syncthreads();
        if (tid < 128) { LAS float* qs = (LAS float*)QS; float run = 1.f;
#pragma unroll
            for (int q = 0; q < 16; ++q) { const float t = qs[q * 128 + tid]; qs[q * 128 + tid] = run; run *= t; }
            DC[tid] = run; }
        LDS_WAIT(); __syncthreads();
        const f32x4 pre = QS[tq * 32 + kq], etot = *(const LAS f32x4*)(DC + 4 * kq);
        btot *= etot;
        f32x4 itot; itot[0] = __builtin_amdgcn_rcpf(etot[0]); itot[1] = __builtin_amdgcn_rcpf(etot[1]); itot[2] = __builtin_amdgcn_rcpf(etot[2]); itot[3] = __builtin_amdgcn_rcpf(etot[3]);
#pragma unroll
        for (int i = 0; i < 4; ++i) { const int tr = 4 * tq + i; float ke[4], qd[4], qe[4];
            const float q4[4] = {bflo(qv[i].x), bfhi(qv[i].x), bflo(qv[i].y), bfhi(qv[i].y)};
#pragma unroll
            for (int cc = 0; cc < 4; ++cc) { const float pb = b[i][cc] * pre[cc];
                ke[cc] = (1.f - g[i][cc]) * etot[cc] * __builtin_amdgcn_rcpf(pb);
                if (PASS_C) { qd[cc] = q4[cc] * pb; qe[cc] = qd[cc] * itot[cc]; } }
            *(LAS u32x2*)(lds + L_KE + tr * S128 + kq * 8) = (u32x2){cvtpk(ke[0], ke[1]), cvtpk(ke[2], ke[3])};
            *(LAS u32x2*)(lds + L_VR + tr * S128 + kq * 8) = vv[i];
            if (PASS_C) { *(LAS u32x2*)(lds + L_QD + tr * S128 + kq * 8) = (u32x2){cvtpk(qd[0], qd[1]), cvtpk(qd[2], qd[3])};
                *(LAS u32x2*)(lds + L_QE + tr * S128 + kq * 8) = (u32x2){cvtpk(qe[0], qe[1]), cvtpk(qe[2], qe[3])}; } }
        LDS_WAIT(); __syncthreads();
        if (c < 7 && !(ABL & 2)) HG_LOAD(c + 1);
        if (PASS_C && !(ABL & 4)) {
            if (wid < 4) {
                const int ti = wid >> 1, si = wid & 1; f32x16 p = f32x16{};
                if (!(ti == 0 && si == 1)) {
#pragma unroll
                    for (int ks = 0; ks < 8; ++ks) p = __builtin_amdgcn_mfma_f32_32x32x16_bf16(frag(lds + L_QE, ti * 32 + r32, S128, ks * 32 + hi * 16), frag(lds + L_KE, si * 32 + r32, S128, ks * 32 + hi * 16), p, 0, 0, 0);
                }
#pragma unroll
                for (int r = 0; r < 16; r += 2) { const int t = ti * 32 + crow(r, hi), s = si * 32 + r32; const unsigned w = cvtpk(s <= t ? p[r] : 0.f, s <= t + 1 ? p[r + 1] : 0.f);
                    *(LAS bf16_t*)(lds + L_P + t * S64 + s * 2) = (bf16_t)(w & 0xffffu); *(LAS bf16_t*)(lds + L_P + (t + 1) * S64 + s * 2) = (bf16_t)(w >> 16); }
            }
            LDS_WAIT(); __syncthreads();
            { const int ti = wid >> 2, vo = wid & 3; f32x16 o = f32x16{};
#pragma unroll
                for (int ks = 0; ks < 8; ++ks) o = __builtin_amdgcn_mfma_f32_32x32x16_bf16(frag(lds + L_QD, ti * 32 + r32, S128, ks * 32 + hi * 16), frag(lds + L_ST, vo * 32 + r32, S128, ks * 32 + hi * 16), o, 0, 0, 0);
#pragma unroll
                for (int ss = 0; ss < 4; ++ss) o = __builtin_amdgcn_mfma_f32_32x32x16_bf16(frag(lds + L_P, ti * 32 + r32, S64, ss * 32 + hi * 16), trfrag(lds + L_VR, ss * 16, vo * 32, lane), o, 0, 0, 0);
#pragma unroll
                for (int r = 0; r < 16; ++r) { const int tl = t0 + ti * 32 + crow(r, hi), tok = dir ? (M - 1 - tl) : tl; if (!(ABL & 1)) O[(size_t)tok * HSEC + head * 128 + vo * 32 + r32] = o[r]; else asm volatile("" :: "v"(o[r])); }
            }
        }
#pragma unroll
        for (int tt = 0; tt < ((ABL & 4) ? 0 : 2); ++tt) { const int ki = ki0 + tt; const float d = DC[ki * 32 + r32];
#pragma unroll
            for (int r = 0; r < 16; ++r) sacc[tt][r] *= d;
#pragma unroll
            for (int ss = 0; ss < 4; ++ss) sacc[tt] = __builtin_amdgcn_mfma_f32_32x32x16_bf16(trfrag(lds + L_VR, ss * 16, vi * 32, lane), trfrag(lds + L_KE, ss * 16, ki * 32, lane), sacc[tt], 0, 0, 0);
        }
        LDS_WAIT(); __syncthreads();
        if (PASS_C) {
#pragma unroll
            for (int tt = 0; tt < 2; ++tt)
#pragma unroll
                for (int r = 0; r < 16; r += 2) { const int v = vi * 32 + crow(r, hi), kk = (ki0 + tt) * 32 + r32; const unsigned w = cvtpk(sacc[tt][r], sacc[tt][r + 1]);
                    *(LAS bf16_t*)(lds + L_ST + v * S128 + kk * 2) = (bf16_t)(w & 0xffffu); *(LAS bf16_t*)(lds + L_ST + (v + 1) * S128 + kk * 2) = (bf16_t)(w >> 16); }
        }
    }
#undef HG_LOAD
    if (!PASS_C) {
        float* hl = HL + (size_t)unit * 16384;
#pragma unroll
        for (int tt = 0; tt < 2; ++tt)
#pragma unroll
            for (int r = 0; r < 16; ++r) { const int v = vi * 32 + crow(r, hi), kk = (ki0 + tt) * 32 + r32; hl[v * 128 + kk] = sacc[tt][r]; }
        if (tq == 0) *(f32x4*)(HD + unit * 128 + 4 * kq) = btot;
    }
    __syncthreads();
}
__device__ __forceinline__ void scan(const float* HL, const float* HD, float* HS, int gtid, int gthreads) {
    for (int id = gtid; id < 8 * 16384; id += gthreads) {
        const int dh = id >> 14, e = id & 16383, k = e & 127; float S = 0.f;
        float hl[32], hd[32];
#pragma unroll
        for (int sc = 0; sc < 32; ++sc) { const int u = dh * 32 + sc; hl[sc] = HL[(size_t)u * 16384 + e]; hd[sc] = HD[u * 128 + k]; }
#pragma unroll
        for (int sc = 0; sc < 32; ++sc) { const int u = dh * 32 + sc; HS[(size_t)u * 16384 + e] = S; S = hd[sc] * S + hl[sc]; }
    }
}
}

namespace att {
__device__ __forceinline__ void hgrn_finalize(int h, int q0, const float* OF, const float* OB, const bf16_t* SG, const float* gain, bf16_t* MIX, int wid, int lane) {
    const float g0 = gain[2 * lane], g1 = gain[2 * lane + 1];
#pragma unroll 1
    for (int i0 = 0; i0 < 32; i0 += 4) { float2 a[4], b[4]; unsigned sg[4]; float x0[4], x1[4], ss[4];
#pragma unroll
        for (int i = 0; i < 4; ++i) { const size_t off = (size_t)(q0 + wid * 32 + i0 + i) * HSEC + h * 128 + 2 * lane; a[i] = *(const float2*)(OF + off); b[i] = *(const float2*)(OB + off); sg[i] = *(const unsigned*)(SG + off); }
#pragma unroll
        for (int i = 0; i < 4; ++i) { x0[i] = a[i].x + b[i].x; x1[i] = a[i].y + b[i].y; ss[i] = x0[i] * x0[i] + x1[i] * x1[i]; }
#pragma unroll
        for (int i = 0; i < 4; ++i) ss[i] = wave_sum(ss[i]);
#pragma unroll
        for (int i = 0; i < 4; ++i) { const float rstd = 1.f / sqrtf(ss[i] * (1.f / 128.f) + 1e-6f);
            *(unsigned*)(MIX + (size_t)(q0 + wid * 32 + i0 + i) * D + h * 128 + 2 * lane) = cvtpk(x0[i] * rstd * g0 * bflo(sg[i]), x1[i] * rstd * g1 * bfhi(sg[i])); } }
}
}

namespace att2 {
typedef short v4i16_t __attribute__((ext_vector_type(4)));
constexpr int KVBLK = 64, LDR = HSEC, NT = M / KVBLK;
constexpr int KSLOT = 8192, VSLOT = 16384, NSLOT = 4;
constexpr int OFF_K = 0, OFF_V = NSLOT * KSLOT, OFF_WS = OFF_V + NSLOT * VSLOT, OFF_END = OFF_WS + NWAVES * 64 * 4;
static_assert(OFF_END <= PHASE_LDS, "attention LDS");
__device__ __forceinline__ s16x4 vtr(const LAS unsigned char* p) { return __builtin_bit_cast(s16x4, __builtin_amdgcn_ds_read_tr16_b64_v4i16((LAS v4i16_t*)p)); }
__device__ __forceinline__ void glds16(const void* sbase, unsigned voff, unsigned lds_dst) { unsigned keep;
    asm volatile("s_mov_b32 %0, m0\n\ts_mov_b32 m0, %3\n\ts_nop 0\n\tglobal_load_lds_dwordx4 %1, %2\n\ts_mov_b32 m0, %0" : "=&s"(keep) : "v"(voff), "s"(sbase), "s"(lds_dst) : "memory"); }
#define ATT2_WAIT_BAR(N) asm volatile("s_waitcnt vmcnt(" #N ") lgkmcnt(0)\n\ts_barrier" ::: "memory")
template <bool DO_QK, bool DO_SM, bool DO_PV>
__device__ __forceinline__ void step(f32x16& sn0, f32x16& sn1, f32x16& sc0, f32x16& sc1, const u32x4& pap0, const u32x4& pap1, const u32x4& pap2, const u32x4& pap3,
                                     u32x4& pan0, u32x4& pan1, u32x4& pan2, u32x4& pan3, f32x16 (&o)[4], const bf16x8 (&qr)[4], const f32x16& negm, float& lsum,
                                     const LAS unsigned char* kc, const LAS unsigned char* knn, const LAS unsigned char* vb, bf16x8& kf0, bf16x8& kf1, bf16x8& kf2) {
    bf16x8 fr0 = kf0, fr1 = kf1, fr2 = kf2, fr3 = kf0; unsigned ca0 = 0, ca1 = 0, cb0 = 0, cb1 = 0;
    (void)ca0; (void)ca1; (void)cb0; (void)cb1;
    if (DO_QK) sn0 = __builtin_amdgcn_mfma_f32_32x32x16_bf16(fr0, qr[0], negm, 0, 0, 0);
    SBAR();
    if (DO_QK) { fr3 = *(const LAS bf16x8*)(kc + 2560); }
    if (DO_SM) { sc0[0] = ex2(sc0[0]); sc0[1] = ex2(sc0[1]); }
    SBAR();
    if (DO_QK) sn1 = __builtin_amdgcn_mfma_f32_32x32x16_bf16(fr1, qr[0], negm, 0, 0, 0);
    SBAR();
    if (DO_QK) { fr0 = *(const LAS bf16x8*)(kc + 4096); }
    if (DO_SM) { sc0[2] = ex2(sc0[2]); sc0[3] = ex2(sc0[3]); lsum += sc0[0]; lsum += sc0[1]; }
    SBAR();
    if (DO_QK) sn0 = __builtin_amdgcn_mfma_f32_32x32x16_bf16(fr2, qr[1], sn0, 0, 0, 0);
    SBAR();
    if (DO_QK) { fr1 = *(const LAS bf16x8*)(kc + 4608); }
    if (DO_SM) { sc0[4] = ex2(sc0[4]); sc0[5] = ex2(sc0[5]); lsum += sc0[2]; lsum += sc0[3]; }
    SBAR();
    if (DO_QK) sn1 = __builtin_amdgcn_mfma_f32_32x32x16_bf16(fr3, qr[1], sn1, 0, 0, 0);
    SBAR();
    if (DO_QK) { fr2 = *(const LAS bf16x8*)(kc + 6144); }
    if (DO_SM) { sc0[6] = ex2(sc0[6]); sc0[7] = ex2(sc0[7]); lsum += sc0[4]; lsum += sc0[5]; }
    SBAR();
    if (DO_QK) sn0 = __builtin_amdgcn_mfma_f32_32x32x16_bf16(fr0, qr[2], sn0, 0, 0, 0);
    SBAR();
    if (DO_QK) { fr3 = *(const LAS bf16x8*)(kc + 6656); }
    if (DO_SM) { sc0[8] = ex2(sc0[8]); sc0[9] = ex2(sc0[9]); lsum += sc0[6]; lsum += sc0[7]; }
    SBAR();
    if (DO_QK) sn1 = __builtin_amdgcn_mfma_f32_32x32x16_bf16(fr1, qr[2], sn1, 0, 0, 0);
    SBAR();
    if (DO_PV) { { const s16x4 l_ = vtr(vb + 0), h_ = vtr(vb + 256); fr0 = (bf16x8){l_[0], l_[1], l_[2], l_[3], h_[0], h_[1], h_[2], h_[3]}; } }
    if (DO_SM) { sc0[10] = ex2(sc0[10]); sc0[11] = ex2(sc0[11]); lsum += sc0[8]; lsum += sc0[9]; }
    SBAR();
    if (DO_QK) sn0 = __builtin_amdgcn_mfma_f32_32x32x16_bf16(fr2, qr[3], sn0, 0, 0, 0);
    SBAR();
    if (DO_PV) { { const s16x4 l_ = vtr(vb + 4096), h_ = vtr(vb + 4352); fr1 = (bf16x8){l_[0], l_[1], l_[2], l_[3], h_[0], h_[1], h_[2], h_[3]}; } }
    if (DO_SM) { sc0[12] = ex2(sc0[12]); sc0[13] = ex2(sc0[13]); lsum += sc0[10]; lsum += sc0[11]; }
    SBAR();
    if (DO_QK) sn1 = __builtin_amdgcn_mfma_f32_32x32x16_bf16(fr3, qr[3], sn1, 0, 0, 0);
    SBAR();
    if (DO_PV) { { const s16x4 l_ = vtr(vb + 8192), h_ = vtr(vb + 8448); fr2 = (bf16x8){l_[0], l_[1], l_[2], l_[3], h_[0], h_[1], h_[2], h_[3]}; } }
    if (DO_SM) { sc0[14] = ex2(sc0[14]); sc0[15] = ex2(sc0[15]); lsum += sc0[12]; lsum += sc0[13]; }
    SBAR();
    if (DO_PV) o[0] = __builtin_amdgcn_mfma_f32_32x32x16_bf16(__builtin_bit_cast(bf16x8, pap0), fr0, o[0], 0, 0, 0);
    SBAR();
    if (DO_PV) { { const s16x4 l_ = vtr(vb + 12288), h_ = vtr(vb + 12544); fr3 = (bf16x8){l_[0], l_[1], l_[2], l_[3], h_[0], h_[1], h_[2], h_[3]}; } }
    if (DO_SM) { sc1[0] = ex2(sc1[0]); sc1[1] = ex2(sc1[1]); lsum += sc0[14]; lsum += sc0[15]; }
    SBAR();
    if (DO_PV) o[0] = __builtin_amdgcn_mfma_f32_32x32x16_bf16(__builtin_bit_cast(bf16x8, pap1), fr1, o[0], 0, 0, 0);
    SBAR();
    if (DO_PV) { { const s16x4 l_ = vtr(vb + 512), h_ = vtr(vb + 768); fr0 = (bf16x8){l_[0], l_[1], l_[2], l_[3], h_[0], h_[1], h_[2], h_[3]}; } }
    if (DO_SM) { sc1[2] = ex2(sc1[2]); sc1[3] = ex2(sc1[3]); lsum += sc1[0]; lsum += sc1[1]; }
    SBAR();
    if (DO_PV) o[0] = __builtin_amdgcn_mfma_f32_32x32x16_bf16(__builtin_bit_cast(bf16x8, pap2), fr2, o[0], 0, 0, 0);
    SBAR();
    if (DO_PV) { { const s16x4 l_ = vtr(vb + 4608), h_ = vtr(vb + 4864); fr1 = (bf16x8){l_[0], l_[1], l_[2], l_[3], h_[0], h_[1], h_[2], h_[3]}; } }
    if (DO_SM) { sc1[4] = ex2(sc1[4]); sc1[5] = ex2(sc1[5]); lsum += sc1[2]; lsum += sc1[3]; }
    SBAR();
    if (DO_PV) o[0] = __builtin_amdgcn_mfma_f32_32x32x16_bf16(__builtin_bit_cast(bf16x8, pap3), fr3, o[0], 0, 0, 0);
    SBAR();
    if (DO_PV) { { const s16x4 l_ = vtr(vb + 8704), h_ = vtr(vb + 8960); fr2 = (bf16x8){l_[0], l_[1], l_[2], l_[3], h_[0], h_[1], h_[2], h_[3]}; } }
    if (DO_SM) { sc1[6] = ex2(sc1[6]); sc1[7] = ex2(sc1[7]); lsum += sc1[4]; lsum += sc1[5]; }
    SBAR();
    if (DO_PV) o[1] = __builtin_amdgcn_mfma_f32_32x32x16_bf16(__builtin_bit_cast(bf16x8, pap0), fr0, o[1], 0, 0, 0);
    SBAR();
    if (DO_PV) { { const s16x4 l_ = vtr(vb + 12800), h_ = vtr(vb + 13056); fr3 = (bf16x8){l_[0], l_[1], l_[2], l_[3], h_[0], h_[1], h_[2], h_[3]}; } }
    if (DO_SM) { sc1[8] = ex2(sc1[8]); sc1[9] = ex2(sc1[9]); lsum += sc1[6]; lsum += sc1[7]; }
    SBAR();
    if (DO_PV) o[1] = __builtin_amdgcn_mfma_f32_32x32x16_bf16(__builtin_bit_cast(bf16x8, pap1), fr1, o[1], 0, 0, 0);
    SBAR();
    if (DO_PV) { { const s16x4 l_ = vtr(vb + 1024), h_ = vtr(vb + 1280); fr0 = (bf16x8){l_[0], l_[1], l_[2], l_[3], h_[0], h_[1], h_[2], h_[3]}; } }
    if (DO_SM) { sc1[10] = ex2(sc1[10]); sc1[11] = ex2(sc1[11]); lsum += sc1[8]; lsum += sc1[9]; }
    SBAR();
    if (DO_PV) o[1] = __builtin_amdgcn_mfma_f32_32x32x16_bf16(__builtin_bit_cast(bf16x8, pap2), fr2, o[1], 0, 0, 0);
    SBAR();
    if (DO_PV) { { const s16x4 l_ = vtr(vb + 5120), h_ = vtr(vb + 5376); fr1 = (bf16x8){l_[0], l_[1], l_[2], l_[3], h_[0], h_[1], h_[2], h_[3]}; } }
    if (DO_SM) { sc1[12] = ex2(sc1[12]); sc1[13] = ex2(sc1[13]); lsum += sc1[10]; lsum += sc1[11]; }
    SBAR();
    if (DO_PV) o[1] = __builtin_amdgcn_mfma_f32_32x32x16_bf16(__builtin_bit_cast(bf16x8, pap3), fr3, o[1], 0, 0, 0);
    SBAR();
    if (DO_PV) { { const s16x4 l_ = vtr(vb + 9216), h_ = vtr(vb + 9472); fr2 = (bf16x8){l_[0], l_[1], l_[2], l_[3], h_[0], h_[1], h_[2], h_[3]}; } }
    if (DO_SM) { sc1[14] = ex2(sc1[14]); sc1[15] = ex2(sc1[15]); lsum += sc1[12]; lsum += sc1[13]; }
    SBAR();
    if (DO_PV) o[2] = __builtin_amdgcn_mfma_f32_32x32x16_bf16(__builtin_bit_cast(bf16x8, pap0), fr0, o[2], 0, 0, 0);
    SBAR();
    if (DO_PV) { { const s16x4 l_ = vtr(vb + 13312), h_ = vtr(vb + 13568); fr3 = (bf16x8){l_[0], l_[1], l_[2], l_[3], h_[0], h_[1], h_[2], h_[3]}; } }
    if (DO_SM) { lsum += sc1[14]; lsum += sc1[15]; ca0 = cvtpk(sc0[0], sc0[1]); ca1 = cvtpk(sc0[2], sc0[3]); }
    SBAR();
    if (DO_PV) o[2] = __builtin_amdgcn_mfma_f32_32x32x16_bf16(__builtin_bit_cast(bf16x8, pap1), fr1, o[2], 0, 0, 0);
    SBAR();
    if (DO_PV) { { const s16x4 l_ = vtr(vb + 1536), h_ = vtr(vb + 1792); fr0 = (bf16x8){l_[0], l_[1], l_[2], l_[3], h_[0], h_[1], h_[2], h_[3]}; } }
    if (DO_SM) { cb0 = cvtpk(sc0[4], sc0[5]); cb1 = cvtpk(sc0[6], sc0[7]); pan0 = (u32x4){ca0, ca1, cb0, cb1}; }
    SBAR();
    if (DO_PV) o[2] = __builtin_amdgcn_mfma_f32_32x32x16_bf16(__builtin_bit_cast(bf16x8, pap2), fr2, o[2], 0, 0, 0);
    SBAR();
    if (DO_PV) { { const s16x4 l_ = vtr(vb + 5632), h_ = vtr(vb + 5888); fr1 = (bf16x8){l_[0], l_[1], l_[2], l_[3], h_[0], h_[1], h_[2], h_[3]}; } }
    if (DO_SM) { ca0 = cvtpk(sc0[8], sc0[9]); ca1 = cvtpk(sc0[10], sc0[11]); }
    SBAR();
    if (DO_PV) o[2] = __builtin_amdgcn_mfma_f32_32x32x16_bf16(__builtin_bit_cast(bf16x8, pap3), fr3, o[2], 0, 0, 0);
    SBAR();
    if (DO_PV) { { const s16x4 l_ = vtr(vb + 9728), h_ = vtr(vb + 9984); fr2 = (bf16x8){l_[0], l_[1], l_[2], l_[3], h_[0], h_[1], h_[2], h_[3]}; } }
    if (DO_SM) { cb0 = cvtpk(sc0[12], sc0[13]); cb1 = cvtpk(sc0[14], sc0[15]); pan1 = (u32x4){ca0, ca1, cb0, cb1}; }
    SBAR();
    if (DO_PV) o[3] = __builtin_amdgcn_mfma_f32_32x32x16_bf16(__builtin_bit_cast(bf16x8, pap0), fr0, o[3], 0, 0, 0);
    SBAR();
    if (DO_PV) { { const s16x4 l_ = vtr(vb + 13824), h_ = vtr(vb + 14080); fr3 = (bf16x8){l_[0], l_[1], l_[2], l_[3], h_[0], h_[1], h_[2], h_[3]}; } }
    if (DO_SM) { ca0 = cvtpk(sc1[0], sc1[1]); ca1 = cvtpk(sc1[2], sc1[3]); }
    SBAR();
    if (DO_PV) o[3] = __builtin_amdgcn_mfma_f32_32x32x16_bf16(__builtin_bit_cast(bf16x8, pap1), fr1, o[3], 0, 0, 0);
    SBAR();
    kf0 = *(const LAS bf16x8*)(knn + 0);
    if (DO_SM) { cb0 = cvtpk(sc1[4], sc1[5]); cb1 = cvtpk(sc1[6], sc1[7]); pan2 = (u32x4){ca0, ca1, cb0, cb1}; }
    SBAR();
    if (DO_PV) o[3] = __builtin_amdgcn_mfma_f32_32x32x16_bf16(__builtin_bit_cast(bf16x8, pap2), fr2, o[3], 0, 0, 0);
    SBAR();
    kf1 = *(const LAS bf16x8*)(knn + 512);
    if (DO_SM) { ca0 = cvtpk(sc1[8], sc1[9]); ca1 = cvtpk(sc1[10], sc1[11]); }
    SBAR();
    if (DO_PV) o[3] = __builtin_amdgcn_mfma_f32_32x32x16_bf16(__builtin_bit_cast(bf16x8, pap3), fr3, o[3], 0, 0, 0);
    SBAR();
    kf2 = *(const LAS bf16x8*)(knn + 2048);
    if (DO_SM) { cb0 = cvtpk(sc1[12], sc1[13]); cb1 = cvtpk(sc1[14], sc1[15]); pan3 = (u32x4){ca0, ca1, cb0, cb1}; }
    SBAR();
}

__device__ __forceinline__ void unit(LAS unsigned char* lds, int h, int q0, const bf16_t* __restrict__ QD, const bf16_t* __restrict__ KD, const bf16_t* __restrict__ VD,
                                     const unsigned* KMAX2, float* O0S, float lam, const float* __restrict__ subg, bf16_t* MIX) {
    const int tid = opaque_tid(), wid = __builtin_amdgcn_readfirstlane(tid >> 6), lane = tid & 63, r32 = lane & 31, hi = lane >> 5;
    const unsigned lds0 = (unsigned)(uintptr_t)lds;
    LAS float* ws = (LAS float*)(lds + OFF_WS) + wid * 64;
    const LAS unsigned char* kbase = lds + OFF_K + hi * 1024 + r32 * 16;
    const LAS unsigned char* vbase = lds + OFF_V + (((lane & 3) << 3) | (((lane >> 2) & 3) << 6) | (((lane >> 4) & 1) << 5) | (((lane >> 5) & 1) << 11));
    const unsigned voK = (unsigned)((lane * LDR + wid * 8) * 2);
    unsigned voV[2];
    { const int kk = 8 * wid + ((lane & 31) >> 2), key = (kk & ~0xC) | ((kk & 4) << 1) | ((kk & 8) >> 1);
#pragma unroll
      for (int j = 0; j < 2; ++j) voV[j] = (unsigned)((key * LDR + (2 * j + (lane >> 5)) * 32 + (lane & 3) * 8) * 2); }
    const unsigned kdst = lds0 + OFF_K + wid * 1024, vdst = lds0 + OFF_V + wid * 2048;
#pragma unroll 1
    for (int mp = 0; mp < 2; ++mp) {
        const bf16_t* Kh = KD + h * 128 + mp * 64; const bf16_t* Vh = VD + h * 128;
        const bf16_t* Qw = QD + (size_t)(q0 + wid * 32 + r32) * LDR + h * 128 + mp * 64 + hi * 8;
#define ATT2_DMA_K(t) do { const int t_ = (t) < NT ? (t) : NT - 1; glds16((const char*)Kh + (size_t)t_ * (KVBLK * LDR * 2), voK, (unsigned)__builtin_amdgcn_readfirstlane(kdst + ((t) & 3) * KSLOT)); } while (0)
#define ATT2_DMA_V(t) do { const int t_ = (t) < NT ? (t) : NT - 1; const char* vs_ = (const char*)Vh + (size_t)t_ * (KVBLK * LDR * 2); const unsigned vd_ = (unsigned)__builtin_amdgcn_readfirstlane(vdst + ((t) & 3) * VSLOT); \
        glds16(vs_, voV[0], vd_); glds16(vs_, voV[1], vd_ + 1024); } while (0)
        ATT2_DMA_K(0); ATT2_DMA_K(1); ATT2_DMA_K(2); ATT2_DMA_V(0);
        bf16x8 qr[4]; float qq = 0.f;
#pragma unroll
        for (int d0 = 0; d0 < 4; ++d0) { qr[d0] = *reinterpret_cast<const bf16x8*>(Qw + d0 * 16);
#pragma unroll
            for (int j = 0; j < 8; ++j) { const float q = bf2f((unsigned short)qr[d0][j]); qq += q * q; } }
        { auto rr = __builtin_amdgcn_permlane32_swap(__float_as_uint(qq), __float_as_uint(qq), false, false); qq = __uint_as_float(rr[0]) + __uint_as_float(rr[1]); }
        const float mref = sqrtf(qq * __uint_as_float(KMAX2[(h * 2 + mp) * 64])) * 1.001f;
        f32x16 negm;
#pragma unroll
        for (int r = 0; r < 16; ++r) negm[r] = -mref;
        f32x16 o[4] = {}; float lsum = 0.f;
        f32x16 sA0, sA1, sB0, sB1; u32x4 pX0, pX1, pX2, pX3, pY0, pY1, pY2, pY3;
        sA0 = f32x16{}; sA1 = f32x16{}; sB0 = f32x16{}; sB1 = f32x16{}; pX0 = pX1 = pX2 = pX3 = pY0 = pY1 = pY2 = pY3 = (u32x4){0u, 0u, 0u, 0u};
        bf16x8 kf0, kf1, kf2;
        ATT2_WAIT_BAR(0);
        kf0 = *(const LAS bf16x8*)(kbase); kf1 = *(const LAS bf16x8*)(kbase + 512); kf2 = *(const LAS bf16x8*)(kbase + 2048);
#define KS(t) (kbase + ((t) & 3) * KSLOT)
#define VS(t) (vbase + ((t) & 3) * VSLOT)
        ATT2_DMA_K(3); ATT2_DMA_V(1);
        step<true, false, false>(sA0, sA1, sB0, sB1, pX0, pX1, pX2, pX3, pY0, pY1, pY2, pY3, o, qr, negm, lsum, KS(0), KS(1), VS(0), kf0, kf1, kf2);
        ATT2_WAIT_BAR(3);
        ATT2_DMA_K(4); ATT2_DMA_V(2);
        step<true, true, false>(sB0, sB1, sA0, sA1, pY0, pY1, pY2, pY3, pX0, pX1, pX2, pX3, o, qr, negm, lsum, KS(1), KS(2), VS(0), kf0, kf1, kf2);
        ATT2_WAIT_BAR(3);
#pragma unroll 1
        for (int i = 1; i + 1 < NT - 1; i += 2) {
            ATT2_DMA_K(i + 4); ATT2_DMA_V(i + 2);
            step<true, true, true>(sA0, sA1, sB0, sB1, pX0, pX1, pX2, pX3, pY0, pY1, pY2, pY3, o, qr, negm, lsum, KS(i + 1), KS(i + 2), VS(i - 1), kf0, kf1, kf2);
            ATT2_WAIT_BAR(3);
            ATT2_DMA_K(i + 5); ATT2_DMA_V(i + 3);
            step<true, true, true>(sB0, sB1, sA0, sA1, pY0, pY1, pY2, pY3, pX0, pX1, pX2, pX3, o, qr, negm, lsum, KS(i + 2), KS(i + 3), VS(i), kf0, kf1, kf2);
            ATT2_WAIT_BAR(3);
        }
        step<false, true, true>(sA0, sA1, sB0, sB1, pX0, pX1, pX2, pX3, pY0, pY1, pY2, pY3, o, qr, negm, lsum, KS(0), KS(0), VS(NT - 2), kf0, kf1, kf2);
        ATT2_WAIT_BAR(0);
        step<false, false, true>(sB0, sB1, sA0, sA1, pY0, pY1, pY2, pY3, pX0, pX1, pX2, pX3, o, qr, negm, lsum, KS(0), KS(0), VS(NT - 1), kf0, kf1, kf2);
        ATT2_WAIT_BAR(0);
#undef KS
#undef VS
#undef ATT2_DMA_K
#undef ATT2_DMA_V
        { auto rr = __builtin_amdgcn_permlane32_swap(__float_as_uint(lsum), __float_as_uint(lsum), false, false); lsum = __uint_as_float(rr[0]) + __uint_as_float(rr[1]); }
        if (hi == 0) ws[r32] = lsum; asm volatile("s_waitcnt lgkmcnt(0)" ::: "memory");
        int rowb = q0 + wid * 32; asm volatile("" : "+s"(rowb));
        float rli[16];
#pragma unroll
        for (int r = 0; r < 16; ++r) rli[r] = __builtin_amdgcn_rcpf(ws[crow(r, hi)]);
        float* o0p = O0S + tid; asm volatile("" : "+v"(o0p));
        if (mp == 0) {
#pragma unroll
            for (int d0 = 0; d0 < 4; ++d0)
#pragma unroll
                for (int r = 0; r < 16; ++r) o0p[(d0 * 16 + r) * 512] = o[d0][r] * rli[r];
        } else {
            float ss[16];
#pragma unroll
            for (int r = 0; r < 16; ++r) ss[r] = 0.f;
#pragma unroll
            for (int d0 = 0; d0 < 4; ++d0)
#pragma unroll
                for (int r = 0; r < 16; ++r) { const float c = o0p[(d0 * 16 + r) * 512] - lam * o[d0][r] * rli[r]; o[d0][r] = c; ss[r] += c * c; }
#pragma unroll
            for (int r = 0; r < 16; ++r) {
                ss[r] += lane_xor<1>(ss[r]); ss[r] += lane_xor<2>(ss[r]); ss[r] += lane_xor<4>(ss[r]); ss[r] += lane_xor<8>(ss[r]); ss[r] += lane_xor<16>(ss[r]);
                ss[r] = 0.8f / sqrtf(ss[r] * (1.f / 128.f) + 1e-5f); }
#pragma unroll
            for (int d0 = 0; d0 < 4; ++d0) { const float g = subg[d0 * 32 + r32];
#pragma unroll
                for (int r = 0; r < 16; ++r) MIX[(size_t)(rowb + crow(r, hi)) * D + 512 + h * 128 + d0 * 32 + r32] = (bf16_t)f2bf(o[d0][r] * ss[r] * g); }
        }
        asm volatile("s_waitcnt vmcnt(0) lgkmcnt(0)\n\ts_barrier" ::: "memory");
    }
}
__device__ __forceinline__ void kmax_rows(LAS unsigned char* lds, const bf16_t* KD, unsigned* KMAX2, int gw, int ngw, int lane, int wave) {
    float mx = 0.f;
    for (int row0 = gw; row0 < M; row0 += 8 * ngw) { u32x4 w[8];
#pragma unroll
        for (int i = 0; i < 8; ++i) { const int row = row0 + i * ngw; w[i] = row < M ? *(const GAS u32x4*)(KD + (size_t)row * HSEC + lane * 8) : (u32x4){0u, 0u, 0u, 0u}; }
#pragma unroll
        for (int i = 0; i < 8; ++i) { const u32x4 v = w[i];
            float s = bflo(v.x) * bflo(v.x) + bfhi(v.x) * bfhi(v.x) + bflo(v.y) * bflo(v.y) + bfhi(v.y) * bfhi(v.y) + bflo(v.z) * bflo(v.z) + bfhi(v.z) * bfhi(v.z) + bflo(v.w) * bflo(v.w) + bfhi(v.w) * bfhi(v.w);
            s += lane_xor<1>(s); s += lane_xor<2>(s); s += lane_xor<4>(s); mx = fmaxf(mx, s); } }
    LAS float* red = (LAS float*)lds; if ((lane & 7) == 0) red[wave * 8 + (lane >> 3)] = mx;
    LDS_WAIT(); __syncthreads();
    if (wave == 0 && lane < 8) { float m = red[lane];
#pragma unroll
        for (int w = 1; w < NWAVES; ++w) m = fmaxf(m, red[w * 8 + lane]);
        atomicMax(KMAX2 + lane * 64, __float_as_uint(m)); }
    __syncthreads();
}
}

__device__ __forceinline__ void route16(const bf16_t* X2B, const u32x4* WRB, const float* rgb, const float* reb,
                                        float* RSTD, int* TOKE, float* TOKW, int* TOKR, unsigned* GCNT, int row0, int lane, LAS float* wl, bool dry = false) {
    typedef float f32x4_ __attribute__((ext_vector_type(4)));
    const int r = lane & 15, q = lane >> 4;
    LAS unsigned* lc = (LAS unsigned*)(wl + 800);
    if (lane < 32) lc[lane] = 0u;
    f32x4_ acc[3]; acc[0] = (f32x4_){0.f, 0.f, 0.f, 0.f}; acc[1] = acc[0]; acc[2] = acc[0];
    float ssq = 0.f;
    const bf16_t* xp = X2B + (size_t)(row0 + r) * D + 8 * q;
#pragma unroll 8
    for (int ks = 0; ks < 32; ++ks) {
        const u32x4 xw = *(const GAS u32x4*)(xp + ks * 32);
        ssq += (bflo(xw.x) * bflo(xw.x) + bfhi(xw.x) * bfhi(xw.x)) + (bflo(xw.y) * bflo(xw.y) + bfhi(xw.y) * bfhi(xw.y)) + (bflo(xw.z) * bflo(xw.z) + bfhi(xw.z) * bfhi(xw.z)) + (bflo(xw.w) * bflo(xw.w) + bfhi(xw.w) * bfhi(xw.w));
        const bf16x8 xh = __builtin_bit_cast(bf16x8, xw);
#pragma unroll
        for (int nt = 0; nt < 3; ++nt) {
            const bf16x8 wh = __builtin_bit_cast(bf16x8, WRB[((ks * 3 + nt) * 2 + 0) * 64 + lane]), wlo = __builtin_bit_cast(bf16x8, WRB[((ks * 3 + nt) * 2 + 1) * 64 + lane]);
            acc[nt] = __builtin_amdgcn_mfma_f32_16x16x32_bf16(wh, xh, acc[nt], 0, 0, 0);
            acc[nt] = __builtin_amdgcn_mfma_f32_16x16x32_bf16(wlo, xh, acc[nt], 0, 0, 0);
        }
    }
    ssq += lane_xor<16>(ssq);
    { auto rr = __builtin_amdgcn_permlane32_swap(__float_as_uint(ssq), __float_as_uint(ssq), false, false); ssq = __uint_as_float(rr[0]) + __uint_as_float(rr[1]); }
    const float rstd = 1.f / sqrtf(ssq * (1.f / 1024.f) + 1e-6f);
#pragma unroll
    for (int nt = 0; nt < 3; ++nt) *(LAS f32x4_*)(wl + r * 48 + nt * 16 + 4 * q) = acc[nt] * rstd;
    LDS_WAIT();
    float lg[36];
#pragma unroll
    for (int n4 = 0; n4 < 9; ++n4) { const f32x4_ t = *(const LAS f32x4_*)(wl + r * 48 + 4 * n4); lg[4 * n4] = t[0]; lg[4 * n4 + 1] = t[1]; lg[4 * n4 + 2] = t[2]; lg[4 * n4 + 3] = t[3]; }
    float gl[4];
#pragma unroll
    for (int g = 0; g < 4; ++g) gl[g] = lg[g] + rgb[g];
    int gi = 0; float gm = gl[0];
#pragma unroll
    for (int g = 1; g < 4; ++g) if (gl[g] > gm) { gm = gl[g]; gi = g; }
    float gs = 0.f;
#pragma unroll
    for (int g = 0; g < 4; ++g) gs += __expf(gl[g] - gm);
    const float gp = 1.f / gs;
    float e[8];
#pragma unroll
    for (int j = 0; j < 8; ++j) { const float a0 = lg[4 + j] + reb[j], a1 = lg[12 + j] + reb[8 + j], a2 = lg[20 + j] + reb[16 + j], a3 = lg[28 + j] + reb[24 + j];
        e[j] = gi == 0 ? a0 : gi == 1 ? a1 : gi == 2 ? a2 : a3; }
    int i1 = 0; float m1 = e[0];
#pragma unroll
    for (int j = 1; j < 8; ++j) if (e[j] > m1) { m1 = e[j]; i1 = j; }
    int i2 = 0; float m2 = -3.0e38f;
#pragma unroll
    for (int j = 0; j < 8; ++j) if (j != i1 && e[j] > m2) { m2 = e[j]; i2 = j; }
    const float p2 = __expf(m2 - m1);
    const float w1 = gp / (1.f + p2), w2 = gp * p2 / (1.f + p2);
    if (q == 0 && !dry) { const int row = row0 + r; const int e1 = gi * 8 + i1, e2 = gi * 8 + i2;
        const int r1 = (int)__hip_atomic_fetch_add(lc + e1, 1u, __ATOMIC_RELAXED, __HIP_MEMORY_SCOPE_WORKGROUP), r2 = (int)__hip_atomic_fetch_add(lc + e2, 1u, __ATOMIC_RELAXED, __HIP_MEMORY_SCOPE_WORKGROUP);
        RSTD[row] = rstd; TOKE[row * 2] = e1; TOKE[row * 2 + 1] = e2; TOKW[row * 2] = w1; TOKW[row * 2 + 1] = w2; TOKR[row * 2] = r1; TOKR[row * 2 + 1] = r2; }
    LDS_WAIT();
    if (lane < 32 && !dry) GCNT[(row0 >> 4) * 32 + lane] = lc[lane];
}
__device__ __forceinline__ void build_tile_prefix(volatile LAS int* tb, const unsigned* CNT) {
    if (threadIdx.x == 0) { int acc = 0;
        for (int e = 0; e < 32; ++e) { tb[e] = acc; const int c = (int)__hip_atomic_load(CNT + e * CNT_STRIDE, __ATOMIC_RELAXED, __HIP_MEMORY_SCOPE_AGENT); tb[64 + e] = c; acc += (c + 255) >> 8; }
        tb[32] = acc; }
    LDS_WAIT(); __syncthreads();
}
__device__ __forceinline__ void sort_slots(LAS unsigned char* lds, volatile LAS int* tb, const unsigned* GCNT, const int* TOKE, const int* TOKR, int* TOKS, int* PERM, const float* RSTD, float* RSLOT, unsigned* CNT, int blk, int nblk) {
    const int t = opaque_tid(), e = t & 31, j = t >> 5; constexpr int NG = M / 16;
    const int gpb = (NG + nblk - 1) / nblk, g0 = blk * gpb, g1 = g0 + gpb < NG ? g0 + gpb : NG;
    LAS int* part = (LAS int*)lds; LAS int* part2 = part + 512; LAS int* tot = part2 + 512; LAS int* base0 = tot + 32;
    int s = 0, s2 = 0;
    for (int g = j; g < NG; g += 16) { const int c = (int)GCNT[g * 32 + e]; s += c; s2 += g < g0 ? c : 0; }
    part[j * 32 + e] = s; part2[j * 32 + e] = s2;
    LDS_WAIT(); __syncthreads();
    if (t < 32) { int a = 0, b = 0;
#pragma unroll
        for (int jj = 0; jj < 16; ++jj) { a += part[jj * 32 + t]; b += part2[jj * 32 + t]; }
        tot[t] = a; base0[t] = b; if (blk == 0) __hip_atomic_store(CNT + t * CNT_STRIDE, (unsigned)a, __ATOMIC_RELAXED, __HIP_MEMORY_SCOPE_AGENT); }
    LDS_WAIT(); __syncthreads();
    if (t == 0) { int acc = 0; for (int ee = 0; ee < 32; ++ee) { tb[ee] = acc; tb[64 + ee] = tot[ee]; acc += (tot[ee] + 255) >> 8; } tb[32] = acc; }
    LDS_WAIT(); __syncthreads();
    for (int idx = t; idx < (g1 - g0) * 32; idx += 512) { const int gi = idx >> 5, p = (g0 + gi) * 32 + (idx & 31), ex = TOKE[p]; int base = base0[ex];
        for (int g = g0; g < g0 + gi; ++g) base += (int)GCNT[g * 32 + ex];
        const int slot = tb[ex] * 256 + base + TOKR[p]; TOKS[p] = slot; PERM[slot] = p >> 1; RSLOT[slot] = RSTD[p >> 1]; }
}
template <int NR>
__device__ __forceinline__ void final_rows(const bf16_t* X2B, float* OUT, const unsigned char* Y, const int* TOKS, const float* TOKW, const float* gain, int m0, int stride, int lane) {
    typedef float f32x2_ __attribute__((ext_vector_type(2)));
    int s0[NR], s1[NR]; float w0[NR], w1[NR];
#pragma unroll
    for (int i = 0; i < NR; ++i) { const int row = m0 + i * stride; s0[i] = TOKS[row * 2]; s1[i] = TOKS[row * 2 + 1]; w0[i] = TOKW[row * 2] * (1.f / F8_YSCALE); w1[i] = TOKW[row * 2 + 1] * (1.f / F8_YSCALE); }
    u32x2 xx[NR][4]; unsigned ya[NR][4], yb[NR][4];
#pragma unroll
    for (int i = 0; i < NR; ++i) { const int row = m0 + i * stride;
        const GAS u32x2* xr = (const GAS u32x2*)(X2B + (size_t)row * D) + lane; const GAS unsigned* y0 = (const GAS unsigned*)(Y + (size_t)s0[i] * D) + lane; const GAS unsigned* y1 = (const GAS unsigned*)(Y + (size_t)s1[i] * D) + lane;
#pragma unroll
        for (int j = 0; j < 4; ++j) { xx[i][j] = xr[64 * j]; ya[i][j] = y0[64 * j]; yb[i][j] = y1[64 * j]; } }
#pragma unroll
    for (int i = 0; i < NR; ++i) { const int row = m0 + i * stride; f32x4 v[4]; float s = 0.f;
#pragma unroll
        for (int j = 0; j < 4; ++j) { const u32x2 x_ = xx[i][j];
            const f32x2_ a0 = __builtin_amdgcn_cvt_pk_f32_fp8((int)ya[i][j], false), a1 = __builtin_amdgcn_cvt_pk_f32_fp8((int)ya[i][j], true), b0 = __builtin_amdgcn_cvt_pk_f32_fp8((int)yb[i][j], false), b1 = __builtin_amdgcn_cvt_pk_f32_fp8((int)yb[i][j], true);
            v[j].x = bflo(x_.x) + w0[i] * a0[0] + w1[i] * b0[0]; v[j].y = bfhi(x_.x) + w0[i] * a0[1] + w1[i] * b0[1]; v[j].z = bflo(x_.y) + w0[i] * a1[0] + w1[i] * b1[0]; v[j].w = bfhi(x_.y) + w0[i] * a1[1] + w1[i] * b1[1];
            s += (v[j].x * v[j].x + v[j].y * v[j].y) + (v[j].z * v[j].z + v[j].w * v[j].w); }
        const float rstd = 1.f / sqrtf(wave_sum(s) * (1.f / 1024.f) + 1e-6f);
        GAS f32x4* orow = (GAS f32x4*)(OUT + (size_t)row * D) + lane;
#pragma unroll
        for (int j = 0; j < 4; ++j) { const f32x4 g = ((const GAS f32x4*)gain)[64 * j + lane]; orow[64 * j] = v[j] * rstd * g; } }
}

#ifndef MK_N_LAUNCHES
#define MK_N_LAUNCHES 1
#endif
constexpr int N_PHASES = 12;
struct Args { const void* in[18]; float* out; unsigned char* ws; int ph_lo, ph_hi; };
static_assert(sizeof(Args) == 18 * 8 + 8 + 8 + 8, "Args has no padding");

__global__ void __launch_bounds__(NWAVES * 64, 2) mk_fwd(Args args) {
    extern __shared__ __attribute__((aligned(16))) unsigned char lds_raw[];
    LAS unsigned char* lds = (LAS unsigned char*)lds_raw;
    volatile LAS unsigned* MISC = (volatile LAS unsigned*)(lds + MISC_OFF);
    const int G = gridDim.x, bx = blockIdx.x, vcu = (G % 8 == 0) ? (bx % 8) * (G / 8) + bx / 8 : bx;
    const int NGW = G * NWAVES;
#define PHASE_IDS const int tid = opaque_tid(), lane = tid & 63, wave = __builtin_amdgcn_readfirstlane(tid >> 6), gw = vcu * NWAVES + wave; (void)lane; (void)gw
    const __attribute__((address_space(4))) Args* A = (const __attribute__((address_space(4))) Args*)__builtin_amdgcn_kernarg_segment_ptr();
    asm volatile("" : "+s"(A));
#define ARGF(i) ((const float*)A->in[i])
#define WSP(T, off) ((T*)(A->ws + (off)))
#define x_in ARGF(0)
#define positions ((const int*)A->in[1])
#define norm1_gain ARGF(2)
#define w_in ARGF(3)
#define hg_lb ARGF(4)
#define hg_norm_gain ARGF(5)
#define diff_lambda ARGF(6)
#define subln_gain ARGF(7)
#define w_out ARGF(8)
#define norm2_gain ARGF(9)
#define rg_w ARGF(10)
#define rg_b ARGF(11)
#define re_w ARGF(12)
#define re_b ARGF(13)
#define w_gate ARGF(14)
#define w_up ARGF(15)
#define w_down ARGF(16)
#define final_gain ARGF(17)
#define out (A->out)
#define cosT WSP(float, WS_ROPE)
#define sinT (WSP(float, WS_ROPE) + M * 8)
#define HD WSP(float, WS_HD)
#define TOKE WSP(int, WS_TOKE)
#define TOKW WSP(float, WS_TOKW)
#define TOKR WSP(int, WS_TOKR)
#define TOKS WSP(int, WS_TOKS)
#define LAMP WSP(float, WS_LAM)
#define WOUT WSP(bf16_t, WS_WOUT)
#define WIN WSP(bf16_t, WS_WIN)
#define XN WSP(bf16_t, WS_XN)
#define QH WSP(bf16_t, WS_QH)
#define VH WSP(bf16_t, WS_VH)
#define SG WSP(bf16_t, WS_SG)
#define QD WSP(bf16_t, WS_QD)
#define KD WSP(bf16_t, WS_KD)
#define VD WSP(bf16_t, WS_VD)
#define GF WSP(half_t, WS_GF)
#define GB WSP(half_t, WS_GB)
#define HS WSP(float, WS_HS)
#define HL WSP(float, WS_HL)
#define OF WSP(float, WS_OF)
#define OB WSP(float, WS_OB)
#define MIX WSP(bf16_t, WS_MIX)
#define X2B WSP(bf16_t, WS_X2B)
#define X2F8 WSP(unsigned char, WS_X2F8)
#define WGU WSP(unsigned char, WS_WGU)
#define WD WSP(unsigned char, WS_WD)
#define HGb WSP(bf16_t, WS_HG)
#define HM WSP(unsigned char, WS_HM)
#define Y WSP(unsigned char, WS_Y)
#define CNT (WSP(unsigned, WS_CTL) + CW_CNT)
    unsigned* ctl = WSP(unsigned, WS_CTL);
    volatile LAS int* tb = (volatile LAS int*)(MISC + 16);

    if (threadIdx.x < 64) MISC[threadIdx.x] = 0u;
    __syncthreads();
    XcdBarrier bar; bar.bar = ctl + CW_BAR; bar.x = 0; bar.st = nullptr;
    const int lo = A->ph_lo, hi = A->ph_hi;
    if (hi - lo > 1) bar = xcd_barrier_post(ctl + CW_BAR, MISC);
#ifndef PH_MASK
#define PH_MASK 0xFFF
#endif
#define IN(k) (((PH_MASK >> (k)) & 1) && lo <= (k) && (k) < hi)
#ifndef DOUBLE_PHASE
#define DOUBLE_PHASE -1
#endif
#define REP(k) for (int rep_ = 0; rep_ < ((DOUBLE_PHASE) == (k) ? 2 : 1); ++rep_)
#ifndef BAR_REPS
#define BAR_REPS 1
#endif
#ifdef DIAG_SPAN_A
#define STAMP(k) do { if (blockIdx.x == 0 && threadIdx.x == 0) WSP(unsigned long long, WS_LAM + 64)[k] = __builtin_amdgcn_s_memrealtime(); } while (0)
#else
#define STAMP(k) do { } while (0)
#endif
#define SEAM(k) do { if (IN(k) && IN((k) + 1)) for (int b_ = 0; b_ < BAR_REPS; ++b_) xcd_barrier(bar); STAMP((k) + 1); } while (0)

    STAMP(0);
    if (IN(0)) REP(0) { PHASE_IDS;
        LAS float* scr = (LAS float*)(lds + wave * 16384);
        constexpr int I_IN = (D / 64) * (NIN / 32), I_OUT = (D / 64) * (D / 32);
        { XposeRegs R;
#define P0_LOAD(it_) do { if ((it_) < I_IN) xpose_load(R, w_in, D, NIN, (it_), lane); else xpose_load(R, w_out, D, D, (it_) - I_IN, lane); } while (0)
            if (gw < I_IN + I_OUT) P0_LOAD(gw);
            for (int it = gw; it < I_IN + I_OUT; it += NGW) { const XposeRegs C = R; const int nx = it + NGW;
                if (nx < I_IN + I_OUT) P0_LOAD(nx);
                if (it < I_IN) xpose_store(C, D, NIN, WIN, 0, 1, scr, it, lane); else xpose_store(C, D, D, WOUT, 0, 1, scr, it - I_IN, lane); }
#undef P0_LOAD
        }
        for (int m = gw; m < M; m += NGW) rms_rows_to_bf16<1>(x_in, norm1_gain, XN, m, NGW, lane, 1e-6f);
        for (int id = bx * 512 + tid; id < M * 8; id += G * 512) {
            const int i = id & 7; const float invf[8] = {1.0f, 0.19392274474868576f, 0.03760603093086393f, 0.007292664737217109f, 0.001414213562373095f, 0.0002742481756762073f, 5.318295896944988e-05f, 1.031338537721246e-05f};
            float f = invf[0];
#pragma unroll
            for (int q = 1; q < 8; ++q) f = (i == q) ? invf[q] : f;
            const float ang = (float)positions[id >> 3] * f;
            const double rev = (double)ang * 0.15915494309189535; const float fr = (float)(rev - __builtin_rint(rev));
            cosT[id] = __builtin_amdgcn_cosf(fr); sinT[id] = __builtin_amdgcn_sinf(fr);
        }
        for (int id = bx * 512 + tid; id < 32 * 3 * 2 * 64; id += G * 512) {
            const int ln = id & 63, part = (id >> 6) & 1, nt = (id >> 7) % 3, ks = (id >> 7) / 3, n = nt * 16 + (ln & 15), k0 = ks * 32 + 8 * (ln >> 4); unsigned w[4];
#pragma unroll
            for (int jj = 0; jj < 4; ++jj) { float v[2];
#pragma unroll
                for (int u = 0; u < 2; ++u) { const int k = k0 + 2 * jj + u; const float wv = (n < 4 ? rg_w[k * 4 + n] : n < 36 ? re_w[k * 32 + (n - 4)] : 0.f) * norm2_gain[k];
                    const float hv = bf2f(f2bf(wv)); v[u] = part ? wv - hv : hv; }
                w[jj] = pk2(v[0], v[1]); }
            WSP(u32x4, WS_WR)[id] = (u32x4){w[0], w[1], w[2], w[3]}; }
        if (bx == 0 && wave == 0) { const float a = wave_sum(diff_lambda[lane] * diff_lambda[64 + lane]), b = wave_sum(diff_lambda[128 + lane] * diff_lambda[192 + lane]);
            if (lane == 0) LAMP[0] = __expf(a) - __expf(b) + 0.2f; }
    }
    SEAM(0);
    if (IN(1)) REP(1) {
        pg8::Gemm g{XN, WIN, M, NIN, D}; pg8::StaticOrder S; S.init(M, NIN, G, bx);
        EpiInProj E{QH, VH, SG, QD, KD, VD, GF, GB, hg_lb, cosT, sinT};
        pg8::gemm_phase<EpiInProj, pg8::StaticOrder, true, true>(lds, g, S, E);
    }
    SEAM(1);
    if (IN(2)) REP(2) { for (int u = vcu; u < 256; u += G) hg::pass<false>(lds, u, QH, VH, GF, GB, HL, HD, HS, OF, OB);
        { PHASE_IDS; att2::kmax_rows(lds, KD, WSP(unsigned, WS_CTL) + CW_KMAX, gw, NGW, lane, wave); } }
    SEAM(2);
    if (IN(3)) REP(3) hg::scan(HL, HD, HS, bx * 512 + opaque_tid(), G * 512);
    SEAM(3);
    if (IN(4)) REP(4) { for (int u = vcu; u < 256; u += G) hg::pass<true>(lds, u, QH, VH, GF, GB, HL, HD, HS, OF, OB); }
    SEAM(4);
    if (IN(5)) REP(5) { PHASE_IDS;
#ifdef DIAG_CLOCK
        if (blockIdx.x == 0 && threadIdx.x == 0) { WSP(unsigned long long, WS_LAM + 64)[20] = __builtin_amdgcn_s_memtime(); WSP(unsigned long long, WS_LAM + 64)[21] = __builtin_amdgcn_s_memrealtime(); }
#endif
        const float lam = LAMP[0];
        for (int u = vcu; u < 256; u += G) { const int h = u >> 6, q0 = (u & 63) * 256;
            int ln = lane; asm volatile("" : "+v"(ln));
            att::hgrn_finalize(h, q0, OF, OB, SG, hg_norm_gain, MIX, wave, ln);
            att2::unit(lds, h, q0, QD, KD, VD, WSP(unsigned, WS_CTL) + CW_KMAX, WSP(float, WS_O0S) + (size_t)bx * 32768, lam, subln_gain, MIX); }
    }
#ifdef DIAG_CLOCK
    if (blockIdx.x == 0 && threadIdx.x == 0) { WSP(unsigned long long, WS_LAM + 64)[22] = __builtin_amdgcn_s_memtime(); WSP(unsigned long long, WS_LAM + 64)[23] = __builtin_amdgcn_s_memrealtime(); }
#endif
    SEAM(5);
    if (IN(6)) REP(6) {
        pg8::Gemm g{MIX, WOUT, M, D, D}; pg8::StaticOrder S; S.init(M, D, G, bx);
        EpiResid E{x_in, X2B, X2F8};
        pg8::gemm_phase<EpiResid, pg8::StaticOrder, true, true>(lds, g, S, E);
    }
    SEAM(6);
    if (IN(7)) { PHASE_IDS;
        const int grp = wave * G + vcu; const bool router = grp * 16 < M;
        LAS float* scr = (LAS float*)(lds + wave * 16384);
        if (router) route16(X2B, WSP(const u32x4, WS_WR), rg_b, re_b, WSP(float, WS_RSTD), TOKE, TOKW, TOKR, WSP(unsigned, WS_GCNT), grp * 16, lane, scr + 3072);
        if (router && (DOUBLE_PHASE) == 77) route16(X2B, WSP(const u32x4, WS_WR), rg_b, re_b, WSP(float, WS_RSTD), TOKE, TOKW, TOKR, WSP(unsigned, WS_GCNT), grp * 16, lane, scr + 3072, true);
        constexpr int I_GU = (D / 64) * (DEXP / 32), I_DN = (DEXP / 64) * (D / 32), I_ALL = NEXP * (2 * I_GU + I_DN);
#ifndef P7_SHARE
#define P7_SHARE 10
#endif
        const int nrt = M / 16, nA = nrt < NGW ? nrt : NGW, nB = NGW - nA;
        const int perA = nB ? (I_ALL * P7_SHARE / 24 + nA - 1) / nA : (I_ALL + nA - 1) / nA, totA = perA * nA < I_ALL ? perA * nA : I_ALL;
        int it0, it1, stp;
        if (router) { it0 = grp; it1 = totA; stp = nA; } else { it0 = totA + (grp - nA); it1 = I_ALL; stp = nB; }
        REP(7) { XposeRegs R0, R1;
#define P7_LOAD(R, it_) do { const int e_ = (it_) / (2 * I_GU + I_DN), r_ = (it_) % (2 * I_GU + I_DN); \
            if (r_ < I_GU) xpose_load(R, w_gate + (size_t)e_ * D * DEXP, D, DEXP, r_, lane); else if (r_ < 2 * I_GU) xpose_load(R, w_up + (size_t)e_ * D * DEXP, D, DEXP, r_ - I_GU, lane); \
            else xpose_load(R, w_down + (size_t)e_ * DEXP * D, DEXP, D, r_ - 2 * I_GU, lane); } while (0)
#define P7_STORE(C, it_) do { const int e = (it_) / (2 * I_GU + I_DN), r = (it_) % (2 * I_GU + I_DN); \
            if (r < I_GU) xpose_store_f8(C, D, DEXP, WGU + (size_t)e * 1024 * D, 0, 2, scr, r, lane, F8_WSCALE, norm2_gain); \
            else if (r < 2 * I_GU) xpose_store_f8(C, D, DEXP, WGU + (size_t)e * 1024 * D, 1, 2, scr, r - I_GU, lane, F8_WSCALE, norm2_gain); \
            else xpose_store_f8(C, DEXP, D, WD + (size_t)e * 1024 * DEXP, 0, 1, scr, r - 2 * I_GU, lane, F8_WSCALE); } while (0)
            if (it0 < it1) P7_LOAD(R0, it0);
            if (it0 + stp < it1) P7_LOAD(R1, it0 + stp);
            for (int it = it0; it < it1; it += 2 * stp) {
                { const XposeRegs C = R0; if (it + 2 * stp < it1) P7_LOAD(R0, it + 2 * stp); P7_STORE(C, it); }
                if (it + stp < it1) { const XposeRegs C = R1; if (it + 3 * stp < it1) P7_LOAD(R1, it + 3 * stp); P7_STORE(C, it + stp); }
            }
#undef P7_STORE
#undef P7_LOAD
        }
    }
    SEAM(7);
    if (IN(8)) REP(8) { sort_slots(lds, tb, WSP(unsigned, WS_GCNT), TOKE, TOKR, TOKS, WSP(int, WS_PERM), WSP(const float, WS_RSTD), WSP(float, WS_RSLOT), CNT, bx, G); }
    SEAM(8);
    if (IN(9)) REP(9) {
        build_tile_prefix(tb, CNT);
        pg8::Gemm g{(const bf16_t*)X2F8, (const bf16_t*)WGU, MAXSLOTS, NEXP * 1024, D / 2}; MoeOrder S{tb, G, bx, WSP(const int, WS_PERM), WSP(unsigned, WS_CTL) + CW_READY, 0}; EpiSwiGlu E{HM, WSP(const float, WS_RSLOT)};
        pg8::gemm_phase_g<EpiSwiGlu, MoeOrder, true, true, true>(lds, g, S, E);
    }
    SEAM(9);
    if (IN(10)) REP(10) {
        build_tile_prefix(tb, CNT);
        pg8::Gemm g{(const bf16_t*)HM, (const bf16_t*)WD, MAXSLOTS, NEXP * 1024, DEXP / 2}; MoeOrder S{tb, G, bx, WSP(const int, WS_PERM), WSP(unsigned, WS_CTL) + CW_READY, 0}; EpiDown E{Y};
        pg8::gemm_phase<EpiDown, MoeOrder, true, true, true>(lds, g, S, E);
    }
    SEAM(10);
    if (IN(11)) { PHASE_IDS; for (int m = gw; m < M; m += NGW) final_rows<1>(X2B, out, Y, TOKS, TOKW, final_gain, m, NGW, lane); }
#ifdef DIAG_SPAN_A
    xcd_barrier(bar); STAMP(12); xcd_barrier(bar);
    { const unsigned long long* st_ = WSP(unsigned long long, WS_LAM + 64);
#ifdef DIAG_CLOCK
      const float d_ = (float)(long long)(st_[22] - st_[20]) / (float)(long long)(st_[23] - st_[21]) * 10.f * DIAG_C;
#else
      const float d_ = (float)(long long)(st_[DIAG_SPAN_B] - st_[DIAG_SPAN_A]) * 0.01f * DIAG_C;
#endif
      for (int m = blockIdx.x * 512 + threadIdx.x; m < M; m += gridDim.x * 512) out[(size_t)m * D] += d_; }
#endif
#undef IN
#undef SEAM
#undef x_in
#undef positions
#undef out
#undef Y
#undef HM
#undef CNT
}

extern "C" void kernel_launch(void* const* d_in, const int* in_sizes, int n_in, void* d_out, int out_size, void* d_ws, size_t ws_size, hipStream_t stream) {
    static int grid = 0;
    if (grid == 0) {
        if (n_in != 18 || in_sizes[0] != M * D || out_size != M * D || ws_size < WS_END) { fprintf(stderr, "kernel_launch: unexpected shapes (n_in %d, in0 %d, out %d, ws %zu)\n", n_in, n_in > 0 ? in_sizes[0] : -1, out_size, ws_size); grid = -1; return; }
        int dev = 0, cus = 0, per_cu = 0;
        if (hipGetDevice(&dev) != hipSuccess || hipDeviceGetAttribute(&cus, hipDeviceAttributeMultiprocessorCount, dev) != hipSuccess) { grid = -1; return; }
        if (hipFuncSetAttribute((const void*)mk_fwd, hipFuncAttributeMaxDynamicSharedMemorySize, LDS_BYTES) != hipSuccess) { fprintf(stderr, "kernel_launch: hipFuncSetAttribute failed\n"); grid = -1; return; }
        if (hipOccupancyMaxActiveBlocksPerMultiprocessor(&per_cu, (const void*)mk_fwd, NWAVES * 64, LDS_BYTES) != hipSuccess || per_cu < 1) { fprintf(stderr, "kernel_launch: occupancy query says %d\n", per_cu); (void)hipGetLastError(); grid = -1; return; }
        grid = cus;
    }
    if (grid < 0) return;
    if (hipMemsetAsync((char*)d_ws + WS_CTL, 0, CTL_ZERO_BYTES, stream) != hipSuccess) return;
    Args a{};
    for (int i = 0; i < 18; ++i) a.in[i] = d_in[i];
    a.out = (float*)d_out; a.ws = (unsigned char*)d_ws;
#if MK_N_LAUNCHES == 1
    a.ph_lo = 0; a.ph_hi = N_PHASES;
    hipLaunchKernelGGL(mk_fwd, dim3(grid), dim3(NWAVES * 64), LDS_BYTES, stream, a);
#else
    for (int p = 0; p < N_PHASES; ++p) { a.ph_lo = p; a.ph_hi = p + 1; hipLaunchKernelGGL(mk_fwd, dim3(grid), dim3(NWAVES * 64), LDS_BYTES, stream, a); }
#endif
}
```

```cpp
#include <hip/hip_runtime.h>
#include <cstdio>
#include <cstdint>
__device__ __forceinline__ int opaque_tid() { int t = threadIdx.x; asm volatile("" : "+v"(t)); return t; }
namespace pg8 {
#define PG8_LAS __attribute__((address_space(3)))
typedef unsigned short bf16_t;
typedef short bf16x8 __attribute__((ext_vector_type(8)));
typedef float f32x4 __attribute__((ext_vector_type(4)));
typedef unsigned u32x4 __attribute__((ext_vector_type(4)));
constexpr int BM = 256, BK = 64, HALF = 128, HTB = HALF * BK * 2  , STAGE_BYTES = 8 * HTB, NXCD = 8, WGM = 8;

__host__ __device__ __forceinline__ int lds_byte(int r, int c) { const int st = (r >> 4) * 2 + (c >> 5), rr = r & 15, cc = c & 31, ob = rr * 64 + cc * 2; return st * 1024 + (ob ^ (((ob >> 9) & 1) << 5)); }
__host__ __device__ __forceinline__ void stage_rc(int b, int& R, int& C) { const int st = b / 1024, sb = b % 1024, swz = sb ^ (((sb >> 9) & 1) << 5); R = (st >> 1) * 16 + swz / 64; C = (st & 1) * 32 + (swz % 64) / 2; }
__host__ __device__ __forceinline__ int perm32(int rho) { const int n = rho >> 4, i = rho & 15; return 8 * (i >> 2) + 4 * n + (i & 3); }

struct Unit { int pm, pn; };
struct Gemm { const bf16_t* A; const bf16_t* Bt; int M, N, K; };

struct StaticOrder {
    int nM, nN, nwg, G, c;
    __host__ __device__ void init(int M, int N, int G_, int c_) { nM = M / BM; nN = N / BM; nwg = nM * nN; G = G_; c = c_; }
    __host__ __device__ bool next(int i, Unit& u) const {
        const long L = (long)i * G + c; if (L >= nwg) return false;
        int wgid = (int)L; { const int q = nwg / NXCD, r = nwg % NXCD, xcd = wgid % NXCD, off = wgid / NXCD; wgid = (xcd < r ? xcd * (q + 1) : r * (q + 1) + (xcd - r) * q) + off; }
        const int nig = WGM * nN, gid = wgid / nig, fm = gid * WGM, gsz = (nM - fm) < WGM ? (nM - fm) : WGM;
        u.pm = fm + ((wgid % nig) % gsz); u.pn = (wgid % nig) / gsz; return true;
    }
    __device__ __forceinline__ bool half_only(const Unit&) const { return false; }
    __device__ __forceinline__ void a_ready(const Unit&) const {}
    __device__ __forceinline__ void done(const Unit&) const {}
};

template <class Epi, class Sched, bool ALIGN_EPI = false, bool SP2 = false, bool F8 = false>
__device__ __forceinline__ void gemm_phase(PG8_LAS unsigned char* lds, const Gemm g, const Sched& S, const Epi& E) {
    const int tid = opaque_tid(), wid = __builtin_amdgcn_readfirstlane(tid >> 6), lane = tid & 63, wr = wid >> 2, wc = wid & 3, fr = lane & 15, fq = lane >> 4;
    const int K = g.K, nt = K / BK;
    unsigned voffA[2], voffB[2];
#pragma unroll
    for (int i = 0; i < 2; ++i) { int R, C; stage_rc(tid * 16 + i * 8192, R, C); const int Rb = Epi::PERM ? ((R & ~31) + perm32(R & 31)) : R;
        voffA[i] = (unsigned)(R * K + C) * 2u; voffB[i] = (unsigned)(Rb * K + C) * 2u; }
    const size_t kstep = (size_t)(BK * 2);
    const size_t hstep = (size_t)HALF * K * 2;
    const size_t tstep = 2 * hstep;
    const unsigned ldsw = (unsigned)wid * 1024u;
    const int aoff = lds_byte(wr * 64 + fr, fq * 8), boff = lds_byte(wc * 32 + fr, fq * 8);
#define PG8_SA(b, h) (((b) * 2 + (h)) * HTB)
#define PG8_SB(b, h) ((4 + (b) * 2 + (h)) * HTB)
#define PG8_STAGE(bufoff, gbase, voff) do { _Pragma("unroll") for (int _i = 0; _i < 2; ++_i) \
        __builtin_amdgcn_global_load_lds((const unsigned*)((const char*)(gbase) + (voff)[_i]), (PG8_LAS unsigned*)(lds + (bufoff) + ldsw + _i * 8192), 16, 0, 0); } while (0)
#define PG8_LDA(dst, b, h) do { _Pragma("unroll") for (int m = 0; m < 4; ++m) _Pragma("unroll") for (int k = 0; k < 2; ++k) dst[m][k] = *(const PG8_LAS bf16x8*)(lds + PG8_SA(b, h) + aoff + m * 2048 + k * 1024); } while (0)
#define PG8_LDB(dst, b, h) do { _Pragma("unroll") for (int n = 0; n < 2; ++n) _Pragma("unroll") for (int k = 0; k < 2; ++k) dst[n][k] = *(const PG8_LAS bf16x8*)(lds + PG8_SB(b, h) + boff + n * 2048 + k * 1024); } while (0)
#define PG8_MMA(ai, bj, At, Bt) do { __builtin_amdgcn_s_setprio(1); _Pragma("unroll") for (int m = 0; m < 4; ++m) _Pragma("unroll") for (int n = 0; n < 2; ++n) _Pragma("unroll") for (int k = 0; k < 2; ++k) { \
        if constexpr (F8) { typedef long v2l_ __attribute__((ext_vector_type(2))); const v2l_ b_ = __builtin_bit_cast(v2l_, Bt[n][k]), a_ = __builtin_bit_cast(v2l_, At[m][k]); \
            acc[ai][bj][m][n] = __builtin_amdgcn_mfma_f32_16x16x32_fp8_fp8(b_[0], a_[0], acc[ai][bj][m][n], 0, 0, 0); acc[ai][bj][m][n] = __builtin_amdgcn_mfma_f32_16x16x32_fp8_fp8(b_[1], a_[1], acc[ai][bj][m][n], 0, 0, 0); } \
        else acc[ai][bj][m][n] = __builtin_amdgcn_mfma_f32_16x16x32_bf16(Bt[n][k], At[m][k], acc[ai][bj][m][n], 0, 0, 0); } \
        __builtin_amdgcn_s_setprio(0); } while (0)
#define PG8_WAIT_V(n) asm volatile("s_waitcnt vmcnt(" #n ")" ::: "memory")
#define PG8_WAIT_L(n) asm volatile("s_waitcnt lgkmcnt(" #n ")" ::: "memory")
#define PG8_BAR __builtin_amdgcn_s_barrier()
#define PG8_SCHED __builtin_amdgcn_sched_barrier(0)
    Unit cur, nxt; int ui = 0;
    if (!S.next(0, cur)) return;
    f32x4 acc[2][2][4][2];
#pragma unroll
    for (int a = 0; a < 2; ++a)
#pragma unroll
        for (int b = 0; b < 2; ++b)
#pragma unroll
            for (int m = 0; m < 4; ++m)
#pragma unroll
                for (int n = 0; n < 2; ++n) acc[a][b][m][n] = (f32x4){0.f, 0.f, 0.f, 0.f};
    bf16x8 At[4][2], B0[2][2], B1[2][2];
    const char* cA = (const char*)g.A + (size_t)cur.pm * tstep; const char* cB = (const char*)g.Bt + (size_t)cur.pn * tstep;
    S.a_ready(cur);
    if constexpr (SP2) {
        PG8_STAGE(PG8_SB(0, 0), cB, voffB); PG8_STAGE(PG8_SB(0, 1), cB + hstep, voffB); PG8_STAGE(PG8_SA(0, 0), cA, voffA); PG8_STAGE(PG8_SA(0, 1), cA + hstep, voffA);
        if (wr == 1) PG8_BAR;
        PG8_WAIT_V(2); PG8_BAR;
        PG8_STAGE(PG8_SB(1, 0), cB + kstep, voffB); PG8_STAGE(PG8_SA(1, 0), cA + kstep, voffA); PG8_STAGE(PG8_SB(1, 1), cB + hstep + kstep, voffB);
        PG8_WAIT_V(6); PG8_BAR;
    } else {
        PG8_STAGE(PG8_SB(0, 0), cB, voffB); PG8_STAGE(PG8_SA(0, 0), cA, voffA); PG8_STAGE(PG8_SB(0, 1), cB + hstep, voffB); PG8_STAGE(PG8_SA(0, 1), cA + hstep, voffA);
        if (wr == 1) PG8_BAR;
        PG8_WAIT_V(4); PG8_BAR;
        PG8_STAGE(PG8_SB(1, 0), cB + kstep, voffB); PG8_STAGE(PG8_SA(1, 0), cA + kstep, voffA); PG8_STAGE(PG8_SB(1, 1), cB + hstep + kstep, voffB);
        PG8_WAIT_V(6); PG8_BAR;
    }
    for (;;) {
        const bool has_next = S.next(ui + 1, nxt);
        const char* nA = has_next ? (const char*)g.A + (size_t)nxt.pm * tstep : cA; const char* nB = has_next ? (const char*)g.Bt + (size_t)nxt.pn * tstep : cB;
        for (int t = 0; t < nt; t += 2) {
            const bool last = (t == nt - 2);
            const char* a1 = cA + (size_t)(t + 1) * kstep;
            const char* a2 = last ? nA : cA + (size_t)(t + 2) * kstep; const char* b2 = last ? nB : cB + (size_t)(t + 2) * kstep;
            const char* a3 = a2 + kstep; const char* b3 = b2 + kstep;
            if (last && has_next) S.a_ready(nxt);
            if constexpr (SP2) {
            PG8_LDB(B0, 0, 0); PG8_LDB(B1, 0, 1); PG8_SCHED; PG8_LDA(At, 0, 0); PG8_STAGE(PG8_SA(1, 1), a1 + hstep, voffA);
            PG8_WAIT_V(8); PG8_WAIT_L(0); PG8_BAR; PG8_MMA(0, 0, At, B0); PG8_MMA(0, 1, At, B1); PG8_BAR; PG8_SCHED;
            PG8_LDA(At, 0, 1); PG8_STAGE(PG8_SB(0, 0), b2, voffB); PG8_STAGE(PG8_SB(0, 1), b2 + hstep, voffB); PG8_STAGE(PG8_SA(0, 0), a2, voffA);
            PG8_WAIT_V(8); PG8_WAIT_L(0); PG8_BAR; PG8_MMA(1, 0, At, B0); PG8_MMA(1, 1, At, B1); PG8_BAR; PG8_SCHED;
            PG8_LDB(B0, 1, 0); PG8_LDB(B1, 1, 1); PG8_SCHED; PG8_LDA(At, 1, 0); PG8_STAGE(PG8_SA(0, 1), a2 + hstep, voffA);
            PG8_WAIT_V(8); PG8_WAIT_L(0); PG8_BAR; PG8_MMA(0, 0, At, B0); PG8_MMA(0, 1, At, B1); PG8_BAR; PG8_SCHED;
            PG8_LDA(At, 1, 1); PG8_STAGE(PG8_SB(1, 0), b3, voffB); PG8_STAGE(PG8_SB(1, 1), b3 + hstep, voffB); PG8_STAGE(PG8_SA(1, 0), a3, voffA);
            PG8_WAIT_V(8); PG8_WAIT_L(0); PG8_BAR; PG8_MMA(1, 0, At, B0); PG8_MMA(1, 1, At, B1); PG8_BAR; PG8_SCHED;
            } else {
            PG8_LDB(B0, 0, 0); PG8_SCHED; PG8_LDA(At, 0, 0); PG8_STAGE(PG8_SA(1, 1), a1 + hstep, voffA);
            PG8_WAIT_L(8); PG8_BAR; PG8_WAIT_L(0); PG8_MMA(0, 0, At, B0); PG8_BAR; PG8_SCHED;
            PG8_LDB(B1, 0, 1); PG8_STAGE(PG8_SB(0, 0), b2, voffB);
            PG8_BAR; PG8_WAIT_L(0); PG8_MMA(0, 1, At, B1); PG8_BAR;
            PG8_LDA(At, 0, 1); PG8_STAGE(PG8_SA(0, 0), a2, voffA);
            PG8_BAR; PG8_WAIT_L(0); PG8_MMA(1, 0, At, B0); PG8_BAR; PG8_SCHED;
            PG8_STAGE(PG8_SB(0, 1), b2 + hstep, voffB);
            PG8_WAIT_V(6); PG8_BAR; PG8_MMA(1, 1, At, B1); PG8_BAR;
            PG8_LDB(B0, 1, 0); PG8_SCHED; PG8_LDA(At, 1, 0); PG8_STAGE(PG8_SA(0, 1), a2 + hstep, voffA);
            PG8_WAIT_L(8); PG8_BAR; PG8_WAIT_L(0); PG8_MMA(0, 0, At, B0); PG8_BAR; PG8_SCHED;
            PG8_LDB(B1, 1, 1); PG8_STAGE(PG8_SB(1, 0), b3, voffB);
            PG8_BAR; PG8_WAIT_L(0); PG8_MMA(0, 1, At, B1); PG8_BAR;
            PG8_LDA(At, 1, 1); PG8_STAGE(PG8_SA(1, 0), a3, voffA);
            PG8_BAR; PG8_WAIT_L(0); PG8_MMA(1, 0, At, B0); PG8_BAR; PG8_SCHED;
            PG8_STAGE(PG8_SB(1, 1), b3 + hstep, voffB);
            PG8_WAIT_V(6); PG8_BAR; PG8_MMA(1, 1, At, B1); PG8_BAR;
            }
        }
        if constexpr (ALIGN_EPI) { if (wr == 0) PG8_BAR; }
        if constexpr (!Epi::AFTER_DRAIN) { E(acc, cur, wr, wc, fr, fq); S.done(cur); }
        if (!has_next) break;
#pragma unroll
        for (int a = 0; a < 2; ++a)
#pragma unroll
            for (int b = 0; b < 2; ++b)
#pragma unroll
                for (int m = 0; m < 4; ++m)
#pragma unroll
                    for (int n = 0; n < 2; ++n) acc[a][b][m][n] = (f32x4){0.f, 0.f, 0.f, 0.f};
        cur = nxt; cA = nA; cB = nB; ++ui;
        if constexpr (ALIGN_EPI) { if (wr == 1) PG8_BAR; }
    }
    PG8_WAIT_V(0);
    if constexpr (!ALIGN_EPI) { if (wr == 0) PG8_BAR; }
    PG8_BAR;
    if constexpr (Epi::AFTER_DRAIN) { E.fused(acc, cur, wr, wc, fr, fq, lds, wid, lane); S.done(cur); }
#undef PG8_SA
#undef PG8_SB
#undef PG8_STAGE
#undef PG8_LDA
#undef PG8_LDB
#undef PG8_MMA
#undef PG8_WAIT_V
#undef PG8_WAIT_L
#undef PG8_BAR
#undef PG8_SCHED
}
}

constexpr int NWAVES = 8;
constexpr int M = 16384, D = 1024, NIN = 4096, HSEC = 512;
constexpr int NEXP = 32, DEXP = 512, MAXTILES = 160, MAXSLOTS = MAXTILES * 256;
constexpr float QSCALE = 0.18033688011112042f;

constexpr size_t MiB = 1u << 20;
constexpr size_t WS_CTL = 0, CTL_ZERO_BYTES = 1 * MiB;
constexpr size_t WS_WR = 1 * MiB;
constexpr size_t WS_ROPE = 2 * MiB;
constexpr size_t WS_HD = 3 * MiB;
constexpr size_t WS_TOKE = 3 * MiB + 256 * 1024, WS_TOKW = WS_TOKE + 128 * 1024, WS_TOKR = WS_TOKW + 128 * 1024, WS_TOKS = WS_TOKR + 128 * 1024, WS_LAM = WS_TOKS + 128 * 1024, WS_GCNT = WS_LAM + 128 * 1024, WS_RSTD = 1 * MiB + 256 * 1024, WS_RSLOT = 1 * MiB + 768 * 1024, WS_PERM = 1 * MiB + 512 * 1024;
constexpr size_t WS_WOUT = 4 * MiB, WS_WIN = 6 * MiB;
constexpr size_t WS_XN = 16 * MiB;
constexpr size_t WS_OF = 16 * MiB;
constexpr size_t WS_X2B = 16 * MiB;
constexpr size_t WS_HM = 144 * MiB;
constexpr size_t WS_X2F8 = 112 * MiB;
constexpr size_t WS_QH = 48 * MiB, WS_VH = 64 * MiB, WS_SG = 80 * MiB, WS_QD = 96 * MiB, WS_KD = 112 * MiB, WS_VD = 128 * MiB;
constexpr size_t WS_WGU = 48 * MiB, WS_WD = 216 * MiB;
constexpr size_t WS_GF = 144 * MiB, WS_GB = 176 * MiB;
constexpr size_t WS_MIX = 144 * MiB;
constexpr size_t WS_HS = 208 * MiB, WS_HL = 224 * MiB;
constexpr size_t WS_OB = 224 * MiB;
constexpr size_t WS_HG = 176 * MiB;
constexpr size_t WS_O0S = 176 * MiB;
constexpr size_t WS_Y = 48 * MiB;
constexpr size_t WS_END = 256 * MiB;
static_assert(WS_Y + (size_t)MAXSLOTS * 1024 * 2 <= WS_HM && WS_HM + (size_t)MAXSLOTS * 512 * 2 <= WS_WD && WS_WD + 32 * MiB <= WS_END, "ws map");
constexpr int CW_BAR = 4096, CW_CNT = 16384, CW_KMAX = 20480, CW_QWD = 21504, CW_READY = 32768, CNT_STRIDE = 64;

constexpr int PHASE_LDS = 147456, MISC_OFF = PHASE_LDS, LDS_BYTES = PHASE_LDS + 1024;

#define GAS __attribute__((address_space(1)))
#define LAS __attribute__((address_space(3)))
typedef unsigned short bf16_t;
typedef _Float16 half_t;
typedef float f32x4 __attribute__((ext_vector_type(4)));
typedef float f32x16 __attribute__((ext_vector_type(16)));
typedef short bf16x8 __attribute__((ext_vector_type(8)));
typedef short s16x4 __attribute__((ext_vector_type(4)));
typedef unsigned u32x4 __attribute__((ext_vector_type(4)));
typedef unsigned u32x2 __attribute__((ext_vector_type(2)));
#define LDS_WAIT() asm volatile("s_waitcnt lgkmcnt(0)" ::: "memory")
#define VM_WAIT() asm volatile("s_waitcnt vmcnt(0)" ::: "memory")
#define SBAR() __builtin_amdgcn_sched_barrier(0)
__device__ __forceinline__ unsigned f2bf(float f) { unsigned u = __builtin_bit_cast(unsigned, f); return (u + 0x7fffu + ((u >> 16) & 1u)) >> 16; }
__device__ __forceinline__ unsigned pk2(float lo, float hi) { return f2bf(lo) | (f2bf(hi) << 16); }
__device__ __forceinline__ float bf2f(unsigned b) { return __builtin_bit_cast(float, b << 16); }
__device__ __forceinline__ float bflo(unsigned w) { return __builtin_bit_cast(float, w << 16); }
__device__ __forceinline__ float bfhi(unsigned w) { return __builtin_bit_cast(float, w & 0xffff0000u); }
__device__ __forceinline__ unsigned cvtpk(float lo, float hi) { unsigned r; asm volatile("v_cvt_pk_bf16_f32 %0, %1, %2" : "=v"(r) : "v"(lo), "v"(hi)); return r; }
__device__ __forceinline__ unsigned pk4_fp8(float a, float b, float c, float d) { int w = 0; w = __builtin_amdgcn_cvt_pk_fp8_f32(a, b, w, false); w = __builtin_amdgcn_cvt_pk_fp8_f32(c, d, w, true); return (unsigned)w; }
constexpr float F8_WSCALE = 256.f, F8_HSCALE = 16.f, F8_YSCALE = 32.f;
__device__ __forceinline__ float ex2(float x) { return __builtin_amdgcn_exp2f(x); }
__device__ __forceinline__ float lg2(float x) { return __builtin_amdgcn_logf(x); }
__device__ __forceinline__ float sigmoidf_(float v) { return __builtin_amdgcn_rcpf(1.f + ex2(-1.4426950408889634f * v)); }
__device__ __forceinline__ bool lane_is_hi() { return (opaque_tid() & 32) != 0; }
template <int X> __device__ __forceinline__ float lane_xor(float v) {
    if constexpr (X == 32) { auto rr = __builtin_amdgcn_permlane32_swap(__float_as_uint(v), __float_as_uint(v), false, false); return __uint_as_float(lane_is_hi() ? rr[0] : rr[1]); }
    else return __int_as_float(__builtin_amdgcn_ds_swizzle(__float_as_int(v), (X << 10) | 0x1F));
}
__device__ __forceinline__ float wave_sum(float v) {
    v += lane_xor<1>(v); v += lane_xor<2>(v); v += lane_xor<4>(v); v += lane_xor<8>(v); v += lane_xor<16>(v);
    auto rr = __builtin_amdgcn_permlane32_swap(__float_as_uint(v), __float_as_uint(v), false, false);
    return __uint_as_float(rr[0]) + __uint_as_float(rr[1]);
}
__device__ __forceinline__ int crow(int r, int hi) { return (r & 3) + 8 * (r >> 2) + 4 * hi; }
#define XB_TMO      128
#define XB_XCNT(j)  (256  + 64 * (j))
#define XB_XSUB(j)  (1280 + 64 * (j))
#define XB_XGEN(j)  (2304 + 64 * (j))
#define XB_TOP      3328
#define XB_TOPGEN   3392
#define XCD_BAR_WORDS 3456
#define XB_SPIN_CAP (1u << 18)

__device__ __forceinline__ unsigned xb_ld(unsigned* p)              { return __hip_atomic_load(p, __ATOMIC_RELAXED, __HIP_MEMORY_SCOPE_AGENT); }
__device__ __forceinline__ unsigned xb_add(unsigned* p, unsigned v) { return __hip_atomic_fetch_add(p, v, __ATOMIC_RELAXED, __HIP_MEMORY_SCOPE_AGENT); }
__device__ __forceinline__ unsigned xb_xcc_id() { return (unsigned)__builtin_amdgcn_s_getreg((3 << 11) | 20) & 0xFu; }
#define XB_SPIN(cond, bar) do { unsigned _sp = 0; while (cond) { __builtin_amdgcn_s_sleep(1); \
    if ((++_sp & 255u) == 0u) { if (xb_ld(&(bar)[XB_TMO])) break; if (_sp > XB_SPIN_CAP) { atomicAdd(&(bar)[XB_TMO], 1u); break; } } } } while (0)

struct XcdBarrier {
    unsigned* bar; unsigned x;
    volatile LAS unsigned* st;
};

__device__ __forceinline__ XcdBarrier xcd_barrier_post(unsigned* bar, volatile LAS unsigned* st) {
    XcdBarrier b; b.bar = bar; b.x = xb_xcc_id(); b.st = st;
    if (threadIdx.x == 0) (void)xb_add(&bar[XB_XCNT(b.x)], 1u);
    return b;
}
__device__ __forceinline__ void xcd_barrier_complete(unsigned* bar, unsigned x, unsigned& nloc, unsigned& nx) {
    const unsigned G = gridDim.x * gridDim.y * gridDim.z;
    unsigned sum, cnt, mine, sp = 0u;
    for (;;) {
        sum = 0u; cnt = 0u; mine = 0u;
#pragma unroll
        for (unsigned j = 0; j < 16; ++j) { const unsigned c = xb_ld(&bar[XB_XCNT(j)]); sum += c; cnt += (c > 0u) ? 1u : 0u; mine = (j == x) ? c : mine; }
        if (sum == G) break;
        __builtin_amdgcn_s_sleep(1);
        if ((++sp & 255u) == 0u) { if (xb_ld(&bar[XB_TMO])) break; if (sp > XB_SPIN_CAP) { atomicAdd(&bar[XB_TMO], 1u); break; } }
    }
    nloc = mine > 0u ? mine : 1u; nx = cnt > 0u ? cnt : 1u;
}

__device__ __forceinline__ void xcd_barrier(const XcdBarrier& b) {
    asm volatile("s_waitcnt vmcnt(0)" ::: "memory");
    __syncthreads();
    if (threadIdx.x == 0) {
        unsigned* bar = b.bar;
        __builtin_amdgcn_s_waitcnt(0);
        unsigned nloc = b.st[0], nx = b.st[1];
        if (nloc == 0u) { xcd_barrier_complete(bar, b.x, nloc, nx); b.st[0] = nloc; b.st[1] = nx; }
        const unsigned old = xb_add(&bar[XB_XSUB(b.x)], 1u);
        const unsigned gen = old / nloc;
        if (old + 1u == (gen + 1u) * nloc) {
            __builtin_amdgcn_fence(__ATOMIC_RELEASE, "agent");
            asm volatile("s_waitcnt vmcnt(0)" ::: "memory");
            const unsigned og = xb_add(&bar[XB_TOP], 1u);
            const unsigned tg = og / nx;
            if (og + 1u == (tg + 1u) * nx) xb_add(&bar[XB_TOPGEN], 1u);
            else XB_SPIN(xb_ld(&bar[XB_TOPGEN]) == tg, bar);
            __builtin_amdgcn_fence(__ATOMIC_ACQUIRE, "agent");
            xb_add(&bar[XB_XGEN(b.x)], 1u);
            asm volatile("s_waitcnt vmcnt(0)" ::: "memory");
        } else {
            XB_SPIN(xb_ld(&bar[XB_XGEN(b.x)]) == gen, bar);
            __builtin_amdgcn_fence(__ATOMIC_ACQUIRE, "agent");
            asm volatile("s_waitcnt vmcnt(0)" ::: "memory");
        }
    }
    __syncthreads();
}

struct XposeRegs { f32x4 v[8]; };
__device__ __forceinline__ void xpose_load(XposeRegs& R, const float* W, int K, int N, int item, int lane) {
    const int nblk = N / 32, kb = item / nblk, nb = item % nblk, k0 = 64 * kb, n0 = 32 * nb; (void)K;
    const float* p = W + (size_t)(k0 + (lane >> 3)) * N + n0 + (lane & 7) * 4;
#pragma unroll
    for (int i = 0; i < 8; ++i) R.v[i] = __builtin_nontemporal_load((const GAS f32x4*)(p + (size_t)(8 * i) * N));
}
__device__ __forceinline__ void xpose_store(const XposeRegs& R, int K, int N, bf16_t* WT, int row_off, int row_mul, LAS float* scr, int item, int lane, const float* kgain = nullptr) {
    const int nblk = N / 32, kb = item / nblk, nb = item % nblk, k0 = 64 * kb, n0 = 32 * nb;
#pragma unroll
    for (int i = 0; i < 8; ++i) { LAS float* d = scr + (8 * i + (lane >> 3)) * 33 + (lane & 7) * 4; d[0] = R.v[i].x; d[1] = R.v[i].y; d[2] = R.v[i].z; d[3] = R.v[i].w; }
    LDS_WAIT(); asm volatile("" ::: "memory");
    const int c = lane & 7;
    f32x4 g0 = {1.f, 1.f, 1.f, 1.f}, g1 = g0;
    if (kgain) { g0 = *(const GAS f32x4*)(kgain + k0 + 8 * c); g1 = *(const GAS f32x4*)(kgain + k0 + 8 * c + 4); }
#pragma unroll
    for (int j = 0; j < 4; ++j) { const int n = (lane >> 3) + 8 * j; const LAS float* s = scr + (8 * c) * 33 + n;
        u32x4 o; o.x = cvtpk(s[0 * 33] * g0.x, s[1 * 33] * g0.y); o.y = cvtpk(s[2 * 33] * g0.z, s[3 * 33] * g0.w); o.z = cvtpk(s[4 * 33] * g1.x, s[5 * 33] * g1.y); o.w = cvtpk(s[6 * 33] * g1.z, s[7 * 33] * g1.w);
        *(GAS u32x4*)(WT + (size_t)(row_off + (n0 + n) * row_mul) * K + k0 + 8 * c) = o; }
    LDS_WAIT(); asm volatile("" ::: "memory");
}
__device__ __forceinline__ void xpose_store_f8(const XposeRegs& R, int K, int N, unsigned char* WT, int row_off, int row_mul, LAS float* scr, int item, int lane, float scale, const float* kgain = nullptr) {
    const int nblk = N / 32, kb = item / nblk, nb = item % nblk, k0 = 64 * kb, n0 = 32 * nb;
#pragma unroll
    for (int i = 0; i < 8; ++i) { LAS float* d = scr + (8 * i + (lane >> 3)) * 33 + (lane & 7) * 4; d[0] = R.v[i].x; d[1] = R.v[i].y; d[2] = R.v[i].z; d[3] = R.v[i].w; }
    LDS_WAIT(); asm volatile("" ::: "memory");
    const int c = lane & 7;
    f32x4 g0 = {scale, scale, scale, scale}, g1 = g0;
    if (kgain) { g0 = *(const GAS f32x4*)(kgain + k0 + 8 * c) * scale; g1 = *(const GAS f32x4*)(kgain + k0 + 8 * c + 4) * scale; }
#pragma unroll
    for (int j = 0; j < 4; ++j) { const int n = (lane >> 3) + 8 * j; const LAS float* s = scr + (8 * c) * 33 + n;
        u32x2 o; o.x = pk4_fp8(s[0 * 33] * g0.x, s[1 * 33] * g0.y, s[2 * 33] * g0.z, s[3 * 33] * g0.w); o.y = pk4_fp8(s[4 * 33] * g1.x, s[5 * 33] * g1.y, s[6 * 33] * g1.z, s[7 * 33] * g1.w);
        *(GAS u32x2*)(WT + (size_t)(row_off + (n0 + n) * row_mul) * K + k0 + 8 * c) = o; }
    LDS_WAIT(); asm volatile("" ::: "memory");
}
template <int NR>
__device__ __forceinline__ void rms_rows_to_bf16(const float* X, const float* gain, bf16_t* O, int m0, int stride, int lane, float eps) {
    f32x4 v[NR][4]; float s[NR];
#pragma unroll
    for (int i = 0; i < NR; ++i) { const GAS f32x4* xr = (const GAS f32x4*)(X + (size_t)(m0 + i * stride) * D) + lane;
#pragma unroll
        for (int j = 0; j < 4; ++j) v[i][j] = xr[64 * j]; }
#pragma unroll
    for (int i = 0; i < NR; ++i) { float t = 0.f;
#pragma unroll
        for (int j = 0; j < 4; ++j) t += (v[i][j].x * v[i][j].x + v[i][j].y * v[i][j].y) + (v[i][j].z * v[i][j].z + v[i][j].w * v[i][j].w);
        s[i] = t; }
#pragma unroll
    for (int i = 0; i < NR; ++i) s[i] = 1.f / sqrtf(wave_sum(s[i]) * (1.f / 1024.f) + eps);
#pragma unroll
    for (int j = 0; j < 4; ++j) { const f32x4 g = ((const GAS f32x4*)gain)[64 * j + lane];
#pragma unroll
        for (int i = 0; i < NR; ++i) { u32x2 w; w.x = cvtpk(v[i][j].x * s[i] * g.x, v[i][j].y * s[i] * g.y); w.y = cvtpk(v[i][j].z * s[i] * g.z, v[i][j].w * s[i] * g.w);
            ((GAS u32x2*)(O + (size_t)(m0 + i * stride) * D) + lane)[64 * j] = w; } }
}

struct EpiInProj {
    static constexpr bool PERM = true, AFTER_DRAIN = false;
    bf16_t *QH, *VH, *SG, *QD, *KD, *VD; half_t *GF, *GB; const float* lbraw; const float *cosT, *sinT;
    __device__ __forceinline__ void operator()(const pg8::f32x4 (&acc)[2][2][4][2], const pg8::Unit& u, int wr, int wc, int fr, int fq) const {
        const int sec = u.pn >> 1;
        const int row0 = u.pm * 256 + wr * 64 + fr;
        const int cs0 = (u.pn & 1) * 256 + wc * 32 + 8 * fq;
        if (sec == 1 || sec == 2) {
            half_t* G = sec == 1 ? GF : GB; const float* lbp = lbraw + (sec - 1) * 1024;
#pragma unroll
            for (int bj = 0; bj < 2; ++bj) { const int c = cs0 + bj * 128; float lb[8];
#pragma unroll
                for (int j = 0; j < 8; ++j) { const float l0 = lbp[c + j], l1 = lbp[512 + c + j]; lb[j] = __builtin_amdgcn_rcpf(1.f + ex2(1.4426950408889634f * (l0 - l1))); }
#pragma unroll
                for (int ai = 0; ai < 2; ++ai)
#pragma unroll
                    for (int m = 0; m < 4; ++m) { const int row = row0 + ai * 128 + m * 16; f32x4 o0, o1;
#pragma unroll
                        for (int j = 0; j < 4; ++j) { o0[j] = lb[j] + (1.f - lb[j]) * sigmoidf_(acc[ai][bj][m][0][j]); o1[j] = lb[4 + j] + (1.f - lb[4 + j]) * sigmoidf_(acc[ai][bj][m][1][j]); }
                        typedef _Float16 h8 __attribute__((ext_vector_type(8)));
                        const h8 hv = {(_Float16)o0[0], (_Float16)o0[1], (_Float16)o0[2], (_Float16)o0[3], (_Float16)o1[0], (_Float16)o1[1], (_Float16)o1[2], (_Float16)o1[3]};
                        *(h8*)(G + (size_t)row * HSEC + c) = hv; } }
            return;
        }
        bf16_t* O = sec == 0 ? QH : sec == 3 ? VH : sec == 4 ? SG : sec == 5 ? QD : sec == 6 ? KD : VD;
        const bool rot = (sec == 5 || sec == 6) && ((wc & 1) == 0);
        const float sc = sec == 5 ? QSCALE : 1.f;
#pragma unroll
        for (int ai = 0; ai < 2; ++ai)
#pragma unroll
            for (int m = 0; m < 4; ++m) { const int row = row0 + ai * 128 + m * 16;
#pragma unroll
                for (int bj = 0; bj < 2; ++bj) { const int c = cs0 + bj * 128; float v[8];
#pragma unroll
                    for (int j = 0; j < 4; ++j) { v[j] = acc[ai][bj][m][0][j]; v[4 + j] = acc[ai][bj][m][1][j]; }
                    if (sec == 4) {
#pragma unroll
                        for (int j = 0; j < 8; ++j) v[j] = v[j] * sigmoidf_(v[j]);
                    }
                    if (rot) {
                        const f32x4 c0 = *(const f32x4*)(cosT + (size_t)row * 8), c1 = *(const f32x4*)(cosT + (size_t)row * 8 + 4);
                        const f32x4 s0 = *(const f32x4*)(sinT + (size_t)row * 8), s1 = *(const f32x4*)(sinT + (size_t)row * 8 + 4);
#pragma unroll
                        for (int j = 0; j < 8; ++j) { const float p = lane_xor<16>(v[j]); const float cj = j < 4 ? c0[j & 3] : c1[j & 3], sj = j < 4 ? s0[j & 3] : s1[j & 3];
                            const float r = fq == 0 ? v[j] * cj - p * sj : v[j] * cj + p * sj; v[j] = fq < 2 ? r : v[j]; }
                    }
                    u32x4 w; w.x = cvtpk(v[0] * sc, v[1] * sc); w.y = cvtpk(v[2] * sc, v[3] * sc); w.z = cvtpk(v[4] * sc, v[5] * sc); w.w = cvtpk(v[6] * sc, v[7] * sc);
                    *(u32x4*)(O + (size_t)row * HSEC + c) = w; } }
    }
};
struct EpiResid {
    static constexpr bool PERM = true, AFTER_DRAIN = false;
    const float* X; bf16_t* O; unsigned char* O8;
    __device__ __forceinline__ void operator()(const pg8::f32x4 (&acc)[2][2][4][2], const pg8::Unit& u, int wr, int wc, int fr, int fq) const {
        const int row0 = u.pm * 256 + wr * 64 + fr, col0 = u.pn * 256 + wc * 32 + 8 * fq;
#pragma unroll
        for (int ai = 0; ai < 2; ++ai)
#pragma unroll
            for (int m = 0; m < 4; ++m) { const size_t off = (size_t)(row0 + ai * 128 + m * 16) * D + col0;
#pragma unroll
                for (int bj = 0; bj < 2; ++bj) { const f32x4 a = *(const f32x4*)(X + off + bj * 128) + acc[ai][bj][m][0], b = *(const f32x4*)(X + off + bj * 128 + 4) + acc[ai][bj][m][1];
                    u32x4 w; w.x = cvtpk(a[0], a[1]); w.y = cvtpk(a[2], a[3]); w.z = cvtpk(b[0], b[1]); w.w = cvtpk(b[2], b[3]); *(u32x4*)(O + off + bj * 128) = w;
                    u32x2 f; f.x = pk4_fp8(a[0], a[1], a[2], a[3]); f.y = pk4_fp8(b[0], b[1], b[2], b[3]); *(u32x2*)(O8 + off + bj * 128) = f; } }
    }
};
struct EpiSwiGlu {
    unsigned char* O; const float* RS;
    __device__ __forceinline__ void operator()(const f32x4 (&acc)[2][4][2], const pg8::Unit& u, int wr, int wc, int fr, int fq) const {
        const int row0 = u.pm * 128 + wr * 64 + fr, col0 = ((u.pn & 3) * 256 + wc * 32 + 8 * fq) >> 1;
#pragma unroll
        for (int m = 0; m < 4; ++m) { const int row = row0 + m * 16; const float rs = RS[row] * (1.f / F8_WSCALE); unsigned char* rowp = O + (size_t)row * DEXP + col0;
#pragma unroll
            for (int bj = 0; bj < 2; ++bj) { const f32x4 a = acc[bj][m][0] * rs, b = acc[bj][m][1] * rs;
                const float h0 = a[0] * sigmoidf_(a[0]) * a[1], h1 = a[2] * sigmoidf_(a[2]) * a[3], h2 = b[0] * sigmoidf_(b[0]) * b[1], h3 = b[2] * sigmoidf_(b[2]) * b[3];
                *(unsigned*)(rowp + bj * 64) = pk4_fp8(__builtin_amdgcn_fmed3f(h0 * F8_HSCALE, -448.f, 448.f), __builtin_amdgcn_fmed3f(h1 * F8_HSCALE, -448.f, 448.f), __builtin_amdgcn_fmed3f(h2 * F8_HSCALE, -448.f, 448.f), __builtin_amdgcn_fmed3f(h3 * F8_HSCALE, -448.f, 448.f)); } }
    }
};
struct EpiDown {
    unsigned char* O;
    __device__ __forceinline__ void operator()(const f32x4 (&acc)[2][4][2], const pg8::Unit& u, int wr, int wc, int fr, int fq) const {
        const int row0 = u.pm * 128 + wr * 64 + fr, col0 = (u.pn & 3) * 256 + wc * 32 + 8 * fq; constexpr float us = F8_YSCALE / (F8_WSCALE * F8_HSCALE);
#pragma unroll
        for (int m = 0; m < 4; ++m) { unsigned char* rowp = O + (size_t)(row0 + m * 16) * D + col0;
#pragma unroll
            for (int bj = 0; bj < 2; ++bj) { const f32x4 a = acc[bj][m][0] * us, b = acc[bj][m][1] * us;
                u32x2 w; w.x = pk4_fp8(__builtin_amdgcn_fmed3f(a[0], -448.f, 448.f), __builtin_amdgcn_fmed3f(a[1], -448.f, 448.f), __builtin_amdgcn_fmed3f(a[2], -448.f, 448.f), __builtin_amdgcn_fmed3f(a[3], -448.f, 448.f));
                w.y = pk4_fp8(__builtin_amdgcn_fmed3f(b[0], -448.f, 448.f), __builtin_amdgcn_fmed3f(b[1], -448.f, 448.f), __builtin_amdgcn_fmed3f(b[2], -448.f, 448.f), __builtin_amdgcn_fmed3f(b[3], -448.f, 448.f));
                *(u32x2*)(rowp + bj * 128) = w; } }
    }
};
struct MoeOrder {
    const volatile LAS int* tb; int G, c; const int* PERM; unsigned* ready; int mode;
    __device__ __forceinline__ bool decode(int L, pg8::Unit& u) const {
        const int x = c & 7; int base = 0;
#pragma unroll 1
        for (int k = 0; k < 4; ++k) { const int e = 4 * x + k, t0 = __builtin_amdgcn_readfirstlane(tb[e]), nt = __builtin_amdgcn_readfirstlane(tb[e + 1]) - t0;
            if (L < base + 4 * nt) { const int idx = L - base; u.pm = t0 + idx % nt; u.pn = e * 4 + idx / nt; return true; }
            base += 4 * nt; }
        return false;
    }
    __device__ __forceinline__ bool next(int i, pg8::Unit& u) const {
        if ((G & 7) == 0) {
            const int x = c & 7, s = c >> 3, nb = G >> 3;
            const int U = 4 * (__builtin_amdgcn_readfirstlane(tb[4 * x + 4]) - __builtin_amdgcn_readfirstlane(tb[4 * x]));
            if (mode == 0) return decode(i * nb + s, u);
            const int i0 = s < U ? (U - s + nb - 1) / nb : 0;
            return decode((i0 + i) * nb + s - U, u);
        }
        const int L = i * G + c, T = __builtin_amdgcn_readfirstlane(tb[32]); if (L >= 4 * T) return false;
        const int tile = L >> 2; int e = 0;
#pragma unroll 1
        for (int j = 1; j < 32; ++j) e += (__builtin_amdgcn_readfirstlane(tb[j]) <= tile) ? 1 : 0;
        u.pm = tile; u.pn = e * 4 + (L & 3); return true;
    }
    __device__ __forceinline__ int row_tok(const pg8::Unit& u, int r) const {
        const int e = u.pn >> 2, rem = __builtin_amdgcn_readfirstlane(tb[64 + e]) - (u.pm - __builtin_amdgcn_readfirstlane(tb[e])) * 128;
        return r < rem ? PERM[u.pm * 128 + r] : 0;
    }
    __device__ __forceinline__ bool half_only(const pg8::Unit&) const { return false; }
    __device__ __forceinline__ void done(const pg8::Unit& u) const {
        if (mode == 2) { asm volatile("s_waitcnt vmcnt(0)" ::: "memory");
            if ((threadIdx.x & 63) == 0) __hip_atomic_fetch_add(ready + 64 * u.pm, 1u, __ATOMIC_RELAXED, __HIP_MEMORY_SCOPE_AGENT); }
    }
    __device__ __forceinline__ void a_ready(const pg8::Unit& u) const {
        if (mode == 1) {
            if (threadIdx.x < 64) { const unsigned long long t0 = __builtin_amdgcn_s_memrealtime();
                while ((unsigned)__builtin_amdgcn_readfirstlane(__hip_atomic_load(ready + 64 * u.pm, __ATOMIC_RELAXED, __HIP_MEMORY_SCOPE_AGENT)) < 32u) {
                    if (__builtin_amdgcn_s_memrealtime() - t0 > 2000000ull) break;
                    __builtin_amdgcn_s_sleep(2); }
                __builtin_amdgcn_fence(__ATOMIC_ACQUIRE, "agent");
                asm volatile("s_waitcnt vmcnt(0)" ::: "memory"); }
            asm volatile("" ::: "memory"); __builtin_amdgcn_s_barrier(); asm volatile("" ::: "memory");
        }
    }
};

namespace mg {
constexpr int TM = 128, BUF = 3 * pg8::HTB;
#define MG_WAIT_V(n) asm volatile("s_waitcnt vmcnt(" #n ")" ::: "memory")
#define MG_WAIT_L0() asm volatile("s_waitcnt lgkmcnt(0)" ::: "memory")
#define MG_BAR() do { asm volatile("" ::: "memory"); __builtin_amdgcn_s_barrier(); asm volatile("" ::: "memory"); __builtin_amdgcn_sched_barrier(0); } while (0)
struct Frags { bf16x8 a[4][2], b[2][2][2]; };
template <class Epi, class Sched, bool GATHER>
__device__ __forceinline__ void gemm(LAS unsigned char* lds, const unsigned char* A, const unsigned char* Bt, int Kb, const Sched& S, const Epi& E) {
    const int tid = opaque_tid(), wid = __builtin_amdgcn_readfirstlane(tid >> 6), lane = tid & 63, wr = wid >> 2, wc = wid & 3, fr = lane & 15, fq = lane >> 4;
    asm volatile("" : "+s"(Kb));
    const int nkt = Kb >> 7;
    unsigned voffB[2], colA[2]; int rowA[2];
#pragma unroll
    for (int i = 0; i < 2; ++i) { int R, C; pg8::stage_rc(tid * 16 + i * 8192, R, C); const int Rb = (R & ~31) + pg8::perm32(R & 31);
        rowA[i] = R; colA[i] = (unsigned)C * 2u; voffB[i] = (unsigned)(Rb * Kb) + (unsigned)C * 2u; }
    const unsigned ldsw = (unsigned)wid * 1024u;
    const int aoff = pg8::lds_byte(wr * 64 + fr, fq * 8), boff = pg8::lds_byte(wc * 32 + fr, fq * 8);
    const size_t bhalf = (size_t)128 * Kb;
#define MG_DMA(slot_, ao_, bb_, kt_) do { const unsigned so_ = (unsigned)(slot_) * BUF; const size_t ko_ = (size_t)(kt_) * 128; \
        _Pragma("unroll") for (int i_ = 0; i_ < 2; ++i_) __builtin_amdgcn_global_load_lds((const unsigned*)(A + (size_t)(ao_)[i_] + ko_), (LAS unsigned*)(lds + so_ + ldsw + i_ * 8192), 16, 0, 0); \
        _Pragma("unroll") for (int h_ = 0; h_ < 2; ++h_) _Pragma("unroll") for (int i_ = 0; i_ < 2; ++i_) \
            __builtin_amdgcn_global_load_lds((const unsigned*)((bb_) + h_ * bhalf + voffB[i_] + ko_), (LAS unsigned*)(lds + so_ + (1 + h_) * pg8::HTB + ldsw + i_ * 8192), 16, 0, 0); } while (0)
#define MG_READ(F_, slot_) do { const LAS unsigned char* p_ = lds + (unsigned)(slot_) * BUF; \
        _Pragma("unroll") for (int m = 0; m < 4; ++m) _Pragma("unroll") for (int k = 0; k < 2; ++k) F_.a[m][k] = *(const LAS bf16x8*)(p_ + aoff + m * 2048 + k * 1024); \
        _Pragma("unroll") for (int bj = 0; bj < 2; ++bj) _Pragma("unroll") for (int n = 0; n < 2; ++n) _Pragma("unroll") for (int k = 0; k < 2; ++k) \
            F_.b[bj][n][k] = *(const LAS bf16x8*)(p_ + (1 + bj) * pg8::HTB + boff + n * 2048 + k * 1024); } while (0)
#ifndef MG_SCALED
#define MG_SCALED 1
#endif
#if MG_SCALED
#define MG_MMA(F_) do { typedef int v4i_ __attribute__((ext_vector_type(4))); __builtin_amdgcn_s_setprio(1); \
        _Pragma("unroll") for (int bj = 0; bj < 2; ++bj) _Pragma("unroll") for (int m = 0; m < 4; ++m) _Pragma("unroll") for (int n = 0; n < 2; ++n) \
            acc[bj][m][n] = __builtin_amdgcn_mfma_scale_f32_16x16x128_f8f6f4(__builtin_shufflevector(__builtin_bit_cast(v4i_, F_.b[bj][n][0]), __builtin_bit_cast(v4i_, F_.b[bj][n][1]), 0, 1, 2, 3, 4, 5, 6, 7), \
                __builtin_shufflevector(__builtin_bit_cast(v4i_, F_.a[m][0]), __builtin_bit_cast(v4i_, F_.a[m][1]), 0, 1, 2, 3, 4, 5, 6, 7), acc[bj][m][n], 0, 0, 0, 0x7F7F7F7F, 0, 0x7F7F7F7F); \
        __builtin_amdgcn_s_setprio(0); } while (0)
#else
#define MG_MMA(F_) do { typedef long v2l_ __attribute__((ext_vector_type(2))); __builtin_amdgcn_s_setprio(1); \
        _Pragma("unroll") for (int bj = 0; bj < 2; ++bj) _Pragma("unroll") for (int m = 0; m < 4; ++m) _Pragma("unroll") for (int n = 0; n < 2; ++n) _Pragma("unroll") for (int k = 0; k < 2; ++k) { \
            const v2l_ b_ = __builtin_bit_cast(v2l_, F_.b[bj][n][k]), a_ = __builtin_bit_cast(v2l_, F_.a[m][k]); \
            acc[bj][m][n] = __builtin_amdgcn_mfma_f32_16x16x32_fp8_fp8(b_[0], a_[0], acc[bj][m][n], 0, 0, 0); acc[bj][m][n] = __builtin_amdgcn_mfma_f32_16x16x32_fp8_fp8(b_[1], a_[1], acc[bj][m][n], 0, 0, 0); } \
        __builtin_amdgcn_s_setprio(0); } while (0)
#endif
#define MG_AOFS(dst_, u_) do { _Pragma("unroll") for (int i_ = 0; i_ < 2; ++i_) dst_[i_] = (GATHER ? (unsigned)S.row_tok(u_, rowA[i_]) : (unsigned)((u_).pm * TM + rowA[i_])) * (unsigned)Kb + colA[i_]; } while (0)
    pg8::Unit cur, nxt; int ui = 0;
    if (!S.next(0, cur)) return;
    f32x4 acc[2][4][2];
#pragma unroll
    for (int b = 0; b < 2; ++b)
#pragma unroll
        for (int m = 0; m < 4; ++m)
#pragma unroll
            for (int n = 0; n < 2; ++n) acc[b][m][n] = (f32x4){0.f, 0.f, 0.f, 0.f};
    unsigned ac[2], an[2];
    MG_AOFS(ac, cur);
    const unsigned char* bc = Bt + (size_t)cur.pn * 256 * Kb;
    Frags FA, FB;
    MG_DMA(0, ac, bc, 0); MG_DMA(1, ac, bc, 1); MG_DMA(2, ac, bc, 2);
    MG_WAIT_V(12); MG_BAR();
    MG_READ(FA, 0); MG_WAIT_L0();
    int sl = 0;
    for (;;) {
        const bool has_next = S.next(ui + 1, nxt);
        if (!has_next) nxt = cur;
        const unsigned char* bn = Bt + (size_t)nxt.pn * 256 * Kb;
        MG_AOFS(an, nxt);
#pragma unroll 1
        for (int kt = 0; kt < nkt; kt += 2) {
            if (!(kt == 0 && ui > 0)) MG_WAIT_V(6);
            MG_BAR();
            if (kt + 3 < nkt) MG_DMA(sl, ac, bc, kt + 3); else MG_DMA(sl, an, bn, kt + 3 - nkt);
            const int s1 = sl == 2 ? 0 : sl + 1;
            MG_READ(FB, s1); __builtin_amdgcn_sched_barrier(0);
            MG_MMA(FA); __builtin_amdgcn_sched_barrier(0);
            MG_WAIT_L0();
            MG_WAIT_V(6); MG_BAR();
            if (kt + 4 < nkt) MG_DMA(s1, ac, bc, kt + 4); else MG_DMA(s1, an, bn, kt + 4 - nkt);
            const int s2 = s1 == 2 ? 0 : s1 + 1;
            MG_READ(FA, s2); __builtin_amdgcn_sched_barrier(0);
            MG_MMA(FB); __builtin_amdgcn_sched_barrier(0);
            if (kt + 2 == nkt) { MG_WAIT_V(6); E(acc, cur, wr, wc, fr, fq);
#pragma unroll
                for (int b = 0; b < 2; ++b)
#pragma unroll
                    for (int m = 0; m < 4; ++m)
#pragma unroll
                        for (int n = 0; n < 2; ++n) acc[b][m][n] = (f32x4){0.f, 0.f, 0.f, 0.f}; }
            MG_WAIT_L0();
            sl = s2;
        }
        if (!has_next) break;
        cur = nxt; ac[0] = an[0]; ac[1] = an[1]; bc = bn; ++ui;
    }
    MG_WAIT_V(0); MG_BAR();
#undef MG_DMA
#undef MG_READ
#undef MG_MMA
#undef MG_AOFS
}
}

namespace hg {
typedef short v4i16_t __attribute__((ext_vector_type(4)));
constexpr int S128 = 272, S64 = 144;
constexpr int L_QD = 0, L_QE = L_QD + 64 * S128, L_KE = L_QE + 64 * S128, L_VR = L_KE + 64 * S128, L_ST = L_VR + 64 * S128,
              L_P = L_ST + 128 * S128, L_QS = L_P + 64 * S64, L_DC = L_QS + 16 * 128 * 4, L_END = L_DC + 128 * 4;
static_assert(L_END <= PHASE_LDS, "hgrn LDS");
__device__ __forceinline__ bf16x8 frag(const LAS unsigned char* base, int row, int stride, int kb  ) { return *(const LAS bf16x8*)(base + row * stride + kb); }
__device__ __forceinline__ bf16x8 trfrag(const LAS unsigned char* tile, int tok0, int chan0, int lane) {
    const LAS unsigned char* p = tile + (tok0 + 8 * (lane >> 5) + ((lane & 15) >> 2)) * S128 + (chan0 + 16 * ((lane >> 4) & 1) + 4 * (lane & 3)) * 2;
    const s16x4 lo = __builtin_bit_cast(s16x4, __builtin_amdgcn_ds_read_tr16_b64_v4i16((LAS v4i16_t*)p)), hi = __builtin_bit_cast(s16x4, __builtin_amdgcn_ds_read_tr16_b64_v4i16((LAS v4i16_t*)(p + 4 * S128)));
    return (bf16x8){lo[0], lo[1], lo[2], lo[3], hi[0], hi[1], hi[2], hi[3]};
}

template <bool PASS_C, int ABL = 0>
__device__ __forceinline__ void pass(LAS unsigned char* lds, int unit, const bf16_t* QH, const bf16_t* VH, const half_t* GF, const half_t* GB,
                                     float* HL, float* HD, const float* HS, float* OF, float* OB) {
    typedef _Float16 h4 __attribute__((ext_vector_type(4)));
    const int tid = opaque_tid(), lane = tid & 63, wid = __builtin_amdgcn_readfirstlane(tid >> 6), r32 = lane & 31, hi = lane >> 5;
    const int dir = unit >> 7, head = (unit >> 5) & 3, sc = unit & 31;
    const int kq = tid & 31, tq = tid >> 5;
    const half_t* G = dir ? GB : GF; float* O = dir ? OB : OF;
    const int vi = wid >> 1, ki0 = (wid & 1) * 2;
    f32x16 sacc[2];
    LAS f32x4* QS = (LAS f32x4*)(lds + L_QS); LAS float* DC = (LAS float*)(lds + L_DC);
    if (PASS_C) {
        const float* hs = HS + (size_t)unit * 16384;
#pragma unroll
        for (int tt = 0; tt < 2; ++tt)
#pragma unroll
            for (int r = 0; r < 16; r += 2) { const int v = vi * 32 + crow(r, hi), kk = (ki0 + tt) * 32 + r32; const float s0 = hs[v * 128 + kk], s1 = hs[(v + 1) * 128 + kk]; sacc[tt][r] = s0; sacc[tt][r + 1] = s1;
                const unsigned w = cvtpk(s0, s1); *(LAS bf16_t*)(lds + L_ST + v * S128 + kk * 2) = (bf16_t)(w & 0xffffu); *(LAS bf16_t*)(lds + L_ST + (v + 1) * S128 + kk * 2) = (bf16_t)(w >> 16); }
    } else { sacc[0] = f32x16{}; sacc[1] = f32x16{}; }
    f32x4 btot = {1.f, 1.f, 1.f, 1.f};
    h4 gh[4]; u32x2 qv[4], vv[4];
#define HG_LOAD(c_) do { const int tb_ = sc * 512 + (c_) * 64 + 4 * tq; _Pragma("unroll") for (int i = 0; i < 4; ++i) { const int tl = tb_ + i, tok = dir ? (M - 1 - tl) : tl; \
        const size_t off = (size_t)tok * HSEC + head * 128 + 4 * kq; gh[i] = *(const h4*)(G + off); vv[i] = *(const u32x2*)(VH + off); if (PASS_C) qv[i] = *(const u32x2*)(QH + off); } } while (0)
    HG_LOAD(0);
#pragma unroll 1
    for (int c = 0; c < 8; ++c) {
        const int t0 = sc * 512 + c * 64;
        f32x4 g[4], b[4];
#pragma unroll
        for (int i = 0; i < 4; ++i) { g[i] = (f32x4){(float)gh[i][0], (float)gh[i][1], (float)gh[i][2], (float)gh[i][3]}; b[i] = i ? b[i - 1] * g[i] : g[i]; }
        QS[tq * 32 + kq] = b[3];
        LDS_WAIT(); __syncthreads();
        if (tid < 128) { LAS float* qs = (LAS float*)QS; float run = 1.f;
#pragma unroll
            for (int q = 0; q < 16; ++q) { const float t = qs[q * 128 + tid]; qs[q * 128 + tid] = run; run *= t; }
            DC[tid] = run; }
        LDS_WAIT(); __syncthreads();
        const f32x4 pre = QS[tq * 32 + kq], etot = *(const LAS f32x4*)(DC + 4 * kq);
        btot *= etot;
        f32x4 itot; itot[0] = __builtin_amdgcn_rcpf(etot[0]); itot[1] = __builtin_amdgcn_rcpf(etot[1]); itot[2] = __builtin_amdgcn_rcpf(etot[2]); itot[3] = __builtin_amdgcn_rcpf(etot[3]);
#pragma unroll
        for (int i = 0; i < 4; ++i) { const int tr = 4 * tq + i; float ke[4], qd[4], qe[4];
            const float q4[4] = {bflo(qv[i].x), bfhi(qv[i].x), bflo(qv[i].y), bfhi(qv[i].y)};
#pragma unroll
            for (int cc = 0; cc < 4; ++cc) { const float pb = b[i][cc] * pre[cc];
                ke[cc] = (1.f - g[i][cc]) * etot[cc] * __builtin_amdgcn_rcpf(pb);
                if (PASS_C) { qd[cc] = q4[cc] * pb; qe[cc] = qd[cc] * itot[cc]; } }
            *(LAS u32x2*)(lds + L_KE + tr * S128 + kq * 8) = (u32x2){cvtpk(ke[0], ke[1]), cvtpk(ke[2], ke[3])};
            *(LAS u32x2*)(lds + L_VR + tr * S128 + kq * 8) = vv[i];
            if (PASS_C) { *(LAS u32x2*)(lds + L_QD + tr * S128 + kq * 8) = (u32x2){cvtpk(qd[0], qd[1]), cvtpk(qd[2], qd[3])};
                *(LAS u32x2*)(lds + L_QE + tr * S128 + kq * 8) = (u32x2){cvtpk(qe[0], qe[1]), cvtpk(qe[2], qe[3])}; } }
        LDS_WAIT(); __syncthreads();
        if (c < 7 && !(ABL & 2)) HG_LOAD(c + 1);
        if (PASS_C && !(ABL & 4)) {
            if (wid < 4) {
                const int ti = wid >> 1, si = wid & 1; f32x16 p = f32x16{};
                if (!(ti == 0 && si == 1)) {
#pragma unroll
                    for (int ks = 0; ks < 8; ++ks) p = __builtin_amdgcn_mfma_f32_32x32x16_bf16(frag(lds + L_QE, ti * 32 + r32, S128, ks * 32 + hi * 16), frag(lds + L_KE, si * 32 + r32, S128, ks * 32 + hi * 16), p, 0, 0, 0);
                }
#pragma unroll
                for (int r = 0; r < 16; r += 2) { const int t = ti * 32 + crow(r, hi), s = si * 32 + r32; const unsigned w = cvtpk(s <= t ? p[r] : 0.f, s <= t + 1 ? p[r + 1] : 0.f);
                    *(LAS bf16_t*)(lds + L_P + t * S64 + s * 2) = (bf16_t)(w & 0xffffu); *(LAS bf16_t*)(lds + L_P + (t + 1) * S64 + s * 2) = (bf16_t)(w >> 16); }
            }
            LDS_WAIT(); __syncthreads();
            { const int ti = wid >> 2, vo = wid & 3; f32x16 o = f32x16{};
#pragma unroll
                for (int ks = 0; ks < 8; ++ks) o = __builtin_amdgcn_mfma_f32_32x32x16_bf16(frag(lds + L_QD, ti * 32 + r32, S128, ks * 32 + hi * 16), frag(lds + L_ST, vo * 32 + r32, S128, ks * 32 + hi * 16), o, 0, 0, 0);
#pragma unroll
                for (int ss = 0; ss < 4; ++ss) o = __builtin_amdgcn_mfma_f32_32x32x16_bf16(frag(lds + L_P, ti * 32 + r32, S64, ss * 32 + hi * 16), trfrag(lds + L_VR, ss * 16, vo * 32, lane), o, 0, 0, 0);
#pragma unroll
                for (int r = 0; r < 16; ++r) { const int tl = t0 + ti * 32 + crow(r, hi), tok = dir ? (M - 1 - tl) : tl; if (!(ABL & 1)) O[(size_t)tok * HSEC + head * 128 + vo * 32 + r32] = o[r]; else asm volatile("" :: "v"(o[r])); }
            }
        }
#pragma unroll
        for (int tt = 0; tt < ((ABL & 4) ? 0 : 2); ++tt) { const int ki = ki0 + tt; const float d = DC[ki * 32 + r32];
#pragma unroll
            for (int r = 0; r < 16; ++r) sacc[tt][r] *= d;
#pragma unroll
            for (int ss = 0; ss < 4; ++ss) sacc[tt] = __builtin_amdgcn_mfma_f32_32x32x16_bf16(trfrag(lds + L_VR, ss * 16, vi * 32, lane), trfrag(lds + L_KE, ss * 16, ki * 32, lane), sacc[tt], 0, 0, 0);
        }
        LDS_WAIT(); __syncthreads();
        if (PASS_C) {
#pragma unroll
            for (int tt = 0; tt < 2; ++tt)
#pragma unroll
                for (int r = 0; r < 16; r += 2) { const int v = vi * 32 + crow(r, hi), kk = (ki0 + tt) * 32 + r32; const unsigned w = cvtpk(sacc[tt][r], sacc[tt][r + 1]);
                    *(LAS bf16_t*)(lds + L_ST + v * S128 + kk * 2) = (bf16_t)(w & 0xffffu); *(LAS bf16_t*)(lds + L_ST + (v + 1) * S128 + kk * 2) = (bf16_t)(w >> 16); }
        }
    }
#undef HG_LOAD
    if (!PASS_C) {
        float* hl = HL + (size_t)unit * 16384;
#pragma unroll
        for (int tt = 0; tt < 2; ++tt)
#pragma unroll
            for (int r = 0; r < 16; ++r) { const int v = vi * 32 + crow(r, hi), kk = (ki0 + tt) * 32 + r32; hl[v * 128 + kk] = sacc[tt][r]; }
        if (tq == 0) *(f32x4*)(HD + unit * 128 + 4 * kq) = btot;
    }
    __syncthreads();
}
__device__ __forceinline__ void scan(const float* HL, const float* HD, float* HS, int gtid, int gthreads) {
    for (int id = gtid; id < 8 * 16384; id += gthreads) {
        const int dh = id >> 14, e = id & 16383, k = e & 127; float S = 0.f;
        float hl[32], hd[32];
#pragma unroll
        for (int sc = 0; sc < 32; ++sc) { const int u = dh * 32 + sc; hl[sc] = HL[(size_t)u * 16384 + e]; hd[sc] = HD[u * 128 + k]; }
#pragma unroll
        for (int sc = 0; sc < 32; ++sc) { const int u = dh * 32 + sc; HS[(size_t)u * 16384 + e] = S; S = hd[sc] * S + hl[sc]; }
    }
}
}

namespace att {
__device__ __forceinline__ void hgrn_finalize(int h, int q0, const float* OF, const float* OB, const bf16_t* SG, const float* gain, bf16_t* MIX, int wid, int lane) {
    const float g0 = gain[2 * lane], g1 = gain[2 * lane + 1];
#pragma unroll 1
    for (int i0 = 0; i0 < 32; i0 += 4) { float2 a[4], b[4]; unsigned sg[4]; float x0[4], x1[4], ss[4];
#pragma unroll
        for (int i = 0; i < 4; ++i) { const size_t off = (size_t)(q0 + wid * 32 + i0 + i) * HSEC + h * 128 + 2 * lane; a[i] = *(const float2*)(OF + off); b[i] = *(const float2*)(OB + off); sg[i] = *(const unsigned*)(SG + off); }
#pragma unroll
        for (int i = 0; i < 4; ++i) { x0[i] = a[i].x + b[i].x; x1[i] = a[i].y + b[i].y; ss[i] = x0[i] * x0[i] + x1[i] * x1[i]; }
#pragma unroll
        for (int i = 0; i < 4; ++i) ss[i] = wave_sum(ss[i]);
#pragma unroll
        for (int i = 0; i < 4; ++i) { const float rstd = 1.f / sqrtf(ss[i] * (1.f / 128.f) + 1e-6f);
            *(unsigned*)(MIX + (size_t)(q0 + wid * 32 + i0 + i) * D + h * 128 + 2 * lane) = cvtpk(x0[i] * rstd * g0 * bflo(sg[i]), x1[i] * rstd * g1 * bfhi(sg[i])); } }
}
}

namespace att2 {
typedef short v4i16_t __attribute__((ext_vector_type(4)));
constexpr int KVBLK = 64, LDR = HSEC, NT = M / KVBLK;
constexpr int KSLOT = 8192, VSLOT = 16384, NSLOT = 4;
constexpr int OFF_K = 0, OFF_V = NSLOT * KSLOT, OFF_WS = OFF_V + NSLOT * VSLOT, OFF_END = OFF_WS + NWAVES * 64 * 4;
static_assert(OFF_END <= PHASE_LDS, "attention LDS");
__device__ __forceinline__ s16x4 vtr(const LAS unsigned char* p) { return __builtin_bit_cast(s16x4, __builtin_amdgcn_ds_read_tr16_b64_v4i16((LAS v4i16_t*)p)); }
__device__ __forceinline__ void glds16(const void* sbase, unsigned voff, unsigned lds_dst) { unsigned keep;
    asm volatile("s_mov_b32 %0, m0\n\ts_mov_b32 m0, %3\n\ts_nop 0\n\tglobal_load_lds_dwordx4 %1, %2\n\ts_mov_b32 m0, %0" : "=&s"(keep) : "v"(voff), "s"(sbase), "s"(lds_dst) : "memory"); }
#define ATT2_WAIT_BAR(N) asm volatile("s_waitcnt vmcnt(" #N ") lgkmcnt(0)\n\ts_barrier" ::: "memory")
template <bool DO_QK, bool DO_SM, bool DO_PV>
__device__ __forceinline__ void step(f32x16& sn0, f32x16& sn1, f32x16& sc0, f32x16& sc1, const u32x4& pap0, const u32x4& pap1, const u32x4& pap2, const u32x4& pap3,
                                     u32x4& pan0, u32x4& pan1, u32x4& pan2, u32x4& pan3, f32x16 (&o)[4], const bf16x8 (&qr)[4], const f32x16& negm, float& lsum,
                                     const LAS unsigned char* kc, const LAS unsigned char* knn, const LAS unsigned char* vb, bf16x8& kf0, bf16x8& kf1, bf16x8& kf2) {
    bf16x8 fr0 = kf0, fr1 = kf1, fr2 = kf2, fr3 = kf0; unsigned ca0 = 0, ca1 = 0, cb0 = 0, cb1 = 0;
    (void)ca0; (void)ca1; (void)cb0; (void)cb1;
    if (DO_QK) sn0 = __builtin_amdgcn_mfma_f32_32x32x16_bf16(fr0, qr[0], negm, 0, 0, 0);
    SBAR();
    if (DO_QK) { fr3 = *(const LAS bf16x8*)(kc + 2560); }
    if (DO_SM) { sc0[0] = ex2(sc0[0]); sc0[1] = ex2(sc0[1]); }
    SBAR();
    if (DO_QK) sn1 = __builtin_amdgcn_mfma_f32_32x32x16_bf16(fr1, qr[0], negm, 0, 0, 0);
    SBAR();
    if (DO_QK) { fr0 = *(const LAS bf16x8*)(kc + 4096); }
    if (DO_SM) { sc0[2] = ex2(sc0[2]); sc0[3] = ex2(sc0[3]); lsum += sc0[0]; lsum += sc0[1]; }
    SBAR();
    if (DO_QK) sn0 = __builtin_amdgcn_mfma_f32_32x32x16_bf16(fr2, qr[1], sn0, 0, 0, 0);
    SBAR();
    if (DO_QK) { fr1 = *(const LAS bf16x8*)(kc + 4608); }
    if (DO_SM) { sc0[4] = ex2(sc0[4]); sc0[5] = ex2(sc0[5]); lsum += sc0[2]; lsum += sc0[3]; }
    SBAR();
    if (DO_QK) sn1 = __builtin_amdgcn_mfma_f32_32x32x16_bf16(fr3, qr[1], sn1, 0, 0, 0);
    SBAR();
    if (DO_QK) { fr2 = *(const LAS bf16x8*)(kc + 6144); }
    if (DO_SM) { sc0[6] = ex2(sc0[6]); sc0[7] = ex2(sc0[7]); lsum += sc0[4]; lsum += sc0[5]; }
    SBAR();
    if (DO_QK) sn0 = __builtin_amdgcn_mfma_f32_32x32x16_bf16(fr0, qr[2], sn0, 0, 0, 0);
    SBAR();
    if (DO_QK) { fr3 = *(const LAS bf16x8*)(kc + 6656); }
    if (DO_SM) { sc0[8] = ex2(sc0[8]); sc0[9] = ex2(sc0[9]); lsum += sc0[6]; lsum += sc0[7]; }
    SBAR();
    if (DO_QK) sn1 = __builtin_amdgcn_mfma_f32_32x32x16_bf16(fr1, qr[2], sn1, 0, 0, 0);
    SBAR();
    if (DO_PV) { { const s16x4 l_ = vtr(vb + 0), h_ = vtr(vb + 256); fr0 = (bf16x8){l_[0], l_[1], l_[2], l_[3], h_[0], h_[1], h_[2], h_[3]}; } }
    if (DO_SM) { sc0[10] = ex2(sc0[10]); sc0[11] = ex2(sc0[11]); lsum += sc0[8]; lsum += sc0[9]; }
    SBAR();
    if (DO_QK) sn0 = __builtin_amdgcn_mfma_f32_32x32x16_bf16(fr2, qr[3], sn0, 0, 0, 0);
    SBAR();
    if (DO_PV) { { const s16x4 l_ = vtr(vb + 4096), h_ = vtr(vb + 4352); fr1 = (bf16x8){l_[0], l_[1], l_[2], l_[3], h_[0], h_[1], h_[2], h_[3]}; } }
    if (DO_SM) { sc0[12] = ex2(sc0[12]); sc0[13] = ex2(sc0[13]); lsum += sc0[10]; lsum += sc0[11]; }
    SBAR();
    if (DO_QK) sn1 = __builtin_amdgcn_mfma_f32_32x32x16_bf16(fr3, qr[3], sn1, 0, 0, 0);
    SBAR();
    if (DO_PV) { { const s16x4 l_ = vtr(vb + 8192), h_ = vtr(vb + 8448); fr2 = (bf16x8){l_[0], l_[1], l_[2], l_[3], h_[0], h_[1], h_[2], h_[3]}; } }
    if (DO_SM) { sc0[14] = ex2(sc0[14]); sc0[15] = ex2(sc0[15]); lsum += sc0[12]; lsum += sc0[13]; }
    SBAR();
    if (DO_PV) o[0] = __builtin_amdgcn_mfma_f32_32x32x16_bf16(__builtin_bit_cast(bf16x8, pap0), fr0, o[0], 0, 0, 0);
    SBAR();
    if (DO_PV) { { const s16x4 l_ = vtr(vb + 12288), h_ = vtr(vb + 12544); fr3 = (bf16x8){l_[0], l_[1], l_[2], l_[3], h_[0], h_[1], h_[2], h_[3]}; } }
    if (DO_SM) { sc1[0] = ex2(sc1[0]); sc1[1] = ex2(sc1[1]); lsum += sc0[14]; lsum += sc0[15]; }
    SBAR();
    if (DO_PV) o[0] = __builtin_amdgcn_mfma_f32_32x32x16_bf16(__builtin_bit_cast(bf16x8, pap1), fr1, o[0], 0, 0, 0);
    SBAR();
    if (DO_PV) { { const s16x4 l_ = vtr(vb + 512), h_ = vtr(vb + 768); fr0 = (bf16x8){l_[0], l_[1], l_[2], l_[3], h_[0], h_[1], h_[2], h_[3]}; } }
    if (DO_SM) { sc1[2] = ex2(sc1[2]); sc1[3] = ex2(sc1[3]); lsum += sc1[0]; lsum += sc1[1]; }
    SBAR();
    if (DO_PV) o[0] = __builtin_amdgcn_mfma_f32_32x32x16_bf16(__builtin_bit_cast(bf16x8, pap2), fr2, o[0], 0, 0, 0);
    SBAR();
    if (DO_PV) { { const s16x4 l_ = vtr(vb + 4608), h_ = vtr(vb + 4864); fr1 = (bf16x8){l_[0], l_[1], l_[2], l_[3], h_[0], h_[1], h_[2], h_[3]}; } }
    if (DO_SM) { sc1[4] = ex2(sc1[4]); sc1[5] = ex2(sc1[5]); lsum += sc1[2]; lsum += sc1[3]; }
    SBAR();
    if (DO_PV) o[0] = __builtin_amdgcn_mfma_f32_32x32x16_bf16(__builtin_bit_cast(bf16x8, pap3), fr3, o[0], 0, 0, 0);
    SBAR();
    if (DO_PV) { { const s16x4 l_ = vtr(vb + 8704), h_ = vtr(vb + 8960); fr2 = (bf16x8){l_[0], l_[1], l_[2], l_[3], h_[0], h_[1], h_[2], h_[3]}; } }
    if (DO_SM) { sc1[6] = ex2(sc1[6]); sc1[7] = ex2(sc1[7]); lsum += sc1[4]; lsum += sc1[5]; }
    SBAR();
    if (DO_PV) o[1] = __builtin_amdgcn_mfma_f32_32x32x16_bf16(__builtin_bit_cast(bf16x8, pap0), fr0, o[1], 0, 0, 0);
    SBAR();
    if (DO_PV) { { const s16x4 l_ = vtr(vb + 12800), h_ = vtr(vb + 13056); fr3 = (bf16x8){l_[0], l_[1], l_[2], l_[3], h_[0], h_[1], h_[2], h_[3]}; } }
    if (DO_SM) { sc1[8] = ex2(sc1[8]); sc1[9] = ex2(sc1[9]); lsum += sc1[6]; lsum += sc1[7]; }
    SBAR();
    if (DO_PV) o[1] = __builtin_amdgcn_mfma_f32_32x32x16_bf16(__builtin_bit_cast(bf16x8, pap1), fr1, o[1], 0, 0, 0);
    SBAR();
    if (DO_PV) { { const s16x4 l_ = vtr(vb + 1024), h_ = vtr(vb + 1280); fr0 = (bf16x8){l_[0], l_[1], l_[2], l_[3], h_[0], h_[1], h_[2], h_[3]}; } }
    if (DO_SM) { sc1[10] = ex2(sc1[10]); sc1[11] = ex2(sc1[11]); lsum += sc1[8]; lsum += sc1[9]; }
    SBAR();
    if (DO_PV) o[1] = __builtin_amdgcn_mfma_f32_32x32x16_bf16(__builtin_bit_cast(bf16x8, pap2), fr2, o[1], 0, 0, 0);
    SBAR();
    if (DO_PV) { { const s16x4 l_ = vtr(vb + 5120), h_ = vtr(vb + 5376); fr1 = (bf16x8){l_[0], l_[1], l_[2], l_[3], h_[0], h_[1], h_[2], h_[3]}; } }
    if (DO_SM) { sc1[12] = ex2(sc1[12]); sc1[13] = ex2(sc1[13]); lsum += sc1[10]; lsum += sc1[11]; }
    SBAR();
    if (DO_PV) o[1] = __builtin_amdgcn_mfma_f32_32x32x16_bf16(__builtin_bit_cast(bf16x8, pap3), fr3, o[1], 0, 0, 0);
    SBAR();
    if (DO_PV) { { const s16x4 l_ = vtr(vb + 9216), h_ = vtr(vb + 9472); fr2 = (bf16x8){l_[0], l_[1], l_[2], l_[3], h_[0], h_[1], h_[2], h_[3]}; } }
    if (DO_SM) { sc1[14] = ex2(sc1[14]); sc1[15] = ex2(sc1[15]); lsum += sc1[12]; lsum += sc1[13]; }
    SBAR();
    if (DO_PV) o[2] = __builtin_amdgcn_mfma_f32_32x32x16_bf16(__builtin_bit_cast(bf16x8, pap0), fr0, o[2], 0, 0, 0);
    SBAR();
    if (DO_PV) { { const s16x4 l_ = vtr(vb + 13312), h_ = vtr(vb + 13568); fr3 = (bf16x8){l_[0], l_[1], l_[2], l_[3], h_[0], h_[1], h_[2], h_[3]}; } }
    if (DO_SM) { lsum += sc1[14]; lsum += sc1[15]; ca0 = cvtpk(sc0[0], sc0[1]); ca1 = cvtpk(sc0[2], sc0[3]); }
    SBAR();
    if (DO_PV) o[2] = __builtin_amdgcn_mfma_f32_32x32x16_bf16(__builtin_bit_cast(bf16x8, pap1), fr1, o[2], 0, 0, 0);
    SBAR();
    if (DO_PV) { { const s16x4 l_ = vtr(vb + 1536), h_ = vtr(vb + 1792); fr0 = (bf16x8){l_[0], l_[1], l_[2], l_[3], h_[0], h_[1], h_[2], h_[3]}; } }
    if (DO_SM) { cb0 = cvtpk(sc0[4], sc0[5]); cb1 = cvtpk(sc0[6], sc0[7]); pan0 = (u32x4){ca0, ca1, cb0, cb1}; }
    SBAR();
    if (DO_PV) o[2] = __builtin_amdgcn_mfma_f32_32x32x16_bf16(__builtin_bit_cast(bf16x8, pap2), fr2, o[2], 0, 0, 0);
    SBAR();
    if (DO_PV) { { const s16x4 l_ = vtr(vb + 5632), h_ = vtr(vb + 5888); fr1 = (bf16x8){l_[0], l_[1], l_[2], l_[3], h_[0], h_[1], h_[2], h_[3]}; } }
    if (DO_SM) { ca0 = cvtpk(sc0[8], sc0[9]); ca1 = cvtpk(sc0[10], sc0[11]); }
    SBAR();
    if (DO_PV) o[2] = __builtin_amdgcn_mfma_f32_32x32x16_bf16(__builtin_bit_cast(bf16x8, pap3), fr3, o[2], 0, 0, 0);
    SBAR();
    if (DO_PV) { { const s16x4 l_ = vtr(vb + 9728), h_ = vtr(vb + 9984); fr2 = (bf16x8){l_[0], l_[1], l_[2], l_[3], h_[0], h_[1], h_[2], h_[3]}; } }
    if (DO_SM) { cb0 = cvtpk(sc0[12], sc0[13]); cb1 = cvtpk(sc0[14], sc0[15]); pan1 = (u32x4){ca0, ca1, cb0, cb1}; }
    SBAR();
    if (DO_PV) o[3] = __builtin_amdgcn_mfma_f32_32x32x16_bf16(__builtin_bit_cast(bf16x8, pap0), fr0, o[3], 0, 0, 0);
    SBAR();
    if (DO_PV) { { const s16x4 l_ = vtr(vb + 13824), h_ = vtr(vb + 14080); fr3 = (bf16x8){l_[0], l_[1], l_[2], l_[3], h_[0], h_[1], h_[2], h_[3]}; } }
    if (DO_SM) { ca0 = cvtpk(sc1[0], sc1[1]); ca1 = cvtpk(sc1[2], sc1[3]); }
    SBAR();
    if (DO_PV) o[3] = __builtin_amdgcn_mfma_f32_32x32x16_bf16(__builtin_bit_cast(bf16x8, pap1), fr1, o[3], 0, 0, 0);
    SBAR();
    kf0 = *(const LAS bf16x8*)(knn + 0);
    if (DO_SM) { cb0 = cvtpk(sc1[4], sc1[5]); cb1 = cvtpk(sc1[6], sc1[7]); pan2 = (u32x4){ca0, ca1, cb0, cb1}; }
    SBAR();
    if (DO_PV) o[3] = __builtin_amdgcn_mfma_f32_32x32x16_bf16(__builtin_bit_cast(bf16x8, pap2), fr2, o[3], 0, 0, 0);
    SBAR();
    kf1 = *(const LAS bf16x8*)(knn + 512);
    if (DO_SM) { ca0 = cvtpk(sc1[8], sc1[9]); ca1 = cvtpk(sc1[10], sc1[11]); }
    SBAR();
    if (DO_PV) o[3] = __builtin_amdgcn_mfma_f32_32x32x16_bf16(__builtin_bit_cast(bf16x8, pap3), fr3, o[3], 0, 0, 0);
    SBAR();
    kf2 = *(const LAS bf16x8*)(knn + 2048);
    if (DO_SM) { cb0 = cvtpk(sc1[12], sc1[13]); cb1 = cvtpk(sc1[14], sc1[15]); pan3 = (u32x4){ca0, ca1, cb0, cb1}; }
    SBAR();
}

__device__ __forceinline__ void unit(LAS unsigned char* lds, int h, int q0, const bf16_t* __restrict__ QD, const bf16_t* __restrict__ KD, const bf16_t* __restrict__ VD,
                                     const unsigned* KMAX2, float* O0S, float lam, const float* __restrict__ subg, bf16_t* MIX) {
    const int tid = opaque_tid(), wid = __builtin_amdgcn_readfirstlane(tid >> 6), lane = tid & 63, r32 = lane & 31, hi = lane >> 5;
    const unsigned lds0 = (unsigned)(uintptr_t)lds;
    LAS float* ws = (LAS float*)(lds + OFF_WS) + wid * 64;
    const LAS unsigned char* kbase = lds + OFF_K + hi * 1024 + r32 * 16;
    const LAS unsigned char* vbase = lds + OFF_V + (((lane & 3) << 3) | (((lane >> 2) & 3) << 6) | (((lane >> 4) & 1) << 5) | (((lane >> 5) & 1) << 11));
    const unsigned voK = (unsigned)((lane * LDR + wid * 8) * 2);
    unsigned voV[2];
    { const int kk = 8 * wid + ((lane & 31) >> 2), key = (kk & ~0xC) | ((kk & 4) << 1) | ((kk & 8) >> 1);
#pragma unroll
      for (int j = 0; j < 2; ++j) voV[j] = (unsigned)((key * LDR + (2 * j + (lane >> 5)) * 32 + (lane & 3) * 8) * 2); }
    const unsigned kdst = lds0 + OFF_K + wid * 1024, vdst = lds0 + OFF_V + wid * 2048;
#pragma unroll 1
    for (int mp = 0; mp < 2; ++mp) {
        const bf16_t* Kh = KD + h * 128 + mp * 64; const bf16_t* Vh = VD + h * 128;
        const bf16_t* Qw = QD + (size_t)(q0 + wid * 32 + r32) * LDR + h * 128 + mp * 64 + hi * 8;
#define ATT2_DMA_K(t) do { const int t_ = (t) < NT ? (t) : NT - 1; glds16((const char*)Kh + (size_t)t_ * (KVBLK * LDR * 2), voK, (unsigned)__builtin_amdgcn_readfirstlane(kdst + ((t) & 3) * KSLOT)); } while (0)
#define ATT2_DMA_V(t) do { const int t_ = (t) < NT ? (t) : NT - 1; const char* vs_ = (const char*)Vh + (size_t)t_ * (KVBLK * LDR * 2); const unsigned vd_ = (unsigned)__builtin_amdgcn_readfirstlane(vdst + ((t) & 3) * VSLOT); \
        glds16(vs_, voV[0], vd_); glds16(vs_, voV[1], vd_ + 1024); } while (0)
        ATT2_DMA_K(0); ATT2_DMA_K(1); ATT2_DMA_K(2); ATT2_DMA_V(0);
        bf16x8 qr[4]; float qq = 0.f;
#pragma unroll
        for (int d0 = 0; d0 < 4; ++d0) { qr[d0] = *reinterpret_cast<const bf16x8*>(Qw + d0 * 16);
#pragma unroll
            for (int j = 0; j < 8; ++j) { const float q = bf2f((unsigned short)qr[d0][j]); qq += q * q; } }
        { auto rr = __builtin_amdgcn_permlane32_swap(__float_as_uint(qq), __float_as_uint(qq), false, false); qq = __uint_as_float(rr[0]) + __uint_as_float(rr[1]); }
        const float mref = sqrtf(qq * __uint_as_float(KMAX2[(h * 2 + mp) * 64])) * 1.001f;
        f32x16 negm;
#pragma unroll
        for (int r = 0; r < 16; ++r) negm[r] = -mref;
        f32x16 o[4] = {}; float lsum = 0.f;
        f32x16 sA0, sA1, sB0, sB1; u32x4 pX0, pX1, pX2, pX3, pY0, pY1, pY2, pY3;
        sA0 = f32x16{}; sA1 = f32x16{}; sB0 = f32x16{}; sB1 = f32x16{}; pX0 = pX1 = pX2 = pX3 = pY0 = pY1 = pY2 = pY3 = (u32x4){0u, 0u, 0u, 0u};
        bf16x8 kf0, kf1, kf2;
        ATT2_WAIT_BAR(0);
        kf0 = *(const LAS bf16x8*)(kbase); kf1 = *(const LAS bf16x8*)(kbase + 512); kf2 = *(const LAS bf16x8*)(kbase + 2048);
#define KS(t) (kbase + ((t) & 3) * KSLOT)
#define VS(t) (vbase + ((t) & 3) * VSLOT)
        ATT2_DMA_K(3); ATT2_DMA_V(1);
        step<true, false, false>(sA0, sA1, sB0, sB1, pX0, pX1, pX2, pX3, pY0, pY1, pY2, pY3, o, qr, negm, lsum, KS(0), KS(1), VS(0), kf0, kf1, kf2);
        ATT2_WAIT_BAR(3);
        ATT2_DMA_K(4); ATT2_DMA_V(2);
        step<true, true, false>(sB0, sB1, sA0, sA1, pY0, pY1, pY2, pY3, pX0, pX1, pX2, pX3, o, qr, negm, lsum, KS(1), KS(2), VS(0), kf0, kf1, kf2);
        ATT2_WAIT_BAR(3);
#pragma unroll 1
        for (int i = 1; i + 1 < NT - 1; i += 2) {
            ATT2_DMA_K(i + 4); ATT2_DMA_V(i + 2);
            step<true, true, true>(sA0, sA1, sB0, sB1, pX0, pX1, pX2, pX3, pY0, pY1, pY2, pY3, o, qr, negm, lsum, KS(i + 1), KS(i + 2), VS(i - 1), kf0, kf1, kf2);
            ATT2_WAIT_BAR(3);
            ATT2_DMA_K(i + 5); ATT2_DMA_V(i + 3);
            step<true, true, true>(sB0, sB1, sA0, sA1, pY0, pY1, pY2, pY3, pX0, pX1, pX2, pX3, o, qr, negm, lsum, KS(i + 2), KS(i + 3), VS(i), kf0, kf1, kf2);
            ATT2_WAIT_BAR(3);
        }
        step<false, true, true>(sA0, sA1, sB0, sB1, pX0, pX1, pX2, pX3, pY0, pY1, pY2, pY3, o, qr, negm, lsum, KS(0), KS(0), VS(NT - 2), kf0, kf1, kf2);
        ATT2_WAIT_BAR(0);
        step<false, false, true>(sB0, sB1, sA0, sA1, pY0, pY1, pY2, pY3, pX0, pX1, pX2, pX3, o, qr, negm, lsum, KS(0), KS(0), VS(NT - 1), kf0, kf1, kf2);
        ATT2_WAIT_BAR(0);
#undef KS
#undef VS
#undef ATT2_DMA_K
#undef ATT2_DMA_V
        { auto rr = __builtin_amdgcn_permlane32_swap(__float_as_uint(lsum), __float_as_uint(lsum), false, false); lsum = __uint_as_float(rr[0]) + __uint_as_float(rr[1]); }
        if (hi == 0) ws[r32] = lsum; asm volatile("s_waitcnt lgkmcnt(0)" ::: "memory");
        int rowb = q0 + wid * 32; asm volatile("" : "+s"(rowb));
        float rli[16];
#pragma unroll
        for (int r = 0; r < 16; ++r) rli[r] = __builtin_amdgcn_rcpf(ws[crow(r, hi)]);
        float* o0p = O0S + tid; asm volatile("" : "+v"(o0p));
        if (mp == 0) {
#pragma unroll
            for (int d0 = 0; d0 < 4; ++d0)
#pragma unroll
                for (int r = 0; r < 16; ++r) o0p[(d0 * 16 + r) * 512] = o[d0][r] * rli[r];
        } else {
            float ss[16];
#pragma unroll
            for (int r = 0; r < 16; ++r) ss[r] = 0.f;
#pragma unroll
            for (int d0 = 0; d0 < 4; ++d0)
#pragma unroll
                for (int r = 0; r < 16; ++r) { const float c = o0p[(d0 * 16 + r) * 512] - lam * o[d0][r] * rli[r]; o[d0][r] = c; ss[r] += c * c; }
#pragma unroll
            for (int r = 0; r < 16; ++r) {
                ss[r] += lane_xor<1>(ss[r]); ss[r] += lane_xor<2>(ss[r]); ss[r] += lane_xor<4>(ss[r]); ss[r] += lane_xor<8>(ss[r]); ss[r] += lane_xor<16>(ss[r]);
                ss[r] = 0.8f / sqrtf(ss[r] * (1.f / 128.f) + 1e-5f); }
#pragma unroll
            for (int d0 = 0; d0 < 4; ++d0) { const float g = subg[d0 * 32 + r32];
#pragma unroll
                for (int r = 0; r < 16; ++r) MIX[(size_t)(rowb + crow(r, hi)) * D + 512 + h * 128 + d0 * 32 + r32] = (bf16_t)f2bf(o[d0][r] * ss[r] * g); }
        }
        asm volatile("s_waitcnt vmcnt(0) lgkmcnt(0)\n\ts_barrier" ::: "memory");
    }
}
__device__ __forceinline__ void kmax_rows(LAS unsigned char* lds, const bf16_t* KD, unsigned* KMAX2, int gw, int ngw, int lane, int wave) {
    float mx = 0.f;
    for (int row0 = gw; row0 < M; row0 += 8 * ngw) { u32x4 w[8];
#pragma unroll
        for (int i = 0; i < 8; ++i) { const int row = row0 + i * ngw; w[i] = row < M ? *(const GAS u32x4*)(KD + (size_t)row * HSEC + lane * 8) : (u32x4){0u, 0u, 0u, 0u}; }
#pragma unroll
        for (int i = 0; i < 8; ++i) { const u32x4 v = w[i];
            float s = bflo(v.x) * bflo(v.x) + bfhi(v.x) * bfhi(v.x) + bflo(v.y) * bflo(v.y) + bfhi(v.y) * bfhi(v.y) + bflo(v.z) * bflo(v.z) + bfhi(v.z) * bfhi(v.z) + bflo(v.w) * bflo(v.w) + bfhi(v.w) * bfhi(v.w);
            s += lane_xor<1>(s); s += lane_xor<2>(s); s += lane_xor<4>(s); mx = fmaxf(mx, s); } }
    LAS float* red = (LAS float*)lds; if ((lane & 7) == 0) red[wave * 8 + (lane >> 3)] = mx;
    LDS_WAIT(); __syncthreads();
    if (wave == 0 && lane < 8) { float m = red[lane];
#pragma unroll
        for (int w = 1; w < NWAVES; ++w) m = fmaxf(m, red[w * 8 + lane]);
        atomicMax(KMAX2 + lane * 64, __float_as_uint(m)); }
    __syncthreads();
}
}

__device__ __forceinline__ void route16(const bf16_t* X2B, const u32x4* WRB, const float* rgb, const float* reb,
                                        float* RSTD, int* TOKE, float* TOKW, int* TOKR, unsigned* GCNT, int row0, int lane, LAS float* wl, bool dry = false) {
    typedef float f32x4_ __attribute__((ext_vector_type(4)));
    const int r = lane & 15, q = lane >> 4;
    LAS unsigned* lc = (LAS unsigned*)(wl + 800);
    if (lane < 32) lc[lane] = 0u;
    f32x4_ acc[3]; acc[0] = (f32x4_){0.f, 0.f, 0.f, 0.f}; acc[1] = acc[0]; acc[2] = acc[0];
    float ssq = 0.f;
    const bf16_t* xp = X2B + (size_t)(row0 + r) * D + 8 * q;
#pragma unroll 8
    for (int ks = 0; ks < 32; ++ks) {
        const u32x4 xw = *(const GAS u32x4*)(xp + ks * 32);
        ssq += (bflo(xw.x) * bflo(xw.x) + bfhi(xw.x) * bfhi(xw.x)) + (bflo(xw.y) * bflo(xw.y) + bfhi(xw.y) * bfhi(xw.y)) + (bflo(xw.z) * bflo(xw.z) + bfhi(xw.z) * bfhi(xw.z)) + (bflo(xw.w) * bflo(xw.w) + bfhi(xw.w) * bfhi(xw.w));
        const bf16x8 xh = __builtin_bit_cast(bf16x8, xw);
#pragma unroll
        for (int nt = 0; nt < 3; ++nt) {
            const bf16x8 wh = __builtin_bit_cast(bf16x8, WRB[((ks * 3 + nt) * 2 + 0) * 64 + lane]), wlo = __builtin_bit_cast(bf16x8, WRB[((ks * 3 + nt) * 2 + 1) * 64 + lane]);
            acc[nt] = __builtin_amdgcn_mfma_f32_16x16x32_bf16(wh, xh, acc[nt], 0, 0, 0);
            acc[nt] = __builtin_amdgcn_mfma_f32_16x16x32_bf16(wlo, xh, acc[nt], 0, 0, 0);
        }
    }
    ssq += lane_xor<16>(ssq);
    { auto rr = __builtin_amdgcn_permlane32_swap(__float_as_uint(ssq), __float_as_uint(ssq), false, false); ssq = __uint_as_float(rr[0]) + __uint_as_float(rr[1]); }
    const float rstd = 1.f / sqrtf(ssq * (1.f / 1024.f) + 1e-6f);
#pragma unroll
    for (int nt = 0; nt < 3; ++nt) *(LAS f32x4_*)(wl + r * 48 + nt * 16 + 4 * q) = acc[nt] * rstd;
    LDS_WAIT();
    float lg[36];
#pragma unroll
    for (int n4 = 0; n4 < 9; ++n4) { const f32x4_ t = *(const LAS f32x4_*)(wl + r * 48 + 4 * n4); lg[4 * n4] = t[0]; lg[4 * n4 + 1] = t[1]; lg[4 * n4 + 2] = t[2]; lg[4 * n4 + 3] = t[3]; }
    float gl[4];
#pragma unroll
    for (int g = 0; g < 4; ++g) gl[g] = lg[g] + rgb[g];
    int gi = 0; float gm = gl[0];
#pragma unroll
    for (int g = 1; g < 4; ++g) if (gl[g] > gm) { gm = gl[g]; gi = g; }
    float gs = 0.f;
#pragma unroll
    for (int g = 0; g < 4; ++g) gs += __expf(gl[g] - gm);
    const float gp = 1.f / gs;
    float e[8];
#pragma unroll
    for (int j = 0; j < 8; ++j) { const float a0 = lg[4 + j] + reb[j], a1 = lg[12 + j] + reb[8 + j], a2 = lg[20 + j] + reb[16 + j], a3 = lg[28 + j] + reb[24 + j];
        e[j] = gi == 0 ? a0 : gi == 1 ? a1 : gi == 2 ? a2 : a3; }
    int i1 = 0; float m1 = e[0];
#pragma unroll
    for (int j = 1; j < 8; ++j) if (e[j] > m1) { m1 = e[j]; i1 = j; }
    int i2 = 0; float m2 = -3.0e38f;
#pragma unroll
    for (int j = 0; j < 8; ++j) if (j != i1 && e[j] > m2) { m2 = e[j]; i2 = j; }
    const float p2 = __expf(m2 - m1);
    const float w1 = gp / (1.f + p2), w2 = gp * p2 / (1.f + p2);
    if (q == 0 && !dry) { const int row = row0 + r; const int e1 = gi * 8 + i1, e2 = gi * 8 + i2;
        const int r1 = (int)__hip_atomic_fetch_add(lc + e1, 1u, __ATOMIC_RELAXED, __HIP_MEMORY_SCOPE_WORKGROUP), r2 = (int)__hip_atomic_fetch_add(lc + e2, 1u, __ATOMIC_RELAXED, __HIP_MEMORY_SCOPE_WORKGROUP);
        RSTD[row] = rstd; TOKE[row * 2] = e1; TOKE[row * 2 + 1] = e2; TOKW[row * 2] = w1; TOKW[row * 2 + 1] = w2; TOKR[row * 2] = r1; TOKR[row * 2 + 1] = r2; }
    LDS_WAIT();
    if (lane < 32 && !dry) GCNT[(row0 >> 4) * 32 + lane] = lc[lane];
}
__device__ __forceinline__ void build_tile_prefix(volatile LAS int* tb, const unsigned* CNT) {
    if (threadIdx.x == 0) { int acc = 0;
        for (int e = 0; e < 32; ++e) { tb[e] = acc; const int c = (int)__hip_atomic_load(CNT + e * CNT_STRIDE, __ATOMIC_RELAXED, __HIP_MEMORY_SCOPE_AGENT); tb[64 + e] = c; acc += (c + 127) >> 7; }
        tb[32] = acc; }
    LDS_WAIT(); __syncthreads();
}
__device__ __forceinline__ void sort_slots(LAS unsigned char* lds, volatile LAS int* tb, const unsigned* GCNT, const int* TOKE, const int* TOKR, int* TOKS, int* PERM, const float* RSTD, float* RSLOT, unsigned* CNT, int blk, int nblk) {
    const int t = opaque_tid(), e = t & 31, j = t >> 5; constexpr int NG = M / 16;
    const int gpb = (NG + nblk - 1) / nblk, g0 = blk * gpb, g1 = g0 + gpb < NG ? g0 + gpb : NG;
    LAS int* part = (LAS int*)lds; LAS int* part2 = part + 512; LAS int* tot = part2 + 512; LAS int* base0 = tot + 32;
    int s = 0, s2 = 0;
    for (int g = j; g < NG; g += 16) { const int c = (int)GCNT[g * 32 + e]; s += c; s2 += g < g0 ? c : 0; }
    part[j * 32 + e] = s; part2[j * 32 + e] = s2;
    LDS_WAIT(); __syncthreads();
    if (t < 32) { int a = 0, b = 0;
#pragma unroll
        for (int jj = 0; jj < 16; ++jj) { a += part[jj * 32 + t]; b += part2[jj * 32 + t]; }
        tot[t] = a; base0[t] = b; if (blk == 0) __hip_atomic_store(CNT + t * CNT_STRIDE, (unsigned)a, __ATOMIC_RELAXED, __HIP_MEMORY_SCOPE_AGENT); }
    LDS_WAIT(); __syncthreads();
    if (t == 0) { int acc = 0; for (int ee = 0; ee < 32; ++ee) { tb[ee] = acc; tb[64 + ee] = tot[ee]; acc += (tot[ee] + 127) >> 7; } tb[32] = acc; }
    LDS_WAIT(); __syncthreads();
    for (int idx = t; idx < (g1 - g0) * 32; idx += 512) { const int gi = idx >> 5, p = (g0 + gi) * 32 + (idx & 31), ex = TOKE[p]; int base = base0[ex];
        for (int g = g0; g < g0 + gi; ++g) base += (int)GCNT[g * 32 + ex];
        const int slot = tb[ex] * 128 + base + TOKR[p]; TOKS[p] = slot; PERM[slot] = p >> 1; RSLOT[slot] = RSTD[p >> 1]; }
}
template <int NR>
__device__ __forceinline__ void final_rows(const bf16_t* X2B, float* OUT, const unsigned char* Y, const int* TOKS, const float* TOKW, const float* gain, int m0, int stride, int lane) {
    typedef float f32x2_ __attribute__((ext_vector_type(2)));
    int s0[NR], s1[NR]; float w0[NR], w1[NR];
#pragma unroll
    for (int i = 0; i < NR; ++i) { const int row = m0 + i * stride; s0[i] = TOKS[row * 2]; s1[i] = TOKS[row * 2 + 1]; w0[i] = TOKW[row * 2] * (1.f / F8_YSCALE); w1[i] = TOKW[row * 2 + 1] * (1.f / F8_YSCALE); }
    u32x2 xx[NR][4]; unsigned ya[NR][4], yb[NR][4];
#pragma unroll
    for (int i = 0; i < NR; ++i) { const int row = m0 + i * stride;
        const GAS u32x2* xr = (const GAS u32x2*)(X2B + (size_t)row * D) + lane; const GAS unsigned* y0 = (const GAS unsigned*)(Y + (size_t)s0[i] * D) + lane; const GAS unsigned* y1 = (const GAS unsigned*)(Y + (size_t)s1[i] * D) + lane;
#pragma unroll
        for (int j = 0; j < 4; ++j) { xx[i][j] = xr[64 * j]; ya[i][j] = y0[64 * j]; yb[i][j] = y1[64 * j]; } }
#pragma unroll
    for (int i = 0; i < NR; ++i) { const int row = m0 + i * stride; f32x4 v[4]; float s = 0.f;
#pragma unroll
        for (int j = 0; j < 4; ++j) { const u32x2 x_ = xx[i][j];
            const f32x2_ a0 = __builtin_amdgcn_cvt_pk_f32_fp8((int)ya[i][j], false), a1 = __builtin_amdgcn_cvt_pk_f32_fp8((int)ya[i][j], true), b0 = __builtin_amdgcn_cvt_pk_f32_fp8((int)yb[i][j], false), b1 = __builtin_amdgcn_cvt_pk_f32_fp8((int)yb[i][j], true);
            v[j].x = bflo(x_.x) + w0[i] * a0[0] + w1[i] * b0[0]; v[j].y = bfhi(x_.x) + w0[i] * a0[1] + w1[i] * b0[1]; v[j].z = bflo(x_.y) + w0[i] * a1[0] + w1[i] * b1[0]; v[j].w = bfhi(x_.y) + w0[i] * a1[1] + w1[i] * b1[1];
            s += (v[j].x * v[j].x + v[j].y * v[j].y) + (v[j].z * v[j].z + v[j].w * v[j].w); }
        const float rstd = 1.f / sqrtf(wave_sum(s) * (1.f / 1024.f) + 1e-6f);
        GAS f32x4* orow = (GAS f32x4*)(OUT + (size_t)row * D) + lane;
#pragma unroll
        for (int j = 0; j < 4; ++j) { const f32x4 g = ((const GAS f32x4*)gain)[64 * j + lane]; orow[64 * j] = v[j] * rstd * g; } }
}

#ifndef MK_N_LAUNCHES
#define MK_N_LAUNCHES 1
#endif
constexpr int N_PHASES = 12;
struct Args { const void* in[18]; float* out; unsigned char* ws; int ph_lo, ph_hi; };
static_assert(sizeof(Args) == 18 * 8 + 8 + 8 + 8, "Args has no padding");

__global__ void __launch_bounds__(NWAVES * 64, 2) mk_fwd(Args args) {
    extern __shared__ __attribute__((aligned(16))) unsigned char lds_raw[];
    LAS unsigned char* lds = (LAS unsigned char*)lds_raw;
    volatile LAS unsigned* MISC = (volatile LAS unsigned*)(lds + MISC_OFF);
    const int G = gridDim.x, bx = blockIdx.x, vcu = (G % 8 == 0) ? (bx % 8) * (G / 8) + bx / 8 : bx;
    const int NGW = G * NWAVES;
#define PHASE_IDS const int tid = opaque_tid(), lane = tid & 63, wave = __builtin_amdgcn_readfirstlane(tid >> 6), gw = vcu * NWAVES + wave; (void)lane; (void)gw
    const __attribute__((address_space(4))) Args* A = (const __attribute__((address_space(4))) Args*)__builtin_amdgcn_kernarg_segment_ptr();
    asm volatile("" : "+s"(A));
#define ARGF(i) ((const float*)A->in[i])
#define WSP(T, off) ((T*)(A->ws + (off)))
#define x_in ARGF(0)
#define positions ((const int*)A->in[1])
#define norm1_gain ARGF(2)
#define w_in ARGF(3)
#define hg_lb ARGF(4)
#define hg_norm_gain ARGF(5)
#define diff_lambda ARGF(6)
#define subln_gain ARGF(7)
#define w_out ARGF(8)
#define norm2_gain ARGF(9)
#define rg_w ARGF(10)
#define rg_b ARGF(11)
#define re_w ARGF(12)
#define re_b ARGF(13)
#define w_gate ARGF(14)
#define w_up ARGF(15)
#define w_down ARGF(16)
#define final_gain ARGF(17)
#define out (A->out)
#define cosT WSP(float, WS_ROPE)
#define sinT (WSP(float, WS_ROPE) + M * 8)
#define HD WSP(float, WS_HD)
#define TOKE WSP(int, WS_TOKE)
#define TOKW WSP(float, WS_TOKW)
#define TOKR WSP(int, WS_TOKR)
#define TOKS WSP(int, WS_TOKS)
#define LAMP WSP(float, WS_LAM)
#define WOUT WSP(bf16_t, WS_WOUT)
#define WIN WSP(bf16_t, WS_WIN)
#define XN WSP(bf16_t, WS_XN)
#define QH WSP(bf16_t, WS_QH)
#define VH WSP(bf16_t, WS_VH)
#define SG WSP(bf16_t, WS_SG)
#define QD WSP(bf16_t, WS_QD)
#define KD WSP(bf16_t, WS_KD)
#define VD WSP(bf16_t, WS_VD)
#define GF WSP(half_t, WS_GF)
#define GB WSP(half_t, WS_GB)
#define HS WSP(float, WS_HS)
#define HL WSP(float, WS_HL)
#define OF WSP(float, WS_OF)
#define OB WSP(float, WS_OB)
#define MIX WSP(bf16_t, WS_MIX)
#define X2B WSP(bf16_t, WS_X2B)
#define X2F8 WSP(unsigned char, WS_X2F8)
#define WGU WSP(unsigned char, WS_WGU)
#define WD WSP(unsigned char, WS_WD)
#define HGb WSP(bf16_t, WS_HG)
#define HM WSP(unsigned char, WS_HM)
#define Y WSP(unsigned char, WS_Y)
#define CNT (WSP(unsigned, WS_CTL) + CW_CNT)
    unsigned* ctl = WSP(unsigned, WS_CTL);
    volatile LAS int* tb = (volatile LAS int*)(MISC + 16);

    if (threadIdx.x < 64) MISC[threadIdx.x] = 0u;
    __syncthreads();
    XcdBarrier bar; bar.bar = ctl + CW_BAR; bar.x = 0; bar.st = nullptr;
    const int lo = A->ph_lo, hi = A->ph_hi;
    if (hi - lo > 1) bar = xcd_barrier_post(ctl + CW_BAR, MISC);
#ifndef PH_MASK
#define PH_MASK 0xFFF
#endif
#define IN(k) (((PH_MASK >> (k)) & 1) && lo <= (k) && (k) < hi)
#ifndef DOUBLE_PHASE
#define DOUBLE_PHASE -1
#endif
#define REP(k) for (int rep_ = 0; rep_ < ((DOUBLE_PHASE) == (k) ? 2 : 1); ++rep_)
#ifndef BAR_REPS
#define BAR_REPS 1
#endif
#ifdef DIAG_SPAN_A
#define STAMP(k) do { if (blockIdx.x == 0 && threadIdx.x == 0) WSP(unsigned long long, WS_LAM + 64)[k] = __builtin_amdgcn_s_memrealtime(); } while (0)
#else
#define STAMP(k) do { } while (0)
#endif
#define SEAM(k) do { if (IN(k) && IN((k) + 1)) for (int b_ = 0; b_ < BAR_REPS; ++b_) xcd_barrier(bar); STAMP((k) + 1); } while (0)

    STAMP(0);
    if (IN(0)) REP(0) { PHASE_IDS;
        LAS float* scr = (LAS float*)(lds + wave * 16384);
        constexpr int I_IN = (D / 64) * (NIN / 32), I_OUT = (D / 64) * (D / 32);
        { XposeRegs R;
#define P0_LOAD(it_) do { if ((it_) < I_IN) xpose_load(R, w_in, D, NIN, (it_), lane); else xpose_load(R, w_out, D, D, (it_) - I_IN, lane); } while (0)
            if (gw < I_IN + I_OUT) P0_LOAD(gw);
            for (int it = gw; it < I_IN + I_OUT; it += NGW) { const XposeRegs C = R; const int nx = it + NGW;
                if (nx < I_IN + I_OUT) P0_LOAD(nx);
                if (it < I_IN) xpose_store(C, D, NIN, WIN, 0, 1, scr, it, lane); else xpose_store(C, D, D, WOUT, 0, 1, scr, it - I_IN, lane); }
#undef P0_LOAD
        }
        for (int m = gw; m < M; m += NGW) rms_rows_to_bf16<1>(x_in, norm1_gain, XN, m, NGW, lane, 1e-6f);
        for (int id = bx * 512 + tid; id < M * 8; id += G * 512) {
            const int i = id & 7; const float invf[8] = {1.0f, 0.19392274474868576f, 0.03760603093086393f, 0.007292664737217109f, 0.001414213562373095f, 0.0002742481756762073f, 5.318295896944988e-05f, 1.031338537721246e-05f};
            float f = invf[0];
#pragma unroll
            for (int q = 1; q < 8; ++q) f = (i == q) ? invf[q] : f;
            const float ang = (float)positions[id >> 3] * f;
            const double rev = (double)ang * 0.15915494309189535; const float fr = (float)(rev - __builtin_rint(rev));
            cosT[id] = __builtin_amdgcn_cosf(fr); sinT[id] = __builtin_amdgcn_sinf(fr);
        }
        for (int id = bx * 512 + tid; id < 32 * 3 * 2 * 64; id += G * 512) {
            const int ln = id & 63, part = (id >> 6) & 1, nt = (id >> 7) % 3, ks = (id >> 7) / 3, n = nt * 16 + (ln & 15), k0 = ks * 32 + 8 * (ln >> 4); unsigned w[4];
#pragma unroll
            for (int jj = 0; jj < 4; ++jj) { float v[2];
#pragma unroll
                for (int u = 0; u < 2; ++u) { const int k = k0 + 2 * jj + u; const float wv = (n < 4 ? rg_w[k * 4 + n] : n < 36 ? re_w[k * 32 + (n - 4)] : 0.f) * norm2_gain[k];
                    const float hv = bf2f(f2bf(wv)); v[u] = part ? wv - hv : hv; }
                w[jj] = pk2(v[0], v[1]); }
            WSP(u32x4, WS_WR)[id] = (u32x4){w[0], w[1], w[2], w[3]}; }
        if (bx == 0 && wave == 0) { const float a = wave_sum(diff_lambda[lane] * diff_lambda[64 + lane]), b = wave_sum(diff_lambda[128 + lane] * diff_lambda[192 + lane]);
            if (lane == 0) LAMP[0] = __expf(a) - __expf(b) + 0.2f; }
    }
    SEAM(0);
    if (IN(1)) REP(1) {
        pg8::Gemm g{XN, WIN, M, NIN, D}; pg8::StaticOrder S; S.init(M, NIN, G, bx);
        EpiInProj E{QH, VH, SG, QD, KD, VD, GF, GB, hg_lb, cosT, sinT};
        pg8::gemm_phase<EpiInProj, pg8::StaticOrder, true, true>(lds, g, S, E);
    }
    SEAM(1);
    if (IN(2)) REP(2) { for (int u = vcu; u < 256; u += G) hg::pass<false>(lds, u, QH, VH, GF, GB, HL, HD, HS, OF, OB);
        { PHASE_IDS; att2::kmax_rows(lds, KD, WSP(unsigned, WS_CTL) + CW_KMAX, gw, NGW, lane, wave); } }
    SEAM(2);
    if (IN(3)) REP(3) hg::scan(HL, HD, HS, bx * 512 + opaque_tid(), G * 512);
    SEAM(3);
    if (IN(4)) REP(4) { for (int u = vcu; u < 256; u += G) hg::pass<true>(lds, u, QH, VH, GF, GB, HL, HD, HS, OF, OB); }
    SEAM(4);
    if (IN(5)) REP(5) { PHASE_IDS;
#ifdef DIAG_CLOCK
        if (blockIdx.x == 0 && threadIdx.x == 0) { WSP(unsigned long long, WS_LAM + 64)[20] = __builtin_amdgcn_s_memtime(); WSP(unsigned long long, WS_LAM + 64)[21] = __builtin_amdgcn_s_memrealtime(); }
#endif
        const float lam = LAMP[0];
        for (int u = vcu; u < 256; u += G) { const int h = u >> 6, q0 = (u & 63) * 256;
            int ln = lane; asm volatile("" : "+v"(ln));
            att::hgrn_finalize(h, q0, OF, OB, SG, hg_norm_gain, MIX, wave, ln);
            att2::unit(lds, h, q0, QD, KD, VD, WSP(unsigned, WS_CTL) + CW_KMAX, WSP(float, WS_O0S) + (size_t)bx * 32768, lam, subln_gain, MIX); }
    }
#ifdef DIAG_CLOCK
    if (blockIdx.x == 0 && threadIdx.x == 0) { WSP(unsigned long long, WS_LAM + 64)[22] = __builtin_amdgcn_s_memtime(); WSP(unsigned long long, WS_LAM + 64)[23] = __builtin_amdgcn_s_memrealtime(); }
#endif
    SEAM(5);
    if (IN(6)) REP(6) {
        pg8::Gemm g{MIX, WOUT, M, D, D}; pg8::StaticOrder S; S.init(M, D, G, bx);
        EpiResid E{x_in, X2B, X2F8};
        pg8::gemm_phase<EpiResid, pg8::StaticOrder, true, true>(lds, g, S, E);
    }
    SEAM(6);
    if (IN(7)) { PHASE_IDS;
        const int grp = wave * G + vcu; const bool router = grp * 16 < M;
        LAS float* scr = (LAS float*)(lds + wave * 16384);
        if (router) route16(X2B, WSP(const u32x4, WS_WR), rg_b, re_b, WSP(float, WS_RSTD), TOKE, TOKW, TOKR, WSP(unsigned, WS_GCNT), grp * 16, lane, scr + 3072);
        if (router && (DOUBLE_PHASE) == 77) route16(X2B, WSP(const u32x4, WS_WR), rg_b, re_b, WSP(float, WS_RSTD), TOKE, TOKW, TOKR, WSP(unsigned, WS_GCNT), grp * 16, lane, scr + 3072, true);
        constexpr int I_GU = (D / 64) * (DEXP / 32), I_DN = (DEXP / 64) * (D / 32), I_ALL = NEXP * (2 * I_GU + I_DN);
#ifndef P7_SHARE
#define P7_SHARE 10
#endif
        const int nrt = M / 16, nA = nrt < NGW ? nrt : NGW, nB = NGW - nA;
        const int perA = nB ? (I_ALL * P7_SHARE / 24 + nA - 1) / nA : (I_ALL + nA - 1) / nA, totA = perA * nA < I_ALL ? perA * nA : I_ALL;
        int it0, it1, stp;
        if (router) { it0 = grp; it1 = totA; stp = nA; } else { it0 = totA + (grp - nA); it1 = I_ALL; stp = nB; }
        REP(7) { XposeRegs R0, R1;
#define P7_LOAD(R, it_) do { const int e_ = (it_) / (2 * I_GU + I_DN), r_ = (it_) % (2 * I_GU + I_DN); \
            if (r_ < I_GU) xpose_load(R, w_gate + (size_t)e_ * D * DEXP, D, DEXP, r_, lane); else if (r_ < 2 * I_GU) xpose_load(R, w_up + (size_t)e_ * D * DEXP, D, DEXP, r_ - I_GU, lane); \
            else xpose_load(R, w_down + (size_t)e_ * DEXP * D, DEXP, D, r_ - 2 * I_GU, lane); } while (0)
#define P7_STORE(C, it_) do { const int e = (it_) / (2 * I_GU + I_DN), r = (it_) % (2 * I_GU + I_DN); \
            if (r < I_GU) xpose_store_f8(C, D, DEXP, WGU + (size_t)e * 1024 * D, 0, 2, scr, r, lane, F8_WSCALE, norm2_gain); \
            else if (r < 2 * I_GU) xpose_store_f8(C, D, DEXP, WGU + (size_t)e * 1024 * D, 1, 2, scr, r - I_GU, lane, F8_WSCALE, norm2_gain); \
            else xpose_store_f8(C, DEXP, D, WD + (size_t)e * 1024 * DEXP, 0, 1, scr, r - 2 * I_GU, lane, F8_WSCALE); } while (0)
            if (it0 < it1) P7_LOAD(R0, it0);
            if (it0 + stp < it1) P7_LOAD(R1, it0 + stp);
            for (int it = it0; it < it1; it += 2 * stp) {
                { const XposeRegs C = R0; if (it + 2 * stp < it1) P7_LOAD(R0, it + 2 * stp); P7_STORE(C, it); }
                if (it + stp < it1) { const XposeRegs C = R1; if (it + 3 * stp < it1) P7_LOAD(R1, it + 3 * stp); P7_STORE(C, it + stp); }
            }
#undef P7_STORE
#undef P7_LOAD
        }
    }
    SEAM(7);
    if (IN(8)) REP(8) { sort_slots(lds, tb, WSP(unsigned, WS_GCNT), TOKE, TOKR, TOKS, WSP(int, WS_PERM), WSP(const float, WS_RSTD), WSP(float, WS_RSLOT), CNT, bx, G); }
    SEAM(8);
    if (IN(9)) REP(9) {
        build_tile_prefix(tb, CNT);
        MoeOrder S{tb, G, bx, WSP(const int, WS_PERM), WSP(unsigned, WS_CTL) + CW_READY, 0}; EpiSwiGlu E{HM, WSP(const float, WS_RSLOT)};
        mg::gemm<EpiSwiGlu, MoeOrder, true>(lds, X2F8, WGU, D, S, E);
    }
    SEAM(9);
    if (IN(10)) REP(10) {
        build_tile_prefix(tb, CNT);
        MoeOrder S{tb, G, bx, WSP(const int, WS_PERM), WSP(unsigned, WS_CTL) + CW_READY, 0}; EpiDown E{Y};
        mg::gemm<EpiDown, MoeOrder, false>(lds, HM, WD, DEXP, S, E);
    }
    SEAM(10);
    if (IN(11)) { PHASE_IDS; for (int m = gw; m < M; m += NGW) final_rows<1>(X2B, out, Y, TOKS, TOKW, final_gain, m, NGW, lane); }
#ifdef DIAG_SPAN_A
    xcd_barrier(bar); STAMP(12); xcd_barrier(bar);
    { const unsigned long long* st_ = WSP(unsigned long long, WS_LAM + 64);
#ifdef DIAG_CLOCK
      const float d_ = (float)(long long)(st_[22] - st_[20]) / (float)(long long)(st_[23] - st_[21]) * 10.f * DIAG_C;
#else
      const float d_ = (float)(long long)(st_[DIAG_SPAN_B] - st_[DIAG_SPAN_A]) * 0.01f * DIAG_C;
#endif
      for (int m = blockIdx.x * 512 + threadIdx.x; m < M; m += gridDim.x * 512) out[(size_t)m * D] += d_; }
#endif
#undef IN
#undef SEAM
#undef x_in
#undef positions
#undef out
#undef Y
#undef HM
#undef CNT
}

extern "C" void kernel_launch(void* const* d_in, const int* in_sizes, int n_in, void* d_out, int out_size, void* d_ws, size_t ws_size, hipStream_t stream) {
    static int grid = 0;
    if (grid == 0) {
        if (n_in != 18 || in_sizes[0] != M * D || out_size != M * D || ws_size < WS_END) { fprintf(stderr, "kernel_launch: unexpected shapes (n_in %d, in0 %d, out %d, ws %zu)\n", n_in, n_in > 0 ? in_sizes[0] : -1, out_size, ws_size); grid = -1; return; }
        int dev = 0, cus = 0, per_cu = 0;
        if (hipGetDevice(&dev) != hipSuccess || hipDeviceGetAttribute(&cus, hipDeviceAttributeMultiprocessorCount, dev) != hipSuccess) { grid = -1; return; }
        if (hipFuncSetAttribute((const void*)mk_fwd, hipFuncAttributeMaxDynamicSharedMemorySize, LDS_BYTES) != hipSuccess) { fprintf(stderr, "kernel_launch: hipFuncSetAttribute failed\n"); grid = -1; return; }
        if (hipOccupancyMaxActiveBlocksPerMultiprocessor(&per_cu, (const void*)mk_fwd, NWAVES * 64, LDS_BYTES) != hipSuccess || per_cu < 1) { fprintf(stderr, "kernel_launch: occupancy query says %d\n", per_cu); (void)hipGetLastError(); grid = -1; return; }
        grid = cus;
    }
    if (grid < 0) return;
    if (hipMemsetAsync((char*)d_ws + WS_CTL, 0, CTL_ZERO_BYTES, stream) != hipSuccess) return;
    Args a{};
    for (int i = 0; i < 18; ++i) a.in[i] = d_in[i];
    a.out = (float*)d_out; a.ws = (unsigned char*)d_ws;
#if MK_N_LAUNCHES == 1
    a.ph_lo = 0; a.ph_hi = N_PHASES;
    hipLaunchKernelGGL(mk_fwd, dim3(grid), dim3(NWAVES * 64), LDS_BYTES, stream, a);
#else
    for (int p = 0; p < N_PHASES; ++p) { a.ph_lo = p; a.ph_hi = p + 1; hipLaunchKernelGGL(mk_fwd, dim3(grid), dim3(NWAVES * 64), LDS_BYTES, stream, a); }
#endif
}
```

```cpp
#include <hip/hip_runtime.h>
#include <cstdio>
#include <cstdint>
__device__ __forceinline__ int opaque_tid() { int t = threadIdx.x; asm volatile("" : "+v"(t)); return t; }
namespace pg8 {
#define PG8_LAS __attribute__((address_space(3)))
typedef unsigned short bf16_t;
typedef short bf16x8 __attribute__((ext_vector_type(8)));
typedef float f32x4 __attribute__((ext_vector_type(4)));
typedef unsigned u32x4 __attribute__((ext_vector_type(4)));
constexpr int BM = 256, BK = 64, HALF = 128, HTB = HALF * BK * 2  , STAGE_BYTES = 8 * HTB, NXCD = 8, WGM = 8;

__host__ __device__ __forceinline__ int lds_byte(int r, int c) { const int st = (r >> 4) * 2 + (c >> 5), rr = r & 15, cc = c & 31, ob = rr * 64 + cc * 2; return st * 1024 + (ob ^ (((ob >> 9) & 1) << 5)); }
__host__ __device__ __forceinline__ void stage_rc(int b, int& R, int& C) { const int st = b / 1024, sb = b % 1024, swz = sb ^ (((sb >> 9) & 1) << 5); R = (st >> 1) * 16 + swz / 64; C = (st & 1) * 32 + (swz % 64) / 2; }
__host__ __device__ __forceinline__ int perm32(int rho) { const int n = rho >> 4, i = rho & 15; return 8 * (i >> 2) + 4 * n + (i & 3); }

struct Unit { int pm, pn; };
struct Gemm { const bf16_t* A; const bf16_t* Bt; int M, N, K; };

struct StaticOrder {
    int nM, nN, nwg, G, c;
    __host__ __device__ void init(int M, int N, int G_, int c_) { nM = M / BM; nN = N / BM; nwg = nM * nN; G = G_; c = c_; }
    __host__ __device__ bool next(int i, Unit& u) const {
        const long L = (long)i * G + c; if (L >= nwg) return false;
        int wgid = (int)L; { const int q = nwg / NXCD, r = nwg % NXCD, xcd = wgid % NXCD, off = wgid / NXCD; wgid = (xcd < r ? xcd * (q + 1) : r * (q + 1) + (xcd - r) * q) + off; }
        const int nig = WGM * nN, gid = wgid / nig, fm = gid * WGM, gsz = (nM - fm) < WGM ? (nM - fm) : WGM;
        u.pm = fm + ((wgid % nig) % gsz); u.pn = (wgid % nig) / gsz; return true;
    }
    __device__ __forceinline__ bool half_only(const Unit&) const { return false; }
    __device__ __forceinline__ void a_ready(const Unit&) const {}
    __device__ __forceinline__ void done(const Unit&) const {}
};

template <class Epi, class Sched, bool ALIGN_EPI = false, bool SP2 = false, bool F8 = false>
__device__ __forceinline__ void gemm_phase(PG8_LAS unsigned char* lds, const Gemm g, const Sched& S, const Epi& E) {
    const int tid = opaque_tid(), wid = __builtin_amdgcn_readfirstlane(tid >> 6), lane = tid & 63, wr = wid >> 2, wc = wid & 3, fr = lane & 15, fq = lane >> 4;
    const int K = g.K, nt = K / BK;
    unsigned voffA[2], voffB[2];
#pragma unroll
    for (int i = 0; i < 2; ++i) { int R, C; stage_rc(tid * 16 + i * 8192, R, C); const int Rb = Epi::PERM ? ((R & ~31) + perm32(R & 31)) : R;
        voffA[i] = (unsigned)(R * K + C) * 2u; voffB[i] = (unsigned)(Rb * K + C) * 2u; }
    const size_t kstep = (size_t)(BK * 2);
    const size_t hstep = (size_t)HALF * K * 2;
    const size_t tstep = 2 * hstep;
    const unsigned ldsw = (unsigned)wid * 1024u;
    const int aoff = lds_byte(wr * 64 + fr, fq * 8), boff = lds_byte(wc * 32 + fr, fq * 8);
#define PG8_SA(b, h) (((b) * 2 + (h)) * HTB)
#define PG8_SB(b, h) ((4 + (b) * 2 + (h)) * HTB)
#define PG8_STAGE(bufoff, gbase, voff) do { _Pragma("unroll") for (int _i = 0; _i < 2; ++_i) \
        __builtin_amdgcn_global_load_lds((const unsigned*)((const char*)(gbase) + (voff)[_i]), (PG8_LAS unsigned*)(lds + (bufoff) + ldsw + _i * 8192), 16, 0, 0); } while (0)
#define PG8_LDA(dst, b, h) do { _Pragma("unroll") for (int m = 0; m < 4; ++m) _Pragma("unroll") for (int k = 0; k < 2; ++k) dst[m][k] = *(const PG8_LAS bf16x8*)(lds + PG8_SA(b, h) + aoff + m * 2048 + k * 1024); } while (0)
#define PG8_LDB(dst, b, h) do { _Pragma("unroll") for (int n = 0; n < 2; ++n) _Pragma("unroll") for (int k = 0; k < 2; ++k) dst[n][k] = *(const PG8_LAS bf16x8*)(lds + PG8_SB(b, h) + boff + n * 2048 + k * 1024); } while (0)
#define PG8_MMA(ai, bj, At, Bt) do { __builtin_amdgcn_s_setprio(1); _Pragma("unroll") for (int m = 0; m < 4; ++m) _Pragma("unroll") for (int n = 0; n < 2; ++n) _Pragma("unroll") for (int k = 0; k < 2; ++k) { \
        if constexpr (F8) { typedef long v2l_ __attribute__((ext_vector_type(2))); const v2l_ b_ = __builtin_bit_cast(v2l_, Bt[n][k]), a_ = __builtin_bit_cast(v2l_, At[m][k]); \
            acc[ai][bj][m][n] = __builtin_amdgcn_mfma_f32_16x16x32_fp8_fp8(b_[0], a_[0], acc[ai][bj][m][n], 0, 0, 0); acc[ai][bj][m][n] = __builtin_amdgcn_mfma_f32_16x16x32_fp8_fp8(b_[1], a_[1], acc[ai][bj][m][n], 0, 0, 0); } \
        else acc[ai][bj][m][n] = __builtin_amdgcn_mfma_f32_16x16x32_bf16(Bt[n][k], At[m][k], acc[ai][bj][m][n], 0, 0, 0); } \
        __builtin_amdgcn_s_setprio(0); } while (0)
#define PG8_WAIT_V(n) asm volatile("s_waitcnt vmcnt(" #n ")" ::: "memory")
#define PG8_WAIT_L(n) asm volatile("s_waitcnt lgkmcnt(" #n ")" ::: "memory")
#define PG8_BAR __builtin_amdgcn_s_barrier()
#define PG8_SCHED __builtin_amdgcn_sched_barrier(0)
    Unit cur, nxt; int ui = 0;
    if (!S.next(0, cur)) return;
    f32x4 acc[2][2][4][2];
#pragma unroll
    for (int a = 0; a < 2; ++a)
#pragma unroll
        for (int b = 0; b < 2; ++b)
#pragma unroll
            for (int m = 0; m < 4; ++m)
#pragma unroll
                for (int n = 0; n < 2; ++n) acc[a][b][m][n] = (f32x4){0.f, 0.f, 0.f, 0.f};
    bf16x8 At[4][2], B0[2][2], B1[2][2];
    const char* cA = (const char*)g.A + (size_t)cur.pm * tstep; const char* cB = (const char*)g.Bt + (size_t)cur.pn * tstep;
    S.a_ready(cur);
    if constexpr (SP2) {
        PG8_STAGE(PG8_SB(0, 0), cB, voffB); PG8_STAGE(PG8_SB(0, 1), cB + hstep, voffB); PG8_STAGE(PG8_SA(0, 0), cA, voffA); PG8_STAGE(PG8_SA(0, 1), cA + hstep, voffA);
        if (wr == 1) PG8_BAR;
        PG8_WAIT_V(2); PG8_BAR;
        PG8_STAGE(PG8_SB(1, 0), cB + kstep, voffB); PG8_STAGE(PG8_SA(1, 0), cA + kstep, voffA); PG8_STAGE(PG8_SB(1, 1), cB + hstep + kstep, voffB);
        PG8_WAIT_V(6); PG8_BAR;
    } else {
        PG8_STAGE(PG8_SB(0, 0), cB, voffB); PG8_STAGE(PG8_SA(0, 0), cA, voffA); PG8_STAGE(PG8_SB(0, 1), cB + hstep, voffB); PG8_STAGE(PG8_SA(0, 1), cA + hstep, voffA);
        if (wr == 1) PG8_BAR;
        PG8_WAIT_V(4); PG8_BAR;
        PG8_STAGE(PG8_SB(1, 0), cB + kstep, voffB); PG8_STAGE(PG8_SA(1, 0), cA + kstep, voffA); PG8_STAGE(PG8_SB(1, 1), cB + hstep + kstep, voffB);
        PG8_WAIT_V(6); PG8_BAR;
    }
    for (;;) {
        const bool has_next = S.next(ui + 1, nxt);
        const char* nA = has_next ? (const char*)g.A + (size_t)nxt.pm * tstep : cA; const char* nB = has_next ? (const char*)g.Bt + (size_t)nxt.pn * tstep : cB;
        for (int t = 0; t < nt; t += 2) {
            const bool last = (t == nt - 2);
            const char* a1 = cA + (size_t)(t + 1) * kstep;
            const char* a2 = last ? nA : cA + (size_t)(t + 2) * kstep; const char* b2 = last ? nB : cB + (size_t)(t + 2) * kstep;
            const char* a3 = a2 + kstep; const char* b3 = b2 + kstep;
            if (last && has_next) S.a_ready(nxt);
            if constexpr (SP2) {
            PG8_LDB(B0, 0, 0); PG8_LDB(B1, 0, 1); PG8_SCHED; PG8_LDA(At, 0, 0); PG8_STAGE(PG8_SA(1, 1), a1 + hstep, voffA);
            PG8_WAIT_V(8); PG8_WAIT_L(0); PG8_BAR; PG8_MMA(0, 0, At, B0); PG8_MMA(0, 1, At, B1); PG8_BAR; PG8_SCHED;
            PG8_LDA(At, 0, 1); PG8_STAGE(PG8_SB(0, 0), b2, voffB); PG8_STAGE(PG8_SB(0, 1), b2 + hstep, voffB); PG8_STAGE(PG8_SA(0, 0), a2, voffA);
            PG8_WAIT_V(8); PG8_WAIT_L(0); PG8_BAR; PG8_MMA(1, 0, At, B0); PG8_MMA(1, 1, At, B1); PG8_BAR; PG8_SCHED;
            PG8_LDB(B0, 1, 0); PG8_LDB(B1, 1, 1); PG8_SCHED; PG8_LDA(At, 1, 0); PG8_STAGE(PG8_SA(0, 1), a2 + hstep, voffA);
            PG8_WAIT_V(8); PG8_WAIT_L(0); PG8_BAR; PG8_MMA(0, 0, At, B0); PG8_MMA(0, 1, At, B1); PG8_BAR; PG8_SCHED;
            PG8_LDA(At, 1, 1); PG8_STAGE(PG8_SB(1, 0), b3, voffB); PG8_STAGE(PG8_SB(1, 1), b3 + hstep, voffB); PG8_STAGE(PG8_SA(1, 0), a3, voffA);
            PG8_WAIT_V(8); PG8_WAIT_L(0); PG8_BAR; PG8_MMA(1, 0, At, B0); PG8_MMA(1, 1, At, B1); PG8_BAR; PG8_SCHED;
            } else {
            PG8_LDB(B0, 0, 0); PG8_SCHED; PG8_LDA(At, 0, 0); PG8_STAGE(PG8_SA(1, 1), a1 + hstep, voffA);
            PG8_WAIT_L(8); PG8_BAR; PG8_WAIT_L(0); PG8_MMA(0, 0, At, B0); PG8_BAR; PG8_SCHED;
            PG8_LDB(B1, 0, 1); PG8_STAGE(PG8_SB(0, 0), b2, voffB);
            PG8_BAR; PG8_WAIT_L(0); PG8_MMA(0, 1, At, B1); PG8_BAR;
            PG8_LDA(At, 0, 1); PG8_STAGE(PG8_SA(0, 0), a2, voffA);
            PG8_BAR; PG8_WAIT_L(0); PG8_MMA(1, 0, At, B0); PG8_BAR; PG8_SCHED;
            PG8_STAGE(PG8_SB(0, 1), b2 + hstep, voffB);
            PG8_WAIT_V(6); PG8_BAR; PG8_MMA(1, 1, At, B1); PG8_BAR;
            PG8_LDB(B0, 1, 0); PG8_SCHED; PG8_LDA(At, 1, 0); PG8_STAGE(PG8_SA(0, 1), a2 + hstep, voffA);
            PG8_WAIT_L(8); PG8_BAR; PG8_WAIT_L(0); PG8_MMA(0, 0, At, B0); PG8_BAR; PG8_SCHED;
            PG8_LDB(B1, 1, 1); PG8_STAGE(PG8_SB(1, 0), b3, voffB);
            PG8_BAR; PG8_WAIT_L(0); PG8_MMA(0, 1, At, B1); PG8_BAR;
            PG8_LDA(At, 1, 1); PG8_STAGE(PG8_SA(1, 0), a3, voffA);
            PG8_BAR; PG8_WAIT_L(0); PG8_MMA(1, 0, At, B0); PG8_BAR; PG8_SCHED;
            PG8_STAGE(PG8_SB(1, 1), b3 + hstep, voffB);
            PG8_WAIT_V(6); PG8_BAR; PG8_MMA(1, 1, At, B1); PG8_BAR;
            }
        }
        if constexpr (ALIGN_EPI) { if (wr == 0) PG8_BAR; }
        if constexpr (!Epi::AFTER_DRAIN) { E(acc, cur, wr, wc, fr, fq); S.done(cur); }
        if (!has_next) break;
#pragma unroll
        for (int a = 0; a < 2; ++a)
#pragma unroll
            for (int b = 0; b < 2; ++b)
#pragma unroll
                for (int m = 0; m < 4; ++m)
#pragma unroll
                    for (int n = 0; n < 2; ++n) acc[a][b][m][n] = (f32x4){0.f, 0.f, 0.f, 0.f};
        cur = nxt; cA = nA; cB = nB; ++ui;
        if constexpr (ALIGN_EPI) { if (wr == 1) PG8_BAR; }
    }
    PG8_WAIT_V(0);
    if constexpr (!ALIGN_EPI) { if (wr == 0) PG8_BAR; }
    PG8_BAR;
    if constexpr (Epi::AFTER_DRAIN) { E.fused(acc, cur, wr, wc, fr, fq, lds, wid, lane); S.done(cur); }
#undef PG8_SA
#undef PG8_SB
#undef PG8_STAGE
#undef PG8_LDA
#undef PG8_LDB
#undef PG8_MMA
#undef PG8_WAIT_V
#undef PG8_WAIT_L
#undef PG8_BAR
#undef PG8_SCHED
}
}

constexpr int NWAVES = 8;
constexpr int M = 16384, D = 1024, NIN = 4096, HSEC = 512;
constexpr int NEXP = 32, DEXP = 512, MAXTILES = 160, MAXSLOTS = MAXTILES * 256;
constexpr float QSCALE = 0.18033688011112042f;

constexpr size_t MiB = 1u << 20;
constexpr size_t WS_CTL = 0, CTL_ZERO_BYTES = 1 * MiB;
constexpr size_t WS_WR = 1 * MiB;
constexpr size_t WS_ROPE = 2 * MiB;
constexpr size_t WS_HD = 3 * MiB;
constexpr size_t WS_TOKE = 3 * MiB + 256 * 1024, WS_TOKW = WS_TOKE + 128 * 1024, WS_TOKR = WS_TOKW + 128 * 1024, WS_TOKS = WS_TOKR + 128 * 1024, WS_LAM = WS_TOKS + 128 * 1024, WS_GCNT = WS_LAM + 128 * 1024, WS_RSTD = 1 * MiB + 256 * 1024, WS_RSLOT = 1 * MiB + 768 * 1024, WS_PERM = 1 * MiB + 512 * 1024;
constexpr size_t WS_WOUT = 4 * MiB, WS_WIN = 6 * MiB;
constexpr size_t WS_XN = 16 * MiB;
constexpr size_t WS_OF = 16 * MiB;
constexpr size_t WS_X2B = 16 * MiB;
constexpr size_t WS_HM = 144 * MiB;
constexpr size_t WS_X2F8 = 112 * MiB;
constexpr size_t WS_QH = 48 * MiB, WS_VH = 64 * MiB, WS_SG = 80 * MiB, WS_QD = 96 * MiB, WS_KD = 112 * MiB, WS_VD = 128 * MiB;
constexpr size_t WS_WGU = 48 * MiB, WS_WD = 216 * MiB;
constexpr size_t WS_GF = 144 * MiB, WS_GB = 176 * MiB;
constexpr size_t WS_MIX = 144 * MiB;
constexpr size_t WS_HS = 208 * MiB, WS_HL = 224 * MiB;
constexpr size_t WS_OB = 224 * MiB;
constexpr size_t WS_HG = 176 * MiB;
constexpr size_t WS_O0S = 176 * MiB;
constexpr size_t WS_Y = 48 * MiB;
constexpr size_t WS_END = 256 * MiB;
static_assert(WS_Y + (size_t)MAXSLOTS * 1024 * 2 <= WS_HM && WS_HM + (size_t)MAXSLOTS * 512 * 2 <= WS_WD && WS_WD + 32 * MiB <= WS_END, "ws map");
constexpr int CW_BAR = 4096, CW_CNT = 16384, CW_KMAX = 20480, CW_QWD = 21504, CW_READY = 32768, CNT_STRIDE = 64;

constexpr int PHASE_LDS = 147456, MISC_OFF = PHASE_LDS, LDS_BYTES = PHASE_LDS + 1024;

#define GAS __attribute__((address_space(1)))
#define LAS __attribute__((address_space(3)))
typedef unsigned short bf16_t;
typedef _Float16 half_t;
typedef float f32x4 __attribute__((ext_vector_type(4)));
typedef float f32x16 __attribute__((ext_vector_type(16)));
typedef short bf16x8 __attribute__((ext_vector_type(8)));
typedef short s16x4 __attribute__((ext_vector_type(4)));
typedef unsigned u32x4 __attribute__((ext_vector_type(4)));
typedef unsigned u32x2 __attribute__((ext_vector_type(2)));
#define LDS_WAIT() asm volatile("s_waitcnt lgkmcnt(0)" ::: "memory")
#define VM_WAIT() asm volatile("s_waitcnt vmcnt(0)" ::: "memory")
#define SBAR() __builtin_amdgcn_sched_barrier(0)
__device__ __forceinline__ unsigned f2bf(float f) { unsigned u = __builtin_bit_cast(unsigned, f); return (u + 0x7fffu + ((u >> 16) & 1u)) >> 16; }
__device__ __forceinline__ unsigned pk2(float lo, float hi) { return f2bf(lo) | (f2bf(hi) << 16); }
__device__ __forceinline__ float bf2f(unsigned b) { return __builtin_bit_cast(float, b << 16); }
__device__ __forceinline__ float bflo(unsigned w) { return __builtin_bit_cast(float, w << 16); }
__device__ __forceinline__ float bfhi(unsigned w) { return __builtin_bit_cast(float, w & 0xffff0000u); }
__device__ __forceinline__ unsigned cvtpk(float lo, float hi) { unsigned r; asm volatile("v_cvt_pk_bf16_f32 %0, %1, %2" : "=v"(r) : "v"(lo), "v"(hi)); return r; }
__device__ __forceinline__ unsigned pk4_fp8(float a, float b, float c, float d) { int w = 0; w = __builtin_amdgcn_cvt_pk_fp8_f32(a, b, w, false); w = __builtin_amdgcn_cvt_pk_fp8_f32(c, d, w, true); return (unsigned)w; }
constexpr float F8_WSCALE = 256.f, F8_HSCALE = 16.f, F8_YSCALE = 32.f;
__device__ __forceinline__ float ex2(float x) { return __builtin_amdgcn_exp2f(x); }
__device__ __forceinline__ float lg2(float x) { return __builtin_amdgcn_logf(x); }
__device__ __forceinline__ float sigmoidf_(float v) { return __builtin_amdgcn_rcpf(1.f + ex2(-1.4426950408889634f * v)); }
__device__ __forceinline__ bool lane_is_hi() { return (opaque_tid() & 32) != 0; }
template <int X> __device__ __forceinline__ float lane_xor(float v) {
    if constexpr (X == 32) { auto rr = __builtin_amdgcn_permlane32_swap(__float_as_uint(v), __float_as_uint(v), false, false); return __uint_as_float(lane_is_hi() ? rr[0] : rr[1]); }
    else return __int_as_float(__builtin_amdgcn_ds_swizzle(__float_as_int(v), (X << 10) | 0x1F));
}
__device__ __forceinline__ float wave_sum(float v) {
    v += lane_xor<1>(v); v += lane_xor<2>(v); v += lane_xor<4>(v); v += lane_xor<8>(v); v += lane_xor<16>(v);
    auto rr = __builtin_amdgcn_permlane32_swap(__float_as_uint(v), __float_as_uint(v), false, false);
    return __uint_as_float(rr[0]) + __uint_as_float(rr[1]);
}
__device__ __forceinline__ int crow(int r, int hi) { return (r & 3) + 8 * (r >> 2) + 4 * hi; }
#define XB_TMO      128
#define XB_XCNT(j)  (256  + 64 * (j))
#define XB_XSUB(j)  (1280 + 64 * (j))
#define XB_XGEN(j)  (2304 + 64 * (j))
#define XB_TOP      3328
#define XB_TOPGEN   3392
#define XCD_BAR_WORDS 3456
#define XB_SPIN_CAP (1u << 18)

__device__ __forceinline__ unsigned xb_ld(unsigned* p)              { return __hip_atomic_load(p, __ATOMIC_RELAXED, __HIP_MEMORY_SCOPE_AGENT); }
__device__ __forceinline__ unsigned xb_add(unsigned* p, unsigned v) { return __hip_atomic_fetch_add(p, v, __ATOMIC_RELAXED, __HIP_MEMORY_SCOPE_AGENT); }
__device__ __forceinline__ unsigned xb_xcc_id() { return (unsigned)__builtin_amdgcn_s_getreg((3 << 11) | 20) & 0xFu; }
#define XB_SPIN(cond, bar) do { unsigned _sp = 0; while (cond) { __builtin_amdgcn_s_sleep(1); \
    if ((++_sp & 255u) == 0u) { if (xb_ld(&(bar)[XB_TMO])) break; if (_sp > XB_SPIN_CAP) { atomicAdd(&(bar)[XB_TMO], 1u); break; } } } } while (0)

struct XcdBarrier {
    unsigned* bar; unsigned x;
    volatile LAS unsigned* st;
};

__device__ __forceinline__ XcdBarrier xcd_barrier_post(unsigned* bar, volatile LAS unsigned* st) {
    XcdBarrier b; b.bar = bar; b.x = xb_xcc_id(); b.st = st;
    if (threadIdx.x == 0) (void)xb_add(&bar[XB_XCNT(b.x)], 1u);
    return b;
}
__device__ __forceinline__ void xcd_barrier_complete(unsigned* bar, unsigned x, unsigned& nloc, unsigned& nx) {
    const unsigned G = gridDim.x * gridDim.y * gridDim.z;
    unsigned sum, cnt, mine, sp = 0u;
    for (;;) {
        sum = 0u; cnt = 0u; mine = 0u;
#pragma unroll
        for (unsigned j = 0; j < 16; ++j) { const unsigned c = xb_ld(&bar[XB_XCNT(j)]); sum += c; cnt += (c > 0u) ? 1u : 0u; mine = (j == x) ? c : mine; }
        if (sum == G) break;
        __builtin_amdgcn_s_sleep(1);
        if ((++sp & 255u) == 0u) { if (xb_ld(&bar[XB_TMO])) break; if (sp > XB_SPIN_CAP) { atomicAdd(&bar[XB_TMO], 1u); break; } }
    }
    nloc = mine > 0u ? mine : 1u; nx = cnt > 0u ? cnt : 1u;
}

__device__ __forceinline__ void xcd_barrier(const XcdBarrier& b) {
    asm volatile("s_waitcnt vmcnt(0)" ::: "memory");
    __syncthreads();
    if (threadIdx.x == 0) {
        unsigned* bar = b.bar;
        __builtin_amdgcn_s_waitcnt(0);
        unsigned nloc = b.st[0], nx = b.st[1];
        if (nloc == 0u) { xcd_barrier_complete(bar, b.x, nloc, nx); b.st[0] = nloc; b.st[1] = nx; }
        const unsigned old = xb_add(&bar[XB_XSUB(b.x)], 1u);
        const unsigned gen = old / nloc;
        if (old + 1u == (gen + 1u) * nloc) {
            __builtin_amdgcn_fence(__ATOMIC_RELEASE, "agent");
            asm volatile("s_waitcnt vmcnt(0)" ::: "memory");
            const unsigned og = xb_add(&bar[XB_TOP], 1u);
            const unsigned tg = og / nx;
            if (og + 1u == (tg + 1u) * nx) xb_add(&bar[XB_TOPGEN], 1u);
            else XB_SPIN(xb_ld(&bar[XB_TOPGEN]) == tg, bar);
            __builtin_amdgcn_fence(__ATOMIC_ACQUIRE, "agent");
            xb_add(&bar[XB_XGEN(b.x)], 1u);
            asm volatile("s_waitcnt vmcnt(0)" ::: "memory");
        } else {
            XB_SPIN(xb_ld(&bar[XB_XGEN(b.x)]) == gen, bar);
            __builtin_amdgcn_fence(__ATOMIC_ACQUIRE, "agent");
            asm volatile("s_waitcnt vmcnt(0)" ::: "memory");
        }
    }
    __syncthreads();
}

struct XposeRegs { f32x4 v[8]; };
__device__ __forceinline__ void xpose_load(XposeRegs& R, const float* W, int K, int N, int item, int lane) {
    const int nblk = N / 32, kb = item / nblk, nb = item % nblk, k0 = 64 * kb, n0 = 32 * nb; (void)K;
    const float* p = W + (size_t)(k0 + (lane >> 3)) * N + n0 + (lane & 7) * 4;
#pragma unroll
    for (int i = 0; i < 8; ++i) R.v[i] = __builtin_nontemporal_load((const GAS f32x4*)(p + (size_t)(8 * i) * N));
}
__device__ __forceinline__ void xpose_store(const XposeRegs& R, int K, int N, bf16_t* WT, int row_off, int row_mul, LAS float* scr, int item, int lane, const float* kgain = nullptr) {
    const int nblk = N / 32, kb = item / nblk, nb = item % nblk, k0 = 64 * kb, n0 = 32 * nb;
#pragma unroll
    for (int i = 0; i < 8; ++i) { LAS float* d = scr + (8 * i + (lane >> 3)) * 33 + (lane & 7) * 4; d[0] = R.v[i].x; d[1] = R.v[i].y; d[2] = R.v[i].z; d[3] = R.v[i].w; }
    LDS_WAIT(); asm volatile("" ::: "memory");
    const int c = lane & 7;
    f32x4 g0 = {1.f, 1.f, 1.f, 1.f}, g1 = g0;
    if (kgain) { g0 = *(const GAS f32x4*)(kgain + k0 + 8 * c); g1 = *(const GAS f32x4*)(kgain + k0 + 8 * c + 4); }
#pragma unroll
    for (int j = 0; j < 4; ++j) { const int n = (lane >> 3) + 8 * j; const LAS float* s = scr + (8 * c) * 33 + n;
        u32x4 o; o.x = cvtpk(s[0 * 33] * g0.x, s[1 * 33] * g0.y); o.y = cvtpk(s[2 * 33] * g0.z, s[3 * 33] * g0.w); o.z = cvtpk(s[4 * 33] * g1.x, s[5 * 33] * g1.y); o.w = cvtpk(s[6 * 33] * g1.z, s[7 * 33] * g1.w);
        *(GAS u32x4*)(WT + (size_t)(row_off + (n0 + n) * row_mul) * K + k0 + 8 * c) = o; }
    LDS_WAIT(); asm volatile("" ::: "memory");
}
__device__ __forceinline__ void xpose_store_f8(const XposeRegs& R, int K, int N, unsigned char* WT, int row_off, int row_mul, LAS float* scr, int item, int lane, float scale, const float* kgain = nullptr) {
    const int nblk = N / 32, kb = item / nblk, nb = item % nblk, k0 = 64 * kb, n0 = 32 * nb;
#pragma unroll
    for (int i = 0; i < 8; ++i) { LAS float* d = scr + (8 * i + (lane >> 3)) * 33 + (lane & 7) * 4; d[0] = R.v[i].x; d[1] = R.v[i].y; d[2] = R.v[i].z; d[3] = R.v[i].w; }
    LDS_WAIT(); asm volatile("" ::: "memory");
    const int c = lane & 7;
    f32x4 g0 = {scale, scale, scale, scale}, g1 = g0;
    if (kgain) { g0 = *(const GAS f32x4*)(kgain + k0 + 8 * c) * scale; g1 = *(const GAS f32x4*)(kgain + k0 + 8 * c + 4) * scale; }
#pragma unroll
    for (int j = 0; j < 4; ++j) { const int n = (lane >> 3) + 8 * j; const LAS float* s = scr + (8 * c) * 33 + n;
        u32x2 o; o.x = pk4_fp8(s[0 * 33] * g0.x, s[1 * 33] * g0.y, s[2 * 33] * g0.z, s[3 * 33] * g0.w); o.y = pk4_fp8(s[4 * 33] * g1.x, s[5 * 33] * g1.y, s[6 * 33] * g1.z, s[7 * 33] * g1.w);
        *(GAS u32x2*)(WT + (size_t)(row_off + (n0 + n) * row_mul) * K + k0 + 8 * c) = o; }
    LDS_WAIT(); asm volatile("" ::: "memory");
}
template <int NR>
__device__ __forceinline__ void rms_rows_to_bf16(const float* X, const float* gain, bf16_t* O, int m0, int stride, int lane, float eps) {
    f32x4 v[NR][4]; float s[NR];
#pragma unroll
    for (int i = 0; i < NR; ++i) { const GAS f32x4* xr = (const GAS f32x4*)(X + (size_t)(m0 + i * stride) * D) + lane;
#pragma unroll
        for (int j = 0; j < 4; ++j) v[i][j] = xr[64 * j]; }
#pragma unroll
    for (int i = 0; i < NR; ++i) { float t = 0.f;
#pragma unroll
        for (int j = 0; j < 4; ++j) t += (v[i][j].x * v[i][j].x + v[i][j].y * v[i][j].y) + (v[i][j].z * v[i][j].z + v[i][j].w * v[i][j].w);
        s[i] = t; }
#pragma unroll
    for (int i = 0; i < NR; ++i) s[i] = 1.f / sqrtf(wave_sum(s[i]) * (1.f / 1024.f) + eps);
#pragma unroll
    for (int j = 0; j < 4; ++j) { const f32x4 g = ((const GAS f32x4*)gain)[64 * j + lane];
#pragma unroll
        for (int i = 0; i < NR; ++i) { u32x2 w; w.x = cvtpk(v[i][j].x * s[i] * g.x, v[i][j].y * s[i] * g.y); w.y = cvtpk(v[i][j].z * s[i] * g.z, v[i][j].w * s[i] * g.w);
            ((GAS u32x2*)(O + (size_t)(m0 + i * stride) * D) + lane)[64 * j] = w; } }
}

struct EpiInProj {
    static constexpr bool PERM = true, AFTER_DRAIN = false;
    bf16_t *QH, *VH, *SG, *QD, *KD, *VD; half_t *GF, *GB; const float* lbraw; const float *cosT, *sinT;
    __device__ __forceinline__ void operator()(const pg8::f32x4 (&acc)[2][2][4][2], const pg8::Unit& u, int wr, int wc, int fr, int fq) const {
        const int sec = u.pn >> 1;
        const int row0 = u.pm * 256 + wr * 64 + fr;
        const int cs0 = (u.pn & 1) * 256 + wc * 32 + 8 * fq;
        if (sec == 1 || sec == 2) {
            half_t* G = sec == 1 ? GF : GB; const float* lbp = lbraw + (sec - 1) * 1024;
#pragma unroll
            for (int bj = 0; bj < 2; ++bj) { const int c = cs0 + bj * 128; float lb[8];
#pragma unroll
                for (int j = 0; j < 8; ++j) { const float l0 = lbp[c + j], l1 = lbp[512 + c + j]; lb[j] = __builtin_amdgcn_rcpf(1.f + ex2(1.4426950408889634f * (l0 - l1))); }
#pragma unroll
                for (int ai = 0; ai < 2; ++ai)
#pragma unroll
                    for (int m = 0; m < 4; ++m) { const int row = row0 + ai * 128 + m * 16; f32x4 o0, o1;
#pragma unroll
                        for (int j = 0; j < 4; ++j) { o0[j] = lb[j] + (1.f - lb[j]) * sigmoidf_(acc[ai][bj][m][0][j]); o1[j] = lb[4 + j] + (1.f - lb[4 + j]) * sigmoidf_(acc[ai][bj][m][1][j]); }
                        typedef _Float16 h8 __attribute__((ext_vector_type(8)));
                        const h8 hv = {(_Float16)o0[0], (_Float16)o0[1], (_Float16)o0[2], (_Float16)o0[3], (_Float16)o1[0], (_Float16)o1[1], (_Float16)o1[2], (_Float16)o1[3]};
                        *(h8*)(G + (size_t)row * HSEC + c) = hv; } }
            return;
        }
        bf16_t* O = sec == 0 ? QH : sec == 3 ? VH : sec == 4 ? SG : sec == 5 ? QD : sec == 6 ? KD : VD;
        const bool rot = (sec == 5 || sec == 6) && ((wc & 1) == 0);
        const float sc = sec == 5 ? QSCALE : 1.f;
#pragma unroll
        for (int ai = 0; ai < 2; ++ai)
#pragma unroll
            for (int m = 0; m < 4; ++m) { const int row = row0 + ai * 128 + m * 16;
#pragma unroll
                for (int bj = 0; bj < 2; ++bj) { const int c = cs0 + bj * 128; float v[8];
#pragma unroll
                    for (int j = 0; j < 4; ++j) { v[j] = acc[ai][bj][m][0][j]; v[4 + j] = acc[ai][bj][m][1][j]; }
                    if (sec == 4) {
#pragma unroll
                        for (int j = 0; j < 8; ++j) v[j] = v[j] * sigmoidf_(v[j]);
                    }
                    if (rot) {
                        const f32x4 c0 = *(const f32x4*)(cosT + (size_t)row * 8), c1 = *(const f32x4*)(cosT + (size_t)row * 8 + 4);
                        const f32x4 s0 = *(const f32x4*)(sinT + (size_t)row * 8), s1 = *(const f32x4*)(sinT + (size_t)row * 8 + 4);
#pragma unroll
                        for (int j = 0; j < 8; ++j) { const float p = lane_xor<16>(v[j]); const float cj = j < 4 ? c0[j & 3] : c1[j & 3], sj = j < 4 ? s0[j & 3] : s1[j & 3];
                            const float r = fq == 0 ? v[j] * cj - p * sj : v[j] * cj + p * sj; v[j] = fq < 2 ? r : v[j]; }
                    }
                    u32x4 w; w.x = cvtpk(v[0] * sc, v[1] * sc); w.y = cvtpk(v[2] * sc, v[3] * sc); w.z = cvtpk(v[4] * sc, v[5] * sc); w.w = cvtpk(v[6] * sc, v[7] * sc);
                    *(u32x4*)(O + (size_t)row * HSEC + c) = w; } }
    }
};
struct EpiResid {
    static constexpr bool PERM = true, AFTER_DRAIN = false;
    const float* X; bf16_t* O; unsigned char* O8;
    __device__ __forceinline__ void operator()(const pg8::f32x4 (&acc)[2][2][4][2], const pg8::Unit& u, int wr, int wc, int fr, int fq) const {
        const int row0 = u.pm * 256 + wr * 64 + fr, col0 = u.pn * 256 + wc * 32 + 8 * fq;
#pragma unroll
        for (int ai = 0; ai < 2; ++ai)
#pragma unroll
            for (int m = 0; m < 4; ++m) { const size_t off = (size_t)(row0 + ai * 128 + m * 16) * D + col0;
#pragma unroll
                for (int bj = 0; bj < 2; ++bj) { const f32x4 a = *(const f32x4*)(X + off + bj * 128) + acc[ai][bj][m][0], b = *(const f32x4*)(X + off + bj * 128 + 4) + acc[ai][bj][m][1];
                    u32x4 w; w.x = cvtpk(a[0], a[1]); w.y = cvtpk(a[2], a[3]); w.z = cvtpk(b[0], b[1]); w.w = cvtpk(b[2], b[3]); *(u32x4*)(O + off + bj * 128) = w;
                    u32x2 f; f.x = pk4_fp8(a[0], a[1], a[2], a[3]); f.y = pk4_fp8(b[0], b[1], b[2], b[3]); *(u32x2*)(O8 + off + bj * 128) = f; } }
    }
};
struct EpiSwiGlu {
    unsigned char* O; const float* RS;
    __device__ __forceinline__ void operator()(const f32x4 (&acc)[2][4][2], const pg8::Unit& u, int wr, int wc, int fr, int fq) const {
        const int row0 = u.pm * 128 + wr * 64 + fr, col0 = ((u.pn & 3) * 256 + wc * 32 + 8 * fq) >> 1;
#pragma unroll
        for (int m = 0; m < 4; ++m) { const int row = row0 + m * 16; const float rs = RS[row] * (1.f / F8_WSCALE); unsigned char* rowp = O + (size_t)row * DEXP + col0;
#pragma unroll
            for (int bj = 0; bj < 2; ++bj) { const f32x4 a = acc[bj][m][0] * rs, b = acc[bj][m][1] * rs;
                const float h0 = a[0] * sigmoidf_(a[0]) * a[1], h1 = a[2] * sigmoidf_(a[2]) * a[3], h2 = b[0] * sigmoidf_(b[0]) * b[1], h3 = b[2] * sigmoidf_(b[2]) * b[3];
                *(unsigned*)(rowp + bj * 64) = pk4_fp8(__builtin_amdgcn_fmed3f(h0 * F8_HSCALE, -448.f, 448.f), __builtin_amdgcn_fmed3f(h1 * F8_HSCALE, -448.f, 448.f), __builtin_amdgcn_fmed3f(h2 * F8_HSCALE, -448.f, 448.f), __builtin_amdgcn_fmed3f(h3 * F8_HSCALE, -448.f, 448.f)); } }
    }
};
struct EpiDown {
    unsigned char* O;
    __device__ __forceinline__ void operator()(const f32x4 (&acc)[2][4][2], const pg8::Unit& u, int wr, int wc, int fr, int fq) const {
        const int row0 = u.pm * 128 + wr * 64 + fr, col0 = (u.pn & 3) * 256 + wc * 32 + 8 * fq; constexpr float us = F8_YSCALE / (F8_WSCALE * F8_HSCALE);
#pragma unroll
        for (int m = 0; m < 4; ++m) { unsigned char* rowp = O + (size_t)(row0 + m * 16) * D + col0;
#pragma unroll
            for (int bj = 0; bj < 2; ++bj) { const f32x4 a = acc[bj][m][0] * us, b = acc[bj][m][1] * us;
                u32x2 w; w.x = pk4_fp8(__builtin_amdgcn_fmed3f(a[0], -448.f, 448.f), __builtin_amdgcn_fmed3f(a[1], -448.f, 448.f), __builtin_amdgcn_fmed3f(a[2], -448.f, 448.f), __builtin_amdgcn_fmed3f(a[3], -448.f, 448.f));
                w.y = pk4_fp8(__builtin_amdgcn_fmed3f(b[0], -448.f, 448.f), __builtin_amdgcn_fmed3f(b[1], -448.f, 448.f), __builtin_amdgcn_fmed3f(b[2], -448.f, 448.f), __builtin_amdgcn_fmed3f(b[3], -448.f, 448.f));
                *(u32x2*)(rowp + bj * 128) = w; } }
    }
};
struct MoeOrder {
    const volatile LAS int* tb; int G, c; const int* PERM; unsigned* ready; int mode;
    __device__ __forceinline__ bool decode(int L, pg8::Unit& u) const {
        const int x = c & 7; int base = 0;
#pragma unroll 1
        for (int k = 0; k < 4; ++k) { const int e = 4 * x + k, t0 = __builtin_amdgcn_readfirstlane(tb[e]), nt = __builtin_amdgcn_readfirstlane(tb[e + 1]) - t0;
            if (L < base + 4 * nt) { const int idx = L - base; u.pm = t0 + idx % nt; u.pn = e * 4 + idx / nt; return true; }
            base += 4 * nt; }
        return false;
    }
    __device__ __forceinline__ bool next(int i, pg8::Unit& u) const {
        if ((G & 7) == 0) {
            const int x = c & 7, s = c >> 3, nb = G >> 3;
            const int U = 4 * (__builtin_amdgcn_readfirstlane(tb[4 * x + 4]) - __builtin_amdgcn_readfirstlane(tb[4 * x]));
            if (mode == 0) return decode(i * nb + s, u);
            const int i0 = s < U ? (U - s + nb - 1) / nb : 0;
            return decode((i0 + i) * nb + s - U, u);
        }
        const int L = i * G + c, T = __builtin_amdgcn_readfirstlane(tb[32]); if (L >= 4 * T) return false;
        const int tile = L >> 2; int e = 0;
#pragma unroll 1
        for (int j = 1; j < 32; ++j) e += (__builtin_amdgcn_readfirstlane(tb[j]) <= tile) ? 1 : 0;
        u.pm = tile; u.pn = e * 4 + (L & 3); return true;
    }
    __device__ __forceinline__ int row_tok(const pg8::Unit& u, int r) const {
        const int e = u.pn >> 2, rem = __builtin_amdgcn_readfirstlane(tb[64 + e]) - (u.pm - __builtin_amdgcn_readfirstlane(tb[e])) * 128;
        return r < rem ? PERM[u.pm * 128 + r] : 0;
    }
    __device__ __forceinline__ bool half_only(const pg8::Unit&) const { return false; }
    __device__ __forceinline__ void done(const pg8::Unit& u) const {
        if (mode == 2) { asm volatile("s_waitcnt vmcnt(0)" ::: "memory");
            if ((threadIdx.x & 63) == 0) __hip_atomic_fetch_add(ready + 64 * u.pm, 1u, __ATOMIC_RELAXED, __HIP_MEMORY_SCOPE_AGENT); }
    }
    __device__ __forceinline__ void a_ready(const pg8::Unit& u) const {
        if (mode == 1) {
            if (threadIdx.x < 64) { const unsigned long long t0 = __builtin_amdgcn_s_memrealtime();
                while ((unsigned)__builtin_amdgcn_readfirstlane(__hip_atomic_load(ready + 64 * u.pm, __ATOMIC_RELAXED, __HIP_MEMORY_SCOPE_AGENT)) < 32u) {
                    if (__builtin_amdgcn_s_memrealtime() - t0 > 2000000ull) break;
                    __builtin_amdgcn_s_sleep(2); }
                __builtin_amdgcn_fence(__ATOMIC_ACQUIRE, "agent");
                asm volatile("s_waitcnt vmcnt(0)" ::: "memory"); }
            asm volatile("" ::: "memory"); __builtin_amdgcn_s_barrier(); asm volatile("" ::: "memory");
        }
    }
};

namespace mg {
constexpr int TM = 128, BUF = 3 * pg8::HTB;
#define MG_WAIT_V(n) asm volatile("s_waitcnt vmcnt(" #n ")" ::: "memory")
#define MG_WAIT_L0() asm volatile("s_waitcnt lgkmcnt(0)" ::: "memory")
#define MG_BAR() do { asm volatile("" ::: "memory"); __builtin_amdgcn_s_barrier(); asm volatile("" ::: "memory"); __builtin_amdgcn_sched_barrier(0); } while (0)
struct Frags { bf16x8 a[4][2], b[2][2][2]; };
template <class Epi, class Sched, bool GATHER>
__device__ __forceinline__ void gemm(LAS unsigned char* lds, const unsigned char* A, const unsigned char* Bt, int Kb, const Sched& S, const Epi& E) {
    const int tid = opaque_tid(), wid = __builtin_amdgcn_readfirstlane(tid >> 6), lane = tid & 63, wr = wid >> 2, wc = wid & 3, fr = lane & 15, fq = lane >> 4;
    asm volatile("" : "+s"(Kb));
    const int nkt = Kb >> 7;
    unsigned voffB[2], colA[2]; int rowA[2];
#pragma unroll
    for (int i = 0; i < 2; ++i) { int R, C; pg8::stage_rc(tid * 16 + i * 8192, R, C); const int Rb = (R & ~31) + pg8::perm32(R & 31);
        rowA[i] = R; colA[i] = (unsigned)C * 2u; voffB[i] = (unsigned)(Rb * Kb) + (unsigned)C * 2u; }
    const unsigned ldsw = (unsigned)wid * 1024u;
    const int aoff = pg8::lds_byte(wr * 64 + fr, fq * 8), boff = pg8::lds_byte(wc * 32 + fr, fq * 8);
    const size_t bhalf = (size_t)128 * Kb;
#define MG_DMA(slot_, ao_, bb_, kt_) do { _Pragma("unroll") for (int p_ = 0; p_ < 6; ++p_) MG_DMA1(p_, slot_, ao_, bb_, kt_); } while (0)
#define MG_DMA1(p_, slot_, ao_, bb_, kt_) do { const unsigned so_ = (unsigned)(slot_) * BUF; const size_t ko_ = (size_t)(kt_) * 128; \
        if ((p_) < 2) __builtin_amdgcn_global_load_lds((const unsigned*)(A + (size_t)(ao_)[(p_) & 1] + ko_), (LAS unsigned*)(lds + so_ + ldsw + ((p_) & 1) * 8192), 16, 0, 0); \
        else __builtin_amdgcn_global_load_lds((const unsigned*)((bb_) + (((p_) - 2) >> 1) * bhalf + voffB[(p_) & 1] + ko_), (LAS unsigned*)(lds + so_ + (1 + (((p_) - 2) >> 1)) * pg8::HTB + ldsw + ((p_) & 1) * 8192), 16, 0, 0); } while (0)
#define MG_READ(F_, slot_) do { const LAS unsigned char* p_ = lds + (unsigned)(slot_) * BUF; \
        _Pragma("unroll") for (int m = 0; m < 4; ++m) _Pragma("unroll") for (int k = 0; k < 2; ++k) F_.a[m][k] = *(const LAS bf16x8*)(p_ + aoff + m * 2048 + k * 1024); \
        _Pragma("unroll") for (int bj = 0; bj < 2; ++bj) _Pragma("unroll") for (int n = 0; n < 2; ++n) _Pragma("unroll") for (int k = 0; k < 2; ++k) \
            F_.b[bj][n][k] = *(const LAS bf16x8*)(p_ + (1 + bj) * pg8::HTB + boff + n * 2048 + k * 1024); } while (0)
#define MG_MMA1(F_, bj_, m_, n_) do { typedef int v4i_ __attribute__((ext_vector_type(4))); \
        acc[bj_][m_][n_] = __builtin_amdgcn_mfma_scale_f32_16x16x128_f8f6f4(__builtin_shufflevector(__builtin_bit_cast(v4i_, F_.b[bj_][n_][0]), __builtin_bit_cast(v4i_, F_.b[bj_][n_][1]), 0, 1, 2, 3, 4, 5, 6, 7), \
            __builtin_shufflevector(__builtin_bit_cast(v4i_, F_.a[m_][0]), __builtin_bit_cast(v4i_, F_.a[m_][1]), 0, 1, 2, 3, 4, 5, 6, 7), acc[bj_][m_][n_], 0, 0, 0, 0x7F7F7F7F, 0, 0x7F7F7F7F); } while (0)
#define MG_SB() __builtin_amdgcn_sched_barrier(0)
#define MG_READB(F_, slot_) do { const LAS unsigned char* p_ = lds + (unsigned)(slot_) * BUF; \
        _Pragma("unroll") for (int bj = 0; bj < 2; ++bj) _Pragma("unroll") for (int n = 0; n < 2; ++n) _Pragma("unroll") for (int k = 0; k < 2; ++k) \
            F_.b[bj][n][k] = *(const LAS bf16x8*)(p_ + (1 + bj) * pg8::HTB + boff + n * 2048 + k * 1024); } while (0)
#define MG_READA(F_, slot_, m_) do { const LAS unsigned char* p_ = lds + (unsigned)(slot_) * BUF; \
        _Pragma("unroll") for (int k = 0; k < 2; ++k) F_.a[m_][k] = *(const LAS bf16x8*)(p_ + aoff + (m_) * 2048 + k * 1024); } while (0)
#define MG_GROUP(Fc_, Fn_, rslot_, m_) do { MG_MMA1(Fc_, 0, m_, 0); MG_MMA1(Fc_, 0, m_, 1); MG_MMA1(Fc_, 1, m_, 0); MG_MMA1(Fc_, 1, m_, 1); MG_SB(); MG_READA(Fn_, rslot_, m_); MG_SB(); } while (0)
#define MG_STEP(Fc_, Fn_, rslot_, dslot_, ao_, bb_, kt_) do { MG_READB(Fn_, rslot_); MG_SB(); __builtin_amdgcn_s_setprio(1); \
        MG_DMA1(0, dslot_, ao_, bb_, kt_); MG_SB(); MG_GROUP(Fc_, Fn_, rslot_, 0); MG_DMA1(1, dslot_, ao_, bb_, kt_); MG_DMA1(2, dslot_, ao_, bb_, kt_); MG_SB(); MG_GROUP(Fc_, Fn_, rslot_, 1); \
        MG_DMA1(3, dslot_, ao_, bb_, kt_); MG_SB(); MG_GROUP(Fc_, Fn_, rslot_, 2); MG_DMA1(4, dslot_, ao_, bb_, kt_); MG_DMA1(5, dslot_, ao_, bb_, kt_); MG_SB(); MG_GROUP(Fc_, Fn_, rslot_, 3); \
        __builtin_amdgcn_s_setprio(0); MG_SB(); } while (0)
#define MG_AOFS(dst_, u_) do { _Pragma("unroll") for (int i_ = 0; i_ < 2; ++i_) dst_[i_] = (GATHER ? (unsigned)S.row_tok(u_, rowA[i_]) : (unsigned)((u_).pm * TM + rowA[i_])) * (unsigned)Kb + colA[i_]; } while (0)
    pg8::Unit cur, nxt; int ui = 0;
    if (!S.next(0, cur)) return;
    f32x4 acc[2][4][2];
#pragma unroll
    for (int b = 0; b < 2; ++b)
#pragma unroll
        for (int m = 0; m < 4; ++m)
#pragma unroll
            for (int n = 0; n < 2; ++n) acc[b][m][n] = (f32x4){0.f, 0.f, 0.f, 0.f};
    unsigned ac[2], an[2];
    MG_AOFS(ac, cur);
    const unsigned char* bc = Bt + (size_t)cur.pn * 256 * Kb;
    Frags FA, FB;
    MG_DMA(0, ac, bc, 0); MG_DMA(1, ac, bc, 1); MG_DMA(2, ac, bc, 2);
    MG_WAIT_V(12); MG_BAR();
    MG_READ(FA, 0); MG_WAIT_L0();
    int sl = 0;
    for (;;) {
        const bool has_next = S.next(ui + 1, nxt);
        if (!has_next) nxt = cur;
        const unsigned char* bn = Bt + (size_t)nxt.pn * 256 * Kb;
        MG_AOFS(an, nxt);
#pragma unroll 1
        for (int kt = 0; kt < nkt; kt += 2) {
            if (!(kt == 0 && ui > 0)) MG_WAIT_V(6);
            MG_BAR();
            const int s1 = sl == 2 ? 0 : sl + 1;
            { const bool in_ = kt + 3 < nkt; const unsigned ax[2] = {in_ ? ac[0] : an[0], in_ ? ac[1] : an[1]}; const unsigned char* bx = in_ ? bc : bn; const int kx = in_ ? kt + 3 : kt + 3 - nkt;
              MG_STEP(FA, FB, s1, sl, ax, bx, kx); }
            MG_WAIT_L0();
            MG_WAIT_V(6); MG_BAR();
            const int s2 = s1 == 2 ? 0 : s1 + 1;
            { const bool in_ = kt + 4 < nkt; const unsigned ax[2] = {in_ ? ac[0] : an[0], in_ ? ac[1] : an[1]}; const unsigned char* bx = in_ ? bc : bn; const int kx = in_ ? kt + 4 : kt + 4 - nkt;
              MG_STEP(FB, FA, s2, s1, ax, bx, kx); }
            if (kt + 2 == nkt) { MG_WAIT_V(6); E(acc, cur, wr, wc, fr, fq);
#pragma unroll
                for (int b = 0; b < 2; ++b)
#pragma unroll
                    for (int m = 0; m < 4; ++m)
#pragma unroll
                        for (int n = 0; n < 2; ++n) acc[b][m][n] = (f32x4){0.f, 0.f, 0.f, 0.f}; }
            MG_WAIT_L0();
            sl = s2;
        }
        if (!has_next) break;
        cur = nxt; ac[0] = an[0]; ac[1] = an[1]; bc = bn; ++ui;
    }
    MG_WAIT_V(0); MG_BAR();
#undef MG_DMA
#undef MG_READ
#undef MG_MMA1
#undef MG_STEP
#undef MG_GROUP
#undef MG_READA
#undef MG_READB
#undef MG_DMA1
#undef MG_AOFS
}
}

namespace hg {
typedef short v4i16_t __attribute__((ext_vector_type(4)));
constexpr int S128 = 272, S64 = 144;
constexpr int L_QD = 0, L_QE = L_QD + 64 * S128, L_KE = L_QE + 64 * S128, L_VR = L_KE + 64 * S128, L_ST = L_VR + 64 * S128,
              L_P = L_ST + 128 * S128, L_QS = L_P + 64 * S64, L_DC = L_QS + 16 * 128 * 4, L_END = L_DC + 128 * 4;
static_assert(L_END <= PHASE_LDS, "hgrn LDS");
__device__ __forceinline__ bf16x8 frag(const LAS unsigned char* base, int row, int stride, int kb  ) { return *(const LAS bf16x8*)(base + row * stride + kb); }
__device__ __forceinline__ bf16x8 trfrag(const LAS unsigned char* tile, int tok0, int chan0, int lane) {
    const LAS unsigned char* p = tile + (tok0 + 8 * (lane >> 5) + ((lane & 15) >> 2)) * S128 + (chan0 + 16 * ((lane >> 4) & 1) + 4 * (lane & 3)) * 2;
    const s16x4 lo = __builtin_bit_cast(s16x4, __builtin_amdgcn_ds_read_tr16_b64_v4i16((LAS v4i16_t*)p)), hi = __builtin_bit_cast(s16x4, __builtin_amdgcn_ds_read_tr16_b64_v4i16((LAS v4i16_t*)(p + 4 * S128)));
    return (bf16x8){lo[0], lo[1], lo[2], lo[3], hi[0], hi[1], hi[2], hi[3]};
}

template <bool PASS_C, int ABL = 0>
__device__ __forceinline__ void pass(LAS unsigned char* lds, int unit, const bf16_t* QH, const bf16_t* VH, const half_t* GF, const half_t* GB,
                                     float* HL, float* HD, const float* HS, float* OF, float* OB) {
    typedef _Float16 h4 __attribute__((ext_vector_type(4)));
    const int tid = opaque_tid(), lane = tid & 63, wid = __builtin_amdgcn_readfirstlane(tid >> 6), r32 = lane & 31, hi = lane >> 5;
    const int dir = unit >> 7, head = (unit >> 5) & 3, sc = unit & 31;
    const int kq = tid & 31, tq = tid >> 5;
    const half_t* G = dir ? GB : GF; float* O = dir ? OB : OF;
    const int vi = wid >> 1, ki0 = (wid & 1) * 2;
    f32x16 sacc[2];
    LAS f32x4* QS = (LAS f32x4*)(lds + L_QS); LAS float* DC = (LAS float*)(lds + L_DC);
    if (PASS_C) {
        const float* hs = HS + (size_t)unit * 16384;
#pragma unroll
        for (int tt = 0; tt < 2; ++tt)
#pragma unroll
            for (int r = 0; r < 16; r += 2) { const int v = vi * 32 + crow(r, hi), kk = (ki0 + tt) * 32 + r32; const float s0 = hs[v * 128 + kk], s1 = hs[(v + 1) * 128 + kk]; sacc[tt][r] = s0; sacc[tt][r + 1] = s1;
                const unsigned w = cvtpk(s0, s1); *(LAS bf16_t*)(lds + L_ST + v * S128 + kk * 2) = (bf16_t)(w & 0xffffu); *(LAS bf16_t*)(lds + L_ST + (v + 1) * S128 + kk * 2) = (bf16_t)(w >> 16); }
    } else { sacc[0] = f32x16{}; sacc[1] = f32x16{}; }
    f32x4 btot = {1.f, 1.f, 1.f, 1.f};
    h4 gh[4]; u32x2 qv[4], vv[4];
#define HG_LOAD(c_) do { const int tb_ = sc * 512 + (c_) * 64 + 4 * tq; _Pragma("unroll") for (int i = 0; i < 4; ++i) { const int tl = tb_ + i, tok = dir ? (M - 1 - tl) : tl; \
        const size_t off = (size_t)tok * HSEC + head * 128 + 4 * kq; gh[i] = *(const h4*)(G + off); vv[i] = *(const u32x2*)(VH + off); if (PASS_C) qv[i] = *(const u32x2*)(QH + off); } } while (0)
    HG_LOAD(0);
#pragma unroll 1
    for (int c = 0; c < 8; ++c) {
        const int t0 = sc * 512 + c * 64;
        f32x4 g[4], b[4];
#pragma unroll
        for (int i = 0; i < 4; ++i) { g[i] = (f32x4){(float)gh[i][0], (float)gh[i][1], (float)gh[i][2], (float)gh[i][3]}; b[i] = i ? b[i - 1] * g[i] : g[i]; }
        QS[tq * 32 + kq] = b[3];
        LDS_WAIT(); __syncthreads();
        if (tid < 128) { LAS float* qs = (LAS float*)QS; float run = 1.f;
#pragma unroll
            for (int q = 0; q < 16; ++q) { const float t = qs[q * 128 + tid]; qs[q * 128 + tid] = run; run *= t; }
            DC[tid] = run; }
        LDS_WAIT(); __syncthreads();
        const f32x4 pre = QS[tq * 32 + kq], etot = *(const LAS f32x4*)(DC + 4 * kq);
        btot *= etot;
        f32x4 itot; itot[0] = __builtin_amdgcn_rcpf(etot[0]); itot[1] = __builtin_amdgcn_rcpf(etot[1]); itot[2] = __builtin_amdgcn_rcpf(etot[2]); itot[3] = __builtin_amdgcn_rcpf(etot[3]);
#pragma unroll
        for (int i = 0; i < 4; ++i) { const int tr = 4 * tq + i; float ke[4], qd[4], qe[4];
            const float q4[4] = {bflo(qv[i].x), bfhi(qv[i].x), bflo(qv[i].y), bfhi(qv[i].y)};
#pragma unroll
            for (int cc = 0; cc < 4; ++cc) { const float pb = b[i][cc] * pre[cc];
                ke[cc] = (1.f - g[i][cc]) * etot[cc] * __builtin_amdgcn_rcpf(pb);
                if (PASS_C) { qd[cc] = q4[cc] * pb; qe[cc] = qd[cc] * itot[cc]; } }
            *(LAS u32x2*)(lds + L_KE + tr * S128 + kq * 8) = (u32x2){cvtpk(ke[0], ke[1]), cvtpk(ke[2], ke[3])};
            *(LAS u32x2*)(lds + L_VR + tr * S128 + kq * 8) = vv[i];
            if (PASS_C) { *(LAS u32x2*)(lds + L_QD + tr * S128 + kq * 8) = (u32x2){cvtpk(qd[0], qd[1]), cvtpk(qd[2], qd[3])};
                *(LAS u32x2*)(lds + L_QE + tr * S128 + kq * 8) = (u32x2){cvtpk(qe[0], qe[1]), cvtpk(qe[2], qe[3])}; } }
        LDS_WAIT(); __syncthreads();
        if (c < 7 && !(ABL & 2)) HG_LOAD(c + 1);
        if (PASS_C && !(ABL & 4)) {
            if (wid < 4) {
                const int ti = wid >> 1, si = wid & 1; f32x16 p = f32x16{};
                if (!(ti == 0 && si == 1)) {
#pragma unroll
                    for (int ks = 0; ks < 8; ++ks) p = __builtin_amdgcn_mfma_f32_32x32x16_bf16(frag(lds + L_QE, ti * 32 + r32, S128, ks * 32 + hi * 16), frag(lds + L_KE, si * 32 + r32, S128, ks * 32 + hi * 16), p, 0, 0, 0);
                }
#pragma unroll
                for (int r = 0; r < 16; r += 2) { const int t = ti * 32 + crow(r, hi), s = si * 32 + r32; const unsigned w = cvtpk(s <= t ? p[r] : 0.f, s <= t + 1 ? p[r + 1] : 0.f);
                    *(LAS bf16_t*)(lds + L_P + t * S64 + s * 2) = (bf16_t)(w & 0xffffu); *(LAS bf16_t*)(lds + L_P + (t + 1) * S64 + s * 2) = (bf16_t)(w >> 16); }
            }
            LDS_WAIT(); __syncthreads();
            { const int ti = wid >> 2, vo = wid & 3; f32x16 o = f32x16{};
#pragma unroll
                for (int ks = 0; ks < 8; ++ks) o = __builtin_amdgcn_mfma_f32_32x32x16_bf16(frag(lds + L_QD, ti * 32 + r32, S128, ks * 32 + hi * 16), frag(lds + L_ST, vo * 32 + r32, S128, ks * 32 + hi * 16), o, 0, 0, 0);
#pragma unroll
                for (int ss = 0; ss < 4; ++ss) o = __builtin_amdgcn_mfma_f32_32x32x16_bf16(frag(lds + L_P, ti * 32 + r32, S64, ss * 32 + hi * 16), trfrag(lds + L_VR, ss * 16, vo * 32, lane), o, 0, 0, 0);
#pragma unroll
                for (int r = 0; r < 16; ++r) { const int tl = t0 + ti * 32 + crow(r, hi), tok = dir ? (M - 1 - tl) : tl; if (!(ABL & 1)) O[(size_t)tok * HSEC + head * 128 + vo * 32 + r32] = o[r]; else asm volatile("" :: "v"(o[r])); }
            }
        }
#pragma unroll
        for (int tt = 0; tt < ((ABL & 4) ? 0 : 2); ++tt) { const int ki = ki0 + tt; const float d = DC[ki * 32 + r32];
#pragma unroll
            for (int r = 0; r < 16; ++r) sacc[tt][r] *= d;
#pragma unroll
            for (int ss = 0; ss < 4; ++ss) sacc[tt] = __builtin_amdgcn_mfma_f32_32x32x16_bf16(trfrag(lds + L_VR, ss * 16, vi * 32, lane), trfrag(lds + L_KE, ss * 16, ki * 32, lane), sacc[tt], 0, 0, 0);
        }
        LDS_WAIT(); __syncthreads();
        if (PASS_C) {
#pragma unroll
            for (int tt = 0; tt < 2; ++tt)
#pragma unroll
                for (int r = 0; r < 16; r += 2) { const int v = vi * 32 + crow(r, hi), kk = (ki0 + tt) * 32 + r32; const unsigned w = cvtpk(sacc[tt][r], sacc[tt][r + 1]);
                    *(LAS bf16_t*)(lds + L_ST + v * S128 + kk * 2) = (bf16_t)(w & 0xffffu); *(LAS bf16_t*)(lds + L_ST + (v + 1) * S128 + kk * 2) = (bf16_t)(w >> 16); }
        }
    }
#undef HG_LOAD
    if (!PASS_C) {
        float* hl = HL + (size_t)unit * 16384;
#pragma unroll
        for (int tt = 0; tt < 2; ++tt)
#pragma unroll
            for (int r = 0; r < 16; ++r) { const int v = vi * 32 + crow(r, hi), kk = (ki0 + tt) * 32 + r32; hl[v * 128 + kk] = sacc[tt][r]; }
        if (tq == 0) *(f32x4*)(HD + unit * 128 + 4 * kq) = btot;
    }
    __syncthreads();
}
__device__ __forceinline__ void scan(const float* HL, const float* HD, float* HS, int gtid, int gthreads) {
    for (int id = gtid; id < 8 * 16384; id += gthreads) {
        const int dh = id >> 14, e = id & 16383, k = e & 127; float S = 0.f;
        float hl[32], hd[32];
#pragma unroll
        for (int sc = 0; sc < 32; ++sc) { const int u = dh * 32 + sc; hl[sc] = HL[(size_t)u * 16384 + e]; hd[sc] = HD[u * 128 + k]; }
#pragma unroll
        for (int sc = 0; sc < 32; ++sc) { const int u = dh * 32 + sc; HS[(size_t)u * 16384 + e] = S; S = hd[sc] * S + hl[sc]; }
    }
}
}

namespace att {
__device__ __forceinline__ void hgrn_finalize(int h, int q0, const float* OF, const float* OB, const bf16_t* SG, const float* gain, bf16_t* MIX, int wid, int lane) {
    const float g0 = gain[2 * lane], g1 = gain[2 * lane + 1];
#pragma unroll 1
    for (int i0 = 0; i0 < 32; i0 += 4) { float2 a[4], b[4]; unsigned sg[4]; float x0[4], x1[4], ss[4];
#pragma unroll
        for (int i = 0; i < 4; ++i) { const size_t off = (size_t)(q0 + wid * 32 + i0 + i) * HSEC + h * 128 + 2 * lane; a[i] = *(const float2*)(OF + off); b[i] = *(const float2*)(OB + off); sg[i] = *(const unsigned*)(SG + off); }
#pragma unroll
        for (int i = 0; i < 4; ++i) { x0[i] = a[i].x + b[i].x; x1[i] = a[i].y + b[i].y; ss[i] = x0[i] * x0[i] + x1[i] * x1[i]; }
#pragma unroll
        for (int i = 0; i < 4; ++i) ss[i] = wave_sum(ss[i]);
#pragma unroll
        for (int i = 0; i < 4; ++i) { const float rstd = 1.f / sqrtf(ss[i] * (1.f / 128.f) + 1e-6f);
            *(unsigned*)(MIX + (size_t)(q0 + wid * 32 + i0 + i) * D + h * 128 + 2 * lane) = cvtpk(x0[i] * rstd * g0 * bflo(sg[i]), x1[i] * rstd * g1 * bfhi(sg[i])); } }
}
}

namespace att2 {
typedef short v4i16_t __attribute__((ext_vector_type(4)));
constexpr int KVBLK = 64, LDR = HSEC, NT = M / KVBLK;
constexpr int KSLOT = 8192, VSLOT = 16384, NSLOT = 4;
constexpr int OFF_K = 0, OFF_V = NSLOT * KSLOT, OFF_WS = OFF_V + NSLOT * VSLOT, OFF_END = OFF_WS + NWAVES * 64 * 4;
static_assert(OFF_END <= PHASE_LDS, "attention LDS");
__device__ __forceinline__ s16x4 vtr(const LAS unsigned char* p) { return __builtin_bit_cast(s16x4, __builtin_amdgcn_ds_read_tr16_b64_v4i16((LAS v4i16_t*)p)); }
__device__ __forceinline__ void glds16(const void* sbase, unsigned voff, unsigned lds_dst) { unsigned keep;
    asm volatile("s_mov_b32 %0, m0\n\ts_mov_b32 m0, %3\n\ts_nop 0\n\tglobal_load_lds_dwordx4 %1, %2\n\ts_mov_b32 m0, %0" : "=&s"(keep) : "v"(voff), "s"(sbase), "s"(lds_dst) : "memory"); }
#define ATT2_WAIT_BAR(N) asm volatile("s_waitcnt vmcnt(" #N ") lgkmcnt(0)\n\ts_barrier" ::: "memory")
template <bool DO_QK, bool DO_SM, bool DO_PV>
__device__ __forceinline__ void step(f32x16& sn0, f32x16& sn1, f32x16& sc0, f32x16& sc1, const u32x4& pap0, const u32x4& pap1, const u32x4& pap2, const u32x4& pap3,
                                     u32x4& pan0, u32x4& pan1, u32x4& pan2, u32x4& pan3, f32x16 (&o)[4], const bf16x8 (&qr)[4], const f32x16& negm, float& lsum,
                                     const LAS unsigned char* kc, const LAS unsigned char* knn, const LAS unsigned char* vb, bf16x8& kf0, bf16x8& kf1, bf16x8& kf2) {
    bf16x8 fr0 = kf0, fr1 = kf1, fr2 = kf2, fr3 = kf0; unsigned ca0 = 0, ca1 = 0, cb0 = 0, cb1 = 0;
    (void)ca0; (void)ca1; (void)cb0; (void)cb1;
    if (DO_QK) sn0 = __builtin_amdgcn_mfma_f32_32x32x16_bf16(fr0, qr[0], negm, 0, 0, 0);
    SBAR();
    if (DO_QK) { fr3 = *(const LAS bf16x8*)(kc + 2560); }
    if (DO_SM) { sc0[0] = ex2(sc0[0]); sc0[1] = ex2(sc0[1]); }
    SBAR();
    if (DO_QK) sn1 = __builtin_amdgcn_mfma_f32_32x32x16_bf16(fr1, qr[0], negm, 0, 0, 0);
    SBAR();
    if (DO_QK) { fr0 = *(const LAS bf16x8*)(kc + 4096); }
    if (DO_SM) { sc0[2] = ex2(sc0[2]); sc0[3] = ex2(sc0[3]); lsum += sc0[0]; lsum += sc0[1]; }
    SBAR();
    if (DO_QK) sn0 = __builtin_amdgcn_mfma_f32_32x32x16_bf16(fr2, qr[1], sn0, 0, 0, 0);
    SBAR();
    if (DO_QK) { fr1 = *(const LAS bf16x8*)(kc + 4608); }
    if (DO_SM) { sc0[4] = ex2(sc0[4]); sc0[5] = ex2(sc0[5]); lsum += sc0[2]; lsum += sc0[3]; }
    SBAR();
    if (DO_QK) sn1 = __builtin_amdgcn_mfma_f32_32x32x16_bf16(fr3, qr[1], sn1, 0, 0, 0);
    SBAR();
    if (DO_QK) { fr2 = *(const LAS bf16x8*)(kc + 6144); }
    if (DO_SM) { sc0[6] = ex2(sc0[6]); sc0[7] = ex2(sc0[7]); lsum += sc0[4]; lsum += sc0[5]; }
    SBAR();
    if (DO_QK) sn0 = __builtin_amdgcn_mfma_f32_32x32x16_bf16(fr0, qr[2], sn0, 0, 0, 0);
    SBAR();
    if (DO_QK) { fr3 = *(const LAS bf16x8*)(kc + 6656); }
    if (DO_SM) { sc0[8] = ex2(sc0[8]); sc0[9] = ex2(sc0[9]); lsum += sc0[6]; lsum += sc0[7]; }
    SBAR();
    if (DO_QK) sn1 = __builtin_amdgcn_mfma_f32_32x32x16_bf16(fr1, qr[2], sn1, 0, 0, 0);
    SBAR();
    if (DO_PV) { { const s16x4 l_ = vtr(vb + 0), h_ = vtr(vb + 256); fr0 = (bf16x8){l_[0], l_[1], l_[2], l_[3], h_[0], h_[1], h_[2], h_[3]}; } }
    if (DO_SM) { sc0[10] = ex2(sc0[10]); sc0[11] = ex2(sc0[11]); lsum += sc0[8]; lsum += sc0[9]; }
    SBAR();
    if (DO_QK) sn0 = __builtin_amdgcn_mfma_f32_32x32x16_bf16(fr2, qr[3], sn0, 0, 0, 0);
    SBAR();
    if (DO_PV) { { const s16x4 l_ = vtr(vb + 4096), h_ = vtr(vb + 4352); fr1 = (bf16x8){l_[0], l_[1], l_[2], l_[3], h_[0], h_[1], h_[2], h_[3]}; } }
    if (DO_SM) { sc0[12] = ex2(sc0[12]); sc0[13] = ex2(sc0[13]); lsum += sc0[10]; lsum += sc0[11]; }
    SBAR();
    if (DO_QK) sn1 = __builtin_amdgcn_mfma_f32_32x32x16_bf16(fr3, qr[3], sn1, 0, 0, 0);
    SBAR();
    if (DO_PV) { { const s16x4 l_ = vtr(vb + 8192), h_ = vtr(vb + 8448); fr2 = (bf16x8){l_[0], l_[1], l_[2], l_[3], h_[0], h_[1], h_[2], h_[3]}; } }
    if (DO_SM) { sc0[14] = ex2(sc0[14]); sc0[15] = ex2(sc0[15]); lsum += sc0[12]; lsum += sc0[13]; }
    SBAR();
    if (DO_PV) o[0] = __builtin_amdgcn_mfma_f32_32x32x16_bf16(__builtin_bit_cast(bf16x8, pap0), fr0, o[0], 0, 0, 0);
    SBAR();
    if (DO_PV) { { const s16x4 l_ = vtr(vb + 12288), h_ = vtr(vb + 12544); fr3 = (bf16x8){l_[0], l_[1], l_[2], l_[3], h_[0], h_[1], h_[2], h_[3]}; } }
    if (DO_SM) { sc1[0] = ex2(sc1[0]); sc1[1] = ex2(sc1[1]); lsum += sc0[14]; lsum += sc0[15]; }
    SBAR();
    if (DO_PV) o[0] = __builtin_amdgcn_mfma_f32_32x32x16_bf16(__builtin_bit_cast(bf16x8, pap1), fr1, o[0], 0, 0, 0);
    SBAR();
    if (DO_PV) { { const s16x4 l_ = vtr(vb + 512), h_ = vtr(vb + 768); fr0 = (bf16x8){l_[0], l_[1], l_[2], l_[3], h_[0], h_[1], h_[2], h_[3]}; } }
    if (DO_SM) { sc1[2] = ex2(sc1[2]); sc1[3] = ex2(sc1[3]); lsum += sc1[0]; lsum += sc1[1]; }
    SBAR();
    if (DO_PV) o[0] = __builtin_amdgcn_mfma_f32_32x32x16_bf16(__builtin_bit_cast(bf16x8, pap2), fr2, o[0], 0, 0, 0);
    SBAR();
    if (DO_PV) { { const s16x4 l_ = vtr(vb + 4608), h_ = vtr(vb + 4864); fr1 = (bf16x8){l_[0], l_[1], l_[2], l_[3], h_[0], h_[1], h_[2], h_[3]}; } }
    if (DO_SM) { sc1[4] = ex2(sc1[4]); sc1[5] = ex2(sc1[5]); lsum += sc1[2]; lsum += sc1[3]; }
    SBAR();
    if (DO_PV) o[0] = __builtin_amdgcn_mfma_f32_32x32x16_bf16(__builtin_bit_cast(bf16x8, pap3), fr3, o[0], 0, 0, 0);
    SBAR();
    if (DO_PV) { { const s16x4 l_ = vtr(vb + 8704), h_ = vtr(vb + 8960); fr2 = (bf16x8){l_[0], l_[1], l_[2], l_[3], h_[0], h_[1], h_[2], h_[3]}; } }
    if (DO_SM) { sc1[6] = ex2(sc1[6]); sc1[7] = ex2(sc1[7]); lsum += sc1[4]; lsum += sc1[5]; }
    SBAR();
    if (DO_PV) o[1] = __builtin_amdgcn_mfma_f32_32x32x16_bf16(__builtin_bit_cast(bf16x8, pap0), fr0, o[1], 0, 0, 0);
    SBAR();
    if (DO_PV) { { const s16x4 l_ = vtr(vb + 12800), h_ = vtr(vb + 13056); fr3 = (bf16x8){l_[0], l_[1], l_[2], l_[3], h_[0], h_[1], h_[2], h_[3]}; } }
    if (DO_SM) { sc1[8] = ex2(sc1[8]); sc1[9] = ex2(sc1[9]); lsum += sc1[6]; lsum += sc1[7]; }
    SBAR();
    if (DO_PV) o[1] = __builtin_amdgcn_mfma_f32_32x32x16_bf16(__builtin_bit_cast(bf16x8, pap1), fr1, o[1], 0, 0, 0);
    SBAR();
    if (DO_PV) { { const s16x4 l_ = vtr(vb + 1024), h_ = vtr(vb + 1280); fr0 = (bf16x8){l_[0], l_[1], l_[2], l_[3], h_[0], h_[1], h_[2], h_[3]}; } }
    if (DO_SM) { sc1[10] = ex2(sc1[10]); sc1[11] = ex2(sc1[11]); lsum += sc1[8]; lsum += sc1[9]; }
    SBAR();
    if (DO_PV) o[1] = __builtin_amdgcn_mfma_f32_32x32x16_bf16(__builtin_bit_cast(bf16x8, pap2), fr2, o[1], 0, 0, 0);
    SBAR();
    if (DO_PV) { { const s16x4 l_ = vtr(vb + 5120), h_ = vtr(vb + 5376); fr1 = (bf16x8){l_[0], l_[1], l_[2], l_[3], h_[0], h_[1], h_[2], h_[3]}; } }
    if (DO_SM) { sc1[12] = ex2(sc1[12]); sc1[13] = ex2(sc1[13]); lsum += sc1[10]; lsum += sc1[11]; }
    SBAR();
    if (DO_PV) o[1] = __builtin_amdgcn_mfma_f32_32x32x16_bf16(__builtin_bit_cast(bf16x8, pap3), fr3, o[1], 0, 0, 0);
    SBAR();
    if (DO_PV) { { const s16x4 l_ = vtr(vb + 9216), h_ = vtr(vb + 9472); fr2 = (bf16x8){l_[0], l_[1], l_[2], l_[3], h_[0], h_[1], h_[2], h_[3]}; } }
    if (DO_SM) { sc1[14] = ex2(sc1[14]); sc1[15] = ex2(sc1[15]); lsum += sc1[12]; lsum += sc1[13]; }
    SBAR();
    if (DO_PV) o[2] = __builtin_amdgcn_mfma_f32_32x32x16_bf16(__builtin_bit_cast(bf16x8, pap0), fr0, o[2], 0, 0, 0);
    SBAR();
    if (DO_PV) { { const s16x4 l_ = vtr(vb + 13312), h_ = vtr(vb + 13568); fr3 = (bf16x8){l_[0], l_[1], l_[2], l_[3], h_[0], h_[1], h_[2], h_[3]}; } }
    if (DO_SM) { lsum += sc1[14]; lsum += sc1[15]; ca0 = cvtpk(sc0[0], sc0[1]); ca1 = cvtpk(sc0[2], sc0[3]); }
    SBAR();
    if (DO_PV) o[2] = __builtin_amdgcn_mfma_f32_32x32x16_bf16(__builtin_bit_cast(bf16x8, pap1), fr1, o[2], 0, 0, 0);
    SBAR();
    if (DO_PV) { { const s16x4 l_ = vtr(vb + 1536), h_ = vtr(vb + 1792); fr0 = (bf16x8){l_[0], l_[1], l_[2], l_[3], h_[0], h_[1], h_[2], h_[3]}; } }
    if (DO_SM) { cb0 = cvtpk(sc0[4], sc0[5]); cb1 = cvtpk(sc0[6], sc0[7]); pan0 = (u32x4){ca0, ca1, cb0, cb1}; }
    SBAR();
    if (DO_PV) o[2] = __builtin_amdgcn_mfma_f32_32x32x16_bf16(__builtin_bit_cast(bf16x8, pap2), fr2, o[2], 0, 0, 0);
    SBAR();
    if (DO_PV) { { const s16x4 l_ = vtr(vb + 5632), h_ = vtr(vb + 5888); fr1 = (bf16x8){l_[0], l_[1], l_[2], l_[3], h_[0], h_[1], h_[2], h_[3]}; } }
    if (DO_SM) { ca0 = cvtpk(sc0[8], sc0[9]); ca1 = cvtpk(sc0[10], sc0[11]); }
    SBAR();
    if (DO_PV) o[2] = __builtin_amdgcn_mfma_f32_32x32x16_bf16(__builtin_bit_cast(bf16x8, pap3), fr3, o[2], 0, 0, 0);
    SBAR();
    if (DO_PV) { { const s16x4 l_ = vtr(vb + 9728), h_ = vtr(vb + 9984); fr2 = (bf16x8){l_[0], l_[1], l_[2], l_[3], h_[0], h_[1], h_[2], h_[3]}; } }
    if (DO_SM) { cb0 = cvtpk(sc0[12], sc0[13]); cb1 = cvtpk(sc0[14], sc0[15]); pan1 = (u32x4){ca0, ca1, cb0, cb1}; }
    SBAR();
    if (DO_PV) o[3] = __builtin_amdgcn_mfma_f32_32x32x16_bf16(__builtin_bit_cast(bf16x8, pap0), fr0, o[3], 0, 0, 0);
    SBAR();
    if (DO_PV) { { const s16x4 l_ = vtr(vb + 13824), h_ = vtr(vb + 14080); fr3 = (bf16x8){l_[0], l_[1], l_[2], l_[3], h_[0], h_[1], h_[2], h_[3]}; } }
    if (DO_SM) { ca0 = cvtpk(sc1[0], sc1[1]); ca1 = cvtpk(sc1[2], sc1[3]); }
    SBAR();
    if (DO_PV) o[3] = __builtin_amdgcn_mfma_f32_32x32x16_bf16(__builtin_bit_cast(bf16x8, pap1), fr1, o[3], 0, 0, 0);
    SBAR();
    kf0 = *(const LAS bf16x8*)(knn + 0);
    if (DO_SM) { cb0 = cvtpk(sc1[4], sc1[5]); cb1 = cvtpk(sc1[6], sc1[7]); pan2 = (u32x4){ca0, ca1, cb0, cb1}; }
    SBAR();
    if (DO_PV) o[3] = __builtin_amdgcn_mfma_f32_32x32x16_bf16(__builtin_bit_cast(bf16x8, pap2), fr2, o[3], 0, 0, 0);
    SBAR();
    kf1 = *(const LAS bf16x8*)(knn + 512);
    if (DO_SM) { ca0 = cvtpk(sc1[8], sc1[9]); ca1 = cvtpk(sc1[10], sc1[11]); }
    SBAR();
    if (DO_PV) o[3] = __builtin_amdgcn_mfma_f32_32x32x16_bf16(__builtin_bit_cast(bf16x8, pap3), fr3, o[3], 0, 0, 0);
    SBAR();
    kf2 = *(const LAS bf16x8*)(knn + 2048);
    if (DO_SM) { cb0 = cvtpk(sc1[12], sc1[13]); cb1 = cvtpk(sc1[14], sc1[15]); pan3 = (u32x4){ca0, ca1, cb0, cb1}; }
    SBAR();
}

__device__ __forceinline__ void unit(LAS unsigned char* lds, int h, int q0, const bf16_t* __restrict__ QD, const bf16_t* __restrict__ KD, const bf16_t* __restrict__ VD,
                                     const unsigned* KMAX2, float* O0S, float lam, const float* __restrict__ subg, bf16_t* MIX) {
    const int tid = opaque_tid(), wid = __builtin_amdgcn_readfirstlane(tid >> 6), lane = tid & 63, r32 = lane & 31, hi = lane >> 5;
    const unsigned lds0 = (unsigned)(uintptr_t)lds;
    LAS float* ws = (LAS float*)(lds + OFF_WS) + wid * 64;
    const LAS unsigned char* kbase = lds + OFF_K + hi * 1024 + r32 * 16;
    const LAS unsigned char* vbase = lds + OFF_V + (((lane & 3) << 3) | (((lane >> 2) & 3) << 6) | (((lane >> 4) & 1) << 5) | (((lane >> 5) & 1) << 11));
    const unsigned voK = (unsigned)((lane * LDR + wid * 8) * 2);
    unsigned voV[2];
    { const int kk = 8 * wid + ((lane & 31) >> 2), key = (kk & ~0xC) | ((kk & 4) << 1) | ((kk & 8) >> 1);
#pragma unroll
      for (int j = 0; j < 2; ++j) voV[j] = (unsigned)((key * LDR + (2 * j + (lane >> 5)) * 32 + (lane & 3) * 8) * 2); }
    const unsigned kdst = lds0 + OFF_K + wid * 1024, vdst = lds0 + OFF_V + wid * 2048;
#pragma unroll 1
    for (int mp = 0; mp < 2; ++mp) {
        const bf16_t* Kh = KD + h * 128 + mp * 64; const bf16_t* Vh = VD + h * 128;
        const bf16_t* Qw = QD + (size_t)(q0 + wid * 32 + r32) * LDR + h * 128 + mp * 64 + hi * 8;
#define ATT2_DMA_K(t) do { const int t_ = (t) < NT ? (t) : NT - 1; glds16((const char*)Kh + (size_t)t_ * (KVBLK * LDR * 2), voK, (unsigned)__builtin_amdgcn_readfirstlane(kdst + ((t) & 3) * KSLOT)); } while (0)
#define ATT2_DMA_V(t) do { const int t_ = (t) < NT ? (t) : NT - 1; const char* vs_ = (const char*)Vh + (size_t)t_ * (KVBLK * LDR * 2); const unsigned vd_ = (unsigned)__builtin_amdgcn_readfirstlane(vdst + ((t) & 3) * VSLOT); \
        glds16(vs_, voV[0], vd_); glds16(vs_, voV[1], vd_ + 1024); } while (0)
        ATT2_DMA_K(0); ATT2_DMA_K(1); ATT2_DMA_K(2); ATT2_DMA_V(0);
        bf16x8 qr[4]; float qq = 0.f;
#pragma unroll
        for (int d0 = 0; d0 < 4; ++d0) { qr[d0] = *reinterpret_cast<const bf16x8*>(Qw + d0 * 16);
#pragma unroll
            for (int j = 0; j < 8; ++j) { const float q = bf2f((unsigned short)qr[d0][j]); qq += q * q; } }
        { auto rr = __builtin_amdgcn_permlane32_swap(__float_as_uint(qq), __float_as_uint(qq), false, false); qq = __uint_as_float(rr[0]) + __uint_as_float(rr[1]); }
        const float mref = sqrtf(qq * __uint_as_float(KMAX2[(h * 2 + mp) * 64])) * 1.001f;
        f32x16 negm;
#pragma unroll
        for (int r = 0; r < 16; ++r) negm[r] = -mref;
        f32x16 o[4] = {}; float lsum = 0.f;
        f32x16 sA0, sA1, sB0, sB1; u32x4 pX0, pX1, pX2, pX3, pY0, pY1, pY2, pY3;
        sA0 = f32x16{}; sA1 = f32x16{}; sB0 = f32x16{}; sB1 = f32x16{}; pX0 = pX1 = pX2 = pX3 = pY0 = pY1 = pY2 = pY3 = (u32x4){0u, 0u, 0u, 0u};
        bf16x8 kf0, kf1, kf2;
        ATT2_WAIT_BAR(0);
        kf0 = *(const LAS bf16x8*)(kbase); kf1 = *(const LAS bf16x8*)(kbase + 512); kf2 = *(const LAS bf16x8*)(kbase + 2048);
#define KS(t) (kbase + ((t) & 3) * KSLOT)
#define VS(t) (vbase + ((t) & 3) * VSLOT)
        ATT2_DMA_K(3); ATT2_DMA_V(1);
        step<true, false, false>(sA0, sA1, sB0, sB1, pX0, pX1, pX2, pX3, pY0, pY1, pY2, pY3, o, qr, negm, lsum, KS(0), KS(1), VS(0), kf0, kf1, kf2);
        ATT2_WAIT_BAR(3);
        ATT2_DMA_K(4); ATT2_DMA_V(2);
        step<true, true, false>(sB0, sB1, sA0, sA1, pY0, pY1, pY2, pY3, pX0, pX1, pX2, pX3, o, qr, negm, lsum, KS(1), KS(2), VS(0), kf0, kf1, kf2);
        ATT2_WAIT_BAR(3);
#pragma unroll 1
        for (int i = 1; i + 1 < NT - 1; i += 2) {
            ATT2_DMA_K(i + 4); ATT2_DMA_V(i + 2);
            step<true, true, true>(sA0, sA1, sB0, sB1, pX0, pX1, pX2, pX3, pY0, pY1, pY2, pY3, o, qr, negm, lsum, KS(i + 1), KS(i + 2), VS(i - 1), kf0, kf1, kf2);
            ATT2_WAIT_BAR(3);
            ATT2_DMA_K(i + 5); ATT2_DMA_V(i + 3);
            step<true, true, true>(sB0, sB1, sA0, sA1, pY0, pY1, pY2, pY3, pX0, pX1, pX2, pX3, o, qr, negm, lsum, KS(i + 2), KS(i + 3), VS(i), kf0, kf1, kf2);
            ATT2_WAIT_BAR(3);
        }
        step<false, true, true>(sA0, sA1, sB0, sB1, pX0, pX1, pX2, pX3, pY0, pY1, pY2, pY3, o, qr, negm, lsum, KS(0), KS(0), VS(NT - 2), kf0, kf1, kf2);
        ATT2_WAIT_BAR(0);
        step<false, false, true>(sB0, sB1, sA0, sA1, pY0, pY1, pY2, pY3, pX0, pX1, pX2, pX3, o, qr, negm, lsum, KS(0), KS(0), VS(NT - 1), kf0, kf1, kf2);
        ATT2_WAIT_BAR(0);
#undef KS
#undef VS
#undef ATT2_DMA_K
#undef ATT2_DMA_V
        { auto rr = __builtin_amdgcn_permlane32_swap(__float_as_uint(lsum), __float_as_uint(lsum), false, false); lsum = __uint_as_float(rr[0]) + __uint_as_float(rr[1]); }
        if (hi == 0) ws[r32] = lsum; asm volatile("s_waitcnt lgkmcnt(0)" ::: "memory");
        int rowb = q0 + wid * 32; asm volatile("" : "+s"(rowb));
        float rli[16];
#pragma unroll
        for (int r = 0; r < 16; ++r) rli[r] = __builtin_amdgcn_rcpf(ws[crow(r, hi)]);
        float* o0p = O0S + tid; asm volatile("" : "+v"(o0p));
        if (mp == 0) {
#pragma unroll
            for (int d0 = 0; d0 < 4; ++d0)
#pragma unroll
                for (int r = 0; r < 16; ++r) o0p[(d0 * 16 + r) * 512] = o[d0][r] * rli[r];
        } else {
            float ss[16];
#pragma unroll
            for (int r = 0; r < 16; ++r) ss[r] = 0.f;
#pragma unroll
            for (int d0 = 0; d0 < 4; ++d0)
#pragma unroll
                for (int r = 0; r < 16; ++r) { const float c = o0p[(d0 * 16 + r) * 512] - lam * o[d0][r] * rli[r]; o[d0][r] = c; ss[r] += c * c; }
#pragma unroll
            for (int r = 0; r < 16; ++r) {
                ss[r] += lane_xor<1>(ss[r]); ss[r] += lane_xor<2>(ss[r]); ss[r] += lane_xor<4>(ss[r]); ss[r] += lane_xor<8>(ss[r]); ss[r] += lane_xor<16>(ss[r]);
                ss[r] = 0.8f / sqrtf(ss[r] * (1.f / 128.f) + 1e-5f); }
#pragma unroll
            for (int d0 = 0; d0 < 4; ++d0) { const float g = subg[d0 * 32 + r32];
#pragma unroll
                for (int r = 0; r < 16; ++r) MIX[(size_t)(rowb + crow(r, hi)) * D + 512 + h * 128 + d0 * 32 + r32] = (bf16_t)f2bf(o[d0][r] * ss[r] * g); }
        }
        asm volatile("s_waitcnt vmcnt(0) lgkmcnt(0)\n\ts_barrier" ::: "memory");
    }
}
__device__ __forceinline__ void kmax_rows(LAS unsigned char* lds, const bf16_t* KD, unsigned* KMAX2, int gw, int ngw, int lane, int wave) {
    float mx = 0.f;
    for (int row0 = gw; row0 < M; row0 += 8 * ngw) { u32x4 w[8];
#pragma unroll
        for (int i = 0; i < 8; ++i) { const int row = row0 + i * ngw; w[i] = row < M ? *(const GAS u32x4*)(KD + (size_t)row * HSEC + lane * 8) : (u32x4){0u, 0u, 0u, 0u}; }
#pragma unroll
        for (int i = 0; i < 8; ++i) { const u32x4 v = w[i];
            float s = bflo(v.x) * bflo(v.x) + bfhi(v.x) * bfhi(v.x) + bflo(v.y) * bflo(v.y) + bfhi(v.y) * bfhi(v.y) + bflo(v.z) * bflo(v.z) + bfhi(v.z) * bfhi(v.z) + bflo(v.w) * bflo(v.w) + bfhi(v.w) * bfhi(v.w);
            s += lane_xor<1>(s); s += lane_xor<2>(s); s += lane_xor<4>(s); mx = fmaxf(mx, s); } }
    LAS float* red = (LAS float*)lds; if ((lane & 7) == 0) red[wave * 8 + (lane >> 3)] = mx;
    LDS_WAIT(); __syncthreads();
    if (wave == 0 && lane < 8) { float m = red[lane];
#pragma unroll
        for (int w = 1; w < NWAVES; ++w) m = fmaxf(m, red[w * 8 + lane]);
        atomicMax(KMAX2 + lane * 64, __float_as_uint(m)); }
    __syncthreads();
}
}

__device__ __forceinline__ void route16(const bf16_t* X2B, const u32x4* WRB, const float* rgb, const float* reb,
                                        float* RSTD, int* TOKE, float* TOKW, int* TOKR, unsigned* GCNT, int row0, int lane, LAS float* wl, bool dry = false) {
    typedef float f32x4_ __attribute__((ext_vector_type(4)));
    const int r = lane & 15, q = lane >> 4;
    LAS unsigned* lc = (LAS unsigned*)(wl + 800);
    if (lane < 32) lc[lane] = 0u;
    f32x4_ acc[3]; acc[0] = (f32x4_){0.f, 0.f, 0.f, 0.f}; acc[1] = acc[0]; acc[2] = acc[0];
    float ssq = 0.f;
    const bf16_t* xp = X2B + (size_t)(row0 + r) * D + 8 * q;
#pragma unroll 8
    for (int ks = 0; ks < 32; ++ks) {
        const u32x4 xw = *(const GAS u32x4*)(xp + ks * 32);
        ssq += (bflo(xw.x) * bflo(xw.x) + bfhi(xw.x) * bfhi(xw.x)) + (bflo(xw.y) * bflo(xw.y) + bfhi(xw.y) * bfhi(xw.y)) + (bflo(xw.z) * bflo(xw.z) + bfhi(xw.z) * bfhi(xw.z)) + (bflo(xw.w) * bflo(xw.w) + bfhi(xw.w) * bfhi(xw.w));
        const bf16x8 xh = __builtin_bit_cast(bf16x8, xw);
#pragma unroll
        for (int nt = 0; nt < 3; ++nt) {
            const bf16x8 wh = __builtin_bit_cast(bf16x8, WRB[((ks * 3 + nt) * 2 + 0) * 64 + lane]), wlo = __builtin_bit_cast(bf16x8, WRB[((ks * 3 + nt) * 2 + 1) * 64 + lane]);
            acc[nt] = __builtin_amdgcn_mfma_f32_16x16x32_bf16(wh, xh, acc[nt], 0, 0, 0);
            acc[nt] = __builtin_amdgcn_mfma_f32_16x16x32_bf16(wlo, xh, acc[nt], 0, 0, 0);
        }
    }
    ssq += lane_xor<16>(ssq);
    { auto rr = __builtin_amdgcn_permlane32_swap(__float_as_uint(ssq), __float_as_uint(ssq), false, false); ssq = __uint_as_float(rr[0]) + __uint_as_float(rr[1]); }
    const float rstd = 1.f / sqrtf(ssq * (1.f / 1024.f) + 1e-6f);
#pragma unroll
    for (int nt = 0; nt < 3; ++nt) *(LAS f32x4_*)(wl + r * 48 + nt * 16 + 4 * q) = acc[nt] * rstd;
    LDS_WAIT();
    float lg[36];
#pragma unroll
    for (int n4 = 0; n4 < 9; ++n4) { const f32x4_ t = *(const LAS f32x4_*)(wl + r * 48 + 4 * n4); lg[4 * n4] = t[0]; lg[4 * n4 + 1] = t[1]; lg[4 * n4 + 2] = t[2]; lg[4 * n4 + 3] = t[3]; }
    float gl[4];
#pragma unroll
    for (int g = 0; g < 4; ++g) gl[g] = lg[g] + rgb[g];
    int gi = 0; float gm = gl[0];
#pragma unroll
    for (int g = 1; g < 4; ++g) if (gl[g] > gm) { gm = gl[g]; gi = g; }
    float gs = 0.f;
#pragma unroll
    for (int g = 0; g < 4; ++g) gs += __expf(gl[g] - gm);
    const float gp = 1.f / gs;
    float e[8];
#pragma unroll
    for (int j = 0; j < 8; ++j) { const float a0 = lg[4 + j] + reb[j], a1 = lg[12 + j] + reb[8 + j], a2 = lg[20 + j] + reb[16 + j], a3 = lg[28 + j] + reb[24 + j];
        e[j] = gi == 0 ? a0 : gi == 1 ? a1 : gi == 2 ? a2 : a3; }
    int i1 = 0; float m1 = e[0];
#pragma unroll
    for (int j = 1; j < 8; ++j) if (e[j] > m1) { m1 = e[j]; i1 = j; }
    int i2 = 0; float m2 = -3.0e38f;
#pragma unroll
    for (int j = 0; j < 8; ++j) if (j != i1 && e[j] > m2) { m2 = e[j]; i2 = j; }
    const float p2 = __expf(m2 - m1);
    const float w1 = gp / (1.f + p2), w2 = gp * p2 / (1.f + p2);
    if (q == 0 && !dry) { const int row = row0 + r; const int e1 = gi * 8 + i1, e2 = gi * 8 + i2;
        const int r1 = (int)__hip_atomic_fetch_add(lc + e1, 1u, __ATOMIC_RELAXED, __HIP_MEMORY_SCOPE_WORKGROUP), r2 = (int)__hip_atomic_fetch_add(lc + e2, 1u, __ATOMIC_RELAXED, __HIP_MEMORY_SCOPE_WORKGROUP);
        RSTD[row] = rstd; TOKE[row * 2] = e1; TOKE[row * 2 + 1] = e2; TOKW[row * 2] = w1; TOKW[row * 2 + 1] = w2; TOKR[row * 2] = r1; TOKR[row * 2 + 1] = r2; }
    LDS_WAIT();
    if (lane < 32 && !dry) GCNT[(row0 >> 4) * 32 + lane] = lc[lane];
}
__device__ __forceinline__ void build_tile_prefix(volatile LAS int* tb, const unsigned* CNT) {
    if (threadIdx.x == 0) { int acc = 0;
        for (int e = 0; e < 32; ++e) { tb[e] = acc; const int c = (int)__hip_atomic_load(CNT + e * CNT_STRIDE, __ATOMIC_RELAXED, __HIP_MEMORY_SCOPE_AGENT); tb[64 + e] = c; acc += (c + 127) >> 7; }
        tb[32] = acc; }
    LDS_WAIT(); __syncthreads();
}
__device__ __forceinline__ void sort_slots(LAS unsigned char* lds, volatile LAS int* tb, const unsigned* GCNT, const int* TOKE, const int* TOKR, int* TOKS, int* PERM, const float* RSTD, float* RSLOT, unsigned* CNT, int blk, int nblk) {
    const int t = opaque_tid(), e = t & 31, j = t >> 5; constexpr int NG = M / 16;
    const int gpb = (NG + nblk - 1) / nblk, g0 = blk * gpb, g1 = g0 + gpb < NG ? g0 + gpb : NG;
    LAS int* part = (LAS int*)lds; LAS int* part2 = part + 512; LAS int* tot = part2 + 512; LAS int* base0 = tot + 32;
    int s = 0, s2 = 0;
    for (int g = j; g < NG; g += 16) { const int c = (int)GCNT[g * 32 + e]; s += c; s2 += g < g0 ? c : 0; }
    part[j * 32 + e] = s; part2[j * 32 + e] = s2;
    LDS_WAIT(); __syncthreads();
    if (t < 32) { int a = 0, b = 0;
#pragma unroll
        for (int jj = 0; jj < 16; ++jj) { a += part[jj * 32 + t]; b += part2[jj * 32 + t]; }
        tot[t] = a; base0[t] = b; if (blk == 0) __hip_atomic_store(CNT + t * CNT_STRIDE, (unsigned)a, __ATOMIC_RELAXED, __HIP_MEMORY_SCOPE_AGENT); }
    LDS_WAIT(); __syncthreads();
    if (t == 0) { int acc = 0; for (int ee = 0; ee < 32; ++ee) { tb[ee] = acc; tb[64 + ee] = tot[ee]; acc += (tot[ee] + 127) >> 7; } tb[32] = acc; }
    LDS_WAIT(); __syncthreads();
    for (int idx = t; idx < (g1 - g0) * 32; idx += 512) { const int gi = idx >> 5, p = (g0 + gi) * 32 + (idx & 31), ex = TOKE[p]; int base = base0[ex];
        for (int g = g0; g < g0 + gi; ++g) base += (int)GCNT[g * 32 + ex];
        const int slot = tb[ex] * 128 + base + TOKR[p]; TOKS[p] = slot; PERM[slot] = p >> 1; RSLOT[slot] = RSTD[p >> 1]; }
}
template <int NR>
__device__ __forceinline__ void final_rows(const bf16_t* X2B, float* OUT, const unsigned char* Y, const int* TOKS, const float* TOKW, const float* gain, int m0, int stride, int lane) {
    typedef float f32x2_ __attribute__((ext_vector_type(2)));
    int s0[NR], s1[NR]; float w0[NR], w1[NR];
#pragma unroll
    for (int i = 0; i < NR; ++i) { const int row = m0 + i * stride; s0[i] = TOKS[row * 2]; s1[i] = TOKS[row * 2 + 1]; w0[i] = TOKW[row * 2] * (1.f / F8_YSCALE); w1[i] = TOKW[row * 2 + 1] * (1.f / F8_YSCALE); }
    u32x2 xx[NR][4]; unsigned ya[NR][4], yb[NR][4];
#pragma unroll
    for (int i = 0; i < NR; ++i) { const int row = m0 + i * stride;
        const GAS u32x2* xr = (const GAS u32x2*)(X2B + (size_t)row * D) + lane; const GAS unsigned* y0 = (const GAS unsigned*)(Y + (size_t)s0[i] * D) + lane; const GAS unsigned* y1 = (const GAS unsigned*)(Y + (size_t)s1[i] * D) + lane;
#pragma unroll
        for (int j = 0; j < 4; ++j) { xx[i][j] = xr[64 * j]; ya[i][j] = y0[64 * j]; yb[i][j] = y1[64 * j]; } }
#pragma unroll
    for (int i = 0; i < NR; ++i) { const int row = m0 + i * stride; f32x4 v[4]; float s = 0.f;
#pragma unroll
        for (int j = 0; j < 4; ++j) { const u32x2 x_ = xx[i][j];
            const f32x2_ a0 = __builtin_amdgcn_cvt_pk_f32_fp8((int)ya[i][j], false), a1 = __builtin_amdgcn_cvt_pk_f32_fp8((int)ya[i][j], true), b0 = __builtin_amdgcn_cvt_pk_f32_fp8((int)yb[i][j], false), b1 = __builtin_amdgcn_cvt_pk_f32_fp8((int)yb[i][j], true);
            v[j].x = bflo(x_.x) + w0[i] * a0[0] + w1[i] * b0[0]; v[j].y = bfhi(x_.x) + w0[i] * a0[1] + w1[i] * b0[1]; v[j].z = bflo(x_.y) + w0[i] * a1[0] + w1[i] * b1[0]; v[j].w = bfhi(x_.y) + w0[i] * a1[1] + w1[i] * b1[1];
            s += (v[j].x * v[j].x + v[j].y * v[j].y) + (v[j].z * v[j].z + v[j].w * v[j].w); }
        const float rstd = 1.f / sqrtf(wave_sum(s) * (1.f / 1024.f) + 1e-6f);
        GAS f32x4* orow = (GAS f32x4*)(OUT + (size_t)row * D) + lane;
#pragma unroll
        for (int j = 0; j < 4; ++j) { const f32x4 g = ((const GAS f32x4*)gain)[64 * j + lane]; orow[64 * j] = v[j] * rstd * g; } }
}

#ifndef MK_N_LAUNCHES
#define MK_N_LAUNCHES 1
#endif
constexpr int N_PHASES = 12;
struct Args { const void* in[18]; float* out; unsigned char* ws; int ph_lo, ph_hi; };
static_assert(sizeof(Args) == 18 * 8 + 8 + 8 + 8, "Args has no padding");

__global__ void __launch_bounds__(NWAVES * 64, 2) mk_fwd(Args args) {
    extern __shared__ __attribute__((aligned(16))) unsigned char lds_raw[];
    LAS unsigned char* lds = (LAS unsigned char*)lds_raw;
    volatile LAS unsigned* MISC = (volatile LAS unsigned*)(lds + MISC_OFF);
    const int G = gridDim.x, bx = blockIdx.x, vcu = (G % 8 == 0) ? (bx % 8) * (G / 8) + bx / 8 : bx;
    const int NGW = G * NWAVES;
#define PHASE_IDS const int tid = opaque_tid(), lane = tid & 63, wave = __builtin_amdgcn_readfirstlane(tid >> 6), gw = vcu * NWAVES + wave; (void)lane; (void)gw
    const __attribute__((address_space(4))) Args* A = (const __attribute__((address_space(4))) Args*)__builtin_amdgcn_kernarg_segment_ptr();
    asm volatile("" : "+s"(A));
#define ARGF(i) ((const float*)A->in[i])
#define WSP(T, off) ((T*)(A->ws + (off)))
#define x_in ARGF(0)
#define positions ((const int*)A->in[1])
#define norm1_gain ARGF(2)
#define w_in ARGF(3)
#define hg_lb ARGF(4)
#define hg_norm_gain ARGF(5)
#define diff_lambda ARGF(6)
#define subln_gain ARGF(7)
#define w_out ARGF(8)
#define norm2_gain ARGF(9)
#define rg_w ARGF(10)
#define rg_b ARGF(11)
#define re_w ARGF(12)
#define re_b ARGF(13)
#define w_gate ARGF(14)
#define w_up ARGF(15)
#define w_down ARGF(16)
#define final_gain ARGF(17)
#define out (A->out)
#define cosT WSP(float, WS_ROPE)
#define sinT (WSP(float, WS_ROPE) + M * 8)
#define HD WSP(float, WS_HD)
#define TOKE WSP(int, WS_TOKE)
#define TOKW WSP(float, WS_TOKW)
#define TOKR WSP(int, WS_TOKR)
#define TOKS WSP(int, WS_TOKS)
#define LAMP WSP(float, WS_LAM)
#define WOUT WSP(bf16_t, WS_WOUT)
#define WIN WSP(bf16_t, WS_WIN)
#define XN WSP(bf16_t, WS_XN)
#define QH WSP(bf16_t, WS_QH)
#define VH WSP(bf16_t, WS_VH)
#define SG WSP(bf16_t, WS_SG)
#define QD WSP(bf16_t, WS_QD)
#define KD WSP(bf16_t, WS_KD)
#define VD WSP(bf16_t, WS_VD)
#define GF WSP(half_t, WS_GF)
#define GB WSP(half_t, WS_GB)
#define HS WSP(float, WS_HS)
#define HL WSP(float, WS_HL)
#define OF WSP(float, WS_OF)
#define OB WSP(float, WS_OB)
#define MIX WSP(bf16_t, WS_MIX)
#define X2B WSP(bf16_t, WS_X2B)
#define X2F8 WSP(unsigned char, WS_X2F8)
#define WGU WSP(unsigned char, WS_WGU)
#define WD WSP(unsigned char, WS_WD)
#define HGb WSP(bf16_t, WS_HG)
#define HM WSP(unsigned char, WS_HM)
#define Y WSP(unsigned char, WS_Y)
#define CNT (WSP(unsigned, WS_CTL) + CW_CNT)
    unsigned* ctl = WSP(unsigned, WS_CTL);
    volatile LAS int* tb = (volatile LAS int*)(MISC + 16);

    if (threadIdx.x < 64) MISC[threadIdx.x] = 0u;
    __syncthreads();
    XcdBarrier bar; bar.bar = ctl + CW_BAR; bar.x = 0; bar.st = nullptr;
    const int lo = A->ph_lo, hi = A->ph_hi;
    if (hi - lo > 1) bar = xcd_barrier_post(ctl + CW_BAR, MISC);
#ifndef PH_MASK
#define PH_MASK 0xFFF
#endif
#define IN(k) (((PH_MASK >> (k)) & 1) && lo <= (k) && (k) < hi)
#ifndef DOUBLE_PHASE
#define DOUBLE_PHASE -1
#endif
#define REP(k) for (int rep_ = 0; rep_ < ((DOUBLE_PHASE) == (k) ? 2 : 1); ++rep_)
#ifndef BAR_REPS
#define BAR_REPS 1
#endif
#ifdef DIAG_SPAN_A
#define STAMP(k) do { if (blockIdx.x == 0 && threadIdx.x == 0) WSP(unsigned long long, WS_LAM + 64)[k] = __builtin_amdgcn_s_memrealtime(); } while (0)
#else
#define STAMP(k) do { } while (0)
#endif
#define SEAM(k) do { if (IN(k) && IN((k) + 1)) for (int b_ = 0; b_ < BAR_REPS; ++b_) xcd_barrier(bar); STAMP((k) + 1); } while (0)

    STAMP(0);
    if (IN(0)) REP(0) { PHASE_IDS;
        LAS float* scr = (LAS float*)(lds + wave * 16384);
        constexpr int I_IN = (D / 64) * (NIN / 32), I_OUT = (D / 64) * (D / 32);
        { XposeRegs R;
#define P0_LOAD(it_) do { if ((it_) < I_IN) xpose_load(R, w_in, D, NIN, (it_), lane); else xpose_load(R, w_out, D, D, (it_) - I_IN, lane); } while (0)
            if (gw < I_IN + I_OUT) P0_LOAD(gw);
            for (int it = gw; it < I_IN + I_OUT; it += NGW) { const XposeRegs C = R; const int nx = it + NGW;
                if (nx < I_IN + I_OUT) P0_LOAD(nx);
                if (it < I_IN) xpose_store(C, D, NIN, WIN, 0, 1, scr, it, lane); else xpose_store(C, D, D, WOUT, 0, 1, scr, it - I_IN, lane); }
#undef P0_LOAD
        }
        for (int m = gw; m < M; m += NGW) rms_rows_to_bf16<1>(x_in, norm1_gain, XN, m, NGW, lane, 1e-6f);
        for (int id = bx * 512 + tid; id < M * 8; id += G * 512) {
            const int i = id & 7; const float invf[8] = {1.0f, 0.19392274474868576f, 0.03760603093086393f, 0.007292664737217109f, 0.001414213562373095f, 0.0002742481756762073f, 5.318295896944988e-05f, 1.031338537721246e-05f};
            float f = invf[0];
#pragma unroll
            for (int q = 1; q < 8; ++q) f = (i == q) ? invf[q] : f;
            const float ang = (float)positions[id >> 3] * f;
            const double rev = (double)ang * 0.15915494309189535; const float fr = (float)(rev - __builtin_rint(rev));
            cosT[id] = __builtin_amdgcn_cosf(fr); sinT[id] = __builtin_amdgcn_sinf(fr);
        }
        for (int id = bx * 512 + tid; id < 32 * 3 * 2 * 64; id += G * 512) {
            const int ln = id & 63, part = (id >> 6) & 1, nt = (id >> 7) % 3, ks = (id >> 7) / 3, n = nt * 16 + (ln & 15), k0 = ks * 32 + 8 * (ln >> 4); unsigned w[4];
#pragma unroll
            for (int jj = 0; jj < 4; ++jj) { float v[2];
#pragma unroll
                for (int u = 0; u < 2; ++u) { const int k = k0 + 2 * jj + u; const float wv = (n < 4 ? rg_w[k * 4 + n] : n < 36 ? re_w[k * 32 + (n - 4)] : 0.f) * norm2_gain[k];
                    const float hv = bf2f(f2bf(wv)); v[u] = part ? wv - hv : hv; }
                w[jj] = pk2(v[0], v[1]); }
            WSP(u32x4, WS_WR)[id] = (u32x4){w[0], w[1], w[2], w[3]}; }
        if (bx == 0 && wave == 0) { const float a = wave_sum(diff_lambda[lane] * diff_lambda[64 + lane]), b = wave_sum(diff_lambda[128 + lane] * diff_lambda[192 + lane]);
            if (lane == 0) LAMP[0] = __expf(a) - __expf(b) + 0.2f; }
    }
    SEAM(0);
    if (IN(1)) REP(1) {
        pg8::Gemm g{XN, WIN, M, NIN, D}; pg8::StaticOrder S; S.init(M, NIN, G, bx);
        EpiInProj E{QH, VH, SG, QD, KD, VD, GF, GB, hg_lb, cosT, sinT};
        pg8::gemm_phase<EpiInProj, pg8::StaticOrder, true, true>(lds, g, S, E);
    }
    SEAM(1);
    if (IN(2)) REP(2) { for (int u = vcu; u < 256; u += G) hg::pass<false>(lds, u, QH, VH, GF, GB, HL, HD, HS, OF, OB);
        { PHASE_IDS; att2::kmax_rows(lds, KD, WSP(unsigned, WS_CTL) + CW_KMAX, gw, NGW, lane, wave); } }
    SEAM(2);
    if (IN(3)) REP(3) hg::scan(HL, HD, HS, bx * 512 + opaque_tid(), G * 512);
    SEAM(3);
    if (IN(4)) REP(4) { for (int u = vcu; u < 256; u += G) hg::pass<true>(lds, u, QH, VH, GF, GB, HL, HD, HS, OF, OB); }
    SEAM(4);
    if (IN(5)) REP(5) { PHASE_IDS;
#ifdef DIAG_CLOCK
        if (blockIdx.x == 0 && threadIdx.x == 0) { WSP(unsigned long long, WS_LAM + 64)[20] = __builtin_amdgcn_s_memtime(); WSP(unsigned long long, WS_LAM + 64)[21] = __builtin_amdgcn_s_memrealtime(); }
#endif
        const float lam = LAMP[0];
        for (int u = vcu; u < 256; u += G) { const int h = u >> 6, q0 = (u & 63) * 256;
            int ln = lane; asm volatile("" : "+v"(ln));
            att::hgrn_finalize(h, q0, OF, OB, SG, hg_norm_gain, MIX, wave, ln);
            att2::unit(lds, h, q0, QD, KD, VD, WSP(unsigned, WS_CTL) + CW_KMAX, WSP(float, WS_O0S) + (size_t)bx * 32768, lam, subln_gain, MIX); }
    }
#ifdef DIAG_CLOCK
    if (blockIdx.x == 0 && threadIdx.x == 0) { WSP(unsigned long long, WS_LAM + 64)[22] = __builtin_amdgcn_s_memtime(); WSP(unsigned long long, WS_LAM + 64)[23] = __builtin_amdgcn_s_memrealtime(); }
#endif
    SEAM(5);
    if (IN(6)) REP(6) {
        pg8::Gemm g{MIX, WOUT, M, D, D}; pg8::StaticOrder S; S.init(M, D, G, bx);
        EpiResid E{x_in, X2B, X2F8};
        pg8::gemm_phase<EpiResid, pg8::StaticOrder, true, true>(lds, g, S, E);
    }
    SEAM(6);
    if (IN(7)) { PHASE_IDS;
        const int grp = wave * G + vcu; const bool router = grp * 16 < M;
        LAS float* scr = (LAS float*)(lds + wave * 16384);
        if (router) route16(X2B, WSP(const u32x4, WS_WR), rg_b, re_b, WSP(float, WS_RSTD), TOKE, TOKW, TOKR, WSP(unsigned, WS_GCNT), grp * 16, lane, scr + 3072);
        if (router && (DOUBLE_PHASE) == 77) route16(X2B, WSP(const u32x4, WS_WR), rg_b, re_b, WSP(float, WS_RSTD), TOKE, TOKW, TOKR, WSP(unsigned, WS_GCNT), grp * 16, lane, scr + 3072, true);
        constexpr int I_GU = (D / 64) * (DEXP / 32), I_DN = (DEXP / 64) * (D / 32), I_ALL = NEXP * (2 * I_GU + I_DN);
#ifndef P7_SHARE
#define P7_SHARE 10
#endif
        const int nrt = M / 16, nA = nrt < NGW ? nrt : NGW, nB = NGW - nA;
        const int perA = nB ? (I_ALL * P7_SHARE / 24 + nA - 1) / nA : (I_ALL + nA - 1) / nA, totA = perA * nA < I_ALL ? perA * nA : I_ALL;
        int it0, it1, stp;
        if (router) { it0 = grp; it1 = totA; stp = nA; } else { it0 = totA + (grp - nA); it1 = I_ALL; stp = nB; }
        REP(7) { XposeRegs R0, R1;
#define P7_LOAD(R, it_) do { const int e_ = (it_) / (2 * I_GU + I_DN), r_ = (it_) % (2 * I_GU + I_DN); \
            if (r_ < I_GU) xpose_load(R, w_gate + (size_t)e_ * D * DEXP, D, DEXP, r_, lane); else if (r_ < 2 * I_GU) xpose_load(R, w_up + (size_t)e_ * D * DEXP, D, DEXP, r_ - I_GU, lane); \
            else xpose_load(R, w_down + (size_t)e_ * DEXP * D, DEXP, D, r_ - 2 * I_GU, lane); } while (0)
#define P7_STORE(C, it_) do { const int e = (it_) / (2 * I_GU + I_DN), r = (it_) % (2 * I_GU + I_DN); \
            if (r < I_GU) xpose_store_f8(C, D, DEXP, WGU + (size_t)e * 1024 * D, 0, 2, scr, r, lane, F8_WSCALE, norm2_gain); \
            else if (r < 2 * I_GU) xpose_store_f8(C, D, DEXP, WGU + (size_t)e * 1024 * D, 1, 2, scr, r - I_GU, lane, F8_WSCALE, norm2_gain); \
            else xpose_store_f8(C, DEXP, D, WD + (size_t)e * 1024 * DEXP, 0, 1, scr, r - 2 * I_GU, lane, F8_WSCALE); } while (0)
            if (it0 < it1) P7_LOAD(R0, it0);
            if (it0 + stp < it1) P7_LOAD(R1, it0 + stp);
            for (int it = it0; it < it1; it += 2 * stp) {
                { const XposeRegs C = R0; if (it + 2 * stp < it1) P7_LOAD(R0, it + 2 * stp); P7_STORE(C, it); }
                if (it + stp < it1) { const XposeRegs C = R1; if (it + 3 * stp < it1) P7_LOAD(R1, it + 3 * stp); P7_STORE(C, it + stp); }
            }
#undef P7_STORE
#undef P7_LOAD
        }
    }
    SEAM(7);
    if (IN(8)) REP(8) { sort_slots(lds, tb, WSP(unsigned, WS_GCNT), TOKE, TOKR, TOKS, WSP(int, WS_PERM), WSP(const float, WS_RSTD), WSP(float, WS_RSLOT), CNT, bx, G); }
    SEAM(8);
    if (IN(9)) REP(9) {
        build_tile_prefix(tb, CNT);
        MoeOrder S{tb, G, bx, WSP(const int, WS_PERM), WSP(unsigned, WS_CTL) + CW_READY, 0}; EpiSwiGlu E{HM, WSP(const float, WS_RSLOT)};
        mg::gemm<EpiSwiGlu, MoeOrder, true>(lds, X2F8, WGU, D, S, E);
    }
    SEAM(9);
    if (IN(10)) REP(10) {
        build_tile_prefix(tb, CNT);
        MoeOrder S{tb, G, bx, WSP(const int, WS_PERM), WSP(unsigned, WS_CTL) + CW_READY, 0}; EpiDown E{Y};
        mg::gemm<EpiDown, MoeOrder, false>(lds, HM, WD, DEXP, S, E);
    }
    SEAM(10);
    if (IN(11)) { PHASE_IDS; for (int m = gw; m < M; m += NGW) final_rows<1>(X2B, out, Y, TOKS, TOKW, final_gain, m, NGW, lane); }
#ifdef DIAG_SPAN_A
    xcd_barrier(bar); STAMP(12); xcd_barrier(bar);
    { const unsigned long long* st_ = WSP(unsigned long long, WS_LAM + 64);
#ifdef DIAG_CLOCK
      const float d_ = (float)(long long)(st_[22] - st_[20]) / (float)(long long)(st_[23] - st_[21]) * 10.f * DIAG_C;
#else
      const float d_ = (float)(long long)(st_[DIAG_SPAN_B] - st_[DIAG_SPAN_A]) * 0.01f * DIAG_C;
#endif
      for (int m = blockIdx.x * 512 + threadIdx.x; m < M; m += gridDim.x * 512) out[(size_t)m * D] += d_; }
#endif
#undef IN
#undef SEAM
#undef x_in
#undef positions
#undef out
#undef Y
#undef HM
#undef CNT
}

extern "C" void kernel_launch(void* const* d_in, const int* in_sizes, int n_in, void* d_out, int out_size, void* d_ws, size_t ws_size, hipStream_t stream) {
    static int grid = 0;
    if (grid == 0) {
        if (n_in != 18 || in_sizes[0] != M * D || out_size != M * D || ws_size < WS_END) { fprintf(stderr, "kernel_launch: unexpected shapes (n_in %d, in0 %d, out %d, ws %zu)\n", n_in, n_in > 0 ? in_sizes[0] : -1, out_size, ws_size); grid = -1; return; }
        int dev = 0, cus = 0, per_cu = 0;
        if (hipGetDevice(&dev) != hipSuccess || hipDeviceGetAttribute(&cus, hipDeviceAttributeMultiprocessorCount, dev) != hipSuccess) { grid = -1; return; }
        if (hipFuncSetAttribute((const void*)mk_fwd, hipFuncAttributeMaxDynamicSharedMemorySize, LDS_BYTES) != hipSuccess) { fprintf(stderr, "kernel_launch: hipFuncSetAttribute failed\n"); grid = -1; return; }
        if (hipOccupancyMaxActiveBlocksPerMultiprocessor(&per_cu, (const void*)mk_fwd, NWAVES * 64, LDS_BYTES) != hipSuccess || per_cu < 1) { fprintf(stderr, "kernel_launch: occupancy query says %d\n", per_cu); (void)hipGetLastError(); grid = -1; return; }
        grid = cus;
    }
    if (grid < 0) return;
    if (hipMemsetAsync((char*)d_ws + WS_CTL, 0, CTL_ZERO_BYTES, stream) != hipSuccess) return;
    Args a{};
    for (int i = 0; i < 18; ++i) a.in[i] = d_in[i];
    a.out = (float*)d_out; a.ws = (unsigned char*)d_ws;
#if MK_N_LAUNCHES == 1
    a.ph_lo = 0; a.ph_hi = N_PHASES;
    hipLaunchKernelGGL(mk_fwd, dim3(grid), dim3(NWAVES * 64), LDS_BYTES, stream, a);
#else
    for (int p = 0; p < N_PHASES; ++p) { a.ph_lo = p; a.ph_hi = p + 1; hipLaunchKernelGGL(mk_fwd, dim3(grid), dim3(NWAVES * 64), LDS_BYTES, stream, a); }
#endif
}
```

```cpp
#include <hip/hip_runtime.h>
#include <cstdio>
#include <cstdint>
__device__ __forceinline__ int opaque_tid() { int t = threadIdx.x; asm volatile("" : "+v"(t)); return t; }
namespace pg8 {
#define PG8_LAS __attribute__((address_space(3)))
typedef unsigned short bf16_t;
typedef short bf16x8 __attribute__((ext_vector_type(8)));
typedef float f32x4 __attribute__((ext_vector_type(4)));
typedef unsigned u32x4 __attribute__((ext_vector_type(4)));
constexpr int BM = 256, BK = 64, HALF = 128, HTB = HALF * BK * 2  , STAGE_BYTES = 8 * HTB, NXCD = 8, WGM = 8;

__host__ __device__ __forceinline__ int lds_byte(int r, int c) { const int st = (r >> 4) * 2 + (c >> 5), rr = r & 15, cc = c & 31, ob = rr * 64 + cc * 2; return st * 1024 + (ob ^ (((ob >> 9) & 1) << 5)); }
__host__ __device__ __forceinline__ void stage_rc(int b, int& R, int& C) { const int st = b / 1024, sb = b % 1024, swz = sb ^ (((sb >> 9) & 1) << 5); R = (st >> 1) * 16 + swz / 64; C = (st & 1) * 32 + (swz % 64) / 2; }
__host__ __device__ __forceinline__ int perm32(int rho) { const int n = rho >> 4, i = rho & 15; return 8 * (i >> 2) + 4 * n + (i & 3); }

struct Unit { int pm, pn; };
struct Gemm { const bf16_t* A; const bf16_t* Bt; int M, N, K; };

struct StaticOrder {
    int nM, nN, nwg, G, c;
    __host__ __device__ void init(int M, int N, int G_, int c_) { nM = M / BM; nN = N / BM; nwg = nM * nN; G = G_; c = c_; }
    __host__ __device__ bool next(int i, Unit& u) const {
        const long L = (long)i * G + c; if (L >= nwg) return false;
        int wgid = (int)L; { const int q = nwg / NXCD, r = nwg % NXCD, xcd = wgid % NXCD, off = wgid / NXCD; wgid = (xcd < r ? xcd * (q + 1) : r * (q + 1) + (xcd - r) * q) + off; }
        const int nig = WGM * nN, gid = wgid / nig, fm = gid * WGM, gsz = (nM - fm) < WGM ? (nM - fm) : WGM;
        u.pm = fm + ((wgid % nig) % gsz); u.pn = (wgid % nig) / gsz; return true;
    }
    __device__ __forceinline__ bool half_only(const Unit&) const { return false; }
    __device__ __forceinline__ void a_ready(const Unit&) const {}
    __device__ __forceinline__ void done(const Unit&) const {}
};

template <class Epi, class Sched, bool ALIGN_EPI = false, bool SP2 = false, bool F8 = false>
__device__ __forceinline__ void gemm_phase(PG8_LAS unsigned char* lds, const Gemm g, const Sched& S, const Epi& E) {
    const int tid = opaque_tid(), wid = __builtin_amdgcn_readfirstlane(tid >> 6), lane = tid & 63, wr = wid >> 2, wc = wid & 3, fr = lane & 15, fq = lane >> 4;
    const int K = g.K, nt = K / BK;
    unsigned voffA[2], voffB[2];
#pragma unroll
    for (int i = 0; i < 2; ++i) { int R, C; stage_rc(tid * 16 + i * 8192, R, C); const int Rb = Epi::PERM ? ((R & ~31) + perm32(R & 31)) : R;
        voffA[i] = (unsigned)(R * K + C) * 2u; voffB[i] = (unsigned)(Rb * K + C) * 2u; }
    const size_t kstep = (size_t)(BK * 2);
    const size_t hstep = (size_t)HALF * K * 2;
    const size_t tstep = 2 * hstep;
    const unsigned ldsw = (unsigned)wid * 1024u;
    const int aoff = lds_byte(wr * 64 + fr, fq * 8), boff = lds_byte(wc * 32 + fr, fq * 8);
#define PG8_SA(b, h) (((b) * 2 + (h)) * HTB)
#define PG8_SB(b, h) ((4 + (b) * 2 + (h)) * HTB)
#define PG8_STAGE(bufoff, gbase, voff) do { _Pragma("unroll") for (int _i = 0; _i < 2; ++_i) \
        __builtin_amdgcn_global_load_lds((const unsigned*)((const char*)(gbase) + (voff)[_i]), (PG8_LAS unsigned*)(lds + (bufoff) + ldsw + _i * 8192), 16, 0, 0); } while (0)
#define PG8_LDA(dst, b, h) do { _Pragma("unroll") for (int m = 0; m < 4; ++m) _Pragma("unroll") for (int k = 0; k < 2; ++k) dst[m][k] = *(const PG8_LAS bf16x8*)(lds + PG8_SA(b, h) + aoff + m * 2048 + k * 1024); } while (0)
#define PG8_LDB(dst, b, h) do { _Pragma("unroll") for (int n = 0; n < 2; ++n) _Pragma("unroll") for (int k = 0; k < 2; ++k) dst[n][k] = *(const PG8_LAS bf16x8*)(lds + PG8_SB(b, h) + boff + n * 2048 + k * 1024); } while (0)
#define PG8_MMA(ai, bj, At, Bt) do { __builtin_amdgcn_s_setprio(1); _Pragma("unroll") for (int m = 0; m < 4; ++m) _Pragma("unroll") for (int n = 0; n < 2; ++n) _Pragma("unroll") for (int k = 0; k < 2; ++k) { \
        if constexpr (F8) { typedef long v2l_ __attribute__((ext_vector_type(2))); const v2l_ b_ = __builtin_bit_cast(v2l_, Bt[n][k]), a_ = __builtin_bit_cast(v2l_, At[m][k]); \
            acc[ai][bj][m][n] = __builtin_amdgcn_mfma_f32_16x16x32_fp8_fp8(b_[0], a_[0], acc[ai][bj][m][n], 0, 0, 0); acc[ai][bj][m][n] = __builtin_amdgcn_mfma_f32_16x16x32_fp8_fp8(b_[1], a_[1], acc[ai][bj][m][n], 0, 0, 0); } \
        else acc[ai][bj][m][n] = __builtin_amdgcn_mfma_f32_16x16x32_bf16(Bt[n][k], At[m][k], acc[ai][bj][m][n], 0, 0, 0); } \
        __builtin_amdgcn_s_setprio(0); } while (0)
#define PG8_WAIT_V(n) asm volatile("s_waitcnt vmcnt(" #n ")" ::: "memory")
#define PG8_WAIT_L(n) asm volatile("s_waitcnt lgkmcnt(" #n ")" ::: "memory")
#define PG8_BAR __builtin_amdgcn_s_barrier()
#define PG8_SCHED __builtin_amdgcn_sched_barrier(0)
    Unit cur, nxt; int ui = 0;
    if (!S.next(0, cur)) return;
    f32x4 acc[2][2][4][2];
#pragma unroll
    for (int a = 0; a < 2; ++a)
#pragma unroll
        for (int b = 0; b < 2; ++b)
#pragma unroll
            for (int m = 0; m < 4; ++m)
#pragma unroll
                for (int n = 0; n < 2; ++n) acc[a][b][m][n] = (f32x4){0.f, 0.f, 0.f, 0.f};
    bf16x8 At[4][2], B0[2][2], B1[2][2];
    const char* cA = (const char*)g.A + (size_t)cur.pm * tstep; const char* cB = (const char*)g.Bt + (size_t)cur.pn * tstep;
    S.a_ready(cur);
    if constexpr (SP2) {
        PG8_STAGE(PG8_SB(0, 0), cB, voffB); PG8_STAGE(PG8_SB(0, 1), cB + hstep, voffB); PG8_STAGE(PG8_SA(0, 0), cA, voffA); PG8_STAGE(PG8_SA(0, 1), cA + hstep, voffA);
        if (wr == 1) PG8_BAR;
        PG8_WAIT_V(2); PG8_BAR;
        PG8_STAGE(PG8_SB(1, 0), cB + kstep, voffB); PG8_STAGE(PG8_SA(1, 0), cA + kstep, voffA); PG8_STAGE(PG8_SB(1, 1), cB + hstep + kstep, voffB);
        PG8_WAIT_V(6); PG8_BAR;
    } else {
        PG8_STAGE(PG8_SB(0, 0), cB, voffB); PG8_STAGE(PG8_SA(0, 0), cA, voffA); PG8_STAGE(PG8_SB(0, 1), cB + hstep, voffB); PG8_STAGE(PG8_SA(0, 1), cA + hstep, voffA);
        if (wr == 1) PG8_BAR;
        PG8_WAIT_V(4); PG8_BAR;
        PG8_STAGE(PG8_SB(1, 0), cB + kstep, voffB); PG8_STAGE(PG8_SA(1, 0), cA + kstep, voffA); PG8_STAGE(PG8_SB(1, 1), cB + hstep + kstep, voffB);
        PG8_WAIT_V(6); PG8_BAR;
    }
    for (;;) {
        const bool has_next = S.next(ui + 1, nxt);
        const char* nA = has_next ? (const char*)g.A + (size_t)nxt.pm * tstep : cA; const char* nB = has_next ? (const char*)g.Bt + (size_t)nxt.pn * tstep : cB;
        for (int t = 0; t < nt; t += 2) {
            const bool last = (t == nt - 2);
            const char* a1 = cA + (size_t)(t + 1) * kstep;
            const char* a2 = last ? nA : cA + (size_t)(t + 2) * kstep; const char* b2 = last ? nB : cB + (size_t)(t + 2) * kstep;
            const char* a3 = a2 + kstep; const char* b3 = b2 + kstep;
            if (last && has_next) S.a_ready(nxt);
            if constexpr (SP2) {
            PG8_LDB(B0, 0, 0); PG8_LDB(B1, 0, 1); PG8_SCHED; PG8_LDA(At, 0, 0); PG8_STAGE(PG8_SA(1, 1), a1 + hstep, voffA);
            PG8_WAIT_V(8); PG8_WAIT_L(0); PG8_BAR; PG8_MMA(0, 0, At, B0); PG8_MMA(0, 1, At, B1); PG8_BAR; PG8_SCHED;
            PG8_LDA(At, 0, 1); PG8_STAGE(PG8_SB(0, 0), b2, voffB); PG8_STAGE(PG8_SB(0, 1), b2 + hstep, voffB); PG8_STAGE(PG8_SA(0, 0), a2, voffA);
            PG8_WAIT_V(8); PG8_WAIT_L(0); PG8_BAR; PG8_MMA(1, 0, At, B0); PG8_MMA(1, 1, At, B1); PG8_BAR; PG8_SCHED;
            PG8_LDB(B0, 1, 0); PG8_LDB(B1, 1, 1); PG8_SCHED; PG8_LDA(At, 1, 0); PG8_STAGE(PG8_SA(0, 1), a2 + hstep, voffA);
            PG8_WAIT_V(8); PG8_WAIT_L(0); PG8_BAR; PG8_MMA(0, 0, At, B0); PG8_MMA(0, 1, At, B1); PG8_BAR; PG8_SCHED;
            PG8_LDA(At, 1, 1); PG8_STAGE(PG8_SB(1, 0), b3, voffB); PG8_STAGE(PG8_SB(1, 1), b3 + hstep, voffB); PG8_STAGE(PG8_SA(1, 0), a3, voffA);
            PG8_WAIT_V(8); PG8_WAIT_L(0); PG8_BAR; PG8_MMA(1, 0, At, B0); PG8_MMA(1, 1, At, B1); PG8_BAR; PG8_SCHED;
            } else {
            PG8_LDB(B0, 0, 0); PG8_SCHED; PG8_LDA(At, 0, 0); PG8_STAGE(PG8_SA(1, 1), a1 + hstep, voffA);
            PG8_WAIT_L(8); PG8_BAR; PG8_WAIT_L(0); PG8_MMA(0, 0, At, B0); PG8_BAR; PG8_SCHED;
            PG8_LDB(B1, 0, 1); PG8_STAGE(PG8_SB(0, 0), b2, voffB);
            PG8_BAR; PG8_WAIT_L(0); PG8_MMA(0, 1, At, B1); PG8_BAR;
            PG8_LDA(At, 0, 1); PG8_STAGE(PG8_SA(0, 0), a2, voffA);
            PG8_BAR; PG8_WAIT_L(0); PG8_MMA(1, 0, At, B0); PG8_BAR; PG8_SCHED;
            PG8_STAGE(PG8_SB(0, 1), b2 + hstep, voffB);
            PG8_WAIT_V(6); PG8_BAR; PG8_MMA(1, 1, At, B1); PG8_BAR;
            PG8_LDB(B0, 1, 0); PG8_SCHED; PG8_LDA(At, 1, 0); PG8_STAGE(PG8_SA(0, 1), a2 + hstep, voffA);
            PG8_WAIT_L(8); PG8_BAR; PG8_WAIT_L(0); PG8_MMA(0, 0, At, B0); PG8_BAR; PG8_SCHED;
            PG8_LDB(B1, 1, 1); PG8_STAGE(PG8_SB(1, 0), b3, voffB);
            PG8_BAR; PG8_WAIT_L(0); PG8_MMA(0, 1, At, B1); PG8_BAR;
            PG8_LDA(At, 1, 1); PG8_STAGE(PG8_SA(1, 0), a3, voffA);
            PG8_BAR; PG8_WAIT_L(0); PG8_MMA(1, 0, At, B0); PG8_BAR; PG8_SCHED;
            PG8_STAGE(PG8_SB(1, 1), b3 + hstep, voffB);
            PG8_WAIT_V(6); PG8_BAR; PG8_MMA(1, 1, At, B1); PG8_BAR;
            }
        }
        if constexpr (ALIGN_EPI) { if (wr == 0) PG8_BAR; }
        if constexpr (!Epi::AFTER_DRAIN) { E(acc, cur, wr, wc, fr, fq); S.done(cur); }
        if (!has_next) break;
#pragma unroll
        for (int a = 0; a < 2; ++a)
#pragma unroll
            for (int b = 0; b < 2; ++b)
#pragma unroll
                for (int m = 0; m < 4; ++m)
#pragma unroll
                    for (int n = 0; n < 2; ++n) acc[a][b][m][n] = (f32x4){0.f, 0.f, 0.f, 0.f};
        cur = nxt; cA = nA; cB = nB; ++ui;
        if constexpr (ALIGN_EPI) { if (wr == 1) PG8_BAR; }
    }
    PG8_WAIT_V(0);
    if constexpr (!ALIGN_EPI) { if (wr == 0) PG8_BAR; }
    PG8_BAR;
    if constexpr (Epi::AFTER_DRAIN) { E.fused(acc, cur, wr, wc, fr, fq, lds, wid, lane); S.done(cur); }
#undef PG8_SA
#undef PG8_SB
#undef PG8_STAGE
#undef PG8_LDA
#undef PG8_LDB
#undef PG8_MMA
#undef PG8_WAIT_V
#undef PG8_WAIT_L
#undef PG8_BAR
#undef PG8_SCHED
}
}

constexpr int NWAVES = 8;
constexpr int M = 16384, D = 1024, NIN = 4096, HSEC = 512;
constexpr int NEXP = 32, DEXP = 512, MAXTILES = 160, MAXSLOTS = MAXTILES * 256;
constexpr float QSCALE = 0.18033688011112042f;

constexpr size_t MiB = 1u << 20;
constexpr size_t WS_CTL = 0, CTL_ZERO_BYTES = 1 * MiB;
constexpr size_t WS_WR = 1 * MiB;
constexpr size_t WS_ROPE = 2 * MiB;
constexpr size_t WS_HD = 3 * MiB;
constexpr size_t WS_TOKE = 3 * MiB + 256 * 1024, WS_TOKW = WS_TOKE + 128 * 1024, WS_TOKR = WS_TOKW + 128 * 1024, WS_TOKS = WS_TOKR + 128 * 1024, WS_LAM = WS_TOKS + 128 * 1024, WS_GCNT = WS_LAM + 128 * 1024, WS_RSTD = 1 * MiB + 256 * 1024, WS_RSLOT = 1 * MiB + 768 * 1024, WS_PERM = 1 * MiB + 512 * 1024;
constexpr size_t WS_WOUT = 4 * MiB, WS_WIN = 6 * MiB;
constexpr size_t WS_XN = 16 * MiB;
constexpr size_t WS_OF = 16 * MiB;
constexpr size_t WS_X2B = 16 * MiB;
constexpr size_t WS_HM = 144 * MiB;
constexpr size_t WS_X2F8 = 112 * MiB;
constexpr size_t WS_QH = 48 * MiB, WS_VH = 64 * MiB, WS_SG = 80 * MiB, WS_QD = 96 * MiB, WS_KD = 112 * MiB, WS_VD = 128 * MiB;
constexpr size_t WS_WGU = 48 * MiB, WS_WD = 216 * MiB;
constexpr size_t WS_GF = 144 * MiB, WS_GB = 176 * MiB;
constexpr size_t WS_MIX = 144 * MiB;
constexpr size_t WS_HS = 208 * MiB, WS_HL = 224 * MiB;
constexpr size_t WS_OB = 224 * MiB;
constexpr size_t WS_HG = 176 * MiB;
constexpr size_t WS_O0S = 176 * MiB;
constexpr size_t WS_Y = 48 * MiB;
constexpr size_t WS_END = 256 * MiB;
static_assert(WS_Y + (size_t)MAXSLOTS * 1024 * 2 <= WS_HM && WS_HM + (size_t)MAXSLOTS * 512 * 2 <= WS_WD && WS_WD + 32 * MiB <= WS_END, "ws map");
constexpr int CW_BAR = 4096, CW_CNT = 16384, CW_KMAX = 20480, CW_QWD = 21504, CW_READY = 32768, CNT_STRIDE = 64;

constexpr int PHASE_LDS = 147456, MISC_OFF = PHASE_LDS, LDS_BYTES = PHASE_LDS + 1024;

#define GAS __attribute__((address_space(1)))
#define LAS __attribute__((address_space(3)))
typedef unsigned short bf16_t;
typedef _Float16 half_t;
typedef float f32x4 __attribute__((ext_vector_type(4)));
typedef float f32x16 __attribute__((ext_vector_type(16)));
typedef short bf16x8 __attribute__((ext_vector_type(8)));
typedef short s16x4 __attribute__((ext_vector_type(4)));
typedef unsigned u32x4 __attribute__((ext_vector_type(4)));
typedef unsigned u32x2 __attribute__((ext_vector_type(2)));
#define LDS_WAIT() asm volatile("s_waitcnt lgkmcnt(0)" ::: "memory")
#define VM_WAIT() asm volatile("s_waitcnt vmcnt(0)" ::: "memory")
#define SBAR() __builtin_amdgcn_sched_barrier(0)
__device__ __forceinline__ unsigned f2bf(float f) { unsigned u = __builtin_bit_cast(unsigned, f); return (u + 0x7fffu + ((u >> 16) & 1u)) >> 16; }
__device__ __forceinline__ unsigned pk2(float lo, float hi) { return f2bf(lo) | (f2bf(hi) << 16); }
__device__ __forceinline__ float bf2f(unsigned b) { return __builtin_bit_cast(float, b << 16); }
__device__ __forceinline__ float bflo(unsigned w) { return __builtin_bit_cast(float, w << 16); }
__device__ __forceinline__ float bfhi(unsigned w) { return __builtin_bit_cast(float, w & 0xffff0000u); }
__device__ __forceinline__ unsigned cvtpk(float lo, float hi) { unsigned r; asm volatile("v_cvt_pk_bf16_f32 %0, %1, %2" : "=v"(r) : "v"(lo), "v"(hi)); return r; }
__device__ __forceinline__ unsigned pk4_fp8(float a, float b, float c, float d) { int w = 0; w = __builtin_amdgcn_cvt_pk_fp8_f32(a, b, w, false); w = __builtin_amdgcn_cvt_pk_fp8_f32(c, d, w, true); return (unsigned)w; }
constexpr float F8_WSCALE = 256.f, F8_HSCALE = 16.f, F8_YSCALE = 32.f;
__device__ __forceinline__ float ex2(float x) { return __builtin_amdgcn_exp2f(x); }
__device__ __forceinline__ float lg2(float x) { return __builtin_amdgcn_logf(x); }
__device__ __forceinline__ float sigmoidf_(float v) { return __builtin_amdgcn_rcpf(1.f + ex2(-1.4426950408889634f * v)); }
__device__ __forceinline__ bool lane_is_hi() { return (opaque_tid() & 32) != 0; }
template <int X> __device__ __forceinline__ float lane_xor(float v) {
    if constexpr (X == 32) { auto rr = __builtin_amdgcn_permlane32_swap(__float_as_uint(v), __float_as_uint(v), false, false); return __uint_as_float(lane_is_hi() ? rr[0] : rr[1]); }
    else return __int_as_float(__builtin_amdgcn_ds_swizzle(__float_as_int(v), (X << 10) | 0x1F));
}
__device__ __forceinline__ float wave_sum(float v) {
    v += lane_xor<1>(v); v += lane_xor<2>(v); v += lane_xor<4>(v); v += lane_xor<8>(v); v += lane_xor<16>(v);
    auto rr = __builtin_amdgcn_permlane32_swap(__float_as_uint(v), __float_as_uint(v), false, false);
    return __uint_as_float(rr[0]) + __uint_as_float(rr[1]);
}
__device__ __forceinline__ int crow(int r, int hi) { return (r & 3) + 8 * (r >> 2) + 4 * hi; }
#define XB_TMO      128
#define XB_XCNT(j)  (256  + 64 * (j))
#define XB_XSUB(j)  (1280 + 64 * (j))
#define XB_XGEN(j)  (2304 + 64 * (j))
#define XB_TOP      3328
#define XB_TOPGEN   3392
#define XCD_BAR_WORDS 3456
#define XB_SPIN_CAP (1u << 18)

__device__ __forceinline__ unsigned xb_ld(unsigned* p)              { return __hip_atomic_load(p, __ATOMIC_RELAXED, __HIP_MEMORY_SCOPE_AGENT); }
__device__ __forceinline__ unsigned xb_add(unsigned* p, unsigned v) { return __hip_atomic_fetch_add(p, v, __ATOMIC_RELAXED, __HIP_MEMORY_SCOPE_AGENT); }
__device__ __forceinline__ unsigned xb_xcc_id() { return (unsigned)__builtin_amdgcn_s_getreg((3 << 11) | 20) & 0xFu; }
#define XB_SPIN(cond, bar) do { unsigned _sp = 0; while (cond) { __builtin_amdgcn_s_sleep(1); \
    if ((++_sp & 255u) == 0u) { if (xb_ld(&(bar)[XB_TMO])) break; if (_sp > XB_SPIN_CAP) { atomicAdd(&(bar)[XB_TMO], 1u); break; } } } } while (0)

struct XcdBarrier {
    unsigned* bar; unsigned x;
    volatile LAS unsigned* st;
};

__device__ __forceinline__ XcdBarrier xcd_barrier_post(unsigned* bar, volatile LAS unsigned* st) {
    XcdBarrier b; b.bar = bar; b.x = xb_xcc_id(); b.st = st;
    if (threadIdx.x == 0) (void)xb_add(&bar[XB_XCNT(b.x)], 1u);
    return b;
}
__device__ __forceinline__ void xcd_barrier_complete(unsigned* bar, unsigned x, unsigned& nloc, unsigned& nx) {
    const unsigned G = gridDim.x * gridDim.y * gridDim.z;
    unsigned sum, cnt, mine, sp = 0u;
    for (;;) {
        sum = 0u; cnt = 0u; mine = 0u;
#pragma unroll
        for (unsigned j = 0; j < 16; ++j) { const unsigned c = xb_ld(&bar[XB_XCNT(j)]); sum += c; cnt += (c > 0u) ? 1u : 0u; mine = (j == x) ? c : mine; }
        if (sum == G) break;
        __builtin_amdgcn_s_sleep(1);
        if ((++sp & 255u) == 0u) { if (xb_ld(&bar[XB_TMO])) break; if (sp > XB_SPIN_CAP) { atomicAdd(&bar[XB_TMO], 1u); break; } }
    }
    nloc = mine > 0u ? mine : 1u; nx = cnt > 0u ? cnt : 1u;
}

__device__ __forceinline__ void xcd_barrier(const XcdBarrier& b) {
    asm volatile("s_waitcnt vmcnt(0)" ::: "memory");
    __syncthreads();
    if (threadIdx.x == 0) {
        unsigned* bar = b.bar;
        __builtin_amdgcn_s_waitcnt(0);
        unsigned nloc = b.st[0], nx = b.st[1];
        if (nloc == 0u) { xcd_barrier_complete(bar, b.x, nloc, nx); b.st[0] = nloc; b.st[1] = nx; }
        const unsigned old = xb_add(&bar[XB_XSUB(b.x)], 1u);
        const unsigned gen = old / nloc;
        if (old + 1u == (gen + 1u) * nloc) {
            __builtin_amdgcn_fence(__ATOMIC_RELEASE, "agent");
            asm volatile("s_waitcnt vmcnt(0)" ::: "memory");
            const unsigned og = xb_add(&bar[XB_TOP], 1u);
            const unsigned tg = og / nx;
            if (og + 1u == (tg + 1u) * nx) xb_add(&bar[XB_TOPGEN], 1u);
            else XB_SPIN(xb_ld(&bar[XB_TOPGEN]) == tg, bar);
            __builtin_amdgcn_fence(__ATOMIC_ACQUIRE, "agent");
            xb_add(&bar[XB_XGEN(b.x)], 1u);
            asm volatile("s_waitcnt vmcnt(0)" ::: "memory");
        } else {
            XB_SPIN(xb_ld(&bar[XB_XGEN(b.x)]) == gen, bar);
            __builtin_amdgcn_fence(__ATOMIC_ACQUIRE, "agent");
            asm volatile("s_waitcnt vmcnt(0)" ::: "memory");
        }
    }
    __syncthreads();
}

struct XposeRegs { f32x4 v[8]; };
__device__ __forceinline__ void xpose_load(XposeRegs& R, const float* W, int K, int N, int item, int lane) {
    const int nblk = N / 32, kb = item / nblk, nb = item % nblk, k0 = 64 * kb, n0 = 32 * nb; (void)K;
    const float* p = W + (size_t)(k0 + (lane >> 3)) * N + n0 + (lane & 7) * 4;
#pragma unroll
    for (int i = 0; i < 8; ++i) R.v[i] = __builtin_nontemporal_load((const GAS f32x4*)(p + (size_t)(8 * i) * N));
}
__device__ __forceinline__ void xpose_store(const XposeRegs& R, int K, int N, bf16_t* WT, int row_off, int row_mul, LAS float* scr, int item, int lane, const float* kgain = nullptr) {
    const int nblk = N / 32, kb = item / nblk, nb = item % nblk, k0 = 64 * kb, n0 = 32 * nb;
#pragma unroll
    for (int i = 0; i < 8; ++i) { LAS float* d = scr + (8 * i + (lane >> 3)) * 33 + (lane & 7) * 4; d[0] = R.v[i].x; d[1] = R.v[i].y; d[2] = R.v[i].z; d[3] = R.v[i].w; }
    LDS_WAIT(); asm volatile("" ::: "memory");
    const int c = lane & 7;
    f32x4 g0 = {1.f, 1.f, 1.f, 1.f}, g1 = g0;
    if (kgain) { g0 = *(const GAS f32x4*)(kgain + k0 + 8 * c); g1 = *(const GAS f32x4*)(kgain + k0 + 8 * c + 4); }
#pragma unroll
    for (int j = 0; j < 4; ++j) { const int n = (lane >> 3) + 8 * j; const LAS float* s = scr + (8 * c) * 33 + n;
        u32x4 o; o.x = cvtpk(s[0 * 33] * g0.x, s[1 * 33] * g0.y); o.y = cvtpk(s[2 * 33] * g0.z, s[3 * 33] * g0.w); o.z = cvtpk(s[4 * 33] * g1.x, s[5 * 33] * g1.y); o.w = cvtpk(s[6 * 33] * g1.z, s[7 * 33] * g1.w);
        *(GAS u32x4*)(WT + (size_t)(row_off + (n0 + n) * row_mul) * K + k0 + 8 * c) = o; }
    LDS_WAIT(); asm volatile("" ::: "memory");
}
__device__ __forceinline__ void xpose_store_f8(const XposeRegs& R, int K, int N, unsigned char* WT, int row_off, int row_mul, LAS float* scr, int item, int lane, float scale, const float* kgain = nullptr) {
    const int nblk = N / 32, kb = item / nblk, nb = item % nblk, k0 = 64 * kb, n0 = 32 * nb;
#pragma unroll
    for (int i = 0; i < 8; ++i) { LAS float* d = scr + (8 * i + (lane >> 3)) * 33 + (lane & 7) * 4; d[0] = R.v[i].x; d[1] = R.v[i].y; d[2] = R.v[i].z; d[3] = R.v[i].w; }
    LDS_WAIT(); asm volatile("" ::: "memory");
    const int c = lane & 7;
    f32x4 g0 = {scale, scale, scale, scale}, g1 = g0;
    if (kgain) { g0 = *(const GAS f32x4*)(kgain + k0 + 8 * c) * scale; g1 = *(const GAS f32x4*)(kgain + k0 + 8 * c + 4) * scale; }
#pragma unroll
    for (int j = 0; j < 4; ++j) { const int n = (lane >> 3) + 8 * j; const LAS float* s = scr + (8 * c) * 33 + n;
        u32x2 o; o.x = pk4_fp8(s[0 * 33] * g0.x, s[1 * 33] * g0.y, s[2 * 33] * g0.z, s[3 * 33] * g0.w); o.y = pk4_fp8(s[4 * 33] * g1.x, s[5 * 33] * g1.y, s[6 * 33] * g1.z, s[7 * 33] * g1.w);
        *(GAS u32x2*)(WT + (size_t)(row_off + (n0 + n) * row_mul) * K + k0 + 8 * c) = o; }
    LDS_WAIT(); asm volatile("" ::: "memory");
}
template <int NR>
__device__ __forceinline__ void rms_rows_to_bf16(const float* X, const float* gain, bf16_t* O, int m0, int stride, int lane, float eps) {
    f32x4 v[NR][4]; float s[NR];
#pragma unroll
    for (int i = 0; i < NR; ++i) { const GAS f32x4* xr = (const GAS f32x4*)(X + (size_t)(m0 + i * stride) * D) + lane;
#pragma unroll
        for (int j = 0; j < 4; ++j) v[i][j] = xr[64 * j]; }
#pragma unroll
    for (int i = 0; i < NR; ++i) { float t = 0.f;
#pragma unroll
        for (int j = 0; j < 4; ++j) t += (v[i][j].x * v[i][j].x + v[i][j].y * v[i][j].y) + (v[i][j].z * v[i][j].z + v[i][j].w * v[i][j].w);
        s[i] = t; }
#pragma unroll
    for (int i = 0; i < NR; ++i) s[i] = 1.f / sqrtf(wave_sum(s[i]) * (1.f / 1024.f) + eps);
#pragma unroll
    for (int j = 0; j < 4; ++j) { const f32x4 g = ((const GAS f32x4*)gain)[64 * j + lane];
#pragma unroll
        for (int i = 0; i < NR; ++i) { u32x2 w; w.x = cvtpk(v[i][j].x * s[i] * g.x, v[i][j].y * s[i] * g.y); w.y = cvtpk(v[i][j].z * s[i] * g.z, v[i][j].w * s[i] * g.w);
            ((GAS u32x2*)(O + (size_t)(m0 + i * stride) * D) + lane)[64 * j] = w; } }
}

__device__ __forceinline__ void rms_rows_piped(const float* X, const float* gain, bf16_t* O, int m0, int stride, int lane, float eps) {
    if (m0 >= M) return;
    f32x4 g[4], c[4], n[4];
#pragma unroll
    for (int j = 0; j < 4; ++j) { g[j] = ((const GAS f32x4*)gain)[64 * j + lane]; c[j] = ((const GAS f32x4*)(X + (size_t)m0 * D) + lane)[64 * j]; }
#pragma unroll 1
    for (int row = m0; row < M; row += stride) {
        if (row + stride < M) {
#pragma unroll
            for (int j = 0; j < 4; ++j) n[j] = ((const GAS f32x4*)(X + (size_t)(row + stride) * D) + lane)[64 * j]; }
        float t = 0.f;
#pragma unroll
        for (int j = 0; j < 4; ++j) t += (c[j].x * c[j].x + c[j].y * c[j].y) + (c[j].z * c[j].z + c[j].w * c[j].w);
        const float s = 1.f / sqrtf(wave_sum(t) * (1.f / 1024.f) + eps);
#pragma unroll
        for (int j = 0; j < 4; ++j) { u32x2 w; w.x = cvtpk(c[j].x * s * g[j].x, c[j].y * s * g[j].y); w.y = cvtpk(c[j].z * s * g[j].z, c[j].w * s * g[j].w); ((GAS u32x2*)(O + (size_t)row * D) + lane)[64 * j] = w; }
#pragma unroll
        for (int j = 0; j < 4; ++j) c[j] = n[j];
    }
}

struct EpiInProj {
    static constexpr bool PERM = true, AFTER_DRAIN = false;
    bf16_t *QH, *VH, *SG, *QD, *KD, *VD; half_t *GF, *GB; const float* lbraw; const float *cosT, *sinT;
    __device__ __forceinline__ void operator()(const pg8::f32x4 (&acc)[2][2][4][2], const pg8::Unit& u, int wr, int wc, int fr, int fq) const {
        const int sec = u.pn >> 1;
        const int row0 = u.pm * 256 + wr * 64 + fr;
        const int cs0 = (u.pn & 1) * 256 + wc * 32 + 8 * fq;
        if (sec == 1 || sec == 2) {
            half_t* G = sec == 1 ? GF : GB; const float* lbp = lbraw + (sec - 1) * 1024;
#pragma unroll
            for (int bj = 0; bj < 2; ++bj) { const int c = cs0 + bj * 128; float lb[8];
#pragma unroll
                for (int j = 0; j < 8; ++j) { const float l0 = lbp[c + j], l1 = lbp[512 + c + j]; lb[j] = __builtin_amdgcn_rcpf(1.f + ex2(1.4426950408889634f * (l0 - l1))); }
#pragma unroll
                for (int ai = 0; ai < 2; ++ai)
#pragma unroll
                    for (int m = 0; m < 4; ++m) { const int row = row0 + ai * 128 + m * 16; f32x4 o0, o1;
#pragma unroll
                        for (int j = 0; j < 4; ++j) { o0[j] = lb[j] + (1.f - lb[j]) * sigmoidf_(acc[ai][bj][m][0][j]); o1[j] = lb[4 + j] + (1.f - lb[4 + j]) * sigmoidf_(acc[ai][bj][m][1][j]); }
                        typedef _Float16 h8 __attribute__((ext_vector_type(8)));
                        const h8 hv = {(_Float16)o0[0], (_Float16)o0[1], (_Float16)o0[2], (_Float16)o0[3], (_Float16)o1[0], (_Float16)o1[1], (_Float16)o1[2], (_Float16)o1[3]};
                        *(h8*)(G + (size_t)row * HSEC + c) = hv; } }
            return;
        }
        bf16_t* O = sec == 0 ? QH : sec == 3 ? VH : sec == 4 ? SG : sec == 5 ? QD : sec == 6 ? KD : VD;
        const bool rot = (sec == 5 || sec == 6) && ((wc & 1) == 0);
        const float sc = sec == 5 ? QSCALE : 1.f;
#pragma unroll
        for (int ai = 0; ai < 2; ++ai)
#pragma unroll
            for (int m = 0; m < 4; ++m) { const int row = row0 + ai * 128 + m * 16;
#pragma unroll
                for (int bj = 0; bj < 2; ++bj) { const int c = cs0 + bj * 128; float v[8];
#pragma unroll
                    for (int j = 0; j < 4; ++j) { v[j] = acc[ai][bj][m][0][j]; v[4 + j] = acc[ai][bj][m][1][j]; }
                    if (sec == 4) {
#pragma unroll
                        for (int j = 0; j < 8; ++j) v[j] = v[j] * sigmoidf_(v[j]);
                    }
                    if (rot) {
                        const f32x4 c0 = *(const f32x4*)(cosT + (size_t)row * 8), c1 = *(const f32x4*)(cosT + (size_t)row * 8 + 4);
                        const f32x4 s0 = *(const f32x4*)(sinT + (size_t)row * 8), s1 = *(const f32x4*)(sinT + (size_t)row * 8 + 4);
#pragma unroll
                        for (int j = 0; j < 8; ++j) { const float p = lane_xor<16>(v[j]); const float cj = j < 4 ? c0[j & 3] : c1[j & 3], sj = j < 4 ? s0[j & 3] : s1[j & 3];
                            const float r = fq == 0 ? v[j] * cj - p * sj : v[j] * cj + p * sj; v[j] = fq < 2 ? r : v[j]; }
                    }
                    u32x4 w; w.x = cvtpk(v[0] * sc, v[1] * sc); w.y = cvtpk(v[2] * sc, v[3] * sc); w.z = cvtpk(v[4] * sc, v[5] * sc); w.w = cvtpk(v[6] * sc, v[7] * sc);
                    *(u32x4*)(O + (size_t)row * HSEC + c) = w; } }
    }
};
struct EpiResid {
    static constexpr bool PERM = true, AFTER_DRAIN = false;
    const float* X; bf16_t* O; unsigned char* O8;
    __device__ __forceinline__ void operator()(const pg8::f32x4 (&acc)[2][2][4][2], const pg8::Unit& u, int wr, int wc, int fr, int fq) const {
        const int row0 = u.pm * 256 + wr * 64 + fr, col0 = u.pn * 256 + wc * 32 + 8 * fq;
#pragma unroll
        for (int ai = 0; ai < 2; ++ai)
#pragma unroll
            for (int m = 0; m < 4; ++m) { const size_t off = (size_t)(row0 + ai * 128 + m * 16) * D + col0;
#pragma unroll
                for (int bj = 0; bj < 2; ++bj) { const f32x4 a = *(const f32x4*)(X + off + bj * 128) + acc[ai][bj][m][0], b = *(const f32x4*)(X + off + bj * 128 + 4) + acc[ai][bj][m][1];
                    u32x4 w; w.x = cvtpk(a[0], a[1]); w.y = cvtpk(a[2], a[3]); w.z = cvtpk(b[0], b[1]); w.w = cvtpk(b[2], b[3]); *(u32x4*)(O + off + bj * 128) = w;
                    u32x2 f; f.x = pk4_fp8(a[0], a[1], a[2], a[3]); f.y = pk4_fp8(b[0], b[1], b[2], b[3]); *(u32x2*)(O8 + off + bj * 128) = f; } }
    }
};
struct EpiSwiGlu {
    unsigned char* O; const float* RS;
    __device__ __forceinline__ void operator()(const f32x4 (&acc)[2][4][2], const pg8::Unit& u, int wr, int wc, int fr, int fq) const {
        const int row0 = u.pm * 128 + wr * 64 + fr, col0 = ((u.pn & 3) * 256 + wc * 32 + 8 * fq) >> 1;
#pragma unroll
        for (int m = 0; m < 4; ++m) { const int row = row0 + m * 16; const float rs = RS[row] * (1.f / F8_WSCALE); unsigned char* rowp = O + (size_t)row * DEXP + col0;
#pragma unroll
            for (int bj = 0; bj < 2; ++bj) { const f32x4 a = acc[bj][m][0] * rs, b = acc[bj][m][1] * rs;
                const float h0 = a[0] * sigmoidf_(a[0]) * a[1], h1 = a[2] * sigmoidf_(a[2]) * a[3], h2 = b[0] * sigmoidf_(b[0]) * b[1], h3 = b[2] * sigmoidf_(b[2]) * b[3];
                *(unsigned*)(rowp + bj * 64) = pk4_fp8(__builtin_amdgcn_fmed3f(h0 * F8_HSCALE, -448.f, 448.f), __builtin_amdgcn_fmed3f(h1 * F8_HSCALE, -448.f, 448.f), __builtin_amdgcn_fmed3f(h2 * F8_HSCALE, -448.f, 448.f), __builtin_amdgcn_fmed3f(h3 * F8_HSCALE, -448.f, 448.f)); } }
    }
};
struct EpiDown {
    unsigned char* O;
    __device__ __forceinline__ void operator()(const f32x4 (&acc)[2][4][2], const pg8::Unit& u, int wr, int wc, int fr, int fq) const {
        const int row0 = u.pm * 128 + wr * 64 + fr, col0 = (u.pn & 3) * 256 + wc * 32 + 8 * fq; constexpr float us = F8_YSCALE / (F8_WSCALE * F8_HSCALE);
#pragma unroll
        for (int m = 0; m < 4; ++m) { unsigned char* rowp = O + (size_t)(row0 + m * 16) * D + col0;
#pragma unroll
            for (int bj = 0; bj < 2; ++bj) { const f32x4 a = acc[bj][m][0] * us, b = acc[bj][m][1] * us;
                u32x2 w; w.x = pk4_fp8(__builtin_amdgcn_fmed3f(a[0], -448.f, 448.f), __builtin_amdgcn_fmed3f(a[1], -448.f, 448.f), __builtin_amdgcn_fmed3f(a[2], -448.f, 448.f), __builtin_amdgcn_fmed3f(a[3], -448.f, 448.f));
                w.y = pk4_fp8(__builtin_amdgcn_fmed3f(b[0], -448.f, 448.f), __builtin_amdgcn_fmed3f(b[1], -448.f, 448.f), __builtin_amdgcn_fmed3f(b[2], -448.f, 448.f), __builtin_amdgcn_fmed3f(b[3], -448.f, 448.f));
                *(u32x2*)(rowp + bj * 128) = w; } }
    }
};
struct MoeOrder {
    const volatile LAS int* tb; int G, c; const int* PERM; unsigned* ready; int mode;
    __device__ __forceinline__ bool decode(int L, pg8::Unit& u) const {
        const int x = c & 7; int base = 0;
#pragma unroll 1
        for (int k = 0; k < 4; ++k) { const int e = 4 * x + k, t0 = __builtin_amdgcn_readfirstlane(tb[e]), nt = __builtin_amdgcn_readfirstlane(tb[e + 1]) - t0;
            if (L < base + 4 * nt) { const int idx = L - base; u.pm = t0 + idx % nt; u.pn = e * 4 + idx / nt; return true; }
            base += 4 * nt; }
        return false;
    }
    __device__ __forceinline__ bool next(int i, pg8::Unit& u) const {
        if ((G & 7) == 0) {
            const int x = c & 7, s = c >> 3, nb = G >> 3;
            const int U = 4 * (__builtin_amdgcn_readfirstlane(tb[4 * x + 4]) - __builtin_amdgcn_readfirstlane(tb[4 * x]));
            if (mode == 0) return decode(i * nb + s, u);
            const int i0 = s < U ? (U - s + nb - 1) / nb : 0;
            return decode((i0 + i) * nb + s - U, u);
        }
        const int L = i * G + c, T = __builtin_amdgcn_readfirstlane(tb[32]); if (L >= 4 * T) return false;
        const int tile = L >> 2; int e = 0;
#pragma unroll 1
        for (int j = 1; j < 32; ++j) e += (__builtin_amdgcn_readfirstlane(tb[j]) <= tile) ? 1 : 0;
        u.pm = tile; u.pn = e * 4 + (L & 3); return true;
    }
    __device__ __forceinline__ int row_tok(const pg8::Unit& u, int r) const {
        const int e = u.pn >> 2, rem = __builtin_amdgcn_readfirstlane(tb[64 + e]) - (u.pm - __builtin_amdgcn_readfirstlane(tb[e])) * 128;
        return r < rem ? PERM[u.pm * 128 + r] : 0;
    }
    __device__ __forceinline__ bool half_only(const pg8::Unit&) const { return false; }
    __device__ __forceinline__ void done(const pg8::Unit& u) const {
        if (mode == 2) { asm volatile("s_waitcnt vmcnt(0)" ::: "memory");
            if ((threadIdx.x & 63) == 0) __hip_atomic_fetch_add(ready + 64 * u.pm, 1u, __ATOMIC_RELAXED, __HIP_MEMORY_SCOPE_AGENT); }
    }
    __device__ __forceinline__ void a_ready(const pg8::Unit& u) const {
        if (mode == 1) {
            if (threadIdx.x < 64) { const unsigned long long t0 = __builtin_amdgcn_s_memrealtime();
                while ((unsigned)__builtin_amdgcn_readfirstlane(__hip_atomic_load(ready + 64 * u.pm, __ATOMIC_RELAXED, __HIP_MEMORY_SCOPE_AGENT)) < 32u) {
                    if (__builtin_amdgcn_s_memrealtime() - t0 > 2000000ull) break;
                    __builtin_amdgcn_s_sleep(2); }
                __builtin_amdgcn_fence(__ATOMIC_ACQUIRE, "agent");
                asm volatile("s_waitcnt vmcnt(0)" ::: "memory"); }
            asm volatile("" ::: "memory"); __builtin_amdgcn_s_barrier(); asm volatile("" ::: "memory");
        }
    }
};

namespace mg {
constexpr int TM = 128, BUF = 3 * pg8::HTB;
#define MG_WAIT_V(n) asm volatile("s_waitcnt vmcnt(" #n ")" ::: "memory")
#define MG_WAIT_L0() asm volatile("s_waitcnt lgkmcnt(0)" ::: "memory")
#define MG_BAR() do { asm volatile("" ::: "memory"); __builtin_amdgcn_s_barrier(); asm volatile("" ::: "memory"); __builtin_amdgcn_sched_barrier(0); } while (0)
struct Frags { bf16x8 a[4][2], b[2][2][2]; };
template <class Epi, class Sched, bool GATHER>
__device__ __forceinline__ void gemm(LAS unsigned char* lds, const unsigned char* A, const unsigned char* Bt, int Kb, const Sched& S, const Epi& E) {
    const int tid = opaque_tid(), wid = __builtin_amdgcn_readfirstlane(tid >> 6), lane = tid & 63, wr = wid >> 2, wc = wid & 3, fr = lane & 15, fq = lane >> 4;
    asm volatile("" : "+s"(Kb));
    const int nkt = Kb >> 7;
    unsigned voffB[2], colA[2]; int rowA[2];
#pragma unroll
    for (int i = 0; i < 2; ++i) { int R, C; pg8::stage_rc(tid * 16 + i * 8192, R, C); const int Rb = (R & ~31) + pg8::perm32(R & 31);
        rowA[i] = R; colA[i] = (unsigned)C * 2u; voffB[i] = (unsigned)(Rb * Kb) + (unsigned)C * 2u; }
    const unsigned ldsw = (unsigned)wid * 1024u;
    const int aoff = pg8::lds_byte(wr * 64 + fr, fq * 8), boff = pg8::lds_byte(wc * 32 + fr, fq * 8);
    const size_t bhalf = (size_t)128 * Kb;
#define MG_DMA(slot_, ao_, bb_, kt_) do { _Pragma("unroll") for (int p_ = 0; p_ < 6; ++p_) MG_DMA1(p_, slot_, ao_, bb_, kt_); } while (0)
#define MG_DMA1(p_, slot_, ao_, bb_, kt_) do { const unsigned so_ = (unsigned)(slot_) * BUF; const size_t ko_ = (size_t)(kt_) * 128; \
        if ((p_) < 2) __builtin_amdgcn_global_load_lds((const unsigned*)(A + (size_t)(ao_)[(p_) & 1] + ko_), (LAS unsigned*)(lds + so_ + ldsw + ((p_) & 1) * 8192), 16, 0, 0); \
        else __builtin_amdgcn_global_load_lds((const unsigned*)((bb_) + (((p_) - 2) >> 1) * bhalf + voffB[(p_) & 1] + ko_), (LAS unsigned*)(lds + so_ + (1 + (((p_) - 2) >> 1)) * pg8::HTB + ldsw + ((p_) & 1) * 8192), 16, 0, 0); } while (0)
#define MG_READ(F_, slot_) do { const LAS unsigned char* p_ = lds + (unsigned)(slot_) * BUF; \
        _Pragma("unroll") for (int m = 0; m < 4; ++m) _Pragma("unroll") for (int k = 0; k < 2; ++k) F_.a[m][k] = *(const LAS bf16x8*)(p_ + aoff + m * 2048 + k * 1024); \
        _Pragma("unroll") for (int bj = 0; bj < 2; ++bj) _Pragma("unroll") for (int n = 0; n < 2; ++n) _Pragma("unroll") for (int k = 0; k < 2; ++k) \
            F_.b[bj][n][k] = *(const LAS bf16x8*)(p_ + (1 + bj) * pg8::HTB + boff + n * 2048 + k * 1024); } while (0)
#define MG_MMA1(F_, bj_, m_, n_) do { typedef int v4i_ __attribute__((ext_vector_type(4))); \
        acc[bj_][m_][n_] = __builtin_amdgcn_mfma_scale_f32_16x16x128_f8f6f4(__builtin_shufflevector(__builtin_bit_cast(v4i_, F_.b[bj_][n_][0]), __builtin_bit_cast(v4i_, F_.b[bj_][n_][1]), 0, 1, 2, 3, 4, 5, 6, 7), \
            __builtin_shufflevector(__builtin_bit_cast(v4i_, F_.a[m_][0]), __builtin_bit_cast(v4i_, F_.a[m_][1]), 0, 1, 2, 3, 4, 5, 6, 7), acc[bj_][m_][n_], 0, 0, 0, 0x7F7F7F7F, 0, 0x7F7F7F7F); } while (0)
#define MG_SB() __builtin_amdgcn_sched_barrier(0)
#define MG_READB(F_, slot_) do { const LAS unsigned char* p_ = lds + (unsigned)(slot_) * BUF; \
        _Pragma("unroll") for (int bj = 0; bj < 2; ++bj) _Pragma("unroll") for (int n = 0; n < 2; ++n) _Pragma("unroll") for (int k = 0; k < 2; ++k) \
            F_.b[bj][n][k] = *(const LAS bf16x8*)(p_ + (1 + bj) * pg8::HTB + boff + n * 2048 + k * 1024); } while (0)
#define MG_READA(F_, slot_, m_) do { const LAS unsigned char* p_ = lds + (unsigned)(slot_) * BUF; \
        _Pragma("unroll") for (int k = 0; k < 2; ++k) F_.a[m_][k] = *(const LAS bf16x8*)(p_ + aoff + (m_) * 2048 + k * 1024); } while (0)
#define MG_GROUP(Fc_, Fn_, rslot_, m_) do { MG_MMA1(Fc_, 0, m_, 0); MG_MMA1(Fc_, 0, m_, 1); MG_MMA1(Fc_, 1, m_, 0); MG_MMA1(Fc_, 1, m_, 1); MG_SB(); MG_READA(Fn_, rslot_, m_); MG_SB(); } while (0)
#define MG_STEP(Fc_, Fn_, rslot_, dslot_, ao_, bb_, kt_) do { MG_READB(Fn_, rslot_); MG_SB(); \
        MG_DMA1(0, dslot_, ao_, bb_, kt_); MG_SB(); MG_GROUP(Fc_, Fn_, rslot_, 0); MG_DMA1(1, dslot_, ao_, bb_, kt_); MG_DMA1(2, dslot_, ao_, bb_, kt_); MG_SB(); MG_GROUP(Fc_, Fn_, rslot_, 1); \
        MG_DMA1(3, dslot_, ao_, bb_, kt_); MG_SB(); MG_GROUP(Fc_, Fn_, rslot_, 2); MG_DMA1(4, dslot_, ao_, bb_, kt_); MG_DMA1(5, dslot_, ao_, bb_, kt_); MG_SB(); MG_GROUP(Fc_, Fn_, rslot_, 3); \
        MG_SB(); } while (0)
#define MG_AOFS(dst_, u_) do { _Pragma("unroll") for (int i_ = 0; i_ < 2; ++i_) dst_[i_] = (GATHER ? (unsigned)S.row_tok(u_, rowA[i_]) : (unsigned)((u_).pm * TM + rowA[i_])) * (unsigned)Kb + colA[i_]; } while (0)
    pg8::Unit cur, nxt; int ui = 0;
    if (!S.next(0, cur)) return;
    f32x4 acc[2][4][2];
#pragma unroll
    for (int b = 0; b < 2; ++b)
#pragma unroll
        for (int m = 0; m < 4; ++m)
#pragma unroll
            for (int n = 0; n < 2; ++n) acc[b][m][n] = (f32x4){0.f, 0.f, 0.f, 0.f};
    unsigned ac[2], an[2];
    MG_AOFS(ac, cur);
    const unsigned char* bc = Bt + (size_t)cur.pn * 256 * Kb;
    Frags FA, FB;
    MG_DMA(0, ac, bc, 0); MG_DMA(1, ac, bc, 1); MG_DMA(2, ac, bc, 2);
    MG_WAIT_V(12); MG_BAR();
    MG_READ(FA, 0); MG_WAIT_L0();
    int sl = 0;
    for (;;) {
        const bool has_next = S.next(ui + 1, nxt);
        if (!has_next) nxt = cur;
        const unsigned char* bn = Bt + (size_t)nxt.pn * 256 * Kb;
        MG_AOFS(an, nxt);
#pragma unroll 1
        for (int kt = 0; kt < nkt; kt += 2) {
            if (!(kt == 0 && ui > 0)) MG_WAIT_V(6);
            MG_BAR();
            const int s1 = sl == 2 ? 0 : sl + 1;
            { const bool in_ = kt + 3 < nkt; const unsigned ax[2] = {in_ ? ac[0] : an[0], in_ ? ac[1] : an[1]}; const unsigned char* bx = in_ ? bc : bn; const int kx = in_ ? kt + 3 : kt + 3 - nkt;
              MG_STEP(FA, FB, s1, sl, ax, bx, kx); }
            MG_WAIT_L0();
            MG_WAIT_V(6); MG_BAR();
            const int s2 = s1 == 2 ? 0 : s1 + 1;
            { const bool in_ = kt + 4 < nkt; const unsigned ax[2] = {in_ ? ac[0] : an[0], in_ ? ac[1] : an[1]}; const unsigned char* bx = in_ ? bc : bn; const int kx = in_ ? kt + 4 : kt + 4 - nkt;
              MG_STEP(FB, FA, s2, s1, ax, bx, kx); }
            if (kt + 2 == nkt) { MG_WAIT_V(6); E(acc, cur, wr, wc, fr, fq);
#pragma unroll
                for (int b = 0; b < 2; ++b)
#pragma unroll
                    for (int m = 0; m < 4; ++m)
#pragma unroll
                        for (int n = 0; n < 2; ++n) acc[b][m][n] = (f32x4){0.f, 0.f, 0.f, 0.f}; }
            MG_WAIT_L0();
            sl = s2;
        }
        if (!has_next) break;
        cur = nxt; ac[0] = an[0]; ac[1] = an[1]; bc = bn; ++ui;
    }
    MG_WAIT_V(0); MG_BAR();
#undef MG_DMA
#undef MG_READ
#undef MG_MMA1
#undef MG_STEP
#undef MG_GROUP
#undef MG_READA
#undef MG_READB
#undef MG_DMA1
#undef MG_AOFS
}
}

namespace hg {
typedef short v4i16_t __attribute__((ext_vector_type(4)));
constexpr int S128 = 272, S64 = 144;
constexpr int L_QD = 0, L_QE = L_QD + 64 * S128, L_KE = L_QE + 64 * S128, L_VR = L_KE + 64 * S128, L_ST = L_VR + 64 * S128,
              L_P = L_ST + 128 * S128, L_QS = L_P + 64 * S64, L_DC = L_QS + 16 * 128 * 4, L_END = L_DC + 128 * 4;
static_assert(L_END <= PHASE_LDS, "hgrn LDS");
__device__ __forceinline__ bf16x8 frag(const LAS unsigned char* base, int row, int stride, int kb  ) { return *(const LAS bf16x8*)(base + row * stride + kb); }
__device__ __forceinline__ bf16x8 trfrag(const LAS unsigned char* tile, int tok0, int chan0, int lane) {
    const LAS unsigned char* p = tile + (tok0 + 8 * (lane >> 5) + ((lane & 15) >> 2)) * S128 + (chan0 + 16 * ((lane >> 4) & 1) + 4 * (lane & 3)) * 2;
    const s16x4 lo = __builtin_bit_cast(s16x4, __builtin_amdgcn_ds_read_tr16_b64_v4i16((LAS v4i16_t*)p)), hi = __builtin_bit_cast(s16x4, __builtin_amdgcn_ds_read_tr16_b64_v4i16((LAS v4i16_t*)(p + 4 * S128)));
    return (bf16x8){lo[0], lo[1], lo[2], lo[3], hi[0], hi[1], hi[2], hi[3]};
}

template <bool PASS_C, int ABL = 0>
__device__ __forceinline__ void pass(LAS unsigned char* lds, int unit, const bf16_t* QH, const bf16_t* VH, const half_t* GF, const half_t* GB,
                                     float* HL, float* HD, const float* HS, float* OF, float* OB) {
    typedef _Float16 h4 __attribute__((ext_vector_type(4)));
    const int tid = opaque_tid(), lane = tid & 63, wid = __builtin_amdgcn_readfirstlane(tid >> 6), r32 = lane & 31, hi = lane >> 5;
    const int dir = unit >> 7, head = (unit >> 5) & 3, sc = unit & 31;
    const int kq = tid & 31, tq = tid >> 5;
    const half_t* G = dir ? GB : GF; float* O = dir ? OB : OF;
    const int vi = wid >> 1, ki0 = (wid & 1) * 2;
    f32x16 sacc[2];
    LAS f32x4* QS = (LAS f32x4*)(lds + L_QS); LAS float* DC = (LAS float*)(lds + L_DC);
    if (PASS_C) {
        const float* hs = HS + (size_t)unit * 16384;
#pragma unroll
        for (int tt = 0; tt < 2; ++tt)
#pragma unroll
            for (int r = 0; r < 16; r += 2) { const int v = vi * 32 + crow(r, hi), kk = (ki0 + tt) * 32 + r32; const float s0 = hs[v * 128 + kk], s1 = hs[(v + 1) * 128 + kk]; sacc[tt][r] = s0; sacc[tt][r + 1] = s1;
                const unsigned w = cvtpk(s0, s1); *(LAS bf16_t*)(lds + L_ST + v * S128 + kk * 2) = (bf16_t)(w & 0xffffu); *(LAS bf16_t*)(lds + L_ST + (v + 1) * S128 + kk * 2) = (bf16_t)(w >> 16); }
    } else { sacc[0] = f32x16{}; sacc[1] = f32x16{}; }
    f32x4 btot = {1.f, 1.f, 1.f, 1.f};
    h4 gh[4]; u32x2 qv[4], vv[4];
#define HG_LOAD(c_) do { const int tb_ = sc * 512 + (c_) * 64 + 4 * tq; _Pragma("unroll") for (int i = 0; i < 4; ++i) { const int tl = tb_ + i, tok = dir ? (M - 1 - tl) : tl; \
        const size_t off = (size_t)tok * HSEC + head * 128 + 4 * kq; gh[i] = *(const h4*)(G + off); vv[i] = *(const u32x2*)(VH + off); if (PASS_C) qv[i] = *(const u32x2*)(QH + off); } } while (0)
    HG_LOAD(0);
#pragma unroll 1
    for (int c = 0; c < 8; ++c) {
        const int t0 = sc * 512 + c * 64;
        f32x4 g[4], b[4];
#pragma unroll
        for (int i = 0; i < 4; ++i) { g[i] = (f32x4){(float)gh[i][0], (float)gh[i][1], (float)gh[i][2], (float)gh[i][3]}; b[i] = i ? b[i - 1] * g[i] : g[i]; }
        QS[tq * 32 + kq] = b[3];
        LDS_WAIT(); __syncthreads();
        if (tid < 128) { LAS float* qs = (LAS float*)QS; float run = 1.f;
#pragma unroll
            for (int q = 0; q < 16; ++q) { const float t = qs[q * 128 + tid]; qs[q * 128 + tid] = run; run *= t; }
            DC[tid] = run; }
        LDS_WAIT(); __syncthreads();
        const f32x4 pre = QS[tq * 32 + kq], etot = *(const LAS f32x4*)(DC + 4 * kq);
        btot *= etot;
        f32x4 itot; itot[0] = __builtin_amdgcn_rcpf(etot[0]); itot[1] = __builtin_amdgcn_rcpf(etot[1]); itot[2] = __builtin_amdgcn_rcpf(etot[2]); itot[3] = __builtin_amdgcn_rcpf(etot[3]);
#pragma unroll
        for (int i = 0; i < 4; ++i) { const int tr = 4 * tq + i; float ke[4], qd[4], qe[4];
            const float q4[4] = {bflo(qv[i].x), bfhi(qv[i].x), bflo(qv[i].y), bfhi(qv[i].y)};
#pragma unroll
            for (int cc = 0; cc < 4; ++cc) { const float pb = b[i][cc] * pre[cc];
                ke[cc] = (1.f - g[i][cc]) * etot[cc] * __builtin_amdgcn_rcpf(pb);
                if (PASS_C) { qd[cc] = q4[cc] * pb; qe[cc] = qd[cc] * itot[cc]; } }
            *(LAS u32x2*)(lds + L_KE + tr * S128 + kq * 8) = (u32x2){cvtpk(ke[0], ke[1]), cvtpk(ke[2], ke[3])};
            *(LAS u32x2*)(lds + L_VR + tr * S128 + kq * 8) = vv[i];
            if (PASS_C) { *(LAS u32x2*)(lds + L_QD + tr * S128 + kq * 8) = (u32x2){cvtpk(qd[0], qd[1]), cvtpk(qd[2], qd[3])};
                *(LAS u32x2*)(lds + L_QE + tr * S128 + kq * 8) = (u32x2){cvtpk(qe[0], qe[1]), cvtpk(qe[2], qe[3])}; } }
        LDS_WAIT(); __syncthreads();
        if (c < 7 && !(ABL & 2)) HG_LOAD(c + 1);
        if (PASS_C && !(ABL & 4)) {
            if (wid < 4) {
                const int ti = wid >> 1, si = wid & 1; f32x16 p = f32x16{};
                if (!(ti == 0 && si == 1)) {
#pragma unroll
                    for (int ks = 0; ks < 8; ++ks) p = __builtin_amdgcn_mfma_f32_32x32x16_bf16(frag(lds + L_QE, ti * 32 + r32, S128, ks * 32 + hi * 16), frag(lds + L_KE, si * 32 + r32, S128, ks * 32 + hi * 16), p, 0, 0, 0);
                }
#pragma unroll
                for (int r = 0; r < 16; r += 2) { const int t = ti * 32 + crow(r, hi), s = si * 32 + r32; const unsigned w = cvtpk(s <= t ? p[r] : 0.f, s <= t + 1 ? p[r + 1] : 0.f);
                    *(LAS bf16_t*)(lds + L_P + t * S64 + s * 2) = (bf16_t)(w & 0xffffu); *(LAS bf16_t*)(lds + L_P + (t + 1) * S64 + s * 2) = (bf16_t)(w >> 16); }
            }
            LDS_WAIT(); __syncthreads();
            { const int ti = wid >> 2, vo = wid & 3; f32x16 o = f32x16{};
#pragma unroll
                for (int ks = 0; ks < 8; ++ks) o = __builtin_amdgcn_mfma_f32_32x32x16_bf16(frag(lds + L_QD, ti * 32 + r32, S128, ks * 32 + hi * 16), frag(lds + L_ST, vo * 32 + r32, S128, ks * 32 + hi * 16), o, 0, 0, 0);
#pragma unroll
                for (int ss = 0; ss < 4; ++ss) o = __builtin_amdgcn_mfma_f32_32x32x16_bf16(frag(lds + L_P, ti * 32 + r32, S64, ss * 32 + hi * 16), trfrag(lds + L_VR, ss * 16, vo * 32, lane), o, 0, 0, 0);
#pragma unroll
                for (int r = 0; r < 16; ++r) { const int tl = t0 + ti * 32 + crow(r, hi), tok = dir ? (M - 1 - tl) : tl; if (!(ABL & 1)) O[(size_t)tok * HSEC + head * 128 + vo * 32 + r32] = o[r]; else asm volatile("" :: "v"(o[r])); }
            }
        }
#pragma unroll
        for (int tt = 0; tt < ((ABL & 4) ? 0 : 2); ++tt) { const int ki = ki0 + tt; const float d = DC[ki * 32 + r32];
#pragma unroll
            for (int r = 0; r < 16; ++r) sacc[tt][r] *= d;
#pragma unroll
            for (int ss = 0; ss < 4; ++ss) sacc[tt] = __builtin_amdgcn_mfma_f32_32x32x16_bf16(trfrag(lds + L_VR, ss * 16, vi * 32, lane), trfrag(lds + L_KE, ss * 16, ki * 32, lane), sacc[tt], 0, 0, 0);
        }
        LDS_WAIT(); __syncthreads();
        if (PASS_C) {
#pragma unroll
            for (int tt = 0; tt < 2; ++tt)
#pragma unroll
                for (int r = 0; r < 16; r += 2) { const int v = vi * 32 + crow(r, hi), kk = (ki0 + tt) * 32 + r32; const unsigned w = cvtpk(sacc[tt][r], sacc[tt][r + 1]);
                    *(LAS bf16_t*)(lds + L_ST + v * S128 + kk * 2) = (bf16_t)(w & 0xffffu); *(LAS bf16_t*)(lds + L_ST + (v + 1) * S128 + kk * 2) = (bf16_t)(w >> 16); }
        }
    }
#undef HG_LOAD
    if (!PASS_C) {
        float* hl = HL + (size_t)unit * 16384;
#pragma unroll
        for (int tt = 0; tt < 2; ++tt)
#pragma unroll
            for (int r = 0; r < 16; ++r) { const int v = vi * 32 + crow(r, hi), kk = (ki0 + tt) * 32 + r32; hl[v * 128 + kk] = sacc[tt][r]; }
        if (tq == 0) *(f32x4*)(HD + unit * 128 + 4 * kq) = btot;
    }
    __syncthreads();
}
__device__ __forceinline__ void scan(const float* HL, const float* HD, float* HS, int gtid, int gthreads) {
    for (int id = gtid; id < 8 * 16384; id += gthreads) {
        const int dh = id >> 14, e = id & 16383, k = e & 127; float S = 0.f;
        float hl[32], hd[32];
#pragma unroll
        for (int sc = 0; sc < 32; ++sc) { const int u = dh * 32 + sc; hl[sc] = HL[(size_t)u * 16384 + e]; hd[sc] = HD[u * 128 + k]; }
#pragma unroll
        for (int sc = 0; sc < 32; ++sc) { const int u = dh * 32 + sc; HS[(size_t)u * 16384 + e] = S; S = hd[sc] * S + hl[sc]; }
    }
}
}

namespace att {
__device__ __forceinline__ void hgrn_finalize(int h, int q0, const float* OF, const float* OB, const bf16_t* SG, const float* gain, bf16_t* MIX, int wid, int lane) {
    const float g0 = gain[2 * lane], g1 = gain[2 * lane + 1];
#pragma unroll 1
    for (int i0 = 0; i0 < 32; i0 += 4) { float2 a[4], b[4]; unsigned sg[4]; float x0[4], x1[4], ss[4];
#pragma unroll
        for (int i = 0; i < 4; ++i) { const size_t off = (size_t)(q0 + wid * 32 + i0 + i) * HSEC + h * 128 + 2 * lane; a[i] = *(const float2*)(OF + off); b[i] = *(const float2*)(OB + off); sg[i] = *(const unsigned*)(SG + off); }
#pragma unroll
        for (int i = 0; i < 4; ++i) { x0[i] = a[i].x + b[i].x; x1[i] = a[i].y + b[i].y; ss[i] = x0[i] * x0[i] + x1[i] * x1[i]; }
#pragma unroll
        for (int i = 0; i < 4; ++i) ss[i] = wave_sum(ss[i]);
#pragma unroll
        for (int i = 0; i < 4; ++i) { const float rstd = 1.f / sqrtf(ss[i] * (1.f / 128.f) + 1e-6f);
            *(unsigned*)(MIX + (size_t)(q0 + wid * 32 + i0 + i) * D + h * 128 + 2 * lane) = cvtpk(x0[i] * rstd * g0 * bflo(sg[i]), x1[i] * rstd * g1 * bfhi(sg[i])); } }
}
}

namespace att2 {
typedef short v4i16_t __attribute__((ext_vector_type(4)));
constexpr int KVBLK = 64, LDR = HSEC, NT = M / KVBLK;
constexpr int KSLOT = 8192, VSLOT = 16384, NSLOT = 4;
constexpr int OFF_K = 0, OFF_V = NSLOT * KSLOT, OFF_WS = OFF_V + NSLOT * VSLOT, OFF_END = OFF_WS + NWAVES * 64 * 4;
static_assert(OFF_END <= PHASE_LDS, "attention LDS");
__device__ __forceinline__ s16x4 vtr(const LAS unsigned char* p) { return __builtin_bit_cast(s16x4, __builtin_amdgcn_ds_read_tr16_b64_v4i16((LAS v4i16_t*)p)); }
__device__ __forceinline__ void glds16(const void* sbase, unsigned voff, unsigned lds_dst) { unsigned keep;
    asm volatile("s_mov_b32 %0, m0\n\ts_mov_b32 m0, %3\n\ts_nop 0\n\tglobal_load_lds_dwordx4 %1, %2\n\ts_mov_b32 m0, %0" : "=&s"(keep) : "v"(voff), "s"(sbase), "s"(lds_dst) : "memory"); }
#define ATT2_WAIT_BAR(N) asm volatile("s_waitcnt vmcnt(" #N ") lgkmcnt(0)\n\ts_barrier" ::: "memory")
template <bool DO_QK, bool DO_SM, bool DO_PV>
__device__ __forceinline__ void step(f32x16& sn0, f32x16& sn1, f32x16& sc0, f32x16& sc1, const u32x4& pap0, const u32x4& pap1, const u32x4& pap2, const u32x4& pap3,
                                     u32x4& pan0, u32x4& pan1, u32x4& pan2, u32x4& pan3, f32x16 (&o)[4], const bf16x8 (&qr)[4], const f32x16& negm, float& lsum,
                                     const LAS unsigned char* kc, const LAS unsigned char* knn, const LAS unsigned char* vb, bf16x8& kf0, bf16x8& kf1, bf16x8& kf2) {
    bf16x8 fr0 = kf0, fr1 = kf1, fr2 = kf2, fr3 = kf0; unsigned ca0 = 0, ca1 = 0, cb0 = 0, cb1 = 0;
    (void)ca0; (void)ca1; (void)cb0; (void)cb1;
    if (DO_QK) sn0 = __builtin_amdgcn_mfma_f32_32x32x16_bf16(fr0, qr[0], negm, 0, 0, 0);
    SBAR();
    if (DO_QK) { fr3 = *(const LAS bf16x8*)(kc + 2560); }
    if (DO_SM) { sc0[0] = ex2(sc0[0]); sc0[1] = ex2(sc0[1]); }
    SBAR();
    if (DO_QK) sn1 = __builtin_amdgcn_mfma_f32_32x32x16_bf16(fr1, qr[0], negm, 0, 0, 0);
    SBAR();
    if (DO_QK) { fr0 = *(const LAS bf16x8*)(kc + 4096); }
    if (DO_SM) { sc0[2] = ex2(sc0[2]); sc0[3] = ex2(sc0[3]); lsum += sc0[0]; lsum += sc0[1]; }
    SBAR();
    if (DO_QK) sn0 = __builtin_amdgcn_mfma_f32_32x32x16_bf16(fr2, qr[1], sn0, 0, 0, 0);
    SBAR();
    if (DO_QK) { fr1 = *(const LAS bf16x8*)(kc + 4608); }
    if (DO_SM) { sc0[4] = ex2(sc0[4]); sc0[5] = ex2(sc0[5]); lsum += sc0[2]; lsum += sc0[3]; }
    SBAR();
    if (DO_QK) sn1 = __builtin_amdgcn_mfma_f32_32x32x16_bf16(fr3, qr[1], sn1, 0, 0, 0);
    SBAR();
    if (DO_QK) { fr2 = *(const LAS bf16x8*)(kc + 6144); }
    if (DO_SM) { sc0[6] = ex2(sc0[6]); sc0[7] = ex2(sc0[7]); lsum += sc0[4]; lsum += sc0[5]; }
    SBAR();
    if (DO_QK) sn0 = __builtin_amdgcn_mfma_f32_32x32x16_bf16(fr0, qr[2], sn0, 0, 0, 0);
    SBAR();
    if (DO_QK) { fr3 = *(const LAS bf16x8*)(kc + 6656); }
    if (DO_SM) { sc0[8] = ex2(sc0[8]); sc0[9] = ex2(sc0[9]); lsum += sc0[6]; lsum += sc0[7]; }
    SBAR();
    if (DO_QK) sn1 = __builtin_amdgcn_mfma_f32_32x32x16_bf16(fr1, qr[2], sn1, 0, 0, 0);
    SBAR();
    if (DO_PV) { { const s16x4 l_ = vtr(vb + 0), h_ = vtr(vb + 256); fr0 = (bf16x8){l_[0], l_[1], l_[2], l_[3], h_[0], h_[1], h_[2], h_[3]}; } }
    if (DO_SM) { sc0[10] = ex2(sc0[10]); sc0[11] = ex2(sc0[11]); lsum += sc0[8]; lsum += sc0[9]; }
    SBAR();
    if (DO_QK) sn0 = __builtin_amdgcn_mfma_f32_32x32x16_bf16(fr2, qr[3], sn0, 0, 0, 0);
    SBAR();
    if (DO_PV) { { const s16x4 l_ = vtr(vb + 4096), h_ = vtr(vb + 4352); fr1 = (bf16x8){l_[0], l_[1], l_[2], l_[3], h_[0], h_[1], h_[2], h_[3]}; } }
    if (DO_SM) { sc0[12] = ex2(sc0[12]); sc0[13] = ex2(sc0[13]); lsum += sc0[10]; lsum += sc0[11]; }
    SBAR();
    if (DO_QK) sn1 = __builtin_amdgcn_mfma_f32_32x32x16_bf16(fr3, qr[3], sn1, 0, 0, 0);
    SBAR();
    if (DO_PV) { { const s16x4 l_ = vtr(vb + 8192), h_ = vtr(vb + 8448); fr2 = (bf16x8){l_[0], l_[1], l_[2], l_[3], h_[0], h_[1], h_[2], h_[3]}; } }
    if (DO_SM) { sc0[14] = ex2(sc0[14]); sc0[15] = ex2(sc0[15]); lsum += sc0[12]; lsum += sc0[13]; }
    SBAR();
    if (DO_PV) o[0] = __builtin_amdgcn_mfma_f32_32x32x16_bf16(__builtin_bit_cast(bf16x8, pap0), fr0, o[0], 0, 0, 0);
    SBAR();
    if (DO_PV) { { const s16x4 l_ = vtr(vb + 12288), h_ = vtr(vb + 12544); fr3 = (bf16x8){l_[0], l_[1], l_[2], l_[3], h_[0], h_[1], h_[2], h_[3]}; } }
    if (DO_SM) { sc1[0] = ex2(sc1[0]); sc1[1] = ex2(sc1[1]); lsum += sc0[14]; lsum += sc0[15]; }
    SBAR();
    if (DO_PV) o[0] = __builtin_amdgcn_mfma_f32_32x32x16_bf16(__builtin_bit_cast(bf16x8, pap1), fr1, o[0], 0, 0, 0);
    SBAR();
    if (DO_PV) { { const s16x4 l_ = vtr(vb + 512), h_ = vtr(vb + 768); fr0 = (bf16x8){l_[0], l_[1], l_[2], l_[3], h_[0], h_[1], h_[2], h_[3]}; } }
    if (DO_SM) { sc1[2] = ex2(sc1[2]); sc1[3] = ex2(sc1[3]); lsum += sc1[0]; lsum += sc1[1]; }
    SBAR();
    if (DO_PV) o[0] = __builtin_amdgcn_mfma_f32_32x32x16_bf16(__builtin_bit_cast(bf16x8, pap2), fr2, o[0], 0, 0, 0);
    SBAR();
    if (DO_PV) { { const s16x4 l_ = vtr(vb + 4608), h_ = vtr(vb + 4864); fr1 = (bf16x8){l_[0], l_[1], l_[2], l_[3], h_[0], h_[1], h_[2], h_[3]}; } }
    if (DO_SM) { sc1[4] = ex2(sc1[4]); sc1[5] = ex2(sc1[5]); lsum += sc1[2]; lsum += sc1[3]; }
    SBAR();
    if (DO_PV) o[0] = __builtin_amdgcn_mfma_f32_32x32x16_bf16(__builtin_bit_cast(bf16x8, pap3), fr3, o[0], 0, 0, 0);
    SBAR();
    if (DO_PV) { { const s16x4 l_ = vtr(vb + 8704), h_ = vtr(vb + 8960); fr2 = (bf16x8){l_[0], l_[1], l_[2], l_[3], h_[0], h_[1], h_[2], h_[3]}; } }
    if (DO_SM) { sc1[6] = ex2(sc1[6]); sc1[7] = ex2(sc1[7]); lsum += sc1[4]; lsum += sc1[5]; }
    SBAR();
    if (DO_PV) o[1] = __builtin_amdgcn_mfma_f32_32x32x16_bf16(__builtin_bit_cast(bf16x8, pap0), fr0, o[1], 0, 0, 0);
    SBAR();
    if (DO_PV) { { const s16x4 l_ = vtr(vb + 12800), h_ = vtr(vb + 13056); fr3 = (bf16x8){l_[0], l_[1], l_[2], l_[3], h_[0], h_[1], h_[2], h_[3]}; } }
    if (DO_SM) { sc1[8] = ex2(sc1[8]); sc1[9] = ex2(sc1[9]); lsum += sc1[6]; lsum += sc1[7]; }
    SBAR();
    if (DO_PV) o[1] = __builtin_amdgcn_mfma_f32_32x32x16_bf16(__builtin_bit_cast(bf16x8, pap1), fr1, o[1], 0, 0, 0);
    SBAR();
    if (DO_PV) { { const s16x4 l_ = vtr(vb + 1024), h_ = vtr(vb + 1280); fr0 = (bf16x8){l_[0], l_[1], l_[2], l_[3], h_[0], h_[1], h_[2], h_[3]}; } }
    if (DO_SM) { sc1[10] = ex2(sc1[10]); sc1[11] = ex2(sc1[11]); lsum += sc1[8]; lsum += sc1[9]; }
    SBAR();
    if (DO_PV) o[1] = __builtin_amdgcn_mfma_f32_32x32x16_bf16(__builtin_bit_cast(bf16x8, pap2), fr2, o[1], 0, 0, 0);
    SBAR();
    if (DO_PV) { { const s16x4 l_ = vtr(vb + 5120), h_ = vtr(vb + 5376); fr1 = (bf16x8){l_[0], l_[1], l_[2], l_[3], h_[0], h_[1], h_[2], h_[3]}; } }
    if (DO_SM) { sc1[12] = ex2(sc1[12]); sc1[13] = ex2(sc1[13]); lsum += sc1[10]; lsum += sc1[11]; }
    SBAR();
    if (DO_PV) o[1] = __builtin_amdgcn_mfma_f32_32x32x16_bf16(__builtin_bit_cast(bf16x8, pap3), fr3, o[1], 0, 0, 0);
    SBAR();
    if (DO_PV) { { const s16x4 l_ = vtr(vb + 9216), h_ = vtr(vb + 9472); fr2 = (bf16x8){l_[0], l_[1], l_[2], l_[3], h_[0], h_[1], h_[2], h_[3]}; } }
    if (DO_SM) { sc1[14] = ex2(sc1[14]); sc1[15] = ex2(sc1[15]); lsum += sc1[12]; lsum += sc1[13]; }
    SBAR();
    if (DO_PV) o[2] = __builtin_amdgcn_mfma_f32_32x32x16_bf16(__builtin_bit_cast(bf16x8, pap0), fr0, o[2], 0, 0, 0);
    SBAR();
    if (DO_PV) { { const s16x4 l_ = vtr(vb + 13312), h_ = vtr(vb + 13568); fr3 = (bf16x8){l_[0], l_[1], l_[2], l_[3], h_[0], h_[1], h_[2], h_[3]}; } }
    if (DO_SM) { lsum += sc1[14]; lsum += sc1[15]; ca0 = cvtpk(sc0[0], sc0[1]); ca1 = cvtpk(sc0[2], sc0[3]); }
    SBAR();
    if (DO_PV) o[2] = __builtin_amdgcn_mfma_f32_32x32x16_bf16(__builtin_bit_cast(bf16x8, pap1), fr1, o[2], 0, 0, 0);
    SBAR();
    if (DO_PV) { { const s16x4 l_ = vtr(vb + 1536), h_ = vtr(vb + 1792); fr0 = (bf16x8){l_[0], l_[1], l_[2], l_[3], h_[0], h_[1], h_[2], h_[3]}; } }
    if (DO_SM) { cb0 = cvtpk(sc0[4], sc0[5]); cb1 = cvtpk(sc0[6], sc0[7]); pan0 = (u32x4){ca0, ca1, cb0, cb1}; }
    SBAR();
    if (DO_PV) o[2] = __builtin_amdgcn_mfma_f32_32x32x16_bf16(__builtin_bit_cast(bf16x8, pap2), fr2, o[2], 0, 0, 0);
    SBAR();
    if (DO_PV) { { const s16x4 l_ = vtr(vb + 5632), h_ = vtr(vb + 5888); fr1 = (bf16x8){l_[0], l_[1], l_[2], l_[3], h_[0], h_[1], h_[2], h_[3]}; } }
    if (DO_SM) { ca0 = cvtpk(sc0[8], sc0[9]); ca1 = cvtpk(sc0[10], sc0[11]); }
    SBAR();
    if (DO_PV) o[2] = __builtin_amdgcn_mfma_f32_32x32x16_bf16(__builtin_bit_cast(bf16x8, pap3), fr3, o[2], 0, 0, 0);
    SBAR();
    if (DO_PV) { { const s16x4 l_ = vtr(vb + 9728), h_ = vtr(vb + 9984); fr2 = (bf16x8){l_[0], l_[1], l_[2], l_[3], h_[0], h_[1], h_[2], h_[3]}; } }
    if (DO_SM) { cb0 = cvtpk(sc0[12], sc0[13]); cb1 = cvtpk(sc0[14], sc0[15]); pan1 = (u32x4){ca0, ca1, cb0, cb1}; }
    SBAR();
    if (DO_PV) o[3] = __builtin_amdgcn_mfma_f32_32x32x16_bf16(__builtin_bit_cast(bf16x8, pap0), fr0, o[3], 0, 0, 0);
    SBAR();
    if (DO_PV) { { const s16x4 l_ = vtr(vb + 13824), h_ = vtr(vb + 14080); fr3 = (bf16x8){l_[0], l_[1], l_[2], l_[3], h_[0], h_[1], h_[2], h_[3]}; } }
    if (DO_SM) { ca0 = cvtpk(sc1[0], sc1[1]); ca1 = cvtpk(sc1[2], sc1[3]); }
    SBAR();
    if (DO_PV) o[3] = __builtin_amdgcn_mfma_f32_32x32x16_bf16(__builtin_bit_cast(bf16x8, pap1), fr1, o[3], 0, 0, 0);
    SBAR();
    kf0 = *(const LAS bf16x8*)(knn + 0);
    if (DO_SM) { cb0 = cvtpk(sc1[4], sc1[5]); cb1 = cvtpk(sc1[6], sc1[7]); pan2 = (u32x4){ca0, ca1, cb0, cb1}; }
    SBAR();
    if (DO_PV) o[3] = __builtin_amdgcn_mfma_f32_32x32x16_bf16(__builtin_bit_cast(bf16x8, pap2), fr2, o[3], 0, 0, 0);
    SBAR();
    kf1 = *(const LAS bf16x8*)(knn + 512);
    if (DO_SM) { ca0 = cvtpk(sc1[8], sc1[9]); ca1 = cvtpk(sc1[10], sc1[11]); }
    SBAR();
    if (DO_PV) o[3] = __builtin_amdgcn_mfma_f32_32x32x16_bf16(__builtin_bit_cast(bf16x8, pap3), fr3, o[3], 0, 0, 0);
    SBAR();
    kf2 = *(const LAS bf16x8*)(knn + 2048);
    if (DO_SM) { cb0 = cvtpk(sc1[12], sc1[13]); cb1 = cvtpk(sc1[14], sc1[15]); pan3 = (u32x4){ca0, ca1, cb0, cb1}; }
    SBAR();
}

__device__ __forceinline__ void unit(LAS unsigned char* lds, int h, int q0, const bf16_t* __restrict__ QD, const bf16_t* __restrict__ KD, const bf16_t* __restrict__ VD,
                                     const unsigned* KMAX2, float* O0S, float lam, const float* __restrict__ subg, bf16_t* MIX) {
    const int tid = opaque_tid(), wid = __builtin_amdgcn_readfirstlane(tid >> 6), lane = tid & 63, r32 = lane & 31, hi = lane >> 5;
    const unsigned lds0 = (unsigned)(uintptr_t)lds;
    LAS float* ws = (LAS float*)(lds + OFF_WS) + wid * 64;
    const LAS unsigned char* kbase = lds + OFF_K + hi * 1024 + r32 * 16;
    const LAS unsigned char* vbase = lds + OFF_V + (((lane & 3) << 3) | (((lane >> 2) & 3) << 6) | (((lane >> 4) & 1) << 5) | (((lane >> 5) & 1) << 11));
    const unsigned voK = (unsigned)((lane * LDR + wid * 8) * 2);
    unsigned voV[2];
    { const int kk = 8 * wid + ((lane & 31) >> 2), key = (kk & ~0xC) | ((kk & 4) << 1) | ((kk & 8) >> 1);
#pragma unroll
      for (int j = 0; j < 2; ++j) voV[j] = (unsigned)((key * LDR + (2 * j + (lane >> 5)) * 32 + (lane & 3) * 8) * 2); }
    const unsigned kdst = lds0 + OFF_K + wid * 1024, vdst = lds0 + OFF_V + wid * 2048;
#pragma unroll 1
    for (int mp = 0; mp < 2; ++mp) {
        const bf16_t* Kh = KD + h * 128 + mp * 64; const bf16_t* Vh = VD + h * 128;
        const bf16_t* Qw = QD + (size_t)(q0 + wid * 32 + r32) * LDR + h * 128 + mp * 64 + hi * 8;
#define ATT2_DMA_K(t) do { const int t_ = (t) < NT ? (t) : NT - 1; glds16((const char*)Kh + (size_t)t_ * (KVBLK * LDR * 2), voK, (unsigned)__builtin_amdgcn_readfirstlane(kdst + ((t) & 3) * KSLOT)); } while (0)
#define ATT2_DMA_V(t) do { const int t_ = (t) < NT ? (t) : NT - 1; const char* vs_ = (const char*)Vh + (size_t)t_ * (KVBLK * LDR * 2); const unsigned vd_ = (unsigned)__builtin_amdgcn_readfirstlane(vdst + ((t) & 3) * VSLOT); \
        glds16(vs_, voV[0], vd_); glds16(vs_, voV[1], vd_ + 1024); } while (0)
        ATT2_DMA_K(0); ATT2_DMA_K(1); ATT2_DMA_K(2); ATT2_DMA_V(0);
        bf16x8 qr[4]; float qq = 0.f;
#pragma unroll
        for (int d0 = 0; d0 < 4; ++d0) { qr[d0] = *reinterpret_cast<const bf16x8*>(Qw + d0 * 16);
#pragma unroll
            for (int j = 0; j < 8; ++j) { const float q = bf2f((unsigned short)qr[d0][j]); qq += q * q; } }
        { auto rr = __builtin_amdgcn_permlane32_swap(__float_as_uint(qq), __float_as_uint(qq), false, false); qq = __uint_as_float(rr[0]) + __uint_as_float(rr[1]); }
        const float mref = sqrtf(qq * __uint_as_float(KMAX2[(h * 2 + mp) * 64])) * 1.001f;
        f32x16 negm;
#pragma unroll
        for (int r = 0; r < 16; ++r) negm[r] = -mref;
        f32x16 o[4] = {}; float lsum = 0.f;
        f32x16 sA0, sA1, sB0, sB1; u32x4 pX0, pX1, pX2, pX3, pY0, pY1, pY2, pY3;
        sA0 = f32x16{}; sA1 = f32x16{}; sB0 = f32x16{}; sB1 = f32x16{}; pX0 = pX1 = pX2 = pX3 = pY0 = pY1 = pY2 = pY3 = (u32x4){0u, 0u, 0u, 0u};
        bf16x8 kf0, kf1, kf2;
        ATT2_WAIT_BAR(0);
        kf0 = *(const LAS bf16x8*)(kbase); kf1 = *(const LAS bf16x8*)(kbase + 512); kf2 = *(const LAS bf16x8*)(kbase + 2048);
#define KS(t) (kbase + ((t) & 3) * KSLOT)
#define VS(t) (vbase + ((t) & 3) * VSLOT)
        ATT2_DMA_K(3); ATT2_DMA_V(1);
        step<true, false, false>(sA0, sA1, sB0, sB1, pX0, pX1, pX2, pX3, pY0, pY1, pY2, pY3, o, qr, negm, lsum, KS(0), KS(1), VS(0), kf0, kf1, kf2);
        ATT2_WAIT_BAR(3);
        ATT2_DMA_K(4); ATT2_DMA_V(2);
        step<true, true, false>(sB0, sB1, sA0, sA1, pY0, pY1, pY2, pY3, pX0, pX1, pX2, pX3, o, qr, negm, lsum, KS(1), KS(2), VS(0), kf0, kf1, kf2);
        ATT2_WAIT_BAR(3);
#pragma unroll 1
        for (int i = 1; i + 1 < NT - 1; i += 2) {
            ATT2_DMA_K(i + 4); ATT2_DMA_V(i + 2);
            step<true, true, true>(sA0, sA1, sB0, sB1, pX0, pX1, pX2, pX3, pY0, pY1, pY2, pY3, o, qr, negm, lsum, KS(i + 1), KS(i + 2), VS(i - 1), kf0, kf1, kf2);
            ATT2_WAIT_BAR(3);
            ATT2_DMA_K(i + 5); ATT2_DMA_V(i + 3);
            step<true, true, true>(sB0, sB1, sA0, sA1, pY0, pY1, pY2, pY3, pX0, pX1, pX2, pX3, o, qr, negm, lsum, KS(i + 2), KS(i + 3), VS(i), kf0, kf1, kf2);
            ATT2_WAIT_BAR(3);
        }
        step<false, true, true>(sA0, sA1, sB0, sB1, pX0, pX1, pX2, pX3, pY0, pY1, pY2, pY3, o, qr, negm, lsum, KS(0), KS(0), VS(NT - 2), kf0, kf1, kf2);
        ATT2_WAIT_BAR(0);
        step<false, false, true>(sB0, sB1, sA0, sA1, pY0, pY1, pY2, pY3, pX0, pX1, pX2, pX3, o, qr, negm, lsum, KS(0), KS(0), VS(NT - 1), kf0, kf1, kf2);
        ATT2_WAIT_BAR(0);
#undef KS
#undef VS
#undef ATT2_DMA_K
#undef ATT2_DMA_V
        { auto rr = __builtin_amdgcn_permlane32_swap(__float_as_uint(lsum), __float_as_uint(lsum), false, false); lsum = __uint_as_float(rr[0]) + __uint_as_float(rr[1]); }
        if (hi == 0) ws[r32] = lsum; asm volatile("s_waitcnt lgkmcnt(0)" ::: "memory");
        int rowb = q0 + wid * 32; asm volatile("" : "+s"(rowb));
        float rli[16];
#pragma unroll
        for (int r = 0; r < 16; ++r) rli[r] = __builtin_amdgcn_rcpf(ws[crow(r, hi)]);
        float* o0p = O0S + tid; asm volatile("" : "+v"(o0p));
        if (mp == 0) {
#pragma unroll
            for (int d0 = 0; d0 < 4; ++d0)
#pragma unroll
                for (int r = 0; r < 16; ++r) o0p[(d0 * 16 + r) * 512] = o[d0][r] * rli[r];
        } else {
            float ss[16];
#pragma unroll
            for (int r = 0; r < 16; ++r) ss[r] = 0.f;
#pragma unroll
            for (int d0 = 0; d0 < 4; ++d0)
#pragma unroll
                for (int r = 0; r < 16; ++r) { const float c = o0p[(d0 * 16 + r) * 512] - lam * o[d0][r] * rli[r]; o[d0][r] = c; ss[r] += c * c; }
#pragma unroll
            for (int r = 0; r < 16; ++r) {
                ss[r] += lane_xor<1>(ss[r]); ss[r] += lane_xor<2>(ss[r]); ss[r] += lane_xor<4>(ss[r]); ss[r] += lane_xor<8>(ss[r]); ss[r] += lane_xor<16>(ss[r]);
                ss[r] = 0.8f / sqrtf(ss[r] * (1.f / 128.f) + 1e-5f); }
#pragma unroll
            for (int d0 = 0; d0 < 4; ++d0) { const float g = subg[d0 * 32 + r32];
#pragma unroll
                for (int r = 0; r < 16; ++r) MIX[(size_t)(rowb + crow(r, hi)) * D + 512 + h * 128 + d0 * 32 + r32] = (bf16_t)f2bf(o[d0][r] * ss[r] * g); }
        }
        asm volatile("s_waitcnt vmcnt(0) lgkmcnt(0)\n\ts_barrier" ::: "memory");
    }
}
__device__ __forceinline__ void kmax_rows(LAS unsigned char* lds, const bf16_t* KD, unsigned* KMAX2, int gw, int ngw, int lane, int wave) {
    float mx = 0.f;
    for (int row0 = gw; row0 < M; row0 += 8 * ngw) { u32x4 w[8];
#pragma unroll
        for (int i = 0; i < 8; ++i) { const int row = row0 + i * ngw; w[i] = row < M ? *(const GAS u32x4*)(KD + (size_t)row * HSEC + lane * 8) : (u32x4){0u, 0u, 0u, 0u}; }
#pragma unroll
        for (int i = 0; i < 8; ++i) { const u32x4 v = w[i];
            float s = bflo(v.x) * bflo(v.x) + bfhi(v.x) * bfhi(v.x) + bflo(v.y) * bflo(v.y) + bfhi(v.y) * bfhi(v.y) + bflo(v.z) * bflo(v.z) + bfhi(v.z) * bfhi(v.z) + bflo(v.w) * bflo(v.w) + bfhi(v.w) * bfhi(v.w);
            s += lane_xor<1>(s); s += lane_xor<2>(s); s += lane_xor<4>(s); mx = fmaxf(mx, s); } }
    LAS float* red = (LAS float*)lds; if ((lane & 7) == 0) red[wave * 8 + (lane >> 3)] = mx;
    LDS_WAIT(); __syncthreads();
    if (wave == 0 && lane < 8) { float m = red[lane];
#pragma unroll
        for (int w = 1; w < NWAVES; ++w) m = fmaxf(m, red[w * 8 + lane]);
        atomicMax(KMAX2 + lane * 64, __float_as_uint(m)); }
    __syncthreads();
}
}

__device__ __forceinline__ void route16(const bf16_t* X2B, const u32x4* WRB, const float* rgb, const float* reb,
                                        float* RSTD, int* TOKE, float* TOKW, int* TOKR, unsigned* GCNT, int row0, int lane, LAS float* wl, bool dry = false) {
    typedef float f32x4_ __attribute__((ext_vector_type(4)));
    const int r = lane & 15, q = lane >> 4;
    LAS unsigned* lc = (LAS unsigned*)(wl + 800);
    if (lane < 32) lc[lane] = 0u;
    f32x4_ acc[3]; acc[0] = (f32x4_){0.f, 0.f, 0.f, 0.f}; acc[1] = acc[0]; acc[2] = acc[0];
    float ssq = 0.f;
    const bf16_t* xp = X2B + (size_t)(row0 + r) * D + 8 * q;
#pragma unroll 8
    for (int ks = 0; ks < 32; ++ks) {
        const u32x4 xw = *(const GAS u32x4*)(xp + ks * 32);
        ssq += (bflo(xw.x) * bflo(xw.x) + bfhi(xw.x) * bfhi(xw.x)) + (bflo(xw.y) * bflo(xw.y) + bfhi(xw.y) * bfhi(xw.y)) + (bflo(xw.z) * bflo(xw.z) + bfhi(xw.z) * bfhi(xw.z)) + (bflo(xw.w) * bflo(xw.w) + bfhi(xw.w) * bfhi(xw.w));
        const bf16x8 xh = __builtin_bit_cast(bf16x8, xw);
#pragma unroll
        for (int nt = 0; nt < 3; ++nt) {
            const bf16x8 wh = __builtin_bit_cast(bf16x8, WRB[((ks * 3 + nt) * 2 + 0) * 64 + lane]), wlo = __builtin_bit_cast(bf16x8, WRB[((ks * 3 + nt) * 2 + 1) * 64 + lane]);
            acc[nt] = __builtin_amdgcn_mfma_f32_16x16x32_bf16(wh, xh, acc[nt], 0, 0, 0);
            acc[nt] = __builtin_amdgcn_mfma_f32_16x16x32_bf16(wlo, xh, acc[nt], 0, 0, 0);
        }
    }
    ssq += lane_xor<16>(ssq);
    { auto rr = __builtin_amdgcn_permlane32_swap(__float_as_uint(ssq), __float_as_uint(ssq), false, false); ssq = __uint_as_float(rr[0]) + __uint_as_float(rr[1]); }
    const float rstd = 1.f / sqrtf(ssq * (1.f / 1024.f) + 1e-6f);
#pragma unroll
    for (int nt = 0; nt < 3; ++nt) *(LAS f32x4_*)(wl + r * 48 + nt * 16 + 4 * q) = acc[nt] * rstd;
    LDS_WAIT();
    float lg[36];
#pragma unroll
    for (int n4 = 0; n4 < 9; ++n4) { const f32x4_ t = *(const LAS f32x4_*)(wl + r * 48 + 4 * n4); lg[4 * n4] = t[0]; lg[4 * n4 + 1] = t[1]; lg[4 * n4 + 2] = t[2]; lg[4 * n4 + 3] = t[3]; }
    float gl[4];
#pragma unroll
    for (int g = 0; g < 4; ++g) gl[g] = lg[g] + rgb[g];
    int gi = 0; float gm = gl[0];
#pragma unroll
    for (int g = 1; g < 4; ++g) if (gl[g] > gm) { gm = gl[g]; gi = g; }
    float gs = 0.f;
#pragma unroll
    for (int g = 0; g < 4; ++g) gs += __expf(gl[g] - gm);
    const float gp = 1.f / gs;
    float e[8];
#pragma unroll
    for (int j = 0; j < 8; ++j) { const float a0 = lg[4 + j] + reb[j], a1 = lg[12 + j] + reb[8 + j], a2 = lg[20 + j] + reb[16 + j], a3 = lg[28 + j] + reb[24 + j];
        e[j] = gi == 0 ? a0 : gi == 1 ? a1 : gi == 2 ? a2 : a3; }
    int i1 = 0; float m1 = e[0];
#pragma unroll
    for (int j = 1; j < 8; ++j) if (e[j] > m1) { m1 = e[j]; i1 = j; }
    int i2 = 0; float m2 = -3.0e38f;
#pragma unroll
    for (int j = 0; j < 8; ++j) if (j != i1 && e[j] > m2) { m2 = e[j]; i2 = j; }
    const float p2 = __expf(m2 - m1);
    const float w1 = gp / (1.f + p2), w2 = gp * p2 / (1.f + p2);
    if (q == 0 && !dry) { const int row = row0 + r; const int e1 = gi * 8 + i1, e2 = gi * 8 + i2;
        const int r1 = (int)__hip_atomic_fetch_add(lc + e1, 1u, __ATOMIC_RELAXED, __HIP_MEMORY_SCOPE_WORKGROUP), r2 = (int)__hip_atomic_fetch_add(lc + e2, 1u, __ATOMIC_RELAXED, __HIP_MEMORY_SCOPE_WORKGROUP);
        RSTD[row] = rstd; TOKE[row * 2] = e1; TOKE[row * 2 + 1] = e2; TOKW[row * 2] = w1; TOKW[row * 2 + 1] = w2; TOKR[row * 2] = r1; TOKR[row * 2 + 1] = r2; }
    LDS_WAIT();
    if (lane < 32 && !dry) GCNT[(row0 >> 4) * 32 + lane] = lc[lane];
}
__device__ __forceinline__ void build_tile_prefix(volatile LAS int* tb, const unsigned* CNT) {
    if (threadIdx.x == 0) { int acc = 0;
        for (int e = 0; e < 32; ++e) { tb[e] = acc; const int c = (int)__hip_atomic_load(CNT + e * CNT_STRIDE, __ATOMIC_RELAXED, __HIP_MEMORY_SCOPE_AGENT); tb[64 + e] = c; acc += (c + 127) >> 7; }
        tb[32] = acc; }
    LDS_WAIT(); __syncthreads();
}
__device__ __forceinline__ void sort_slots(LAS unsigned char* lds, volatile LAS int* tb, const unsigned* GCNT, const int* TOKE, const int* TOKR, int* TOKS, int* PERM, const float* RSTD, float* RSLOT, unsigned* CNT, int blk, int nblk) {
    const int t = opaque_tid(), e = t & 31, j = t >> 5; constexpr int NG = M / 16;
    const int gpb = (NG + nblk - 1) / nblk, g0 = blk * gpb, g1 = g0 + gpb < NG ? g0 + gpb : NG;
    LAS int* part = (LAS int*)lds; LAS int* part2 = part + 512; LAS int* tot = part2 + 512; LAS int* base0 = tot + 32;
    int s = 0, s2 = 0;
    for (int g = j; g < NG; g += 16) { const int c = (int)GCNT[g * 32 + e]; s += c; s2 += g < g0 ? c : 0; }
    part[j * 32 + e] = s; part2[j * 32 + e] = s2;
    LDS_WAIT(); __syncthreads();
    if (t < 32) { int a = 0, b = 0;
#pragma unroll
        for (int jj = 0; jj < 16; ++jj) { a += part[jj * 32 + t]; b += part2[jj * 32 + t]; }
        tot[t] = a; base0[t] = b; if (blk == 0) __hip_atomic_store(CNT + t * CNT_STRIDE, (unsigned)a, __ATOMIC_RELAXED, __HIP_MEMORY_SCOPE_AGENT); }
    LDS_WAIT(); __syncthreads();
    if (t == 0) { int acc = 0; for (int ee = 0; ee < 32; ++ee) { tb[ee] = acc; tb[64 + ee] = tot[ee]; acc += (tot[ee] + 127) >> 7; } tb[32] = acc; }
    LDS_WAIT(); __syncthreads();
    for (int idx = t; idx < (g1 - g0) * 32; idx += 512) { const int gi = idx >> 5, p = (g0 + gi) * 32 + (idx & 31), ex = TOKE[p]; int base = base0[ex];
        for (int g = g0; g < g0 + gi; ++g) base += (int)GCNT[g * 32 + ex];
        const int slot = tb[ex] * 128 + base + TOKR[p]; TOKS[p] = slot; PERM[slot] = p >> 1; RSLOT[slot] = RSTD[p >> 1]; }
}
template <int NR>
__device__ __forceinline__ void final_rows(const bf16_t* X2B, float* OUT, const unsigned char* Y, const int* TOKS, const float* TOKW, const float* gain, int m0, int stride, int lane) {
    typedef float f32x2_ __attribute__((ext_vector_type(2)));
    int s0[NR], s1[NR]; float w0[NR], w1[NR];
#pragma unroll
    for (int i = 0; i < NR; ++i) { const int row = m0 + i * stride; s0[i] = TOKS[row * 2]; s1[i] = TOKS[row * 2 + 1]; w0[i] = TOKW[row * 2] * (1.f / F8_YSCALE); w1[i] = TOKW[row * 2 + 1] * (1.f / F8_YSCALE); }
    u32x2 xx[NR][4]; unsigned ya[NR][4], yb[NR][4];
#pragma unroll
    for (int i = 0; i < NR; ++i) { const int row = m0 + i * stride;
        const GAS u32x2* xr = (const GAS u32x2*)(X2B + (size_t)row * D) + lane; const GAS unsigned* y0 = (const GAS unsigned*)(Y + (size_t)s0[i] * D) + lane; const GAS unsigned* y1 = (const GAS unsigned*)(Y + (size_t)s1[i] * D) + lane;
#pragma unroll
        for (int j = 0; j < 4; ++j) { xx[i][j] = xr[64 * j]; ya[i][j] = y0[64 * j]; yb[i][j] = y1[64 * j]; } }
#pragma unroll
    for (int i = 0; i < NR; ++i) { const int row = m0 + i * stride; f32x4 v[4]; float s = 0.f;
#pragma unroll
        for (int j = 0; j < 4; ++j) { const u32x2 x_ = xx[i][j];
            const f32x2_ a0 = __builtin_amdgcn_cvt_pk_f32_fp8((int)ya[i][j], false), a1 = __builtin_amdgcn_cvt_pk_f32_fp8((int)ya[i][j], true), b0 = __builtin_amdgcn_cvt_pk_f32_fp8((int)yb[i][j], false), b1 = __builtin_amdgcn_cvt_pk_f32_fp8((int)yb[i][j], true);
            v[j].x = bflo(x_.x) + w0[i] * a0[0] + w1[i] * b0[0]; v[j].y = bfhi(x_.x) + w0[i] * a0[1] + w1[i] * b0[1]; v[j].z = bflo(x_.y) + w0[i] * a1[0] + w1[i] * b1[0]; v[j].w = bfhi(x_.y) + w0[i] * a1[1] + w1[i] * b1[1];
            s += (v[j].x * v[j].x + v[j].y * v[j].y) + (v[j].z * v[j].z + v[j].w * v[j].w); }
        const float rstd = 1.f / sqrtf(wave_sum(s) * (1.f / 1024.f) + 1e-6f);
        GAS f32x4* orow = (GAS f32x4*)(OUT + (size_t)row * D) + lane;
#pragma unroll
        for (int j = 0; j < 4; ++j) { const f32x4 g = ((const GAS f32x4*)gain)[64 * j + lane]; orow[64 * j] = v[j] * rstd * g; } }
}
__device__ __forceinline__ void final_rows_piped(const bf16_t* X2B, float* OUT, const unsigned char* Y, const int* TOKS, const float* TOKW, const float* gain, int m0, int stride, int lane) {
    typedef float f32x2_ __attribute__((ext_vector_type(2)));
    if (m0 >= M) return;
    f32x4 g[4];
#pragma unroll
    for (int j = 0; j < 4; ++j) g[j] = ((const GAS f32x4*)gain)[64 * j + lane];
    u32x2 xc[4], xn[4]; unsigned ac[4], bc[4], an[4], bn[4];
    int s0n, s1n; float w0c, w1c, w0n, w1n, w0f = 0.f, w1f = 0.f; int s0f = 0, s1f = 0;
#define FR_META(row_, s0_, s1_, w0_, w1_) do { s0_ = TOKS[(row_) * 2]; s1_ = TOKS[(row_) * 2 + 1]; w0_ = TOKW[(row_) * 2] * (1.f / F8_YSCALE); w1_ = TOKW[(row_) * 2 + 1] * (1.f / F8_YSCALE); } while (0)
#define FR_LOAD(row_, s0_, s1_, x_, a_, b_) do { const GAS u32x2* xr_ = (const GAS u32x2*)(X2B + (size_t)(row_) * D) + lane; const GAS unsigned* y0_ = (const GAS unsigned*)(Y + (size_t)(s0_) * D) + lane; \
        const GAS unsigned* y1_ = (const GAS unsigned*)(Y + (size_t)(s1_) * D) + lane; _Pragma("unroll") for (int j = 0; j < 4; ++j) { x_[j] = xr_[64 * j]; a_[j] = y0_[64 * j]; b_[j] = y1_[64 * j]; } } while (0)
    { int s0c, s1c; FR_META(m0, s0c, s1c, w0c, w1c); FR_LOAD(m0, s0c, s1c, xc, ac, bc); }
    if (m0 + stride < M) FR_META(m0 + stride, s0n, s1n, w0n, w1n); else { s0n = 0; s1n = 0; w0n = 0.f; w1n = 0.f; }
#pragma unroll 1
    for (int row = m0; row < M; row += stride) {
        const int r1 = row + stride, r2 = row + 2 * stride;
        if (r2 < M) FR_META(r2, s0f, s1f, w0f, w1f);
        if (r1 < M) FR_LOAD(r1, s0n, s1n, xn, an, bn);
        f32x4 v[4]; float s = 0.f;
#pragma unroll
        for (int j = 0; j < 4; ++j) { const u32x2 x_ = xc[j];
            const f32x2_ a0 = __builtin_amdgcn_cvt_pk_f32_fp8((int)ac[j], false), a1 = __builtin_amdgcn_cvt_pk_f32_fp8((int)ac[j], true), b0 = __builtin_amdgcn_cvt_pk_f32_fp8((int)bc[j], false), b1 = __builtin_amdgcn_cvt_pk_f32_fp8((int)bc[j], true);
            v[j].x = bflo(x_.x) + w0c * a0[0] + w1c * b0[0]; v[j].y = bfhi(x_.x) + w0c * a0[1] + w1c * b0[1]; v[j].z = bflo(x_.y) + w0c * a1[0] + w1c * b1[0]; v[j].w = bfhi(x_.y) + w0c * a1[1] + w1c * b1[1];
            s += (v[j].x * v[j].x + v[j].y * v[j].y) + (v[j].z * v[j].z + v[j].w * v[j].w); }
        const float rstd = 1.f / sqrtf(wave_sum(s) * (1.f / 1024.f) + 1e-6f);
        GAS f32x4* orow = (GAS f32x4*)(OUT + (size_t)row * D) + lane;
#pragma unroll
        for (int j = 0; j < 4; ++j) orow[64 * j] = v[j] * rstd * g[j];
#pragma unroll
        for (int j = 0; j < 4; ++j) { xc[j] = xn[j]; ac[j] = an[j]; bc[j] = bn[j]; }
        w0c = w0n; w1c = w1n; s0n = s0f; s1n = s1f; w0n = w0f; w1n = w1f;
    }
#undef FR_META
#undef FR_LOAD
}

#ifndef MK_N_LAUNCHES
#define MK_N_LAUNCHES 1
#endif
constexpr int N_PHASES = 12;
struct Args { const void* in[18]; float* out; unsigned char* ws; int ph_lo, ph_hi; };
static_assert(sizeof(Args) == 18 * 8 + 8 + 8 + 8, "Args has no padding");

__global__ void __launch_bounds__(NWAVES * 64, 2) mk_fwd(Args args) {
    extern __shared__ __attribute__((aligned(16))) unsigned char lds_raw[];
    LAS unsigned char* lds = (LAS unsigned char*)lds_raw;
    volatile LAS unsigned* MISC = (volatile LAS unsigned*)(lds + MISC_OFF);
    const int G = gridDim.x, bx = blockIdx.x, vcu = (G % 8 == 0) ? (bx % 8) * (G / 8) + bx / 8 : bx;
    const int NGW = G * NWAVES;
#define PHASE_IDS const int tid = opaque_tid(), lane = tid & 63, wave = __builtin_amdgcn_readfirstlane(tid >> 6), gw = vcu * NWAVES + wave; (void)lane; (void)gw
    const __attribute__((address_space(4))) Args* A = (const __attribute__((address_space(4))) Args*)__builtin_amdgcn_kernarg_segment_ptr();
    asm volatile("" : "+s"(A));
#define ARGF(i) ((const float*)A->in[i])
#define WSP(T, off) ((T*)(A->ws + (off)))
#define x_in ARGF(0)
#define positions ((const int*)A->in[1])
#define norm1_gain ARGF(2)
#define w_in ARGF(3)
#define hg_lb ARGF(4)
#define hg_norm_gain ARGF(5)
#define diff_lambda ARGF(6)
#define subln_gain ARGF(7)
#define w_out ARGF(8)
#define norm2_gain ARGF(9)
#define rg_w ARGF(10)
#define rg_b ARGF(11)
#define re_w ARGF(12)
#define re_b ARGF(13)
#define w_gate ARGF(14)
#define w_up ARGF(15)
#define w_down ARGF(16)
#define final_gain ARGF(17)
#define out (A->out)
#define cosT WSP(float, WS_ROPE)
#define sinT (WSP(float, WS_ROPE) + M * 8)
#define HD WSP(float, WS_HD)
#define TOKE WSP(int, WS_TOKE)
#define TOKW WSP(float, WS_TOKW)
#define TOKR WSP(int, WS_TOKR)
#define TOKS WSP(int, WS_TOKS)
#define LAMP WSP(float, WS_LAM)
#define WOUT WSP(bf16_t, WS_WOUT)
#define WIN WSP(bf16_t, WS_WIN)
#define XN WSP(bf16_t, WS_XN)
#define QH WSP(bf16_t, WS_QH)
#define VH WSP(bf16_t, WS_VH)
#define SG WSP(bf16_t, WS_SG)
#define QD WSP(bf16_t, WS_QD)
#define KD WSP(bf16_t, WS_KD)
#define VD WSP(bf16_t, WS_VD)
#define GF WSP(half_t, WS_GF)
#define GB WSP(half_t, WS_GB)
#define HS WSP(float, WS_HS)
#define HL WSP(float, WS_HL)
#define OF WSP(float, WS_OF)
#define OB WSP(float, WS_OB)
#define MIX WSP(bf16_t, WS_MIX)
#define X2B WSP(bf16_t, WS_X2B)
#define X2F8 WSP(unsigned char, WS_X2F8)
#define WGU WSP(unsigned char, WS_WGU)
#define WD WSP(unsigned char, WS_WD)
#define HGb WSP(bf16_t, WS_HG)
#define HM WSP(unsigned char, WS_HM)
#define Y WSP(unsigned char, WS_Y)
#define CNT (WSP(unsigned, WS_CTL) + CW_CNT)
    unsigned* ctl = WSP(unsigned, WS_CTL);
    volatile LAS int* tb = (volatile LAS int*)(MISC + 16);

    if (threadIdx.x < 64) MISC[threadIdx.x] = 0u;
    __syncthreads();
    XcdBarrier bar; bar.bar = ctl + CW_BAR; bar.x = 0; bar.st = nullptr;
    const int lo = A->ph_lo, hi = A->ph_hi;
    if (hi - lo > 1) bar = xcd_barrier_post(ctl + CW_BAR, MISC);
#ifndef PH_MASK
#define PH_MASK 0xFFF
#endif
#define IN(k) (((PH_MASK >> (k)) & 1) && lo <= (k) && (k) < hi)
#ifndef DOUBLE_PHASE
#define DOUBLE_PHASE -1
#endif
#define REP(k) for (int rep_ = 0; rep_ < ((DOUBLE_PHASE) == (k) ? 2 : 1); ++rep_)
#ifndef BAR_REPS
#define BAR_REPS 1
#endif
#ifdef DIAG_SPAN_A
#define STAMP(k) do { if (blockIdx.x == 0 && threadIdx.x == 0) WSP(unsigned long long, WS_LAM + 64)[k] = __builtin_amdgcn_s_memrealtime(); } while (0)
#else
#define STAMP(k) do { } while (0)
#endif
#define SEAM(k) do { if (IN(k) && IN((k) + 1)) for (int b_ = 0; b_ < BAR_REPS; ++b_) xcd_barrier(bar); STAMP((k) + 1); } while (0)

    STAMP(0);
    if (IN(0)) REP(0) { PHASE_IDS;
        LAS float* scr = (LAS float*)(lds + wave * 16384);
        constexpr int I_IN = (D / 64) * (NIN / 32), I_OUT = (D / 64) * (D / 32);
        { XposeRegs R;
#define P0_LOAD(it_) do { if ((it_) < I_IN) xpose_load(R, w_in, D, NIN, (it_), lane); else xpose_load(R, w_out, D, D, (it_) - I_IN, lane); } while (0)
            if (gw < I_IN + I_OUT) P0_LOAD(gw);
            for (int it = gw; it < I_IN + I_OUT; it += NGW) { const XposeRegs C = R; const int nx = it + NGW;
                if (nx < I_IN + I_OUT) P0_LOAD(nx);
                if (it < I_IN) xpose_store(C, D, NIN, WIN, 0, 1, scr, it, lane); else xpose_store(C, D, D, WOUT, 0, 1, scr, it - I_IN, lane); }
#undef P0_LOAD
        }
        rms_rows_piped(x_in, norm1_gain, XN, gw, NGW, lane, 1e-6f);
        for (int id = bx * 512 + tid; id < M * 8; id += G * 512) {
            const int i = id & 7; const float invf[8] = {1.0f, 0.19392274474868576f, 0.03760603093086393f, 0.007292664737217109f, 0.001414213562373095f, 0.0002742481756762073f, 5.318295896944988e-05f, 1.031338537721246e-05f};
            float f = invf[0];
#pragma unroll
            for (int q = 1; q < 8; ++q) f = (i == q) ? invf[q] : f;
            const float ang = (float)positions[id >> 3] * f;
            const double rev = (double)ang * 0.15915494309189535; const float fr = (float)(rev - __builtin_rint(rev));
            cosT[id] = __builtin_amdgcn_cosf(fr); sinT[id] = __builtin_amdgcn_sinf(fr);
        }
        for (int id = bx * 512 + tid; id < 32 * 3 * 2 * 64; id += G * 512) {
            const int ln = id & 63, part = (id >> 6) & 1, nt = (id >> 7) % 3, ks = (id >> 7) / 3, n = nt * 16 + (ln & 15), k0 = ks * 32 + 8 * (ln >> 4); unsigned w[4];
#pragma unroll
            for (int jj = 0; jj < 4; ++jj) { float v[2];
#pragma unroll
                for (int u = 0; u < 2; ++u) { const int k = k0 + 2 * jj + u; const float wv = (n < 4 ? rg_w[k * 4 + n] : n < 36 ? re_w[k * 32 + (n - 4)] : 0.f) * norm2_gain[k];
                    const float hv = bf2f(f2bf(wv)); v[u] = part ? wv - hv : hv; }
                w[jj] = pk2(v[0], v[1]); }
            WSP(u32x4, WS_WR)[id] = (u32x4){w[0], w[1], w[2], w[3]}; }
        if (bx == 0 && wave == 0) { const float a = wave_sum(diff_lambda[lane] * diff_lambda[64 + lane]), b = wave_sum(diff_lambda[128 + lane] * diff_lambda[192 + lane]);
            if (lane == 0) LAMP[0] = __expf(a) - __expf(b) + 0.2f; }
    }
    SEAM(0);
    if (IN(1)) REP(1) {
        pg8::Gemm g{XN, WIN, M, NIN, D}; pg8::StaticOrder S; S.init(M, NIN, G, bx);
        EpiInProj E{QH, VH, SG, QD, KD, VD, GF, GB, hg_lb, cosT, sinT};
        pg8::gemm_phase<EpiInProj, pg8::StaticOrder, true, true>(lds, g, S, E);
    }
    SEAM(1);
    if (IN(2)) REP(2) { for (int u = vcu; u < 256; u += G) hg::pass<false>(lds, u, QH, VH, GF, GB, HL, HD, HS, OF, OB);
        { PHASE_IDS; att2::kmax_rows(lds, KD, WSP(unsigned, WS_CTL) + CW_KMAX, gw, NGW, lane, wave); } }
    SEAM(2);
    if (IN(3)) REP(3) hg::scan(HL, HD, HS, bx * 512 + opaque_tid(), G * 512);
    SEAM(3);
    if (IN(4)) REP(4) { for (int u = vcu; u < 256; u += G) hg::pass<true>(lds, u, QH, VH, GF, GB, HL, HD, HS, OF, OB); }
    SEAM(4);
    if (IN(5)) REP(5) { PHASE_IDS;
#ifdef DIAG_CLOCK
        if (blockIdx.x == 0 && threadIdx.x == 0) { WSP(unsigned long long, WS_LAM + 64)[20] = __builtin_amdgcn_s_memtime(); WSP(unsigned long long, WS_LAM + 64)[21] = __builtin_amdgcn_s_memrealtime(); }
#endif
        const float lam = LAMP[0];
        for (int u = vcu; u < 256; u += G) { const int h = u >> 6, q0 = (u & 63) * 256;
            int ln = lane; asm volatile("" : "+v"(ln));
            att::hgrn_finalize(h, q0, OF, OB, SG, hg_norm_gain, MIX, wave, ln);
            att2::unit(lds, h, q0, QD, KD, VD, WSP(unsigned, WS_CTL) + CW_KMAX, WSP(float, WS_O0S) + (size_t)bx * 32768, lam, subln_gain, MIX); }
    }
#ifdef DIAG_CLOCK
    if (blockIdx.x == 0 && threadIdx.x == 0) { WSP(unsigned long long, WS_LAM + 64)[22] = __builtin_amdgcn_s_memtime(); WSP(unsigned long long, WS_LAM + 64)[23] = __builtin_amdgcn_s_memrealtime(); }
#endif
    SEAM(5);
    if (IN(6)) REP(6) {
        pg8::Gemm g{MIX, WOUT, M, D, D}; pg8::StaticOrder S; S.init(M, D, G, bx);
        EpiResid E{x_in, X2B, X2F8};
        pg8::gemm_phase<EpiResid, pg8::StaticOrder, true, true>(lds, g, S, E);
    }
    SEAM(6);
    if (IN(7)) { PHASE_IDS;
        const int grp = wave * G + vcu; const bool router = grp * 16 < M;
        LAS float* scr = (LAS float*)(lds + wave * 16384);
        if (router) route16(X2B, WSP(const u32x4, WS_WR), rg_b, re_b, WSP(float, WS_RSTD), TOKE, TOKW, TOKR, WSP(unsigned, WS_GCNT), grp * 16, lane, scr + 3072);
        if (router && (DOUBLE_PHASE) == 77) route16(X2B, WSP(const u32x4, WS_WR), rg_b, re_b, WSP(float, WS_RSTD), TOKE, TOKW, TOKR, WSP(unsigned, WS_GCNT), grp * 16, lane, scr + 3072, true);
        constexpr int I_GU = (D / 64) * (DEXP / 32), I_DN = (DEXP / 64) * (D / 32), I_ALL = NEXP * (2 * I_GU + I_DN);
#ifndef P7_SHARE
#define P7_SHARE 10
#endif
        const int nrt = M / 16, nA = nrt < NGW ? nrt : NGW, nB = NGW - nA;
        const int perA = nB ? (I_ALL * P7_SHARE / 24 + nA - 1) / nA : (I_ALL + nA - 1) / nA, totA = perA * nA < I_ALL ? perA * nA : I_ALL;
        int it0, it1, stp;
        if (router) { it0 = grp; it1 = totA; stp = nA; } else { it0 = totA + (grp - nA); it1 = I_ALL; stp = nB; }
        REP(7) { XposeRegs R0, R1;
#define P7_LOAD(R, it_) do { const int e_ = (it_) / (2 * I_GU + I_DN), r_ = (it_) % (2 * I_GU + I_DN); \
            if (r_ < I_GU) xpose_load(R, w_gate + (size_t)e_ * D * DEXP, D, DEXP, r_, lane); else if (r_ < 2 * I_GU) xpose_load(R, w_up + (size_t)e_ * D * DEXP, D, DEXP, r_ - I_GU, lane); \
            else xpose_load(R, w_down + (size_t)e_ * DEXP * D, DEXP, D, r_ - 2 * I_GU, lane); } while (0)
#define P7_STORE(C, it_) do { const int e = (it_) / (2 * I_GU + I_DN), r = (it_) % (2 * I_GU + I_DN); \
            if (r < I_GU) xpose_store_f8(C, D, DEXP, WGU + (size_t)e * 1024 * D, 0, 2, scr, r, lane, F8_WSCALE, norm2_gain); \
            else if (r < 2 * I_GU) xpose_store_f8(C, D, DEXP, WGU + (size_t)e * 1024 * D, 1, 2, scr, r - I_GU, lane, F8_WSCALE, norm2_gain); \
            else xpose_store_f8(C, DEXP, D, WD + (size_t)e * 1024 * DEXP, 0, 1, scr, r - 2 * I_GU, lane, F8_WSCALE); } while (0)
            if (it0 < it1) P7_LOAD(R0, it0);
            if (it0 + stp < it1) P7_LOAD(R1, it0 + stp);
            for (int it = it0; it < it1; it += 2 * stp) {
                { const XposeRegs C = R0; if (it + 2 * stp < it1) P7_LOAD(R0, it + 2 * stp); P7_STORE(C, it); }
                if (it + stp < it1) { const XposeRegs C = R1; if (it + 3 * stp < it1) P7_LOAD(R1, it + 3 * stp); P7_STORE(C, it + stp); }
            }
#undef P7_STORE
#undef P7_LOAD
        }
    }
    SEAM(7);
    if (IN(8)) REP(8) { sort_slots(lds, tb, WSP(unsigned, WS_GCNT), TOKE, TOKR, TOKS, WSP(int, WS_PERM), WSP(const float, WS_RSTD), WSP(float, WS_RSLOT), CNT, bx, G); }
    SEAM(8);
    if (IN(9)) REP(9) {
        build_tile_prefix(tb, CNT);
        MoeOrder S{tb, G, bx, WSP(const int, WS_PERM), WSP(unsigned, WS_CTL) + CW_READY, 0}; EpiSwiGlu E{HM, WSP(const float, WS_RSLOT)};
        mg::gemm<EpiSwiGlu, MoeOrder, true>(lds, X2F8, WGU, D, S, E);
    }
    SEAM(9);
    if (IN(10)) REP(10) {
        build_tile_prefix(tb, CNT);
        MoeOrder S{tb, G, bx, WSP(const int, WS_PERM), WSP(unsigned, WS_CTL) + CW_READY, 0}; EpiDown E{Y};
        mg::gemm<EpiDown, MoeOrder, false>(lds, HM, WD, DEXP, S, E);
    }
    SEAM(10);
    if (IN(11)) { PHASE_IDS; final_rows_piped(X2B, out, Y, TOKS, TOKW, final_gain, gw, NGW, lane); }
#ifdef DIAG_SPAN_A
    xcd_barrier(bar); STAMP(12); xcd_barrier(bar);
    { const unsigned long long* st_ = WSP(unsigned long long, WS_LAM + 64);
#ifdef DIAG_CLOCK
      const float d_ = (float)(long long)(st_[22] - st_[20]) / (float)(long long)(st_[23] - st_[21]) * 10.f * DIAG_C;
#else
      const float d_ = (float)(long long)(st_[DIAG_SPAN_B] - st_[DIAG_SPAN_A]) * 0.01f * DIAG_C;
#endif
      for (int m = blockIdx.x * 512 + threadIdx.x; m < M; m += gridDim.x * 512) out[(size_t)m * D] += d_; }
#endif
#undef IN
#undef SEAM
#undef x_in
#undef positions
#undef out
#undef Y
#undef HM
#undef CNT
}

extern "C" void kernel_launch(void* const* d_in, const int* in_sizes, int n_in, void* d_out, int out_size, void* d_ws, size_t ws_size, hipStream_t stream) {
    static int grid = 0;
    if (grid == 0) {
        if (n_in != 18 || in_sizes[0] != M * D || out_size != M * D || ws_size < WS_END) { fprintf(stderr, "kernel_launch: unexpected shapes (n_in %d, in0 %d, out %d, ws %zu)\n", n_in, n_in > 0 ? in_sizes[0] : -1, out_size, ws_size); grid = -1; return; }
        int dev = 0, cus = 0, per_cu = 0;
        if (hipGetDevice(&dev) != hipSuccess || hipDeviceGetAttribute(&cus, hipDeviceAttributeMultiprocessorCount, dev) != hipSuccess) { grid = -1; return; }
        if (hipFuncSetAttribute((const void*)mk_fwd, hipFuncAttributeMaxDynamicSharedMemorySize, LDS_BYTES) != hipSuccess) { fprintf(stderr, "kernel_launch: hipFuncSetAttribute failed\n"); grid = -1; return; }
        if (hipOccupancyMaxActiveBlocksPerMultiprocessor(&per_cu, (const void*)mk_fwd, NWAVES * 64, LDS_BYTES) != hipSuccess || per_cu < 1) { fprintf(stderr, "kernel_launch: occupancy query says %d\n", per_cu); (void)hipGetLastError(); grid = -1; return; }
        grid = cus;
    }
    if (grid < 0) return;
    if (hipMemsetAsync((char*)d_ws + WS_CTL, 0, CTL_ZERO_BYTES, stream) != hipSuccess) return;
    Args a{};
    for (int i = 0; i < 18; ++i) a.in[i] = d_in[i];
    a.out = (float*)d_out; a.ws = (unsigned char*)d_ws;
#if MK_N_LAUNCHES == 1
    a.ph_lo = 0; a.ph_hi = N_PHASES;
    hipLaunchKernelGGL(mk_fwd, dim3(grid), dim3(NWAVES * 64), LDS_BYTES, stream, a);
#else
    for (int p = 0; p < N_PHASES; ++p) { a.ph_lo = p; a.ph_hi = p + 1; hipLaunchKernelGGL(mk_fwd, dim3(grid), dim3(NWAVES * 64), LDS_BYTES, stream, a); }
#endif
}
```

```cpp
#include <hip/hip_runtime.h>
#include <cstdio>
#include <cstdint>
__device__ __forceinline__ int opaque_tid() { int t = threadIdx.x; asm volatile("" : "+v"(t)); return t; }
namespace pg8 {
#define PG8_LAS __attribute__((address_space(3)))
typedef unsigned short bf16_t;
typedef short bf16x8 __attribute__((ext_vector_type(8)));
typedef float f32x4 __attribute__((ext_vector_type(4)));
typedef unsigned u32x4 __attribute__((ext_vector_type(4)));
constexpr int BM = 256, BK = 64, HALF = 128, HTB = HALF * BK * 2  , STAGE_BYTES = 8 * HTB, NXCD = 8, WGM = 8;

__host__ __device__ __forceinline__ int lds_byte(int r, int c) { const int st = (r >> 4) * 2 + (c >> 5), rr = r & 15, cc = c & 31, ob = rr * 64 + cc * 2; return st * 1024 + (ob ^ (((ob >> 9) & 1) << 5)); }
__host__ __device__ __forceinline__ void stage_rc(int b, int& R, int& C) { const int st = b / 1024, sb = b % 1024, swz = sb ^ (((sb >> 9) & 1) << 5); R = (st >> 1) * 16 + swz / 64; C = (st & 1) * 32 + (swz % 64) / 2; }
__host__ __device__ __forceinline__ int perm32(int rho) { const int n = rho >> 4, i = rho & 15; return 8 * (i >> 2) + 4 * n + (i & 3); }

struct Unit { int pm, pn; };
struct Gemm { const bf16_t* A; const bf16_t* Bt; int M, N, K; };

struct StaticOrder {
    int nM, nN, nwg, G, c;
    __host__ __device__ void init(int M, int N, int G_, int c_) { nM = M / BM; nN = N / BM; nwg = nM * nN; G = G_; c = c_; }
    __host__ __device__ bool next(int i, Unit& u) const {
        const long L = (long)i * G + c; if (L >= nwg) return false;
        int wgid = (int)L; { const int q = nwg / NXCD, r = nwg % NXCD, xcd = wgid % NXCD, off = wgid / NXCD; wgid = (xcd < r ? xcd * (q + 1) : r * (q + 1) + (xcd - r) * q) + off; }
        const int nig = WGM * nN, gid = wgid / nig, fm = gid * WGM, gsz = (nM - fm) < WGM ? (nM - fm) : WGM;
        u.pm = fm + ((wgid % nig) % gsz); u.pn = (wgid % nig) / gsz; return true;
    }
    __device__ __forceinline__ bool half_only(const Unit&) const { return false; }
    __device__ __forceinline__ void a_ready(const Unit&) const {}
    __device__ __forceinline__ void done(const Unit&) const {}
};

template <class Epi, class Sched, bool ALIGN_EPI = false, bool SP2 = false, bool F8 = false>
__device__ __forceinline__ void gemm_phase(PG8_LAS unsigned char* lds, const Gemm g, const Sched& S, const Epi& E) {
    const int tid = opaque_tid(), wid = __builtin_amdgcn_readfirstlane(tid >> 6), lane = tid & 63, wr = wid >> 2, wc = wid & 3, fr = lane & 15, fq = lane >> 4;
    const int K = g.K, nt = K / BK;
    unsigned voffA[2], voffB[2];
#pragma unroll
    for (int i = 0; i < 2; ++i) { int R, C; stage_rc(tid * 16 + i * 8192, R, C); const int Rb = Epi::PERM ? ((R & ~31) + perm32(R & 31)) : R;
        voffA[i] = (unsigned)(R * K + C) * 2u; voffB[i] = (unsigned)(Rb * K + C) * 2u; }
    const size_t kstep = (size_t)(BK * 2);
    const size_t hstep = (size_t)HALF * K * 2;
    const size_t tstep = 2 * hstep;
    const unsigned ldsw = (unsigned)wid * 1024u;
    const int aoff = lds_byte(wr * 64 + fr, fq * 8), boff = lds_byte(wc * 32 + fr, fq * 8);
#define PG8_SA(b, h) (((b) * 2 + (h)) * HTB)
#define PG8_SB(b, h) ((4 + (b) * 2 + (h)) * HTB)
#define PG8_STAGE(bufoff, gbase, voff) do { _Pragma("unroll") for (int _i = 0; _i < 2; ++_i) \
        __builtin_amdgcn_global_load_lds((const unsigned*)((const char*)(gbase) + (voff)[_i]), (PG8_LAS unsigned*)(lds + (bufoff) + ldsw + _i * 8192), 16, 0, 0); } while (0)
#define PG8_LDA(dst, b, h) do { _Pragma("unroll") for (int m = 0; m < 4; ++m) _Pragma("unroll") for (int k = 0; k < 2; ++k) dst[m][k] = *(const PG8_LAS bf16x8*)(lds + PG8_SA(b, h) + aoff + m * 2048 + k * 1024); } while (0)
#define PG8_LDB(dst, b, h) do { _Pragma("unroll") for (int n = 0; n < 2; ++n) _Pragma("unroll") for (int k = 0; k < 2; ++k) dst[n][k] = *(const PG8_LAS bf16x8*)(lds + PG8_SB(b, h) + boff + n * 2048 + k * 1024); } while (0)
#define PG8_MMA(ai, bj, At, Bt) do { __builtin_amdgcn_s_setprio(1); _Pragma("unroll") for (int m = 0; m < 4; ++m) _Pragma("unroll") for (int n = 0; n < 2; ++n) _Pragma("unroll") for (int k = 0; k < 2; ++k) { \
        if constexpr (F8) { typedef long v2l_ __attribute__((ext_vector_type(2))); const v2l_ b_ = __builtin_bit_cast(v2l_, Bt[n][k]), a_ = __builtin_bit_cast(v2l_, At[m][k]); \
            acc[ai][bj][m][n] = __builtin_amdgcn_mfma_f32_16x16x32_fp8_fp8(b_[0], a_[0], acc[ai][bj][m][n], 0, 0, 0); acc[ai][bj][m][n] = __builtin_amdgcn_mfma_f32_16x16x32_fp8_fp8(b_[1], a_[1], acc[ai][bj][m][n], 0, 0, 0); } \
        else acc[ai][bj][m][n] = __builtin_amdgcn_mfma_f32_16x16x32_bf16(Bt[n][k], At[m][k], acc[ai][bj][m][n], 0, 0, 0); } \
        __builtin_amdgcn_s_setprio(0); } while (0)
#define PG8_WAIT_V(n) asm volatile("s_waitcnt vmcnt(" #n ")" ::: "memory")
#define PG8_WAIT_L(n) asm volatile("s_waitcnt lgkmcnt(" #n ")" ::: "memory")
#define PG8_BAR __builtin_amdgcn_s_barrier()
#define PG8_SCHED __builtin_amdgcn_sched_barrier(0)
    Unit cur, nxt; int ui = 0;
    if (!S.next(0, cur)) return;
    f32x4 acc[2][2][4][2];
#pragma unroll
    for (int a = 0; a < 2; ++a)
#pragma unroll
        for (int b = 0; b < 2; ++b)
#pragma unroll
            for (int m = 0; m < 4; ++m)
#pragma unroll
                for (int n = 0; n < 2; ++n) acc[a][b][m][n] = (f32x4){0.f, 0.f, 0.f, 0.f};
    bf16x8 At[4][2], B0[2][2], B1[2][2];
    const char* cA = (const char*)g.A + (size_t)cur.pm * tstep; const char* cB = (const char*)g.Bt + (size_t)cur.pn * tstep;
    S.a_ready(cur);
    if constexpr (SP2) {
        PG8_STAGE(PG8_SB(0, 0), cB, voffB); PG8_STAGE(PG8_SB(0, 1), cB + hstep, voffB); PG8_STAGE(PG8_SA(0, 0), cA, voffA); PG8_STAGE(PG8_SA(0, 1), cA + hstep, voffA);
        if (wr == 1) PG8_BAR;
        PG8_WAIT_V(2); PG8_BAR;
        PG8_STAGE(PG8_SB(1, 0), cB + kstep, voffB); PG8_STAGE(PG8_SA(1, 0), cA + kstep, voffA); PG8_STAGE(PG8_SB(1, 1), cB + hstep + kstep, voffB);
        PG8_WAIT_V(6); PG8_BAR;
    } else {
        PG8_STAGE(PG8_SB(0, 0), cB, voffB); PG8_STAGE(PG8_SA(0, 0), cA, voffA); PG8_STAGE(PG8_SB(0, 1), cB + hstep, voffB); PG8_STAGE(PG8_SA(0, 1), cA + hstep, voffA);
        if (wr == 1) PG8_BAR;
        PG8_WAIT_V(4); PG8_BAR;
        PG8_STAGE(PG8_SB(1, 0), cB + kstep, voffB); PG8_STAGE(PG8_SA(1, 0), cA + kstep, voffA); PG8_STAGE(PG8_SB(1, 1), cB + hstep + kstep, voffB);
        PG8_WAIT_V(6); PG8_BAR;
    }
    for (;;) {
        const bool has_next = S.next(ui + 1, nxt);
        const char* nA = has_next ? (const char*)g.A + (size_t)nxt.pm * tstep : cA; const char* nB = has_next ? (const char*)g.Bt + (size_t)nxt.pn * tstep : cB;
        for (int t = 0; t < nt; t += 2) {
            const bool last = (t == nt - 2);
            const char* a1 = cA + (size_t)(t + 1) * kstep;
            const char* a2 = last ? nA : cA + (size_t)(t + 2) * kstep; const char* b2 = last ? nB : cB + (size_t)(t + 2) * kstep;
            const char* a3 = a2 + kstep; const char* b3 = b2 + kstep;
            if (last && has_next) S.a_ready(nxt);
            if constexpr (SP2) {
            PG8_LDB(B0, 0, 0); PG8_LDB(B1, 0, 1); PG8_SCHED; PG8_LDA(At, 0, 0); PG8_STAGE(PG8_SA(1, 1), a1 + hstep, voffA);
            PG8_WAIT_V(8); PG8_WAIT_L(0); PG8_BAR; PG8_MMA(0, 0, At, B0); PG8_MMA(0, 1, At, B1); PG8_BAR; PG8_SCHED;
            PG8_LDA(At, 0, 1); PG8_STAGE(PG8_SB(0, 0), b2, voffB); PG8_STAGE(PG8_SB(0, 1), b2 + hstep, voffB); PG8_STAGE(PG8_SA(0, 0), a2, voffA);
            PG8_WAIT_V(8); PG8_WAIT_L(0); PG8_BAR; PG8_MMA(1, 0, At, B0); PG8_MMA(1, 1, At, B1); PG8_BAR; PG8_SCHED;
            PG8_LDB(B0, 1, 0); PG8_LDB(B1, 1, 1); PG8_SCHED; PG8_LDA(At, 1, 0); PG8_STAGE(PG8_SA(0, 1), a2 + hstep, voffA);
            PG8_WAIT_V(8); PG8_WAIT_L(0); PG8_BAR; PG8_MMA(0, 0, At, B0); PG8_MMA(0, 1, At, B1); PG8_BAR; PG8_SCHED;
            PG8_LDA(At, 1, 1); PG8_STAGE(PG8_SB(1, 0), b3, voffB); PG8_STAGE(PG8_SB(1, 1), b3 + hstep, voffB); PG8_STAGE(PG8_SA(1, 0), a3, voffA);
            PG8_WAIT_V(8); PG8_WAIT_L(0); PG8_BAR; PG8_MMA(1, 0, At, B0); PG8_MMA(1, 1, At, B1); PG8_BAR; PG8_SCHED;
            } else {
            PG8_LDB(B0, 0, 0); PG8_SCHED; PG8_LDA(At, 0, 0); PG8_STAGE(PG8_SA(1, 1), a1 + hstep, voffA);
            PG8_WAIT_L(8); PG8_BAR; PG8_WAIT_L(0); PG8_MMA(0, 0, At, B0); PG8_BAR; PG8_SCHED;
            PG8_LDB(B1, 0, 1); PG8_STAGE(PG8_SB(0, 0), b2, voffB);
            PG8_BAR; PG8_WAIT_L(0); PG8_MMA(0, 1, At, B1); PG8_BAR;
            PG8_LDA(At, 0, 1); PG8_STAGE(PG8_SA(0, 0), a2, voffA);
            PG8_BAR; PG8_WAIT_L(0); PG8_MMA(1, 0, At, B0); PG8_BAR; PG8_SCHED;
            PG8_STAGE(PG8_SB(0, 1), b2 + hstep, voffB);
            PG8_WAIT_V(6); PG8_BAR; PG8_MMA(1, 1, At, B1); PG8_BAR;
            PG8_LDB(B0, 1, 0); PG8_SCHED; PG8_LDA(At, 1, 0); PG8_STAGE(PG8_SA(0, 1), a2 + hstep, voffA);
            PG8_WAIT_L(8); PG8_BAR; PG8_WAIT_L(0); PG8_MMA(0, 0, At, B0); PG8_BAR; PG8_SCHED;
            PG8_LDB(B1, 1, 1); PG8_STAGE(PG8_SB(1, 0), b3, voffB);
            PG8_BAR; PG8_WAIT_L(0); PG8_MMA(0, 1, At, B1); PG8_BAR;
            PG8_LDA(At, 1, 1); PG8_STAGE(PG8_SA(1, 0), a3, voffA);
            PG8_BAR; PG8_WAIT_L(0); PG8_MMA(1, 0, At, B0); PG8_BAR; PG8_SCHED;
            PG8_STAGE(PG8_SB(1, 1), b3 + hstep, voffB);
            PG8_WAIT_V(6); PG8_BAR; PG8_MMA(1, 1, At, B1); PG8_BAR;
            }
        }
        if constexpr (ALIGN_EPI) { if (wr == 0) PG8_BAR; }
        if constexpr (!Epi::AFTER_DRAIN) { E(acc, cur, wr, wc, fr, fq); S.done(cur); }
        if (!has_next) break;
#pragma unroll
        for (int a = 0; a < 2; ++a)
#pragma unroll
            for (int b = 0; b < 2; ++b)
#pragma unroll
                for (int m = 0; m < 4; ++m)
#pragma unroll
                    for (int n = 0; n < 2; ++n) acc[a][b][m][n] = (f32x4){0.f, 0.f, 0.f, 0.f};
        cur = nxt; cA = nA; cB = nB; ++ui;
        if constexpr (ALIGN_EPI) { if (wr == 1) PG8_BAR; }
    }
    PG8_WAIT_V(0);
    if constexpr (!ALIGN_EPI) { if (wr == 0) PG8_BAR; }
    PG8_BAR;
    if constexpr (Epi::AFTER_DRAIN) { E.fused(acc, cur, wr, wc, fr, fq, lds, wid, lane); S.done(cur); }
#undef PG8_SA
#undef PG8_SB
#undef PG8_STAGE
#undef PG8_LDA
#undef PG8_LDB
#undef PG8_MMA
#undef PG8_WAIT_V
#undef PG8_WAIT_L
#undef PG8_BAR
#undef PG8_SCHED
}
}

constexpr int NWAVES = 8;
constexpr int M = 16384, D = 1024, NIN = 4096, HSEC = 512;
constexpr int NEXP = 32, DEXP = 512, MAXTILES = 160, MAXSLOTS = MAXTILES * 256;
constexpr float QSCALE = 0.18033688011112042f;

constexpr size_t MiB = 1u << 20;
constexpr size_t WS_CTL = 0, CTL_ZERO_BYTES = 1 * MiB;
constexpr size_t WS_WR = 1 * MiB;
constexpr size_t WS_ROPE = 2 * MiB;
constexpr size_t WS_HD = 3 * MiB;
constexpr size_t WS_TOKE = 3 * MiB + 256 * 1024, WS_TOKW = WS_TOKE + 128 * 1024, WS_TOKR = WS_TOKW + 128 * 1024, WS_TOKS = WS_TOKR + 128 * 1024, WS_LAM = WS_TOKS + 128 * 1024, WS_GCNT = WS_LAM + 128 * 1024, WS_RSTD = 1 * MiB + 256 * 1024, WS_RSLOT = 1 * MiB + 768 * 1024, WS_PERM = 1 * MiB + 512 * 1024;
constexpr size_t WS_WOUT = 4 * MiB, WS_WIN = 6 * MiB;
constexpr size_t WS_XN = 16 * MiB;
constexpr size_t WS_OF = 16 * MiB;
constexpr size_t WS_X2B = 16 * MiB;
constexpr size_t WS_HM = 144 * MiB;
constexpr size_t WS_X2F8 = 112 * MiB;
constexpr size_t WS_QH = 48 * MiB, WS_VH = 64 * MiB, WS_SG = 80 * MiB, WS_QD = 96 * MiB, WS_KD = 112 * MiB, WS_VD = 128 * MiB;
constexpr size_t WS_WGU = 48 * MiB, WS_WD = 216 * MiB;
constexpr size_t WS_GF = 144 * MiB, WS_GB = 176 * MiB;
constexpr size_t WS_MIX = 144 * MiB;
constexpr size_t WS_HS = 208 * MiB, WS_HL = 224 * MiB;
constexpr size_t WS_OB = 224 * MiB;
constexpr size_t WS_HG = 176 * MiB;
constexpr size_t WS_O0S = 176 * MiB;
constexpr size_t WS_Y = 48 * MiB;
constexpr size_t WS_END = 256 * MiB;
static_assert(WS_Y + (size_t)MAXSLOTS * 1024 * 2 <= WS_HM && WS_HM + (size_t)MAXSLOTS * 512 * 2 <= WS_WD && WS_WD + 32 * MiB <= WS_END, "ws map");
constexpr int CW_BAR = 4096, CW_CNT = 16384, CW_KMAX = 20480, CW_QWD = 21504, CW_READY = 32768, CNT_STRIDE = 64;

constexpr int PHASE_LDS = 147456, MISC_OFF = PHASE_LDS, LDS_BYTES = PHASE_LDS + 1024;

#define GAS __attribute__((address_space(1)))
#define LAS __attribute__((address_space(3)))
typedef unsigned short bf16_t;
typedef _Float16 half_t;
typedef float f32x4 __attribute__((ext_vector_type(4)));
typedef float f32x16 __attribute__((ext_vector_type(16)));
typedef short bf16x8 __attribute__((ext_vector_type(8)));
typedef short s16x4 __attribute__((ext_vector_type(4)));
typedef unsigned u32x4 __attribute__((ext_vector_type(4)));
typedef unsigned u32x2 __attribute__((ext_vector_type(2)));
#define LDS_WAIT() asm volatile("s_waitcnt lgkmcnt(0)" ::: "memory")
#define VM_WAIT() asm volatile("s_waitcnt vmcnt(0)" ::: "memory")
#define SBAR() __builtin_amdgcn_sched_barrier(0)
__device__ __forceinline__ unsigned f2bf(float f) { unsigned u = __builtin_bit_cast(unsigned, f); return (u + 0x7fffu + ((u >> 16) & 1u)) >> 16; }
__device__ __forceinline__ unsigned pk2(float lo, float hi) { return f2bf(lo) | (f2bf(hi) << 16); }
__device__ __forceinline__ float bf2f(unsigned b) { return __builtin_bit_cast(float, b << 16); }
__device__ __forceinline__ float bflo(unsigned w) { return __builtin_bit_cast(float, w << 16); }
__device__ __forceinline__ float bfhi(unsigned w) { return __builtin_bit_cast(float, w & 0xffff0000u); }
__device__ __forceinline__ unsigned cvtpk(float lo, float hi) { unsigned r; asm volatile("v_cvt_pk_bf16_f32 %0, %1, %2" : "=v"(r) : "v"(lo), "v"(hi)); return r; }
__device__ __forceinline__ unsigned pk4_fp8(float a, float b, float c, float d) { int w = 0; w = __builtin_amdgcn_cvt_pk_fp8_f32(a, b, w, false); w = __builtin_amdgcn_cvt_pk_fp8_f32(c, d, w, true); return (unsigned)w; }
constexpr float F8_WSCALE = 256.f, F8_HSCALE = 16.f, F8_YSCALE = 32.f;
__device__ __forceinline__ float ex2(float x) { return __builtin_amdgcn_exp2f(x); }
__device__ __forceinline__ float lg2(float x) { return __builtin_amdgcn_logf(x); }
__device__ __forceinline__ float sigmoidf_(float v) { return __builtin_amdgcn_rcpf(1.f + ex2(-1.4426950408889634f * v)); }
__device__ __forceinline__ bool lane_is_hi() { return (opaque_tid() & 32) != 0; }
template <int X> __device__ __forceinline__ float lane_xor(float v) {
    if constexpr (X == 32) { auto rr = __builtin_amdgcn_permlane32_swap(__float_as_uint(v), __float_as_uint(v), false, false); return __uint_as_float(lane_is_hi() ? rr[0] : rr[1]); }
    else return __int_as_float(__builtin_amdgcn_ds_swizzle(__float_as_int(v), (X << 10) | 0x1F));
}
__device__ __forceinline__ float wave_sum(float v) {
    v += lane_xor<1>(v); v += lane_xor<2>(v); v += lane_xor<4>(v); v += lane_xor<8>(v); v += lane_xor<16>(v);
    auto rr = __builtin_amdgcn_permlane32_swap(__float_as_uint(v), __float_as_uint(v), false, false);
    return __uint_as_float(rr[0]) + __uint_as_float(rr[1]);
}
__device__ __forceinline__ int crow(int r, int hi) { return (r & 3) + 8 * (r >> 2) + 4 * hi; }
#define XB_TMO      128
#define XB_XCNT(j)  (256  + 64 * (j))
#define XB_XSUB(j)  (1280 + 64 * (j))
#define XB_XGEN(j)  (2304 + 64 * (j))
#define XB_TOP      3328
#define XB_TOPGEN   3392
#define XCD_BAR_WORDS 3456
#define XB_SPIN_CAP (1u << 18)

__device__ __forceinline__ unsigned xb_ld(unsigned* p)              { return __hip_atomic_load(p, __ATOMIC_RELAXED, __HIP_MEMORY_SCOPE_AGENT); }
__device__ __forceinline__ unsigned xb_add(unsigned* p, unsigned v) { return __hip_atomic_fetch_add(p, v, __ATOMIC_RELAXED, __HIP_MEMORY_SCOPE_AGENT); }
__device__ __forceinline__ unsigned xb_xcc_id() { return (unsigned)__builtin_amdgcn_s_getreg((3 << 11) | 20) & 0xFu; }
#define XB_SPIN(cond, bar) do { unsigned _sp = 0; while (cond) { __builtin_amdgcn_s_sleep(1); \
    if ((++_sp & 255u) == 0u) { if (xb_ld(&(bar)[XB_TMO])) break; if (_sp > XB_SPIN_CAP) { atomicAdd(&(bar)[XB_TMO], 1u); break; } } } } while (0)

struct XcdBarrier {
    unsigned* bar; unsigned x;
    volatile LAS unsigned* st;
};

__device__ __forceinline__ XcdBarrier xcd_barrier_post(unsigned* bar, volatile LAS unsigned* st) {
    XcdBarrier b; b.bar = bar; b.x = xb_xcc_id(); b.st = st;
    if (threadIdx.x == 0) (void)xb_add(&bar[XB_XCNT(b.x)], 1u);
    return b;
}
__device__ __forceinline__ void xcd_barrier_complete(unsigned* bar, unsigned x, unsigned& nloc, unsigned& nx) {
    const unsigned G = gridDim.x * gridDim.y * gridDim.z;
    unsigned sum, cnt, mine, sp = 0u;
    for (;;) {
        sum = 0u; cnt = 0u; mine = 0u;
#pragma unroll
        for (unsigned j = 0; j < 16; ++j) { const unsigned c = xb_ld(&bar[XB_XCNT(j)]); sum += c; cnt += (c > 0u) ? 1u : 0u; mine = (j == x) ? c : mine; }
        if (sum == G) break;
        __builtin_amdgcn_s_sleep(1);
        if ((++sp & 255u) == 0u) { if (xb_ld(&bar[XB_TMO])) break; if (sp > XB_SPIN_CAP) { atomicAdd(&bar[XB_TMO], 1u); break; } }
    }
    nloc = mine > 0u ? mine : 1u; nx = cnt > 0u ? cnt : 1u;
}

__device__ __forceinline__ void xcd_barrier(const XcdBarrier& b) {
    asm volatile("s_waitcnt vmcnt(0)" ::: "memory");
    __syncthreads();
    if (threadIdx.x == 0) {
        unsigned* bar = b.bar;
        __builtin_amdgcn_s_waitcnt(0);
        unsigned nloc = b.st[0], nx = b.st[1];
        if (nloc == 0u) { xcd_barrier_complete(bar, b.x, nloc, nx); b.st[0] = nloc; b.st[1] = nx; }
        const unsigned old = xb_add(&bar[XB_XSUB(b.x)], 1u);
        const unsigned gen = old / nloc;
        if (old + 1u == (gen + 1u) * nloc) {
            __builtin_amdgcn_fence(__ATOMIC_RELEASE, "agent");
            asm volatile("s_waitcnt vmcnt(0)" ::: "memory");
            const unsigned og = xb_add(&bar[XB_TOP], 1u);
            const unsigned tg = og / nx;
            if (og + 1u == (tg + 1u) * nx) xb_add(&bar[XB_TOPGEN], 1u);
            else XB_SPIN(xb_ld(&bar[XB_TOPGEN]) == tg, bar);
            __builtin_amdgcn_fence(__ATOMIC_ACQUIRE, "agent");
            xb_add(&bar[XB_XGEN(b.x)], 1u);
            asm volatile("s_waitcnt vmcnt(0)" ::: "memory");
        } else {
            XB_SPIN(xb_ld(&bar[XB_XGEN(b.x)]) == gen, bar);
            __builtin_amdgcn_fence(__ATOMIC_ACQUIRE, "agent");
            asm volatile("s_waitcnt vmcnt(0)" ::: "memory");
        }
    }
    __syncthreads();
}

struct XposeRegs { f32x4 v[8]; };
__device__ __forceinline__ void xpose_load(XposeRegs& R, const float* W, int K, int N, int item, int lane) {
    const int nblk = N / 32, kb = item / nblk, nb = item % nblk, k0 = 64 * kb, n0 = 32 * nb; (void)K;
    const float* p = W + (size_t)(k0 + (lane >> 3)) * N + n0 + (lane & 7) * 4;
#pragma unroll
    for (int i = 0; i < 8; ++i) R.v[i] = __builtin_nontemporal_load((const GAS f32x4*)(p + (size_t)(8 * i) * N));
}
__device__ __forceinline__ void xpose_store(const XposeRegs& R, int K, int N, bf16_t* WT, int row_off, int row_mul, LAS float* scr, int item, int lane, const float* kgain = nullptr) {
    const int nblk = N / 32, kb = item / nblk, nb = item % nblk, k0 = 64 * kb, n0 = 32 * nb;
#pragma unroll
    for (int i = 0; i < 8; ++i) { LAS float* d = scr + (8 * i + (lane >> 3)) * 33 + (lane & 7) * 4; d[0] = R.v[i].x; d[1] = R.v[i].y; d[2] = R.v[i].z; d[3] = R.v[i].w; }
    LDS_WAIT(); asm volatile("" ::: "memory");
    const int c = lane & 7;
    f32x4 g0 = {1.f, 1.f, 1.f, 1.f}, g1 = g0;
    if (kgain) { g0 = *(const GAS f32x4*)(kgain + k0 + 8 * c); g1 = *(const GAS f32x4*)(kgain + k0 + 8 * c + 4); }
#pragma unroll
    for (int j = 0; j < 4; ++j) { const int n = (lane >> 3) + 8 * j; const LAS float* s = scr + (8 * c) * 33 + n;
        u32x4 o; o.x = cvtpk(s[0 * 33] * g0.x, s[1 * 33] * g0.y); o.y = cvtpk(s[2 * 33] * g0.z, s[3 * 33] * g0.w); o.z = cvtpk(s[4 * 33] * g1.x, s[5 * 33] * g1.y); o.w = cvtpk(s[6 * 33] * g1.z, s[7 * 33] * g1.w);
        *(GAS u32x4*)(WT + (size_t)(row_off + (n0 + n) * row_mul) * K + k0 + 8 * c) = o; }
    LDS_WAIT(); asm volatile("" ::: "memory");
}
__device__ __forceinline__ void xpose_store_f8(const XposeRegs& R, int K, int N, unsigned char* WT, int row_off, int row_mul, LAS float* scr, int item, int lane, float scale, const float* kgain = nullptr) {
    const int nblk = N / 32, kb = item / nblk, nb = item % nblk, k0 = 64 * kb, n0 = 32 * nb;
#pragma unroll
    for (int i = 0; i < 8; ++i) { LAS float* d = scr + (8 * i + (lane >> 3)) * 33 + (lane & 7) * 4; d[0] = R.v[i].x; d[1] = R.v[i].y; d[2] = R.v[i].z; d[3] = R.v[i].w; }
    LDS_WAIT(); asm volatile("" ::: "memory");
    const int c = lane & 7;
    f32x4 g0 = {scale, scale, scale, scale}, g1 = g0;
    if (kgain) { g0 = *(const GAS f32x4*)(kgain + k0 + 8 * c) * scale; g1 = *(const GAS f32x4*)(kgain + k0 + 8 * c + 4) * scale; }
#pragma unroll
    for (int j = 0; j < 4; ++j) { const int n = (lane >> 3) + 8 * j; const LAS float* s = scr + (8 * c) * 33 + n;
        u32x2 o; o.x = pk4_fp8(s[0 * 33] * g0.x, s[1 * 33] * g0.y, s[2 * 33] * g0.z, s[3 * 33] * g0.w); o.y = pk4_fp8(s[4 * 33] * g1.x, s[5 * 33] * g1.y, s[6 * 33] * g1.z, s[7 * 33] * g1.w);
        *(GAS u32x2*)(WT + (size_t)(row_off + (n0 + n) * row_mul) * K + k0 + 8 * c) = o; }
    LDS_WAIT(); asm volatile("" ::: "memory");
}
template <int NR>
__device__ __forceinline__ void rms_rows_to_bf16(const float* X, const float* gain, bf16_t* O, int m0, int stride, int lane, float eps) {
    f32x4 v[NR][4]; float s[NR];
#pragma unroll
    for (int i = 0; i < NR; ++i) { const GAS f32x4* xr = (const GAS f32x4*)(X + (size_t)(m0 + i * stride) * D) + lane;
#pragma unroll
        for (int j = 0; j < 4; ++j) v[i][j] = xr[64 * j]; }
#pragma unroll
    for (int i = 0; i < NR; ++i) { float t = 0.f;
#pragma unroll
        for (int j = 0; j < 4; ++j) t += (v[i][j].x * v[i][j].x + v[i][j].y * v[i][j].y) + (v[i][j].z * v[i][j].z + v[i][j].w * v[i][j].w);
        s[i] = t; }
#pragma unroll
    for (int i = 0; i < NR; ++i) s[i] = 1.f / sqrtf(wave_sum(s[i]) * (1.f / 1024.f) + eps);
#pragma unroll
    for (int j = 0; j < 4; ++j) { const f32x4 g = ((const GAS f32x4*)gain)[64 * j + lane];
#pragma unroll
        for (int i = 0; i < NR; ++i) { u32x2 w; w.x = cvtpk(v[i][j].x * s[i] * g.x, v[i][j].y * s[i] * g.y); w.y = cvtpk(v[i][j].z * s[i] * g.z, v[i][j].w * s[i] * g.w);
            ((GAS u32x2*)(O + (size_t)(m0 + i * stride) * D) + lane)[64 * j] = w; } }
}

__device__ __forceinline__ void rms_rows_piped(const float* X, const float* gain, bf16_t* O, int m0, int stride, int lane, float eps) {
    if (m0 >= M) return;
    f32x4 g[4], c[4], n[4];
#pragma unroll
    for (int j = 0; j < 4; ++j) { g[j] = ((const GAS f32x4*)gain)[64 * j + lane]; c[j] = ((const GAS f32x4*)(X + (size_t)m0 * D) + lane)[64 * j]; }
#pragma unroll 1
    for (int row = m0; row < M; row += stride) {
        if (row + stride < M) {
#pragma unroll
            for (int j = 0; j < 4; ++j) n[j] = ((const GAS f32x4*)(X + (size_t)(row + stride) * D) + lane)[64 * j]; }
        float t = 0.f;
#pragma unroll
        for (int j = 0; j < 4; ++j) t += (c[j].x * c[j].x + c[j].y * c[j].y) + (c[j].z * c[j].z + c[j].w * c[j].w);
        const float s = 1.f / sqrtf(wave_sum(t) * (1.f / 1024.f) + eps);
#pragma unroll
        for (int j = 0; j < 4; ++j) { u32x2 w; w.x = cvtpk(c[j].x * s * g[j].x, c[j].y * s * g[j].y); w.y = cvtpk(c[j].z * s * g[j].z, c[j].w * s * g[j].w); ((GAS u32x2*)(O + (size_t)row * D) + lane)[64 * j] = w; }
#pragma unroll
        for (int j = 0; j < 4; ++j) c[j] = n[j];
    }
}

struct EpiInProj {
    static constexpr bool PERM = true, AFTER_DRAIN = false;
    bf16_t *QH, *VH, *SG, *QD, *KD, *VD; half_t *GF, *GB; const float* lbraw; const float *cosT, *sinT;
    __device__ __forceinline__ void operator()(const pg8::f32x4 (&acc)[2][2][4][2], const pg8::Unit& u, int wr, int wc, int fr, int fq) const {
        const int sec = u.pn >> 1;
        const int row0 = u.pm * 256 + wr * 64 + fr;
        const int cs0 = (u.pn & 1) * 256 + wc * 32 + 8 * fq;
        if (sec == 1 || sec == 2) {
            half_t* G = sec == 1 ? GF : GB; const float* lbp = lbraw + (sec - 1) * 1024;
#pragma unroll
            for (int bj = 0; bj < 2; ++bj) { const int c = cs0 + bj * 128; float lb[8];
#pragma unroll
                for (int j = 0; j < 8; ++j) { const float l0 = lbp[c + j], l1 = lbp[512 + c + j]; lb[j] = __builtin_amdgcn_rcpf(1.f + ex2(1.4426950408889634f * (l0 - l1))); }
#pragma unroll
                for (int ai = 0; ai < 2; ++ai)
#pragma unroll
                    for (int m = 0; m < 4; ++m) { const int row = row0 + ai * 128 + m * 16; f32x4 o0, o1;
#pragma unroll
                        for (int j = 0; j < 4; ++j) { o0[j] = lb[j] + (1.f - lb[j]) * sigmoidf_(acc[ai][bj][m][0][j]); o1[j] = lb[4 + j] + (1.f - lb[4 + j]) * sigmoidf_(acc[ai][bj][m][1][j]); }
                        typedef _Float16 h8 __attribute__((ext_vector_type(8)));
                        const h8 hv = {(_Float16)o0[0], (_Float16)o0[1], (_Float16)o0[2], (_Float16)o0[3], (_Float16)o1[0], (_Float16)o1[1], (_Float16)o1[2], (_Float16)o1[3]};
                        *(h8*)(G + (size_t)row * HSEC + c) = hv; } }
            return;
        }
        bf16_t* O = sec == 0 ? QH : sec == 3 ? VH : sec == 4 ? SG : sec == 5 ? QD : sec == 6 ? KD : VD;
        const bool rot = (sec == 5 || sec == 6) && ((wc & 1) == 0);
        const float sc = sec == 5 ? QSCALE : 1.f;
#pragma unroll
        for (int ai = 0; ai < 2; ++ai)
#pragma unroll
            for (int m = 0; m < 4; ++m) { const int row = row0 + ai * 128 + m * 16;
#pragma unroll
                for (int bj = 0; bj < 2; ++bj) { const int c = cs0 + bj * 128; float v[8];
#pragma unroll
                    for (int j = 0; j < 4; ++j) { v[j] = acc[ai][bj][m][0][j]; v[4 + j] = acc[ai][bj][m][1][j]; }
                    if (sec == 4) {
#pragma unroll
                        for (int j = 0; j < 8; ++j) v[j] = v[j] * sigmoidf_(v[j]);
                    }
                    if (rot) {
                        const f32x4 c0 = *(const f32x4*)(cosT + (size_t)row * 8), c1 = *(const f32x4*)(cosT + (size_t)row * 8 + 4);
                        const f32x4 s0 = *(const f32x4*)(sinT + (size_t)row * 8), s1 = *(const f32x4*)(sinT + (size_t)row * 8 + 4);
#pragma unroll
                        for (int j = 0; j < 8; ++j) { const float p = lane_xor<16>(v[j]); const float cj = j < 4 ? c0[j & 3] : c1[j & 3], sj = j < 4 ? s0[j & 3] : s1[j & 3];
                            const float r = fq == 0 ? v[j] * cj - p * sj : v[j] * cj + p * sj; v[j] = fq < 2 ? r : v[j]; }
                    }
                    u32x4 w; w.x = cvtpk(v[0] * sc, v[1] * sc); w.y = cvtpk(v[2] * sc, v[3] * sc); w.z = cvtpk(v[4] * sc, v[5] * sc); w.w = cvtpk(v[6] * sc, v[7] * sc);
                    *(u32x4*)(O + (size_t)row * HSEC + c) = w; } }
    }
};
struct EpiResid {
    static constexpr bool PERM = true, AFTER_DRAIN = false;
    const float* X; bf16_t* O; unsigned char* O8;
    __device__ __forceinline__ void operator()(const pg8::f32x4 (&acc)[2][2][4][2], const pg8::Unit& u, int wr, int wc, int fr, int fq) const {
        const int row0 = u.pm * 256 + wr * 64 + fr, col0 = u.pn * 256 + wc * 32 + 8 * fq;
#pragma unroll
        for (int ai = 0; ai < 2; ++ai)
#pragma unroll
            for (int m = 0; m < 4; ++m) { const size_t off = (size_t)(row0 + ai * 128 + m * 16) * D + col0;
#pragma unroll
                for (int bj = 0; bj < 2; ++bj) { const f32x4 a = *(const f32x4*)(X + off + bj * 128) + acc[ai][bj][m][0], b = *(const f32x4*)(X + off + bj * 128 + 4) + acc[ai][bj][m][1];
                    u32x4 w; w.x = cvtpk(a[0], a[1]); w.y = cvtpk(a[2], a[3]); w.z = cvtpk(b[0], b[1]); w.w = cvtpk(b[2], b[3]); *(u32x4*)(O + off + bj * 128) = w;
                    u32x2 f; f.x = pk4_fp8(a[0], a[1], a[2], a[3]); f.y = pk4_fp8(b[0], b[1], b[2], b[3]); *(u32x2*)(O8 + off + bj * 128) = f; } }
    }
};
struct EpiSwiGlu {
    unsigned char* O; const float* RS;
    __device__ __forceinline__ void operator()(const f32x4 (&acc)[2][4][2], const pg8::Unit& u, int wr, int wc, int fr, int fq) const {
        const int row0 = u.pm * 128 + wr * 64 + fr, col0 = ((u.pn & 3) * 256 + wc * 32 + 8 * fq) >> 1;
#pragma unroll
        for (int m = 0; m < 4; ++m) { const int row = row0 + m * 16; const float rs = RS[row] * (1.f / F8_WSCALE); unsigned char* rowp = O + (size_t)row * DEXP + col0;
#pragma unroll
            for (int bj = 0; bj < 2; ++bj) { const f32x4 a = acc[bj][m][0] * rs, b = acc[bj][m][1] * rs;
                const float h0 = a[0] * sigmoidf_(a[0]) * a[1], h1 = a[2] * sigmoidf_(a[2]) * a[3], h2 = b[0] * sigmoidf_(b[0]) * b[1], h3 = b[2] * sigmoidf_(b[2]) * b[3];
                *(unsigned*)(rowp + bj * 64) = pk4_fp8(__builtin_amdgcn_fmed3f(h0 * F8_HSCALE, -448.f, 448.f), __builtin_amdgcn_fmed3f(h1 * F8_HSCALE, -448.f, 448.f), __builtin_amdgcn_fmed3f(h2 * F8_HSCALE, -448.f, 448.f), __builtin_amdgcn_fmed3f(h3 * F8_HSCALE, -448.f, 448.f)); } }
    }
};
struct EpiDown {
    unsigned char* O;
    __device__ __forceinline__ void operator()(const f32x4 (&acc)[2][4][2], const pg8::Unit& u, int wr, int wc, int fr, int fq) const {
        const int row0 = u.pm * 128 + wr * 64 + fr, col0 = (u.pn & 3) * 256 + wc * 32 + 8 * fq; constexpr float us = F8_YSCALE / (F8_WSCALE * F8_HSCALE);
#pragma unroll
        for (int m = 0; m < 4; ++m) { unsigned char* rowp = O + (size_t)(row0 + m * 16) * D + col0;
#pragma unroll
            for (int bj = 0; bj < 2; ++bj) { const f32x4 a = acc[bj][m][0] * us, b = acc[bj][m][1] * us;
                u32x2 w; w.x = pk4_fp8(__builtin_amdgcn_fmed3f(a[0], -448.f, 448.f), __builtin_amdgcn_fmed3f(a[1], -448.f, 448.f), __builtin_amdgcn_fmed3f(a[2], -448.f, 448.f), __builtin_amdgcn_fmed3f(a[3], -448.f, 448.f));
                w.y = pk4_fp8(__builtin_amdgcn_fmed3f(b[0], -448.f, 448.f), __builtin_amdgcn_fmed3f(b[1], -448.f, 448.f), __builtin_amdgcn_fmed3f(b[2], -448.f, 448.f), __builtin_amdgcn_fmed3f(b[3], -448.f, 448.f));
                *(u32x2*)(rowp + bj * 128) = w; } }
    }
};
struct MoeOrder {
    const volatile LAS int* tb; int G, c; const int* PERM; unsigned* ready; int mode;
    __device__ __forceinline__ bool decode(int L, pg8::Unit& u) const {
        const int x = c & 7; int base = 0;
#pragma unroll 1
        for (int k = 0; k < 4; ++k) { const int e = 4 * x + k, t0 = __builtin_amdgcn_readfirstlane(tb[e]), nt = __builtin_amdgcn_readfirstlane(tb[e + 1]) - t0;
            if (L < base + 4 * nt) { const int idx = L - base; u.pm = t0 + idx % nt; u.pn = e * 4 + idx / nt; return true; }
            base += 4 * nt; }
        return false;
    }
    __device__ __forceinline__ bool next(int i, pg8::Unit& u) const {
        if ((G & 7) == 0) {
            const int x = c & 7, s = c >> 3, nb = G >> 3;
            const int U = 4 * (__builtin_amdgcn_readfirstlane(tb[4 * x + 4]) - __builtin_amdgcn_readfirstlane(tb[4 * x]));
            if (mode == 0) return decode(i * nb + s, u);
            const int i0 = s < U ? (U - s + nb - 1) / nb : 0;
            return decode((i0 + i) * nb + s - U, u);
        }
        const int L = i * G + c, T = __builtin_amdgcn_readfirstlane(tb[32]); if (L >= 4 * T) return false;
        const int tile = L >> 2; int e = 0;
#pragma unroll 1
        for (int j = 1; j < 32; ++j) e += (__builtin_amdgcn_readfirstlane(tb[j]) <= tile) ? 1 : 0;
        u.pm = tile; u.pn = e * 4 + (L & 3); return true;
    }
    __device__ __forceinline__ int row_tok(const pg8::Unit& u, int r) const {
        const int e = u.pn >> 2, rem = __builtin_amdgcn_readfirstlane(tb[64 + e]) - (u.pm - __builtin_amdgcn_readfirstlane(tb[e])) * 128;
        return r < rem ? PERM[u.pm * 128 + r] : 0;
    }
    __device__ __forceinline__ bool half_only(const pg8::Unit&) const { return false; }
    __device__ __forceinline__ void done(const pg8::Unit& u) const {
        if (mode == 2) { asm volatile("s_waitcnt vmcnt(0)" ::: "memory");
            if ((threadIdx.x & 63) == 0) __hip_atomic_fetch_add(ready + 64 * u.pm, 1u, __ATOMIC_RELAXED, __HIP_MEMORY_SCOPE_AGENT); }
    }
    __device__ __forceinline__ void a_ready(const pg8::Unit& u) const {
        if (mode == 1) {
            if (threadIdx.x < 64) { const unsigned long long t0 = __builtin_amdgcn_s_memrealtime();
                while ((unsigned)__builtin_amdgcn_readfirstlane(__hip_atomic_load(ready + 64 * u.pm, __ATOMIC_RELAXED, __HIP_MEMORY_SCOPE_AGENT)) < 32u) {
                    if (__builtin_amdgcn_s_memrealtime() - t0 > 2000000ull) break;
                    __builtin_amdgcn_s_sleep(2); }
                __builtin_amdgcn_fence(__ATOMIC_ACQUIRE, "agent");
                asm volatile("s_waitcnt vmcnt(0)" ::: "memory"); }
            asm volatile("" ::: "memory"); __builtin_amdgcn_s_barrier(); asm volatile("" ::: "memory");
        }
    }
};

namespace mg {
constexpr int TM = 128, BUF = 3 * pg8::HTB;
#define MG_WAIT_V(n) asm volatile("s_waitcnt vmcnt(" #n ")" ::: "memory")
#define MG_WAIT_L0() asm volatile("s_waitcnt lgkmcnt(0)" ::: "memory")
#define MG_BAR() do { asm volatile("" ::: "memory"); __builtin_amdgcn_s_barrier(); asm volatile("" ::: "memory"); __builtin_amdgcn_sched_barrier(0); } while (0)
struct Frags { bf16x8 a[4][2], b[2][2][2]; };
template <class Epi, class Sched, bool GATHER>
__device__ __forceinline__ void gemm(LAS unsigned char* lds, const unsigned char* A, const unsigned char* Bt, int Kb, const Sched& S, const Epi& E) {
    const int tid = opaque_tid(), wid = __builtin_amdgcn_readfirstlane(tid >> 6), lane = tid & 63, wr = wid >> 2, wc = wid & 3, fr = lane & 15, fq = lane >> 4;
    asm volatile("" : "+s"(Kb));
    const int nkt = Kb >> 7;
    unsigned voffB[2], colA[2]; int rowA[2];
#pragma unroll
    for (int i = 0; i < 2; ++i) { int R, C; pg8::stage_rc(tid * 16 + i * 8192, R, C); const int Rb = (R & ~31) + pg8::perm32(R & 31);
        rowA[i] = R; colA[i] = (unsigned)C * 2u; voffB[i] = (unsigned)(Rb * Kb) + (unsigned)C * 2u; }
    const unsigned ldsw = (unsigned)wid * 1024u;
    const int aoff = pg8::lds_byte(wr * 64 + fr, fq * 8), boff = pg8::lds_byte(wc * 32 + fr, fq * 8);
    const size_t bhalf = (size_t)128 * Kb;
#define MG_DMA(slot_, ao_, bb_, kt_) do { _Pragma("unroll") for (int p_ = 0; p_ < 6; ++p_) MG_DMA1(p_, slot_, ao_, bb_, kt_); } while (0)
#define MG_DMA1(p_, slot_, ao_, bb_, kt_) do { const unsigned so_ = (unsigned)(slot_) * BUF; const size_t ko_ = (size_t)(kt_) * 128; \
        if ((p_) < 2) __builtin_amdgcn_global_load_lds((const unsigned*)(A + (size_t)(ao_)[(p_) & 1] + ko_), (LAS unsigned*)(lds + so_ + ldsw + ((p_) & 1) * 8192), 16, 0, 0); \
        else __builtin_amdgcn_global_load_lds((const unsigned*)((bb_) + (((p_) - 2) >> 1) * bhalf + voffB[(p_) & 1] + ko_), (LAS unsigned*)(lds + so_ + (1 + (((p_) - 2) >> 1)) * pg8::HTB + ldsw + ((p_) & 1) * 8192), 16, 0, 0); } while (0)
#define MG_READ(F_, slot_) do { const LAS unsigned char* p_ = lds + (unsigned)(slot_) * BUF; \
        _Pragma("unroll") for (int m = 0; m < 4; ++m) _Pragma("unroll") for (int k = 0; k < 2; ++k) F_.a[m][k] = *(const LAS bf16x8*)(p_ + aoff + m * 2048 + k * 1024); \
        _Pragma("unroll") for (int bj = 0; bj < 2; ++bj) _Pragma("unroll") for (int n = 0; n < 2; ++n) _Pragma("unroll") for (int k = 0; k < 2; ++k) \
            F_.b[bj][n][k] = *(const LAS bf16x8*)(p_ + (1 + bj) * pg8::HTB + boff + n * 2048 + k * 1024); } while (0)
#define MG_MMA1(F_, bj_, m_, n_) do { typedef int v4i_ __attribute__((ext_vector_type(4))); \
        acc[bj_][m_][n_] = __builtin_amdgcn_mfma_scale_f32_16x16x128_f8f6f4(__builtin_shufflevector(__builtin_bit_cast(v4i_, F_.b[bj_][n_][0]), __builtin_bit_cast(v4i_, F_.b[bj_][n_][1]), 0, 1, 2, 3, 4, 5, 6, 7), \
            __builtin_shufflevector(__builtin_bit_cast(v4i_, F_.a[m_][0]), __builtin_bit_cast(v4i_, F_.a[m_][1]), 0, 1, 2, 3, 4, 5, 6, 7), acc[bj_][m_][n_], 0, 0, 0, 0x7F7F7F7F, 0, 0x7F7F7F7F); } while (0)
#define MG_SB() __builtin_amdgcn_sched_barrier(0)
#define MG_READB(F_, slot_) do { const LAS unsigned char* p_ = lds + (unsigned)(slot_) * BUF; \
        _Pragma("unroll") for (int bj = 0; bj < 2; ++bj) _Pragma("unroll") for (int n = 0; n < 2; ++n) _Pragma("unroll") for (int k = 0; k < 2; ++k) \
            F_.b[bj][n][k] = *(const LAS bf16x8*)(p_ + (1 + bj) * pg8::HTB + boff + n * 2048 + k * 1024); } while (0)
#define MG_READA(F_, slot_, m_) do { const LAS unsigned char* p_ = lds + (unsigned)(slot_) * BUF; \
        _Pragma("unroll") for (int k = 0; k < 2; ++k) F_.a[m_][k] = *(const LAS bf16x8*)(p_ + aoff + (m_) * 2048 + k * 1024); } while (0)
#define MG_GROUP(Fc_, Fn_, rslot_, m_) do { MG_MMA1(Fc_, 0, m_, 0); MG_MMA1(Fc_, 0, m_, 1); MG_MMA1(Fc_, 1, m_, 0); MG_MMA1(Fc_, 1, m_, 1); MG_SB(); MG_READA(Fn_, rslot_, m_); MG_SB(); } while (0)
#define MG_STEP(Fc_, Fn_, rslot_, dslot_, ao_, bb_, kt_) do { MG_READB(Fn_, rslot_); MG_SB(); \
        MG_DMA1(0, dslot_, ao_, bb_, kt_); MG_SB(); MG_GROUP(Fc_, Fn_, rslot_, 0); MG_DMA1(1, dslot_, ao_, bb_, kt_); MG_DMA1(2, dslot_, ao_, bb_, kt_); MG_SB(); MG_GROUP(Fc_, Fn_, rslot_, 1); \
        MG_DMA1(3, dslot_, ao_, bb_, kt_); MG_SB(); MG_GROUP(Fc_, Fn_, rslot_, 2); MG_DMA1(4, dslot_, ao_, bb_, kt_); MG_DMA1(5, dslot_, ao_, bb_, kt_); MG_SB(); MG_GROUP(Fc_, Fn_, rslot_, 3); \
        MG_SB(); } while (0)
#define MG_AOFS(dst_, u_) do { _Pragma("unroll") for (int i_ = 0; i_ < 2; ++i_) dst_[i_] = (GATHER ? (unsigned)S.row_tok(u_, rowA[i_]) : (unsigned)((u_).pm * TM + rowA[i_])) * (unsigned)Kb + colA[i_]; } while (0)
    pg8::Unit cur, nxt; int ui = 0;
    if (!S.next(0, cur)) return;
    f32x4 acc[2][4][2];
#pragma unroll
    for (int b = 0; b < 2; ++b)
#pragma unroll
        for (int m = 0; m < 4; ++m)
#pragma unroll
            for (int n = 0; n < 2; ++n) acc[b][m][n] = (f32x4){0.f, 0.f, 0.f, 0.f};
    unsigned ac[2], an[2];
    MG_AOFS(ac, cur);
    const unsigned char* bc = Bt + (size_t)cur.pn * 256 * Kb;
    Frags FA, FB;
    MG_DMA(0, ac, bc, 0); MG_DMA(1, ac, bc, 1); MG_DMA(2, ac, bc, 2);
    MG_WAIT_V(12); MG_BAR();
    MG_READ(FA, 0); MG_WAIT_L0();
    int sl = 0;
    for (;;) {
        const bool has_next = S.next(ui + 1, nxt);
        if (!has_next) nxt = cur;
        const unsigned char* bn = Bt + (size_t)nxt.pn * 256 * Kb;
        MG_AOFS(an, nxt);
#pragma unroll 1
        for (int kt = 0; kt < nkt; kt += 2) {
            if (!(kt == 0 && ui > 0)) MG_WAIT_V(6);
            MG_BAR();
            const int s1 = sl == 2 ? 0 : sl + 1;
            { const bool in_ = kt + 3 < nkt; const unsigned ax[2] = {in_ ? ac[0] : an[0], in_ ? ac[1] : an[1]}; const unsigned char* bx = in_ ? bc : bn; const int kx = in_ ? kt + 3 : kt + 3 - nkt;
              MG_STEP(FA, FB, s1, sl, ax, bx, kx); }
            MG_WAIT_L0();
            MG_WAIT_V(6); MG_BAR();
            const int s2 = s1 == 2 ? 0 : s1 + 1;
            { const bool in_ = kt + 4 < nkt; const unsigned ax[2] = {in_ ? ac[0] : an[0], in_ ? ac[1] : an[1]}; const unsigned char* bx = in_ ? bc : bn; const int kx = in_ ? kt + 4 : kt + 4 - nkt;
              MG_STEP(FB, FA, s2, s1, ax, bx, kx); }
            if (kt + 2 == nkt) { MG_WAIT_V(6); E(acc, cur, wr, wc, fr, fq);
#pragma unroll
                for (int b = 0; b < 2; ++b)
#pragma unroll
                    for (int m = 0; m < 4; ++m)
#pragma unroll
                        for (int n = 0; n < 2; ++n) acc[b][m][n] = (f32x4){0.f, 0.f, 0.f, 0.f}; }
            MG_WAIT_L0();
            sl = s2;
        }
        if (!has_next) break;
        cur = nxt; ac[0] = an[0]; ac[1] = an[1]; bc = bn; ++ui;
    }
    MG_WAIT_V(0); MG_BAR();
#undef MG_DMA
#undef MG_READ
#undef MG_MMA1
#undef MG_STEP
#undef MG_GROUP
#undef MG_READA
#undef MG_READB
#undef MG_DMA1
#undef MG_AOFS
}
}

namespace hg {
typedef short v4i16_t __attribute__((ext_vector_type(4)));
constexpr int S128 = 272, S64 = 144;
constexpr int L_QD = 0, L_QE = L_QD + 64 * S128, L_KE = L_QE + 64 * S128, L_VR = L_KE + 64 * S128, L_ST = L_VR + 64 * S128,
              L_P = L_ST + 128 * S128, L_QS = L_P + 64 * S64, L_DC = L_QS + 16 * 128 * 4, L_END = L_DC + 128 * 4;
static_assert(L_END <= PHASE_LDS, "hgrn LDS");
__device__ __forceinline__ bf16x8 frag(const LAS unsigned char* base, int row, int stride, int kb  ) { return *(const LAS bf16x8*)(base + row * stride + kb); }
__device__ __forceinline__ bf16x8 trfrag(const LAS unsigned char* tile, int tok0, int chan0, int lane) {
    const LAS unsigned char* p = tile + (tok0 + 8 * (lane >> 5) + ((lane & 15) >> 2)) * S128 + (chan0 + 16 * ((lane >> 4) & 1) + 4 * (lane & 3)) * 2;
    const s16x4 lo = __builtin_bit_cast(s16x4, __builtin_amdgcn_ds_read_tr16_b64_v4i16((LAS v4i16_t*)p)), hi = __builtin_bit_cast(s16x4, __builtin_amdgcn_ds_read_tr16_b64_v4i16((LAS v4i16_t*)(p + 4 * S128)));
    return (bf16x8){lo[0], lo[1], lo[2], lo[3], hi[0], hi[1], hi[2], hi[3]};
}

template <bool PASS_C, int ABL = 0>
__device__ __forceinline__ void pass(LAS unsigned char* lds, int unit, const bf16_t* QH, const bf16_t* VH, const half_t* GF, const half_t* GB,
                                     float* HL, float* HD, const float* HS, float* OF, float* OB) {
    typedef _Float16 h4 __attribute__((ext_vector_type(4)));
    const int tid = opaque_tid(), lane = tid & 63, wid = __builtin_amdgcn_readfirstlane(tid >> 6), r32 = lane & 31, hi = lane >> 5;
    const int dir = unit >> 7, head = (unit >> 5) & 3, sc = unit & 31;
    const int kq = tid & 31, tq = tid >> 5;
    const half_t* G = dir ? GB : GF; float* O = dir ? OB : OF;
    const int vi = wid >> 1, ki0 = (wid & 1) * 2;
    f32x16 sacc[2];
    LAS f32x4* QS = (LAS f32x4*)(lds + L_QS); LAS float* DC = (LAS float*)(lds + L_DC);
    if (PASS_C) {
        const float* hs = HS + (size_t)unit * 16384;
#pragma unroll
        for (int tt = 0; tt < 2; ++tt)
#pragma unroll
            for (int r = 0; r < 16; r += 2) { const int v = vi * 32 + crow(r, hi), kk = (ki0 + tt) * 32 + r32; const float s0 = hs[v * 128 + kk], s1 = hs[(v + 1) * 128 + kk]; sacc[tt][r] = s0; sacc[tt][r + 1] = s1;
                const unsigned w = cvtpk(s0, s1); *(LAS bf16_t*)(lds + L_ST + v * S128 + kk * 2) = (bf16_t)(w & 0xffffu); *(LAS bf16_t*)(lds + L_ST + (v + 1) * S128 + kk * 2) = (bf16_t)(w >> 16); }
    } else { sacc[0] = f32x16{}; sacc[1] = f32x16{}; }
    f32x4 btot = {1.f, 1.f, 1.f, 1.f};
    h4 gh[4]; u32x2 qv[4], vv[4];
#define HG_LOAD(c_) do { const int tb_ = sc * 512 + (c_) * 64 + 4 * tq; _Pragma("unroll") for (int i = 0; i < 4; ++i) { const int tl = tb_ + i, tok = dir ? (M - 1 - tl) : tl; \
        const size_t off = (size_t)tok * HSEC + head * 128 + 4 * kq; gh[i] = *(const h4*)(G + off); vv[i] = *(const u32x2*)(VH + off); if (PASS_C) qv[i] = *(const u32x2*)(QH + off); } } while (0)
    HG_LOAD(0);
#pragma unroll 1
    for (int c = 0; c < 8; ++c) {
        const int t0 = sc * 512 + c * 64;
        f32x4 g[4], b[4];
#pragma unroll
        for (int i = 0; i < 4; ++i) { g[i] = (f32x4){(float)gh[i][0], (float)gh[i][1], (float)gh[i][2], (float)gh[i][3]}; b[i] = i ? b[i - 1] * g[i] : g[i]; }
        QS[tq * 32 + kq] = b[3];
        LDS_WAIT(); __syncthreads();
        if (tid < 128) { LAS float* qs = (LAS float*)QS; float run = 1.f;
#pragma unroll
            for (int q = 0; q < 16; ++q) { const float t = qs[q * 128 + tid]; qs[q * 128 + tid] = run; run *= t; }
            DC[tid] = run; }
        LDS_WAIT(); __syncthreads();
        const f32x4 pre = QS[tq * 32 + kq], etot = *(const LAS f32x4*)(DC + 4 * kq);
        btot *= etot;
        f32x4 itot; itot[0] = __builtin_amdgcn_rcpf(etot[0]); itot[1] = __builtin_amdgcn_rcpf(etot[1]); itot[2] = __builtin_amdgcn_rcpf(etot[2]); itot[3] = __builtin_amdgcn_rcpf(etot[3]);
#pragma unroll
        for (int i = 0; i < 4; ++i) { const int tr = 4 * tq + i; float ke[4], qd[4], qe[4];
            const float q4[4] = {bflo(qv[i].x), bfhi(qv[i].x), bflo(qv[i].y), bfhi(qv[i].y)};
#pragma unroll
            for (int cc = 0; cc < 4; ++cc) { const float pb = b[i][cc] * pre[cc];
                ke[cc] = (1.f - g[i][cc]) * etot[cc] * __builtin_amdgcn_rcpf(pb);
                if (PASS_C) { qd[cc] = q4[cc] * pb; qe[cc] = qd[cc] * itot[cc]; } }
            *(LAS u32x2*)(lds + L_KE + tr * S128 + kq * 8) = (u32x2){cvtpk(ke[0], ke[1]), cvtpk(ke[2], ke[3])};
            *(LAS u32x2*)(lds + L_VR + tr * S128 + kq * 8) = vv[i];
            if (PASS_C) { *(LAS u32x2*)(lds + L_QD + tr * S128 + kq * 8) = (u32x2){cvtpk(qd[0], qd[1]), cvtpk(qd[2], qd[3])};
                *(LAS u32x2*)(lds + L_QE + tr * S128 + kq * 8) = (u32x2){cvtpk(qe[0], qe[1]), cvtpk(qe[2], qe[3])}; } }
        LDS_WAIT(); __syncthreads();
        if (c < 7 && !(ABL & 2)) HG_LOAD(c + 1);
        if (PASS_C && !(ABL & 4)) {
            if (wid < 4) {
                const int ti = wid >> 1, si = wid & 1; f32x16 p = f32x16{};
                if (!(ti == 0 && si == 1)) {
#pragma unroll
                    for (int ks = 0; ks < 8; ++ks) p = __builtin_amdgcn_mfma_f32_32x32x16_bf16(frag(lds + L_QE, ti * 32 + r32, S128, ks * 32 + hi * 16), frag(lds + L_KE, si * 32 + r32, S128, ks * 32 + hi * 16), p, 0, 0, 0);
                }
#pragma unroll
                for (int r = 0; r < 16; r += 2) { const int t = ti * 32 + crow(r, hi), s = si * 32 + r32; const unsigned w = cvtpk(s <= t ? p[r] : 0.f, s <= t + 1 ? p[r + 1] : 0.f);
                    *(LAS bf16_t*)(lds + L_P + t * S64 + s * 2) = (bf16_t)(w & 0xffffu); *(LAS bf16_t*)(lds + L_P + (t + 1) * S64 + s * 2) = (bf16_t)(w >> 16); }
            }
            LDS_WAIT(); __syncthreads();
            { const int ti = wid >> 2, vo = wid & 3; f32x16 o = f32x16{};
#pragma unroll
                for (int ks = 0; ks < 8; ++ks) o = __builtin_amdgcn_mfma_f32_32x32x16_bf16(frag(lds + L_QD, ti * 32 + r32, S128, ks * 32 + hi * 16), frag(lds + L_ST, vo * 32 + r32, S128, ks * 32 + hi * 16), o, 0, 0, 0);
#pragma unroll
                for (int ss = 0; ss < 4; ++ss) o = __builtin_amdgcn_mfma_f32_32x32x16_bf16(frag(lds + L_P, ti * 32 + r32, S64, ss * 32 + hi * 16), trfrag(lds + L_VR, ss * 16, vo * 32, lane), o, 0, 0, 0);
#pragma unroll
                for (int r = 0; r < 16; ++r) { const int tl = t0 + ti * 32 + crow(r, hi), tok = dir ? (M - 1 - tl) : tl; if (!(ABL & 1)) O[(size_t)tok * HSEC + head * 128 + vo * 32 + r32] = o[r]; else asm volatile("" :: "v"(o[r])); }
            }
        }
#pragma unroll
        for (int tt = 0; tt < ((ABL & 4) ? 0 : 2); ++tt) { const int ki = ki0 + tt; const float d = DC[ki * 32 + r32];
#pragma unroll
            for (int r = 0; r < 16; ++r) sacc[tt][r] *= d;
#pragma unroll
            for (int ss = 0; ss < 4; ++ss) sacc[tt] = __builtin_amdgcn_mfma_f32_32x32x16_bf16(trfrag(lds + L_VR, ss * 16, vi * 32, lane), trfrag(lds + L_KE, ss * 16, ki * 32, lane), sacc[tt], 0, 0, 0);
        }
        LDS_WAIT(); __syncthreads();
        if (PASS_C) {
#pragma unroll
            for (int tt = 0; tt < 2; ++tt)
#pragma unroll
                for (int r = 0; r < 16; r += 2) { const int v = vi * 32 + crow(r, hi), kk = (ki0 + tt) * 32 + r32; const unsigned w = cvtpk(sacc[tt][r], sacc[tt][r + 1]);
                    *(LAS bf16_t*)(lds + L_ST + v * S128 + kk * 2) = (bf16_t)(w & 0xffffu); *(LAS bf16_t*)(lds + L_ST + (v + 1) * S128 + kk * 2) = (bf16_t)(w >> 16); }
        }
    }
#undef HG_LOAD
    if (!PASS_C) {
        float* hl = HL + (size_t)unit * 16384;
#pragma unroll
        for (int tt = 0; tt < 2; ++tt)
#pragma unroll
            for (int r = 0; r < 16; ++r) { const int v = vi * 32 + crow(r, hi), kk = (ki0 + tt) * 32 + r32; hl[v * 128 + kk] = sacc[tt][r]; }
        if (tq == 0) *(f32x4*)(HD + unit * 128 + 4 * kq) = btot;
    }
    __syncthreads();
}
__device__ __forceinline__ void scan(const float* HL, const float* HD, float* HS, int gtid, int gthreads) {
    for (int id = gtid; id < 8 * 16384; id += gthreads) {
        const int dh = id >> 14, e = id & 16383, k = e & 127; float S = 0.f;
        float hl[32], hd[32];
#pragma unroll
        for (int sc = 0; sc < 32; ++sc) { const int u = dh * 32 + sc; hl[sc] = HL[(size_t)u * 16384 + e]; hd[sc] = HD[u * 128 + k]; }
#pragma unroll
        for (int sc = 0; sc < 32; ++sc) { const int u = dh * 32 + sc; HS[(size_t)u * 16384 + e] = S; S = hd[sc] * S + hl[sc]; }
    }
}
}

namespace att {
__device__ __forceinline__ void hgrn_finalize(int h, int q0, const float* OF, const float* OB, const bf16_t* SG, const float* gain, bf16_t* MIX, int wid, int lane) {
    const float g0 = gain[2 * lane], g1 = gain[2 * lane + 1];
#pragma unroll 1
    for (int i0 = 0; i0 < 32; i0 += 4) { float2 a[4], b[4]; unsigned sg[4]; float x0[4], x1[4], ss[4];
#pragma unroll
        for (int i = 0; i < 4; ++i) { const size_t off = (size_t)(q0 + wid * 32 + i0 + i) * HSEC + h * 128 + 2 * lane; a[i] = *(const float2*)(OF + off); b[i] = *(const float2*)(OB + off); sg[i] = *(const unsigned*)(SG + off); }
#pragma unroll
        for (int i = 0; i < 4; ++i) { x0[i] = a[i].x + b[i].x; x1[i] = a[i].y + b[i].y; ss[i] = x0[i] * x0[i] + x1[i] * x1[i]; }
#pragma unroll
        for (int i = 0; i < 4; ++i) ss[i] = wave_sum(ss[i]);
#pragma unroll
        for (int i = 0; i < 4; ++i) { const float rstd = 1.f / sqrtf(ss[i] * (1.f / 128.f) + 1e-6f);
            *(unsigned*)(MIX + (size_t)(q0 + wid * 32 + i0 + i) * D + h * 128 + 2 * lane) = cvtpk(x0[i] * rstd * g0 * bflo(sg[i]), x1[i] * rstd * g1 * bfhi(sg[i])); } }
}
}

namespace att2 {
typedef short v4i16_t __attribute__((ext_vector_type(4)));
constexpr int KVBLK = 64, LDR = HSEC, NT = M / KVBLK;
constexpr int KSLOT = 8192, VSLOT = 16384, NSLOT = 4;
constexpr int OFF_K = 0, OFF_V = NSLOT * KSLOT, OFF_WS = OFF_V + NSLOT * VSLOT, OFF_END = OFF_WS + NWAVES * 64 * 4;
static_assert(OFF_END <= PHASE_LDS, "attention LDS");
__device__ __forceinline__ s16x4 vtr(const LAS unsigned char* p) { return __builtin_bit_cast(s16x4, __builtin_amdgcn_ds_read_tr16_b64_v4i16((LAS v4i16_t*)p)); }
__device__ __forceinline__ void glds16(const void* sbase, unsigned voff, unsigned lds_dst) { unsigned keep;
    asm volatile("s_mov_b32 %0, m0\n\ts_mov_b32 m0, %3\n\ts_nop 0\n\tglobal_load_lds_dwordx4 %1, %2\n\ts_mov_b32 m0, %0" : "=&s"(keep) : "v"(voff), "s"(sbase), "s"(lds_dst) : "memory"); }
#define ATT2_WAIT_BAR(N) asm volatile("s_waitcnt vmcnt(" #N ") lgkmcnt(0)\n\ts_barrier" ::: "memory")
template <bool DO_QK, bool DO_SM, bool DO_PV, bool DO_DMA = false>
__device__ __forceinline__ void step(f32x16& sn0, f32x16& sn1, f32x16& sc0, f32x16& sc1, const u32x4& pap0, const u32x4& pap1, const u32x4& pap2, const u32x4& pap3,
                                     u32x4& pan0, u32x4& pan1, u32x4& pan2, u32x4& pan3, f32x16 (&o)[4], const bf16x8 (&qr)[4], const f32x16& negm, float& lsum,
                                     const LAS unsigned char* kc, const LAS unsigned char* knn, const LAS unsigned char* vb, bf16x8& kf0, bf16x8& kf1, bf16x8& kf2,
                                     const char* ksrc = nullptr, unsigned kvo = 0, unsigned kds = 0, const char* vsrc = nullptr, unsigned vvo0 = 0, unsigned vvo1 = 0, unsigned vds = 0) {
    bf16x8 fr0 = kf0, fr1 = kf1, fr2 = kf2, fr3 = kf0; unsigned ca0 = 0, ca1 = 0, cb0 = 0, cb1 = 0;
    (void)ca0; (void)ca1; (void)cb0; (void)cb1;
    if (DO_QK) sn0 = __builtin_amdgcn_mfma_f32_32x32x16_bf16(fr0, qr[0], negm, 0, 0, 0);
    SBAR();
    if (DO_QK) { fr3 = *(const LAS bf16x8*)(kc + 2560); }
    if (DO_SM) { sc0[0] = ex2(sc0[0]); sc0[1] = ex2(sc0[1]); }
    SBAR();
    if (DO_QK) sn1 = __builtin_amdgcn_mfma_f32_32x32x16_bf16(fr1, qr[0], negm, 0, 0, 0);
    SBAR();
    if (DO_QK) { fr0 = *(const LAS bf16x8*)(kc + 4096); }
    if (DO_SM) { sc0[2] = ex2(sc0[2]); sc0[3] = ex2(sc0[3]); lsum += sc0[0]; lsum += sc0[1]; }
    SBAR();
    if (DO_QK) sn0 = __builtin_amdgcn_mfma_f32_32x32x16_bf16(fr2, qr[1], sn0, 0, 0, 0);
    SBAR();
    if (DO_QK) { fr1 = *(const LAS bf16x8*)(kc + 4608); }
    if (DO_SM) { sc0[4] = ex2(sc0[4]); sc0[5] = ex2(sc0[5]); lsum += sc0[2]; lsum += sc0[3]; }
    SBAR();
    if (DO_QK) sn1 = __builtin_amdgcn_mfma_f32_32x32x16_bf16(fr3, qr[1], sn1, 0, 0, 0);
    SBAR();
    if (DO_QK) { fr2 = *(const LAS bf16x8*)(kc + 6144); }
    if (DO_SM) { sc0[6] = ex2(sc0[6]); sc0[7] = ex2(sc0[7]); lsum += sc0[4]; lsum += sc0[5]; }
    SBAR();
    if (DO_QK) sn0 = __builtin_amdgcn_mfma_f32_32x32x16_bf16(fr0, qr[2], sn0, 0, 0, 0);
    SBAR();
    if (DO_QK) { fr3 = *(const LAS bf16x8*)(kc + 6656); }
    if (DO_SM) { sc0[8] = ex2(sc0[8]); sc0[9] = ex2(sc0[9]); lsum += sc0[6]; lsum += sc0[7]; }
    SBAR();
    if (DO_QK) sn1 = __builtin_amdgcn_mfma_f32_32x32x16_bf16(fr1, qr[2], sn1, 0, 0, 0);
    SBAR();
    if (DO_PV) { { const s16x4 l_ = vtr(vb + 0), h_ = vtr(vb + 256); fr0 = (bf16x8){l_[0], l_[1], l_[2], l_[3], h_[0], h_[1], h_[2], h_[3]}; } }
    if (DO_SM) { sc0[10] = ex2(sc0[10]); sc0[11] = ex2(sc0[11]); lsum += sc0[8]; lsum += sc0[9]; }
    SBAR();
    if (DO_QK) sn0 = __builtin_amdgcn_mfma_f32_32x32x16_bf16(fr2, qr[3], sn0, 0, 0, 0);
    SBAR();
    if (DO_PV) { { const s16x4 l_ = vtr(vb + 4096), h_ = vtr(vb + 4352); fr1 = (bf16x8){l_[0], l_[1], l_[2], l_[3], h_[0], h_[1], h_[2], h_[3]}; } }
    if (DO_SM) { sc0[12] = ex2(sc0[12]); sc0[13] = ex2(sc0[13]); lsum += sc0[10]; lsum += sc0[11]; }
    SBAR();
    if (DO_QK) sn1 = __builtin_amdgcn_mfma_f32_32x32x16_bf16(fr3, qr[3], sn1, 0, 0, 0);
    SBAR();
    if (DO_PV) { { const s16x4 l_ = vtr(vb + 8192), h_ = vtr(vb + 8448); fr2 = (bf16x8){l_[0], l_[1], l_[2], l_[3], h_[0], h_[1], h_[2], h_[3]}; } }
    if (DO_SM) { sc0[14] = ex2(sc0[14]); sc0[15] = ex2(sc0[15]); lsum += sc0[12]; lsum += sc0[13]; }
    SBAR();
    if (DO_PV) o[0] = __builtin_amdgcn_mfma_f32_32x32x16_bf16(__builtin_bit_cast(bf16x8, pap0), fr0, o[0], 0, 0, 0);
    SBAR();
    if (DO_PV) { { const s16x4 l_ = vtr(vb + 12288), h_ = vtr(vb + 12544); fr3 = (bf16x8){l_[0], l_[1], l_[2], l_[3], h_[0], h_[1], h_[2], h_[3]}; } }
    if (DO_SM) { sc1[0] = ex2(sc1[0]); sc1[1] = ex2(sc1[1]); lsum += sc0[14]; lsum += sc0[15]; }
    SBAR();
    if (DO_PV) o[0] = __builtin_amdgcn_mfma_f32_32x32x16_bf16(__builtin_bit_cast(bf16x8, pap1), fr1, o[0], 0, 0, 0);
    SBAR();
    if (DO_PV) { { const s16x4 l_ = vtr(vb + 512), h_ = vtr(vb + 768); fr0 = (bf16x8){l_[0], l_[1], l_[2], l_[3], h_[0], h_[1], h_[2], h_[3]}; } }
    if (DO_SM) { sc1[2] = ex2(sc1[2]); sc1[3] = ex2(sc1[3]); lsum += sc1[0]; lsum += sc1[1]; }
    SBAR();
    if (DO_PV) o[0] = __builtin_amdgcn_mfma_f32_32x32x16_bf16(__builtin_bit_cast(bf16x8, pap2), fr2, o[0], 0, 0, 0);
    SBAR();
    if (DO_PV) { { const s16x4 l_ = vtr(vb + 4608), h_ = vtr(vb + 4864); fr1 = (bf16x8){l_[0], l_[1], l_[2], l_[3], h_[0], h_[1], h_[2], h_[3]}; } }
    if (DO_SM) { sc1[4] = ex2(sc1[4]); sc1[5] = ex2(sc1[5]); lsum += sc1[2]; lsum += sc1[3]; }
    SBAR();
    if (DO_PV) o[0] = __builtin_amdgcn_mfma_f32_32x32x16_bf16(__builtin_bit_cast(bf16x8, pap3), fr3, o[0], 0, 0, 0);
    SBAR();
    if (DO_PV) { { const s16x4 l_ = vtr(vb + 8704), h_ = vtr(vb + 8960); fr2 = (bf16x8){l_[0], l_[1], l_[2], l_[3], h_[0], h_[1], h_[2], h_[3]}; } }
    if (DO_SM) { sc1[6] = ex2(sc1[6]); sc1[7] = ex2(sc1[7]); lsum += sc1[4]; lsum += sc1[5]; }
    SBAR();
    if (DO_PV) o[1] = __builtin_amdgcn_mfma_f32_32x32x16_bf16(__builtin_bit_cast(bf16x8, pap0), fr0, o[1], 0, 0, 0);
    SBAR();
    if (DO_PV) { { const s16x4 l_ = vtr(vb + 12800), h_ = vtr(vb + 13056); fr3 = (bf16x8){l_[0], l_[1], l_[2], l_[3], h_[0], h_[1], h_[2], h_[3]}; } }
    if (DO_SM) { sc1[8] = ex2(sc1[8]); sc1[9] = ex2(sc1[9]); lsum += sc1[6]; lsum += sc1[7]; }
    SBAR();
    if (DO_PV) o[1] = __builtin_amdgcn_mfma_f32_32x32x16_bf16(__builtin_bit_cast(bf16x8, pap1), fr1, o[1], 0, 0, 0);
    SBAR();
    if (DO_PV) { { const s16x4 l_ = vtr(vb + 1024), h_ = vtr(vb + 1280); fr0 = (bf16x8){l_[0], l_[1], l_[2], l_[3], h_[0], h_[1], h_[2], h_[3]}; } }
    if (DO_SM) { sc1[10] = ex2(sc1[10]); sc1[11] = ex2(sc1[11]); lsum += sc1[8]; lsum += sc1[9]; }
    SBAR();
    if (DO_PV) o[1] = __builtin_amdgcn_mfma_f32_32x32x16_bf16(__builtin_bit_cast(bf16x8, pap2), fr2, o[1], 0, 0, 0);
    SBAR();
    if (DO_PV) { { const s16x4 l_ = vtr(vb + 5120), h_ = vtr(vb + 5376); fr1 = (bf16x8){l_[0], l_[1], l_[2], l_[3], h_[0], h_[1], h_[2], h_[3]}; } }
    if (DO_SM) { sc1[12] = ex2(sc1[12]); sc1[13] = ex2(sc1[13]); lsum += sc1[10]; lsum += sc1[11]; }
    SBAR();
    if (DO_PV) o[1] = __builtin_amdgcn_mfma_f32_32x32x16_bf16(__builtin_bit_cast(bf16x8, pap3), fr3, o[1], 0, 0, 0);
    SBAR();
    if (DO_PV) { { const s16x4 l_ = vtr(vb + 9216), h_ = vtr(vb + 9472); fr2 = (bf16x8){l_[0], l_[1], l_[2], l_[3], h_[0], h_[1], h_[2], h_[3]}; } }
    if (DO_SM) { sc1[14] = ex2(sc1[14]); sc1[15] = ex2(sc1[15]); lsum += sc1[12]; lsum += sc1[13]; }
    SBAR();
    if (DO_PV) o[2] = __builtin_amdgcn_mfma_f32_32x32x16_bf16(__builtin_bit_cast(bf16x8, pap0), fr0, o[2], 0, 0, 0);
    SBAR();
    if (DO_PV) { { const s16x4 l_ = vtr(vb + 13312), h_ = vtr(vb + 13568); fr3 = (bf16x8){l_[0], l_[1], l_[2], l_[3], h_[0], h_[1], h_[2], h_[3]}; } }
    if (DO_SM) { lsum += sc1[14]; lsum += sc1[15]; ca0 = cvtpk(sc0[0], sc0[1]); ca1 = cvtpk(sc0[2], sc0[3]); }
    SBAR();
    if (DO_PV) o[2] = __builtin_amdgcn_mfma_f32_32x32x16_bf16(__builtin_bit_cast(bf16x8, pap1), fr1, o[2], 0, 0, 0);
    SBAR();
    if (DO_PV) { { const s16x4 l_ = vtr(vb + 1536), h_ = vtr(vb + 1792); fr0 = (bf16x8){l_[0], l_[1], l_[2], l_[3], h_[0], h_[1], h_[2], h_[3]}; } }
    if (DO_SM) { cb0 = cvtpk(sc0[4], sc0[5]); cb1 = cvtpk(sc0[6], sc0[7]); pan0 = (u32x4){ca0, ca1, cb0, cb1}; }
    if (DO_DMA) { glds16(ksrc, kvo, kds); }
    SBAR();
    if (DO_PV) o[2] = __builtin_amdgcn_mfma_f32_32x32x16_bf16(__builtin_bit_cast(bf16x8, pap2), fr2, o[2], 0, 0, 0);
    SBAR();
    if (DO_PV) { { const s16x4 l_ = vtr(vb + 5632), h_ = vtr(vb + 5888); fr1 = (bf16x8){l_[0], l_[1], l_[2], l_[3], h_[0], h_[1], h_[2], h_[3]}; } }
    if (DO_SM) { ca0 = cvtpk(sc0[8], sc0[9]); ca1 = cvtpk(sc0[10], sc0[11]); }
    SBAR();
    if (DO_PV) o[2] = __builtin_amdgcn_mfma_f32_32x32x16_bf16(__builtin_bit_cast(bf16x8, pap3), fr3, o[2], 0, 0, 0);
    SBAR();
    if (DO_PV) { { const s16x4 l_ = vtr(vb + 9728), h_ = vtr(vb + 9984); fr2 = (bf16x8){l_[0], l_[1], l_[2], l_[3], h_[0], h_[1], h_[2], h_[3]}; } }
    if (DO_SM) { cb0 = cvtpk(sc0[12], sc0[13]); cb1 = cvtpk(sc0[14], sc0[15]); pan1 = (u32x4){ca0, ca1, cb0, cb1}; }
    if (DO_DMA) { glds16(vsrc, vvo0, vds); }
    SBAR();
    if (DO_PV) o[3] = __builtin_amdgcn_mfma_f32_32x32x16_bf16(__builtin_bit_cast(bf16x8, pap0), fr0, o[3], 0, 0, 0);
    SBAR();
    if (DO_PV) { { const s16x4 l_ = vtr(vb + 13824), h_ = vtr(vb + 14080); fr3 = (bf16x8){l_[0], l_[1], l_[2], l_[3], h_[0], h_[1], h_[2], h_[3]}; } }
    if (DO_SM) { ca0 = cvtpk(sc1[0], sc1[1]); ca1 = cvtpk(sc1[2], sc1[3]); }
    SBAR();
    if (DO_PV) o[3] = __builtin_amdgcn_mfma_f32_32x32x16_bf16(__builtin_bit_cast(bf16x8, pap1), fr1, o[3], 0, 0, 0);
    SBAR();
    kf0 = *(const LAS bf16x8*)(knn + 0);
    if (DO_SM) { cb0 = cvtpk(sc1[4], sc1[5]); cb1 = cvtpk(sc1[6], sc1[7]); pan2 = (u32x4){ca0, ca1, cb0, cb1}; }
    if (DO_DMA) { glds16(vsrc, vvo1, vds + 1024); }
    SBAR();
    if (DO_PV) o[3] = __builtin_amdgcn_mfma_f32_32x32x16_bf16(__builtin_bit_cast(bf16x8, pap2), fr2, o[3], 0, 0, 0);
    SBAR();
    kf1 = *(const LAS bf16x8*)(knn + 512);
    if (DO_SM) { ca0 = cvtpk(sc1[8], sc1[9]); ca1 = cvtpk(sc1[10], sc1[11]); }
    SBAR();
    if (DO_PV) o[3] = __builtin_amdgcn_mfma_f32_32x32x16_bf16(__builtin_bit_cast(bf16x8, pap3), fr3, o[3], 0, 0, 0);
    SBAR();
    kf2 = *(const LAS bf16x8*)(knn + 2048);
    if (DO_SM) { cb0 = cvtpk(sc1[12], sc1[13]); cb1 = cvtpk(sc1[14], sc1[15]); pan3 = (u32x4){ca0, ca1, cb0, cb1}; }
    SBAR();
}

__device__ __forceinline__ void unit(LAS unsigned char* lds, int h, int q0, const bf16_t* __restrict__ QD, const bf16_t* __restrict__ KD, const bf16_t* __restrict__ VD,
                                     const unsigned* KMAX2, float* O0S, float lam, const float* __restrict__ subg, bf16_t* MIX) {
    const int tid = opaque_tid(), wid = __builtin_amdgcn_readfirstlane(tid >> 6), lane = tid & 63, r32 = lane & 31, hi = lane >> 5;
    const unsigned lds0 = (unsigned)(uintptr_t)lds;
    LAS float* ws = (LAS float*)(lds + OFF_WS) + wid * 64;
    const LAS unsigned char* kbase = lds + OFF_K + hi * 1024 + r32 * 16;
    const LAS unsigned char* vbase = lds + OFF_V + (((lane & 3) << 3) | (((lane >> 2) & 3) << 6) | (((lane >> 4) & 1) << 5) | (((lane >> 5) & 1) << 11));
    const unsigned voK = (unsigned)((lane * LDR + wid * 8) * 2);
    unsigned voV[2];
    { const int kk = 8 * wid + ((lane & 31) >> 2), key = (kk & ~0xC) | ((kk & 4) << 1) | ((kk & 8) >> 1);
#pragma unroll
      for (int j = 0; j < 2; ++j) voV[j] = (unsigned)((key * LDR + (2 * j + (lane >> 5)) * 32 + (lane & 3) * 8) * 2); }
    const unsigned kdst = lds0 + OFF_K + wid * 1024, vdst = lds0 + OFF_V + wid * 2048;
#pragma unroll 1
    for (int mp = 0; mp < 2; ++mp) {
        const bf16_t* Kh = KD + h * 128 + mp * 64; const bf16_t* Vh = VD + h * 128;
        const bf16_t* Qw = QD + (size_t)(q0 + wid * 32 + r32) * LDR + h * 128 + mp * 64 + hi * 8;
#define ATT2_DMA_K(t) do { const int t_ = (t) < NT ? (t) : NT - 1; glds16((const char*)Kh + (size_t)t_ * (KVBLK * LDR * 2), voK, (unsigned)__builtin_amdgcn_readfirstlane(kdst + ((t) & 3) * KSLOT)); } while (0)
#define ATT2_DMA_V(t) do { const int t_ = (t) < NT ? (t) : NT - 1; const char* vs_ = (const char*)Vh + (size_t)t_ * (KVBLK * LDR * 2); const unsigned vd_ = (unsigned)__builtin_amdgcn_readfirstlane(vdst + ((t) & 3) * VSLOT); \
        glds16(vs_, voV[0], vd_); glds16(vs_, voV[1], vd_ + 1024); } while (0)
        ATT2_DMA_K(0); ATT2_DMA_K(1); ATT2_DMA_K(2); ATT2_DMA_V(0);
        bf16x8 qr[4]; float qq = 0.f;
#pragma unroll
        for (int d0 = 0; d0 < 4; ++d0) { qr[d0] = *reinterpret_cast<const bf16x8*>(Qw + d0 * 16);
#pragma unroll
            for (int j = 0; j < 8; ++j) { const float q = bf2f((unsigned short)qr[d0][j]); qq += q * q; } }
        { auto rr = __builtin_amdgcn_permlane32_swap(__float_as_uint(qq), __float_as_uint(qq), false, false); qq = __uint_as_float(rr[0]) + __uint_as_float(rr[1]); }
        const float mref = sqrtf(qq * __uint_as_float(KMAX2[(h * 2 + mp) * 64])) * 1.001f;
        f32x16 negm;
#pragma unroll
        for (int r = 0; r < 16; ++r) negm[r] = -mref;
        f32x16 o[4] = {}; float lsum = 0.f;
        f32x16 sA0, sA1, sB0, sB1; u32x4 pX0, pX1, pX2, pX3, pY0, pY1, pY2, pY3;
        sA0 = f32x16{}; sA1 = f32x16{}; sB0 = f32x16{}; sB1 = f32x16{}; pX0 = pX1 = pX2 = pX3 = pY0 = pY1 = pY2 = pY3 = (u32x4){0u, 0u, 0u, 0u};
        bf16x8 kf0, kf1, kf2;
        ATT2_WAIT_BAR(0);
        kf0 = *(const LAS bf16x8*)(kbase); kf1 = *(const LAS bf16x8*)(kbase + 512); kf2 = *(const LAS bf16x8*)(kbase + 2048);
#define KS(t) (kbase + ((t) & 3) * KSLOT)
#define VS(t) (vbase + ((t) & 3) * VSLOT)
        ATT2_DMA_K(3); ATT2_DMA_V(1);
        step<true, false, false>(sA0, sA1, sB0, sB1, pX0, pX1, pX2, pX3, pY0, pY1, pY2, pY3, o, qr, negm, lsum, KS(0), KS(1), VS(0), kf0, kf1, kf2);
        ATT2_WAIT_BAR(3);
        ATT2_DMA_K(4); ATT2_DMA_V(2);
        step<true, true, false>(sB0, sB1, sA0, sA1, pY0, pY1, pY2, pY3, pX0, pX1, pX2, pX3, o, qr, negm, lsum, KS(1), KS(2), VS(0), kf0, kf1, kf2);
        ATT2_WAIT_BAR(3);
#pragma unroll 1
        for (int i = 1; i + 1 < NT - 1; i += 2) {
#define ATT2_TS(t) ((size_t)((t) < NT ? (t) : NT - 1) * (KVBLK * LDR * 2))
#define ATT2_DARGS(tk, tv) (const char*)Kh + ATT2_TS(tk), voK, (unsigned)__builtin_amdgcn_readfirstlane(kdst + ((tk) & 3) * KSLOT), (const char*)Vh + ATT2_TS(tv), voV[0], voV[1], (unsigned)__builtin_amdgcn_readfirstlane(vdst + ((tv) & 3) * VSLOT)
            step<true, true, true, true>(sA0, sA1, sB0, sB1, pX0, pX1, pX2, pX3, pY0, pY1, pY2, pY3, o, qr, negm, lsum, KS(i + 1), KS(i + 2), VS(i - 1), kf0, kf1, kf2, ATT2_DARGS(i + 4, i + 2));
            ATT2_WAIT_BAR(3);
            step<true, true, true, true>(sB0, sB1, sA0, sA1, pY0, pY1, pY2, pY3, pX0, pX1, pX2, pX3, o, qr, negm, lsum, KS(i + 2), KS(i + 3), VS(i), kf0, kf1, kf2, ATT2_DARGS(i + 5, i + 3));
            ATT2_WAIT_BAR(3);
        }
        step<false, true, true>(sA0, sA1, sB0, sB1, pX0, pX1, pX2, pX3, pY0, pY1, pY2, pY3, o, qr, negm, lsum, KS(0), KS(0), VS(NT - 2), kf0, kf1, kf2);
        ATT2_WAIT_BAR(0);
        step<false, false, true>(sB0, sB1, sA0, sA1, pY0, pY1, pY2, pY3, pX0, pX1, pX2, pX3, o, qr, negm, lsum, KS(0), KS(0), VS(NT - 1), kf0, kf1, kf2);
        ATT2_WAIT_BAR(0);
#undef KS
#undef VS
#undef ATT2_DMA_K
#undef ATT2_DMA_V
        { auto rr = __builtin_amdgcn_permlane32_swap(__float_as_uint(lsum), __float_as_uint(lsum), false, false); lsum = __uint_as_float(rr[0]) + __uint_as_float(rr[1]); }
        if (hi == 0) ws[r32] = lsum; asm volatile("s_waitcnt lgkmcnt(0)" ::: "memory");
        int rowb = q0 + wid * 32; asm volatile("" : "+s"(rowb));
        float rli[16];
#pragma unroll
        for (int r = 0; r < 16; ++r) rli[r] = __builtin_amdgcn_rcpf(ws[crow(r, hi)]);
        float* o0p = O0S + tid; asm volatile("" : "+v"(o0p));
        if (mp == 0) {
#pragma unroll
            for (int d0 = 0; d0 < 4; ++d0)
#pragma unroll
                for (int r = 0; r < 16; ++r) o0p[(d0 * 16 + r) * 512] = o[d0][r] * rli[r];
        } else {
            float ss[16];
#pragma unroll
            for (int r = 0; r < 16; ++r) ss[r] = 0.f;
#pragma unroll
            for (int d0 = 0; d0 < 4; ++d0)
#pragma unroll
                for (int r = 0; r < 16; ++r) { const float c = o0p[(d0 * 16 + r) * 512] - lam * o[d0][r] * rli[r]; o[d0][r] = c; ss[r] += c * c; }
#pragma unroll
            for (int r = 0; r < 16; ++r) {
                ss[r] += lane_xor<1>(ss[r]); ss[r] += lane_xor<2>(ss[r]); ss[r] += lane_xor<4>(ss[r]); ss[r] += lane_xor<8>(ss[r]); ss[r] += lane_xor<16>(ss[r]);
                ss[r] = 0.8f / sqrtf(ss[r] * (1.f / 128.f) + 1e-5f); }
#pragma unroll
            for (int d0 = 0; d0 < 4; ++d0) { const float g = subg[d0 * 32 + r32];
#pragma unroll
                for (int r = 0; r < 16; ++r) MIX[(size_t)(rowb + crow(r, hi)) * D + 512 + h * 128 + d0 * 32 + r32] = (bf16_t)f2bf(o[d0][r] * ss[r] * g); }
        }
        asm volatile("s_waitcnt vmcnt(0) lgkmcnt(0)\n\ts_barrier" ::: "memory");
    }
}
__device__ __forceinline__ void kmax_rows(LAS unsigned char* lds, const bf16_t* KD, unsigned* KMAX2, int gw, int ngw, int lane, int wave) {
    float mx = 0.f;
    for (int row0 = gw; row0 < M; row0 += 8 * ngw) { u32x4 w[8];
#pragma unroll
        for (int i = 0; i < 8; ++i) { const int row = row0 + i * ngw; w[i] = row < M ? *(const GAS u32x4*)(KD + (size_t)row * HSEC + lane * 8) : (u32x4){0u, 0u, 0u, 0u}; }
#pragma unroll
        for (int i = 0; i < 8; ++i) { const u32x4 v = w[i];
            float s = bflo(v.x) * bflo(v.x) + bfhi(v.x) * bfhi(v.x) + bflo(v.y) * bflo(v.y) + bfhi(v.y) * bfhi(v.y) + bflo(v.z) * bflo(v.z) + bfhi(v.z) * bfhi(v.z) + bflo(v.w) * bflo(v.w) + bfhi(v.w) * bfhi(v.w);
            s += lane_xor<1>(s); s += lane_xor<2>(s); s += lane_xor<4>(s); mx = fmaxf(mx, s); } }
    LAS float* red = (LAS float*)lds; if ((lane & 7) == 0) red[wave * 8 + (lane >> 3)] = mx;
    LDS_WAIT(); __syncthreads();
    if (wave == 0 && lane < 8) { float m = red[lane];
#pragma unroll
        for (int w = 1; w < NWAVES; ++w) m = fmaxf(m, red[w * 8 + lane]);
        atomicMax(KMAX2 + lane * 64, __float_as_uint(m)); }
    __syncthreads();
}
}

__device__ __forceinline__ void route16(const bf16_t* X2B, const u32x4* WRB, const float* rgb, const float* reb,
                                        float* RSTD, int* TOKE, float* TOKW, int* TOKR, unsigned* GCNT, int row0, int lane, LAS float* wl, bool dry = false) {
    typedef float f32x4_ __attribute__((ext_vector_type(4)));
    const int r = lane & 15, q = lane >> 4;
    LAS unsigned* lc = (LAS unsigned*)(wl + 800);
    if (lane < 32) lc[lane] = 0u;
    f32x4_ acc[3]; acc[0] = (f32x4_){0.f, 0.f, 0.f, 0.f}; acc[1] = acc[0]; acc[2] = acc[0];
    float ssq = 0.f;
    const bf16_t* xp = X2B + (size_t)(row0 + r) * D + 8 * q;
#pragma unroll 8
    for (int ks = 0; ks < 32; ++ks) {
        const u32x4 xw = *(const GAS u32x4*)(xp + ks * 32);
        ssq += (bflo(xw.x) * bflo(xw.x) + bfhi(xw.x) * bfhi(xw.x)) + (bflo(xw.y) * bflo(xw.y) + bfhi(xw.y) * bfhi(xw.y)) + (bflo(xw.z) * bflo(xw.z) + bfhi(xw.z) * bfhi(xw.z)) + (bflo(xw.w) * bflo(xw.w) + bfhi(xw.w) * bfhi(xw.w));
        const bf16x8 xh = __builtin_bit_cast(bf16x8, xw);
#pragma unroll
        for (int nt = 0; nt < 3; ++nt) {
            const bf16x8 wh = __builtin_bit_cast(bf16x8, WRB[((ks * 3 + nt) * 2 + 0) * 64 + lane]), wlo = __builtin_bit_cast(bf16x8, WRB[((ks * 3 + nt) * 2 + 1) * 64 + lane]);
            acc[nt] = __builtin_amdgcn_mfma_f32_16x16x32_bf16(wh, xh, acc[nt], 0, 0, 0);
            acc[nt] = __builtin_amdgcn_mfma_f32_16x16x32_bf16(wlo, xh, acc[nt], 0, 0, 0);
        }
    }
    ssq += lane_xor<16>(ssq);
    { auto rr = __builtin_amdgcn_permlane32_swap(__float_as_uint(ssq), __float_as_uint(ssq), false, false); ssq = __uint_as_float(rr[0]) + __uint_as_float(rr[1]); }
    const float rstd = 1.f / sqrtf(ssq * (1.f / 1024.f) + 1e-6f);
#pragma unroll
    for (int nt = 0; nt < 3; ++nt) *(LAS f32x4_*)(wl + r * 48 + nt * 16 + 4 * q) = acc[nt] * rstd;
    LDS_WAIT();
    float lg[36];
#pragma unroll
    for (int n4 = 0; n4 < 9; ++n4) { const f32x4_ t = *(const LAS f32x4_*)(wl + r * 48 + 4 * n4); lg[4 * n4] = t[0]; lg[4 * n4 + 1] = t[1]; lg[4 * n4 + 2] = t[2]; lg[4 * n4 + 3] = t[3]; }
    float gl[4];
#pragma unroll
    for (int g = 0; g < 4; ++g) gl[g] = lg[g] + rgb[g];
    int gi = 0; float gm = gl[0];
#pragma unroll
    for (int g = 1; g < 4; ++g) if (gl[g] > gm) { gm = gl[g]; gi = g; }
    float gs = 0.f;
#pragma unroll
    for (int g = 0; g < 4; ++g) gs += __expf(gl[g] - gm);
    const float gp = 1.f / gs;
    float e[8];
#pragma unroll
    for (int j = 0; j < 8; ++j) { const float a0 = lg[4 + j] + reb[j], a1 = lg[12 + j] + reb[8 + j], a2 = lg[20 + j] + reb[16 + j], a3 = lg[28 + j] + reb[24 + j];
        e[j] = gi == 0 ? a0 : gi == 1 ? a1 : gi == 2 ? a2 : a3; }
    int i1 = 0; float m1 = e[0];
#pragma unroll
    for (int j = 1; j < 8; ++j) if (e[j] > m1) { m1 = e[j]; i1 = j; }
    int i2 = 0; float m2 = -3.0e38f;
#pragma unroll
    for (int j = 0; j < 8; ++j) if (j != i1 && e[j] > m2) { m2 = e[j]; i2 = j; }
    const float p2 = __expf(m2 - m1);
    const float w1 = gp / (1.f + p2), w2 = gp * p2 / (1.f + p2);
    if (q == 0 && !dry) { const int row = row0 + r; const int e1 = gi * 8 + i1, e2 = gi * 8 + i2;
        const int r1 = (int)__hip_atomic_fetch_add(lc + e1, 1u, __ATOMIC_RELAXED, __HIP_MEMORY_SCOPE_WORKGROUP), r2 = (int)__hip_atomic_fetch_add(lc + e2, 1u, __ATOMIC_RELAXED, __HIP_MEMORY_SCOPE_WORKGROUP);
        RSTD[row] = rstd; TOKE[row * 2] = e1; TOKE[row * 2 + 1] = e2; TOKW[row * 2] = w1; TOKW[row * 2 + 1] = w2; TOKR[row * 2] = r1; TOKR[row * 2 + 1] = r2; }
    LDS_WAIT();
    if (lane < 32 && !dry) GCNT[(row0 >> 4) * 32 + lane] = lc[lane];
}
__device__ __forceinline__ void build_tile_prefix(volatile LAS int* tb, const unsigned* CNT) {
    if (threadIdx.x == 0) { int acc = 0;
        for (int e = 0; e < 32; ++e) { tb[e] = acc; const int c = (int)__hip_atomic_load(CNT + e * CNT_STRIDE, __ATOMIC_RELAXED, __HIP_MEMORY_SCOPE_AGENT); tb[64 + e] = c; acc += (c + 127) >> 7; }
        tb[32] = acc; }
    LDS_WAIT(); __syncthreads();
}
__device__ __forceinline__ void sort_slots(LAS unsigned char* lds, volatile LAS int* tb, const unsigned* GCNT, const int* TOKE, const int* TOKR, int* TOKS, int* PERM, const float* RSTD, float* RSLOT, unsigned* CNT, int blk, int nblk) {
    const int t = opaque_tid(), e = t & 31, j = t >> 5; constexpr int NG = M / 16;
    const int gpb = (NG + nblk - 1) / nblk, g0 = blk * gpb, g1 = g0 + gpb < NG ? g0 + gpb : NG;
    LAS int* part = (LAS int*)lds; LAS int* part2 = part + 512; LAS int* tot = part2 + 512; LAS int* base0 = tot + 32;
    int s = 0, s2 = 0;
    for (int g = j; g < NG; g += 16) { const int c = (int)GCNT[g * 32 + e]; s += c; s2 += g < g0 ? c : 0; }
    part[j * 32 + e] = s; part2[j * 32 + e] = s2;
    LDS_WAIT(); __syncthreads();
    if (t < 32) { int a = 0, b = 0;
#pragma unroll
        for (int jj = 0; jj < 16; ++jj) { a += part[jj * 32 + t]; b += part2[jj * 32 + t]; }
        tot[t] = a; base0[t] = b; if (blk == 0) __hip_atomic_store(CNT + t * CNT_STRIDE, (unsigned)a, __ATOMIC_RELAXED, __HIP_MEMORY_SCOPE_AGENT); }
    LDS_WAIT(); __syncthreads();
    if (t == 0) { int acc = 0; for (int ee = 0; ee < 32; ++ee) { tb[ee] = acc; tb[64 + ee] = tot[ee]; acc += (tot[ee] + 127) >> 7; } tb[32] = acc; }
    LDS_WAIT(); __syncthreads();
    for (int idx = t; idx < (g1 - g0) * 32; idx += 512) { const int gi = idx >> 5, p = (g0 + gi) * 32 + (idx & 31), ex = TOKE[p]; int base = base0[ex];
        for (int g = g0; g < g0 + gi; ++g) base += (int)GCNT[g * 32 + ex];
        const int slot = tb[ex] * 128 + base + TOKR[p]; TOKS[p] = slot; PERM[slot] = p >> 1; RSLOT[slot] = RSTD[p >> 1]; }
}
template <int NR>
__device__ __forceinline__ void final_rows(const bf16_t* X2B, float* OUT, const unsigned char* Y, const int* TOKS, const float* TOKW, const float* gain, int m0, int stride, int lane) {
    typedef float f32x2_ __attribute__((ext_vector_type(2)));
    int s0[NR], s1[NR]; float w0[NR], w1[NR];
#pragma unroll
    for (int i = 0; i < NR; ++i) { const int row = m0 + i * stride; s0[i] = TOKS[row * 2]; s1[i] = TOKS[row * 2 + 1]; w0[i] = TOKW[row * 2] * (1.f / F8_YSCALE); w1[i] = TOKW[row * 2 + 1] * (1.f / F8_YSCALE); }
    u32x2 xx[NR][4]; unsigned ya[NR][4], yb[NR][4];
#pragma unroll
    for (int i = 0; i < NR; ++i) { const int row = m0 + i * stride;
        const GAS u32x2* xr = (const GAS u32x2*)(X2B + (size_t)row * D) + lane; const GAS unsigned* y0 = (const GAS unsigned*)(Y + (size_t)s0[i] * D) + lane; const GAS unsigned* y1 = (const GAS unsigned*)(Y + (size_t)s1[i] * D) + lane;
#pragma unroll
        for (int j = 0; j < 4; ++j) { xx[i][j] = xr[64 * j]; ya[i][j] = y0[64 * j]; yb[i][j] = y1[64 * j]; } }
#pragma unroll
    for (int i = 0; i < NR; ++i) { const int row = m0 + i * stride; f32x4 v[4]; float s = 0.f;
#pragma unroll
        for (int j = 0; j < 4; ++j) { const u32x2 x_ = xx[i][j];
            const f32x2_ a0 = __builtin_amdgcn_cvt_pk_f32_fp8((int)ya[i][j], false), a1 = __builtin_amdgcn_cvt_pk_f32_fp8((int)ya[i][j], true), b0 = __builtin_amdgcn_cvt_pk_f32_fp8((int)yb[i][j], false), b1 = __builtin_amdgcn_cvt_pk_f32_fp8((int)yb[i][j], true);
            v[j].x = bflo(x_.x) + w0[i] * a0[0] + w1[i] * b0[0]; v[j].y = bfhi(x_.x) + w0[i] * a0[1] + w1[i] * b0[1]; v[j].z = bflo(x_.y) + w0[i] * a1[0] + w1[i] * b1[0]; v[j].w = bfhi(x_.y) + w0[i] * a1[1] + w1[i] * b1[1];
            s += (v[j].x * v[j].x + v[j].y * v[j].y) + (v[j].z * v[j].z + v[j].w * v[j].w); }
        const float rstd = 1.f / sqrtf(wave_sum(s) * (1.f / 1024.f) + 1e-6f);
        GAS f32x4* orow = (GAS f32x4*)(OUT + (size_t)row * D) + lane;
#pragma unroll
        for (int j = 0; j < 4; ++j) { const f32x4 g = ((const GAS f32x4*)gain)[64 * j + lane]; orow[64 * j] = v[j] * rstd * g; } }
}
__device__ __forceinline__ void final_rows_piped(const bf16_t* X2B, float* OUT, const unsigned char* Y, const int* TOKS, const float* TOKW, const float* gain, int m0, int stride, int lane) {
    typedef float f32x2_ __attribute__((ext_vector_type(2)));
    if (m0 >= M) return;
    f32x4 g[4];
#pragma unroll
    for (int j = 0; j < 4; ++j) g[j] = ((const GAS f32x4*)gain)[64 * j + lane];
    u32x2 xc[4], xn[4]; unsigned ac[4], bc[4], an[4], bn[4];
    int s0n, s1n; float w0c, w1c, w0n, w1n, w0f = 0.f, w1f = 0.f; int s0f = 0, s1f = 0;
#define FR_META(row_, s0_, s1_, w0_, w1_) do { s0_ = TOKS[(row_) * 2]; s1_ = TOKS[(row_) * 2 + 1]; w0_ = TOKW[(row_) * 2] * (1.f / F8_YSCALE); w1_ = TOKW[(row_) * 2 + 1] * (1.f / F8_YSCALE); } while (0)
#define FR_LOAD(row_, s0_, s1_, x_, a_, b_) do { const GAS u32x2* xr_ = (const GAS u32x2*)(X2B + (size_t)(row_) * D) + lane; const GAS unsigned* y0_ = (const GAS unsigned*)(Y + (size_t)(s0_) * D) + lane; \
        const GAS unsigned* y1_ = (const GAS unsigned*)(Y + (size_t)(s1_) * D) + lane; _Pragma("unroll") for (int j = 0; j < 4; ++j) { x_[j] = xr_[64 * j]; a_[j] = y0_[64 * j]; b_[j] = y1_[64 * j]; } } while (0)
    { int s0c, s1c; FR_META(m0, s0c, s1c, w0c, w1c); FR_LOAD(m0, s0c, s1c, xc, ac, bc); }
    if (m0 + stride < M) FR_META(m0 + stride, s0n, s1n, w0n, w1n); else { s0n = 0; s1n = 0; w0n = 0.f; w1n = 0.f; }
#pragma unroll 1
    for (int row = m0; row < M; row += stride) {
        const int r1 = row + stride, r2 = row + 2 * stride;
        if (r2 < M) FR_META(r2, s0f, s1f, w0f, w1f);
        if (r1 < M) FR_LOAD(r1, s0n, s1n, xn, an, bn);
        f32x4 v[4]; float s = 0.f;
#pragma unroll
        for (int j = 0; j < 4; ++j) { const u32x2 x_ = xc[j];
            const f32x2_ a0 = __builtin_amdgcn_cvt_pk_f32_fp8((int)ac[j], false), a1 = __builtin_amdgcn_cvt_pk_f32_fp8((int)ac[j], true), b0 = __builtin_amdgcn_cvt_pk_f32_fp8((int)bc[j], false), b1 = __builtin_amdgcn_cvt_pk_f32_fp8((int)bc[j], true);
            v[j].x = bflo(x_.x) + w0c * a0[0] + w1c * b0[0]; v[j].y = bfhi(x_.x) + w0c * a0[1] + w1c * b0[1]; v[j].z = bflo(x_.y) + w0c * a1[0] + w1c * b1[0]; v[j].w = bfhi(x_.y) + w0c * a1[1] + w1c * b1[1];
            s += (v[j].x * v[j].x + v[j].y * v[j].y) + (v[j].z * v[j].z + v[j].w * v[j].w); }
        const float rstd = 1.f / sqrtf(wave_sum(s) * (1.f / 1024.f) + 1e-6f);
        GAS f32x4* orow = (GAS f32x4*)(OUT + (size_t)row * D) + lane;
#pragma unroll
        for (int j = 0; j < 4; ++j) orow[64 * j] = v[j] * rstd * g[j];
#pragma unroll
        for (int j = 0; j < 4; ++j) { xc[j] = xn[j]; ac[j] = an[j]; bc[j] = bn[j]; }
        w0c = w0n; w1c = w1n; s0n = s0f; s1n = s1f; w0n = w0f; w1n = w1f;
    }
#undef FR_META
#undef FR_LOAD
}

#ifndef MK_N_LAUNCHES
#define MK_N_LAUNCHES 1
#endif
constexpr int N_PHASES = 12;
struct Args { const void* in[18]; float* out; unsigned char* ws; int ph_lo, ph_hi; };
static_assert(sizeof(Args) == 18 * 8 + 8 + 8 + 8, "Args has no padding");

__global__ void __launch_bounds__(NWAVES * 64, 2) mk_fwd(Args args) {
    extern __shared__ __attribute__((aligned(16))) unsigned char lds_raw[];
    LAS unsigned char* lds = (LAS unsigned char*)lds_raw;
    volatile LAS unsigned* MISC = (volatile LAS unsigned*)(lds + MISC_OFF);
    const int G = gridDim.x, bx = blockIdx.x, vcu = (G % 8 == 0) ? (bx % 8) * (G / 8) + bx / 8 : bx;
    const int NGW = G * NWAVES;
#define PHASE_IDS const int tid = opaque_tid(), lane = tid & 63, wave = __builtin_amdgcn_readfirstlane(tid >> 6), gw = vcu * NWAVES + wave; (void)lane; (void)gw
    const __attribute__((address_space(4))) Args* A = (const __attribute__((address_space(4))) Args*)__builtin_amdgcn_kernarg_segment_ptr();
    asm volatile("" : "+s"(A));
#define ARGF(i) ((const float*)A->in[i])
#define WSP(T, off) ((T*)(A->ws + (off)))
#define x_in ARGF(0)
#define positions ((const int*)A->in[1])
#define norm1_gain ARGF(2)
#define w_in ARGF(3)
#define hg_lb ARGF(4)
#define hg_norm_gain ARGF(5)
#define diff_lambda ARGF(6)
#define subln_gain ARGF(7)
#define w_out ARGF(8)
#define norm2_gain ARGF(9)
#define rg_w ARGF(10)
#define rg_b ARGF(11)
#define re_w ARGF(12)
#define re_b ARGF(13)
#define w_gate ARGF(14)
#define w_up ARGF(15)
#define w_down ARGF(16)
#define final_gain ARGF(17)
#define out (A->out)
#define cosT WSP(float, WS_ROPE)
#define sinT (WSP(float, WS_ROPE) + M * 8)
#define HD WSP(float, WS_HD)
#define TOKE WSP(int, WS_TOKE)
#define TOKW WSP(float, WS_TOKW)
#define TOKR WSP(int, WS_TOKR)
#define TOKS WSP(int, WS_TOKS)
#define LAMP WSP(float, WS_LAM)
#define WOUT WSP(bf16_t, WS_WOUT)
#define WIN WSP(bf16_t, WS_WIN)
#define XN WSP(bf16_t, WS_XN)
#define QH WSP(bf16_t, WS_QH)
#define VH WSP(bf16_t, WS_VH)
#define SG WSP(bf16_t, WS_SG)
#define QD WSP(bf16_t, WS_QD)
#define KD WSP(bf16_t, WS_KD)
#define VD WSP(bf16_t, WS_VD)
#define GF WSP(half_t, WS_GF)
#define GB WSP(half_t, WS_GB)
#define HS WSP(float, WS_HS)
#define HL WSP(float, WS_HL)
#define OF WSP(float, WS_OF)
#define OB WSP(float, WS_OB)
#define MIX WSP(bf16_t, WS_MIX)
#define X2B WSP(bf16_t, WS_X2B)
#define X2F8 WSP(unsigned char, WS_X2F8)
#define WGU WSP(unsigned char, WS_WGU)
#define WD WSP(unsigned char, WS_WD)
#define HGb WSP(bf16_t, WS_HG)
#define HM WSP(unsigned char, WS_HM)
#define Y WSP(unsigned char, WS_Y)
#define CNT (WSP(unsigned, WS_CTL) + CW_CNT)
    unsigned* ctl = WSP(unsigned, WS_CTL);
    volatile LAS int* tb = (volatile LAS int*)(MISC + 16);

    if (threadIdx.x < 64) MISC[threadIdx.x] = 0u;
    __syncthreads();
    XcdBarrier bar; bar.bar = ctl + CW_BAR; bar.x = 0; bar.st = nullptr;
    const int lo = A->ph_lo, hi = A->ph_hi;
    if (hi - lo > 1) bar = xcd_barrier_post(ctl + CW_BAR, MISC);
#ifndef PH_MASK
#define PH_MASK 0xFFF
#endif
#define IN(k) (((PH_MASK >> (k)) & 1) && lo <= (k) && (k) < hi)
#ifndef DOUBLE_PHASE
#define DOUBLE_PHASE -1
#endif
#define REP(k) for (int rep_ = 0; rep_ < ((DOUBLE_PHASE) == (k) ? 2 : 1); ++rep_)
#ifndef BAR_REPS
#define BAR_REPS 1
#endif
#ifdef DIAG_SPAN_A
#define STAMP(k) do { if (blockIdx.x == 0 && threadIdx.x == 0) WSP(unsigned long long, WS_LAM + 64)[k] = __builtin_amdgcn_s_memrealtime(); } while (0)
#else
#define STAMP(k) do { } while (0)
#endif
#define SEAM(k) do { if (IN(k) && IN((k) + 1)) for (int b_ = 0; b_ < BAR_REPS; ++b_) xcd_barrier(bar); STAMP((k) + 1); } while (0)

    STAMP(0);
    if (IN(0)) REP(0) { PHASE_IDS;
        LAS float* scr = (LAS float*)(lds + wave * 16384);
        constexpr int I_IN = (D / 64) * (NIN / 32), I_OUT = (D / 64) * (D / 32);
        { XposeRegs R;
#define P0_LOAD(it_) do { if ((it_) < I_IN) xpose_load(R, w_in, D, NIN, (it_), lane); else xpose_load(R, w_out, D, D, (it_) - I_IN, lane); } while (0)
            if (gw < I_IN + I_OUT) P0_LOAD(gw);
            for (int it = gw; it < I_IN + I_OUT; it += NGW) { const XposeRegs C = R; const int nx = it + NGW;
                if (nx < I_IN + I_OUT) P0_LOAD(nx);
                if (it < I_IN) xpose_store(C, D, NIN, WIN, 0, 1, scr, it, lane); else xpose_store(C, D, D, WOUT, 0, 1, scr, it - I_IN, lane); }
#undef P0_LOAD
        }
        rms_rows_piped(x_in, norm1_gain, XN, gw, NGW, lane, 1e-6f);
        for (int id = bx * 512 + tid; id < M * 8; id += G * 512) {
            const int i = id & 7; const float invf[8] = {1.0f, 0.19392274474868576f, 0.03760603093086393f, 0.007292664737217109f, 0.001414213562373095f, 0.0002742481756762073f, 5.318295896944988e-05f, 1.031338537721246e-05f};
            float f = invf[0];
#pragma unroll
            for (int q = 1; q < 8; ++q) f = (i == q) ? invf[q] : f;
            const float ang = (float)positions[id >> 3] * f;
            const double rev = (double)ang * 0.15915494309189535; const float fr = (float)(rev - __builtin_rint(rev));
            cosT[id] = __builtin_amdgcn_cosf(fr); sinT[id] = __builtin_amdgcn_sinf(fr);
        }
        for (int id = bx * 512 + tid; id < 32 * 3 * 2 * 64; id += G * 512) {
            const int ln = id & 63, part = (id >> 6) & 1, nt = (id >> 7) % 3, ks = (id >> 7) / 3, n = nt * 16 + (ln & 15), k0 = ks * 32 + 8 * (ln >> 4); unsigned w[4];
#pragma unroll
            for (int jj = 0; jj < 4; ++jj) { float v[2];
#pragma unroll
                for (int u = 0; u < 2; ++u) { const int k = k0 + 2 * jj + u; const float wv = (n < 4 ? rg_w[k * 4 + n] : n < 36 ? re_w[k * 32 + (n - 4)] : 0.f) * norm2_gain[k];
                    const float hv = bf2f(f2bf(wv)); v[u] = part ? wv - hv : hv; }
                w[jj] = pk2(v[0], v[1]); }
            WSP(u32x4, WS_WR)[id] = (u32x4){w[0], w[1], w[2], w[3]}; }
        if (bx == 0 && wave == 0) { const float a = wave_sum(diff_lambda[lane] * diff_lambda[64 + lane]), b = wave_sum(diff_lambda[128 + lane] * diff_lambda[192 + lane]);
            if (lane == 0) LAMP[0] = __expf(a) - __expf(b) + 0.2f; }
    }
    SEAM(0);
    if (IN(1)) REP(1) {
        pg8::Gemm g{XN, WIN, M, NIN, D}; pg8::StaticOrder S; S.init(M, NIN, G, bx);
        EpiInProj E{QH, VH, SG, QD, KD, VD, GF, GB, hg_lb, cosT, sinT};
        pg8::gemm_phase<EpiInProj, pg8::StaticOrder, true, true>(lds, g, S, E);
    }
    SEAM(1);
    if (IN(2)) REP(2) { for (int u = vcu; u < 256; u += G) hg::pass<false>(lds, u, QH, VH, GF, GB, HL, HD, HS, OF, OB);
        { PHASE_IDS; att2::kmax_rows(lds, KD, WSP(unsigned, WS_CTL) + CW_KMAX, gw, NGW, lane, wave); } }
    SEAM(2);
    if (IN(3)) REP(3) hg::scan(HL, HD, HS, bx * 512 + opaque_tid(), G * 512);
    SEAM(3);
    if (IN(4)) REP(4) { for (int u = vcu; u < 256; u += G) hg::pass<true>(lds, u, QH, VH, GF, GB, HL, HD, HS, OF, OB); }
    SEAM(4);
    if (IN(5)) REP(5) { PHASE_IDS;
#ifdef DIAG_CLOCK
        if (blockIdx.x == 0 && threadIdx.x == 0) { WSP(unsigned long long, WS_LAM + 64)[20] = __builtin_amdgcn_s_memtime(); WSP(unsigned long long, WS_LAM + 64)[21] = __builtin_amdgcn_s_memrealtime(); }
#endif
        const float lam = LAMP[0];
        for (int u = vcu; u < 256; u += G) { const int h = u >> 6, q0 = (u & 63) * 256;
            int ln = lane; asm volatile("" : "+v"(ln));
            att::hgrn_finalize(h, q0, OF, OB, SG, hg_norm_gain, MIX, wave, ln);
            att2::unit(lds, h, q0, QD, KD, VD, WSP(unsigned, WS_CTL) + CW_KMAX, WSP(float, WS_O0S) + (size_t)bx * 32768, lam, subln_gain, MIX); }
    }
#ifdef DIAG_CLOCK
    if (blockIdx.x == 0 && threadIdx.x == 0) { WSP(unsigned long long, WS_LAM + 64)[22] = __builtin_amdgcn_s_memtime(); WSP(unsigned long long, WS_LAM + 64)[23] = __builtin_amdgcn_s_memrealtime(); }
#endif
    SEAM(5);
    if (IN(6)) REP(6) {
        pg8::Gemm g{MIX, WOUT, M, D, D}; pg8::StaticOrder S; S.init(M, D, G, bx);
        EpiResid E{x_in, X2B, X2F8};
        pg8::gemm_phase<EpiResid, pg8::StaticOrder, true, true>(lds, g, S, E);
    }
    SEAM(6);
    if (IN(7)) { PHASE_IDS;
        const int grp = wave * G + vcu; const bool router = grp * 16 < M;
        LAS float* scr = (LAS float*)(lds + wave * 16384);
        if (router) route16(X2B, WSP(const u32x4, WS_WR), rg_b, re_b, WSP(float, WS_RSTD), TOKE, TOKW, TOKR, WSP(unsigned, WS_GCNT), grp * 16, lane, scr + 3072);
        if (router && (DOUBLE_PHASE) == 77) route16(X2B, WSP(const u32x4, WS_WR), rg_b, re_b, WSP(float, WS_RSTD), TOKE, TOKW, TOKR, WSP(unsigned, WS_GCNT), grp * 16, lane, scr + 3072, true);
        constexpr int I_GU = (D / 64) * (DEXP / 32), I_DN = (DEXP / 64) * (D / 32), I_ALL = NEXP * (2 * I_GU + I_DN);
#ifndef P7_SHARE
#define P7_SHARE 10
#endif
        const int nrt = M / 16, nA = nrt < NGW ? nrt : NGW, nB = NGW - nA;
        const int perA = nB ? (I_ALL * P7_SHARE / 24 + nA - 1) / nA : (I_ALL + nA - 1) / nA, totA = perA * nA < I_ALL ? perA * nA : I_ALL;
        int it0, it1, stp;
        if (router) { it0 = grp; it1 = totA; stp = nA; } else { it0 = totA + (grp - nA); it1 = I_ALL; stp = nB; }
        REP(7) { XposeRegs R0, R1;
#define P7_LOAD(R, it_) do { const int e_ = (it_) / (2 * I_GU + I_DN), r_ = (it_) % (2 * I_GU + I_DN); \
            if (r_ < I_GU) xpose_load(R, w_gate + (size_t)e_ * D * DEXP, D, DEXP, r_, lane); else if (r_ < 2 * I_GU) xpose_load(R, w_up + (size_t)e_ * D * DEXP, D, DEXP, r_ - I_GU, lane); \
            else xpose_load(R, w_down + (size_t)e_ * DEXP * D, DEXP, D, r_ - 2 * I_GU, lane); } while (0)
#define P7_STORE(C, it_) do { const int e = (it_) / (2 * I_GU + I_DN), r = (it_) % (2 * I_GU + I_DN); \
            if (r < I_GU) xpose_store_f8(C, D, DEXP, WGU + (size_t)e * 1024 * D, 0, 2, scr, r, lane, F8_WSCALE, norm2_gain); \
            else if (r < 2 * I_GU) xpose_store_f8(C, D, DEXP, WGU + (size_t)e * 1024 * D, 1, 2, scr, r - I_GU, lane, F8_WSCALE, norm2_gain); \
            else xpose_store_f8(C, DEXP, D, WD + (size_t)e * 1024 * DEXP, 0, 1, scr, r - 2 * I_GU, lane, F8_WSCALE); } while (0)
            if (it0 < it1) P7_LOAD(R0, it0);
            if (it0 + stp < it1) P7_LOAD(R1, it0 + stp);
            for (int it = it0; it < it1; it += 2 * stp) {
                { const XposeRegs C = R0; if (it + 2 * stp < it1) P7_LOAD(R0, it + 2 * stp); P7_STORE(C, it); }
                if (it + stp < it1) { const XposeRegs C = R1; if (it + 3 * stp < it1) P7_LOAD(R1, it + 3 * stp); P7_STORE(C, it + stp); }
            }
#undef P7_STORE
#undef P7_LOAD
        }
    }
    SEAM(7);
    if (IN(8)) REP(8) { sort_slots(lds, tb, WSP(unsigned, WS_GCNT), TOKE, TOKR, TOKS, WSP(int, WS_PERM), WSP(const float, WS_RSTD), WSP(float, WS_RSLOT), CNT, bx, G); }
    SEAM(8);
    if (IN(9)) REP(9) {
        build_tile_prefix(tb, CNT);
        MoeOrder S{tb, G, bx, WSP(const int, WS_PERM), WSP(unsigned, WS_CTL) + CW_READY, 0}; EpiSwiGlu E{HM, WSP(const float, WS_RSLOT)};
        mg::gemm<EpiSwiGlu, MoeOrder, true>(lds, X2F8, WGU, D, S, E);
    }
    SEAM(9);
    if (IN(10)) REP(10) {
        build_tile_prefix(tb, CNT);
        MoeOrder S{tb, G, bx, WSP(const int, WS_PERM), WSP(unsigned, WS_CTL) + CW_READY, 0}; EpiDown E{Y};
        mg::gemm<EpiDown, MoeOrder, false>(lds, HM, WD, DEXP, S, E);
    }
    SEAM(10);
    if (IN(11)) { PHASE_IDS; final_rows_piped(X2B, out, Y, TOKS, TOKW, final_gain, gw, NGW, lane); }
#ifdef DIAG_SPAN_A
    xcd_barrier(bar); STAMP(12); xcd_barrier(bar);
    { const unsigned long long* st_ = WSP(unsigned long long, WS_LAM + 64);
#ifdef DIAG_CLOCK
      const float d_ = (float)(long long)(st_[22] - st_[20]) / (float)(long long)(st_[23] - st_[21]) * 10.f * DIAG_C;
#else
      const float d_ = (float)(long long)(st_[DIAG_SPAN_B] - st_[DIAG_SPAN_A]) * 0.01f * DIAG_C;
#endif
      for (int m = blockIdx.x * 512 + threadIdx.x; m < M; m += gridDim.x * 512) out[(size_t)m * D] += d_; }
#endif
#undef IN
#undef SEAM
#undef x_in
#undef positions
#undef out
#undef Y
#undef HM
#undef CNT
}

extern "C" void kernel_launch(void* const* d_in, const int* in_sizes, int n_in, void* d_out, int out_size, void* d_ws, size_t ws_size, hipStream_t stream) {
    static int grid = 0;
    if (grid == 0) {
        if (n_in != 18 || in_sizes[0] != M * D || out_size != M * D || ws_size < WS_END) { fprintf(stderr, "kernel_launch: unexpected shapes (n_in %d, in0 %d, out %d, ws %zu)\n", n_in, n_in > 0 ? in_sizes[0] : -1, out_size, ws_size); grid = -1; return; }
        int dev = 0, cus = 0, per_cu = 0;
        if (hipGetDevice(&dev) != hipSuccess || hipDeviceGetAttribute(&cus, hipDeviceAttributeMultiprocessorCount, dev) != hipSuccess) { grid = -1; return; }
        if (hipFuncSetAttribute((const void*)mk_fwd, hipFuncAttributeMaxDynamicSharedMemorySize, LDS_BYTES) != hipSuccess) { fprintf(stderr, "kernel_launch: hipFuncSetAttribute failed\n"); grid = -1; return; }
        if (hipOccupancyMaxActiveBlocksPerMultiprocessor(&per_cu, (const void*)mk_fwd, NWAVES * 64, LDS_BYTES) != hipSuccess || per_cu < 1) { fprintf(stderr, "kernel_launch: occupancy query says %d\n", per_cu); (void)hipGetLastError(); grid = -1; return; }
        grid = cus;
    }
    if (grid < 0) return;
    if (hipMemsetAsync((char*)d_ws + WS_CTL, 0, CTL_ZERO_BYTES, stream) != hipSuccess) return;
    Args a{};
    for (int i = 0; i < 18; ++i) a.in[i] = d_in[i];
    a.out = (float*)d_out; a.ws = (unsigned char*)d_ws;
#if MK_N_LAUNCHES == 1
    a.ph_lo = 0; a.ph_hi = N_PHASES;
    hipLaunchKernelGGL(mk_fwd, dim3(grid), dim3(NWAVES * 64), LDS_BYTES, stream, a);
#else
    for (int p = 0; p < N_PHASES; ++p) { a.ph_lo = p; a.ph_hi = p + 1; hipLaunchKernelGGL(mk_fwd, dim3(grid), dim3(NWAVES * 64), LDS_BYTES, stream, a); }
#endif
}
```

```cpp
#include <hip/hip_runtime.h>
#include <cstdio>
#include <cstdint>
__device__ __forceinline__ int opaque_tid() { int t = threadIdx.x; asm volatile("" : "+v"(t)); return t; }
namespace pg8 {
#define PG8_LAS __attribute__((address_space(3)))
typedef unsigned short bf16_t;
typedef short bf16x8 __attribute__((ext_vector_type(8)));
typedef float f32x4 __attribute__((ext_vector_type(4)));
typedef unsigned u32x4 __attribute__((ext_vector_type(4)));
constexpr int BM = 256, BK = 64, HALF = 128, HTB = HALF * BK * 2  , STAGE_BYTES = 8 * HTB, NXCD = 8, WGM = 8;

__host__ __device__ __forceinline__ int lds_byte(int r, int c) { const int st = (r >> 4) * 2 + (c >> 5), rr = r & 15, cc = c & 31, ob = rr * 64 + cc * 2; return st * 1024 + (ob ^ (((ob >> 9) & 1) << 5)); }
__host__ __device__ __forceinline__ void stage_rc(int b, int& R, int& C) { const int st = b / 1024, sb = b % 1024, swz = sb ^ (((sb >> 9) & 1) << 5); R = (st >> 1) * 16 + swz / 64; C = (st & 1) * 32 + (swz % 64) / 2; }
__host__ __device__ __forceinline__ int perm32(int rho) { const int n = rho >> 4, i = rho & 15; return 8 * (i >> 2) + 4 * n + (i & 3); }

struct Unit { int pm, pn; };
struct Gemm { const bf16_t* A; const bf16_t* Bt; int M, N, K; };

struct StaticOrder {
    int nM, nN, nwg, G, c;
    __host__ __device__ void init(int M, int N, int G_, int c_) { nM = M / BM; nN = N / BM; nwg = nM * nN; G = G_; c = c_; }
    __host__ __device__ bool next(int i, Unit& u) const {
        const long L = (long)i * G + c; if (L >= nwg) return false;
        int wgid = (int)L; { const int q = nwg / NXCD, r = nwg % NXCD, xcd = wgid % NXCD, off = wgid / NXCD; wgid = (xcd < r ? xcd * (q + 1) : r * (q + 1) + (xcd - r) * q) + off; }
        const int nig = WGM * nN, gid = wgid / nig, fm = gid * WGM, gsz = (nM - fm) < WGM ? (nM - fm) : WGM;
        u.pm = fm + ((wgid % nig) % gsz); u.pn = (wgid % nig) / gsz; return true;
    }
    __device__ __forceinline__ bool half_only(const Unit&) const { return false; }
    __device__ __forceinline__ void a_ready(const Unit&) const {}
    __device__ __forceinline__ void done(const Unit&) const {}
};

template <class Epi, class Sched, bool ALIGN_EPI = false, bool SP2 = false, bool F8 = false>
__device__ __forceinline__ void gemm_phase(PG8_LAS unsigned char* lds, const Gemm g, const Sched& S, const Epi& E) {
    const int tid = opaque_tid(), wid = __builtin_amdgcn_readfirstlane(tid >> 6), lane = tid & 63, wr = wid >> 2, wc = wid & 3, fr = lane & 15, fq = lane >> 4;
    const int K = g.K, nt = K / BK;
    unsigned voffA[2], voffB[2];
#pragma unroll
    for (int i = 0; i < 2; ++i) { int R, C; stage_rc(tid * 16 + i * 8192, R, C); const int Rb = Epi::PERM ? ((R & ~31) + perm32(R & 31)) : R;
        voffA[i] = (unsigned)(R * K + C) * 2u; voffB[i] = (unsigned)(Rb * K + C) * 2u; }
    const size_t kstep = (size_t)(BK * 2);
    const size_t hstep = (size_t)HALF * K * 2;
    const size_t tstep = 2 * hstep;
    const unsigned ldsw = (unsigned)wid * 1024u;
    const int aoff = lds_byte(wr * 64 + fr, fq * 8), boff = lds_byte(wc * 32 + fr, fq * 8);
#define PG8_SA(b, h) (((b) * 2 + (h)) * HTB)
#define PG8_SB(b, h) ((4 + (b) * 2 + (h)) * HTB)
#define PG8_STAGE(bufoff, gbase, voff) do { _Pragma("unroll") for (int _i = 0; _i < 2; ++_i) \
        __builtin_amdgcn_global_load_lds((const unsigned*)((const char*)(gbase) + (voff)[_i]), (PG8_LAS unsigned*)(lds + (bufoff) + ldsw + _i * 8192), 16, 0, 0); } while (0)
#define PG8_LDA(dst, b, h) do { _Pragma("unroll") for (int m = 0; m < 4; ++m) _Pragma("unroll") for (int k = 0; k < 2; ++k) dst[m][k] = *(const PG8_LAS bf16x8*)(lds + PG8_SA(b, h) + aoff + m * 2048 + k * 1024); } while (0)
#define PG8_LDB(dst, b, h) do { _Pragma("unroll") for (int n = 0; n < 2; ++n) _Pragma("unroll") for (int k = 0; k < 2; ++k) dst[n][k] = *(const PG8_LAS bf16x8*)(lds + PG8_SB(b, h) + boff + n * 2048 + k * 1024); } while (0)
#define PG8_MMA(ai, bj, At, Bt) do { __builtin_amdgcn_s_setprio(1); _Pragma("unroll") for (int m = 0; m < 4; ++m) _Pragma("unroll") for (int n = 0; n < 2; ++n) _Pragma("unroll") for (int k = 0; k < 2; ++k) { \
        if constexpr (F8) { typedef long v2l_ __attribute__((ext_vector_type(2))); const v2l_ b_ = __builtin_bit_cast(v2l_, Bt[n][k]), a_ = __builtin_bit_cast(v2l_, At[m][k]); \
            acc[ai][bj][m][n] = __builtin_amdgcn_mfma_f32_16x16x32_fp8_fp8(b_[0], a_[0], acc[ai][bj][m][n], 0, 0, 0); acc[ai][bj][m][n] = __builtin_amdgcn_mfma_f32_16x16x32_fp8_fp8(b_[1], a_[1], acc[ai][bj][m][n], 0, 0, 0); } \
        else acc[ai][bj][m][n] = __builtin_amdgcn_mfma_f32_16x16x32_bf16(Bt[n][k], At[m][k], acc[ai][bj][m][n], 0, 0, 0); } \
        __builtin_amdgcn_s_setprio(0); } while (0)
#define PG8_WAIT_V(n) asm volatile("s_waitcnt vmcnt(" #n ")" ::: "memory")
#define PG8_WAIT_L(n) asm volatile("s_waitcnt lgkmcnt(" #n ")" ::: "memory")
#define PG8_BAR __builtin_amdgcn_s_barrier()
#define PG8_SCHED __builtin_amdgcn_sched_barrier(0)
    Unit cur, nxt; int ui = 0;
    if (!S.next(0, cur)) return;
    f32x4 acc[2][2][4][2];
#pragma unroll
    for (int a = 0; a < 2; ++a)
#pragma unroll
        for (int b = 0; b < 2; ++b)
#pragma unroll
            for (int m = 0; m < 4; ++m)
#pragma unroll
                for (int n = 0; n < 2; ++n) acc[a][b][m][n] = (f32x4){0.f, 0.f, 0.f, 0.f};
    bf16x8 At[4][2], B0[2][2], B1[2][2];
    const char* cA = (const char*)g.A + (size_t)cur.pm * tstep; const char* cB = (const char*)g.Bt + (size_t)cur.pn * tstep;
    S.a_ready(cur);
    if constexpr (SP2) {
        PG8_STAGE(PG8_SB(0, 0), cB, voffB); PG8_STAGE(PG8_SB(0, 1), cB + hstep, voffB); PG8_STAGE(PG8_SA(0, 0), cA, voffA); PG8_STAGE(PG8_SA(0, 1), cA + hstep, voffA);
        if (wr == 1) PG8_BAR;
        PG8_WAIT_V(2); PG8_BAR;
        PG8_STAGE(PG8_SB(1, 0), cB + kstep, voffB); PG8_STAGE(PG8_SA(1, 0), cA + kstep, voffA); PG8_STAGE(PG8_SB(1, 1), cB + hstep + kstep, voffB);
        PG8_WAIT_V(6); PG8_BAR;
    } else {
        PG8_STAGE(PG8_SB(0, 0), cB, voffB); PG8_STAGE(PG8_SA(0, 0), cA, voffA); PG8_STAGE(PG8_SB(0, 1), cB + hstep, voffB); PG8_STAGE(PG8_SA(0, 1), cA + hstep, voffA);
        if (wr == 1) PG8_BAR;
        PG8_WAIT_V(4); PG8_BAR;
        PG8_STAGE(PG8_SB(1, 0), cB + kstep, voffB); PG8_STAGE(PG8_SA(1, 0), cA + kstep, voffA); PG8_STAGE(PG8_SB(1, 1), cB + hstep + kstep, voffB);
        PG8_WAIT_V(6); PG8_BAR;
    }
    for (;;) {
        const bool has_next = S.next(ui + 1, nxt);
        const char* nA = has_next ? (const char*)g.A + (size_t)nxt.pm * tstep : cA; const char* nB = has_next ? (const char*)g.Bt + (size_t)nxt.pn * tstep : cB;
        for (int t = 0; t < nt; t += 2) {
            const bool last = (t == nt - 2);
            const char* a1 = cA + (size_t)(t + 1) * kstep;
            const char* a2 = last ? nA : cA + (size_t)(t + 2) * kstep; const char* b2 = last ? nB : cB + (size_t)(t + 2) * kstep;
            const char* a3 = a2 + kstep; const char* b3 = b2 + kstep;
            if (last && has_next) S.a_ready(nxt);
            if constexpr (SP2) {
            PG8_LDB(B0, 0, 0); PG8_LDB(B1, 0, 1); PG8_SCHED; PG8_LDA(At, 0, 0); PG8_STAGE(PG8_SA(1, 1), a1 + hstep, voffA);
            PG8_WAIT_V(8); PG8_WAIT_L(0); PG8_BAR; PG8_MMA(0, 0, At, B0); PG8_MMA(0, 1, At, B1); PG8_BAR; PG8_SCHED;
            PG8_LDA(At, 0, 1); PG8_STAGE(PG8_SB(0, 0), b2, voffB); PG8_STAGE(PG8_SB(0, 1), b2 + hstep, voffB); PG8_STAGE(PG8_SA(0, 0), a2, voffA);
            PG8_WAIT_V(8); PG8_WAIT_L(0); PG8_BAR; PG8_MMA(1, 0, At, B0); PG8_MMA(1, 1, At, B1); PG8_BAR; PG8_SCHED;
            PG8_LDB(B0, 1, 0); PG8_LDB(B1, 1, 1); PG8_SCHED; PG8_LDA(At, 1, 0); PG8_STAGE(PG8_SA(0, 1), a2 + hstep, voffA);
            PG8_WAIT_V(8); PG8_WAIT_L(0); PG8_BAR; PG8_MMA(0, 0, At, B0); PG8_MMA(0, 1, At, B1); PG8_BAR; PG8_SCHED;
            PG8_LDA(At, 1, 1); PG8_STAGE(PG8_SB(1, 0), b3, voffB); PG8_STAGE(PG8_SB(1, 1), b3 + hstep, voffB); PG8_STAGE(PG8_SA(1, 0), a3, voffA);
            PG8_WAIT_V(8); PG8_WAIT_L(0); PG8_BAR; PG8_MMA(1, 0, At, B0); PG8_MMA(1, 1, At, B1); PG8_BAR; PG8_SCHED;
            } else {
            PG8_LDB(B0, 0, 0); PG8_SCHED; PG8_LDA(At, 0, 0); PG8_STAGE(PG8_SA(1, 1), a1 + hstep, voffA);
            PG8_WAIT_L(8); PG8_BAR; PG8_WAIT_L(0); PG8_MMA(0, 0, At, B0); PG8_BAR; PG8_SCHED;
            PG8_LDB(B1, 0, 1); PG8_STAGE(PG8_SB(0, 0), b2, voffB);
            PG8_BAR; PG8_WAIT_L(0); PG8_MMA(0, 1, At, B1); PG8_BAR;
            PG8_LDA(At, 0, 1); PG8_STAGE(PG8_SA(0, 0), a2, voffA);
            PG8_BAR; PG8_WAIT_L(0); PG8_MMA(1, 0, At, B0); PG8_BAR; PG8_SCHED;
            PG8_STAGE(PG8_SB(0, 1), b2 + hstep, voffB);
            PG8_WAIT_V(6); PG8_BAR; PG8_MMA(1, 1, At, B1); PG8_BAR;
            PG8_LDB(B0, 1, 0); PG8_SCHED; PG8_LDA(At, 1, 0); PG8_STAGE(PG8_SA(0, 1), a2 + hstep, voffA);
            PG8_WAIT_L(8); PG8_BAR; PG8_WAIT_L(0); PG8_MMA(0, 0, At, B0); PG8_BAR; PG8_SCHED;
            PG8_LDB(B1, 1, 1); PG8_STAGE(PG8_SB(1, 0), b3, voffB);
            PG8_BAR; PG8_WAIT_L(0); PG8_MMA(0, 1, At, B1); PG8_BAR;
            PG8_LDA(At, 1, 1); PG8_STAGE(PG8_SA(1, 0), a3, voffA);
            PG8_BAR; PG8_WAIT_L(0); PG8_MMA(1, 0, At, B0); PG8_BAR; PG8_SCHED;
            PG8_STAGE(PG8_SB(1, 1), b3 + hstep, voffB);
            PG8_WAIT_V(6); PG8_BAR; PG8_MMA(1, 1, At, B1); PG8_BAR;
            }
        }
        if constexpr (ALIGN_EPI) { if (wr == 0) PG8_BAR; }
        if constexpr (!Epi::AFTER_DRAIN) { E(acc, cur, wr, wc, fr, fq); S.done(cur); }
        if (!has_next) break;
#pragma unroll
        for (int a = 0; a < 2; ++a)
#pragma unroll
            for (int b = 0; b < 2; ++b)
#pragma unroll
                for (int m = 0; m < 4; ++m)
#pragma unroll
                    for (int n = 0; n < 2; ++n) acc[a][b][m][n] = (f32x4){0.f, 0.f, 0.f, 0.f};
        cur = nxt; cA = nA; cB = nB; ++ui;
        if constexpr (ALIGN_EPI) { if (wr == 1) PG8_BAR; }
    }
    PG8_WAIT_V(0);
    if constexpr (!ALIGN_EPI) { if (wr == 0) PG8_BAR; }
    PG8_BAR;
    if constexpr (Epi::AFTER_DRAIN) { E.fused(acc, cur, wr, wc, fr, fq, lds, wid, lane); S.done(cur); }
#undef PG8_SA
#undef PG8_SB
#undef PG8_STAGE
#undef PG8_LDA
#undef PG8_LDB
#undef PG8_MMA
#undef PG8_WAIT_V
#undef PG8_WAIT_L
#undef PG8_BAR
#undef PG8_SCHED
}
}

constexpr int NWAVES = 8;
constexpr int M = 16384, D = 1024, NIN = 4096, HSEC = 512;
constexpr int NEXP = 32, DEXP = 512, MAXTILES = 160, MAXSLOTS = MAXTILES * 256;
constexpr float QSCALE = 0.18033688011112042f;

constexpr size_t MiB = 1u << 20;
constexpr size_t WS_CTL = 0, CTL_ZERO_BYTES = 1 * MiB;
constexpr size_t WS_WR = 1 * MiB;
constexpr size_t WS_ROPE = 2 * MiB;
constexpr size_t WS_HD = 3 * MiB;
constexpr size_t WS_TOKE = 3 * MiB + 256 * 1024, WS_TOKW = WS_TOKE + 128 * 1024, WS_TOKR = WS_TOKW + 128 * 1024, WS_TOKS = WS_TOKR + 128 * 1024, WS_LAM = WS_TOKS + 128 * 1024, WS_GCNT = WS_LAM + 128 * 1024, WS_RSTD = 1 * MiB + 256 * 1024, WS_RSLOT = 1 * MiB + 768 * 1024, WS_PERM = 1 * MiB + 512 * 1024;
constexpr size_t WS_WOUT = 4 * MiB, WS_WIN = 6 * MiB;
constexpr size_t WS_XN = 16 * MiB;
constexpr size_t WS_OF = 16 * MiB;
constexpr size_t WS_X2B = 16 * MiB;
constexpr size_t WS_HM = 144 * MiB;
constexpr size_t WS_X2F8 = 112 * MiB;
constexpr size_t WS_QH = 48 * MiB, WS_VH = 64 * MiB, WS_SG = 80 * MiB, WS_QD = 96 * MiB, WS_KD = 112 * MiB, WS_VD = 128 * MiB;
constexpr size_t WS_WGU = 48 * MiB, WS_WD = 216 * MiB;
constexpr size_t WS_GF = 144 * MiB, WS_GB = 176 * MiB;
constexpr size_t WS_MIX = 144 * MiB;
constexpr size_t WS_HS = 208 * MiB, WS_HL = 224 * MiB;
constexpr size_t WS_OB = 224 * MiB;
constexpr size_t WS_HG = 176 * MiB;
constexpr size_t WS_O0S = 176 * MiB;
constexpr size_t WS_Y = 48 * MiB;
constexpr size_t WS_END = 256 * MiB;
static_assert(WS_Y + (size_t)MAXSLOTS * 1024 * 2 <= WS_HM && WS_HM + (size_t)MAXSLOTS * 512 * 2 <= WS_WD && WS_WD + 32 * MiB <= WS_END, "ws map");
constexpr int CW_BAR = 4096, CW_CNT = 16384, CW_KMAX = 20480, CW_QWD = 21504, CW_READY = 32768, CNT_STRIDE = 64;

constexpr int PHASE_LDS = 147456, MISC_OFF = PHASE_LDS, LDS_BYTES = PHASE_LDS + 1024;

#define GAS __attribute__((address_space(1)))
#define LAS __attribute__((address_space(3)))
typedef unsigned short bf16_t;
typedef _Float16 half_t;
typedef float f32x4 __attribute__((ext_vector_type(4)));
typedef float f32x16 __attribute__((ext_vector_type(16)));
typedef short bf16x8 __attribute__((ext_vector_type(8)));
typedef short s16x4 __attribute__((ext_vector_type(4)));
typedef unsigned u32x4 __attribute__((ext_vector_type(4)));
typedef unsigned u32x2 __attribute__((ext_vector_type(2)));
#define LDS_WAIT() asm volatile("s_waitcnt lgkmcnt(0)" ::: "memory")
#define VM_WAIT() asm volatile("s_waitcnt vmcnt(0)" ::: "memory")
#define SBAR() __builtin_amdgcn_sched_barrier(0)
__device__ __forceinline__ unsigned f2bf(float f) { unsigned u = __builtin_bit_cast(unsigned, f); return (u + 0x7fffu + ((u >> 16) & 1u)) >> 16; }
__device__ __forceinline__ unsigned pk2(float lo, float hi) { return f2bf(lo) | (f2bf(hi) << 16); }
__device__ __forceinline__ float bf2f(unsigned b) { return __builtin_bit_cast(float, b << 16); }
__device__ __forceinline__ float bflo(unsigned w) { return __builtin_bit_cast(float, w << 16); }
__device__ __forceinline__ float bfhi(unsigned w) { return __builtin_bit_cast(float, w & 0xffff0000u); }
__device__ __forceinline__ unsigned cvtpk(float lo, float hi) { unsigned r; asm volatile("v_cvt_pk_bf16_f32 %0, %1, %2" : "=v"(r) : "v"(lo), "v"(hi)); return r; }
__device__ __forceinline__ unsigned pk4_fp8(float a, float b, float c, float d) { int w = 0; w = __builtin_amdgcn_cvt_pk_fp8_f32(a, b, w, false); w = __builtin_amdgcn_cvt_pk_fp8_f32(c, d, w, true); return (unsigned)w; }
constexpr float F8_WSCALE = 256.f, F8_HSCALE = 16.f, F8_YSCALE = 32.f;
__device__ __forceinline__ float ex2(float x) { return __builtin_amdgcn_exp2f(x); }
__device__ __forceinline__ float lg2(float x) { return __builtin_amdgcn_logf(x); }
__device__ __forceinline__ float sigmoidf_(float v) { return __builtin_amdgcn_rcpf(1.f + ex2(-1.4426950408889634f * v)); }
__device__ __forceinline__ bool lane_is_hi() { return (opaque_tid() & 32) != 0; }
template <int X> __device__ __forceinline__ float lane_xor(float v) {
    if constexpr (X == 32) { auto rr = __builtin_amdgcn_permlane32_swap(__float_as_uint(v), __float_as_uint(v), false, false); return __uint_as_float(lane_is_hi() ? rr[0] : rr[1]); }
    else return __int_as_float(__builtin_amdgcn_ds_swizzle(__float_as_int(v), (X << 10) | 0x1F));
}
__device__ __forceinline__ float wave_sum(float v) {
    v += lane_xor<1>(v); v += lane_xor<2>(v); v += lane_xor<4>(v); v += lane_xor<8>(v); v += lane_xor<16>(v);
    auto rr = __builtin_amdgcn_permlane32_swap(__float_as_uint(v), __float_as_uint(v), false, false);
    return __uint_as_float(rr[0]) + __uint_as_float(rr[1]);
}
__device__ __forceinline__ int crow(int r, int hi) { return (r & 3) + 8 * (r >> 2) + 4 * hi; }
#define XB_TMO      128
#define XB_XCNT(j)  (256  + 64 * (j))
#define XB_XSUB(j)  (1280 + 64 * (j))
#define XB_XGEN(j)  (2304 + 64 * (j))
#define XB_TOP      3328
#define XB_TOPGEN   3392
#define XCD_BAR_WORDS 3456
#define XB_SPIN_CAP (1u << 18)

__device__ __forceinline__ unsigned xb_ld(unsigned* p)              { return __hip_atomic_load(p, __ATOMIC_RELAXED, __HIP_MEMORY_SCOPE_AGENT); }
__device__ __forceinline__ unsigned xb_add(unsigned* p, unsigned v) { return __hip_atomic_fetch_add(p, v, __ATOMIC_RELAXED, __HIP_MEMORY_SCOPE_AGENT); }
__device__ __forceinline__ unsigned xb_xcc_id() { return (unsigned)__builtin_amdgcn_s_getreg((3 << 11) | 20) & 0xFu; }
#define XB_SPIN(cond, bar) do { unsigned _sp = 0; while (cond) { __builtin_amdgcn_s_sleep(1); \
    if ((++_sp & 255u) == 0u) { if (xb_ld(&(bar)[XB_TMO])) break; if (_sp > XB_SPIN_CAP) { atomicAdd(&(bar)[XB_TMO], 1u); break; } } } } while (0)

struct XcdBarrier {
    unsigned* bar; unsigned x;
    volatile LAS unsigned* st;
};

__device__ __forceinline__ XcdBarrier xcd_barrier_post(unsigned* bar, volatile LAS unsigned* st) {
    XcdBarrier b; b.bar = bar; b.x = xb_xcc_id(); b.st = st;
    if (threadIdx.x == 0) (void)xb_add(&bar[XB_XCNT(b.x)], 1u);
    return b;
}
__device__ __forceinline__ void xcd_barrier_complete(unsigned* bar, unsigned x, unsigned& nloc, unsigned& nx) {
    const unsigned G = gridDim.x * gridDim.y * gridDim.z;
    unsigned sum, cnt, mine, sp = 0u;
    for (;;) {
        sum = 0u; cnt = 0u; mine = 0u;
#pragma unroll
        for (unsigned j = 0; j < 16; ++j) { const unsigned c = xb_ld(&bar[XB_XCNT(j)]); sum += c; cnt += (c > 0u) ? 1u : 0u; mine = (j == x) ? c : mine; }
        if (sum == G) break;
        __builtin_amdgcn_s_sleep(1);
        if ((++sp & 255u) == 0u) { if (xb_ld(&bar[XB_TMO])) break; if (sp > XB_SPIN_CAP) { atomicAdd(&bar[XB_TMO], 1u); break; } }
    }
    nloc = mine > 0u ? mine : 1u; nx = cnt > 0u ? cnt : 1u;
}

__device__ __forceinline__ void xcd_barrier(const XcdBarrier& b) {
    asm volatile("s_waitcnt vmcnt(0)" ::: "memory");
    __syncthreads();
    if (threadIdx.x == 0) {
        unsigned* bar = b.bar;
        __builtin_amdgcn_s_waitcnt(0);
        unsigned nloc = b.st[0], nx = b.st[1];
        if (nloc == 0u) { xcd_barrier_complete(bar, b.x, nloc, nx); b.st[0] = nloc; b.st[1] = nx; }
        const unsigned old = xb_add(&bar[XB_XSUB(b.x)], 1u);
        const unsigned gen = old / nloc;
        if (old + 1u == (gen + 1u) * nloc) {
            __builtin_amdgcn_fence(__ATOMIC_RELEASE, "agent");
            asm volatile("s_waitcnt vmcnt(0)" ::: "memory");
            const unsigned og = xb_add(&bar[XB_TOP], 1u);
            const unsigned tg = og / nx;
            if (og + 1u == (tg + 1u) * nx) xb_add(&bar[XB_TOPGEN], 1u);
            else XB_SPIN(xb_ld(&bar[XB_TOPGEN]) == tg, bar);
            __builtin_amdgcn_fence(__ATOMIC_ACQUIRE, "agent");
            xb_add(&bar[XB_XGEN(b.x)], 1u);
            asm volatile("s_waitcnt vmcnt(0)" ::: "memory");
        } else {
            XB_SPIN(xb_ld(&bar[XB_XGEN(b.x)]) == gen, bar);
            __builtin_amdgcn_fence(__ATOMIC_ACQUIRE, "agent");
            asm volatile("s_waitcnt vmcnt(0)" ::: "memory");
        }
    }
    __syncthreads();
}

struct XposeRegs { f32x4 v[8]; };
__device__ __forceinline__ void xpose_load(XposeRegs& R, const float* W, int K, int N, int item, int lane) {
    const int nblk = N / 32, kb = item / nblk, nb = item % nblk, k0 = 64 * kb, n0 = 32 * nb; (void)K;
    const float* p = W + (size_t)(k0 + (lane >> 3)) * N + n0 + (lane & 7) * 4;
#pragma unroll
    for (int i = 0; i < 8; ++i) R.v[i] = __builtin_nontemporal_load((const GAS f32x4*)(p + (size_t)(8 * i) * N));
}
__device__ __forceinline__ void xpose_store(const XposeRegs& R, int K, int N, bf16_t* WT, int row_off, int row_mul, LAS float* scr, int item, int lane, const float* kgain = nullptr) {
    const int nblk = N / 32, kb = item / nblk, nb = item % nblk, k0 = 64 * kb, n0 = 32 * nb;
#pragma unroll
    for (int i = 0; i < 8; ++i) { LAS float* d = scr + (8 * i + (lane >> 3)) * 33 + (lane & 7) * 4; d[0] = R.v[i].x; d[1] = R.v[i].y; d[2] = R.v[i].z; d[3] = R.v[i].w; }
    LDS_WAIT(); asm volatile("" ::: "memory");
    const int c = lane & 7;
    f32x4 g0 = {1.f, 1.f, 1.f, 1.f}, g1 = g0;
    if (kgain) { g0 = *(const GAS f32x4*)(kgain + k0 + 8 * c); g1 = *(const GAS f32x4*)(kgain + k0 + 8 * c + 4); }
#pragma unroll
    for (int j = 0; j < 4; ++j) { const int n = (lane >> 3) + 8 * j; const LAS float* s = scr + (8 * c) * 33 + n;
        u32x4 o; o.x = cvtpk(s[0 * 33] * g0.x, s[1 * 33] * g0.y); o.y = cvtpk(s[2 * 33] * g0.z, s[3 * 33] * g0.w); o.z = cvtpk(s[4 * 33] * g1.x, s[5 * 33] * g1.y); o.w = cvtpk(s[6 * 33] * g1.z, s[7 * 33] * g1.w);
        *(GAS u32x4*)(WT + (size_t)(row_off + (n0 + n) * row_mul) * K + k0 + 8 * c) = o; }
    LDS_WAIT(); asm volatile("" ::: "memory");
}
__device__ __forceinline__ void xpose_store_f8(const XposeRegs& R, int K, int N, unsigned char* WT, int row_off, int row_mul, LAS float* scr, int item, int lane, float scale, const float* kgain = nullptr) {
    const int nblk = N / 32, kb = item / nblk, nb = item % nblk, k0 = 64 * kb, n0 = 32 * nb;
#pragma unroll
    for (int i = 0; i < 8; ++i) { LAS float* d = scr + (8 * i + (lane >> 3)) * 33 + (lane & 7) * 4; d[0] = R.v[i].x; d[1] = R.v[i].y; d[2] = R.v[i].z; d[3] = R.v[i].w; }
    LDS_WAIT(); asm volatile("" ::: "memory");
    const int c = lane & 7;
    f32x4 g0 = {scale, scale, scale, scale}, g1 = g0;
    if (kgain) { g0 = *(const GAS f32x4*)(kgain + k0 + 8 * c) * scale; g1 = *(const GAS f32x4*)(kgain + k0 + 8 * c + 4) * scale; }
#pragma unroll
    for (int j = 0; j < 4; ++j) { const int n = (lane >> 3) + 8 * j; const LAS float* s = scr + (8 * c) * 33 + n;
        u32x2 o; o.x = pk4_fp8(s[0 * 33] * g0.x, s[1 * 33] * g0.y, s[2 * 33] * g0.z, s[3 * 33] * g0.w); o.y = pk4_fp8(s[4 * 33] * g1.x, s[5 * 33] * g1.y, s[6 * 33] * g1.z, s[7 * 33] * g1.w);
        *(GAS u32x2*)(WT + (size_t)(row_off + (n0 + n) * row_mul) * K + k0 + 8 * c) = o; }
    LDS_WAIT(); asm volatile("" ::: "memory");
}
template <int NR>
__device__ __forceinline__ void rms_rows_to_bf16(const float* X, const float* gain, bf16_t* O, int m0, int stride, int lane, float eps) {
    f32x4 v[NR][4]; float s[NR];
#pragma unroll
    for (int i = 0; i < NR; ++i) { const GAS f32x4* xr = (const GAS f32x4*)(X + (size_t)(m0 + i * stride) * D) + lane;
#pragma unroll
        for (int j = 0; j < 4; ++j) v[i][j] = xr[64 * j]; }
#pragma unroll
    for (int i = 0; i < NR; ++i) { float t = 0.f;
#pragma unroll
        for (int j = 0; j < 4; ++j) t += (v[i][j].x * v[i][j].x + v[i][j].y * v[i][j].y) + (v[i][j].z * v[i][j].z + v[i][j].w * v[i][j].w);
        s[i] = t; }
#pragma unroll
    for (int i = 0; i < NR; ++i) s[i] = 1.f / sqrtf(wave_sum(s[i]) * (1.f / 1024.f) + eps);
#pragma unroll
    for (int j = 0; j < 4; ++j) { const f32x4 g = ((const GAS f32x4*)gain)[64 * j + lane];
#pragma unroll
        for (int i = 0; i < NR; ++i) { u32x2 w; w.x = cvtpk(v[i][j].x * s[i] * g.x, v[i][j].y * s[i] * g.y); w.y = cvtpk(v[i][j].z * s[i] * g.z, v[i][j].w * s[i] * g.w);
            ((GAS u32x2*)(O + (size_t)(m0 + i * stride) * D) + lane)[64 * j] = w; } }
}

__device__ __forceinline__ void rms_rows_piped(const float* X, const float* gain, bf16_t* O, int m0, int stride, int lane, float eps) {
    if (m0 >= M) return;
    f32x4 g[4], c[4], n[4];
#pragma unroll
    for (int j = 0; j < 4; ++j) { g[j] = ((const GAS f32x4*)gain)[64 * j + lane]; c[j] = ((const GAS f32x4*)(X + (size_t)m0 * D) + lane)[64 * j]; }
#pragma unroll 1
    for (int row = m0; row < M; row += stride) {
        if (row + stride < M) {
#pragma unroll
            for (int j = 0; j < 4; ++j) n[j] = ((const GAS f32x4*)(X + (size_t)(row + stride) * D) + lane)[64 * j]; }
        float t = 0.f;
#pragma unroll
        for (int j = 0; j < 4; ++j) t += (c[j].x * c[j].x + c[j].y * c[j].y) + (c[j].z * c[j].z + c[j].w * c[j].w);
        const float s = 1.f / sqrtf(wave_sum(t) * (1.f / 1024.f) + eps);
#pragma unroll
        for (int j = 0; j < 4; ++j) { u32x2 w; w.x = cvtpk(c[j].x * s * g[j].x, c[j].y * s * g[j].y); w.y = cvtpk(c[j].z * s * g[j].z, c[j].w * s * g[j].w); ((GAS u32x2*)(O + (size_t)row * D) + lane)[64 * j] = w; }
#pragma unroll
        for (int j = 0; j < 4; ++j) c[j] = n[j];
    }
}

struct EpiInProj {
    static constexpr bool PERM = true, AFTER_DRAIN = false;
    bf16_t *QH, *VH, *SG, *QD, *KD, *VD; half_t *GF, *GB; const float* lbraw; const float *cosT, *sinT;
    __device__ __forceinline__ void operator()(const pg8::f32x4 (&acc)[2][2][4][2], const pg8::Unit& u, int wr, int wc, int fr, int fq) const {
        const int sec = u.pn >> 1;
        const int row0 = u.pm * 256 + wr * 64 + fr;
        const int cs0 = (u.pn & 1) * 256 + wc * 32 + 8 * fq;
        if (sec == 1 || sec == 2) {
            half_t* G = sec == 1 ? GF : GB; const float* lbp = lbraw + (sec - 1) * 1024;
#pragma unroll
            for (int bj = 0; bj < 2; ++bj) { const int c = cs0 + bj * 128; float lb[8];
#pragma unroll
                for (int j = 0; j < 8; ++j) { const float l0 = lbp[c + j], l1 = lbp[512 + c + j]; lb[j] = __builtin_amdgcn_rcpf(1.f + ex2(1.4426950408889634f * (l0 - l1))); }
#pragma unroll
                for (int ai = 0; ai < 2; ++ai)
#pragma unroll
                    for (int m = 0; m < 4; ++m) { const int row = row0 + ai * 128 + m * 16; f32x4 o0, o1;
#pragma unroll
                        for (int j = 0; j < 4; ++j) { o0[j] = lb[j] + (1.f - lb[j]) * sigmoidf_(acc[ai][bj][m][0][j]); o1[j] = lb[4 + j] + (1.f - lb[4 + j]) * sigmoidf_(acc[ai][bj][m][1][j]); }
                        typedef _Float16 h8 __attribute__((ext_vector_type(8)));
                        const h8 hv = {(_Float16)o0[0], (_Float16)o0[1], (_Float16)o0[2], (_Float16)o0[3], (_Float16)o1[0], (_Float16)o1[1], (_Float16)o1[2], (_Float16)o1[3]};
                        *(h8*)(G + (size_t)row * HSEC + c) = hv; } }
            return;
        }
        bf16_t* O = sec == 0 ? QH : sec == 3 ? VH : sec == 4 ? SG : sec == 5 ? QD : sec == 6 ? KD : VD;
        const bool rot = (sec == 5 || sec == 6) && ((wc & 1) == 0);
        const float sc = sec == 5 ? QSCALE : 1.f;
#pragma unroll
        for (int ai = 0; ai < 2; ++ai)
#pragma unroll
            for (int m = 0; m < 4; ++m) { const int row = row0 + ai * 128 + m * 16;
#pragma unroll
                for (int bj = 0; bj < 2; ++bj) { const int c = cs0 + bj * 128; float v[8];
#pragma unroll
                    for (int j = 0; j < 4; ++j) { v[j] = acc[ai][bj][m][0][j]; v[4 + j] = acc[ai][bj][m][1][j]; }
                    if (sec == 4) {
#pragma unroll
                        for (int j = 0; j < 8; ++j) v[j] = v[j] * sigmoidf_(v[j]);
                    }
                    if (rot) {
                        const f32x4 c0 = *(const f32x4*)(cosT + (size_t)row * 8), c1 = *(const f32x4*)(cosT + (size_t)row * 8 + 4);
                        const f32x4 s0 = *(const f32x4*)(sinT + (size_t)row * 8), s1 = *(const f32x4*)(sinT + (size_t)row * 8 + 4);
#pragma unroll
                        for (int j = 0; j < 8; ++j) { const float p = lane_xor<16>(v[j]); const float cj = j < 4 ? c0[j & 3] : c1[j & 3], sj = j < 4 ? s0[j & 3] : s1[j & 3];
                            const float r = fq == 0 ? v[j] * cj - p * sj : v[j] * cj + p * sj; v[j] = fq < 2 ? r : v[j]; }
                    }
                    u32x4 w; w.x = cvtpk(v[0] * sc, v[1] * sc); w.y = cvtpk(v[2] * sc, v[3] * sc); w.z = cvtpk(v[4] * sc, v[5] * sc); w.w = cvtpk(v[6] * sc, v[7] * sc);
                    *(u32x4*)(O + (size_t)row * HSEC + c) = w; } }
    }
};
struct EpiResid {
    static constexpr bool PERM = true, AFTER_DRAIN = false;
    const float* X; bf16_t* O; unsigned char* O8;
    __device__ __forceinline__ void operator()(const pg8::f32x4 (&acc)[2][2][4][2], const pg8::Unit& u, int wr, int wc, int fr, int fq) const {
        const int row0 = u.pm * 256 + wr * 64 + fr, col0 = u.pn * 256 + wc * 32 + 8 * fq;
#pragma unroll
        for (int ai = 0; ai < 2; ++ai)
#pragma unroll
            for (int m = 0; m < 4; ++m) { const size_t off = (size_t)(row0 + ai * 128 + m * 16) * D + col0;
#pragma unroll
                for (int bj = 0; bj < 2; ++bj) { const f32x4 a = *(const f32x4*)(X + off + bj * 128) + acc[ai][bj][m][0], b = *(const f32x4*)(X + off + bj * 128 + 4) + acc[ai][bj][m][1];
                    u32x4 w; w.x = cvtpk(a[0], a[1]); w.y = cvtpk(a[2], a[3]); w.z = cvtpk(b[0], b[1]); w.w = cvtpk(b[2], b[3]); *(u32x4*)(O + off + bj * 128) = w;
                    u32x2 f; f.x = pk4_fp8(a[0], a[1], a[2], a[3]); f.y = pk4_fp8(b[0], b[1], b[2], b[3]); *(u32x2*)(O8 + off + bj * 128) = f; } }
    }
};
struct EpiSwiGlu {
    unsigned char* O; const float* RS;
    __device__ __forceinline__ void operator()(const f32x4 (&acc)[2][4][2], const pg8::Unit& u, int wr, int wc, int fr, int fq) const {
        const int row0 = u.pm * 128 + wr * 64 + fr, col0 = ((u.pn & 3) * 256 + wc * 32 + 8 * fq) >> 1;
#pragma unroll
        for (int m = 0; m < 4; ++m) { const int row = row0 + m * 16; const float rs = RS[row] * (1.f / F8_WSCALE); unsigned char* rowp = O + (size_t)row * DEXP + col0;
#pragma unroll
            for (int bj = 0; bj < 2; ++bj) { const f32x4 a = acc[bj][m][0] * rs, b = acc[bj][m][1] * rs;
                const float h0 = a[0] * sigmoidf_(a[0]) * a[1], h1 = a[2] * sigmoidf_(a[2]) * a[3], h2 = b[0] * sigmoidf_(b[0]) * b[1], h3 = b[2] * sigmoidf_(b[2]) * b[3];
                *(unsigned*)(rowp + bj * 64) = pk4_fp8(__builtin_amdgcn_fmed3f(h0 * F8_HSCALE, -448.f, 448.f), __builtin_amdgcn_fmed3f(h1 * F8_HSCALE, -448.f, 448.f), __builtin_amdgcn_fmed3f(h2 * F8_HSCALE, -448.f, 448.f), __builtin_amdgcn_fmed3f(h3 * F8_HSCALE, -448.f, 448.f)); } }
    }
};
struct EpiDown {
    unsigned char* O;
    __device__ __forceinline__ void operator()(const f32x4 (&acc)[2][4][2], const pg8::Unit& u, int wr, int wc, int fr, int fq) const {
        const int row0 = u.pm * 128 + wr * 64 + fr, col0 = (u.pn & 3) * 256 + wc * 32 + 8 * fq; constexpr float us = F8_YSCALE / (F8_WSCALE * F8_HSCALE);
#pragma unroll
        for (int m = 0; m < 4; ++m) { unsigned char* rowp = O + (size_t)(row0 + m * 16) * D + col0;
#pragma unroll
            for (int bj = 0; bj < 2; ++bj) { const f32x4 a = acc[bj][m][0] * us, b = acc[bj][m][1] * us;
                u32x2 w; w.x = pk4_fp8(__builtin_amdgcn_fmed3f(a[0], -448.f, 448.f), __builtin_amdgcn_fmed3f(a[1], -448.f, 448.f), __builtin_amdgcn_fmed3f(a[2], -448.f, 448.f), __builtin_amdgcn_fmed3f(a[3], -448.f, 448.f));
                w.y = pk4_fp8(__builtin_amdgcn_fmed3f(b[0], -448.f, 448.f), __builtin_amdgcn_fmed3f(b[1], -448.f, 448.f), __builtin_amdgcn_fmed3f(b[2], -448.f, 448.f), __builtin_amdgcn_fmed3f(b[3], -448.f, 448.f));
                *(u32x2*)(rowp + bj * 128) = w; } }
    }
};
struct MoeOrder {
    const volatile LAS int* tb; int G, c; const int* PERM; unsigned* ready; int mode;
    __device__ __forceinline__ bool decode(int L, pg8::Unit& u) const {
        const int x = c & 7; int base = 0;
#pragma unroll 1
        for (int k = 0; k < 4; ++k) { const int e = 4 * x + k, t0 = __builtin_amdgcn_readfirstlane(tb[e]), nt = __builtin_amdgcn_readfirstlane(tb[e + 1]) - t0;
            if (L < base + 4 * nt) { const int idx = L - base; u.pm = t0 + idx % nt; u.pn = e * 4 + idx / nt; return true; }
            base += 4 * nt; }
        return false;
    }
    __device__ __forceinline__ bool next(int i, pg8::Unit& u) const {
        if ((G & 7) == 0) {
            const int x = c & 7, s = c >> 3, nb = G >> 3;
            const int U = 4 * (__builtin_amdgcn_readfirstlane(tb[4 * x + 4]) - __builtin_amdgcn_readfirstlane(tb[4 * x]));
            if (mode == 0) return decode(i * nb + s, u);
            const int i0 = s < U ? (U - s + nb - 1) / nb : 0;
            return decode((i0 + i) * nb + s - U, u);
        }
        const int L = i * G + c, T = __builtin_amdgcn_readfirstlane(tb[32]); if (L >= 4 * T) return false;
        const int tile = L >> 2; int e = 0;
#pragma unroll 1
        for (int j = 1; j < 32; ++j) e += (__builtin_amdgcn_readfirstlane(tb[j]) <= tile) ? 1 : 0;
        u.pm = tile; u.pn = e * 4 + (L & 3); return true;
    }
    __device__ __forceinline__ int row_tok(const pg8::Unit& u, int r) const {
        const int e = u.pn >> 2, rem = __builtin_amdgcn_readfirstlane(tb[64 + e]) - (u.pm - __builtin_amdgcn_readfirstlane(tb[e])) * 128;
        return r < rem ? PERM[u.pm * 128 + r] : 0;
    }
    __device__ __forceinline__ bool half_only(const pg8::Unit&) const { return false; }
    __device__ __forceinline__ void done(const pg8::Unit& u) const {
        if (mode == 2) { asm volatile("s_waitcnt vmcnt(0)" ::: "memory");
            if ((threadIdx.x & 63) == 0) __hip_atomic_fetch_add(ready + 64 * u.pm, 1u, __ATOMIC_RELAXED, __HIP_MEMORY_SCOPE_AGENT); }
    }
    __device__ __forceinline__ void a_ready(const pg8::Unit& u) const {
        if (mode == 1) {
            if (threadIdx.x < 64) { const unsigned long long t0 = __builtin_amdgcn_s_memrealtime();
                while ((unsigned)__builtin_amdgcn_readfirstlane(__hip_atomic_load(ready + 64 * u.pm, __ATOMIC_RELAXED, __HIP_MEMORY_SCOPE_AGENT)) < 32u) {
                    if (__builtin_amdgcn_s_memrealtime() - t0 > 2000000ull) break;
                    __builtin_amdgcn_s_sleep(2); }
                __builtin_amdgcn_fence(__ATOMIC_ACQUIRE, "agent");
                asm volatile("s_waitcnt vmcnt(0)" ::: "memory"); }
            asm volatile("" ::: "memory"); __builtin_amdgcn_s_barrier(); asm volatile("" ::: "memory");
        }
    }
};

namespace mg {
constexpr int TM = 128, BUF = 3 * pg8::HTB;
#define MG_WAIT_V(n) asm volatile("s_waitcnt vmcnt(" #n ")" ::: "memory")
#define MG_WAIT_L0() asm volatile("s_waitcnt lgkmcnt(0)" ::: "memory")
#define MG_BAR() do { asm volatile("" ::: "memory"); __builtin_amdgcn_s_barrier(); asm volatile("" ::: "memory"); __builtin_amdgcn_sched_barrier(0); } while (0)
struct Frags { bf16x8 a[4][2], b[2][2][2]; };
template <class Epi, class Sched, bool GATHER>
__device__ __forceinline__ void gemm(LAS unsigned char* lds, const unsigned char* A, const unsigned char* Bt, int Kb, const Sched& S, const Epi& E) {
    const int tid = opaque_tid(), wid = __builtin_amdgcn_readfirstlane(tid >> 6), lane = tid & 63, wr = wid >> 2, wc = wid & 3, fr = lane & 15, fq = lane >> 4;
    asm volatile("" : "+s"(Kb));
    const int nkt = Kb >> 7;
    unsigned voffB[2], colA[2]; int rowA[2];
#pragma unroll
    for (int i = 0; i < 2; ++i) { int R, C; pg8::stage_rc(tid * 16 + i * 8192, R, C); const int Rb = (R & ~31) + pg8::perm32(R & 31);
        rowA[i] = R; colA[i] = (unsigned)C * 2u; voffB[i] = (unsigned)(Rb * Kb) + (unsigned)C * 2u; }
    const unsigned ldsw = (unsigned)wid * 1024u;
    const int aoff = pg8::lds_byte(wr * 64 + fr, fq * 8), boff = pg8::lds_byte(wc * 32 + fr, fq * 8);
    const size_t bhalf = (size_t)128 * Kb;
#define MG_DMA(slot_, ao_, bb_, kt_) do { _Pragma("unroll") for (int p_ = 0; p_ < 6; ++p_) MG_DMA1(p_, slot_, ao_, bb_, kt_); } while (0)
#define MG_DMA1(p_, slot_, ao_, bb_, kt_) do { const unsigned so_ = (unsigned)(slot_) * BUF; const size_t ko_ = (size_t)(kt_) * 128; \
        if ((p_) < 2) __builtin_amdgcn_global_load_lds((const unsigned*)(A + (size_t)(ao_)[(p_) & 1] + ko_), (LAS unsigned*)(lds + so_ + ldsw + ((p_) & 1) * 8192), 16, 0, 0); \
        else __builtin_amdgcn_global_load_lds((const unsigned*)((bb_) + (((p_) - 2) >> 1) * bhalf + voffB[(p_) & 1] + ko_), (LAS unsigned*)(lds + so_ + (1 + (((p_) - 2) >> 1)) * pg8::HTB + ldsw + ((p_) & 1) * 8192), 16, 0, 0); } while (0)
#define MG_READ(F_, slot_) do { const LAS unsigned char* p_ = lds + (unsigned)(slot_) * BUF; \
        _Pragma("unroll") for (int m = 0; m < 4; ++m) _Pragma("unroll") for (int k = 0; k < 2; ++k) F_.a[m][k] = *(const LAS bf16x8*)(p_ + aoff + m * 2048 + k * 1024); \
        _Pragma("unroll") for (int bj = 0; bj < 2; ++bj) _Pragma("unroll") for (int n = 0; n < 2; ++n) _Pragma("unroll") for (int k = 0; k < 2; ++k) \
            F_.b[bj][n][k] = *(const LAS bf16x8*)(p_ + (1 + bj) * pg8::HTB + boff + n * 2048 + k * 1024); } while (0)
#define MG_MMA1(F_, bj_, m_, n_) do { typedef int v4i_ __attribute__((ext_vector_type(4))); \
        acc[bj_][m_][n_] = __builtin_amdgcn_mfma_scale_f32_16x16x128_f8f6f4(__builtin_shufflevector(__builtin_bit_cast(v4i_, F_.b[bj_][n_][0]), __builtin_bit_cast(v4i_, F_.b[bj_][n_][1]), 0, 1, 2, 3, 4, 5, 6, 7), \
            __builtin_shufflevector(__builtin_bit_cast(v4i_, F_.a[m_][0]), __builtin_bit_cast(v4i_, F_.a[m_][1]), 0, 1, 2, 3, 4, 5, 6, 7), acc[bj_][m_][n_], 0, 0, 0, 0x7F7F7F7F, 0, 0x7F7F7F7F); } while (0)
#define MG_SB() __builtin_amdgcn_sched_barrier(0)
#define MG_READB(F_, slot_) do { const LAS unsigned char* p_ = lds + (unsigned)(slot_) * BUF; \
        _Pragma("unroll") for (int bj = 0; bj < 2; ++bj) _Pragma("unroll") for (int n = 0; n < 2; ++n) _Pragma("unroll") for (int k = 0; k < 2; ++k) \
            F_.b[bj][n][k] = *(const LAS bf16x8*)(p_ + (1 + bj) * pg8::HTB + boff + n * 2048 + k * 1024); } while (0)
#define MG_READA(F_, slot_, m_) do { const LAS unsigned char* p_ = lds + (unsigned)(slot_) * BUF; \
        _Pragma("unroll") for (int k = 0; k < 2; ++k) F_.a[m_][k] = *(const LAS bf16x8*)(p_ + aoff + (m_) * 2048 + k * 1024); } while (0)
#define MG_GROUP(Fc_, Fn_, rslot_, m_) do { MG_MMA1(Fc_, 0, m_, 0); MG_MMA1(Fc_, 0, m_, 1); MG_MMA1(Fc_, 1, m_, 0); MG_MMA1(Fc_, 1, m_, 1); MG_SB(); MG_READA(Fn_, rslot_, m_); MG_SB(); } while (0)
#define MG_STEP(Fc_, Fn_, rslot_, dslot_, ao_, bb_, kt_) do { MG_READB(Fn_, rslot_); MG_SB(); \
        MG_DMA1(0, dslot_, ao_, bb_, kt_); MG_SB(); MG_GROUP(Fc_, Fn_, rslot_, 0); MG_DMA1(1, dslot_, ao_, bb_, kt_); MG_DMA1(2, dslot_, ao_, bb_, kt_); MG_SB(); MG_GROUP(Fc_, Fn_, rslot_, 1); \
        MG_DMA1(3, dslot_, ao_, bb_, kt_); MG_SB(); MG_GROUP(Fc_, Fn_, rslot_, 2); MG_DMA1(4, dslot_, ao_, bb_, kt_); MG_DMA1(5, dslot_, ao_, bb_, kt_); MG_SB(); MG_GROUP(Fc_, Fn_, rslot_, 3); \
        MG_SB(); } while (0)
#define MG_AOFS(dst_, u_) do { _Pragma("unroll") for (int i_ = 0; i_ < 2; ++i_) dst_[i_] = (GATHER ? (unsigned)S.row_tok(u_, rowA[i_]) : (unsigned)((u_).pm * TM + rowA[i_])) * (unsigned)Kb + colA[i_]; } while (0)
    pg8::Unit cur, nxt; int ui = 0;
    if (!S.next(0, cur)) return;
    f32x4 acc[2][4][2];
#pragma unroll
    for (int b = 0; b < 2; ++b)
#pragma unroll
        for (int m = 0; m < 4; ++m)
#pragma unroll
            for (int n = 0; n < 2; ++n) acc[b][m][n] = (f32x4){0.f, 0.f, 0.f, 0.f};
    unsigned ac[2], an[2];
    MG_AOFS(ac, cur);
    const unsigned char* bc = Bt + (size_t)cur.pn * 256 * Kb;
    Frags FA, FB;
    MG_DMA(0, ac, bc, 0); MG_DMA(1, ac, bc, 1); MG_DMA(2, ac, bc, 2);
    MG_WAIT_V(12); MG_BAR();
    MG_READ(FA, 0); MG_WAIT_L0();
    int sl = 0;
    for (;;) {
        const bool has_next = S.next(ui + 1, nxt);
        if (!has_next) nxt = cur;
        const unsigned char* bn = Bt + (size_t)nxt.pn * 256 * Kb;
        MG_AOFS(an, nxt);
#pragma unroll 1
        for (int kt = 0; kt < nkt; kt += 2) {
            if (!(kt == 0 && ui > 0)) MG_WAIT_V(6);
            MG_BAR();
            const int s1 = sl == 2 ? 0 : sl + 1;
            { const bool in_ = kt + 3 < nkt; const unsigned ax[2] = {in_ ? ac[0] : an[0], in_ ? ac[1] : an[1]}; const unsigned char* bx = in_ ? bc : bn; const int kx = in_ ? kt + 3 : kt + 3 - nkt;
              MG_STEP(FA, FB, s1, sl, ax, bx, kx); }
            MG_WAIT_L0();
            MG_WAIT_V(6); MG_BAR();
            const int s2 = s1 == 2 ? 0 : s1 + 1;
            { const bool in_ = kt + 4 < nkt; const unsigned ax[2] = {in_ ? ac[0] : an[0], in_ ? ac[1] : an[1]}; const unsigned char* bx = in_ ? bc : bn; const int kx = in_ ? kt + 4 : kt + 4 - nkt;
              MG_STEP(FB, FA, s2, s1, ax, bx, kx); }
            if (kt + 2 == nkt) { MG_WAIT_V(6); E(acc, cur, wr, wc, fr, fq);
#pragma unroll
                for (int b = 0; b < 2; ++b)
#pragma unroll
                    for (int m = 0; m < 4; ++m)
#pragma unroll
                        for (int n = 0; n < 2; ++n) acc[b][m][n] = (f32x4){0.f, 0.f, 0.f, 0.f}; }
            MG_WAIT_L0();
            sl = s2;
        }
        if (!has_next) break;
        cur = nxt; ac[0] = an[0]; ac[1] = an[1]; bc = bn; ++ui;
    }
    MG_WAIT_V(0); MG_BAR();
#undef MG_DMA
#undef MG_READ
#undef MG_MMA1
#undef MG_STEP
#undef MG_GROUP
#undef MG_READA
#undef MG_READB
#undef MG_DMA1
#undef MG_AOFS
}
}

namespace hg {
typedef short v4i16_t __attribute__((ext_vector_type(4)));
constexpr int S128 = 272, S64 = 144;
constexpr int L_QD = 0, L_QE = L_QD + 64 * S128, L_KE = L_QE + 64 * S128, L_VR = L_KE + 64 * S128, L_ST = L_VR + 64 * S128,
              L_P = L_ST + 128 * S128, L_QS = L_P + 64 * S64, L_DC = L_QS + 16 * 128 * 4, L_END = L_DC + 128 * 4;
static_assert(L_END <= PHASE_LDS, "hgrn LDS");
__device__ __forceinline__ bf16x8 frag(const LAS unsigned char* base, int row, int stride, int kb  ) { return *(const LAS bf16x8*)(base + row * stride + kb); }
__device__ __forceinline__ bf16x8 trfrag(const LAS unsigned char* tile, int tok0, int chan0, int lane) {
    const LAS unsigned char* p = tile + (tok0 + 8 * (lane >> 5) + ((lane & 15) >> 2)) * S128 + (chan0 + 16 * ((lane >> 4) & 1) + 4 * (lane & 3)) * 2;
    const s16x4 lo = __builtin_bit_cast(s16x4, __builtin_amdgcn_ds_read_tr16_b64_v4i16((LAS v4i16_t*)p)), hi = __builtin_bit_cast(s16x4, __builtin_amdgcn_ds_read_tr16_b64_v4i16((LAS v4i16_t*)(p + 4 * S128)));
    return (bf16x8){lo[0], lo[1], lo[2], lo[3], hi[0], hi[1], hi[2], hi[3]};
}

template <bool PASS_C, int ABL = 0>
__device__ __forceinline__ void pass(LAS unsigned char* lds, int unit, const bf16_t* QH, const bf16_t* VH, const half_t* GF, const half_t* GB,
                                     float* HL, float* HD, const float* HS, float* OF, float* OB) {
    typedef _Float16 h4 __attribute__((ext_vector_type(4)));
    const int tid = opaque_tid(), lane = tid & 63, wid = __builtin_amdgcn_readfirstlane(tid >> 6), r32 = lane & 31, hi = lane >> 5;
    const int dir = unit >> 7, head = (unit >> 5) & 3, sc = unit & 31;
    const int kq = tid & 31, tq = tid >> 5;
    const half_t* G = dir ? GB : GF; float* O = dir ? OB : OF;
    const int vi = wid >> 1, ki0 = (wid & 1) * 2;
    f32x16 sacc[2];
    LAS f32x4* QS = (LAS f32x4*)(lds + L_QS); LAS float* DC = (LAS float*)(lds + L_DC);
    if (PASS_C) {
        const float* hs = HS + (size_t)unit * 16384;
#pragma unroll
        for (int tt = 0; tt < 2; ++tt)
#pragma unroll
            for (int r = 0; r < 16; r += 2) { const int v = vi * 32 + crow(r, hi), kk = (ki0 + tt) * 32 + r32; const float s0 = hs[v * 128 + kk], s1 = hs[(v + 1) * 128 + kk]; sacc[tt][r] = s0; sacc[tt][r + 1] = s1;
                const unsigned w = cvtpk(s0, s1); *(LAS bf16_t*)(lds + L_ST + v * S128 + kk * 2) = (bf16_t)(w & 0xffffu); *(LAS bf16_t*)(lds + L_ST + (v + 1) * S128 + kk * 2) = (bf16_t)(w >> 16); }
    } else { sacc[0] = f32x16{}; sacc[1] = f32x16{}; }
    f32x4 btot = {1.f, 1.f, 1.f, 1.f};
    h4 gh[4]; u32x2 qv[4], vv[4];
#define HG_LOAD(c_) do { const int tb_ = sc * 512 + (c_) * 64 + 4 * tq; _Pragma("unroll") for (int i = 0; i < 4; ++i) { const int tl = tb_ + i, tok = dir ? (M - 1 - tl) : tl; \
        const size_t off = (size_t)tok * HSEC + head * 128 + 4 * kq; gh[i] = *(const h4*)(G + off); vv[i] = *(const u32x2*)(VH + off); if (PASS_C) qv[i] = *(const u32x2*)(QH + off); } } while (0)
    HG_LOAD(0);
#pragma unroll 1
    for (int c = 0; c < 8; ++c) {
        const int t0 = sc * 512 + c * 64;
        f32x4 g[4], b[4];
#pragma unroll
        for (int i = 0; i < 4; ++i) { g[i] = (f32x4){(float)gh[i][0], (float)gh[i][1], (float)gh[i][2], (float)gh[i][3]}; b[i] = i ? b[i - 1] * g[i] : g[i]; }
        QS[tq * 32 + kq] = b[3];
        LDS_WAIT(); __syncthreads();
        if (tid < 128) { LAS float* qs = (LAS float*)QS; float run = 1.f;
#pragma unroll
            for (int q = 0; q < 16; ++q) { const float t = qs[q * 128 + tid]; qs[q * 128 + tid] = run; run *= t; }
            DC[tid] = run; }
        LDS_WAIT(); __syncthreads();
        const f32x4 pre = QS[tq * 32 + kq], etot = *(const LAS f32x4*)(DC + 4 * kq);
        btot *= etot;
        f32x4 itot; itot[0] = __builtin_amdgcn_rcpf(etot[0]); itot[1] = __builtin_amdgcn_rcpf(etot[1]); itot[2] = __builtin_amdgcn_rcpf(etot[2]); itot[3] = __builtin_amdgcn_rcpf(etot[3]);
#pragma unroll
        for (int i = 0; i < 4; ++i) { const int tr = 4 * tq + i; float ke[4], qd[4], qe[4];
            const float q4[4] = {bflo(qv[i].x), bfhi(qv[i].x), bflo(qv[i].y), bfhi(qv[i].y)};
#pragma unroll
            for (int cc = 0; cc < 4; ++cc) { const float pb = b[i][cc] * pre[cc];
                ke[cc] = (1.f - g[i][cc]) * etot[cc] * __builtin_amdgcn_rcpf(pb);
                if (PASS_C) { qd[cc] = q4[cc] * pb; qe[cc] = qd[cc] * itot[cc]; } }
            *(LAS u32x2*)(lds + L_KE + tr * S128 + kq * 8) = (u32x2){cvtpk(ke[0], ke[1]), cvtpk(ke[2], ke[3])};
            *(LAS u32x2*)(lds + L_VR + tr * S128 + kq * 8) = vv[i];
            if (PASS_C) { *(LAS u32x2*)(lds + L_QD + tr * S128 + kq * 8) = (u32x2){cvtpk(qd[0], qd[1]), cvtpk(qd[2], qd[3])};
                *(LAS u32x2*)(lds + L_QE + tr * S128 + kq * 8) = (u32x2){cvtpk(qe[0], qe[1]), cvtpk(qe[2], qe[3])}; } }
        LDS_WAIT(); __syncthreads();
        if (c < 7 && !(ABL & 2)) HG_LOAD(c + 1);
        if (PASS_C && !(ABL & 4)) {
            if (wid < 4) {
                const int ti = wid >> 1, si = wid & 1; f32x16 p = f32x16{};
                if (!(ti == 0 && si == 1)) {
#pragma unroll
                    for (int ks = 0; ks < 8; ++ks) p = __builtin_amdgcn_mfma_f32_32x32x16_bf16(frag(lds + L_QE, ti * 32 + r32, S128, ks * 32 + hi * 16), frag(lds + L_KE, si * 32 + r32, S128, ks * 32 + hi * 16), p, 0, 0, 0);
                }
#pragma unroll
                for (int r = 0; r < 16; r += 2) { const int t = ti * 32 + crow(r, hi), s = si * 32 + r32; const unsigned w = cvtpk(s <= t ? p[r] : 0.f, s <= t + 1 ? p[r + 1] : 0.f);
                    *(LAS bf16_t*)(lds + L_P + t * S64 + s * 2) = (bf16_t)(w & 0xffffu); *(LAS bf16_t*)(lds + L_P + (t + 1) * S64 + s * 2) = (bf16_t)(w >> 16); }
            }
            LDS_WAIT(); __syncthreads();
            { const int ti = wid >> 2, vo = wid & 3; f32x16 o = f32x16{};
#pragma unroll
                for (int ks = 0; ks < 8; ++ks) o = __builtin_amdgcn_mfma_f32_32x32x16_bf16(frag(lds + L_QD, ti * 32 + r32, S128, ks * 32 + hi * 16), frag(lds + L_ST, vo * 32 + r32, S128, ks * 32 + hi * 16), o, 0, 0, 0);
#pragma unroll
                for (int ss = 0; ss < 4; ++ss) o = __builtin_amdgcn_mfma_f32_32x32x16_bf16(frag(lds + L_P, ti * 32 + r32, S64, ss * 32 + hi * 16), trfrag(lds + L_VR, ss * 16, vo * 32, lane), o, 0, 0, 0);
#pragma unroll
                for (int r = 0; r < 16; ++r) { const int tl = t0 + ti * 32 + crow(r, hi), tok = dir ? (M - 1 - tl) : tl; if (!(ABL & 1)) O[(size_t)tok * HSEC + head * 128 + vo * 32 + r32] = o[r]; else asm volatile("" :: "v"(o[r])); }
            }
        }
#pragma unroll
        for (int tt = 0; tt < ((ABL & 4) ? 0 : 2); ++tt) { const int ki = ki0 + tt; const float d = DC[ki * 32 + r32];
#pragma unroll
            for (int r = 0; r < 16; ++r) sacc[tt][r] *= d;
#pragma unroll
            for (int ss = 0; ss < 4; ++ss) sacc[tt] = __builtin_amdgcn_mfma_f32_32x32x16_bf16(trfrag(lds + L_VR, ss * 16, vi * 32, lane), trfrag(lds + L_KE, ss * 16, ki * 32, lane), sacc[tt], 0, 0, 0);
        }
        LDS_WAIT(); __syncthreads();
        if (PASS_C) {
#pragma unroll
            for (int tt = 0; tt < 2; ++tt)
#pragma unroll
                for (int r = 0; r < 16; r += 2) { const int v = vi * 32 + crow(r, hi), kk = (ki0 + tt) * 32 + r32; const unsigned w = cvtpk(sacc[tt][r], sacc[tt][r + 1]);
                    *(LAS bf16_t*)(lds + L_ST + v * S128 + kk * 2) = (bf16_t)(w & 0xffffu); *(LAS bf16_t*)(lds + L_ST + (v + 1) * S128 + kk * 2) = (bf16_t)(w >> 16); }
        }
    }
#undef HG_LOAD
    if (!PASS_C) {
        float* hl = HL + (size_t)unit * 16384;
#pragma unroll
        for (int tt = 0; tt < 2; ++tt)
#pragma unroll
            for (int r = 0; r < 16; ++r) { const int v = vi * 32 + crow(r, hi), kk = (ki0 + tt) * 32 + r32; hl[v * 128 + kk] = sacc[tt][r]; }
        if (tq == 0) *(f32x4*)(HD + unit * 128 + 4 * kq) = btot;
    }
    __syncthreads();
}
__device__ __forceinline__ void scan(const float* HL, const float* HD, float* HS, int gtid, int gthreads) {
    for (int id = gtid; id < 8 * 16384; id += gthreads) {
        const int dh = id >> 14, e = id & 16383, k = e & 127; float S = 0.f;
        float hl[32], hd[32];
#pragma unroll
        for (int sc = 0; sc < 32; ++sc) { const int u = dh * 32 + sc; hl[sc] = HL[(size_t)u * 16384 + e]; hd[sc] = HD[u * 128 + k]; }
#pragma unroll
        for (int sc = 0; sc < 32; ++sc) { const int u = dh * 32 + sc; HS[(size_t)u * 16384 + e] = S; S = hd[sc] * S + hl[sc]; }
    }
}
}

namespace att {
__device__ __forceinline__ void hgrn_finalize(int h, int q0, const float* OF, const float* OB, const bf16_t* SG, const float* gain, bf16_t* MIX, int wid, int lane) {
    const float g0 = gain[2 * lane], g1 = gain[2 * lane + 1];
    float2 a[4], b[4], an[4], bn[4]; unsigned sg[4], sgn[4];
#define HF_LOAD(A_, B_, S_, i0_) do { _Pragma("unroll") for (int i = 0; i < 4; ++i) { const size_t off = (size_t)(q0 + wid * 32 + (i0_) + i) * HSEC + h * 128 + 2 * lane; \
        A_[i] = *(const float2*)(OF + off); B_[i] = *(const float2*)(OB + off); S_[i] = *(const unsigned*)(SG + off); } } while (0)
    HF_LOAD(a, b, sg, 0);
#pragma unroll 1
    for (int i0 = 0; i0 < 32; i0 += 4) { float x0[4], x1[4], ss[4];
        if (i0 + 4 < 32) HF_LOAD(an, bn, sgn, i0 + 4);
#pragma unroll
        for (int i = 0; i < 4; ++i) { x0[i] = a[i].x + b[i].x; x1[i] = a[i].y + b[i].y; ss[i] = x0[i] * x0[i] + x1[i] * x1[i]; }
#pragma unroll
        for (int i = 0; i < 4; ++i) ss[i] = wave_sum(ss[i]);
#pragma unroll
        for (int i = 0; i < 4; ++i) { const float rstd = 1.f / sqrtf(ss[i] * (1.f / 128.f) + 1e-6f);
            *(unsigned*)(MIX + (size_t)(q0 + wid * 32 + i0 + i) * D + h * 128 + 2 * lane) = cvtpk(x0[i] * rstd * g0 * bflo(sg[i]), x1[i] * rstd * g1 * bfhi(sg[i])); }
#pragma unroll
        for (int i = 0; i < 4; ++i) { a[i] = an[i]; b[i] = bn[i]; sg[i] = sgn[i]; } }
#undef HF_LOAD
}
}

namespace att2 {
typedef short v4i16_t __attribute__((ext_vector_type(4)));
constexpr int KVBLK = 64, LDR = HSEC, NT = M / KVBLK;
constexpr int KSLOT = 8192, VSLOT = 16384, NSLOT = 4;
constexpr int OFF_K = 0, OFF_V = NSLOT * KSLOT, OFF_WS = OFF_V + NSLOT * VSLOT, OFF_END = OFF_WS + NWAVES * 64 * 4;
static_assert(OFF_END <= PHASE_LDS, "attention LDS");
__device__ __forceinline__ s16x4 vtr(const LAS unsigned char* p) { return __builtin_bit_cast(s16x4, __builtin_amdgcn_ds_read_tr16_b64_v4i16((LAS v4i16_t*)p)); }
__device__ __forceinline__ void glds16(const void* sbase, unsigned voff, unsigned lds_dst) { unsigned keep;
    asm volatile("s_mov_b32 %0, m0\n\ts_mov_b32 m0, %3\n\ts_nop 0\n\tglobal_load_lds_dwordx4 %1, %2\n\ts_mov_b32 m0, %0" : "=&s"(keep) : "v"(voff), "s"(sbase), "s"(lds_dst) : "memory"); }
#define ATT2_WAIT_BAR(N) asm volatile("s_waitcnt vmcnt(" #N ") lgkmcnt(0)\n\ts_barrier" ::: "memory")
template <bool DO_QK, bool DO_SM, bool DO_PV, bool DO_DMA = false>
__device__ __forceinline__ void step(f32x16& sn0, f32x16& sn1, f32x16& sc0, f32x16& sc1, const u32x4& pap0, const u32x4& pap1, const u32x4& pap2, const u32x4& pap3,
                                     u32x4& pan0, u32x4& pan1, u32x4& pan2, u32x4& pan3, f32x16 (&o)[4], const bf16x8 (&qr)[4], const f32x16& negm, float& lsum,
                                     const LAS unsigned char* kc, const LAS unsigned char* knn, const LAS unsigned char* vb, bf16x8& kf0, bf16x8& kf1, bf16x8& kf2,
                                     const char* ksrc = nullptr, unsigned kvo = 0, unsigned kds = 0, const char* vsrc = nullptr, unsigned vvo0 = 0, unsigned vvo1 = 0, unsigned vds = 0) {
    bf16x8 fr0 = kf0, fr1 = kf1, fr2 = kf2, fr3 = kf0; unsigned ca0 = 0, ca1 = 0, cb0 = 0, cb1 = 0;
    (void)ca0; (void)ca1; (void)cb0; (void)cb1;
    if (DO_QK) sn0 = __builtin_amdgcn_mfma_f32_32x32x16_bf16(fr0, qr[0], negm, 0, 0, 0);
    SBAR();
    if (DO_QK) { fr3 = *(const LAS bf16x8*)(kc + 2560); }
    if (DO_SM) { sc0[0] = ex2(sc0[0]); sc0[1] = ex2(sc0[1]); }
    SBAR();
    if (DO_QK) sn1 = __builtin_amdgcn_mfma_f32_32x32x16_bf16(fr1, qr[0], negm, 0, 0, 0);
    SBAR();
    if (DO_QK) { fr0 = *(const LAS bf16x8*)(kc + 4096); }
    if (DO_SM) { sc0[2] = ex2(sc0[2]); sc0[3] = ex2(sc0[3]); lsum += sc0[0]; lsum += sc0[1]; }
    SBAR();
    if (DO_QK) sn0 = __builtin_amdgcn_mfma_f32_32x32x16_bf16(fr2, qr[1], sn0, 0, 0, 0);
    SBAR();
    if (DO_QK) { fr1 = *(const LAS bf16x8*)(kc + 4608); }
    if (DO_SM) { sc0[4] = ex2(sc0[4]); sc0[5] = ex2(sc0[5]); lsum += sc0[2]; lsum += sc0[3]; }
    SBAR();
    if (DO_QK) sn1 = __builtin_amdgcn_mfma_f32_32x32x16_bf16(fr3, qr[1], sn1, 0, 0, 0);
    SBAR();
    if (DO_QK) { fr2 = *(const LAS bf16x8*)(kc + 6144); }
    if (DO_SM) { sc0[6] = ex2(sc0[6]); sc0[7] = ex2(sc0[7]); lsum += sc0[4]; lsum += sc0[5]; }
    SBAR();
    if (DO_QK) sn0 = __builtin_amdgcn_mfma_f32_32x32x16_bf16(fr0, qr[2], sn0, 0, 0, 0);
    SBAR();
    if (DO_QK) { fr3 = *(const LAS bf16x8*)(kc + 6656); }
    if (DO_SM) { sc0[8] = ex2(sc0[8]); sc0[9] = ex2(sc0[9]); lsum += sc0[6]; lsum += sc0[7]; }
    SBAR();
    if (DO_QK) sn1 = __builtin_amdgcn_mfma_f32_32x32x16_bf16(fr1, qr[2], sn1, 0, 0, 0);
    SBAR();
    if (DO_PV) { { const s16x4 l_ = vtr(vb + 0), h_ = vtr(vb + 256); fr0 = (bf16x8){l_[0], l_[1], l_[2], l_[3], h_[0], h_[1], h_[2], h_[3]}; } }
    if (DO_SM) { sc0[10] = ex2(sc0[10]); sc0[11] = ex2(sc0[11]); lsum += sc0[8]; lsum += sc0[9]; }
    SBAR();
    if (DO_QK) sn0 = __builtin_amdgcn_mfma_f32_32x32x16_bf16(fr2, qr[3], sn0, 0, 0, 0);
    SBAR();
    if (DO_PV) { { const s16x4 l_ = vtr(vb + 4096), h_ = vtr(vb + 4352); fr1 = (bf16x8){l_[0], l_[1], l_[2], l_[3], h_[0], h_[1], h_[2], h_[3]}; } }
    if (DO_SM) { sc0[12] = ex2(sc0[12]); sc0[13] = ex2(sc0[13]); lsum += sc0[10]; lsum += sc0[11]; }
    SBAR();
    if (DO_QK) sn1 = __builtin_amdgcn_mfma_f32_32x32x16_bf16(fr3, qr[3], sn1, 0, 0, 0);
    SBAR();
    if (DO_PV) { { const s16x4 l_ = vtr(vb + 8192), h_ = vtr(vb + 8448); fr2 = (bf16x8){l_[0], l_[1], l_[2], l_[3], h_[0], h_[1], h_[2], h_[3]}; } }
    if (DO_SM) { sc0[14] = ex2(sc0[14]); sc0[15] = ex2(sc0[15]); lsum += sc0[12]; lsum += sc0[13]; }
    SBAR();
    if (DO_PV) o[0] = __builtin_amdgcn_mfma_f32_32x32x16_bf16(__builtin_bit_cast(bf16x8, pap0), fr0, o[0], 0, 0, 0);
    SBAR();
    if (DO_PV) { { const s16x4 l_ = vtr(vb + 12288), h_ = vtr(vb + 12544); fr3 = (bf16x8){l_[0], l_[1], l_[2], l_[3], h_[0], h_[1], h_[2], h_[3]}; } }
    if (DO_SM) { sc1[0] = ex2(sc1[0]); sc1[1] = ex2(sc1[1]); lsum += sc0[14]; lsum += sc0[15]; }
    SBAR();
    if (DO_PV) o[0] = __builtin_amdgcn_mfma_f32_32x32x16_bf16(__builtin_bit_cast(bf16x8, pap1), fr1, o[0], 0, 0, 0);
    SBAR();
    if (DO_PV) { { const s16x4 l_ = vtr(vb + 512), h_ = vtr(vb + 768); fr0 = (bf16x8){l_[0], l_[1], l_[2], l_[3], h_[0], h_[1], h_[2], h_[3]}; } }
    if (DO_SM) { sc1[2] = ex2(sc1[2]); sc1[3] = ex2(sc1[3]); lsum += sc1[0]; lsum += sc1[1]; }
    SBAR();
    if (DO_PV) o[0] = __builtin_amdgcn_mfma_f32_32x32x16_bf16(__builtin_bit_cast(bf16x8, pap2), fr2, o[0], 0, 0, 0);
    SBAR();
    if (DO_PV) { { const s16x4 l_ = vtr(vb + 4608), h_ = vtr(vb + 4864); fr1 = (bf16x8){l_[0], l_[1], l_[2], l_[3], h_[0], h_[1], h_[2], h_[3]}; } }
    if (DO_SM) { sc1[4] = ex2(sc1[4]); sc1[5] = ex2(sc1[5]); lsum += sc1[2]; lsum += sc1[3]; }
    SBAR();
    if (DO_PV) o[0] = __builtin_amdgcn_mfma_f32_32x32x16_bf16(__builtin_bit_cast(bf16x8, pap3), fr3, o[0], 0, 0, 0);
    SBAR();
    if (DO_PV) { { const s16x4 l_ = vtr(vb + 8704), h_ = vtr(vb + 8960); fr2 = (bf16x8){l_[0], l_[1], l_[2], l_[3], h_[0], h_[1], h_[2], h_[3]}; } }
    if (DO_SM) { sc1[6] = ex2(sc1[6]); sc1[7] = ex2(sc1[7]); lsum += sc1[4]; lsum += sc1[5]; }
    SBAR();
    if (DO_PV) o[1] = __builtin_amdgcn_mfma_f32_32x32x16_bf16(__builtin_bit_cast(bf16x8, pap0), fr0, o[1], 0, 0, 0);
    SBAR();
    if (DO_PV) { { const s16x4 l_ = vtr(vb + 12800), h_ = vtr(vb + 13056); fr3 = (bf16x8){l_[0], l_[1], l_[2], l_[3], h_[0], h_[1], h_[2], h_[3]}; } }
    if (DO_SM) { sc1[8] = ex2(sc1[8]); sc1[9] = ex2(sc1[9]); lsum += sc1[6]; lsum += sc1[7]; }
    SBAR();
    if (DO_PV) o[1] = __builtin_amdgcn_mfma_f32_32x32x16_bf16(__builtin_bit_cast(bf16x8, pap1), fr1, o[1], 0, 0, 0);
    SBAR();
    if (DO_PV) { { const s16x4 l_ = vtr(vb + 1024), h_ = vtr(vb + 1280); fr0 = (bf16x8){l_[0], l_[1], l_[2], l_[3], h_[0], h_[1], h_[2], h_[3]}; } }
    if (DO_SM) { sc1[10] = ex2(sc1[10]); sc1[11] = ex2(sc1[11]); lsum += sc1[8]; lsum += sc1[9]; }
    SBAR();
    if (DO_PV) o[1] = __builtin_amdgcn_mfma_f32_32x32x16_bf16(__builtin_bit_cast(bf16x8, pap2), fr2, o[1], 0, 0, 0);
    SBAR();
    if (DO_PV) { { const s16x4 l_ = vtr(vb + 5120), h_ = vtr(vb + 5376); fr1 = (bf16x8){l_[0], l_[1], l_[2], l_[3], h_[0], h_[1], h_[2], h_[3]}; } }
    if (DO_SM) { sc1[12] = ex2(sc1[12]); sc1[13] = ex2(sc1[13]); lsum += sc1[10]; lsum += sc1[11]; }
    SBAR();
    if (DO_PV) o[1] = __builtin_amdgcn_mfma_f32_32x32x16_bf16(__builtin_bit_cast(bf16x8, pap3), fr3, o[1], 0, 0, 0);
    SBAR();
    if (DO_PV) { { const s16x4 l_ = vtr(vb + 9216), h_ = vtr(vb + 9472); fr2 = (bf16x8){l_[0], l_[1], l_[2], l_[3], h_[0], h_[1], h_[2], h_[3]}; } }
    if (DO_SM) { sc1[14] = ex2(sc1[14]); sc1[15] = ex2(sc1[15]); lsum += sc1[12]; lsum += sc1[13]; }
    SBAR();
    if (DO_PV) o[2] = __builtin_amdgcn_mfma_f32_32x32x16_bf16(__builtin_bit_cast(bf16x8, pap0), fr0, o[2], 0, 0, 0);
    SBAR();
    if (DO_PV) { { const s16x4 l_ = vtr(vb + 13312), h_ = vtr(vb + 13568); fr3 = (bf16x8){l_[0], l_[1], l_[2], l_[3], h_[0], h_[1], h_[2], h_[3]}; } }
    if (DO_SM) { lsum += sc1[14]; lsum += sc1[15]; ca0 = cvtpk(sc0[0], sc0[1]); ca1 = cvtpk(sc0[2], sc0[3]); }
    SBAR();
    if (DO_PV) o[2] = __builtin_amdgcn_mfma_f32_32x32x16_bf16(__builtin_bit_cast(bf16x8, pap1), fr1, o[2], 0, 0, 0);
    SBAR();
    if (DO_PV) { { const s16x4 l_ = vtr(vb + 1536), h_ = vtr(vb + 1792); fr0 = (bf16x8){l_[0], l_[1], l_[2], l_[3], h_[0], h_[1], h_[2], h_[3]}; } }
    if (DO_SM) { cb0 = cvtpk(sc0[4], sc0[5]); cb1 = cvtpk(sc0[6], sc0[7]); pan0 = (u32x4){ca0, ca1, cb0, cb1}; }
    if (DO_DMA) { glds16(ksrc, kvo, kds); }
    SBAR();
    if (DO_PV) o[2] = __builtin_amdgcn_mfma_f32_32x32x16_bf16(__builtin_bit_cast(bf16x8, pap2), fr2, o[2], 0, 0, 0);
    SBAR();
    if (DO_PV) { { const s16x4 l_ = vtr(vb + 5632), h_ = vtr(vb + 5888); fr1 = (bf16x8){l_[0], l_[1], l_[2], l_[3], h_[0], h_[1], h_[2], h_[3]}; } }
    if (DO_SM) { ca0 = cvtpk(sc0[8], sc0[9]); ca1 = cvtpk(sc0[10], sc0[11]); }
    SBAR();
    if (DO_PV) o[2] = __builtin_amdgcn_mfma_f32_32x32x16_bf16(__builtin_bit_cast(bf16x8, pap3), fr3, o[2], 0, 0, 0);
    SBAR();
    if (DO_PV) { { const s16x4 l_ = vtr(vb + 9728), h_ = vtr(vb + 9984); fr2 = (bf16x8){l_[0], l_[1], l_[2], l_[3], h_[0], h_[1], h_[2], h_[3]}; } }
    if (DO_SM) { cb0 = cvtpk(sc0[12], sc0[13]); cb1 = cvtpk(sc0[14], sc0[15]); pan1 = (u32x4){ca0, ca1, cb0, cb1}; }
    if (DO_DMA) { glds16(vsrc, vvo0, vds); }
    SBAR();
    if (DO_PV) o[3] = __builtin_amdgcn_mfma_f32_32x32x16_bf16(__builtin_bit_cast(bf16x8, pap0), fr0, o[3], 0, 0, 0);
    SBAR();
    if (DO_PV) { { const s16x4 l_ = vtr(vb + 13824), h_ = vtr(vb + 14080); fr3 = (bf16x8){l_[0], l_[1], l_[2], l_[3], h_[0], h_[1], h_[2], h_[3]}; } }
    if (DO_SM) { ca0 = cvtpk(sc1[0], sc1[1]); ca1 = cvtpk(sc1[2], sc1[3]); }
    SBAR();
    if (DO_PV) o[3] = __builtin_amdgcn_mfma_f32_32x32x16_bf16(__builtin_bit_cast(bf16x8, pap1), fr1, o[3], 0, 0, 0);
    SBAR();
    kf0 = *(const LAS bf16x8*)(knn + 0);
    if (DO_SM) { cb0 = cvtpk(sc1[4], sc1[5]); cb1 = cvtpk(sc1[6], sc1[7]); pan2 = (u32x4){ca0, ca1, cb0, cb1}; }
    if (DO_DMA) { glds16(vsrc, vvo1, vds + 1024); }
    SBAR();
    if (DO_PV) o[3] = __builtin_amdgcn_mfma_f32_32x32x16_bf16(__builtin_bit_cast(bf16x8, pap2), fr2, o[3], 0, 0, 0);
    SBAR();
    kf1 = *(const LAS bf16x8*)(knn + 512);
    if (DO_SM) { ca0 = cvtpk(sc1[8], sc1[9]); ca1 = cvtpk(sc1[10], sc1[11]); }
    SBAR();
    if (DO_PV) o[3] = __builtin_amdgcn_mfma_f32_32x32x16_bf16(__builtin_bit_cast(bf16x8, pap3), fr3, o[3], 0, 0, 0);
    SBAR();
    kf2 = *(const LAS bf16x8*)(knn + 2048);
    if (DO_SM) { cb0 = cvtpk(sc1[12], sc1[13]); cb1 = cvtpk(sc1[14], sc1[15]); pan3 = (u32x4){ca0, ca1, cb0, cb1}; }
    SBAR();
}

__device__ __forceinline__ void unit(LAS unsigned char* lds, int h, int q0, const bf16_t* __restrict__ QD, const bf16_t* __restrict__ KD, const bf16_t* __restrict__ VD,
                                     const unsigned* KMAX2, float* O0S, float lam, const float* __restrict__ subg, bf16_t* MIX) {
    const int tid = opaque_tid(), wid = __builtin_amdgcn_readfirstlane(tid >> 6), lane = tid & 63, r32 = lane & 31, hi = lane >> 5;
    const unsigned lds0 = (unsigned)(uintptr_t)lds;
    LAS float* ws = (LAS float*)(lds + OFF_WS) + wid * 64;
    const LAS unsigned char* kbase = lds + OFF_K + hi * 1024 + r32 * 16;
    const LAS unsigned char* vbase = lds + OFF_V + (((lane & 3) << 3) | (((lane >> 2) & 3) << 6) | (((lane >> 4) & 1) << 5) | (((lane >> 5) & 1) << 11));
    const unsigned voK = (unsigned)((lane * LDR + wid * 8) * 2);
    unsigned voV[2];
    { const int kk = 8 * wid + ((lane & 31) >> 2), key = (kk & ~0xC) | ((kk & 4) << 1) | ((kk & 8) >> 1);
#pragma unroll
      for (int j = 0; j < 2; ++j) voV[j] = (unsigned)((key * LDR + (2 * j + (lane >> 5)) * 32 + (lane & 3) * 8) * 2); }
    const unsigned kdst = lds0 + OFF_K + wid * 1024, vdst = lds0 + OFF_V + wid * 2048;
#pragma unroll 1
    for (int mp = 0; mp < 2; ++mp) {
        const bf16_t* Kh = KD + h * 128 + mp * 64; const bf16_t* Vh = VD + h * 128;
        const bf16_t* Qw = QD + (size_t)(q0 + wid * 32 + r32) * LDR + h * 128 + mp * 64 + hi * 8;
#define ATT2_DMA_K(t) do { const int t_ = (t) < NT ? (t) : NT - 1; glds16((const char*)Kh + (size_t)t_ * (KVBLK * LDR * 2), voK, (unsigned)__builtin_amdgcn_readfirstlane(kdst + ((t) & 3) * KSLOT)); } while (0)
#define ATT2_DMA_V(t) do { const int t_ = (t) < NT ? (t) : NT - 1; const char* vs_ = (const char*)Vh + (size_t)t_ * (KVBLK * LDR * 2); const unsigned vd_ = (unsigned)__builtin_amdgcn_readfirstlane(vdst + ((t) & 3) * VSLOT); \
        glds16(vs_, voV[0], vd_); glds16(vs_, voV[1], vd_ + 1024); } while (0)
        ATT2_DMA_K(0); ATT2_DMA_K(1); ATT2_DMA_K(2); ATT2_DMA_V(0);
        bf16x8 qr[4]; float qq = 0.f;
#pragma unroll
        for (int d0 = 0; d0 < 4; ++d0) { qr[d0] = *reinterpret_cast<const bf16x8*>(Qw + d0 * 16);
#pragma unroll
            for (int j = 0; j < 8; ++j) { const float q = bf2f((unsigned short)qr[d0][j]); qq += q * q; } }
        { auto rr = __builtin_amdgcn_permlane32_swap(__float_as_uint(qq), __float_as_uint(qq), false, false); qq = __uint_as_float(rr[0]) + __uint_as_float(rr[1]); }
        const float mref = sqrtf(qq * __uint_as_float(KMAX2[(h * 2 + mp) * 64])) * 1.001f;
        f32x16 negm;
#pragma unroll
        for (int r = 0; r < 16; ++r) negm[r] = -mref;
        f32x16 o[4] = {}; float lsum = 0.f;
        f32x16 sA0, sA1, sB0, sB1; u32x4 pX0, pX1, pX2, pX3, pY0, pY1, pY2, pY3;
        sA0 = f32x16{}; sA1 = f32x16{}; sB0 = f32x16{}; sB1 = f32x16{}; pX0 = pX1 = pX2 = pX3 = pY0 = pY1 = pY2 = pY3 = (u32x4){0u, 0u, 0u, 0u};
        bf16x8 kf0, kf1, kf2;
        ATT2_WAIT_BAR(0);
        kf0 = *(const LAS bf16x8*)(kbase); kf1 = *(const LAS bf16x8*)(kbase + 512); kf2 = *(const LAS bf16x8*)(kbase + 2048);
#define KS(t) (kbase + ((t) & 3) * KSLOT)
#define VS(t) (vbase + ((t) & 3) * VSLOT)
        ATT2_DMA_K(3); ATT2_DMA_V(1);
        step<true, false, false>(sA0, sA1, sB0, sB1, pX0, pX1, pX2, pX3, pY0, pY1, pY2, pY3, o, qr, negm, lsum, KS(0), KS(1), VS(0), kf0, kf1, kf2);
        ATT2_WAIT_BAR(3);
        ATT2_DMA_K(4); ATT2_DMA_V(2);
        step<true, true, false>(sB0, sB1, sA0, sA1, pY0, pY1, pY2, pY3, pX0, pX1, pX2, pX3, o, qr, negm, lsum, KS(1), KS(2), VS(0), kf0, kf1, kf2);
        ATT2_WAIT_BAR(3);
#pragma unroll 1
        for (int i = 1; i + 1 < NT - 1; i += 2) {
#define ATT2_TS(t) ((size_t)((t) < NT ? (t) : NT - 1) * (KVBLK * LDR * 2))
#define ATT2_DARGS(tk, tv) (const char*)Kh + ATT2_TS(tk), voK, (unsigned)__builtin_amdgcn_readfirstlane(kdst + ((tk) & 3) * KSLOT), (const char*)Vh + ATT2_TS(tv), voV[0], voV[1], (unsigned)__builtin_amdgcn_readfirstlane(vdst + ((tv) & 3) * VSLOT)
            step<true, true, true, true>(sA0, sA1, sB0, sB1, pX0, pX1, pX2, pX3, pY0, pY1, pY2, pY3, o, qr, negm, lsum, KS(i + 1), KS(i + 2), VS(i - 1), kf0, kf1, kf2, ATT2_DARGS(i + 4, i + 2));
            ATT2_WAIT_BAR(3);
            step<true, true, true, true>(sB0, sB1, sA0, sA1, pY0, pY1, pY2, pY3, pX0, pX1, pX2, pX3, o, qr, negm, lsum, KS(i + 2), KS(i + 3), VS(i), kf0, kf1, kf2, ATT2_DARGS(i + 5, i + 3));
            ATT2_WAIT_BAR(3);
        }
        step<false, true, true>(sA0, sA1, sB0, sB1, pX0, pX1, pX2, pX3, pY0, pY1, pY2, pY3, o, qr, negm, lsum, KS(0), KS(0), VS(NT - 2), kf0, kf1, kf2);
        ATT2_WAIT_BAR(0);
        step<false, false, true>(sB0, sB1, sA0, sA1, pY0, pY1, pY2, pY3, pX0, pX1, pX2, pX3, o, qr, negm, lsum, KS(0), KS(0), VS(NT - 1), kf0, kf1, kf2);
        ATT2_WAIT_BAR(0);
#undef KS
#undef VS
#undef ATT2_DMA_K
#undef ATT2_DMA_V
        { auto rr = __builtin_amdgcn_permlane32_swap(__float_as_uint(lsum), __float_as_uint(lsum), false, false); lsum = __uint_as_float(rr[0]) + __uint_as_float(rr[1]); }
        if (hi == 0) ws[r32] = lsum; asm volatile("s_waitcnt lgkmcnt(0)" ::: "memory");
        int rowb = q0 + wid * 32; asm volatile("" : "+s"(rowb));
        float rli[16];
#pragma unroll
        for (int r = 0; r < 16; ++r) rli[r] = __builtin_amdgcn_rcpf(ws[crow(r, hi)]);
        float* o0p = O0S + tid; asm volatile("" : "+v"(o0p));
        if (mp == 0) {
#pragma unroll
            for (int d0 = 0; d0 < 4; ++d0)
#pragma unroll
                for (int r = 0; r < 16; ++r) o0p[(d0 * 16 + r) * 512] = o[d0][r] * rli[r];
        } else {
            float ss[16];
#pragma unroll
            for (int r = 0; r < 16; ++r) ss[r] = 0.f;
#pragma unroll
            for (int d0 = 0; d0 < 4; ++d0)
#pragma unroll
                for (int r = 0; r < 16; ++r) { const float c = o0p[(d0 * 16 + r) * 512] - lam * o[d0][r] * rli[r]; o[d0][r] = c; ss[r] += c * c; }
#pragma unroll
            for (int r = 0; r < 16; ++r) {
                ss[r] += lane_xor<1>(ss[r]); ss[r] += lane_xor<2>(ss[r]); ss[r] += lane_xor<4>(ss[r]); ss[r] += lane_xor<8>(ss[r]); ss[r] += lane_xor<16>(ss[r]);
                ss[r] = 0.8f / sqrtf(ss[r] * (1.f / 128.f) + 1e-5f); }
#pragma unroll
            for (int d0 = 0; d0 < 4; ++d0) { const float g = subg[d0 * 32 + r32];
#pragma unroll
                for (int r = 0; r < 16; ++r) MIX[(size_t)(rowb + crow(r, hi)) * D + 512 + h * 128 + d0 * 32 + r32] = (bf16_t)f2bf(o[d0][r] * ss[r] * g); }
        }
        asm volatile("s_waitcnt vmcnt(0) lgkmcnt(0)\n\ts_barrier" ::: "memory");
    }
}
__device__ __forceinline__ void kmax_rows(LAS unsigned char* lds, const bf16_t* KD, unsigned* KMAX2, int gw, int ngw, int lane, int wave) {
    float mx = 0.f;
    for (int row0 = gw; row0 < M; row0 += 8 * ngw) { u32x4 w[8];
#pragma unroll
        for (int i = 0; i < 8; ++i) { const int row = row0 + i * ngw; w[i] = row < M ? *(const GAS u32x4*)(KD + (size_t)row * HSEC + lane * 8) : (u32x4){0u, 0u, 0u, 0u}; }
#pragma unroll
        for (int i = 0; i < 8; ++i) { const u32x4 v = w[i];
            float s = bflo(v.x) * bflo(v.x) + bfhi(v.x) * bfhi(v.x) + bflo(v.y) * bflo(v.y) + bfhi(v.y) * bfhi(v.y) + bflo(v.z) * bflo(v.z) + bfhi(v.z) * bfhi(v.z) + bflo(v.w) * bflo(v.w) + bfhi(v.w) * bfhi(v.w);
            s += lane_xor<1>(s); s += lane_xor<2>(s); s += lane_xor<4>(s); mx = fmaxf(mx, s); } }
    LAS float* red = (LAS float*)lds; if ((lane & 7) == 0) red[wave * 8 + (lane >> 3)] = mx;
    LDS_WAIT(); __syncthreads();
    if (wave == 0 && lane < 8) { float m = red[lane];
#pragma unroll
        for (int w = 1; w < NWAVES; ++w) m = fmaxf(m, red[w * 8 + lane]);
        atomicMax(KMAX2 + lane * 64, __float_as_uint(m)); }
    __syncthreads();
}
}

__device__ __forceinline__ void route16(const bf16_t* X2B, const u32x4* WRB, const float* rgb, const float* reb,
                                        float* RSTD, int* TOKE, float* TOKW, int* TOKR, unsigned* GCNT, int row0, int lane, LAS float* wl, bool dry = false) {
    typedef float f32x4_ __attribute__((ext_vector_type(4)));
    const int r = lane & 15, q = lane >> 4;
    LAS unsigned* lc = (LAS unsigned*)(wl + 800);
    if (lane < 32) lc[lane] = 0u;
    f32x4_ acc[3]; acc[0] = (f32x4_){0.f, 0.f, 0.f, 0.f}; acc[1] = acc[0]; acc[2] = acc[0];
    float ssq = 0.f;
    const bf16_t* xp = X2B + (size_t)(row0 + r) * D + 8 * q;
#pragma unroll 8
    for (int ks = 0; ks < 32; ++ks) {
        const u32x4 xw = *(const GAS u32x4*)(xp + ks * 32);
        ssq += (bflo(xw.x) * bflo(xw.x) + bfhi(xw.x) * bfhi(xw.x)) + (bflo(xw.y) * bflo(xw.y) + bfhi(xw.y) * bfhi(xw.y)) + (bflo(xw.z) * bflo(xw.z) + bfhi(xw.z) * bfhi(xw.z)) + (bflo(xw.w) * bflo(xw.w) + bfhi(xw.w) * bfhi(xw.w));
        const bf16x8 xh = __builtin_bit_cast(bf16x8, xw);
#pragma unroll
        for (int nt = 0; nt < 3; ++nt) {
            const bf16x8 wh = __builtin_bit_cast(bf16x8, WRB[((ks * 3 + nt) * 2 + 0) * 64 + lane]), wlo = __builtin_bit_cast(bf16x8, WRB[((ks * 3 + nt) * 2 + 1) * 64 + lane]);
            acc[nt] = __builtin_amdgcn_mfma_f32_16x16x32_bf16(wh, xh, acc[nt], 0, 0, 0);
            acc[nt] = __builtin_amdgcn_mfma_f32_16x16x32_bf16(wlo, xh, acc[nt], 0, 0, 0);
        }
    }
    ssq += lane_xor<16>(ssq);
    { auto rr = __builtin_amdgcn_permlane32_swap(__float_as_uint(ssq), __float_as_uint(ssq), false, false); ssq = __uint_as_float(rr[0]) + __uint_as_float(rr[1]); }
    const float rstd = 1.f / sqrtf(ssq * (1.f / 1024.f) + 1e-6f);
#pragma unroll
    for (int nt = 0; nt < 3; ++nt) *(LAS f32x4_*)(wl + r * 48 + nt * 16 + 4 * q) = acc[nt] * rstd;
    LDS_WAIT();
    float lg[36];
#pragma unroll
    for (int n4 = 0; n4 < 9; ++n4) { const f32x4_ t = *(const LAS f32x4_*)(wl + r * 48 + 4 * n4); lg[4 * n4] = t[0]; lg[4 * n4 + 1] = t[1]; lg[4 * n4 + 2] = t[2]; lg[4 * n4 + 3] = t[3]; }
    float gl[4];
#pragma unroll
    for (int g = 0; g < 4; ++g) gl[g] = lg[g] + rgb[g];
    int gi = 0; float gm = gl[0];
#pragma unroll
    for (int g = 1; g < 4; ++g) if (gl[g] > gm) { gm = gl[g]; gi = g; }
    float gs = 0.f;
#pragma unroll
    for (int g = 0; g < 4; ++g) gs += __expf(gl[g] - gm);
    const float gp = 1.f / gs;
    float e[8];
#pragma unroll
    for (int j = 0; j < 8; ++j) { const float a0 = lg[4 + j] + reb[j], a1 = lg[12 + j] + reb[8 + j], a2 = lg[20 + j] + reb[16 + j], a3 = lg[28 + j] + reb[24 + j];
        e[j] = gi == 0 ? a0 : gi == 1 ? a1 : gi == 2 ? a2 : a3; }
    int i1 = 0; float m1 = e[0];
#pragma unroll
    for (int j = 1; j < 8; ++j) if (e[j] > m1) { m1 = e[j]; i1 = j; }
    int i2 = 0; float m2 = -3.0e38f;
#pragma unroll
    for (int j = 0; j < 8; ++j) if (j != i1 && e[j] > m2) { m2 = e[j]; i2 = j; }
    const float p2 = __expf(m2 - m1);
    const float w1 = gp / (1.f + p2), w2 = gp * p2 / (1.f + p2);
    if (q == 0 && !dry) { const int row = row0 + r; const int e1 = gi * 8 + i1, e2 = gi * 8 + i2;
        const int r1 = (int)__hip_atomic_fetch_add(lc + e1, 1u, __ATOMIC_RELAXED, __HIP_MEMORY_SCOPE_WORKGROUP), r2 = (int)__hip_atomic_fetch_add(lc + e2, 1u, __ATOMIC_RELAXED, __HIP_MEMORY_SCOPE_WORKGROUP);
        RSTD[row] = rstd; TOKE[row * 2] = e1; TOKE[row * 2 + 1] = e2; TOKW[row * 2] = w1; TOKW[row * 2 + 1] = w2; TOKR[row * 2] = r1; TOKR[row * 2 + 1] = r2; }
    LDS_WAIT();
    if (lane < 32 && !dry) GCNT[(row0 >> 4) * 32 + lane] = lc[lane];
}
__device__ __forceinline__ void build_tile_prefix(volatile LAS int* tb, const unsigned* CNT) {
    if (threadIdx.x == 0) { int acc = 0;
        for (int e = 0; e < 32; ++e) { tb[e] = acc; const int c = (int)__hip_atomic_load(CNT + e * CNT_STRIDE, __ATOMIC_RELAXED, __HIP_MEMORY_SCOPE_AGENT); tb[64 + e] = c; acc += (c + 127) >> 7; }
        tb[32] = acc; }
    LDS_WAIT(); __syncthreads();
}
__device__ __forceinline__ void sort_slots(LAS unsigned char* lds, volatile LAS int* tb, const unsigned* GCNT, const int* TOKE, const int* TOKR, int* TOKS, int* PERM, const float* RSTD, float* RSLOT, unsigned* CNT, int blk, int nblk) {
    const int t = opaque_tid(), e = t & 31, j = t >> 5; constexpr int NG = M / 16;
    const int gpb = (NG + nblk - 1) / nblk, g0 = blk * gpb, g1 = g0 + gpb < NG ? g0 + gpb : NG;
    LAS int* part = (LAS int*)lds; LAS int* part2 = part + 512; LAS int* tot = part2 + 512; LAS int* base0 = tot + 32;
    int s = 0, s2 = 0;
    for (int g = j; g < NG; g += 16) { const int c = (int)GCNT[g * 32 + e]; s += c; s2 += g < g0 ? c : 0; }
    part[j * 32 + e] = s; part2[j * 32 + e] = s2;
    LDS_WAIT(); __syncthreads();
    if (t < 32) { int a = 0, b = 0;
#pragma unroll
        for (int jj = 0; jj < 16; ++jj) { a += part[jj * 32 + t]; b += part2[jj * 32 + t]; }
        tot[t] = a; base0[t] = b; if (blk == 0) __hip_atomic_store(CNT + t * CNT_STRIDE, (unsigned)a, __ATOMIC_RELAXED, __HIP_MEMORY_SCOPE_AGENT); }
    LDS_WAIT(); __syncthreads();
    if (t == 0) { int acc = 0; for (int ee = 0; ee < 32; ++ee) { tb[ee] = acc; tb[64 + ee] = tot[ee]; acc += (tot[ee] + 127) >> 7; } tb[32] = acc; }
    LDS_WAIT(); __syncthreads();
    for (int idx = t; idx < (g1 - g0) * 32; idx += 512) { const int gi = idx >> 5, p = (g0 + gi) * 32 + (idx & 31), ex = TOKE[p]; int base = base0[ex];
        for (int g = g0; g < g0 + gi; ++g) base += (int)GCNT[g * 32 + ex];
        const int slot = tb[ex] * 128 + base + TOKR[p]; TOKS[p] = slot; PERM[slot] = p >> 1; RSLOT[slot] = RSTD[p >> 1]; }
}
template <int NR>
__device__ __forceinline__ void final_rows(const bf16_t* X2B, float* OUT, const unsigned char* Y, const int* TOKS, const float* TOKW, const float* gain, int m0, int stride, int lane) {
    typedef float f32x2_ __attribute__((ext_vector_type(2)));
    int s0[NR], s1[NR]; float w0[NR], w1[NR];
#pragma unroll
    for (int i = 0; i < NR; ++i) { const int row = m0 + i * stride; s0[i] = TOKS[row * 2]; s1[i] = TOKS[row * 2 + 1]; w0[i] = TOKW[row * 2] * (1.f / F8_YSCALE); w1[i] = TOKW[row * 2 + 1] * (1.f / F8_YSCALE); }
    u32x2 xx[NR][4]; unsigned ya[NR][4], yb[NR][4];
#pragma unroll
    for (int i = 0; i < NR; ++i) { const int row = m0 + i * stride;
        const GAS u32x2* xr = (const GAS u32x2*)(X2B + (size_t)row * D) + lane; const GAS unsigned* y0 = (const GAS unsigned*)(Y + (size_t)s0[i] * D) + lane; const GAS unsigned* y1 = (const GAS unsigned*)(Y + (size_t)s1[i] * D) + lane;
#pragma unroll
        for (int j = 0; j < 4; ++j) { xx[i][j] = xr[64 * j]; ya[i][j] = y0[64 * j]; yb[i][j] = y1[64 * j]; } }
#pragma unroll
    for (int i = 0; i < NR; ++i) { const int row = m0 + i * stride; f32x4 v[4]; float s = 0.f;
#pragma unroll
        for (int j = 0; j < 4; ++j) { const u32x2 x_ = xx[i][j];
            const f32x2_ a0 = __builtin_amdgcn_cvt_pk_f32_fp8((int)ya[i][j], false), a1 = __builtin_amdgcn_cvt_pk_f32_fp8((int)ya[i][j], true), b0 = __builtin_amdgcn_cvt_pk_f32_fp8((int)yb[i][j], false), b1 = __builtin_amdgcn_cvt_pk_f32_fp8((int)yb[i][j], true);
            v[j].x = bflo(x_.x) + w0[i] * a0[0] + w1[i] * b0[0]; v[j].y = bfhi(x_.x) + w0[i] * a0[1] + w1[i] * b0[1]; v[j].z = bflo(x_.y) + w0[i] * a1[0] + w1[i] * b1[0]; v[j].w = bfhi(x_.y) + w0[i] * a1[1] + w1[i] * b1[1];
            s += (v[j].x * v[j].x + v[j].y * v[j].y) + (v[j].z * v[j].z + v[j].w * v[j].w); }
        const float rstd = 1.f / sqrtf(wave_sum(s) * (1.f / 1024.f) + 1e-6f);
        GAS f32x4* orow = (GAS f32x4*)(OUT + (size_t)row * D) + lane;
#pragma unroll
        for (int j = 0; j < 4; ++j) { const f32x4 g = ((const GAS f32x4*)gain)[64 * j + lane]; orow[64 * j] = v[j] * rstd * g; } }
}
__device__ __forceinline__ void final_rows_piped(const bf16_t* X2B, float* OUT, const unsigned char* Y, const int* TOKS, const float* TOKW, const float* gain, int m0, int stride, int lane) {
    typedef float f32x2_ __attribute__((ext_vector_type(2)));
    if (m0 >= M) return;
    f32x4 g[4];
#pragma unroll
    for (int j = 0; j < 4; ++j) g[j] = ((const GAS f32x4*)gain)[64 * j + lane];
    u32x2 xc[4], xn[4]; unsigned ac[4], bc[4], an[4], bn[4];
    int s0n, s1n; float w0c, w1c, w0n, w1n, w0f = 0.f, w1f = 0.f; int s0f = 0, s1f = 0;
#define FR_META(row_, s0_, s1_, w0_, w1_) do { s0_ = TOKS[(row_) * 2]; s1_ = TOKS[(row_) * 2 + 1]; w0_ = TOKW[(row_) * 2] * (1.f / F8_YSCALE); w1_ = TOKW[(row_) * 2 + 1] * (1.f / F8_YSCALE); } while (0)
#define FR_LOAD(row_, s0_, s1_, x_, a_, b_) do { const GAS u32x2* xr_ = (const GAS u32x2*)(X2B + (size_t)(row_) * D) + lane; const GAS unsigned* y0_ = (const GAS unsigned*)(Y + (size_t)(s0_) * D) + lane; \
        const GAS unsigned* y1_ = (const GAS unsigned*)(Y + (size_t)(s1_) * D) + lane; _Pragma("unroll") for (int j = 0; j < 4; ++j) { x_[j] = xr_[64 * j]; a_[j] = y0_[64 * j]; b_[j] = y1_[64 * j]; } } while (0)
    { int s0c, s1c; FR_META(m0, s0c, s1c, w0c, w1c); FR_LOAD(m0, s0c, s1c, xc, ac, bc); }
    if (m0 + stride < M) FR_META(m0 + stride, s0n, s1n, w0n, w1n); else { s0n = 0; s1n = 0; w0n = 0.f; w1n = 0.f; }
#pragma unroll 1
    for (int row = m0; row < M; row += stride) {
        const int r1 = row + stride, r2 = row + 2 * stride;
        if (r2 < M) FR_META(r2, s0f, s1f, w0f, w1f);
        if (r1 < M) FR_LOAD(r1, s0n, s1n, xn, an, bn);
        f32x4 v[4]; float s = 0.f;
#pragma unroll
        for (int j = 0; j < 4; ++j) { const u32x2 x_ = xc[j];
            const f32x2_ a0 = __builtin_amdgcn_cvt_pk_f32_fp8((int)ac[j], false), a1 = __builtin_amdgcn_cvt_pk_f32_fp8((int)ac[j], true), b0 = __builtin_amdgcn_cvt_pk_f32_fp8((int)bc[j], false), b1 = __builtin_amdgcn_cvt_pk_f32_fp8((int)bc[j], true);
            v[j].x = bflo(x_.x) + w0c * a0[0] + w1c * b0[0]; v[j].y = bfhi(x_.x) + w0c * a0[1] + w1c * b0[1]; v[j].z = bflo(x_.y) + w0c * a1[0] + w1c * b1[0]; v[j].w = bfhi(x_.y) + w0c * a1[1] + w1c * b1[1];
            s += (v[j].x * v[j].x + v[j].y * v[j].y) + (v[j].z * v[j].z + v[j].w * v[j].w); }
        const float rstd = 1.f / sqrtf(wave_sum(s) * (1.f / 1024.f) + 1e-6f);
        GAS f32x4* orow = (GAS f32x4*)(OUT + (size_t)row * D) + lane;
#pragma unroll
        for (int j = 0; j < 4; ++j) orow[64 * j] = v[j] * rstd * g[j];
#pragma unroll
        for (int j = 0; j < 4; ++j) { xc[j] = xn[j]; ac[j] = an[j]; bc[j] = bn[j]; }
        w0c = w0n; w1c = w1n; s0n = s0f; s1n = s1f; w0n = w0f; w1n = w1f;
    }
#undef FR_META
#undef FR_LOAD
}

#ifndef MK_N_LAUNCHES
#define MK_N_LAUNCHES 1
#endif
constexpr int N_PHASES = 12;
struct Args { const void* in[18]; float* out; unsigned char* ws; int ph_lo, ph_hi; };
static_assert(sizeof(Args) == 18 * 8 + 8 + 8 + 8, "Args has no padding");

__global__ void __launch_bounds__(NWAVES * 64, 2) mk_fwd(Args args) {
    extern __shared__ __attribute__((aligned(16))) unsigned char lds_raw[];
    LAS unsigned char* lds = (LAS unsigned char*)lds_raw;
    volatile LAS unsigned* MISC = (volatile LAS unsigned*)(lds + MISC_OFF);
    const int G = gridDim.x, bx = blockIdx.x, vcu = (G % 8 == 0) ? (bx % 8) * (G / 8) + bx / 8 : bx;
    const int NGW = G * NWAVES;
#define PHASE_IDS const int tid = opaque_tid(), lane = tid & 63, wave = __builtin_amdgcn_readfirstlane(tid >> 6), gw = vcu * NWAVES + wave; (void)lane; (void)gw
    const __attribute__((address_space(4))) Args* A = (const __attribute__((address_space(4))) Args*)__builtin_amdgcn_kernarg_segment_ptr();
    asm volatile("" : "+s"(A));
#define ARGF(i) ((const float*)A->in[i])
#define WSP(T, off) ((T*)(A->ws + (off)))
#define x_in ARGF(0)
#define positions ((const int*)A->in[1])
#define norm1_gain ARGF(2)
#define w_in ARGF(3)
#define hg_lb ARGF(4)
#define hg_norm_gain ARGF(5)
#define diff_lambda ARGF(6)
#define subln_gain ARGF(7)
#define w_out ARGF(8)
#define norm2_gain ARGF(9)
#define rg_w ARGF(10)
#define rg_b ARGF(11)
#define re_w ARGF(12)
#define re_b ARGF(13)
#define w_gate ARGF(14)
#define w_up ARGF(15)
#define w_down ARGF(16)
#define final_gain ARGF(17)
#define out (A->out)
#define cosT WSP(float, WS_ROPE)
#define sinT (WSP(float, WS_ROPE) + M * 8)
#define HD WSP(float, WS_HD)
#define TOKE WSP(int, WS_TOKE)
#define TOKW WSP(float, WS_TOKW)
#define TOKR WSP(int, WS_TOKR)
#define TOKS WSP(int, WS_TOKS)
#define LAMP WSP(float, WS_LAM)
#define WOUT WSP(bf16_t, WS_WOUT)
#define WIN WSP(bf16_t, WS_WIN)
#define XN WSP(bf16_t, WS_XN)
#define QH WSP(bf16_t, WS_QH)
#define VH WSP(bf16_t, WS_VH)
#define SG WSP(bf16_t, WS_SG)
#define QD WSP(bf16_t, WS_QD)
#define KD WSP(bf16_t, WS_KD)
#define VD WSP(bf16_t, WS_VD)
#define GF WSP(half_t, WS_GF)
#define GB WSP(half_t, WS_GB)
#define HS WSP(float, WS_HS)
#define HL WSP(float, WS_HL)
#define OF WSP(float, WS_OF)
#define OB WSP(float, WS_OB)
#define MIX WSP(bf16_t, WS_MIX)
#define X2B WSP(bf16_t, WS_X2B)
#define X2F8 WSP(unsigned char, WS_X2F8)
#define WGU WSP(unsigned char, WS_WGU)
#define WD WSP(unsigned char, WS_WD)
#define HGb WSP(bf16_t, WS_HG)
#define HM WSP(unsigned char, WS_HM)
#define Y WSP(unsigned char, WS_Y)
#define CNT (WSP(unsigned, WS_CTL) + CW_CNT)
    unsigned* ctl = WSP(unsigned, WS_CTL);
    volatile LAS int* tb = (volatile LAS int*)(MISC + 16);

    if (threadIdx.x < 64) MISC[threadIdx.x] = 0u;
    __syncthreads();
    XcdBarrier bar; bar.bar = ctl + CW_BAR; bar.x = 0; bar.st = nullptr;
    const int lo = A->ph_lo, hi = A->ph_hi;
    if (hi - lo > 1) bar = xcd_barrier_post(ctl + CW_BAR, MISC);
#ifndef PH_MASK
#define PH_MASK 0xFFF
#endif
#define IN(k) (((PH_MASK >> (k)) & 1) && lo <= (k) && (k) < hi)
#ifndef DOUBLE_PHASE
#define DOUBLE_PHASE -1
#endif
#define REP(k) for (int rep_ = 0; rep_ < ((DOUBLE_PHASE) == (k) ? 2 : 1); ++rep_)
#ifndef BAR_REPS
#define BAR_REPS 1
#endif
#ifdef DIAG_SPAN_A
#define STAMP(k) do { if (blockIdx.x == 0 && threadIdx.x == 0) WSP(unsigned long long, WS_LAM + 64)[k] = __builtin_amdgcn_s_memrealtime(); } while (0)
#else
#define STAMP(k) do { } while (0)
#endif
#define SEAM(k) do { if (IN(k) && IN((k) + 1)) for (int b_ = 0; b_ < BAR_REPS; ++b_) xcd_barrier(bar); STAMP((k) + 1); } while (0)

    STAMP(0);
    if (IN(0)) REP(0) { PHASE_IDS;
        LAS float* scr = (LAS float*)(lds + wave * 16384);
        constexpr int I_IN = (D / 64) * (NIN / 32), I_OUT = (D / 64) * (D / 32);
        { XposeRegs R;
#define P0_LOAD(it_) do { if ((it_) < I_IN) xpose_load(R, w_in, D, NIN, (it_), lane); else xpose_load(R, w_out, D, D, (it_) - I_IN, lane); } while (0)
            if (gw < I_IN + I_OUT) P0_LOAD(gw);
            for (int it = gw; it < I_IN + I_OUT; it += NGW) { const XposeRegs C = R; const int nx = it + NGW;
                if (nx < I_IN + I_OUT) P0_LOAD(nx);
                if (it < I_IN) xpose_store(C, D, NIN, WIN, 0, 1, scr, it, lane); else xpose_store(C, D, D, WOUT, 0, 1, scr, it - I_IN, lane); }
#undef P0_LOAD
        }
        rms_rows_piped(x_in, norm1_gain, XN, gw, NGW, lane, 1e-6f);
        for (int id = bx * 512 + tid; id < M * 8; id += G * 512) {
            const int i = id & 7; const float invf[8] = {1.0f, 0.19392274474868576f, 0.03760603093086393f, 0.007292664737217109f, 0.001414213562373095f, 0.0002742481756762073f, 5.318295896944988e-05f, 1.031338537721246e-05f};
            float f = invf[0];
#pragma unroll
            for (int q = 1; q < 8; ++q) f = (i == q) ? invf[q] : f;
            const float ang = (float)positions[id >> 3] * f;
            const double rev = (double)ang * 0.15915494309189535; const float fr = (float)(rev - __builtin_rint(rev));
            cosT[id] = __builtin_amdgcn_cosf(fr); sinT[id] = __builtin_amdgcn_sinf(fr);
        }
        for (int id = bx * 512 + tid; id < 32 * 3 * 2 * 64; id += G * 512) {
            const int ln = id & 63, part = (id >> 6) & 1, nt = (id >> 7) % 3, ks = (id >> 7) / 3, n = nt * 16 + (ln & 15), k0 = ks * 32 + 8 * (ln >> 4); unsigned w[4];
#pragma unroll
            for (int jj = 0; jj < 4; ++jj) { float v[2];
#pragma unroll
                for (int u = 0; u < 2; ++u) { const int k = k0 + 2 * jj + u; const float wv = (n < 4 ? rg_w[k * 4 + n] : n < 36 ? re_w[k * 32 + (n - 4)] : 0.f) * norm2_gain[k];
                    const float hv = bf2f(f2bf(wv)); v[u] = part ? wv - hv : hv; }
                w[jj] = pk2(v[0], v[1]); }
            WSP(u32x4, WS_WR)[id] = (u32x4){w[0], w[1], w[2], w[3]}; }
        if (bx == 0 && wave == 0) { const float a = wave_sum(diff_lambda[lane] * diff_lambda[64 + lane]), b = wave_sum(diff_lambda[128 + lane] * diff_lambda[192 + lane]);
            if (lane == 0) LAMP[0] = __expf(a) - __expf(b) + 0.2f; }
    }
    SEAM(0);
    if (IN(1)) REP(1) {
        pg8::Gemm g{XN, WIN, M, NIN, D}; pg8::StaticOrder S; S.init(M, NIN, G, bx);
        EpiInProj E{QH, VH, SG, QD, KD, VD, GF, GB, hg_lb, cosT, sinT};
        pg8::gemm_phase<EpiInProj, pg8::StaticOrder, true, true>(lds, g, S, E);
    }
    SEAM(1);
    if (IN(2)) REP(2) { for (int u = vcu; u < 256; u += G) hg::pass<false>(lds, u, QH, VH, GF, GB, HL, HD, HS, OF, OB);
        { PHASE_IDS; att2::kmax_rows(lds, KD, WSP(unsigned, WS_CTL) + CW_KMAX, gw, NGW, lane, wave); } }
    SEAM(2);
    if (IN(3)) REP(3) hg::scan(HL, HD, HS, bx * 512 + opaque_tid(), G * 512);
    SEAM(3);
    if (IN(4)) REP(4) { for (int u = vcu; u < 256; u += G) hg::pass<true>(lds, u, QH, VH, GF, GB, HL, HD, HS, OF, OB); }
    SEAM(4);
    if (IN(5)) REP(5) { PHASE_IDS;
#ifdef DIAG_CLOCK
        if (blockIdx.x == 0 && threadIdx.x == 0) { WSP(unsigned long long, WS_LAM + 64)[20] = __builtin_amdgcn_s_memtime(); WSP(unsigned long long, WS_LAM + 64)[21] = __builtin_amdgcn_s_memrealtime(); }
#endif
        const float lam = LAMP[0];
        for (int u = vcu; u < 256; u += G) { const int h = u >> 6, q0 = (u & 63) * 256;
            int ln = lane; asm volatile("" : "+v"(ln));
            att::hgrn_finalize(h, q0, OF, OB, SG, hg_norm_gain, MIX, wave, ln);
            att2::unit(lds, h, q0, QD, KD, VD, WSP(unsigned, WS_CTL) + CW_KMAX, WSP(float, WS_O0S) + (size_t)bx * 32768, lam, subln_gain, MIX); }
    }
#ifdef DIAG_CLOCK
    if (blockIdx.x == 0 && threadIdx.x == 0) { WSP(unsigned long long, WS_LAM + 64)[22] = __builtin_amdgcn_s_memtime(); WSP(unsigned long long, WS_LAM + 64)[23] = __builtin_amdgcn_s_memrealtime(); }
#endif
    SEAM(5);
    if (IN(6)) REP(6) {
        pg8::Gemm g{MIX, WOUT, M, D, D}; pg8::StaticOrder S; S.init(M, D, G, bx);
        EpiResid E{x_in, X2B, X2F8};
        pg8::gemm_phase<EpiResid, pg8::StaticOrder, true, true>(lds, g, S, E);
    }
    SEAM(6);
    if (IN(7)) { PHASE_IDS;
        const int grp = wave * G + vcu; const bool router = grp * 16 < M;
        LAS float* scr = (LAS float*)(lds + wave * 16384);
        if (router) route16(X2B, WSP(const u32x4, WS_WR), rg_b, re_b, WSP(float, WS_RSTD), TOKE, TOKW, TOKR, WSP(unsigned, WS_GCNT), grp * 16, lane, scr + 3072);
        if (router && (DOUBLE_PHASE) == 77) route16(X2B, WSP(const u32x4, WS_WR), rg_b, re_b, WSP(float, WS_RSTD), TOKE, TOKW, TOKR, WSP(unsigned, WS_GCNT), grp * 16, lane, scr + 3072, true);
        constexpr int I_GU = (D / 64) * (DEXP / 32), I_DN = (DEXP / 64) * (D / 32), I_ALL = NEXP * (2 * I_GU + I_DN);
#ifndef P7_SHARE
#define P7_SHARE 10
#endif
        const int nrt = M / 16, nA = nrt < NGW ? nrt : NGW, nB = NGW - nA;
        const int perA = nB ? (I_ALL * P7_SHARE / 24 + nA - 1) / nA : (I_ALL + nA - 1) / nA, totA = perA * nA < I_ALL ? perA * nA : I_ALL;
        int it0, it1, stp;
        if (router) { it0 = grp; it1 = totA; stp = nA; } else { it0 = totA + (grp - nA); it1 = I_ALL; stp = nB; }
        REP(7) { XposeRegs R0, R1;
#define P7_LOAD(R, it_) do { const int e_ = (it_) / (2 * I_GU + I_DN), r_ = (it_) % (2 * I_GU + I_DN); \
            if (r_ < I_GU) xpose_load(R, w_gate + (size_t)e_ * D * DEXP, D, DEXP, r_, lane); else if (r_ < 2 * I_GU) xpose_load(R, w_up + (size_t)e_ * D * DEXP, D, DEXP, r_ - I_GU, lane); \
            else xpose_load(R, w_down + (size_t)e_ * DEXP * D, DEXP, D, r_ - 2 * I_GU, lane); } while (0)
#define P7_STORE(C, it_) do { const int e = (it_) / (2 * I_GU + I_DN), r = (it_) % (2 * I_GU + I_DN); \
            if (r < I_GU) xpose_store_f8(C, D, DEXP, WGU + (size_t)e * 1024 * D, 0, 2, scr, r, lane, F8_WSCALE, norm2_gain); \
            else if (r < 2 * I_GU) xpose_store_f8(C, D, DEXP, WGU + (size_t)e * 1024 * D, 1, 2, scr, r - I_GU, lane, F8_WSCALE, norm2_gain); \
            else xpose_store_f8(C, DEXP, D, WD + (size_t)e * 1024 * DEXP, 0, 1, scr, r - 2 * I_GU, lane, F8_WSCALE); } while (0)
            if (it0 < it1) P7_LOAD(R0, it0);
            if (it0 + stp < it1) P7_LOAD(R1, it0 + stp);
            for (int it = it0; it < it1; it += 2 * stp) {
                { const XposeRegs C = R0; if (it + 2 * stp < it1) P7_LOAD(R0, it + 2 * stp); P7_STORE(C, it); }
                if (it + stp < it1) { const XposeRegs C = R1; if (it + 3 * stp < it1) P7_LOAD(R1, it + 3 * stp); P7_STORE(C, it + stp); }
            }
#undef P7_STORE
#undef P7_LOAD
        }
    }
    SEAM(7);
    if (IN(8)) REP(8) { sort_slots(lds, tb, WSP(unsigned, WS_GCNT), TOKE, TOKR, TOKS, WSP(int, WS_PERM), WSP(const float, WS_RSTD), WSP(float, WS_RSLOT), CNT, bx, G); }
    SEAM(8);
    if (IN(9)) REP(9) {
        build_tile_prefix(tb, CNT);
        MoeOrder S{tb, G, bx, WSP(const int, WS_PERM), WSP(unsigned, WS_CTL) + CW_READY, 0}; EpiSwiGlu E{HM, WSP(const float, WS_RSLOT)};
        mg::gemm<EpiSwiGlu, MoeOrder, true>(lds, X2F8, WGU, D, S, E);
    }
    SEAM(9);
    if (IN(10)) REP(10) {
        build_tile_prefix(tb, CNT);
        MoeOrder S{tb, G, bx, WSP(const int, WS_PERM), WSP(unsigned, WS_CTL) + CW_READY, 0}; EpiDown E{Y};
        mg::gemm<EpiDown, MoeOrder, false>(lds, HM, WD, DEXP, S, E);
    }
    SEAM(10);
    if (IN(11)) { PHASE_IDS; final_rows_piped(X2B, out, Y, TOKS, TOKW, final_gain, gw, NGW, lane); }
#ifdef DIAG_SPAN_A
    xcd_barrier(bar); STAMP(12); xcd_barrier(bar);
    { const unsigned long long* st_ = WSP(unsigned long long, WS_LAM + 64);
#ifdef DIAG_CLOCK
      const float d_ = (float)(long long)(st_[22] - st_[20]) / (float)(long long)(st_[23] - st_[21]) * 10.f * DIAG_C;
#else
      const float d_ = (float)(long long)(st_[DIAG_SPAN_B] - st_[DIAG_SPAN_A]) * 0.01f * DIAG_C;
#endif
      for (int m = blockIdx.x * 512 + threadIdx.x; m < M; m += gridDim.x * 512) out[(size_t)m * D] += d_; }
#endif
#undef IN
#undef SEAM
#undef x_in
#undef positions
#undef out
#undef Y
#undef HM
#undef CNT
}

extern "C" void kernel_launch(void* const* d_in, const int* in_sizes, int n_in, void* d_out, int out_size, void* d_ws, size_t ws_size, hipStream_t stream) {
    static int grid = 0;
    if (grid == 0) {
        if (n_in != 18 || in_sizes[0] != M * D || out_size != M * D || ws_size < WS_END) { fprintf(stderr, "kernel_launch: unexpected shapes (n_in %d, in0 %d, out %d, ws %zu)\n", n_in, n_in > 0 ? in_sizes[0] : -1, out_size, ws_size); grid = -1; return; }
        int dev = 0, cus = 0, per_cu = 0;
        if (hipGetDevice(&dev) != hipSuccess || hipDeviceGetAttribute(&cus, hipDeviceAttributeMultiprocessorCount, dev) != hipSuccess) { grid = -1; return; }
        if (hipFuncSetAttribute((const void*)mk_fwd, hipFuncAttributeMaxDynamicSharedMemorySize, LDS_BYTES) != hipSuccess) { fprintf(stderr, "kernel_launch: hipFuncSetAttribute failed\n"); grid = -1; return; }
        if (hipOccupancyMaxActiveBlocksPerMultiprocessor(&per_cu, (const void*)mk_fwd, NWAVES * 64, LDS_BYTES) != hipSuccess || per_cu < 1) { fprintf(stderr, "kernel_launch: occupancy query says %d\n", per_cu); (void)hipGetLastError(); grid = -1; return; }
        grid = cus;
    }
    if (grid < 0) return;
    if (hipMemsetAsync((char*)d_ws + WS_CTL, 0, CTL_ZERO_BYTES, stream) != hipSuccess) return;
    Args a{};
    for (int i = 0; i < 18; ++i) a.in[i] = d_in[i];
    a.out = (float*)d_out; a.ws = (unsigned char*)d_ws;
#if MK_N_LAUNCHES == 1
    a.ph_lo = 0; a.ph_hi = N_PHASES;
    hipLaunchKernelGGL(mk_fwd, dim3(grid), dim3(NWAVES * 64), LDS_BYTES, stream, a);
#else
    for (int p = 0; p < N_PHASES; ++p) { a.ph_lo = p; a.ph_hi = p + 1; hipLaunchKernelGGL(mk_fwd, dim3(grid), dim3(NWAVES * 64), LDS_BYTES, stream, a); }
#endif
}
```
